# Optimizing an MI355X kernel written in HIP

```python
import math
import jax, jax.numpy as jnp
from jax import lax
import numpy as np

D_MODEL = 1024
BATCH = 8
SEQ = 4096
DEPTH = 1

GLA_HEADS = 4
GLA_DK = D_MODEL // 2
GLA_DV = D_MODEL
GLA_GATE_RANK = 16
GLA_TAU = 16.0
GLA_CHUNK = 64
DSA_HEADS = 8
DSA_HEAD_DIM = 128
DSA_LATENT = 256
IDX_HEADS = 8
IDX_DIM = 64
DSA_TOPK = 256
Q_BLOCK = 128
PEER_HEADS = 8
PEER_NKEYS = 128
PEER_NEXPERTS = PEER_NKEYS * PEER_NKEYS
PEER_DKEY = 256
PEER_TOPK = 16
PEER_TOKEN_BLOCK = 128
NORM_EPS = 1e-6

IN_SIZES = (GLA_DK, GLA_DK, GLA_DV, GLA_DV, GLA_GATE_RANK,
            DSA_HEADS * DSA_HEAD_DIM, DSA_LATENT, IDX_HEADS * IDX_DIM, IDX_DIM, IDX_HEADS,
            D_MODEL, D_MODEL)
IN_TOTAL = sum(IN_SIZES)

kernel_name = "hybrid_gla_dsa_peer_block"


def _rmsnorm(x, g):
    x32 = x.astype(jnp.float32)
    y = x32 * lax.rsqrt(jnp.mean(x32 * x32, axis=-1, keepdims=True) + NORM_EPS)
    return (y * g.astype(jnp.float32)).astype(x.dtype)


def _alibi_slopes(n_heads):
    return jnp.exp2(-8.0 * jnp.arange(1, n_heads + 1, dtype=jnp.float32) / n_heads)


def _gla_chunked(q, k, v, log_alpha):
    B, H, S, dk = q.shape
    dv = v.shape[-1]
    C = GLA_CHUNK
    n = S // C
    q, k, v, la = [t.astype(jnp.float32).reshape(B, H, n, C, t.shape[-1]) for t in (q, k, v, log_alpha)]
    b = jnp.cumsum(la, axis=3)
    b_last = b[:, :, :, -1:, :]
    q_dec = q * jnp.exp(b)
    k_inv = k * jnp.exp(-b)
    k_end = k * jnp.exp(b_last - b)
    causal = jnp.tril(jnp.ones((C, C), dtype=bool))
    attn = jnp.where(causal, jnp.einsum('bhnid,bhnjd->bhnij', q_dec, k_inv), 0.0)
    o_intra = jnp.einsum('bhnij,bhnjv->bhniv', attn, v)

    def step(state, inp):
        q_c, k_c, v_c, decay_c = inp
        o_c = jnp.einsum('bhid,bhdv->bhiv', q_c, state)
        state = decay_c[..., None] * state + jnp.einsum('bhjd,bhjv->bhdv', k_c, v_c)
        return state, o_c

    xs = (jnp.moveaxis(q_dec, 2, 0), jnp.moveaxis(k_end, 2, 0), jnp.moveaxis(v, 2, 0),
          jnp.moveaxis(jnp.exp(b_last[:, :, :, 0, :]), 2, 0))
    state0 = jnp.zeros((B, H, dk, dv), jnp.float32)
    _, o_inter = lax.scan(step, state0, xs)
    o = o_intra + jnp.moveaxis(o_inter, 0, 2)
    return o.reshape(B, H, S, dv)


def _gla_branch(q, k, v, r, g_low, w_gate_up, b_gate, norm_g):
    B, S, _ = q.shape
    dkh = GLA_DK // GLA_HEADS
    dvh = GLA_DV // GLA_HEADS
    gate_logit = (g_low @ w_gate_up + b_gate).astype(jnp.float32)
    log_alpha = jax.nn.log_sigmoid(gate_logit) / GLA_TAU

    def heads(t, d):
        return t.reshape(B, S, GLA_HEADS, d).transpose(0, 2, 1, 3)

    o = _gla_chunked(heads(q, dkh) * (dkh ** -0.5), heads(k, dkh), heads(v, dvh), heads(log_alpha, dkh))
    o = o.transpose(0, 2, 1, 3)
    o = _rmsnorm(o, norm_g.reshape(GLA_HEADS, dvh)).reshape(B, S, GLA_DV)
    return o.astype(r.dtype) * jax.nn.silu(r)


def _dsa_branch(q, kv_raw, iq, ik, iw, kv_norm_g, w_uk, w_uv):
    B, S, _ = q.shape
    n_blocks = S // Q_BLOCK
    k_sel = min(DSA_TOPK, S // 4)
    c_kv = _rmsnorm(kv_raw, kv_norm_g)
    slopes = _alibi_slopes(DSA_HEADS)
    key_pos = jnp.arange(S, dtype=jnp.int32)

    def to_blocks(t):
        return t.reshape((B, n_blocks, Q_BLOCK) + t.shape[2:]).swapaxes(0, 1)

    q_b = to_blocks(q.reshape(B, S, DSA_HEADS, DSA_HEAD_DIM))
    iq_b = to_blocks(iq.reshape(B, S, IDX_HEADS, IDX_DIM))
    iw_b = to_blocks(iw)

    def block(inp):
        qb, iqb, iwb, blk = inp
        t = blk * Q_BLOCK + jnp.arange(Q_BLOCK, dtype=jnp.int32)
        rel = jax.nn.relu(jnp.einsum('bqhd,bsd->bqhs', iqb, ik).astype(jnp.float32) * (IDX_DIM ** -0.5))
        score = jnp.einsum('bqh,bqhs->bqs', iwb.astype(jnp.float32) * (IDX_HEADS ** -0.5), rel)
        score = jnp.where(key_pos[None, None, :] <= t[None, :, None], score, -jnp.inf)
        _, idx = lax.top_k(score, k_sel)
        kv_sel = jax.vmap(lambda cb, ib: cb[ib])(c_kv, idx)
        q_lat = jnp.einsum('bqhd,hdc->bqhc', qb, w_uk)
        logits = jnp.einsum('bqhc,bqkc->bqhk', q_lat, kv_sel).astype(jnp.float32) * (DSA_HEAD_DIM ** -0.5)
        dist = t[None, :, None] - idx
        logits = logits - slopes[None, None, :, None] * dist[:, :, None, :].astype(jnp.float32)
        logits = jnp.where((dist >= 0)[:, :, None, :], logits, -jnp.inf)
        p = jax.nn.softmax(logits, axis=-1).astype(kv_sel.dtype)
        o_lat = jnp.einsum('bqhk,bqkc->bqhc', p, kv_sel)
        o = jnp.einsum('bqhc,hcd->bqhd', o_lat, w_uv)
        return o.reshape(B, Q_BLOCK, DSA_HEADS * DSA_HEAD_DIM)

    out = lax.map(block, (q_b, iq_b, iw_b, jnp.arange(n_blocks, dtype=jnp.int32)))
    return out.swapaxes(0, 1).reshape(B, S, DSA_HEADS * DSA_HEAD_DIM)


def _peer(h, w_q, sub_keys_1, sub_keys_2, expert_u, expert_v):
    B, S, D = h.shape
    half = PEER_DKEY // 2
    q = (h @ w_q).reshape(B, S, PEER_HEADS, PEER_DKEY)
    s1 = jnp.einsum('bshd,nd->bshn', q[..., :half], sub_keys_1).astype(jnp.float32)
    s2 = jnp.einsum('bshd,nd->bshn', q[..., half:], sub_keys_2).astype(jnp.float32)
    v1, i1 = lax.top_k(s1, PEER_TOPK)
    v2, i2 = lax.top_k(s2, PEER_TOPK)
    cand = (v1[..., :, None] + v2[..., None, :]).reshape(B, S, PEER_HEADS, PEER_TOPK * PEER_TOPK)
    best, ci = lax.top_k(cand, PEER_TOPK)
    ia = jnp.take_along_axis(i1, ci // PEER_TOPK, axis=-1)
    ib = jnp.take_along_axis(i2, ci % PEER_TOPK, axis=-1)
    expert_idx = ia * PEER_NKEYS + ib
    gates = jax.nn.softmax(best, axis=-1)
    n_blocks = (B * S) // PEER_TOKEN_BLOCK
    h_b = h.reshape(n_blocks, PEER_TOKEN_BLOCK, D)
    i_b = expert_idx.reshape(n_blocks, PEER_TOKEN_BLOCK, PEER_HEADS, PEER_TOPK)
    g_b = gates.reshape(n_blocks, PEER_TOKEN_BLOCK, PEER_HEADS, PEER_TOPK)

    def block(inp):
        hx, ix, gx = inp
        u = expert_u[ix]
        v = expert_v[ix]
        a = jax.nn.gelu(jnp.einsum('td,thkd->thk', hx, u).astype(jnp.float32), approximate=False) * gx
        return jnp.einsum('thk,thkd->td', a.astype(hx.dtype), v)

    return lax.map(block, (h_b, i_b, g_b)).reshape(B, S, D)


def setup_inputs(seed: int = 0) -> dict:
    key = jax.random.key(seed)
    ks = jax.random.split(key, 24)
    D = D_MODEL

    def nrm(k, shape, scale):
        return jax.random.normal(k, shape, jnp.float32) * scale

    def gain(k, shape):
        return 1.0 + 0.1 * jax.random.normal(k, shape, jnp.float32)

    return {
        "x": nrm(ks[0], (BATCH, SEQ, D), 1.0),
        "c": nrm(ks[1], (BATCH, D), 1.0),
        "w_ada": nrm(ks[2], (DEPTH, D, 6 * D), 0.5 * D ** -0.5),
        "b_ada": nrm(ks[3], (DEPTH, 6 * D), 0.02),
        "norm1_g": gain(ks[4], (DEPTH, D)),
        "w_in": nrm(ks[5], (DEPTH, D, IN_TOTAL), D ** -0.5),
        "gla_w_gate_up": nrm(ks[6], (DEPTH, GLA_GATE_RANK, GLA_DK), GLA_GATE_RANK ** -0.5),
        "gla_b_gate": nrm(ks[7], (DEPTH, GLA_DK), 0.1),
        "gla_norm_g": gain(ks[8], (DEPTH, GLA_DV)),
        "dsa_kv_norm_g": gain(ks[9], (DEPTH, DSA_LATENT)),
        "dsa_w_uk": nrm(ks[10], (DEPTH, DSA_HEADS, DSA_HEAD_DIM, DSA_LATENT), DSA_HEAD_DIM ** -0.5),
        "dsa_w_uv": nrm(ks[11], (DEPTH, DSA_HEADS, DSA_LATENT, DSA_HEAD_DIM), DSA_LATENT ** -0.5),
        "w_branch_a": nrm(ks[12], (DEPTH, GLA_DV, D), GLA_DV ** -0.5),
        "w_branch_b": nrm(ks[13], (DEPTH, DSA_HEADS * DSA_HEAD_DIM, D), (DSA_HEADS * DSA_HEAD_DIM) ** -0.5),
        "w_out": nrm(ks[14], (DEPTH, D, D), D ** -0.5),
        "norm2_g": gain(ks[15], (DEPTH, D)),
        "peer_w_q": nrm(ks[16], (DEPTH, D, PEER_HEADS * PEER_DKEY), D ** -0.5),
        "peer_sub_keys_1": nrm(ks[17], (DEPTH, PEER_NKEYS, PEER_DKEY // 2), (PEER_DKEY // 2) ** -0.5),
        "peer_sub_keys_2": nrm(ks[18], (DEPTH, PEER_NKEYS, PEER_DKEY // 2), (PEER_DKEY // 2) ** -0.5),
        "peer_u": nrm(ks[19], (DEPTH, PEER_NEXPERTS, D), D ** -0.5),
        "peer_v": nrm(ks[20], (DEPTH, PEER_NEXPERTS, D), PEER_HEADS ** -0.5),
        "final_norm_g": gain(ks[21], (D,)),
    }


def reference(x, c, w_ada, b_ada, norm1_g, w_in, gla_w_gate_up, gla_b_gate, gla_norm_g,
              dsa_kv_norm_g, dsa_w_uk, dsa_w_uv, w_branch_a, w_branch_b, w_out, norm2_g,
              peer_w_q, peer_sub_keys_1, peer_sub_keys_2, peer_u, peer_v, final_norm_g):
    split_points = np.cumsum(IN_SIZES)[:-1].tolist()
    for l in range(DEPTH):
        ada = jax.nn.silu(c) @ w_ada[l] + b_ada[l]
        shift1, scale1, gate1, shift2, scale2, gate2 = jnp.split(ada[:, None, :], 6, axis=-1)

        h = _rmsnorm(x, norm1_g[l]) * (1.0 + scale1) + shift1
        proj = h @ w_in[l]
        (gq, gk, gv, gr, glow, dq, dkv, iq, ik, iw, za, zb) = jnp.split(proj, split_points, axis=-1)
        ya = _gla_branch(gq, gk, gv, gr, glow, gla_w_gate_up[l], gla_b_gate[l], gla_norm_g[l]) @ w_branch_a[l]
        yb = _dsa_branch(dq, dkv, iq, ik, iw, dsa_kv_norm_g[l], dsa_w_uk[l], dsa_w_uv[l]) @ w_branch_b[l]
        y = (jax.nn.sigmoid(za) * ya + jax.nn.sigmoid(zb) * yb) @ w_out[l]
        x = x + gate1 * y

        h2 = _rmsnorm(x, norm2_g[l]) * (1.0 + scale2) + shift2
        x = x + gate2 * _peer(h2, peer_w_q[l], peer_sub_keys_1[l], peer_sub_keys_2[l], peer_u[l], peer_v[l])
    return _rmsnorm(x, final_norm_g)
```

```cpp
#include <hip/hip_runtime.h>
#include <hip/hip_cooperative_groups.h>
#include <cstdio>
#include <cstdint>
namespace cg = cooperative_groups;

#ifndef ONE_LAUNCH
#define ONE_LAUNCH 1
#endif

#define TT 32768
#define SEQ 4096
#define DM 1024
#define NIN 7000
typedef unsigned short bf16;

struct P {
  const float *x, *c, *w_ada, *b_ada, *norm1_g, *w_in, *w_gate_up, *b_gate, *gla_norm_g, *kv_norm_g,
      *w_uk, *w_uv, *w_a, *w_b, *w_out, *norm2_g, *w_q, *sk1, *sk2, *peer_u, *peer_v, *final_g;
  float* out;
  char* ws;
};

#define MB (1ull << 20)
#define OFF_ADA   (0ull)
#define OFF_H     (1 * MB)
#define OFF_Q     (65 * MB)
#define OFF_K     (97 * MB)
#define OFF_MIX   (65 * MB)
#define OFF_V     (129 * MB)
#define OFF_DQ    (193 * MB)
#define OFF_PQ    (129 * MB)
#define OFF_CKVR  (257 * MB)
#define OFF_CKV   (289 * MB)
#define OFF_IQ    (305 * MB)
#define OFF_IK    (337 * MB)
#define OFF_IW    (341 * MB)
#define OFF_GLOW  (342 * MB)
#define OFF_ODSA  (344 * MB)
#define WS_NEED   (408 * MB)

__device__ __forceinline__ bf16 f2bf(float f) {
  unsigned u = __float_as_uint(f);
  u += 0x7fffu + ((u >> 16) & 1u);
  return (bf16)(u >> 16);
}
__device__ __forceinline__ float bf2f(bf16 h) { return __uint_as_float(((unsigned)h) << 16); }
__device__ __forceinline__ float wave_sum(float v) {
#pragma unroll
  for (int o = 32; o > 0; o >>= 1) v += __shfl_xor(v, o);
  return v;
}
__device__ __forceinline__ float wave_max(float v) {
#pragma unroll
  for (int o = 32; o > 0; o >>= 1) v = fmaxf(v, __shfl_xor(v, o));
  return v;
}
__device__ __forceinline__ float sigmoidf_(float v) { return 1.f / (1.f + __expf(-v)); }
__device__ __forceinline__ float siluf_(float v) { return v / (1.f + __expf(-v)); }

__device__ void ph_ada(const P& p, int bid, int nb, float* sm) {
  float* ada = (float*)(p.ws + OFF_ADA);
  for (int i = threadIdx.x; i < 8 * 1024; i += 256) sm[i] = siluf_(p.c[i]);
  __syncthreads();
  for (int cb = bid; cb < 6144 / 256; cb += nb) {
    int n = cb * 256 + threadIdx.x;
    float acc[8];
#pragma unroll
    for (int b = 0; b < 8; ++b) acc[b] = 0.f;
    for (int k = 0; k < 1024; ++k) {
      float w = p.w_ada[(size_t)k * 6144 + n];
#pragma unroll
      for (int b = 0; b < 8; ++b) acc[b] += sm[b * 1024 + k] * w;
    }
    float bb = p.b_ada[n];
#pragma unroll
    for (int b = 0; b < 8; ++b) ada[b * 6144 + n] = acc[b] + bb;
  }
  __syncthreads();
}

__device__ void ph_mod(const P& p, const float* X, const float* g, int shift_off, int scale_off, bf16* H, int bid, int nb) {
  const float* ada = (const float*)(p.ws + OFF_ADA);
  int wave = threadIdx.x >> 6, lane = threadIdx.x & 63;
  for (int row = bid * 4 + wave; row < TT; row += nb * 4) {
    const float4* xr = (const float4*)(X + (size_t)row * DM);
    float4 v[4];
    float ss = 0.f;
#pragma unroll
    for (int i = 0; i < 4; ++i) {
      v[i] = xr[lane + i * 64];
      ss += v[i].x * v[i].x + v[i].y * v[i].y + v[i].z * v[i].z + v[i].w * v[i].w;
    }
    ss = wave_sum(ss);
    float rstd = rsqrtf(ss * (1.f / DM) + 1e-6f);
    int b = row >> 12;
    const float* sh = ada + b * 6144 + shift_off;
    const float* sc = ada + b * 6144 + scale_off;
#pragma unroll
    for (int i = 0; i < 4; ++i) {
      int c0 = (lane + i * 64) * 4;
      float4 gg = *(const float4*)(g + c0);
      float4 s4 = *(const float4*)(sc + c0);
      float4 h4 = *(const float4*)(sh + c0);
      ushort4 o;
      o.x = f2bf(v[i].x * rstd * gg.x * (1.f + s4.x) + h4.x);
      o.y = f2bf(v[i].y * rstd * gg.y * (1.f + s4.y) + h4.y);
      o.z = f2bf(v[i].z * rstd * gg.z * (1.f + s4.z) + h4.z);
      o.w = f2bf(v[i].w * rstd * gg.w * (1.f + s4.w) + h4.w);
      *(ushort4*)(H + (size_t)row * DM + c0) = o;
    }
  }
}

__device__ __forceinline__ void nacc(float (&acc)[32], const bf16* A, int lda, int row0, const float* W, int ldw, int n,
                                     bool nvalid, int K, float* sm) {
  for (int k0 = 0; k0 < K; k0 += 128) {
    __syncthreads();
    for (int i = threadIdx.x; i < 32 * 128; i += 256) {
      int r = i >> 7, kk = i & 127;
      sm[i] = bf2f(A[(size_t)(row0 + r) * lda + k0 + kk]);
    }
    __syncthreads();
    if (nvalid) {
      for (int kk = 0; kk < 128; kk += 4) {
        const float* wp = W + (size_t)(k0 + kk) * ldw + n;
        float w0 = wp[0], w1 = wp[ldw], w2 = wp[2 * (size_t)ldw], w3 = wp[3 * (size_t)ldw];
#pragma unroll
        for (int r = 0; r < 32; ++r) {
          float4 a = *(const float4*)&sm[r * 128 + kk];
          acc[r] += a.x * w0 + a.y * w1 + a.z * w2 + a.w * w3;
        }
      }
    }
  }
}

__device__ void ph_inproj(const P& p, int bid, int nb, float* sm) {
  const bf16* H = (const bf16*)(p.ws + OFF_H);
  bf16* Q = (bf16*)(p.ws + OFF_Q);
  bf16* K = (bf16*)(p.ws + OFF_K);
  bf16* V = (bf16*)(p.ws + OFF_V);
  bf16* DQ = (bf16*)(p.ws + OFF_DQ);
  float* CKVR = (float*)(p.ws + OFF_CKVR);
  bf16* IQ = (bf16*)(p.ws + OFF_IQ);
  bf16* IK = (bf16*)(p.ws + OFF_IK);
  float* IW = (float*)(p.ws + OFF_IW);
  float* GLOW = (float*)(p.ws + OFF_GLOW);
  for (int it = bid; it < 16 * 1024; it += nb) {
    int cbi = it & 15, rt = it >> 4;
    int cb = cbi < 8 ? cbi : cbi + 4;
    int n = cb * 256 + threadIdx.x;
    bool valid = n < 4952;
    int row0 = rt * 32;
    float acc[32];
#pragma unroll
    for (int r = 0; r < 32; ++r) acc[r] = 0.f;
    nacc(acc, H, DM, row0, p.w_in, NIN, n, valid, DM, sm);
    if (valid) {
#pragma unroll
      for (int r = 0; r < 32; ++r) {
        size_t t = row0 + r;
        float v = acc[r];
        if (n < 512) Q[t * 512 + n] = f2bf(v * 0.08838834764831845f);
        else if (n < 1024) K[t * 512 + (n - 512)] = f2bf(v);
        else if (n < 2048) V[t * 1024 + (n - 1024)] = f2bf(v);
        else if (n < 3072) {}
        else if (n < 3088) GLOW[t * 16 + (n - 3072)] = v;
        else if (n < 4112) DQ[t * 1024 + (n - 3088)] = f2bf(v);
        else if (n < 4368) CKVR[t * 256 + (n - 4112)] = v;
        else if (n < 4880) IQ[t * 512 + (n - 4368)] = f2bf(v * 0.125f);
        else if (n < 4944) IK[t * 64 + (n - 4880)] = f2bf(v);
        else IW[t * 8 + (n - 4944)] = v * 0.35355339059327373f;
      }
    }
  }
}

__device__ void ph_ckvnorm(const P& p, int bid, int nb) {
  const float* CKVR = (const float*)(p.ws + OFF_CKVR);
  bf16* CKV = (bf16*)(p.ws + OFF_CKV);
  int wave = threadIdx.x >> 6, lane = threadIdx.x & 63;
  for (int row = bid * 4 + wave; row < TT; row += nb * 4) {
    float4 v = *(const float4*)(CKVR + (size_t)row * 256 + lane * 4);
    float ss = wave_sum(v.x * v.x + v.y * v.y + v.z * v.z + v.w * v.w);
    float rstd = rsqrtf(ss * (1.f / 256.f) + 1e-6f);
    float4 g = *(const float4*)(p.kv_norm_g + lane * 4);
    ushort4 o;
    o.x = f2bf(v.x * rstd * g.x); o.y = f2bf(v.y * rstd * g.y); o.z = f2bf(v.z * rstd * g.z); o.w = f2bf(v.w * rstd * g.w);
    *(ushort4*)(CKV + (size_t)row * 256 + lane * 4) = o;
  }
}

#define GCH 16
__device__ void ph_gla(const P& p, int item, float* sm) {
  const bf16* Q = (const bf16*)(p.ws + OFF_Q);
  const bf16* K = (const bf16*)(p.ws + OFF_K);
  bf16* V = (bf16*)(p.ws + OFF_V);
  const float* GLOW = (const float*)(p.ws + OFF_GLOW);
  float* qs = sm;
  float* ks = qs + GCH * 128;
  float* as = ks + GCH * 128;
  float* os = as + GCH * 128;
  int b = item >> 2, h = item & 3, j = threadIdx.x;
  int wave = threadIdx.x >> 6, lane = threadIdx.x & 63;
  float S[128];
#pragma unroll
  for (int d = 0; d < 128; ++d) S[d] = 0.f;
  for (int t0 = 0; t0 < SEQ; t0 += GCH) {
    __syncthreads();
    for (int i = threadIdx.x; i < GCH * 128; i += 256) {
      int tt = i >> 7, d = i & 127;
      size_t tok = (size_t)b * SEQ + t0 + tt;
      qs[i] = bf2f(Q[tok * 512 + h * 128 + d]);
      ks[i] = bf2f(K[tok * 512 + h * 128 + d]);
      float gl = p.b_gate[h * 128 + d];
#pragma unroll
      for (int r = 0; r < 16; ++r) gl += GLOW[tok * 16 + r] * p.w_gate_up[r * 512 + h * 128 + d];
      float ls = fminf(gl, 0.f) - log1pf(__expf(-fabsf(gl)));
      as[i] = __expf(ls * (1.f / 16.f));
    }
    __syncthreads();
    for (int tt = 0; tt < GCH; ++tt) {
      size_t tok = (size_t)b * SEQ + t0 + tt;
      float v = bf2f(V[tok * 1024 + h * 256 + j]);
      float o = 0.f;
#pragma unroll
      for (int d = 0; d < 128; d += 4) {
        float4 a4 = *(const float4*)&as[tt * 128 + d];
        float4 k4 = *(const float4*)&ks[tt * 128 + d];
        float4 q4 = *(const float4*)&qs[tt * 128 + d];
        S[d + 0] = a4.x * S[d + 0] + k4.x * v; o += q4.x * S[d + 0];
        S[d + 1] = a4.y * S[d + 1] + k4.y * v; o += q4.y * S[d + 1];
        S[d + 2] = a4.z * S[d + 2] + k4.z * v; o += q4.z * S[d + 2];
        S[d + 3] = a4.w * S[d + 3] + k4.w * v; o += q4.w * S[d + 3];
      }
      os[tt * 256 + j] = o;
    }
    __syncthreads();
    for (int tt = wave; tt < GCH; tt += 4) {
      size_t tok = (size_t)b * SEQ + t0 + tt;
      float4 o4 = *(const float4*)&os[tt * 256 + lane * 4];
      float ss = wave_sum(o4.x * o4.x + o4.y * o4.y + o4.z * o4.z + o4.w * o4.w);
      float rstd = rsqrtf(ss * (1.f / 256.f) + 1e-6f);
      float4 g = *(const float4*)(p.gla_norm_g + h * 256 + lane * 4);
      ushort4 o;
      o.x = f2bf(o4.x * rstd * g.x); o.y = f2bf(o4.y * rstd * g.y); o.z = f2bf(o4.z * rstd * g.z); o.w = f2bf(o4.w * rstd * g.w);
      *(ushort4*)(V + tok * 1024 + h * 256 + lane * 4) = o;
    }
  }
  __syncthreads();
}

__device__ __forceinline__ int block_scan_incl(int v, int* buf) {
  int tid = threadIdx.x;
  buf[tid] = v;
  __syncthreads();
#pragma unroll
  for (int o = 1; o < 256; o <<= 1) {
    int a = (tid >= o) ? buf[tid - o] : 0;
    __syncthreads();
    buf[tid] += a;
    __syncthreads();
  }
  int r = buf[tid];
  __syncthreads();
  return r;
}

__device__ __forceinline__ unsigned f2ord(float f) {
  if (f == 0.f) f = 0.f;
  unsigned u = __float_as_uint(f);
  return (u & 0x80000000u) ? ~u : (u | 0x80000000u);
}

__device__ void ph_dsa(const P& p, int tok, float* sm) {
  const bf16* DQ = (const bf16*)(p.ws + OFF_DQ);
  const bf16* CKV = (const bf16*)(p.ws + OFF_CKV);
  const bf16* IQ = (const bf16*)(p.ws + OFF_IQ);
  const bf16* IK = (const bf16*)(p.ws + OFF_IK);
  const float* IW = (const float*)(p.ws + OFF_IW);
  bf16* ODSA = (bf16*)(p.ws + OFF_ODSA);
  float* sc = sm;
  float* iqs = sc + 4096;
  float* qlat = iqs + 512;
  float* pp = qlat + 2048;
  float* olat = pp + 2048;
  int* selidx = (int*)(olat + 2048);
  int* ibuf = selidx + 256;
  int* misc = ibuf + 256;
  int tid = threadIdx.x, wave = tid >> 6, lane = tid & 63;
  int b = tok >> 12, t = tok & 4095;
  __syncthreads();
  for (int i = tid; i < 512; i += 256) iqs[i] = bf2f(IQ[(size_t)tok * 512 + i]);
  for (int i = tid; i < 1024; i += 256) pp[i] = bf2f(DQ[(size_t)tok * 1024 + i]);
  __syncthreads();
#pragma unroll 1
  for (int h = 0; h < 8; ++h) {
    float acc = 0.f;
    const float* w = p.w_uk + (size_t)h * 128 * 256 + tid;
    for (int d = 0; d < 128; ++d) acc += pp[h * 128 + d] * w[(size_t)d * 256];
    qlat[h * 256 + tid] = acc * 0.08838834764831845f;
  }
  float iw[8];
#pragma unroll
  for (int h = 0; h < 8; ++h) iw[h] = IW[(size_t)tok * 8 + h];
  for (int m = 0; m < 16; ++m) {
    int s = tid * 16 + m;
    float score = -INFINITY;
    if (s <= t) {
      const uint4* kr = (const uint4*)(IK + ((size_t)b * SEQ + s) * 64);
      float kf[64];
#pragma unroll
      for (int i = 0; i < 8; ++i) {
        uint4 u = kr[i];
        kf[i * 8 + 0] = __uint_as_float(u.x << 16); kf[i * 8 + 1] = __uint_as_float(u.x & 0xffff0000u);
        kf[i * 8 + 2] = __uint_as_float(u.y << 16); kf[i * 8 + 3] = __uint_as_float(u.y & 0xffff0000u);
        kf[i * 8 + 4] = __uint_as_float(u.z << 16); kf[i * 8 + 5] = __uint_as_float(u.z & 0xffff0000u);
        kf[i * 8 + 6] = __uint_as_float(u.w << 16); kf[i * 8 + 7] = __uint_as_float(u.w & 0xffff0000u);
      }
      score = 0.f;
#pragma unroll
      for (int h = 0; h < 8; ++h) {
        float d = 0.f;
#pragma unroll
        for (int e = 0; e < 64; ++e) d += iqs[h * 64 + e] * kf[e];
        score += iw[h] * fmaxf(d, 0.f);
      }
    }
    sc[s] = score;
  }
  __syncthreads();
  int nsel = (t + 1 < 256) ? (t + 1) : 256;
  if (t + 1 <= 256) {
    if (tid <= t) selidx[tid] = tid;
    __syncthreads();
  } else {
    unsigned prefix = 0, mask = 0;
    int krem = 256;
    for (int pass = 0; pass < 4; ++pass) {
      int shift = 24 - 8 * pass;
      ibuf[tid] = 0;
      __syncthreads();
      for (int m = 0; m < 16; ++m) {
        int s = tid * 16 + m;
        if (s <= t) {
          unsigned u = f2ord(sc[s]);
          if ((u & mask) == prefix) atomicAdd(&ibuf[(u >> shift) & 255], 1);
        }
      }
      __syncthreads();
      int d = 255 - tid;
      int hd = ibuf[d];
      __syncthreads();
      int incl = block_scan_incl(hd, ibuf);
      int above = incl - hd;
      if (above < krem && incl >= krem) { misc[0] = d; misc[1] = krem - above; }
      __syncthreads();
      prefix |= ((unsigned)misc[0]) << shift;
      mask |= 255u << shift;
      krem = misc[1];
      __syncthreads();
    }
    int cgt = 0, ceq = 0;
    for (int m = 0; m < 16; ++m) {
      int s = tid * 16 + m;
      if (s <= t) {
        unsigned u = f2ord(sc[s]);
        cgt += (u > prefix);
        ceq += (u == prefix);
      }
    }
    int eq_incl = block_scan_incl(ceq, ibuf);
    int eq_before = eq_incl - ceq;
    int take_eq = krem - eq_before;
    take_eq = take_eq < 0 ? 0 : (take_eq > ceq ? ceq : take_eq);
    int nmine = cgt + take_eq;
    int pos_incl = block_scan_incl(nmine, ibuf);
    int pos = pos_incl - nmine;
    int eqc = 0;
    for (int m = 0; m < 16; ++m) {
      int s = tid * 16 + m;
      if (s <= t) {
        unsigned u = f2ord(sc[s]);
        bool take = (u > prefix);
        if (u == prefix) { take = eqc < take_eq; ++eqc; }
        if (take) { if (pos < 256) selidx[pos] = s; ++pos; }
      }
    }
    __syncthreads();
  }
  {
    float lg[8];
#pragma unroll
    for (int h = 0; h < 8; ++h) lg[h] = 0.f;
    int s = 0;
    if (tid < nsel) {
      s = selidx[tid];
      const uint4* kr = (const uint4*)(CKV + ((size_t)b * SEQ + s) * 256);
      for (int i = 0; i < 32; ++i) {
        uint4 u = kr[i];
        float f[8];
        f[0] = __uint_as_float(u.x << 16); f[1] = __uint_as_float(u.x & 0xffff0000u);
        f[2] = __uint_as_float(u.y << 16); f[3] = __uint_as_float(u.y & 0xffff0000u);
        f[4] = __uint_as_float(u.z << 16); f[5] = __uint_as_float(u.z & 0xffff0000u);
        f[6] = __uint_as_float(u.w << 16); f[7] = __uint_as_float(u.w & 0xffff0000u);
#pragma unroll
        for (int h = 0; h < 8; ++h) {
#pragma unroll
          for (int e = 0; e < 8; ++e) lg[h] += qlat[h * 256 + i * 8 + e] * f[e];
        }
      }
    }
    float dist = (float)(t - s);
#pragma unroll
    for (int h = 0; h < 8; ++h) {
      float slope = exp2f(-(float)(h + 1));
      pp[h * 256 + tid] = (tid < nsel) ? (lg[h] - slope * dist) : -INFINITY;
    }
  }
  __syncthreads();
  for (int h = wave; h < 8; h += 4) {
    float4 v = *(const float4*)&pp[h * 256 + lane * 4];
    float mx = wave_max(fmaxf(fmaxf(v.x, v.y), fmaxf(v.z, v.w)));
    v.x = __expf(v.x - mx); v.y = __expf(v.y - mx); v.z = __expf(v.z - mx); v.w = __expf(v.w - mx);
    float sum = wave_sum(v.x + v.y + v.z + v.w);
    float inv = 1.f / sum;
    v.x *= inv; v.y *= inv; v.z *= inv; v.w *= inv;
    *(float4*)&pp[h * 256 + lane * 4] = v;
  }
  __syncthreads();
  {
    float acc[8];
#pragma unroll
    for (int h = 0; h < 8; ++h) acc[h] = 0.f;
    for (int jj = 0; jj < nsel; ++jj) {
      int s = selidx[jj];
      float v = bf2f(CKV[((size_t)b * SEQ + s) * 256 + tid]);
#pragma unroll
      for (int h = 0; h < 8; ++h) acc[h] += pp[h * 256 + jj] * v;
    }
#pragma unroll
    for (int h = 0; h < 8; ++h) olat[h * 256 + tid] = acc[h];
  }
  __syncthreads();
#pragma unroll 1
  for (int i = 0; i < 4; ++i) {
    int n = i * 256 + tid;
    int h = n >> 7, d = n & 127;
    float acc = 0.f;
    const float* w = p.w_uv + (size_t)h * 256 * 128 + d;
    for (int c = 0; c < 256; ++c) acc += olat[h * 256 + c] * w[(size_t)c * 128];
    ODSA[(size_t)tok * 1024 + n] = f2bf(acc);
  }
}

__device__ void ph_g(const P& p, int bid, int nb, float* sm) {
  const bf16* H = (const bf16*)(p.ws + OFF_H);
  bf16* O = (bf16*)(p.ws + OFF_V);
  for (int it = bid; it < 4 * 1024; it += nb) {
    int cb = it & 3, rt = it >> 2;
    int n = cb * 256 + threadIdx.x;
    int row0 = rt * 32;
    float acc[32];
#pragma unroll
    for (int r = 0; r < 32; ++r) acc[r] = 0.f;
    nacc(acc, H, DM, row0, p.w_in + 2048, NIN, n, true, DM, sm);
#pragma unroll
    for (int r = 0; r < 32; ++r) {
      size_t idx = (size_t)(row0 + r) * 1024 + n;
      O[idx] = f2bf(bf2f(O[idx]) * siluf_(acc[r]));
    }
  }
}

__device__ void ph_mix(const P& p, int bid, int nb, float* sm) {
  const bf16* H = (const bf16*)(p.ws + OFF_H);
  const bf16* G = (const bf16*)(p.ws + OFF_V);
  const bf16* OD = (const bf16*)(p.ws + OFF_ODSA);
  bf16* MIX = (bf16*)(p.ws + OFF_MIX);
  for (int it = bid; it < 4 * 1024; it += nb) {
    int cb = it & 3, rt = it >> 2;
    int n = cb * 256 + threadIdx.x;
    int row0 = rt * 32;
    float m[32], y[32], z[32];
#pragma unroll
    for (int r = 0; r < 32; ++r) { y[r] = 0.f; z[r] = 0.f; }
    nacc(y, G, DM, row0, p.w_a, DM, n, true, DM, sm);
    nacc(z, H, DM, row0, p.w_in + 4952, NIN, n, true, DM, sm);
#pragma unroll
    for (int r = 0; r < 32; ++r) { m[r] = sigmoidf_(z[r]) * y[r]; y[r] = 0.f; z[r] = 0.f; }
    nacc(y, OD, DM, row0, p.w_b, DM, n, true, DM, sm);
    nacc(z, H, DM, row0, p.w_in + 5976, NIN, n, true, DM, sm);
#pragma unroll
    for (int r = 0; r < 32; ++r) {
      m[r] += sigmoidf_(z[r]) * y[r];
      MIX[(size_t)(row0 + r) * 1024 + n] = f2bf(m[r]);
    }
  }
}

__device__ void ph_x1(const P& p, int bid, int nb, float* sm) {
  const bf16* MIX = (const bf16*)(p.ws + OFF_MIX);
  const float* ada = (const float*)(p.ws + OFF_ADA);
  for (int it = bid; it < 4 * 1024; it += nb) {
    int cb = it & 3, rt = it >> 2;
    int n = cb * 256 + threadIdx.x;
    int row0 = rt * 32;
    float acc[32];
#pragma unroll
    for (int r = 0; r < 32; ++r) acc[r] = 0.f;
    nacc(acc, MIX, DM, row0, p.w_out, DM, n, true, DM, sm);
    int b = row0 >> 12;
    float g1 = ada[b * 6144 + 2048 + n];
#pragma unroll
    for (int r = 0; r < 32; ++r) {
      size_t idx = (size_t)(row0 + r) * 1024 + n;
      p.out[idx] = p.x[idx] + g1 * acc[r];
    }
  }
}

__device__ void ph_pq(const P& p, int bid, int nb, float* sm) {
  const bf16* H2 = (const bf16*)(p.ws + OFF_H);
  bf16* PQ = (bf16*)(p.ws + OFF_PQ);
  for (int it = bid; it < 8 * 1024; it += nb) {
    int cb = it & 7, rt = it >> 3;
    int n = cb * 256 + threadIdx.x;
    int row0 = rt * 32;
    float acc[32];
#pragma unroll
    for (int r = 0; r < 32; ++r) acc[r] = 0.f;
    nacc(acc, H2, DM, row0, p.w_q, 2048, n, true, DM, sm);
#pragma unroll
    for (int r = 0; r < 32; ++r) PQ[(size_t)(row0 + r) * 2048 + n] = f2bf(acc[r]);
  }
}

__device__ void ph_peer(const P& p, int tok, float* sm) {
  const bf16* H2 = (const bf16*)(p.ws + OFF_H);
  const bf16* PQ = (const bf16*)(p.ws + OFF_PQ);
  const float* ada = (const float*)(p.ws + OFF_ADA);
  float* h2 = sm;
  float* q = h2 + 1024;
  float* s12 = q + 2048;
  float* v12 = s12 + 256;
  int* i12 = (int*)(v12 + 32);
  float* cand = (float*)(i12 + 32);
  float* best = cand + 256;
  int* ci = (int*)(best + 16);
  int* eidx = ci + 16;
  float* eg = (float*)(eidx + 128);
  float* red = eg + 128;
  int tid = threadIdx.x, wave = tid >> 6, lane = tid & 63;
  __syncthreads();
  for (int i = tid; i < 1024; i += 256) h2[i] = bf2f(H2[(size_t)tok * 1024 + i]);
  for (int i = tid; i < 2048; i += 256) q[i] = bf2f(PQ[(size_t)tok * 2048 + i]);
  __syncthreads();
#pragma unroll 1
  for (int hd = 0; hd < 8; ++hd) {
    int half = tid >> 7, n = tid & 127;
    {
      const float* keys = (half ? p.sk2 : p.sk1) + (size_t)n * 128;
      const float* qq = q + hd * 256 + half * 128;
      float acc = 0.f;
      for (int d = 0; d < 128; d += 4) {
        float4 k4 = *(const float4*)(keys + d);
        acc += qq[d] * k4.x + qq[d + 1] * k4.y + qq[d + 2] * k4.z + qq[d + 3] * k4.w;
      }
      s12[tid] = acc;
    }
    __syncthreads();
    {
      float mine = s12[tid];
      int r = 0;
      const float* sb = s12 + half * 128;
      for (int m = 0; m < 128; ++m) {
        float o = sb[m];
        r += (o > mine) || (o == mine && m < n);
      }
      if (r < 16) { v12[half * 16 + r] = mine; i12[half * 16 + r] = n; }
    }
    __syncthreads();
    cand[tid] = v12[tid >> 4] + v12[16 + (tid & 15)];
    __syncthreads();
    {
      float mine = cand[tid];
      int r = 0;
      for (int m = 0; m < 256; ++m) {
        float o = cand[m];
        r += (o > mine) || (o == mine && m < tid);
      }
      if (r < 16) { best[r] = mine; ci[r] = tid; }
    }
    __syncthreads();
    if (tid < 16) {
      float mx = best[0];
      float sum = 0.f;
      for (int m = 0; m < 16; ++m) sum += __expf(best[m] - mx);
      int c = ci[tid];
      eidx[hd * 16 + tid] = i12[c >> 4] * 128 + i12[16 + (c & 15)];
      eg[hd * 16 + tid] = __expf(best[tid] - mx) / sum;
    }
    __syncthreads();
  }
  for (int e = wave; e < 128; e += 4) {
    const float4* ur = (const float4*)(p.peer_u + (size_t)eidx[e] * 1024);
    float acc = 0.f;
#pragma unroll
    for (int i = 0; i < 4; ++i) {
      float4 u4 = ur[lane + i * 64];
      const float* hh = h2 + (lane + i * 64) * 4;
      acc += u4.x * hh[0] + u4.y * hh[1] + u4.z * hh[2] + u4.w * hh[3];
    }
    acc = wave_sum(acc);
    if (lane == 0) {
      float gl = 0.5f * acc * (1.f + erff(acc * 0.7071067811865476f));
      eg[e] = gl * eg[e];
    }
  }
  __syncthreads();
  float4 acc = make_float4(0.f, 0.f, 0.f, 0.f);
  for (int e = 0; e < 128; ++e) {
    float a = eg[e];
    float4 v4 = *(const float4*)(p.peer_v + (size_t)eidx[e] * 1024 + tid * 4);
    acc.x += a * v4.x; acc.y += a * v4.y; acc.z += a * v4.z; acc.w += a * v4.w;
  }
  int b = tok >> 12;
  float4 g2 = *(const float4*)(ada + b * 6144 + 5120 + tid * 4);
  float4 x1 = *(const float4*)(p.out + (size_t)tok * 1024 + tid * 4);
  float4 x2;
  x2.x = x1.x + g2.x * acc.x; x2.y = x1.y + g2.y * acc.y; x2.z = x1.z + g2.z * acc.z; x2.w = x1.w + g2.w * acc.w;
  float ss = wave_sum(x2.x * x2.x + x2.y * x2.y + x2.z * x2.z + x2.w * x2.w);
  if (lane == 0) red[wave] = ss;
  __syncthreads();
  float tot = red[0] + red[1] + red[2] + red[3];
  float rstd = rsqrtf(tot * (1.f / 1024.f) + 1e-6f);
  float4 fg = *(const float4*)(p.final_g + tid * 4);
  float4 o;
  o.x = x2.x * rstd * fg.x; o.y = x2.y * rstd * fg.y; o.z = x2.z * rstd * fg.z; o.w = x2.w * rstd * fg.w;
  *(float4*)(p.out + (size_t)tok * 1024 + tid * 4) = o;
}

#define SMEM_FLOATS (4096 + 512 + 2048 * 3 + 256 + 256 + 64)

template <int PH>
__device__ __forceinline__ void run_phase(const P& p, int bid, int nb, float* sm) {
  if (PH == 0) ph_ada(p, bid, nb, sm);
  if (PH == 1) ph_mod(p, p.x, p.norm1_g, 0, 1024, (bf16*)(p.ws + OFF_H), bid, nb);
  if (PH == 2) ph_inproj(p, bid, nb, sm);
  if (PH == 3) ph_ckvnorm(p, bid, nb);
  if (PH == 4) {
    for (int it = bid; it < 32 + TT; it += nb) {
      if (it < 32) ph_gla(p, it, sm);
      else ph_dsa(p, it - 32, sm);
    }
  }
  if (PH == 5) ph_g(p, bid, nb, sm);
  if (PH == 6) ph_mix(p, bid, nb, sm);
  if (PH == 7) ph_x1(p, bid, nb, sm);
  if (PH == 8) ph_mod(p, p.out, p.norm2_g, 3072, 4096, (bf16*)(p.ws + OFF_H), bid, nb);
  if (PH == 9) ph_pq(p, bid, nb, sm);
  if (PH == 10) {
    for (int it = bid; it < TT; it += nb) ph_peer(p, it, sm);
  }
}

#if ONE_LAUNCH
__global__ void __launch_bounds__(256) mega(P p) {
  __shared__ float sm[SMEM_FLOATS];
  cg::grid_group grid = cg::this_grid();
  int bid = blockIdx.x, nb = gridDim.x;
  run_phase<0>(p, bid, nb, sm); grid.sync();
  run_phase<1>(p, bid, nb, sm); grid.sync();
  run_phase<2>(p, bid, nb, sm); grid.sync();
  run_phase<3>(p, bid, nb, sm); grid.sync();
  run_phase<4>(p, bid, nb, sm); grid.sync();
  run_phase<5>(p, bid, nb, sm); grid.sync();
  run_phase<6>(p, bid, nb, sm); grid.sync();
  run_phase<7>(p, bid, nb, sm); grid.sync();
  run_phase<8>(p, bid, nb, sm); grid.sync();
  run_phase<9>(p, bid, nb, sm); grid.sync();
  run_phase<10>(p, bid, nb, sm);
}
#else
template <int PH>
__global__ void __launch_bounds__(256) kphase(P p) {
  __shared__ float sm[SMEM_FLOATS];
  run_phase<PH>(p, blockIdx.x, gridDim.x, sm);
}
#endif

extern "C" void kernel_launch(void* const* d_in, const int* in_sizes, int n_in, void* d_out, int out_size, void* d_ws,
                              size_t ws_size, hipStream_t stream) {
  P p{};
  const float** f = (const float**)&p;
  for (int i = 0; i < 22; ++i) f[i] = (const float*)d_in[i];
  p.out = (float*)d_out;
  p.ws = (char*)d_ws;
  if (ws_size < WS_NEED) { fprintf(stderr, "workspace too small: %zu\n", ws_size); return; }
#if ONE_LAUNCH
  static int grid_blocks = 0;
  if (!grid_blocks) {
    int dev = 0, cus = 0, per_cu = 0;
    hipGetDevice(&dev);
    hipDeviceGetAttribute(&cus, hipDeviceAttributeMultiprocessorCount, dev);
    hipOccupancyMaxActiveBlocksPerMultiprocessor(&per_cu, mega, 256, 0);
    if (per_cu > 2) per_cu = 2;
    grid_blocks = cus * per_cu;
  }
  void* args[] = {&p};
  hipError_t e = hipLaunchCooperativeKernel((void*)mega, dim3(grid_blocks), dim3(256), args, 0, stream);
  if (e != hipSuccess) fprintf(stderr, "cooperative launch failed: %s (grid %d)\n", hipGetErrorString(e), grid_blocks);
#else
  const int G = 1024;
  kphase<0><<<G, 256, 0, stream>>>(p);
  kphase<1><<<G, 256, 0, stream>>>(p);
  kphase<2><<<G, 256, 0, stream>>>(p);
  kphase<3><<<G, 256, 0, stream>>>(p);
  kphase<4><<<G, 256, 0, stream>>>(p);
  kphase<5><<<G, 256, 0, stream>>>(p);
  kphase<6><<<G, 256, 0, stream>>>(p);
  kphase<7><<<G, 256, 0, stream>>>(p);
  kphase<8><<<G, 256, 0, stream>>>(p);
  kphase<9><<<G, 256, 0, stream>>>(p);
  kphase<10><<<G, 256, 0, stream>>>(p);
#endif
}
```

```cpp
#include <hip/hip_runtime.h>
#include <hip/hip_cooperative_groups.h>
#include <cstdio>
#include <cstdint>
namespace cg = cooperative_groups;

#define TT 32768
#define SEQ 4096
#define DM 1024
#define NIN 7000
typedef unsigned short bf16;
#define LAS __attribute__((address_space(3)))

struct P {
  const float *x, *c, *w_ada, *b_ada, *norm1_g, *w_in, *w_gate_up, *b_gate, *gla_norm_g, *kv_norm_g,
      *w_uk, *w_uv, *w_a, *w_b, *w_out, *norm2_g, *w_q, *sk1, *sk2, *peer_u, *peer_v, *final_g;
  float* out;
  char* ws;
};

#define MB (1ull << 20)
#define OFF_ADA   (0ull)
#define OFF_H     (1 * MB)
#define OFF_ODSA  (1 * MB)
#define OFF_Q     (65 * MB)
#define OFF_K     (97 * MB)
#define OFF_MIX   (65 * MB)
#define OFF_V     (129 * MB)
#define OFF_DQ    (193 * MB)
#define OFF_PQ    (129 * MB)
#define OFF_DSCR  (257 * MB)
#define OFF_SSP   (256ull * 1024)
#define OFF_CKV   (289 * MB)
#define OFF_IQ    (305 * MB)
#define OFF_IK    (337 * MB)
#define OFF_IW    (341 * MB)
#define OFF_GLOW  (342 * MB)
#define OFF_SGR   (344 * MB)
#define OFF_WT    (408 * MB)
#define OFF_WT_IN  (OFF_WT)
#define OFF_WT_A   (OFF_WT + 7168ull * 2048)
#define OFF_WT_B   (OFF_WT_A + 1024ull * 2048)
#define OFF_WT_OUT (OFF_WT_B + 1024ull * 2048)
#define OFF_WT_Q   (OFF_WT_OUT + 1024ull * 2048)
#define OFF_PU    (432 * MB)
#define OFF_PV    (464 * MB)
#define OFF_SK    (496 * MB)
#define OFF_WUK   (497 * MB)
#define OFF_WUV   (497 * MB + 512 * 1024)
#define WS_NEED   (498 * MB)

__device__ __forceinline__ bf16 f2bf(float f) {
  unsigned u = __float_as_uint(f);
  u += 0x7fffu + ((u >> 16) & 1u);
  return (bf16)(u >> 16);
}
__device__ __forceinline__ unsigned pk2(float lo, float hi) { return (unsigned)f2bf(lo) | ((unsigned)f2bf(hi) << 16); }
__device__ __forceinline__ float bf2f(bf16 h) { return __uint_as_float(((unsigned)h) << 16); }
__device__ __forceinline__ float bflo(unsigned u) { return __uint_as_float(u << 16); }
__device__ __forceinline__ float bfhi(unsigned u) { return __uint_as_float(u & 0xffff0000u); }
__device__ __forceinline__ float wave_sum(float v) {
#pragma unroll
  for (int o = 32; o > 0; o >>= 1) v += __shfl_xor(v, o);
  return v;
}
__device__ __forceinline__ float wave_max(float v) {
#pragma unroll
  for (int o = 32; o > 0; o >>= 1) v = fmaxf(v, __shfl_xor(v, o));
  return v;
}
__device__ __forceinline__ int tid_fresh() { int t = threadIdx.x; asm volatile("" : "+v"(t)); return t; }
__device__ __forceinline__ float sigmoidf_(float v) { return 1.f / (1.f + __expf(-v)); }
__device__ __forceinline__ float siluf_(float v) { return v / (1.f + __expf(-v)); }

#include <hip/hip_runtime.h>
namespace pg8 {
#define PG8_LAS __attribute__((address_space(3)))
typedef unsigned short bf16_t;
typedef short bf16x8 __attribute__((ext_vector_type(8)));
typedef float f32x4 __attribute__((ext_vector_type(4)));
typedef unsigned u32x4 __attribute__((ext_vector_type(4)));
constexpr int BM = 256, BK = 64, HALF = 128, HTB = HALF * BK * 2  , STAGE_BYTES = 8 * HTB, NXCD = 8, WGM = 8;

__host__ __device__ __forceinline__ int lds_byte(int r, int c) { const int st = (r >> 4) * 2 + (c >> 5), rr = r & 15, cc = c & 31, ob = rr * 64 + cc * 2; return st * 1024 + (ob ^ (((ob >> 9) & 1) << 5)); }
__host__ __device__ __forceinline__ void stage_rc(int b, int& R, int& C) { const int st = b / 1024, sb = b % 1024, swz = sb ^ (((sb >> 9) & 1) << 5); R = (st >> 1) * 16 + swz / 64; C = (st & 1) * 32 + (swz % 64) / 2; }
__host__ __device__ __forceinline__ int perm32(int rho) { const int n = rho >> 4, i = rho & 15; return 8 * (i >> 2) + 4 * n + (i & 3); }

struct Unit { int pm, pn; };
struct Gemm { const bf16_t* A; const bf16_t* Bt; int M, N, K; };

struct StaticOrder {
    int nM, nN, nwg, G, c;
    __host__ __device__ void init(int M, int N, int G_, int c_) { nM = M / BM; nN = N / BM; nwg = nM * nN; G = G_; c = c_; }
    __host__ __device__ bool next(int i, Unit& u) const {
        const long L = (long)i * G + c; if (L >= nwg) return false;
        int wgid = (int)L; { const int q = nwg / NXCD, r = nwg % NXCD, xcd = wgid % NXCD, off = wgid / NXCD; wgid = (xcd < r ? xcd * (q + 1) : r * (q + 1) + (xcd - r) * q) + off; }
        const int nig = WGM * nN, gid = wgid / nig, fm = gid * WGM, gsz = (nM - fm) < WGM ? (nM - fm) : WGM;
        u.pm = fm + ((wgid % nig) % gsz); u.pn = (wgid % nig) / gsz; return true;
    }
    __device__ __forceinline__ void a_ready(const Unit&) const {}
    __device__ __forceinline__ void done(const Unit&) const {}
};
__device__ __forceinline__ unsigned cvt_pk_bf16(float lo, float hi) { unsigned r; asm volatile("v_cvt_pk_bf16_f32 %0, %1, %2" : "=v"(r) : "v"(lo), "v"(hi)); return r; }

template <class Epi, class Sched, bool STAMP = false>
__device__ __forceinline__ void gemm_phase(PG8_LAS unsigned char* lds, const Gemm g, const Sched& S, const Epi& E, unsigned long long* stamps) {
    const int tid = ::tid_fresh(), wid = __builtin_amdgcn_readfirstlane(tid >> 6), lane = tid & 63, wr = wid >> 2, wc = wid & 3, fr = lane & 15, fq = lane >> 4;
    const int K = g.K, nt = K / BK;
    int ts_lo = 0, ts_hi = 0, nts = 0; const unsigned long long rt_entry = STAMP ? (unsigned long long)wall_clock64() : 0ull;
#define PG8_STAMP() do { if (STAMP && wid == 0 && nts < 64) { const unsigned long long _c = (unsigned long long)clock64(); \
        ts_lo = (lane == nts) ? (int)(unsigned)_c : ts_lo; ts_hi = (lane == nts) ? (int)(unsigned)(_c >> 32) : ts_hi; ++nts; } } while (0)
    PG8_STAMP();
    unsigned voffA[2], voffB[2];
#pragma unroll
    for (int i = 0; i < 2; ++i) { int R, C; stage_rc(tid * 16 + i * 8192, R, C); const int Rb = Epi::PERM ? ((R & ~31) + perm32(R & 31)) : R;
        voffA[i] = (unsigned)(R * K + C) * 2u; voffB[i] = (unsigned)(Rb * K + C) * 2u; }
    const size_t kstep = (size_t)(BK * 2);
    const size_t hstep = (size_t)HALF * K * 2;
    const size_t tstep = 2 * hstep;
    const unsigned ldsw = (unsigned)wid * 1024u;
    const int aoff = lds_byte(wr * 64 + fr, fq * 8), boff = lds_byte(wc * 32 + fr, fq * 8);
#define PG8_SA(b, h) (((b) * 2 + (h)) * HTB)
#define PG8_SB(b, h) ((4 + (b) * 2 + (h)) * HTB)
#define PG8_STAGE(bufoff, gbase, voff) do { _Pragma("unroll") for (int _i = 0; _i < 2; ++_i) \
        __builtin_amdgcn_global_load_lds((const unsigned*)((const char*)(gbase) + (voff)[_i]), (PG8_LAS unsigned*)(lds + (bufoff) + ldsw + _i * 8192), 16, 0, 0); } while (0)
#define PG8_LDA(dst, b, h) do { _Pragma("unroll") for (int m = 0; m < 4; ++m) _Pragma("unroll") for (int k = 0; k < 2; ++k) dst[m][k] = *(const PG8_LAS bf16x8*)(lds + PG8_SA(b, h) + aoff + m * 2048 + k * 1024); } while (0)
#define PG8_LDB(dst, b, h) do { _Pragma("unroll") for (int n = 0; n < 2; ++n) _Pragma("unroll") for (int k = 0; k < 2; ++k) dst[n][k] = *(const PG8_LAS bf16x8*)(lds + PG8_SB(b, h) + boff + n * 2048 + k * 1024); } while (0)
#define PG8_MMA(ai, bj, At, Bt) do { __builtin_amdgcn_s_setprio(1); _Pragma("unroll") for (int m = 0; m < 4; ++m) _Pragma("unroll") for (int n = 0; n < 2; ++n) _Pragma("unroll") for (int k = 0; k < 2; ++k) \
        acc[ai][bj][m][n] = __builtin_amdgcn_mfma_f32_16x16x32_bf16(Bt[n][k], At[m][k], acc[ai][bj][m][n], 0, 0, 0); __builtin_amdgcn_s_setprio(0); } while (0)
#define PG8_WAIT_V(n) asm volatile("s_waitcnt vmcnt(" #n ")" ::: "memory")
#define PG8_WAIT_L(n) asm volatile("s_waitcnt lgkmcnt(" #n ")" ::: "memory")
#define PG8_BAR __builtin_amdgcn_s_barrier()
#define PG8_SCHED __builtin_amdgcn_sched_barrier(0)
    Unit cur, nxt; int ui = 0;
    if (!S.next(0, cur)) return;
    f32x4 acc[2][2][4][2];
#pragma unroll
    for (int a = 0; a < 2; ++a)
#pragma unroll
        for (int b = 0; b < 2; ++b)
#pragma unroll
            for (int m = 0; m < 4; ++m)
#pragma unroll
                for (int n = 0; n < 2; ++n) acc[a][b][m][n] = (f32x4){0.f, 0.f, 0.f, 0.f};
    bf16x8 At[4][2], B0[2][2], B1[2][2];
    const char* cA = (const char*)g.A + (size_t)cur.pm * tstep; const char* cB = (const char*)g.Bt + (size_t)cur.pn * tstep;
    S.a_ready(cur);
    PG8_STAGE(PG8_SB(0, 0), cB, voffB); PG8_STAGE(PG8_SA(0, 0), cA, voffA); PG8_STAGE(PG8_SB(0, 1), cB + hstep, voffB); PG8_STAGE(PG8_SA(0, 1), cA + hstep, voffA);
    if (wr == 1) PG8_BAR;
    PG8_WAIT_V(4); PG8_BAR;
    PG8_STAGE(PG8_SB(1, 0), cB + kstep, voffB); PG8_STAGE(PG8_SA(1, 0), cA + kstep, voffA); PG8_STAGE(PG8_SB(1, 1), cB + hstep + kstep, voffB);
    PG8_WAIT_V(6); PG8_BAR;
    PG8_STAMP();
    for (;;) {
        const bool has_next = S.next(ui + 1, nxt);
        const char* nA = has_next ? (const char*)g.A + (size_t)nxt.pm * tstep : cA; const char* nB = has_next ? (const char*)g.Bt + (size_t)nxt.pn * tstep : cB;
        for (int t = 0; t < nt; t += 2) {
            const bool last = (t == nt - 2);
            const char* a1 = cA + (size_t)(t + 1) * kstep;
            const char* a2 = last ? nA : cA + (size_t)(t + 2) * kstep; const char* b2 = last ? nB : cB + (size_t)(t + 2) * kstep;
            const char* a3 = a2 + kstep; const char* b3 = b2 + kstep;
            if (last && has_next) S.a_ready(nxt);
            PG8_LDB(B0, 0, 0); PG8_SCHED; PG8_LDA(At, 0, 0); PG8_STAGE(PG8_SA(1, 1), a1 + hstep, voffA);
            PG8_WAIT_L(8); PG8_BAR; PG8_WAIT_L(0); PG8_MMA(0, 0, At, B0); PG8_BAR; PG8_SCHED;
            PG8_LDB(B1, 0, 1); PG8_STAGE(PG8_SB(0, 0), b2, voffB);
            PG8_BAR; PG8_WAIT_L(0); PG8_MMA(0, 1, At, B1); PG8_BAR;
            PG8_LDA(At, 0, 1); PG8_STAGE(PG8_SA(0, 0), a2, voffA);
            PG8_BAR; PG8_WAIT_L(0); PG8_MMA(1, 0, At, B0); PG8_BAR; PG8_SCHED;
            PG8_STAGE(PG8_SB(0, 1), b2 + hstep, voffB);
            PG8_WAIT_V(6); PG8_BAR; PG8_MMA(1, 1, At, B1); PG8_BAR;
            PG8_LDB(B0, 1, 0); PG8_SCHED; PG8_LDA(At, 1, 0); PG8_STAGE(PG8_SA(0, 1), a2 + hstep, voffA);
            PG8_WAIT_L(8); PG8_BAR; PG8_WAIT_L(0); PG8_MMA(0, 0, At, B0); PG8_BAR; PG8_SCHED;
            PG8_LDB(B1, 1, 1); PG8_STAGE(PG8_SB(1, 0), b3, voffB);
            PG8_BAR; PG8_WAIT_L(0); PG8_MMA(0, 1, At, B1); PG8_BAR;
            PG8_LDA(At, 1, 1); PG8_STAGE(PG8_SA(1, 0), a3, voffA);
            PG8_BAR; PG8_WAIT_L(0); PG8_MMA(1, 0, At, B0); PG8_BAR; PG8_SCHED;
            PG8_STAGE(PG8_SB(1, 1), b3 + hstep, voffB);
            PG8_WAIT_V(6); PG8_BAR; PG8_MMA(1, 1, At, B1); PG8_BAR;
        }
        PG8_STAMP();
        if constexpr (!Epi::AFTER_DRAIN) { E(acc, cur, wr, wc, fr, fq); S.done(cur); }
        PG8_STAMP();
        if (!has_next) break;
#pragma unroll
        for (int a = 0; a < 2; ++a)
#pragma unroll
            for (int b = 0; b < 2; ++b)
#pragma unroll
                for (int m = 0; m < 4; ++m)
#pragma unroll
                    for (int n = 0; n < 2; ++n) acc[a][b][m][n] = (f32x4){0.f, 0.f, 0.f, 0.f};
        cur = nxt; cA = nA; cB = nB; ++ui;
    }
    PG8_WAIT_V(0);
    if (wr == 0) PG8_BAR;
    PG8_BAR;
    if constexpr (Epi::AFTER_DRAIN) { E.fused(acc, cur, wr, wc, fr, fq, lds, wid, lane); S.done(cur); }
    PG8_STAMP();
    if (STAMP && wid == 0) { stamps[lane] = lane < nts ? (((unsigned long long)(unsigned)ts_hi << 32) | (unsigned)ts_lo) : 0ull;
        if (lane == 62) stamps[62] = rt_entry; if (lane == 63) stamps[63] = (unsigned long long)wall_clock64(); }
#undef PG8_STAMP
#undef PG8_SA
#undef PG8_SB
#undef PG8_STAGE
#undef PG8_LDA
#undef PG8_LDB
#undef PG8_MMA
#undef PG8_WAIT_V
#undef PG8_WAIT_L
#undef PG8_BAR
#undef PG8_SCHED
}
}
__device__ void ph_mod(const P& p, const float* X, const float* g, int shift_off, int scale_off, bf16* H, int bid, int nb) {
  const float* ada = (const float*)(p.ws + OFF_ADA);
  const int tidm = tid_fresh(); int wave = tidm >> 6, lane = tidm & 63;
  for (int row = bid * (int)(blockDim.x >> 6) + wave; row < TT; row += nb * (int)(blockDim.x >> 6)) {
    const float4* xr = (const float4*)(X + (size_t)row * DM);
    float4 v[4];
    float ss = 0.f;
#pragma unroll
    for (int i = 0; i < 4; ++i) {
      v[i] = xr[lane + i * 64];
      ss += v[i].x * v[i].x + v[i].y * v[i].y + v[i].z * v[i].z + v[i].w * v[i].w;
    }
    ss = wave_sum(ss);
    float rstd = rsqrtf(ss * (1.f / DM) + 1e-6f);
    int b = row >> 12;
    const float* sh = ada + b * 6144 + shift_off;
    const float* sc = ada + b * 6144 + scale_off;
#pragma unroll
    for (int i = 0; i < 4; ++i) {
      int c0 = (lane + i * 64) * 4;
      float4 gg = *(const float4*)(g + c0);
      float4 s4 = *(const float4*)(sc + c0);
      float4 h4 = *(const float4*)(sh + c0);
      ushort4 o;
      o.x = f2bf(v[i].x * rstd * gg.x * (1.f + s4.x) + h4.x);
      o.y = f2bf(v[i].y * rstd * gg.y * (1.f + s4.y) + h4.y);
      o.z = f2bf(v[i].z * rstd * gg.z * (1.f + s4.z) + h4.z);
      o.w = f2bf(v[i].w * rstd * gg.w * (1.f + s4.w) + h4.w);
      *(ushort4*)(H + (size_t)row * DM + c0) = o;
    }
  }
}

__device__ __forceinline__ int in_srcmap(int d) {
  if (d < 2048) return d;
  if (d < 3072) return 3088 + (d - 2048);
  if (d < 3328) return 4112 + (d - 3072);
  if (d < 3840) return 4368 + (d - 3328);
  if (d < 3904) return 4880 + (d - 3840);
  if (d < 3912) return 4944 + (d - 3904);
  if (d < 3928) return 3072 + (d - 3912);
  if (d < 4096) return -1;
  if (d < 5120) return 2048 + (d - 4096);
  return 4952 + (d - 5120);
}
template <bool MAP>
__device__ __forceinline__ void transpose_item(const float* W, int ldw, int K, bf16* WT, int item, int nblk, float* scr, int lane) {
  const int kb = item / nblk, nbk = item % nblk, k0 = 64 * kb, n0 = 32 * nbk;
  const int d = n0 + (lane & 31);
  const int src = MAP ? in_srcmap(d) : d;
#pragma unroll 8
  for (int i = 0; i < 32; ++i) {
    const int kk = 2 * i + (lane >> 5);
    scr[kk * 33 + (lane & 31)] = (src >= 0) ? W[(size_t)(k0 + kk) * ldw + src] : 0.f;
  }
  asm volatile("s_waitcnt lgkmcnt(0)" ::: "memory");
  const int c = lane & 7;
#pragma unroll
  for (int j = 0; j < 4; ++j) {
    const int n = (lane >> 3) + 8 * j;
    const float* s = scr + (8 * c) * 33 + n;
    uint4 o;
    o.x = pk2(s[0 * 33], s[1 * 33]); o.y = pk2(s[2 * 33], s[3 * 33]); o.z = pk2(s[4 * 33], s[5 * 33]); o.w = pk2(s[6 * 33], s[7 * 33]);
    *(uint4*)(WT + (size_t)(n0 + n) * K + k0 + 8 * c) = o;
  }
  asm volatile("s_waitcnt lgkmcnt(0)" ::: "memory");
}

__device__ void ph_prep(const P& p, float* sm) {
  const int tid = tid_fresh(), wave = tid >> 6, lane = tid & 63;
  const int bid = blockIdx.x, nb = gridDim.x;
  float* silc = sm + 8 * 2112 + 64;
  float* red = silc + 8192;
  float* ada = (float*)(p.ws + OFF_ADA);
  if (bid < 192) {
    for (int i = tid; i < 8192; i += 512) silc[i] = siluf_(p.c[i]);
    __syncthreads();
    for (int it = bid; it < 192; it += nb) {
      const int kg = tid >> 5, cn = tid & 31, n = it * 32 + cn;
      float acc[8];
#pragma unroll
      for (int b = 0; b < 8; ++b) acc[b] = 0.f;
      for (int k = kg * 64; k < kg * 64 + 64; ++k) {
        const float w = p.w_ada[(size_t)k * 6144 + n];
#pragma unroll
        for (int b = 0; b < 8; ++b) acc[b] += silc[b * 1024 + k] * w;
      }
#pragma unroll
      for (int b = 0; b < 8; ++b) red[(kg * 8 + b) * 32 + cn] = acc[b];
      __syncthreads();
      if (tid < 256) {
        const int b = tid >> 5, c2 = tid & 31;
        float s = 0.f;
#pragma unroll
        for (int g = 0; g < 16; ++g) s += red[(g * 8 + b) * 32 + c2];
        ada[b * 6144 + it * 32 + c2] = s + p.b_ada[it * 32 + c2];
      }
      __syncthreads();
    }
  }
  {
    const size_t n8 = (size_t)16384 * 1024 / 8, gt = (size_t)bid * 512 + tid, gs = (size_t)nb * 512;
    for (size_t i = gt; i < 2 * n8 + 2 * 2048; i += gs) {
      const float* src; bf16* dst; size_t j = i;
      if (j < n8) { src = p.peer_u; dst = (bf16*)(p.ws + OFF_PU); }
      else if (j < 2 * n8) { j -= n8; src = p.peer_v; dst = (bf16*)(p.ws + OFF_PV); }
      else if (j < 2 * n8 + 2048) { j -= 2 * n8; src = p.sk1; dst = (bf16*)(p.ws + OFF_SK); }
      else { j -= 2 * n8 + 2048; src = p.sk2; dst = (bf16*)(p.ws + OFF_SK) + 16384; }
      const float4 v0 = *(const float4*)(src + j * 8), v1 = *(const float4*)(src + j * 8 + 4);
      uint4 o; o.x = pk2(v0.x, v0.y); o.y = pk2(v0.z, v0.w); o.z = pk2(v1.x, v1.y); o.w = pk2(v1.z, v1.w);
      *(uint4*)(dst + j * 8) = o;
    }
  }
  {
    bf16* WUK = (bf16*)(p.ws + OFF_WUK);
    bf16* WUV = (bf16*)(p.ws + OFF_WUV);
    for (int i = bid * 512 + tid; i < 2 * 262144; i += nb * 512) {
      if (i < 262144) {
        const int d = i & 127, cc = (i >> 7) & 255, h = i >> 15;
        WUK[i] = f2bf(p.w_uk[((size_t)h * 128 + d) * 256 + cc] * p.kv_norm_g[cc] * 0.08838834764831845f);
      } else {
        const int k = i - 262144;
        const int cc = k & 255, d = (k >> 8) & 127, h = k >> 15;
        WUV[k] = f2bf(p.w_uv[((size_t)h * 256 + cc) * 128 + d] * p.kv_norm_g[cc]);
      }
    }
  }
  float* scr = sm + wave * 2112;
  const int gw = bid * 8 + wave, ngw = nb * 8;
  constexpr int I_IN = 16 * 224, I_SQ = 16 * 32, I_Q = 16 * 64;
  for (int it = gw; it < I_IN + 3 * I_SQ + I_Q; it += ngw) {
    int r = it;
    if (r < I_IN) { transpose_item<true>(p.w_in, NIN, 1024, (bf16*)(p.ws + OFF_WT_IN), r, 224, scr, lane); continue; }
    r -= I_IN;
    if (r < I_SQ) { transpose_item<false>(p.w_a, 1024, 1024, (bf16*)(p.ws + OFF_WT_A), r, 32, scr, lane); continue; }
    r -= I_SQ;
    if (r < I_SQ) { transpose_item<false>(p.w_b, 1024, 1024, (bf16*)(p.ws + OFF_WT_B), r, 32, scr, lane); continue; }
    r -= I_SQ;
    if (r < I_SQ) { transpose_item<false>(p.w_out, 1024, 1024, (bf16*)(p.ws + OFF_WT_OUT), r, 32, scr, lane); continue; }
    r -= I_SQ;
    transpose_item<false>(p.w_q, 2048, 1024, (bf16*)(p.ws + OFF_WT_Q), r, 64, scr, lane);
  }
}

using pg8::f32x4;
using pg8::u32x4;
using pg8::Unit;
using pg8::cvt_pk_bf16;

struct EpiIn {
  static constexpr bool PERM = true, AFTER_DRAIN = false;
  char* ws; float* out;
  __device__ __forceinline__ void operator()(const f32x4 (&acc)[2][2][4][2], const Unit& u, int wr, int wc, int fr, int fq) const {
    const int pn = u.pn;
    const int row0 = u.pm * 256 + wr * 64 + fr, cl0 = wc * 32 + 8 * fq;
    if (pn == 12) {
      bf16* dst = (bf16*)(ws + OFF_CKV);
      float* ssp = (float*)(ws + OFF_SSP);
#pragma unroll
      for (int ai = 0; ai < 2; ++ai)
#pragma unroll
        for (int m = 0; m < 4; ++m) {
          const size_t row = row0 + ai * 128 + m * 16;
          float ss = 0.f;
#pragma unroll
          for (int bj = 0; bj < 2; ++bj) {
            const f32x4 v0 = acc[ai][bj][m][0], v1 = acc[ai][bj][m][1];
            ss += (v0[0] * v0[0] + v0[1] * v0[1]) + (v0[2] * v0[2] + v0[3] * v0[3]) + (v1[0] * v1[0] + v1[1] * v1[1]) + (v1[2] * v1[2] + v1[3] * v1[3]);
            u32x4 w; w.x = cvt_pk_bf16(v0[0], v0[1]); w.y = cvt_pk_bf16(v0[2], v0[3]); w.z = cvt_pk_bf16(v1[0], v1[1]); w.w = cvt_pk_bf16(v1[2], v1[3]);
            *(u32x4*)(dst + row * 256 + cl0 + bj * 128) = w;
          }
          ss += __shfl_xor(ss, 16); ss += __shfl_xor(ss, 32);
          if (fq == 0) ssp[row * 4 + wc] = ss;
        }
    } else if (pn == 15) {
      bf16* IK = (bf16*)(ws + OFF_IK);
      float* IW = (float*)(ws + OFF_IW);
      float* GLOW = (float*)(ws + OFF_GLOW);
#pragma unroll
      for (int ai = 0; ai < 2; ++ai)
#pragma unroll
        for (int m = 0; m < 4; ++m) {
          const size_t row = row0 + ai * 128 + m * 16;
          const int cl = cl0;
          const f32x4 v0 = acc[ai][0][m][0], v1 = acc[ai][0][m][1];
          if (cl < 64) {
            u32x4 w; w.x = cvt_pk_bf16(v0[0], v0[1]); w.y = cvt_pk_bf16(v0[2], v0[3]); w.z = cvt_pk_bf16(v1[0], v1[1]); w.w = cvt_pk_bf16(v1[2], v1[3]);
            *(u32x4*)(IK + row * 64 + cl) = w;
          } else if (cl < 72) {
            *(f32x4*)(IW + row * 8) = v0 * 0.35355339059327373f;
            *(f32x4*)(IW + row * 8 + 4) = v1 * 0.35355339059327373f;
          } else if (cl < 88) {
            *(f32x4*)(GLOW + row * 16 + (cl - 72)) = v0;
            *(f32x4*)(GLOW + row * 16 + (cl - 72) + 4) = v1;
          }
        }
    } else {
      bf16* dst; int ld; float scale = 1.f; int act = 0; int coff;
      if (pn < 2) { dst = (bf16*)(ws + OFF_Q); ld = 512; coff = pn * 256; scale = 0.08838834764831845f; }
      else if (pn < 4) { dst = (bf16*)(ws + OFF_K); ld = 512; coff = (pn - 2) * 256; }
      else if (pn < 8) { dst = (bf16*)(ws + OFF_V); ld = 1024; coff = (pn - 4) * 256; }
      else if (pn < 12) { dst = (bf16*)(ws + OFF_DQ); ld = 1024; coff = (pn - 8) * 256; }
      else if (pn < 15) { dst = (bf16*)(ws + OFF_IQ); ld = 512; coff = (pn - 13) * 256; scale = 0.125f; }
      else if (pn < 20) { dst = (bf16*)(ws + OFF_SGR); ld = 1024; coff = (pn - 16) * 256; act = 1; }
      else if (pn < 24) { dst = (bf16*)out; ld = 1024; coff = (pn - 20) * 256; act = 2; }
      else { dst = (bf16*)out + (size_t)TT * 1024; ld = 1024; coff = (pn - 24) * 256; act = 2; }
#pragma unroll
      for (int ai = 0; ai < 2; ++ai)
#pragma unroll
        for (int m = 0; m < 4; ++m) {
          bf16* rowp = dst + (size_t)(row0 + ai * 128 + m * 16) * ld + coff + cl0;
#pragma unroll
          for (int bj = 0; bj < 2; ++bj) {
            f32x4 v0 = acc[ai][bj][m][0] * scale, v1 = acc[ai][bj][m][1] * scale;
            if (act == 1) {
#pragma unroll
              for (int j = 0; j < 4; ++j) { v0[j] = siluf_(v0[j]); v1[j] = siluf_(v1[j]); }
            } else if (act == 2) {
#pragma unroll
              for (int j = 0; j < 4; ++j) { v0[j] = sigmoidf_(v0[j]); v1[j] = sigmoidf_(v1[j]); }
            }
            u32x4 w; w.x = cvt_pk_bf16(v0[0], v0[1]); w.y = cvt_pk_bf16(v0[2], v0[3]); w.z = cvt_pk_bf16(v1[0], v1[1]); w.w = cvt_pk_bf16(v1[2], v1[3]);
            *(u32x4*)(rowp + bj * 128) = w;
          }
        }
    }
  }
};

template <bool ADD> struct EpiMix {
  static constexpr bool PERM = true, AFTER_DRAIN = false;
  const bf16* SZ; bf16* MIX;
  __device__ __forceinline__ void operator()(const f32x4 (&acc)[2][2][4][2], const Unit& u, int wr, int wc, int fr, int fq) const {
    const int row0 = u.pm * 256 + wr * 64 + fr, col0 = u.pn * 256 + wc * 32 + 8 * fq;
#pragma unroll
    for (int ai = 0; ai < 2; ++ai)
#pragma unroll
      for (int m = 0; m < 4; ++m)
#pragma unroll
        for (int bj = 0; bj < 2; ++bj) {
          const size_t idx = (size_t)(row0 + ai * 128 + m * 16) * 1024 + col0 + bj * 128;
          const u32x4 s = *(const u32x4*)(SZ + idx);
          f32x4 v0 = acc[ai][bj][m][0], v1 = acc[ai][bj][m][1];
          v0[0] *= bflo(s.x); v0[1] *= bfhi(s.x); v0[2] *= bflo(s.y); v0[3] *= bfhi(s.y);
          v1[0] *= bflo(s.z); v1[1] *= bfhi(s.z); v1[2] *= bflo(s.w); v1[3] *= bfhi(s.w);
          if (ADD) {
            const u32x4 o = *(const u32x4*)(MIX + idx);
            v0[0] += bflo(o.x); v0[1] += bfhi(o.x); v0[2] += bflo(o.y); v0[3] += bfhi(o.y);
            v1[0] += bflo(o.z); v1[1] += bfhi(o.z); v1[2] += bflo(o.w); v1[3] += bfhi(o.w);
          }
          u32x4 w; w.x = cvt_pk_bf16(v0[0], v0[1]); w.y = cvt_pk_bf16(v0[2], v0[3]); w.z = cvt_pk_bf16(v1[0], v1[1]); w.w = cvt_pk_bf16(v1[2], v1[3]);
          *(u32x4*)(MIX + idx) = w;
        }
  }
};

struct EpiX1 {
  static constexpr bool PERM = true, AFTER_DRAIN = false;
  const float* x; const float* ada; float* out;
  __device__ __forceinline__ void operator()(const f32x4 (&acc)[2][2][4][2], const Unit& u, int wr, int wc, int fr, int fq) const {
    const int row0 = u.pm * 256 + wr * 64 + fr, col0 = u.pn * 256 + wc * 32 + 8 * fq;
    const int b = (u.pm * 256) >> 12;
    f32x4 g[2][2];
#pragma unroll
    for (int bj = 0; bj < 2; ++bj) {
      g[bj][0] = *(const f32x4*)(ada + b * 6144 + 2048 + col0 + bj * 128);
      g[bj][1] = *(const f32x4*)(ada + b * 6144 + 2048 + col0 + bj * 128 + 4);
    }
#pragma unroll
    for (int ai = 0; ai < 2; ++ai)
#pragma unroll
      for (int m = 0; m < 4; ++m)
#pragma unroll
        for (int bj = 0; bj < 2; ++bj) {
          const size_t idx = (size_t)(row0 + ai * 128 + m * 16) * 1024 + col0 + bj * 128;
          const f32x4 x0 = *(const f32x4*)(x + idx), x1 = *(const f32x4*)(x + idx + 4);
          *(f32x4*)(out + idx) = x0 + g[bj][0] * acc[ai][bj][m][0];
          *(f32x4*)(out + idx + 4) = x1 + g[bj][1] * acc[ai][bj][m][1];
        }
  }
};

struct EpiPlain {
  static constexpr bool PERM = true, AFTER_DRAIN = false;
  bf16* O; int ld;
  __device__ __forceinline__ void operator()(const f32x4 (&acc)[2][2][4][2], const Unit& u, int wr, int wc, int fr, int fq) const {
    const int row0 = u.pm * 256 + wr * 64 + fr, col0 = u.pn * 256 + wc * 32 + 8 * fq;
#pragma unroll
    for (int ai = 0; ai < 2; ++ai)
#pragma unroll
      for (int m = 0; m < 4; ++m)
#pragma unroll
        for (int bj = 0; bj < 2; ++bj) {
          const f32x4 v0 = acc[ai][bj][m][0], v1 = acc[ai][bj][m][1];
          u32x4 w; w.x = cvt_pk_bf16(v0[0], v0[1]); w.y = cvt_pk_bf16(v0[2], v0[3]); w.z = cvt_pk_bf16(v1[0], v1[1]); w.w = cvt_pk_bf16(v1[2], v1[3]);
          *(u32x4*)(O + (size_t)(row0 + ai * 128 + m * 16) * ld + col0 + bj * 128) = w;
        }
  }
};

template <class Epi>
__device__ __forceinline__ void gemm_run(LAS unsigned char* lds, const bf16* A, const bf16* Bt, int M, int N, int K, const Epi& E) {
  pg8::Gemm g{A, Bt, M, N, K};
  pg8::StaticOrder S;
  S.init(M, N, gridDim.x, blockIdx.x);
  pg8::gemm_phase<Epi, pg8::StaticOrder, false>(lds, g, S, E, nullptr);
}

typedef short bf16x8_t __attribute__((ext_vector_type(8)));
typedef __bf16 bf16x2_t __attribute__((ext_vector_type(2)));
__device__ __forceinline__ float dot2bf(unsigned a, unsigned b, float acc) {
  return __builtin_amdgcn_fdot2_f32_bf16(__builtin_bit_cast(bf16x2_t, a), __builtin_bit_cast(bf16x2_t, b), acc, false);
}
__device__ __forceinline__ void wave_lds_fence() { asm volatile("s_waitcnt lgkmcnt(0)" ::: "memory"); }
template <int N> __device__ __forceinline__ float row_ror(float x) {
  return __int_as_float(__builtin_amdgcn_update_dpp(0, __float_as_int(x), 0x120 + N, 0xf, 0xf, false));
}
__device__ __forceinline__ float row16_max(float m) {
  m = fmaxf(m, row_ror<8>(m)); m = fmaxf(m, row_ror<4>(m)); m = fmaxf(m, row_ror<2>(m)); m = fmaxf(m, row_ror<1>(m));
  return m;
}
__device__ __forceinline__ float row16_sum(float m) {
  m += row_ror<8>(m); m += row_ror<4>(m); m += row_ror<2>(m); m += row_ror<1>(m);
  return m;
}
__device__ __forceinline__ float wave_sum_dpp(float s) {
  s = row16_sum(s);
  const int si = __float_as_int(s);
  return __int_as_float(__builtin_amdgcn_readlane(si, 0)) + __int_as_float(__builtin_amdgcn_readlane(si, 16)) +
         (__int_as_float(__builtin_amdgcn_readlane(si, 32)) + __int_as_float(__builtin_amdgcn_readlane(si, 48)));
}
__device__ __forceinline__ constexpr int cand_i(int L) {
  return L < 16 ? 0 : L < 24 ? 1 : L < 29 ? 2 : L < 33 ? 3 : L < 36 ? 4 : L < 38 ? 5 : L < 40 ? 6 : L < 42 ? 7 : (L - 42 + 8);
}
__device__ __forceinline__ constexpr int cand_j(int L) {
  return L < 16 ? L : L < 24 ? L - 16 : L < 29 ? L - 24 : L < 33 ? L - 29 : L < 36 ? L - 33 : L < 38 ? L - 36 : L < 40 ? L - 38 : L < 42 ? L - 40 : 0;
}
template <int K> struct CandRank {
  static __device__ __forceinline__ void run(int vi, float val, int myflat, int& rank) {
    const float o = __int_as_float(__builtin_amdgcn_readlane(vi, K));
    constexpr int fk = cand_i(K) * 16 + cand_j(K);
    rank += ((o > val) || (o == val && fk < myflat)) ? 1 : 0;
    CandRank<K + 1>::run(vi, val, myflat, rank);
  }
};
template <> struct CandRank<50> { static __device__ __forceinline__ void run(int, float, int, int&) {} };

__device__ __forceinline__ float gelu_exact(float v) { return 0.5f * v * (1.f + erff(v * 0.7071067811865476f)); }

#define PEER_LOAD(bufa, bufb, TAB, e0)                                                            \
  _Pragma("unroll") for (int j = 0; j < 4; ++j) {                                                 \
    const int e = __builtin_amdgcn_readfirstlane((int)ridx[tt * 128 + (e0) + j]);                 \
    const bf16* rp = (TAB) + (size_t)e * 1024 + lane * 8;                                         \
    bufa[j] = *(const uint4*)rp; bufb[j] = *(const uint4*)(rp + 512);                             \
  }
#define PEER_UDOT(bufa, bufb, e0)                                                                 \
  _Pragma("unroll") for (int j = 0; j < 4; ++j) {                                                 \
    float s0 = dot2bf(bufa[j].x, hA.x, 0.f), s1 = dot2bf(bufa[j].y, hA.y, 0.f);                   \
    s0 = dot2bf(bufa[j].z, hA.z, s0); s1 = dot2bf(bufa[j].w, hA.w, s1);                           \
    s0 = dot2bf(bufb[j].x, hB.x, s0); s1 = dot2bf(bufb[j].y, hB.y, s1);                           \
    s0 = dot2bf(bufb[j].z, hB.z, s0); s1 = dot2bf(bufb[j].w, hB.w, s1);                           \
    const float s = wave_sum_dpp(s0 + s1);                                                        \
    const int ee = (e0) + j;                                                                      \
    if (ee < 64) dotA = (lane == ee) ? s : dotA; else dotB = (lane == ee - 64) ? s : dotB;        \
  }
#define PEER_VACC(bufa, bufb, e0)                                                                 \
  _Pragma("unroll") for (int j = 0; j < 4; ++j) {                                                 \
    const int ee = (e0) + j;                                                                      \
    const float a = __int_as_float(__builtin_amdgcn_readlane(__float_as_int(ee < 64 ? aA : aB), ee & 63)); \
    acc[0] += a * bflo(bufa[j].x); acc[1] += a * bfhi(bufa[j].x); acc[2] += a * bflo(bufa[j].y); acc[3] += a * bfhi(bufa[j].y); \
    acc[4] += a * bflo(bufa[j].z); acc[5] += a * bfhi(bufa[j].z); acc[6] += a * bflo(bufa[j].w); acc[7] += a * bfhi(bufa[j].w); \
    acc[8] += a * bflo(bufb[j].x); acc[9] += a * bfhi(bufb[j].x); acc[10] += a * bflo(bufb[j].y); acc[11] += a * bfhi(bufb[j].y); \
    acc[12] += a * bflo(bufb[j].z); acc[13] += a * bfhi(bufb[j].z); acc[14] += a * bflo(bufb[j].w); acc[15] += a * bfhi(bufb[j].w); \
  }

__device__ void ph_peer512(const P& p, unsigned char* lds_raw) {
  const int tid = tid_fresh(), wave = tid >> 6, lane = tid & 63, g = lane >> 4, c = lane & 15;
  const bf16* H2 = (const bf16*)(p.ws + OFF_H);
  const bf16* PQ = (const bf16*)(p.ws + OFF_PQ);
  const bf16* SK = (const bf16*)(p.ws + OFF_SK);
  const bf16* PU = (const bf16*)(p.ws + OFF_PU);
  const bf16* PV = (const bf16*)(p.ws + OFF_PV);
  const float* ada = (const float*)(p.ws + OFF_ADA);
  float* tv = (float*)(lds_raw + wave * 16384);
  int* ti = (int*)(tv + 512);
  float* rgate = (float*)(ti + 512);
  unsigned short* ridx = (unsigned short*)(rgate + 2048);
  for (int tile = blockIdx.x * 8 + wave; tile < TT / 16; tile += gridDim.x * 8) {
    const int tok0 = tile * 16;
#pragma unroll 1
    for (int hd = 0; hd < 8; ++hd) {
#pragma unroll 1
      for (int hf = 0; hf < 2; ++hf) {
        f32x4 acc[8];
#pragma unroll
        for (int nt = 0; nt < 8; ++nt) acc[nt] = (f32x4){0.f, 0.f, 0.f, 0.f};
#pragma unroll
        for (int ks = 0; ks < 4; ++ks) {
          const bf16x8_t a = *(const bf16x8_t*)(PQ + (size_t)(tok0 + c) * 2048 + hd * 256 + hf * 128 + ks * 32 + 8 * g);
#pragma unroll
          for (int nt = 0; nt < 8; ++nt) {
            const bf16x8_t b = *(const bf16x8_t*)(SK + hf * 16384 + (nt * 16 + c) * 128 + ks * 32 + 8 * g);
            acc[nt] = __builtin_amdgcn_mfma_f32_16x16x32_bf16(a, b, acc[nt], 0, 0, 0);
          }
        }
#pragma unroll
        for (int i = 0; i < 4; ++i) {
          float v[8];
#pragma unroll
          for (int nt = 0; nt < 8; ++nt) v[nt] = acc[nt][i];
          const int row = 4 * g + i;
#pragma unroll 1
          for (int r = 0; r < 16; ++r) {
            const float m = fmaxf(fmaxf(fmaxf(v[0], v[1]), fmaxf(v[2], v[3])), fmaxf(fmaxf(v[4], v[5]), fmaxf(v[6], v[7])));
            const float gm = row16_max(m);
            const unsigned long long bal = __ballot(m == gm);
            const unsigned gb = (unsigned)(bal >> (16 * g)) & 0xffffu;
            const bool win = (c == (__ffs(gb) - 1));
            int sel = -1;
#pragma unroll
            for (int nt = 0; nt < 8; ++nt) {
              const bool hit = win && (sel < 0) && (v[nt] == gm);
              sel = hit ? nt : sel;
              v[nt] = hit ? -INFINITY : v[nt];
            }
            if (win) { tv[(hf * 16 + row) * 16 + r] = gm; ti[(hf * 16 + row) * 16 + r] = sel * 16 + c; }
          }
        }
      }
      wave_lds_fence();
      const int ci = cand_i(lane < 50 ? lane : 0), cj = cand_j(lane < 50 ? lane : 0);
      const int myflat = ci * 16 + cj;
#pragma unroll 1
      for (int row = 0; row < 16; ++row) {
        const float val = (lane < 50) ? (tv[row * 16 + ci] + tv[(16 + row) * 16 + cj]) : -INFINITY;
        int rank = 0;
        CandRank<0>::run(__float_as_int(val), val, myflat, rank);
        if (lane < 50 && rank < 16) {
          rgate[row * 128 + hd * 16 + rank] = val;
          ridx[row * 128 + hd * 16 + rank] = (unsigned short)(ti[row * 16 + ci] * 128 + ti[(16 + row) * 16 + cj]);
        }
      }
      wave_lds_fence();
      {
        const int row = lane >> 2, q = lane & 3;
        float* gp = rgate + row * 128 + hd * 16;
        const float mx = gp[0];
        const f32x4 b4 = *(const f32x4*)(gp + q * 4);
        f32x4 e4;
        e4[0] = __expf(b4[0] - mx); e4[1] = __expf(b4[1] - mx); e4[2] = __expf(b4[2] - mx); e4[3] = __expf(b4[3] - mx);
        float s = (e4[0] + e4[1]) + (e4[2] + e4[3]);
        s += __shfl_xor(s, 1); s += __shfl_xor(s, 2);
        const float inv = 1.f / s;
        wave_lds_fence();
        *(f32x4*)(gp + q * 4) = e4 * inv;
      }
      wave_lds_fence();
    }
#pragma unroll 1
    for (int tt = 0; tt < 16; ++tt) {
      const size_t tok = (size_t)tok0 + tt;
      const uint4 hA = *(const uint4*)(H2 + tok * 1024 + lane * 8), hB = *(const uint4*)(H2 + tok * 1024 + 512 + lane * 8);
      float dotA = 0.f, dotB = 0.f;
      uint4 a0[4], b0[4], a1[4], b1[4];
      PEER_LOAD(a0, b0, PU, 0);
#pragma unroll 1
      for (int e0 = 0; e0 < 128; e0 += 8) {
        PEER_LOAD(a1, b1, PU, e0 + 4);
        PEER_UDOT(a0, b0, e0);
        if (e0 + 8 < 128) { PEER_LOAD(a0, b0, PU, e0 + 8); }
        else { PEER_LOAD(a0, b0, PV, 0); }
        PEER_UDOT(a1, b1, e0 + 4);
      }
      const float aA = gelu_exact(dotA) * rgate[tt * 128 + lane], aB = gelu_exact(dotB) * rgate[tt * 128 + 64 + lane];
      float acc[16];
#pragma unroll
      for (int k = 0; k < 16; ++k) acc[k] = 0.f;
#pragma unroll 1
      for (int e0 = 0; e0 < 128; e0 += 8) {
        PEER_LOAD(a1, b1, PV, e0 + 4);
        PEER_VACC(a0, b0, e0);
        if (e0 + 8 < 128) { PEER_LOAD(a0, b0, PV, e0 + 8); }
        PEER_VACC(a1, b1, e0 + 4);
      }
      const int b = (int)(tok >> 12);
      float* orow = p.out + tok * 1024;
      const float* g2 = ada + b * 6144 + 5120;
      float x2[16];
      float ss = 0.f;
#pragma unroll
      for (int h = 0; h < 2; ++h)
#pragma unroll
        for (int q = 0; q < 2; ++q) {
          const int col = h * 512 + lane * 8 + q * 4;
          const f32x4 xv = *(const f32x4*)(orow + col), gv = *(const f32x4*)(g2 + col);
#pragma unroll
          for (int k = 0; k < 4; ++k) { const float t = xv[k] + gv[k] * acc[h * 8 + q * 4 + k]; x2[h * 8 + q * 4 + k] = t; ss += t * t; }
        }
      ss = wave_sum_dpp(ss);
      const float rstd = rsqrtf(ss * (1.f / 1024.f) + 1e-6f);
#pragma unroll
      for (int h = 0; h < 2; ++h)
#pragma unroll
        for (int q = 0; q < 2; ++q) {
          const int col = h * 512 + lane * 8 + q * 4;
          const f32x4 fg = *(const f32x4*)(p.final_g + col);
          f32x4 o;
#pragma unroll
          for (int k = 0; k < 4; ++k) o[k] = x2[h * 8 + q * 4 + k] * rstd * fg[k];
          *(f32x4*)(orow + col) = o;
        }
    }
    wave_lds_fence();
  }
}

#define DS_KEY16   0
#define DS_CHUNK   17408
#define DS_SEL     139264
#define DS_WAVE    147456
#define DS_TOTAL   155648
#define DS_RS      544
typedef short s16x4_t __attribute__((ext_vector_type(4)));
typedef unsigned u32x4_t __attribute__((ext_vector_type(4)));
typedef unsigned short u16x4_t __attribute__((ext_vector_type(4)));

__device__ __forceinline__ unsigned f2ord(float f) {
  if (f == 0.f) f = 0.f;
  unsigned u = __float_as_uint(f);
  return (u & 0x80000000u) ? ~u : (u | 0x80000000u);
}
__device__ __forceinline__ int wave_scan_incl(int v, int lane) {
#pragma unroll
  for (int o = 1; o < 64; o <<= 1) { const int t = __shfl_up(v, o); v += (lane >= o) ? t : 0; }
  return v;
}
__device__ __forceinline__ void find_digit(const LAS unsigned* hist, int K, int lane, int& digit, int& above) {
  const u32x4_t h4 = *(const LAS u32x4_t*)(hist + 252 - 4 * lane);
  const int c0 = (int)h4.w, c1 = (int)h4.z, c2 = (int)h4.y, c3 = (int)h4.x;
  const int tot = c0 + c1 + c2 + c3;
  int run = wave_scan_incl(tot, lane) - tot;
  int found = -1, ab = 0;
  if (run < K && run + c0 >= K) { found = 255 - 4 * lane; ab = run; } run += c0;
  if (run < K && run + c1 >= K) { found = 254 - 4 * lane; ab = run; } run += c1;
  if (run < K && run + c2 >= K) { found = 253 - 4 * lane; ab = run; } run += c2;
  if (run < K && run + c3 >= K) { found = 252 - 4 * lane; ab = run; }
  const unsigned long long mk = __ballot(found >= 0);
  const int src = (int)__ffsll((unsigned long long)mk) - 1;
  digit = __builtin_amdgcn_readlane(found, src);
  above = __builtin_amdgcn_readlane(ab, src);
}

__device__ __forceinline__ s16x4_t tr_read_b64(unsigned addr) {
  s16x4_t r; asm volatile("ds_read_b64_tr_b16 %0, %1" : "=&v"(r) : "v"(addr) : "memory"); return r;
}

__device__ void dsa_batch(const P& p, unsigned char* lds_raw, int b, int pos) {
  const int t0 = pos * 16;
#define DSA_IDS const int tid = tid_fresh(), wave = __builtin_amdgcn_readfirstlane(tid >> 6), lane = tid & 63, g = lane >> 4, c = lane & 15; (void)wave; (void)g; (void)c;
  const size_t tokb = (size_t)b * SEQ, tok0 = tokb + t0;
  const bf16* DQ = (const bf16*)(p.ws + OFF_DQ);
  const bf16* CKV = (const bf16*)(p.ws + OFF_CKV);
  const float* SSP = (const float*)(p.ws + OFF_SSP);
  const bf16* IQ = (const bf16*)(p.ws + OFF_IQ);
  const bf16* IK = (const bf16*)(p.ws + OFF_IK);
  const float* IW = (const float*)(p.ws + OFF_IW);
  const bf16* WUK = (const bf16*)(p.ws + OFF_WUK);
  const bf16* WUV = (const bf16*)(p.ws + OFF_WUV);
  bf16* ODSA = (bf16*)(p.ws + OFF_ODSA);
  bf16* QL = (bf16*)(p.ws + OFF_DSCR + (size_t)blockIdx.x * 131072);
  bf16* OL = QL + 32768;
  LAS unsigned char* lds = (LAS unsigned char*)lds_raw;
  LAS unsigned short* key16 = (LAS unsigned short*)(lds + DS_KEY16);
  LAS unsigned short* sel = (LAS unsigned short*)(lds + DS_SEL);

  {
    DSA_IDS
    const int h = wave;
    bf16x8_t dqf[4];
#pragma unroll
    for (int ks = 0; ks < 4; ++ks) dqf[ks] = *(const bf16x8_t*)(DQ + (tok0 + c) * 1024 + h * 128 + ks * 32 + 8 * g);
#pragma unroll 4
    for (int nt = 0; nt < 16; ++nt) {
      f32x4 a = (f32x4){0.f, 0.f, 0.f, 0.f};
#pragma unroll
      for (int ks = 0; ks < 4; ++ks) {
        const bf16x8_t wf = *(const bf16x8_t*)(WUK + (size_t)(h * 256 + nt * 16 + c) * 128 + ks * 32 + 8 * g);
        a = __builtin_amdgcn_mfma_f32_16x16x32_bf16(wf, dqf[ks], a, 0, 0, 0);
      }
      uint2 o; o.x = pk2(a[0], a[1]); o.y = pk2(a[2], a[3]);
      *(uint2*)(QL + c * 2048 + h * 256 + nt * 16 + 4 * g) = o;
    }
  }
  if (t0 >= 256) {
    DSA_IDS
    bf16x8_t qf[8][2];
    float iw[8];
#pragma unroll
    for (int h = 0; h < 8; ++h) {
      qf[h][0] = *(const bf16x8_t*)(IQ + (tok0 + c) * 512 + h * 64 + 8 * g);
      qf[h][1] = *(const bf16x8_t*)(IQ + (tok0 + c) * 512 + h * 64 + 32 + 8 * g);
      iw[h] = IW[(tok0 + c) * 8 + h];
    }
    const int ntile = pos + 1;
    for (int kt = wave; kt < ntile; kt += 8) {
      const bf16* kr = IK + (tokb + kt * 16 + c) * 64 + 8 * g;
      const bf16x8_t k0 = *(const bf16x8_t*)kr, k1 = *(const bf16x8_t*)(kr + 32);
      f32x4 sc = (f32x4){0.f, 0.f, 0.f, 0.f};
#pragma unroll
      for (int h = 0; h < 8; ++h) {
        f32x4 d = __builtin_amdgcn_mfma_f32_16x16x32_bf16(k0, qf[h][0], (f32x4){0.f, 0.f, 0.f, 0.f}, 0, 0, 0);
        d = __builtin_amdgcn_mfma_f32_16x16x32_bf16(k1, qf[h][1], d, 0, 0, 0);
#pragma unroll
        for (int i = 0; i < 4; ++i) sc[i] += iw[h] * fmaxf(d[i], 0.f);
      }
      u16x4_t o;
      const int sb = kt * 16 + 4 * g, tq = t0 + c;
      o.x = (sb + 0 <= tq) ? (unsigned short)(f2ord(sc[0]) >> 16) : (unsigned short)0;
      o.y = (sb + 1 <= tq) ? (unsigned short)(f2ord(sc[1]) >> 16) : (unsigned short)0;
      o.z = (sb + 2 <= tq) ? (unsigned short)(f2ord(sc[2]) >> 16) : (unsigned short)0;
      o.w = (sb + 3 <= tq) ? (unsigned short)(f2ord(sc[3]) >> 16) : (unsigned short)0;
      *(LAS u16x4_t*)(key16 + c * 4096 + sb) = o;
    }
  }
  __syncthreads();
#pragma unroll 1
  for (int qq = 0; qq < 2; ++qq) {
    DSA_IDS
    const int q = wave + 8 * qq, t = t0 + q;
    LAS unsigned short* selq = sel + q * 256;
    if (t < 256) {
      for (int j = lane; j < 256; j += 64) selq[j] = (unsigned short)((j <= t) ? j : 0);
    } else {
      LAS unsigned* hist = (LAS unsigned*)(lds + DS_WAVE + wave * 1024);
      const LAS unsigned short* kq = key16 + q * 4096;
      *(LAS u32x4_t*)(hist + 4 * lane) = (u32x4_t){0u, 0u, 0u, 0u};
      wave_lds_fence();
      for (int s = lane; s <= t; s += 64) __hip_atomic_fetch_add(hist + (kq[s] >> 8), 1u, __ATOMIC_RELAXED, __HIP_MEMORY_SCOPE_WORKGROUP);
      wave_lds_fence();
      int d1, ab1;
      find_digit(hist, 256, lane, d1, ab1);
      wave_lds_fence();
      *(LAS u32x4_t*)(hist + 4 * lane) = (u32x4_t){0u, 0u, 0u, 0u};
      wave_lds_fence();
      for (int s = lane; s <= t; s += 64) {
        const unsigned k = kq[s];
        if ((int)(k >> 8) == d1) __hip_atomic_fetch_add(hist + (k & 255u), 1u, __ATOMIC_RELAXED, __HIP_MEMORY_SCOPE_WORKGROUP);
      }
      wave_lds_fence();
      int d2, ab2;
      find_digit(hist, 256 - ab1, lane, d2, ab2);
      const unsigned B = ((unsigned)d1 << 8) | (unsigned)d2;
      const int m = 256 - ab1 - ab2;
      int base = 0, eqbase = 0;
      const unsigned long long ltmask = (1ull << lane) - 1ull;
      for (int s0 = 0; s0 <= t; s0 += 64) {
        const int s = s0 + lane;
        const unsigned k = (s <= t) ? (unsigned)kq[s] : 0u;
        const bool eq = (s <= t) && (k == B);
        const unsigned long long em = __ballot(eq);
        const int eqrank = eqbase + __popcll(em & ltmask);
        const bool take = (k > B) || (eq && eqrank < m);
        const unsigned long long tm = __ballot(take);
        const int ps = base + __popcll(tm & ltmask);
        if (take && ps < 256) selq[ps] = (unsigned short)s;
        base += __popcll(tm);
        eqbase += __popcll(em);
      }
    }
  }
  __syncthreads();
  {
    DSA_IDS
    LAS unsigned char* buf = lds + DS_KEY16 + wave * DS_CHUNK;
    LAS float* kr = (LAS float*)(lds + DS_WAVE + wave * 1024);
    LAS float* kd = kr + 32;
    const unsigned bufaddr = (unsigned)(uintptr_t)buf;
    const unsigned vb = bufaddr + (unsigned)((4 * g + (c >> 2)) * DS_RS + 8 * (c & 3));
    const float slope = (c < 8) ? exp2f(-(float)(c + 1)) : 0.f;
#pragma unroll 1
    for (int qq = 0; qq < 2; ++qq) {
      const int q = wave + 8 * qq, t = t0 + q;
      const int nsel = (t + 1 < 256) ? (t + 1) : 256, nch = (nsel + 31) >> 5;
      const LAS unsigned short* selq = sel + q * 256;
      const bf16* qlp = QL + q * 2048 + (c & 7) * 256 + 8 * g;
      float mrun = -1e30f, lrun = 0.f;
      f32x4 o[16];
#pragma unroll
      for (int nt = 0; nt < 16; ++nt) o[nt] = (f32x4){0.f, 0.f, 0.f, 0.f};
      u32x4_t st[16];
      float st_r = 0.f, st_d = -1.f;
#define DSA_ISSUE(ch)                                                                                   \
      {                                                                                                 \
        _Pragma("unroll") for (int r = 0; r < 16; ++r) {                                                \
          const int j = (ch) * 32 + 2 * r + (lane >> 5);                                                \
          const int idx = (j < nsel) ? (int)selq[j] : 0;                                                \
          st[r] = *(const u32x4_t*)(CKV + (tokb + idx) * 256 + (lane & 31) * 8);                          \
        }                                                                                               \
        const int j2 = (ch) * 32 + (lane & 31);                                                         \
        const int idx2 = (j2 < nsel) ? (int)selq[j2] : 0;                                               \
        const float4 ss = *(const float4*)(SSP + (tokb + idx2) * 4);                                    \
        st_r = rsqrtf(((ss.x + ss.y) + (ss.z + ss.w)) * (1.f / 256.f) + 1e-6f);                         \
        st_d = (j2 < nsel) ? (float)(t - idx2) : -1.f;                                                  \
      }
      DSA_ISSUE(0);
#pragma unroll 1
      for (int ch = 0; ch < nch; ++ch) {
#pragma unroll
        for (int r = 0; r < 16; ++r) *(LAS u32x4_t*)(buf + (2 * r + (lane >> 5)) * DS_RS + (lane & 31) * 16) = st[r];
        if (lane < 32) { kr[lane] = st_r; kd[lane] = st_d; }
        wave_lds_fence();
        if (ch + 1 < nch) DSA_ISSUE(ch + 1);
        f32x4 s0 = (f32x4){0.f, 0.f, 0.f, 0.f}, s1 = (f32x4){0.f, 0.f, 0.f, 0.f};
#pragma unroll
        for (int ks = 0; ks < 8; ++ks) {
          const bf16x8_t a0 = *(const LAS bf16x8_t*)(buf + c * DS_RS + (ks * 32 + 8 * g) * 2);
          const bf16x8_t a1 = *(const LAS bf16x8_t*)(buf + (16 + c) * DS_RS + (ks * 32 + 8 * g) * 2);
          const bf16x8_t qfk = *(const bf16x8_t*)(qlp + ks * 32);
          s0 = __builtin_amdgcn_mfma_f32_16x16x32_bf16(a0, qfk, s0, 0, 0, 0);
          s1 = __builtin_amdgcn_mfma_f32_16x16x32_bf16(a1, qfk, s1, 0, 0, 0);
        }
        const f32x4 r0 = *(const LAS f32x4*)(kr + 4 * g), r1 = *(const LAS f32x4*)(kr + 16 + 4 * g);
        const f32x4 d0 = *(const LAS f32x4*)(kd + 4 * g), d1 = *(const LAS f32x4*)(kd + 16 + 4 * g);
        float x[8];
#pragma unroll
        for (int i = 0; i < 4; ++i) {
          x[i] = (d0[i] < 0.f) ? -1e30f : (s0[i] * r0[i] - slope * d0[i]);
          x[4 + i] = (d1[i] < 0.f) ? -1e30f : (s1[i] * r1[i] - slope * d1[i]);
        }
        float mx = fmaxf(fmaxf(fmaxf(x[0], x[1]), fmaxf(x[2], x[3])), fmaxf(fmaxf(x[4], x[5]), fmaxf(x[6], x[7])));
        mx = fmaxf(mx, __shfl_xor(mx, 16)); mx = fmaxf(mx, __shfl_xor(mx, 32));
        const float mn = fmaxf(mrun, mx);
        const float alpha = __expf(mrun - mn);
        mrun = mn;
        float pr[8], ps = 0.f;
#pragma unroll
        for (int i = 0; i < 8; ++i) { pr[i] = (x[i] <= -1e29f) ? 0.f : __expf(x[i] - mn); ps += pr[i]; }
        ps += __shfl_xor(ps, 16); ps += __shfl_xor(ps, 32);
        lrun = lrun * alpha + ps;
#pragma unroll
        for (int nt = 0; nt < 16; ++nt) o[nt] *= alpha;
        union { bf16x8_t v; unsigned u[4]; } pf;
        pf.u[0] = pk2(pr[0] * r0[0], pr[1] * r0[1]); pf.u[1] = pk2(pr[2] * r0[2], pr[3] * r0[3]);
        pf.u[2] = pk2(pr[4] * r1[0], pr[5] * r1[1]); pf.u[3] = pk2(pr[6] * r1[2], pr[7] * r1[3]);
#pragma unroll
        for (int nt = 0; nt < 16; nt += 4) {
          s16x4_t lo[4], hi[4];
#pragma unroll
          for (int u = 0; u < 4; ++u) { lo[u] = tr_read_b64(vb + (nt + u) * 32); hi[u] = tr_read_b64(vb + (nt + u) * 32 + 16 * DS_RS); }
          asm volatile("s_waitcnt lgkmcnt(0)" ::: "memory");
          __builtin_amdgcn_sched_barrier(0);
#pragma unroll
          for (int u = 0; u < 4; ++u) {
            const bf16x8_t af = (bf16x8_t){lo[u][0], lo[u][1], lo[u][2], lo[u][3], hi[u][0], hi[u][1], hi[u][2], hi[u][3]};
            o[nt + u] = __builtin_amdgcn_mfma_f32_16x16x32_bf16(af, pf.v, o[nt + u], 0, 0, 0);
          }
        }
        wave_lds_fence();
      }
#undef DSA_ISSUE
      if (c < 8) {
        const float inv = 1.f / lrun;
#pragma unroll
        for (int nt = 0; nt < 16; ++nt) {
          uint2 w; w.x = pk2(o[nt][0] * inv, o[nt][1] * inv); w.y = pk2(o[nt][2] * inv, o[nt][3] * inv);
          *(uint2*)(OL + q * 2048 + c * 256 + nt * 16 + 4 * g) = w;
        }
      }
    }
  }
  __syncthreads();
  {
    DSA_IDS
    const int h = wave;
    bf16x8_t of[8];
#pragma unroll
    for (int ks = 0; ks < 8; ++ks) of[ks] = *(const bf16x8_t*)(OL + c * 2048 + h * 256 + ks * 32 + 8 * g);
#pragma unroll 2
    for (int nt = 0; nt < 8; ++nt) {
      f32x4 a = (f32x4){0.f, 0.f, 0.f, 0.f};
#pragma unroll
      for (int ks = 0; ks < 8; ++ks) {
        const bf16x8_t wf = *(const bf16x8_t*)(WUV + (size_t)(h * 128 + nt * 16 + c) * 256 + ks * 32 + 8 * g);
        a = __builtin_amdgcn_mfma_f32_16x16x32_bf16(wf, of[ks], a, 0, 0, 0);
      }
      uint2 w; w.x = pk2(a[0], a[1]); w.y = pk2(a[2], a[3]);
      *(uint2*)(ODSA + (tok0 + c) * 1024 + h * 128 + nt * 16 + 4 * g) = w;
    }
  }
  __syncthreads();
}

#undef DSA_IDS
__device__ void ph_dsa512(const P& p, unsigned char* lds_raw) {
  for (int it = blockIdx.x; it < TT / 16; it += gridDim.x) {
    const int k = it >> 8, j = it & 255;
    dsa_batch(p, lds_raw, k, (k & 1) ? 255 - j : j);
  }
}

#define GL_QD    0
#define GL_KI    18432
#define GL_KE    36864
#define GL_V     55296
#define GL_AT    90112
#define GL_GLOW  99328
#define GL_QT    103424
#define GL_DEC   105472
#define GL_SSQ   105984
#define GL_LB    108032
#define GL_TOTAL 140800

__device__ void gla_item(const P& p, unsigned char* lds_raw, int item) {
  int tid = tid_fresh();
  const int b = item >> 2, h = item & 3;
  const size_t tokb = (size_t)b * SEQ;
  const bf16* Qg = (const bf16*)(p.ws + OFF_Q);
  const bf16* Kg = (const bf16*)(p.ws + OFF_K);
  bf16* Vg = (bf16*)(p.ws + OFF_V);
  const float* GLOWg = (const float*)(p.ws + OFF_GLOW);
  const bf16* SGR = (const bf16*)(p.ws + OFF_SGR);
  LAS unsigned char* lds = (LAS unsigned char*)lds_raw;
  const unsigned lds0 = (unsigned)(uintptr_t)lds;
  LAS float* QT = (LAS float*)(lds + GL_QT);
  LAS float* DEC = (LAS float*)(lds + GL_DEC);
  LAS float* SSQ = (LAS float*)(lds + GL_SSQ);
  float wg[16];
#pragma unroll
  for (int r = 0; r < 16; ++r) wg[r] = p.w_gate_up[r * 512 + h * 128 + (tid & 127)];
  const float bg = p.b_gate[h * 128 + (tid & 127)];
  const float gn0 = p.gla_norm_g[h * 256 + 32 * (tid >> 6) + (tid & 15)], gn1 = p.gla_norm_g[h * 256 + 32 * (tid >> 6) + 16 + (tid & 15)];
  u32x4_t rq[2], rk[2], rv[4], rg = (u32x4_t){0u, 0u, 0u, 0u};
#define GLA_LOAD(ch)                                                                                      \
  {                                                                                                       \
    const size_t tb = tokb + (size_t)(ch) * 64;                                                           \
    _Pragma("unroll") for (int i = 0; i < 2; ++i) {                                                       \
      const int id = tid + 512 * i, tk = id >> 4, part = id & 15;                                         \
      rq[i] = *(const u32x4_t*)(Qg + (tb + tk) * 512 + h * 128 + part * 8);                               \
      rk[i] = *(const u32x4_t*)(Kg + (tb + tk) * 512 + h * 128 + part * 8);                               \
    }                                                                                                     \
    _Pragma("unroll") for (int i = 0; i < 4; ++i) {                                                       \
      const int id = tid + 512 * i, tk = id >> 5, part = id & 31;                                         \
      rv[i] = *(const u32x4_t*)(Vg + (tb + tk) * 1024 + h * 256 + part * 8);                              \
    }                                                                                                     \
    if (tid < 256) rg = *(const u32x4_t*)(GLOWg + (tb + (tid >> 2)) * 16 + (tid & 3) * 4);                \
  }
  f32x4 S[8][2];
#pragma unroll
  for (int a = 0; a < 8; ++a) { S[a][0] = (f32x4){0.f, 0.f, 0.f, 0.f}; S[a][1] = (f32x4){0.f, 0.f, 0.f, 0.f}; }
  GLA_LOAD(0);
#pragma unroll 1
  for (int ch = 0; ch < SEQ / 64; ++ch) {
    asm volatile("" : "+v"(tid));
    const int wave = __builtin_amdgcn_readfirstlane(tid >> 6), lane = tid & 63, g = lane >> 4, c = lane & 15;
    const int d = tid & 127, tq = __builtin_amdgcn_readfirstlane(tid >> 7);
    const unsigned vtr = lds0 + GL_V + (unsigned)((8 * g + (c >> 2)) * 544 + (32 * wave + 4 * (c & 3)) * 2);
    const unsigned ketr = lds0 + GL_KE + (unsigned)((8 * g + (c >> 2)) * 288 + (4 * (c & 3)) * 2);
    const size_t tb = tokb + (size_t)ch * 64;
#pragma unroll
    for (int i = 0; i < 2; ++i) {
      const int id = tid + 512 * i, tk = id >> 4, part = id & 15;
      *(LAS u32x4_t*)(lds + GL_QD + tk * 288 + part * 16) = rq[i];
      *(LAS u32x4_t*)(lds + GL_KI + tk * 288 + part * 16) = rk[i];
    }
#pragma unroll
    for (int i = 0; i < 4; ++i) {
      const int id = tid + 512 * i, tk = id >> 5, part = id & 31;
      *(LAS u32x4_t*)(lds + GL_V + tk * 544 + part * 16) = rv[i];
    }
    if (tid < 256) *(LAS u32x4_t*)(lds + GL_GLOW + (tid >> 2) * 64 + (tid & 3) * 16) = rg;
    __syncthreads();
    if (ch + 1 < SEQ / 64) GLA_LOAD(ch + 1);
    LAS float* LB = (LAS float*)(lds + GL_LB);
    float run = 0.f;
#pragma unroll 2
    for (int i = 0; i < 16; ++i) {
      const LAS f32x4* gp = (const LAS f32x4*)(lds + GL_GLOW + (16 * tq + i) * 64);
      const f32x4 g0 = gp[0], g1 = gp[1], g2 = gp[2], g3 = gp[3];
      float gl = bg;
      gl += g0[0] * wg[0] + g0[1] * wg[1] + g0[2] * wg[2] + g0[3] * wg[3];
      gl += g1[0] * wg[4] + g1[1] * wg[5] + g1[2] * wg[6] + g1[3] * wg[7];
      gl += g2[0] * wg[8] + g2[1] * wg[9] + g2[2] * wg[10] + g2[3] * wg[11];
      gl += g3[0] * wg[12] + g3[1] * wg[13] + g3[2] * wg[14] + g3[3] * wg[15];
      const float ls = fminf(gl, 0.f) - __logf(1.f + __expf(-fabsf(gl)));
      run += ls * (1.f / 16.f);
      LB[(16 * tq + i) * 128 + d] = run;
    }
    QT[tq * 128 + d] = run;
    __syncthreads();
    {
      float off = 0.f, tot = 0.f;
#pragma unroll
      for (int k = 0; k < 4; ++k) { const float v = QT[k * 128 + d]; tot += v; off += (k < tq) ? v : 0.f; }
      const float eb = __expf(tot);
#pragma unroll 2
      for (int i = 0; i < 16; ++i) {
        const int t = 16 * tq + i;
        const float bb = LB[t * 128 + d] + off;
        const float e = __expf(bb), r = __expf(-bb);
        LAS bf16* qp = (LAS bf16*)(lds + GL_QD + t * 288) + d;
        LAS bf16* kp = (LAS bf16*)(lds + GL_KI + t * 288) + d;
        LAS bf16* ep = (LAS bf16*)(lds + GL_KE + t * 288) + d;
        const float q = bf2f(*qp), k = bf2f(*kp);
        *qp = f2bf(q * e);
        *kp = f2bf(k * r);
        *ep = f2bf(k * (eb * r));
      }
      if (tq == 0) DEC[d] = eb;
    }
    __syncthreads();
    {
      const int ti = wave >> 1;
#pragma unroll
      for (int u = 0; u < 2; ++u) {
        const int tj = 2 * (wave & 1) + u;
        f32x4 acc = (f32x4){0.f, 0.f, 0.f, 0.f};
        if (tj <= ti) {
#pragma unroll
          for (int ks = 0; ks < 4; ++ks) {
            const bf16x8_t a = *(const LAS bf16x8_t*)(lds + GL_QD + (16 * ti + c) * 288 + (32 * ks + 8 * g) * 2);
            const bf16x8_t bb = *(const LAS bf16x8_t*)(lds + GL_KI + (16 * tj + c) * 288 + (32 * ks + 8 * g) * 2);
            acc = __builtin_amdgcn_mfma_f32_16x16x32_bf16(a, bb, acc, 0, 0, 0);
          }
        }
#pragma unroll
        for (int r = 0; r < 4; ++r) {
          const int i = 16 * ti + 4 * g + r, j = 16 * tj + c;
          *((LAS bf16*)(lds + GL_AT + i * 144) + j) = f2bf((j <= i) ? acc[r] : 0.f);
        }
      }
    }
    __syncthreads();
    f32x4 o[4][2];
    {
      bf16x8_t vf[2][2];
      {
        s16x4_t lo[4], hi[4];
#pragma unroll
        for (int ks = 0; ks < 2; ++ks)
#pragma unroll
          for (int tn = 0; tn < 2; ++tn) {
            lo[ks * 2 + tn] = tr_read_b64(vtr + (32 * ks) * 544 + tn * 32);
            hi[ks * 2 + tn] = tr_read_b64(vtr + (32 * ks + 4) * 544 + tn * 32);
          }
        asm volatile("s_waitcnt lgkmcnt(0)" ::: "memory");
        __builtin_amdgcn_sched_barrier(0);
#pragma unroll
        for (int u = 0; u < 4; ++u)
          vf[u >> 1][u & 1] = (bf16x8_t){lo[u][0], lo[u][1], lo[u][2], lo[u][3], hi[u][0], hi[u][1], hi[u][2], hi[u][3]};
      }
#pragma unroll
      for (int tm = 0; tm < 4; ++tm) { o[tm][0] = (f32x4){0.f, 0.f, 0.f, 0.f}; o[tm][1] = (f32x4){0.f, 0.f, 0.f, 0.f}; }
#pragma unroll
      for (int tm = 0; tm < 4; ++tm)
#pragma unroll
        for (int ks = 0; ks < 2; ++ks) {
          if (ks == 1 && tm < 2) continue;
          const bf16x8_t a = *(const LAS bf16x8_t*)(lds + GL_AT + (16 * tm + c) * 144 + (32 * ks + 8 * g) * 2);
          o[tm][0] = __builtin_amdgcn_mfma_f32_16x16x32_bf16(a, vf[ks][0], o[tm][0], 0, 0, 0);
          o[tm][1] = __builtin_amdgcn_mfma_f32_16x16x32_bf16(a, vf[ks][1], o[tm][1], 0, 0, 0);
          __builtin_amdgcn_sched_barrier(0);
        }
#pragma unroll
      for (int u = 0; u < 4; ++u) {
        union { bf16x8_t v; unsigned w[4]; } s0, s1;
        s0.w[0] = pk2(S[2 * u][0][0], S[2 * u][0][1]); s0.w[1] = pk2(S[2 * u][0][2], S[2 * u][0][3]);
        s0.w[2] = pk2(S[2 * u + 1][0][0], S[2 * u + 1][0][1]); s0.w[3] = pk2(S[2 * u + 1][0][2], S[2 * u + 1][0][3]);
        s1.w[0] = pk2(S[2 * u][1][0], S[2 * u][1][1]); s1.w[1] = pk2(S[2 * u][1][2], S[2 * u][1][3]);
        s1.w[2] = pk2(S[2 * u + 1][1][0], S[2 * u + 1][1][1]); s1.w[3] = pk2(S[2 * u + 1][1][2], S[2 * u + 1][1][3]);
#pragma unroll
        for (int tm = 0; tm < 4; ++tm) {
          const LAS unsigned char* qrow = lds + GL_QD + (16 * tm + c) * 288 + (32 * u + 4 * g) * 2;
          const s16x4_t q0 = *(const LAS s16x4_t*)qrow, q1 = *(const LAS s16x4_t*)(qrow + 32);
          const bf16x8_t a = (bf16x8_t){q0[0], q0[1], q0[2], q0[3], q1[0], q1[1], q1[2], q1[3]};
          o[tm][0] = __builtin_amdgcn_mfma_f32_16x16x32_bf16(a, s0.v, o[tm][0], 0, 0, 0);
          o[tm][1] = __builtin_amdgcn_mfma_f32_16x16x32_bf16(a, s1.v, o[tm][1], 0, 0, 0);
        }
        __builtin_amdgcn_sched_barrier(0);
      }
#pragma unroll
      for (int tk = 0; tk < 8; ++tk) {
        const f32x4 dec4 = *(const LAS f32x4*)(DEC + 16 * tk + 4 * g);
        S[tk][0] *= dec4; S[tk][1] *= dec4;
        s16x4_t lo0 = tr_read_b64(ketr + tk * 32), hi0 = tr_read_b64(ketr + 4 * 288 + tk * 32);
        s16x4_t lo1 = tr_read_b64(ketr + 32 * 288 + tk * 32), hi1 = tr_read_b64(ketr + 36 * 288 + tk * 32);
        asm volatile("s_waitcnt lgkmcnt(0)" ::: "memory");
        __builtin_amdgcn_sched_barrier(0);
        const bf16x8_t a0 = (bf16x8_t){lo0[0], lo0[1], lo0[2], lo0[3], hi0[0], hi0[1], hi0[2], hi0[3]};
        const bf16x8_t a1 = (bf16x8_t){lo1[0], lo1[1], lo1[2], lo1[3], hi1[0], hi1[1], hi1[2], hi1[3]};
        S[tk][0] = __builtin_amdgcn_mfma_f32_16x16x32_bf16(a0, vf[0][0], S[tk][0], 0, 0, 0);
        S[tk][1] = __builtin_amdgcn_mfma_f32_16x16x32_bf16(a0, vf[0][1], S[tk][1], 0, 0, 0);
        S[tk][0] = __builtin_amdgcn_mfma_f32_16x16x32_bf16(a1, vf[1][0], S[tk][0], 0, 0, 0);
        S[tk][1] = __builtin_amdgcn_mfma_f32_16x16x32_bf16(a1, vf[1][1], S[tk][1], 0, 0, 0);
        __builtin_amdgcn_sched_barrier(0);
      }
#pragma unroll
      for (int tm = 0; tm < 4; ++tm)
#pragma unroll
        for (int r = 0; r < 4; ++r) {
          float ss = o[tm][0][r] * o[tm][0][r] + o[tm][1][r] * o[tm][1][r];
          ss = row16_sum(ss);
          if (c == 0) SSQ[(16 * tm + 4 * g + r) * 8 + wave] = ss;
        }
    }
    __syncthreads();
#pragma unroll
    for (int tm = 0; tm < 4; ++tm)
#pragma unroll
      for (int r = 0; r < 4; ++r) {
        const int t = 16 * tm + 4 * g + r;
        const f32x4 p0 = *(const LAS f32x4*)(SSQ + t * 8), p1 = *(const LAS f32x4*)(SSQ + t * 8 + 4);
        const float tot = ((p0[0] + p0[1]) + (p0[2] + p0[3])) + ((p1[0] + p1[1]) + (p1[2] + p1[3]));
        const float rstd = rsqrtf(tot * (1.f / 256.f) + 1e-6f);
        const size_t gi = (tb + t) * 1024 + h * 256 + 32 * wave + c;
        Vg[gi] = f2bf(o[tm][0][r] * rstd * gn0 * bf2f(SGR[gi]));
        Vg[gi + 16] = f2bf(o[tm][1][r] * rstd * gn1 * bf2f(SGR[gi + 16]));
      }
  }
#undef GLA_LOAD
  __syncthreads();
}

#define LDS_BYTES 155712
#define OFF_CTR (200ull * 1024)

__device__ __forceinline__ void ph_mixer(const P& p, unsigned char* lds_raw) {
  if (blockIdx.x < 32) gla_item(p, lds_raw, blockIdx.x);
  unsigned* ctr = (unsigned*)(p.ws + OFF_CTR);
  LAS unsigned* slot = (LAS unsigned*)((LAS unsigned char*)lds_raw + DS_TOTAL);
  for (;;) {
    if (tid_fresh() == 0) *slot = __hip_atomic_fetch_add(ctr, 1u, __ATOMIC_RELAXED, __HIP_MEMORY_SCOPE_AGENT);
    __syncthreads();
    const unsigned qi = *slot;
    __syncthreads();
    if (qi >= TT / 16) break;
    dsa_batch(p, lds_raw, (int)(qi & 7u), 255 - (int)(qi >> 3));
  }
}

__global__ void __launch_bounds__(512, 2) mega(P p) {
  extern __shared__ __attribute__((aligned(16))) unsigned char lds_raw[];
  LAS unsigned char* lds = (LAS unsigned char*)lds_raw;
  cg::grid_group grid = cg::this_grid();
  char* ws = p.ws;
  const int bid = blockIdx.x, nb = gridDim.x;
  if (bid == 0 && threadIdx.x == 0) *(unsigned*)(ws + OFF_CTR) = 0u;
  ph_prep(p, (float*)lds_raw);
  grid.sync();
  ph_mod(p, p.x, p.norm1_g, 0, 1024, (bf16*)(ws + OFF_H), bid, nb);
  grid.sync();
  gemm_run(lds, (const bf16*)(ws + OFF_H), (const bf16*)(ws + OFF_WT_IN), TT, 7168, 1024, EpiIn{ws, p.out});
  grid.sync();
  ph_mixer(p, lds_raw);
  grid.sync();
  gemm_run(lds, (const bf16*)(ws + OFF_V), (const bf16*)(ws + OFF_WT_A), TT, 1024, 1024,
           EpiMix<false>{(const bf16*)p.out, (bf16*)(ws + OFF_MIX)});
  gemm_run(lds, (const bf16*)(ws + OFF_ODSA), (const bf16*)(ws + OFF_WT_B), TT, 1024, 1024,
           EpiMix<true>{(const bf16*)p.out + (size_t)TT * 1024, (bf16*)(ws + OFF_MIX)});
  grid.sync();
  gemm_run(lds, (const bf16*)(ws + OFF_MIX), (const bf16*)(ws + OFF_WT_OUT), TT, 1024, 1024,
           EpiX1{p.x, (const float*)(ws + OFF_ADA), p.out});
  grid.sync();
  ph_mod(p, p.out, p.norm2_g, 3072, 4096, (bf16*)(ws + OFF_H), bid, nb);
  grid.sync();
  gemm_run(lds, (const bf16*)(ws + OFF_H), (const bf16*)(ws + OFF_WT_Q), TT, 2048, 1024, EpiPlain{(bf16*)(ws + OFF_PQ), 2048});
  grid.sync();
  ph_peer512(p, lds_raw);
}

extern "C" void kernel_launch(void* const* d_in, const int* in_sizes, int n_in, void* d_out, int out_size, void* d_ws,
                              size_t ws_size, hipStream_t stream) {
  P p{};
  const float** f = (const float**)&p;
  for (int i = 0; i < 22; ++i) f[i] = (const float*)d_in[i];
  p.out = (float*)d_out;
  p.ws = (char*)d_ws;
  if (ws_size < WS_NEED) { fprintf(stderr, "workspace too small: %zu\n", ws_size); return; }
  static int grid_blocks = 0;
  if (!grid_blocks) {
    int dev = 0, cus = 0, per_cu = 0;
    (void)hipGetDevice(&dev);
    (void)hipDeviceGetAttribute(&cus, hipDeviceAttributeMultiprocessorCount, dev);
    if (hipFuncSetAttribute((const void*)mega, hipFuncAttributeMaxDynamicSharedMemorySize, LDS_BYTES) != hipSuccess) {
      fprintf(stderr, "hipFuncSetAttribute failed\n"); grid_blocks = -1; return;
    }
    if (hipOccupancyMaxActiveBlocksPerMultiprocessor(&per_cu, (const void*)mega, 512, LDS_BYTES) != hipSuccess || per_cu < 1) {
      fprintf(stderr, "occupancy query failed\n"); grid_blocks = -1; return;
    }
    grid_blocks = cus;
  }
  if (grid_blocks <= 0) return;
  void* args[] = {&p};
  hipError_t e = hipLaunchCooperativeKernel((void*)mega, dim3(grid_blocks), dim3(512), args, LDS_BYTES, stream);
  if (e != hipSuccess) fprintf(stderr, "cooperative launch failed: %s (grid %d)\n", hipGetErrorString(e), grid_blocks);
}
```

```cpp
#include <hip/hip_runtime.h>
#include <hip/hip_cooperative_groups.h>
#include <cstdio>
#include <cstdint>
namespace cg = cooperative_groups;

#define TT 32768
#define SEQ 4096
#define DM 1024
#define NIN 7000
typedef unsigned short bf16;
#define LAS __attribute__((address_space(3)))

struct P {
  const float *x, *c, *w_ada, *b_ada, *norm1_g, *w_in, *w_gate_up, *b_gate, *gla_norm_g, *kv_norm_g,
      *w_uk, *w_uv, *w_a, *w_b, *w_out, *norm2_g, *w_q, *sk1, *sk2, *peer_u, *peer_v, *final_g;
  float* out;
  char* ws;
};

#define MB (1ull << 20)
#define OFF_ADA   (0ull)
#define OFF_H     (1 * MB)
#define OFF_ODSA  (1 * MB)
#define OFF_Q     (65 * MB)
#define OFF_K     (97 * MB)
#define OFF_MIX   (65 * MB)
#define OFF_V     (129 * MB)
#define OFF_DQ    (193 * MB)
#define OFF_PQ    (129 * MB)
#define OFF_DSCR  (257 * MB)
#define OFF_SSP   (256ull * 1024)
#define OFF_CKV   (289 * MB)
#define OFF_IQ    (305 * MB)
#define OFF_IK    (337 * MB)
#define OFF_IW    (341 * MB)
#define OFF_GLOW  (342 * MB)
#define OFF_SGR   (344 * MB)
#define OFF_WT    (408 * MB)
#define OFF_WT_IN  (OFF_WT)
#define OFF_WT_A   (OFF_WT + 7168ull * 2048)
#define OFF_WT_B   (OFF_WT_A + 1024ull * 2048)
#define OFF_WT_OUT (OFF_WT_B + 1024ull * 2048)
#define OFF_WT_Q   (OFF_WT_OUT + 1024ull * 2048)
#define OFF_PU    (432 * MB)
#define OFF_PV    (464 * MB)
#define OFF_SK    (496 * MB)
#define OFF_PSC   (496 * MB + 128 * 1024)
#define OFF_WUK   (497 * MB)
#define OFF_WUV   (497 * MB + 512 * 1024)
#define WS_NEED   (498 * MB)

__device__ __forceinline__ bf16 f2bf(float f) {
  unsigned u = __float_as_uint(f);
  u += 0x7fffu + ((u >> 16) & 1u);
  return (bf16)(u >> 16);
}
__device__ __forceinline__ unsigned pk2(float lo, float hi) { return (unsigned)f2bf(lo) | ((unsigned)f2bf(hi) << 16); }
__device__ __forceinline__ float bf2f(bf16 h) { return __uint_as_float(((unsigned)h) << 16); }
__device__ __forceinline__ float bflo(unsigned u) { return __uint_as_float(u << 16); }
__device__ __forceinline__ float bfhi(unsigned u) { return __uint_as_float(u & 0xffff0000u); }
__device__ __forceinline__ float wave_sum(float v) {
#pragma unroll
  for (int o = 32; o > 0; o >>= 1) v += __shfl_xor(v, o);
  return v;
}
__device__ __forceinline__ float wave_max(float v) {
#pragma unroll
  for (int o = 32; o > 0; o >>= 1) v = fmaxf(v, __shfl_xor(v, o));
  return v;
}
#ifndef PROBE_TS
#define PROBE_TS 0
#endif
#define OFF_TS (208ull * 1024)
#if PROBE_TS
#define TS_SET(p, k) do { if (threadIdx.x == 0) ((unsigned long long*)((p).ws + OFF_TS))[k] = __builtin_amdgcn_s_memrealtime(); } while (0)
#define TS_ADD(p, k, t0) do { if (threadIdx.x == 0) ((unsigned long long*)((p).ws + OFF_TS))[k] += __builtin_amdgcn_s_memrealtime() - (t0); } while (0)
#define TS_NOW() __builtin_amdgcn_s_memrealtime()
#else
#define TS_SET(p, k) do {} while (0)
#define TS_ADD(p, k, t0) do {} while (0)
#define TS_NOW() 0ull
#endif
__device__ __forceinline__ int tid_fresh() { int t = threadIdx.x; asm volatile("" : "+v"(t)); return t; }
__device__ __forceinline__ float sigmoidf_(float v) { return 1.f / (1.f + __expf(-v)); }
__device__ __forceinline__ float siluf_(float v) { return v / (1.f + __expf(-v)); }

#include <hip/hip_runtime.h>
namespace pg8 {
#define PG8_LAS __attribute__((address_space(3)))
typedef unsigned short bf16_t;
typedef short bf16x8 __attribute__((ext_vector_type(8)));
typedef float f32x4 __attribute__((ext_vector_type(4)));
typedef unsigned u32x4 __attribute__((ext_vector_type(4)));
constexpr int BM = 256, BK = 64, HALF = 128, HTB = HALF * BK * 2  , STAGE_BYTES = 8 * HTB, NXCD = 8, WGM = 8;

__host__ __device__ __forceinline__ int lds_byte(int r, int c) { const int st = (r >> 4) * 2 + (c >> 5), rr = r & 15, cc = c & 31, ob = rr * 64 + cc * 2; return st * 1024 + (ob ^ (((ob >> 9) & 1) << 5)); }
__host__ __device__ __forceinline__ void stage_rc(int b, int& R, int& C) { const int st = b / 1024, sb = b % 1024, swz = sb ^ (((sb >> 9) & 1) << 5); R = (st >> 1) * 16 + swz / 64; C = (st & 1) * 32 + (swz % 64) / 2; }
__host__ __device__ __forceinline__ int perm32(int rho) { const int n = rho >> 4, i = rho & 15; return 8 * (i >> 2) + 4 * n + (i & 3); }

struct Unit { int pm, pn; };
struct Gemm { const bf16_t* A; const bf16_t* Bt; int M, N, K; };

struct StaticOrder {
    int nM, nN, nwg, G, c;
    __host__ __device__ void init(int M, int N, int G_, int c_) { nM = M / BM; nN = N / BM; nwg = nM * nN; G = G_; c = c_; }
    __host__ __device__ bool next(int i, Unit& u) const {
        const long L = (long)i * G + c; if (L >= nwg) return false;
        int wgid = (int)L; { const int q = nwg / NXCD, r = nwg % NXCD, xcd = wgid % NXCD, off = wgid / NXCD; wgid = (xcd < r ? xcd * (q + 1) : r * (q + 1) + (xcd - r) * q) + off; }
        const int nig = WGM * nN, gid = wgid / nig, fm = gid * WGM, gsz = (nM - fm) < WGM ? (nM - fm) : WGM;
        u.pm = fm + ((wgid % nig) % gsz); u.pn = (wgid % nig) / gsz; return true;
    }
    __device__ __forceinline__ void a_ready(const Unit&) const {}
    __device__ __forceinline__ void done(const Unit&) const {}
};
__device__ __forceinline__ unsigned cvt_pk_bf16(float lo, float hi) { unsigned r; asm volatile("v_cvt_pk_bf16_f32 %0, %1, %2" : "=v"(r) : "v"(lo), "v"(hi)); return r; }

template <class Epi, class Sched, bool STAMP = false>
__device__ __forceinline__ void gemm_phase(PG8_LAS unsigned char* lds, const Gemm g, const Sched& S, const Epi& E, unsigned long long* stamps) {
    const int tid = ::tid_fresh(), wid = __builtin_amdgcn_readfirstlane(tid >> 6), lane = tid & 63, wr = wid >> 2, wc = wid & 3, fr = lane & 15, fq = lane >> 4;
    const int K = g.K, nt = K / BK;
    int ts_lo = 0, ts_hi = 0, nts = 0; const unsigned long long rt_entry = STAMP ? (unsigned long long)wall_clock64() : 0ull;
#define PG8_STAMP() do { if (STAMP && wid == 0 && nts < 64) { const unsigned long long _c = (unsigned long long)clock64(); \
        ts_lo = (lane == nts) ? (int)(unsigned)_c : ts_lo; ts_hi = (lane == nts) ? (int)(unsigned)(_c >> 32) : ts_hi; ++nts; } } while (0)
    PG8_STAMP();
    unsigned voffA[2], voffB[2];
#pragma unroll
    for (int i = 0; i < 2; ++i) { int R, C; stage_rc(tid * 16 + i * 8192, R, C); const int Rb = Epi::PERM ? ((R & ~31) + perm32(R & 31)) : R;
        voffA[i] = (unsigned)(R * K + C) * 2u; voffB[i] = (unsigned)(Rb * K + C) * 2u; }
    const size_t kstep = (size_t)(BK * 2);
    const size_t hstep = (size_t)HALF * K * 2;
    const size_t tstep = 2 * hstep;
    const unsigned ldsw = (unsigned)wid * 1024u;
    const int aoff = lds_byte(wr * 64 + fr, fq * 8), boff = lds_byte(wc * 32 + fr, fq * 8);
#define PG8_SA(b, h) (((b) * 2 + (h)) * HTB)
#define PG8_SB(b, h) ((4 + (b) * 2 + (h)) * HTB)
#define PG8_STAGE(bufoff, gbase, voff) do { _Pragma("unroll") for (int _i = 0; _i < 2; ++_i) \
        __builtin_amdgcn_global_load_lds((const unsigned*)((const char*)(gbase) + (voff)[_i]), (PG8_LAS unsigned*)(lds + (bufoff) + ldsw + _i * 8192), 16, 0, 0); } while (0)
#define PG8_LDA(dst, b, h) do { _Pragma("unroll") for (int m = 0; m < 4; ++m) _Pragma("unroll") for (int k = 0; k < 2; ++k) dst[m][k] = *(const PG8_LAS bf16x8*)(lds + PG8_SA(b, h) + aoff + m * 2048 + k * 1024); } while (0)
#define PG8_LDB(dst, b, h) do { _Pragma("unroll") for (int n = 0; n < 2; ++n) _Pragma("unroll") for (int k = 0; k < 2; ++k) dst[n][k] = *(const PG8_LAS bf16x8*)(lds + PG8_SB(b, h) + boff + n * 2048 + k * 1024); } while (0)
#define PG8_MMA(ai, bj, At, Bt) do { __builtin_amdgcn_s_setprio(1); _Pragma("unroll") for (int m = 0; m < 4; ++m) _Pragma("unroll") for (int n = 0; n < 2; ++n) _Pragma("unroll") for (int k = 0; k < 2; ++k) \
        acc[ai][bj][m][n] = __builtin_amdgcn_mfma_f32_16x16x32_bf16(Bt[n][k], At[m][k], acc[ai][bj][m][n], 0, 0, 0); __builtin_amdgcn_s_setprio(0); } while (0)
#define PG8_WAIT_V(n) asm volatile("s_waitcnt vmcnt(" #n ")" ::: "memory")
#define PG8_WAIT_L(n) asm volatile("s_waitcnt lgkmcnt(" #n ")" ::: "memory")
#define PG8_BAR __builtin_amdgcn_s_barrier()
#define PG8_SCHED __builtin_amdgcn_sched_barrier(0)
    Unit cur, nxt; int ui = 0;
    if (!S.next(0, cur)) return;
    f32x4 acc[2][2][4][2];
#pragma unroll
    for (int a = 0; a < 2; ++a)
#pragma unroll
        for (int b = 0; b < 2; ++b)
#pragma unroll
            for (int m = 0; m < 4; ++m)
#pragma unroll
                for (int n = 0; n < 2; ++n) acc[a][b][m][n] = (f32x4){0.f, 0.f, 0.f, 0.f};
    bf16x8 At[4][2], B0[2][2], B1[2][2];
    const char* cA = (const char*)g.A + (size_t)cur.pm * tstep; const char* cB = (const char*)g.Bt + (size_t)cur.pn * tstep;
    S.a_ready(cur);
    PG8_STAGE(PG8_SB(0, 0), cB, voffB); PG8_STAGE(PG8_SA(0, 0), cA, voffA); PG8_STAGE(PG8_SB(0, 1), cB + hstep, voffB); PG8_STAGE(PG8_SA(0, 1), cA + hstep, voffA);
    if (wr == 1) PG8_BAR;
    PG8_WAIT_V(4); PG8_BAR;
    PG8_STAGE(PG8_SB(1, 0), cB + kstep, voffB); PG8_STAGE(PG8_SA(1, 0), cA + kstep, voffA); PG8_STAGE(PG8_SB(1, 1), cB + hstep + kstep, voffB);
    PG8_WAIT_V(6); PG8_BAR;
    PG8_STAMP();
    for (;;) {
        const bool has_next = S.next(ui + 1, nxt);
        const char* nA = has_next ? (const char*)g.A + (size_t)nxt.pm * tstep : cA; const char* nB = has_next ? (const char*)g.Bt + (size_t)nxt.pn * tstep : cB;
        for (int t = 0; t < nt; t += 2) {
            const bool last = (t == nt - 2);
            const char* a1 = cA + (size_t)(t + 1) * kstep;
            const char* a2 = last ? nA : cA + (size_t)(t + 2) * kstep; const char* b2 = last ? nB : cB + (size_t)(t + 2) * kstep;
            const char* a3 = a2 + kstep; const char* b3 = b2 + kstep;
            if (last && has_next) S.a_ready(nxt);
            PG8_LDB(B0, 0, 0); PG8_SCHED; PG8_LDA(At, 0, 0); PG8_STAGE(PG8_SA(1, 1), a1 + hstep, voffA);
            PG8_WAIT_L(8); PG8_BAR; PG8_WAIT_L(0); PG8_MMA(0, 0, At, B0); PG8_BAR; PG8_SCHED;
            PG8_LDB(B1, 0, 1); PG8_STAGE(PG8_SB(0, 0), b2, voffB);
            PG8_BAR; PG8_WAIT_L(0); PG8_MMA(0, 1, At, B1); PG8_BAR;
            PG8_LDA(At, 0, 1); PG8_STAGE(PG8_SA(0, 0), a2, voffA);
            PG8_BAR; PG8_WAIT_L(0); PG8_MMA(1, 0, At, B0); PG8_BAR; PG8_SCHED;
            PG8_STAGE(PG8_SB(0, 1), b2 + hstep, voffB);
            PG8_WAIT_V(6); PG8_BAR; PG8_MMA(1, 1, At, B1); PG8_BAR;
            PG8_LDB(B0, 1, 0); PG8_SCHED; PG8_LDA(At, 1, 0); PG8_STAGE(PG8_SA(0, 1), a2 + hstep, voffA);
            PG8_WAIT_L(8); PG8_BAR; PG8_WAIT_L(0); PG8_MMA(0, 0, At, B0); PG8_BAR; PG8_SCHED;
            PG8_LDB(B1, 1, 1); PG8_STAGE(PG8_SB(1, 0), b3, voffB);
            PG8_BAR; PG8_WAIT_L(0); PG8_MMA(0, 1, At, B1); PG8_BAR;
            PG8_LDA(At, 1, 1); PG8_STAGE(PG8_SA(1, 0), a3, voffA);
            PG8_BAR; PG8_WAIT_L(0); PG8_MMA(1, 0, At, B0); PG8_BAR; PG8_SCHED;
            PG8_STAGE(PG8_SB(1, 1), b3 + hstep, voffB);
            PG8_WAIT_V(6); PG8_BAR; PG8_MMA(1, 1, At, B1); PG8_BAR;
        }
        PG8_STAMP();
        if constexpr (!Epi::AFTER_DRAIN) { E(acc, cur, wr, wc, fr, fq); S.done(cur); }
        PG8_STAMP();
        if (!has_next) break;
#pragma unroll
        for (int a = 0; a < 2; ++a)
#pragma unroll
            for (int b = 0; b < 2; ++b)
#pragma unroll
                for (int m = 0; m < 4; ++m)
#pragma unroll
                    for (int n = 0; n < 2; ++n) acc[a][b][m][n] = (f32x4){0.f, 0.f, 0.f, 0.f};
        cur = nxt; cA = nA; cB = nB; ++ui;
    }
    PG8_WAIT_V(0);
    if (wr == 0) PG8_BAR;
    PG8_BAR;
    if constexpr (Epi::AFTER_DRAIN) { E.fused(acc, cur, wr, wc, fr, fq, lds, wid, lane); S.done(cur); }
    PG8_STAMP();
    if (STAMP && wid == 0) { stamps[lane] = lane < nts ? (((unsigned long long)(unsigned)ts_hi << 32) | (unsigned)ts_lo) : 0ull;
        if (lane == 62) stamps[62] = rt_entry; if (lane == 63) stamps[63] = (unsigned long long)wall_clock64(); }
#undef PG8_STAMP
#undef PG8_SA
#undef PG8_SB
#undef PG8_STAGE
#undef PG8_LDA
#undef PG8_LDB
#undef PG8_MMA
#undef PG8_WAIT_V
#undef PG8_WAIT_L
#undef PG8_BAR
#undef PG8_SCHED
}
}
__device__ void ph_mod(const P& p, const float* X, const float* g, int shift_off, int scale_off, bf16* H, int bid, int nb) {
  const float* ada = (const float*)(p.ws + OFF_ADA);
  const int tidm = tid_fresh(); int wave = tidm >> 6, lane = tidm & 63;
  for (int row = bid * (int)(blockDim.x >> 6) + wave; row < TT; row += nb * (int)(blockDim.x >> 6)) {
    const float4* xr = (const float4*)(X + (size_t)row * DM);
    float4 v[4];
    float ss = 0.f;
#pragma unroll
    for (int i = 0; i < 4; ++i) {
      v[i] = xr[lane + i * 64];
      ss += v[i].x * v[i].x + v[i].y * v[i].y + v[i].z * v[i].z + v[i].w * v[i].w;
    }
    ss = wave_sum(ss);
    float rstd = rsqrtf(ss * (1.f / DM) + 1e-6f);
    int b = row >> 12;
    const float* sh = ada + b * 6144 + shift_off;
    const float* sc = ada + b * 6144 + scale_off;
#pragma unroll
    for (int i = 0; i < 4; ++i) {
      int c0 = (lane + i * 64) * 4;
      float4 gg = *(const float4*)(g + c0);
      float4 s4 = *(const float4*)(sc + c0);
      float4 h4 = *(const float4*)(sh + c0);
      ushort4 o;
      o.x = f2bf(v[i].x * rstd * gg.x * (1.f + s4.x) + h4.x);
      o.y = f2bf(v[i].y * rstd * gg.y * (1.f + s4.y) + h4.y);
      o.z = f2bf(v[i].z * rstd * gg.z * (1.f + s4.z) + h4.z);
      o.w = f2bf(v[i].w * rstd * gg.w * (1.f + s4.w) + h4.w);
      *(ushort4*)(H + (size_t)row * DM + c0) = o;
    }
  }
}

using pg8::f32x4;
using pg8::u32x4;
using pg8::Unit;
using pg8::cvt_pk_bf16;
typedef short s16x4_t __attribute__((ext_vector_type(4)));
typedef unsigned u32x4_t __attribute__((ext_vector_type(4)));
typedef unsigned short u16x4_t __attribute__((ext_vector_type(4)));

__device__ __forceinline__ int in_srcmap(int d) {
  if (d < 2048) return d;
  if (d < 3072) return 3088 + (d - 2048);
  if (d < 3328) return 4112 + (d - 3072);
  if (d < 3840) return 4368 + (d - 3328);
  if (d < 3904) return 4880 + (d - 3840);
  if (d < 3912) return 4944 + (d - 3904);
  if (d < 3928) return 3072 + (d - 3912);
  if (d < 4096) return -1;
  if (d < 5120) return 2048 + (d - 4096);
  return 4952 + (d - 5120);
}
template <bool MAP>
__device__ __forceinline__ void transpose_item(const float* W, int ldw, int K, bf16* WT, int item, int nblk, float* scr, int lane) {
  const int kb = item / nblk, nbk = item % nblk, k0 = 64 * kb, n0 = 32 * nbk;
  const int d = n0 + (lane & 31);
  const int src = MAP ? in_srcmap(d) : d;
#pragma unroll 8
  for (int i = 0; i < 32; ++i) {
    const int kk = 2 * i + (lane >> 5);
    scr[kk * 33 + (lane & 31)] = (src >= 0) ? W[(size_t)(k0 + kk) * ldw + src] : 0.f;
  }
  asm volatile("s_waitcnt lgkmcnt(0)" ::: "memory");
  const int c = lane & 7;
#pragma unroll
  for (int j = 0; j < 4; ++j) {
    const int n = (lane >> 3) + 8 * j;
    const float* s = scr + (8 * c) * 33 + n;
    uint4 o;
    o.x = pk2(s[0 * 33], s[1 * 33]); o.y = pk2(s[2 * 33], s[3 * 33]); o.z = pk2(s[4 * 33], s[5 * 33]); o.w = pk2(s[6 * 33], s[7 * 33]);
    *(uint4*)(WT + (size_t)(n0 + n) * K + k0 + 8 * c) = o;
  }
  asm volatile("s_waitcnt lgkmcnt(0)" ::: "memory");
}

__device__ void ph_prep(const P& p, float* sm) {
  const int tid = tid_fresh(), wave = tid >> 6, lane = tid & 63;
  const int bid = blockIdx.x, nb = gridDim.x;
  float* silc = sm + 8 * 2112 + 64;
  float* red = silc + 8192;
  float* ada = (float*)(p.ws + OFF_ADA);
  if (bid < 192) {
    for (int i = tid; i < 8192; i += 512) silc[i] = siluf_(p.c[i]);
    __syncthreads();
    for (int it = bid; it < 192; it += nb) {
      const int kg = tid >> 5, cn = tid & 31, n = it * 32 + cn;
      float acc[8];
#pragma unroll
      for (int b = 0; b < 8; ++b) acc[b] = 0.f;
      for (int k = kg * 64; k < kg * 64 + 64; ++k) {
        const float w = p.w_ada[(size_t)k * 6144 + n];
#pragma unroll
        for (int b = 0; b < 8; ++b) acc[b] += silc[b * 1024 + k] * w;
      }
#pragma unroll
      for (int b = 0; b < 8; ++b) red[(kg * 8 + b) * 32 + cn] = acc[b];
      __syncthreads();
      if (tid < 256) {
        const int b = tid >> 5, c2 = tid & 31;
        float s = 0.f;
#pragma unroll
        for (int g = 0; g < 16; ++g) s += red[(g * 8 + b) * 32 + c2];
        ada[b * 6144 + it * 32 + c2] = s + p.b_ada[it * 32 + c2];
      }
      __syncthreads();
    }
  }
  {
    unsigned char* PU8 = (unsigned char*)(p.ws + OFF_PU);
    unsigned char* PV8 = (unsigned char*)(p.ws + OFF_PV);
    float* PSC = (float*)(p.ws + OFF_PSC);
    for (int row = bid * 8 + wave; row < 2 * 16384; row += nb * 8) {
      const float* src = (row < 16384 ? p.peer_u : p.peer_v) + (size_t)(row & 16383) * 1024 + lane * 16;
      f32x4 v[4];
      float mx = 0.f;
#pragma unroll
      for (int q = 0; q < 4; ++q) {
        v[q] = *(const f32x4*)(src + q * 4);
        mx = fmaxf(mx, fmaxf(fmaxf(fabsf(v[q][0]), fabsf(v[q][1])), fmaxf(fabsf(v[q][2]), fabsf(v[q][3]))));
      }
      mx = wave_max(mx);
      const float sc = (mx > 0.f) ? exp2f(floorf(log2f(448.f / mx))) : 1.f;
      u32x4 o;
#pragma unroll
      for (int q = 0; q < 4; ++q) {
        int w = __builtin_amdgcn_cvt_pk_fp8_f32(v[q][0] * sc, v[q][1] * sc, 0, false);
        w = __builtin_amdgcn_cvt_pk_fp8_f32(v[q][2] * sc, v[q][3] * sc, w, true);
        o[q] = (unsigned)w;
      }
      *(u32x4*)((row < 16384 ? PU8 : PV8) + (size_t)(row & 16383) * 1024 + lane * 16) = o;
      if (lane == 0) PSC[row] = 1.f / sc;
    }
    for (int i = bid * 512 + tid; i < 2 * 2048; i += nb * 512) {
      const float* src = (i < 2048) ? p.sk1 : p.sk2;
      const int j = i & 2047;
      const float4 v0 = *(const float4*)(src + j * 8), v1 = *(const float4*)(src + j * 8 + 4);
      uint4 o; o.x = pk2(v0.x, v0.y); o.y = pk2(v0.z, v0.w); o.z = pk2(v1.x, v1.y); o.w = pk2(v1.z, v1.w);
      *(uint4*)((bf16*)(p.ws + OFF_SK) + (size_t)i * 8) = o;
    }
  }
  {
    bf16* WUK = (bf16*)(p.ws + OFF_WUK);
    bf16* WUV = (bf16*)(p.ws + OFF_WUV);
    for (int i = bid * 512 + tid; i < 2 * 262144; i += nb * 512) {
      if (i < 262144) {
        const int d = i & 127, cc = (i >> 7) & 255, h = i >> 15;
        WUK[i] = f2bf(p.w_uk[((size_t)h * 128 + d) * 256 + cc] * p.kv_norm_g[cc] * 0.08838834764831845f);
      } else {
        const int k = i - 262144;
        const int cc = k & 255, d = (k >> 8) & 127, h = k >> 15;
        WUV[k] = f2bf(p.w_uv[((size_t)h * 256 + cc) * 128 + d] * p.kv_norm_g[cc]);
      }
    }
  }
  float* scr = sm + wave * 2112;
  const int gw = bid * 8 + wave, ngw = nb * 8;
  constexpr int I_IN = 16 * 224, I_SQ = 16 * 32, I_Q = 16 * 64;
  for (int it = gw; it < I_IN + 3 * I_SQ + I_Q; it += ngw) {
    int r = it;
    if (r < I_IN) { transpose_item<true>(p.w_in, NIN, 1024, (bf16*)(p.ws + OFF_WT_IN), r, 224, scr, lane); continue; }
    r -= I_IN;
    if (r < I_SQ) { transpose_item<false>(p.w_a, 1024, 1024, (bf16*)(p.ws + OFF_WT_A), r, 32, scr, lane); continue; }
    r -= I_SQ;
    if (r < I_SQ) { transpose_item<false>(p.w_b, 1024, 1024, (bf16*)(p.ws + OFF_WT_B), r, 32, scr, lane); continue; }
    r -= I_SQ;
    if (r < I_SQ) { transpose_item<false>(p.w_out, 1024, 1024, (bf16*)(p.ws + OFF_WT_OUT), r, 32, scr, lane); continue; }
    r -= I_SQ;
    transpose_item<false>(p.w_q, 2048, 1024, (bf16*)(p.ws + OFF_WT_Q), r, 64, scr, lane);
  }
}


struct EpiIn {
  static constexpr bool PERM = true, AFTER_DRAIN = false;
  char* ws; float* out;
  __device__ __forceinline__ void operator()(const f32x4 (&acc)[2][2][4][2], const Unit& u, int wr, int wc, int fr, int fq) const {
    const int pn = u.pn;
    const int row0 = u.pm * 256 + wr * 64 + fr, cl0 = wc * 32 + 8 * fq;
    if (pn == 12) {
      bf16* dst = (bf16*)(ws + OFF_CKV);
      float* ssp = (float*)(ws + OFF_SSP);
#pragma unroll
      for (int ai = 0; ai < 2; ++ai)
#pragma unroll
        for (int m = 0; m < 4; ++m) {
          const size_t row = row0 + ai * 128 + m * 16;
          float ss = 0.f;
#pragma unroll
          for (int bj = 0; bj < 2; ++bj) {
            const f32x4 v0 = acc[ai][bj][m][0], v1 = acc[ai][bj][m][1];
            ss += (v0[0] * v0[0] + v0[1] * v0[1]) + (v0[2] * v0[2] + v0[3] * v0[3]) + (v1[0] * v1[0] + v1[1] * v1[1]) + (v1[2] * v1[2] + v1[3] * v1[3]);
            u32x4 w; w.x = cvt_pk_bf16(v0[0], v0[1]); w.y = cvt_pk_bf16(v0[2], v0[3]); w.z = cvt_pk_bf16(v1[0], v1[1]); w.w = cvt_pk_bf16(v1[2], v1[3]);
            *(u32x4*)(dst + row * 256 + cl0 + bj * 128) = w;
          }
          ss += __shfl_xor(ss, 16); ss += __shfl_xor(ss, 32);
          if (fq == 0) ssp[row * 4 + wc] = ss;
        }
    } else if (pn == 15) {
      bf16* IK = (bf16*)(ws + OFF_IK);
      float* IW = (float*)(ws + OFF_IW);
      float* GLOW = (float*)(ws + OFF_GLOW);
#pragma unroll
      for (int ai = 0; ai < 2; ++ai)
#pragma unroll
        for (int m = 0; m < 4; ++m) {
          const size_t row = row0 + ai * 128 + m * 16;
          const int cl = cl0;
          const f32x4 v0 = acc[ai][0][m][0], v1 = acc[ai][0][m][1];
          if (cl < 64) {
            u32x4 w; w.x = cvt_pk_bf16(v0[0], v0[1]); w.y = cvt_pk_bf16(v0[2], v0[3]); w.z = cvt_pk_bf16(v1[0], v1[1]); w.w = cvt_pk_bf16(v1[2], v1[3]);
            *(u32x4*)(IK + row * 64 + cl) = w;
          } else if (cl < 72) {
            *(f32x4*)(IW + row * 8) = v0 * 0.35355339059327373f;
            *(f32x4*)(IW + row * 8 + 4) = v1 * 0.35355339059327373f;
          } else if (cl < 88) {
            *(f32x4*)(GLOW + row * 16 + (cl - 72)) = v0;
            *(f32x4*)(GLOW + row * 16 + (cl - 72) + 4) = v1;
          }
        }
    } else {
      bf16* dst; int ld; float scale = 1.f; int act = 0; int coff;
      if (pn < 2) { dst = (bf16*)(ws + OFF_Q); ld = 512; coff = pn * 256; scale = 0.08838834764831845f; }
      else if (pn < 4) { dst = (bf16*)(ws + OFF_K); ld = 512; coff = (pn - 2) * 256; }
      else if (pn < 8) { dst = (bf16*)(ws + OFF_V); ld = 1024; coff = (pn - 4) * 256; }
      else if (pn < 12) { dst = (bf16*)(ws + OFF_DQ); ld = 1024; coff = (pn - 8) * 256; }
      else if (pn < 15) { dst = (bf16*)(ws + OFF_IQ); ld = 512; coff = (pn - 13) * 256; scale = 0.125f; }
      else if (pn < 20) { dst = (bf16*)(ws + OFF_SGR); ld = 1024; coff = (pn - 16) * 256; act = 1; }
      else if (pn < 24) { dst = (bf16*)out; ld = 1024; coff = (pn - 20) * 256; act = 2; }
      else { dst = (bf16*)out + (size_t)TT * 1024; ld = 1024; coff = (pn - 24) * 256; act = 2; }
#pragma unroll
      for (int ai = 0; ai < 2; ++ai)
#pragma unroll
        for (int m = 0; m < 4; ++m) {
          bf16* rowp = dst + (size_t)(row0 + ai * 128 + m * 16) * ld + coff + cl0;
#pragma unroll
          for (int bj = 0; bj < 2; ++bj) {
            f32x4 v0 = acc[ai][bj][m][0] * scale, v1 = acc[ai][bj][m][1] * scale;
            if (act == 1) {
#pragma unroll
              for (int j = 0; j < 4; ++j) { v0[j] = siluf_(v0[j]); v1[j] = siluf_(v1[j]); }
            } else if (act == 2) {
#pragma unroll
              for (int j = 0; j < 4; ++j) { v0[j] = sigmoidf_(v0[j]); v1[j] = sigmoidf_(v1[j]); }
            }
            u32x4 w; w.x = cvt_pk_bf16(v0[0], v0[1]); w.y = cvt_pk_bf16(v0[2], v0[3]); w.z = cvt_pk_bf16(v1[0], v1[1]); w.w = cvt_pk_bf16(v1[2], v1[3]);
            *(u32x4*)(rowp + bj * 128) = w;
          }
        }
    }
  }
};

template <bool ADD> struct EpiMix {
  static constexpr bool PERM = true, AFTER_DRAIN = false;
  const bf16* SZ; bf16* MIX;
  __device__ __forceinline__ void operator()(const f32x4 (&acc)[2][2][4][2], const Unit& u, int wr, int wc, int fr, int fq) const {
    const int row0 = u.pm * 256 + wr * 64 + fr, col0 = u.pn * 256 + wc * 32 + 8 * fq;
#pragma unroll
    for (int ai = 0; ai < 2; ++ai)
#pragma unroll
      for (int m = 0; m < 4; ++m)
#pragma unroll
        for (int bj = 0; bj < 2; ++bj) {
          const size_t idx = (size_t)(row0 + ai * 128 + m * 16) * 1024 + col0 + bj * 128;
          const u32x4 s = *(const u32x4*)(SZ + idx);
          f32x4 v0 = acc[ai][bj][m][0], v1 = acc[ai][bj][m][1];
          v0[0] *= bflo(s.x); v0[1] *= bfhi(s.x); v0[2] *= bflo(s.y); v0[3] *= bfhi(s.y);
          v1[0] *= bflo(s.z); v1[1] *= bfhi(s.z); v1[2] *= bflo(s.w); v1[3] *= bfhi(s.w);
          if (ADD) {
            const u32x4 o = *(const u32x4*)(MIX + idx);
            v0[0] += bflo(o.x); v0[1] += bfhi(o.x); v0[2] += bflo(o.y); v0[3] += bfhi(o.y);
            v1[0] += bflo(o.z); v1[1] += bfhi(o.z); v1[2] += bflo(o.w); v1[3] += bfhi(o.w);
          }
          u32x4 w; w.x = cvt_pk_bf16(v0[0], v0[1]); w.y = cvt_pk_bf16(v0[2], v0[3]); w.z = cvt_pk_bf16(v1[0], v1[1]); w.w = cvt_pk_bf16(v1[2], v1[3]);
          *(u32x4*)(MIX + idx) = w;
        }
  }
};

struct EpiX1 {
  static constexpr bool PERM = true, AFTER_DRAIN = false;
  const float* x; const float* ada; float* out;
  __device__ __forceinline__ void operator()(const f32x4 (&acc)[2][2][4][2], const Unit& u, int wr, int wc, int fr, int fq) const {
    const int row0 = u.pm * 256 + wr * 64 + fr, col0 = u.pn * 256 + wc * 32 + 8 * fq;
    const int b = (u.pm * 256) >> 12;
    f32x4 g[2][2];
#pragma unroll
    for (int bj = 0; bj < 2; ++bj) {
      g[bj][0] = *(const f32x4*)(ada + b * 6144 + 2048 + col0 + bj * 128);
      g[bj][1] = *(const f32x4*)(ada + b * 6144 + 2048 + col0 + bj * 128 + 4);
    }
#pragma unroll
    for (int ai = 0; ai < 2; ++ai)
#pragma unroll
      for (int m = 0; m < 4; ++m)
#pragma unroll
        for (int bj = 0; bj < 2; ++bj) {
          const size_t idx = (size_t)(row0 + ai * 128 + m * 16) * 1024 + col0 + bj * 128;
          const f32x4 x0 = *(const f32x4*)(x + idx), x1 = *(const f32x4*)(x + idx + 4);
          *(f32x4*)(out + idx) = x0 + g[bj][0] * acc[ai][bj][m][0];
          *(f32x4*)(out + idx + 4) = x1 + g[bj][1] * acc[ai][bj][m][1];
        }
  }
};

struct EpiPlain {
  static constexpr bool PERM = true, AFTER_DRAIN = false;
  bf16* O; int ld;
  __device__ __forceinline__ void operator()(const f32x4 (&acc)[2][2][4][2], const Unit& u, int wr, int wc, int fr, int fq) const {
    const int row0 = u.pm * 256 + wr * 64 + fr, col0 = u.pn * 256 + wc * 32 + 8 * fq;
#pragma unroll
    for (int ai = 0; ai < 2; ++ai)
#pragma unroll
      for (int m = 0; m < 4; ++m)
#pragma unroll
        for (int bj = 0; bj < 2; ++bj) {
          const f32x4 v0 = acc[ai][bj][m][0], v1 = acc[ai][bj][m][1];
          u32x4 w; w.x = cvt_pk_bf16(v0[0], v0[1]); w.y = cvt_pk_bf16(v0[2], v0[3]); w.z = cvt_pk_bf16(v1[0], v1[1]); w.w = cvt_pk_bf16(v1[2], v1[3]);
          *(u32x4*)(O + (size_t)(row0 + ai * 128 + m * 16) * ld + col0 + bj * 128) = w;
        }
  }
};

template <class Epi>
__device__ __forceinline__ void gemm_run(LAS unsigned char* lds, const bf16* A, const bf16* Bt, int M, int N, int K, const Epi& E) {
  pg8::Gemm g{A, Bt, M, N, K};
  pg8::StaticOrder S;
  S.init(M, N, gridDim.x, blockIdx.x);
  pg8::gemm_phase<Epi, pg8::StaticOrder, false>(lds, g, S, E, nullptr);
}

typedef short bf16x8_t __attribute__((ext_vector_type(8)));
typedef __bf16 bf16x2_t __attribute__((ext_vector_type(2)));
__device__ __forceinline__ float dot2bf(unsigned a, unsigned b, float acc) {
  return __builtin_amdgcn_fdot2_f32_bf16(__builtin_bit_cast(bf16x2_t, a), __builtin_bit_cast(bf16x2_t, b), acc, false);
}
__device__ __forceinline__ void wave_lds_fence() { asm volatile("s_waitcnt lgkmcnt(0)" ::: "memory"); }
template <int N> __device__ __forceinline__ float row_ror(float x) {
  return __int_as_float(__builtin_amdgcn_update_dpp(0, __float_as_int(x), 0x120 + N, 0xf, 0xf, false));
}
__device__ __forceinline__ float row16_max(float m) {
  m = fmaxf(m, row_ror<8>(m)); m = fmaxf(m, row_ror<4>(m)); m = fmaxf(m, row_ror<2>(m)); m = fmaxf(m, row_ror<1>(m));
  return m;
}
__device__ __forceinline__ float row16_sum(float m) {
  m += row_ror<8>(m); m += row_ror<4>(m); m += row_ror<2>(m); m += row_ror<1>(m);
  return m;
}
__device__ __forceinline__ float wave_sum_dpp(float s) {
  s = row16_sum(s);
  const int si = __float_as_int(s);
  return __int_as_float(__builtin_amdgcn_readlane(si, 0)) + __int_as_float(__builtin_amdgcn_readlane(si, 16)) +
         (__int_as_float(__builtin_amdgcn_readlane(si, 32)) + __int_as_float(__builtin_amdgcn_readlane(si, 48)));
}
__device__ __forceinline__ constexpr int cand_i(int L) {
  return L < 16 ? 0 : L < 24 ? 1 : L < 29 ? 2 : L < 33 ? 3 : L < 36 ? 4 : L < 38 ? 5 : L < 40 ? 6 : L < 42 ? 7 : (L - 42 + 8);
}
__device__ __forceinline__ constexpr int cand_j(int L) {
  return L < 16 ? L : L < 24 ? L - 16 : L < 29 ? L - 24 : L < 33 ? L - 29 : L < 36 ? L - 33 : L < 38 ? L - 36 : L < 40 ? L - 38 : L < 42 ? L - 40 : 0;
}
template <int K> struct CandRank {
  static __device__ __forceinline__ void run(int vi, float val, int myflat, int& rank) {
    const float o = __int_as_float(__builtin_amdgcn_readlane(vi, K));
    constexpr int fk = cand_i(K) * 16 + cand_j(K);
    rank += ((o > val) || (o == val && fk < myflat)) ? 1 : 0;
    CandRank<K + 1>::run(vi, val, myflat, rank);
  }
};
template <> struct CandRank<50> { static __device__ __forceinline__ void run(int, float, int, int&) {} };

__device__ __forceinline__ float gelu_exact(float v) { return 0.5f * v * (1.f + erff(v * 0.7071067811865476f)); }

typedef float f32x2_t __attribute__((ext_vector_type(2)));
#define PEER_LOAD(buf, TAB, e0)                                                                   \
  _Pragma("unroll") for (int j = 0; j < 8; ++j) {                                                 \
    const int e = __builtin_amdgcn_readfirstlane((int)ridx[tt * 128 + (e0) + j]);                 \
    buf[j] = *(const u32x4_t*)((TAB) + (size_t)e * 1024 + lane * 16);                             \
  }
#define PEER_UDOT(buf, e0)                                                                        \
  _Pragma("unroll") for (int j = 0; j < 8; ++j) {                                                 \
    float s0 = 0.f, s1 = 0.f;                                                                     \
    _Pragma("unroll") for (int w = 0; w < 4; ++w) {                                               \
      const f32x2_t lo = __builtin_amdgcn_cvt_pk_f32_fp8((int)buf[j][w], false);                  \
      const f32x2_t hi = __builtin_amdgcn_cvt_pk_f32_fp8((int)buf[j][w], true);                   \
      s0 += lo.x * hf[4 * w] + hi.x * hf[4 * w + 2];                                              \
      s1 += lo.y * hf[4 * w + 1] + hi.y * hf[4 * w + 3];                                          \
    }                                                                                             \
    const float s = wave_sum_dpp(s0 + s1);                                                        \
    const int ee = (e0) + j;                                                                      \
    if (ee < 64) dotA = (lane == ee) ? s : dotA; else dotB = (lane == ee - 64) ? s : dotB;        \
  }
#define PEER_VACC(buf, e0)                                                                        \
  _Pragma("unroll") for (int j = 0; j < 8; ++j) {                                                 \
    const int ee = (e0) + j;                                                                      \
    const float a = __int_as_float(__builtin_amdgcn_readlane(__float_as_int(ee < 64 ? aA : aB), ee & 63)); \
    _Pragma("unroll") for (int w = 0; w < 4; ++w) {                                               \
      const f32x2_t lo = __builtin_amdgcn_cvt_pk_f32_fp8((int)buf[j][w], false);                  \
      const f32x2_t hi = __builtin_amdgcn_cvt_pk_f32_fp8((int)buf[j][w], true);                   \
      acc[4 * w] += a * lo.x; acc[4 * w + 1] += a * lo.y; acc[4 * w + 2] += a * hi.x; acc[4 * w + 3] += a * hi.y; \
    }                                                                                             \
  }

__device__ void ph_peer512(const P& p, unsigned char* lds_raw, float* dst_base) {
  const int tid = tid_fresh(), wave = tid >> 6, lane = tid & 63, g = lane >> 4, c = lane & 15;
  const bf16* H2 = (const bf16*)(p.ws + OFF_H);
  const bf16* PQ = (const bf16*)(p.ws + OFF_PQ);
  const bf16* SK = (const bf16*)(p.ws + OFF_SK);
  const unsigned char* PU = (const unsigned char*)(p.ws + OFF_PU);
  const unsigned char* PV = (const unsigned char*)(p.ws + OFF_PV);
  const float* USC = (const float*)(p.ws + OFF_PSC);
  const float* VSC = USC + 16384;
  const float* ada = (const float*)(p.ws + OFF_ADA);
  float* tv = (float*)(lds_raw + wave * 16384);
  int* ti = (int*)(tv + 512);
  float* rgate = (float*)(ti + 512);
  unsigned short* ridx = (unsigned short*)(rgate + 2048);
  for (int tile = blockIdx.x * 8 + wave; tile < TT / 16; tile += gridDim.x * 8) {
    const int tok0 = tile * 16;
    unsigned long long pts0 = TS_NOW();
#pragma unroll 1
    for (int hd = 0; hd < 8; ++hd) {
#pragma unroll 1
      for (int hf = 0; hf < 2; ++hf) {
        f32x4 acc[8];
#pragma unroll
        for (int nt = 0; nt < 8; ++nt) acc[nt] = (f32x4){0.f, 0.f, 0.f, 0.f};
#pragma unroll
        for (int ks = 0; ks < 4; ++ks) {
          const bf16x8_t a = *(const bf16x8_t*)(PQ + (size_t)(tok0 + c) * 2048 + hd * 256 + hf * 128 + ks * 32 + 8 * g);
#pragma unroll
          for (int nt = 0; nt < 8; ++nt) {
            const bf16x8_t b = *(const bf16x8_t*)(SK + hf * 16384 + (nt * 16 + c) * 128 + ks * 32 + 8 * g);
            acc[nt] = __builtin_amdgcn_mfma_f32_16x16x32_bf16(a, b, acc[nt], 0, 0, 0);
          }
        }
#pragma unroll
        for (int i = 0; i < 4; ++i) {
          float v[8];
#pragma unroll
          for (int nt = 0; nt < 8; ++nt) v[nt] = acc[nt][i];
          const int row = 4 * g + i;
#pragma unroll 1
          for (int r = 0; r < 16; ++r) {
            const float m = fmaxf(fmaxf(fmaxf(v[0], v[1]), fmaxf(v[2], v[3])), fmaxf(fmaxf(v[4], v[5]), fmaxf(v[6], v[7])));
            const float gm = row16_max(m);
            const unsigned long long bal = __ballot(m == gm);
            const unsigned gb = (unsigned)(bal >> (16 * g)) & 0xffffu;
            const bool win = (c == (__ffs(gb) - 1));
            int sel = -1;
#pragma unroll
            for (int nt = 0; nt < 8; ++nt) {
              const bool hit = win && (sel < 0) && (v[nt] == gm);
              sel = hit ? nt : sel;
              v[nt] = hit ? -INFINITY : v[nt];
            }
            if (win) { tv[(hf * 16 + row) * 16 + r] = gm; ti[(hf * 16 + row) * 16 + r] = sel * 16 + c; }
          }
        }
      }
      wave_lds_fence();
      const int ci = cand_i(lane < 50 ? lane : 0), cj = cand_j(lane < 50 ? lane : 0);
      const int myflat = ci * 16 + cj;
#pragma unroll 1
      for (int row = 0; row < 16; ++row) {
        const float val = (lane < 50) ? (tv[row * 16 + ci] + tv[(16 + row) * 16 + cj]) : -INFINITY;
        int rank = 0;
        CandRank<0>::run(__float_as_int(val), val, myflat, rank);
        if (lane < 50 && rank < 16) {
          rgate[row * 128 + hd * 16 + rank] = val;
          ridx[row * 128 + hd * 16 + rank] = (unsigned short)(ti[row * 16 + ci] * 128 + ti[(16 + row) * 16 + cj]);
        }
      }
      wave_lds_fence();
      {
        const int row = lane >> 2, q = lane & 3;
        float* gp = rgate + row * 128 + hd * 16;
        const float mx = gp[0];
        const f32x4 b4 = *(const f32x4*)(gp + q * 4);
        f32x4 e4;
        e4[0] = __expf(b4[0] - mx); e4[1] = __expf(b4[1] - mx); e4[2] = __expf(b4[2] - mx); e4[3] = __expf(b4[3] - mx);
        float s = (e4[0] + e4[1]) + (e4[2] + e4[3]);
        s += __shfl_xor(s, 1); s += __shfl_xor(s, 2);
        const float inv = 1.f / s;
        wave_lds_fence();
        *(f32x4*)(gp + q * 4) = e4 * inv;
      }
      wave_lds_fence();
    }
    if (blockIdx.x == 0) { TS_ADD(p, 40, pts0); } pts0 = TS_NOW();
#pragma unroll 1
    for (int tt = 0; tt < 16; ++tt) {
      const int lane = tid_fresh() & 63;
      const size_t tok = (size_t)tok0 + tt;
      float hf[16];
      {
        const u32x4_t h0 = *(const u32x4_t*)(H2 + tok * 1024 + lane * 16), h1 = *(const u32x4_t*)(H2 + tok * 1024 + lane * 16 + 8);
#pragma unroll
        for (int w = 0; w < 4; ++w) { hf[2 * w] = bflo(h0[w]); hf[2 * w + 1] = bfhi(h0[w]); hf[8 + 2 * w] = bflo(h1[w]); hf[8 + 2 * w + 1] = bfhi(h1[w]); }
      }
      const int eA = (int)ridx[tt * 128 + lane], eB = (int)ridx[tt * 128 + 64 + lane];
      const float usA = USC[eA], usB = USC[eB], vsA = VSC[eA], vsB = VSC[eB];
      float dotA = 0.f, dotB = 0.f;
      u32x4_t a0[8], a1[8];
      PEER_LOAD(a0, PU, 0);
#pragma unroll 1
      for (int e0 = 0; e0 < 128; e0 += 16) {
        PEER_LOAD(a1, PU, e0 + 8);
        PEER_UDOT(a0, e0);
        if (e0 + 16 < 128) { PEER_LOAD(a0, PU, e0 + 16); }
        else { PEER_LOAD(a0, PV, 0); }
        PEER_UDOT(a1, e0 + 8);
      }
      const float aA = gelu_exact(dotA * usA) * rgate[tt * 128 + lane] * vsA, aB = gelu_exact(dotB * usB) * rgate[tt * 128 + 64 + lane] * vsB;
      float acc[16];
#pragma unroll
      for (int k = 0; k < 16; ++k) acc[k] = 0.f;
#pragma unroll 1
      for (int e0 = 0; e0 < 128; e0 += 16) {
        PEER_LOAD(a1, PV, e0 + 8);
        PEER_VACC(a0, e0);
        if (e0 + 16 < 128) { PEER_LOAD(a0, PV, e0 + 16); }
        PEER_VACC(a1, e0 + 8);
      }
      const int b = (int)(tok >> 12);
      const float* xrow = p.out + tok * 1024;
      float* orow = dst_base + tok * 1024;
      const float* g2 = ada + b * 6144 + 5120;
      float x2[16];
      float ss = 0.f;
#pragma unroll
      for (int q = 0; q < 4; ++q) {
        const int col = lane * 16 + q * 4;
        const f32x4 xv = *(const f32x4*)(xrow + col), gv = *(const f32x4*)(g2 + col);
#pragma unroll
        for (int k = 0; k < 4; ++k) { const float t = xv[k] + gv[k] * acc[q * 4 + k]; x2[q * 4 + k] = t; ss += t * t; }
      }
      ss = wave_sum_dpp(ss);
      const float rstd = rsqrtf(ss * (1.f / 1024.f) + 1e-6f);
#pragma unroll
      for (int q = 0; q < 4; ++q) {
        const int col = lane * 16 + q * 4;
        const f32x4 fg = *(const f32x4*)(p.final_g + col);
        f32x4 o;
#pragma unroll
        for (int k = 0; k < 4; ++k) o[k] = x2[q * 4 + k] * rstd * fg[k];
        *(f32x4*)(orow + col) = o;
      }
    }
    if (blockIdx.x == 0) { TS_ADD(p, 41, pts0); }
    wave_lds_fence();
  }
}

#define DS_KEY16   0
#define DS_CHUNK   17408
#define DS_SEL     139264
#define DS_WAVE    147456
#define DS_TOTAL   155648
#define DS_RS      544

__device__ __forceinline__ unsigned f2ord(float f) {
  if (f == 0.f) f = 0.f;
  unsigned u = __float_as_uint(f);
  return (u & 0x80000000u) ? ~u : (u | 0x80000000u);
}
__device__ __forceinline__ int wave_scan_incl(int v, int lane) {
#pragma unroll
  for (int o = 1; o < 64; o <<= 1) { const int t = __shfl_up(v, o); v += (lane >= o) ? t : 0; }
  return v;
}
__device__ __forceinline__ void find_digit(const LAS unsigned* hist, int K, int lane, int& digit, int& above) {
  const u32x4_t h4 = *(const LAS u32x4_t*)(hist + 252 - 4 * lane);
  const int c0 = (int)h4.w, c1 = (int)h4.z, c2 = (int)h4.y, c3 = (int)h4.x;
  const int tot = c0 + c1 + c2 + c3;
  int run = wave_scan_incl(tot, lane) - tot;
  int found = -1, ab = 0;
  if (run < K && run + c0 >= K) { found = 255 - 4 * lane; ab = run; } run += c0;
  if (run < K && run + c1 >= K) { found = 254 - 4 * lane; ab = run; } run += c1;
  if (run < K && run + c2 >= K) { found = 253 - 4 * lane; ab = run; } run += c2;
  if (run < K && run + c3 >= K) { found = 252 - 4 * lane; ab = run; }
  const unsigned long long mk = __ballot(found >= 0);
  const int src = (int)__ffsll((unsigned long long)mk) - 1;
  digit = __builtin_amdgcn_readlane(found, src);
  above = __builtin_amdgcn_readlane(ab, src);
}

__device__ __forceinline__ s16x4_t tr_read_b64(unsigned addr) {
  s16x4_t r; asm volatile("ds_read_b64_tr_b16 %0, %1" : "=&v"(r) : "v"(addr) : "memory"); return r;
}

__device__ void dsa_batch(const P& p, unsigned char* lds_raw, int b, int pos) {
  const int t0 = pos * 16;
#define DSA_IDS const int tid = tid_fresh(), wave = __builtin_amdgcn_readfirstlane(tid >> 6), lane = tid & 63, g = lane >> 4, c = lane & 15; (void)wave; (void)g; (void)c;
  const size_t tokb = (size_t)b * SEQ, tok0 = tokb + t0;
  const bf16* DQ = (const bf16*)(p.ws + OFF_DQ);
  const bf16* CKV = (const bf16*)(p.ws + OFF_CKV);
  const float* SSP = (const float*)(p.ws + OFF_SSP);
  const bf16* IQ = (const bf16*)(p.ws + OFF_IQ);
  const bf16* IK = (const bf16*)(p.ws + OFF_IK);
  const float* IW = (const float*)(p.ws + OFF_IW);
  const bf16* WUK = (const bf16*)(p.ws + OFF_WUK);
  const bf16* WUV = (const bf16*)(p.ws + OFF_WUV);
  bf16* ODSA = (bf16*)(p.ws + OFF_ODSA);
  bf16* QL = (bf16*)(p.ws + OFF_DSCR + (size_t)blockIdx.x * 131072);
  bf16* OL = QL + 32768;
  LAS unsigned char* lds = (LAS unsigned char*)lds_raw;
  LAS unsigned short* key16 = (LAS unsigned short*)(lds + DS_KEY16);
  LAS unsigned short* sel = (LAS unsigned short*)(lds + DS_SEL);

  const bool tsb = (blockIdx.x == 40);
  unsigned long long ts0 = TS_NOW();
  {
    DSA_IDS
    const int h = wave;
    bf16x8_t dqf[4];
#pragma unroll
    for (int ks = 0; ks < 4; ++ks) dqf[ks] = *(const bf16x8_t*)(DQ + (tok0 + c) * 1024 + h * 128 + ks * 32 + 8 * g);
#pragma unroll 4
    for (int nt = 0; nt < 16; ++nt) {
      f32x4 a = (f32x4){0.f, 0.f, 0.f, 0.f};
#pragma unroll
      for (int ks = 0; ks < 4; ++ks) {
        const bf16x8_t wf = *(const bf16x8_t*)(WUK + (size_t)(h * 256 + nt * 16 + c) * 128 + ks * 32 + 8 * g);
        a = __builtin_amdgcn_mfma_f32_16x16x32_bf16(wf, dqf[ks], a, 0, 0, 0);
      }
      uint2 o; o.x = pk2(a[0], a[1]); o.y = pk2(a[2], a[3]);
      *(uint2*)(QL + c * 2048 + h * 256 + nt * 16 + 4 * g) = o;
    }
  }
  if (tsb) { TS_ADD(p, 30, ts0); } ts0 = TS_NOW();
  if (t0 >= 256) {
    DSA_IDS
    bf16x8_t qf[8][2];
    float iw[8];
#pragma unroll
    for (int h = 0; h < 8; ++h) {
      qf[h][0] = *(const bf16x8_t*)(IQ + (tok0 + c) * 512 + h * 64 + 8 * g);
      qf[h][1] = *(const bf16x8_t*)(IQ + (tok0 + c) * 512 + h * 64 + 32 + 8 * g);
      iw[h] = IW[(tok0 + c) * 8 + h];
    }
    const int ntile = pos + 1;
    bf16x8_t k0n = (bf16x8_t){0, 0, 0, 0, 0, 0, 0, 0}, k1n = k0n;
    if (wave < ntile) { const bf16* kr = IK + (tokb + wave * 16 + c) * 64 + 8 * g; k0n = *(const bf16x8_t*)kr; k1n = *(const bf16x8_t*)(kr + 32); }
    for (int kt = wave; kt < ntile; kt += 8) {
      const bf16x8_t k0 = k0n, k1 = k1n;
      if (kt + 8 < ntile) { const bf16* kr = IK + (tokb + (kt + 8) * 16 + c) * 64 + 8 * g; k0n = *(const bf16x8_t*)kr; k1n = *(const bf16x8_t*)(kr + 32); }
      f32x4 sc = (f32x4){0.f, 0.f, 0.f, 0.f};
#pragma unroll
      for (int h = 0; h < 8; ++h) {
        f32x4 d = __builtin_amdgcn_mfma_f32_16x16x32_bf16(k0, qf[h][0], (f32x4){0.f, 0.f, 0.f, 0.f}, 0, 0, 0);
        d = __builtin_amdgcn_mfma_f32_16x16x32_bf16(k1, qf[h][1], d, 0, 0, 0);
#pragma unroll
        for (int i = 0; i < 4; ++i) sc[i] += iw[h] * fmaxf(d[i], 0.f);
      }
      u16x4_t o;
      const int sb = kt * 16 + 4 * g, tq = t0 + c;
      o.x = (sb + 0 <= tq) ? (unsigned short)(f2ord(sc[0]) >> 16) : (unsigned short)0;
      o.y = (sb + 1 <= tq) ? (unsigned short)(f2ord(sc[1]) >> 16) : (unsigned short)0;
      o.z = (sb + 2 <= tq) ? (unsigned short)(f2ord(sc[2]) >> 16) : (unsigned short)0;
      o.w = (sb + 3 <= tq) ? (unsigned short)(f2ord(sc[3]) >> 16) : (unsigned short)0;
      *(LAS u16x4_t*)(key16 + c * 4096 + sb) = o;
    }
  }
  __syncthreads();
  if (tsb) { TS_ADD(p, 31, ts0); } ts0 = TS_NOW();
#pragma unroll 1
  for (int qq = 0; qq < 2; ++qq) {
    DSA_IDS
    const int q = wave + 8 * qq, t = t0 + q;
    LAS unsigned short* selq = sel + q * 256;
    if (t < 256) {
      for (int j = lane; j < 256; j += 64) selq[j] = (unsigned short)((j <= t) ? j : 0);
    } else {
      const LAS unsigned short* kq = key16 + q * 4096;
      unsigned kk[8][8];
#pragma unroll
      for (int it = 0; it < 8; ++it) {
        const int s0 = 512 * it + 8 * lane;
        u32x4_t v = (u32x4_t){0u, 0u, 0u, 0u};
        if (s0 <= t) v = *(const LAS u32x4_t*)(kq + s0);
#pragma unroll
        for (int j = 0; j < 4; ++j) {
          kk[it][2 * j] = (s0 + 2 * j <= t) ? (v[j] & 0xffffu) : 0u;
          kk[it][2 * j + 1] = (s0 + 2 * j + 1 <= t) ? (v[j] >> 16) : 0u;
        }
      }
      unsigned B = 0u;
#pragma unroll 1
      for (int bit = 15; bit >= 0; --bit) {
        const unsigned cand = B | (1u << bit);
        int cnt = 0;
#pragma unroll
        for (int it = 0; it < 8; ++it)
#pragma unroll
          for (int j = 0; j < 8; ++j) cnt += (kk[it][j] >= cand) ? 1 : 0;
        const int tot = (int)wave_sum_dpp((float)cnt);
        if (tot >= 256) B = cand;
      }
      int cgt = 0;
#pragma unroll
      for (int it = 0; it < 8; ++it)
#pragma unroll
        for (int j = 0; j < 8; ++j) cgt += (kk[it][j] > B) ? 1 : 0;
      const int m = 256 - (int)wave_sum_dpp((float)cgt);
      int base = 0, eqbase = 0;
#pragma unroll
      for (int it = 0; it < 8; ++it) {
        if (512 * it <= t) {
          int ceq = 0;
#pragma unroll
          for (int j = 0; j < 8; ++j) ceq += (kk[it][j] == B) ? 1 : 0;
          const int eqi = wave_scan_incl(ceq, lane);
          int eqr = eqbase + eqi - ceq;
          unsigned tmask = 0u; int ct = 0;
#pragma unroll
          for (int j = 0; j < 8; ++j) {
            const bool eq = kk[it][j] == B;
            const bool take = (kk[it][j] > B) || (eq && eqr < m);
            eqr += eq ? 1 : 0;
            tmask |= take ? (1u << j) : 0u;
            ct += take ? 1 : 0;
          }
          const int pi = wave_scan_incl(ct, lane);
          int ps = base + pi - ct;
#pragma unroll
          for (int j = 0; j < 8; ++j) {
            if ((tmask >> j) & 1u) { if (ps < 256) selq[ps] = (unsigned short)(512 * it + 8 * lane + j); ++ps; }
          }
          base += __builtin_amdgcn_readlane(pi, 63);
          eqbase += __builtin_amdgcn_readlane(eqi, 63);
        }
      }
    }
  }
  __syncthreads();
  if (tsb) { TS_ADD(p, 32, ts0); } ts0 = TS_NOW();
  {
    DSA_IDS
    LAS unsigned char* buf = lds + DS_KEY16 + wave * DS_CHUNK;
    LAS float* kr = (LAS float*)(lds + DS_WAVE + wave * 1024);
    LAS float* kd = kr + 32;
    const unsigned bufaddr = (unsigned)(uintptr_t)buf;
    const unsigned vb = bufaddr + (unsigned)((4 * g + (c >> 2)) * DS_RS + 8 * (c & 3));
    const float slope = (c < 8) ? exp2f(-(float)(c + 1)) : 0.f;
#pragma unroll 1
    for (int qq = 0; qq < 2; ++qq) {
      const int q = wave + 8 * qq, t = t0 + q;
      const int nsel = (t + 1 < 256) ? (t + 1) : 256, nch = (nsel + 31) >> 5;
      const LAS unsigned short* selq = sel + q * 256;
      const bf16* qlp = QL + q * 2048 + (c & 7) * 256 + 8 * g;
      float mrun = -1e30f, lrun = 0.f;
      f32x4 o[16];
#pragma unroll
      for (int nt = 0; nt < 16; ++nt) o[nt] = (f32x4){0.f, 0.f, 0.f, 0.f};
      u32x4_t st[16];
      float st_r = 0.f, st_d = -1.f;
#define DSA_ISSUE(ch)                                                                                   \
      {                                                                                                 \
        _Pragma("unroll") for (int r = 0; r < 16; ++r) {                                                \
          const int j = (ch) * 32 + 2 * r + (lane >> 5);                                                \
          const int idx = (j < nsel) ? (int)selq[j] : 0;                                                \
          st[r] = *(const u32x4_t*)(CKV + (tokb + idx) * 256 + (lane & 31) * 8);                          \
        }                                                                                               \
        const int j2 = (ch) * 32 + (lane & 31);                                                         \
        const int idx2 = (j2 < nsel) ? (int)selq[j2] : 0;                                               \
        const float4 ss = *(const float4*)(SSP + (tokb + idx2) * 4);                                    \
        st_r = rsqrtf(((ss.x + ss.y) + (ss.z + ss.w)) * (1.f / 256.f) + 1e-6f);                         \
        st_d = (j2 < nsel) ? (float)(t - idx2) : -1.f;                                                  \
      }
      DSA_ISSUE(0);
#pragma unroll 1
      for (int ch = 0; ch < nch; ++ch) {
#pragma unroll
        for (int r = 0; r < 16; ++r) *(LAS u32x4_t*)(buf + (2 * r + (lane >> 5)) * DS_RS + (lane & 31) * 16) = st[r];
        if (lane < 32) { kr[lane] = st_r; kd[lane] = st_d; }
        wave_lds_fence();
        f32x4 s0 = (f32x4){0.f, 0.f, 0.f, 0.f}, s1 = (f32x4){0.f, 0.f, 0.f, 0.f};
#pragma unroll
        for (int ks = 0; ks < 8; ++ks) {
          const bf16x8_t a0 = *(const LAS bf16x8_t*)(buf + c * DS_RS + (ks * 32 + 8 * g) * 2);
          const bf16x8_t a1 = *(const LAS bf16x8_t*)(buf + (16 + c) * DS_RS + (ks * 32 + 8 * g) * 2);
          const bf16x8_t qfk = *(const bf16x8_t*)(qlp + ks * 32);
          s0 = __builtin_amdgcn_mfma_f32_16x16x32_bf16(a0, qfk, s0, 0, 0, 0);
          s1 = __builtin_amdgcn_mfma_f32_16x16x32_bf16(a1, qfk, s1, 0, 0, 0);
        }
        if (ch + 1 < nch) DSA_ISSUE(ch + 1);
        const f32x4 r0 = *(const LAS f32x4*)(kr + 4 * g), r1 = *(const LAS f32x4*)(kr + 16 + 4 * g);
        const f32x4 d0 = *(const LAS f32x4*)(kd + 4 * g), d1 = *(const LAS f32x4*)(kd + 16 + 4 * g);
        float x[8];
#pragma unroll
        for (int i = 0; i < 4; ++i) {
          x[i] = (d0[i] < 0.f) ? -1e30f : (s0[i] * r0[i] - slope * d0[i]);
          x[4 + i] = (d1[i] < 0.f) ? -1e30f : (s1[i] * r1[i] - slope * d1[i]);
        }
        float mx = fmaxf(fmaxf(fmaxf(x[0], x[1]), fmaxf(x[2], x[3])), fmaxf(fmaxf(x[4], x[5]), fmaxf(x[6], x[7])));
        mx = fmaxf(mx, __shfl_xor(mx, 16)); mx = fmaxf(mx, __shfl_xor(mx, 32));
        const float mn = fmaxf(mrun, mx);
        const float alpha = __expf(mrun - mn);
        mrun = mn;
        float pr[8], ps = 0.f;
#pragma unroll
        for (int i = 0; i < 8; ++i) { pr[i] = (x[i] <= -1e29f) ? 0.f : __expf(x[i] - mn); ps += pr[i]; }
        ps += __shfl_xor(ps, 16); ps += __shfl_xor(ps, 32);
        lrun = lrun * alpha + ps;
#pragma unroll
        for (int nt = 0; nt < 16; ++nt) o[nt] *= alpha;
        union { bf16x8_t v; unsigned u[4]; } pf;
        pf.u[0] = pk2(pr[0] * r0[0], pr[1] * r0[1]); pf.u[1] = pk2(pr[2] * r0[2], pr[3] * r0[3]);
        pf.u[2] = pk2(pr[4] * r1[0], pr[5] * r1[1]); pf.u[3] = pk2(pr[6] * r1[2], pr[7] * r1[3]);
#pragma unroll
        for (int nt = 0; nt < 16; nt += 4) {
          s16x4_t lo[4], hi[4];
#pragma unroll
          for (int u = 0; u < 4; ++u) { lo[u] = tr_read_b64(vb + (nt + u) * 32); hi[u] = tr_read_b64(vb + (nt + u) * 32 + 16 * DS_RS); }
          asm volatile("s_waitcnt lgkmcnt(0)" ::: "memory");
          __builtin_amdgcn_sched_barrier(0);
#pragma unroll
          for (int u = 0; u < 4; ++u) {
            const bf16x8_t af = (bf16x8_t){lo[u][0], lo[u][1], lo[u][2], lo[u][3], hi[u][0], hi[u][1], hi[u][2], hi[u][3]};
            o[nt + u] = __builtin_amdgcn_mfma_f32_16x16x32_bf16(af, pf.v, o[nt + u], 0, 0, 0);
          }
        }
        wave_lds_fence();
      }
#undef DSA_ISSUE
      if (c < 8) {
        const float inv = 1.f / lrun;
#pragma unroll
        for (int nt = 0; nt < 16; ++nt) {
          uint2 w; w.x = pk2(o[nt][0] * inv, o[nt][1] * inv); w.y = pk2(o[nt][2] * inv, o[nt][3] * inv);
          *(uint2*)(OL + q * 2048 + c * 256 + nt * 16 + 4 * g) = w;
        }
      }
    }
  }
  __syncthreads();
  if (tsb) { TS_ADD(p, 33, ts0); } ts0 = TS_NOW();
  {
    DSA_IDS
    const int h = wave;
    bf16x8_t of[8];
#pragma unroll
    for (int ks = 0; ks < 8; ++ks) of[ks] = *(const bf16x8_t*)(OL + c * 2048 + h * 256 + ks * 32 + 8 * g);
#pragma unroll 2
    for (int nt = 0; nt < 8; ++nt) {
      f32x4 a = (f32x4){0.f, 0.f, 0.f, 0.f};
#pragma unroll
      for (int ks = 0; ks < 8; ++ks) {
        const bf16x8_t wf = *(const bf16x8_t*)(WUV + (size_t)(h * 128 + nt * 16 + c) * 256 + ks * 32 + 8 * g);
        a = __builtin_amdgcn_mfma_f32_16x16x32_bf16(wf, of[ks], a, 0, 0, 0);
      }
      uint2 w; w.x = pk2(a[0], a[1]); w.y = pk2(a[2], a[3]);
      *(uint2*)(ODSA + (tok0 + c) * 1024 + h * 128 + nt * 16 + 4 * g) = w;
    }
  }
  __syncthreads();
  if (tsb) { TS_ADD(p, 34, ts0); TS_ADD(p, 35, TS_NOW() - 1ull); }
}

#undef DSA_IDS
__device__ void ph_dsa512(const P& p, unsigned char* lds_raw) {
  for (int it = blockIdx.x; it < TT / 16; it += gridDim.x) {
    const int k = it >> 8, j = it & 255;
    dsa_batch(p, lds_raw, k, (k & 1) ? 255 - j : j);
  }
}

#define GL_QD    0
#define GL_KI    18432
#define GL_KE    36864
#define GL_V     55296
#define GL_AT    90112
#define GL_GLOW  99328
#define GL_QT    103424
#define GL_DEC   105472
#define GL_SSQ   105984
#define GL_LB    108032
#define GL_TOTAL 140800

#define GLA_BAR() do { asm volatile("s_waitcnt lgkmcnt(0)" ::: "memory"); __builtin_amdgcn_s_barrier(); asm volatile("" ::: "memory"); } while (0)
__device__ void gla_item(const P& p, unsigned char* lds_raw, int item) {
  int tid = tid_fresh();
  const int b = item >> 2, h = item & 3;
  const size_t tokb = (size_t)b * SEQ;
  const bf16* Qg = (const bf16*)(p.ws + OFF_Q);
  const bf16* Kg = (const bf16*)(p.ws + OFF_K);
  bf16* Vg = (bf16*)(p.ws + OFF_V);
  const float* GLOWg = (const float*)(p.ws + OFF_GLOW);
  const bf16* SGR = (const bf16*)(p.ws + OFF_SGR);
  LAS unsigned char* lds = (LAS unsigned char*)lds_raw;
  const unsigned lds0 = (unsigned)(uintptr_t)lds;
  LAS float* QT = (LAS float*)(lds + GL_QT);
  LAS float* DEC = (LAS float*)(lds + GL_DEC);
  LAS float* SSQ = (LAS float*)(lds + GL_SSQ);
  float wg[16];
#pragma unroll
  for (int r = 0; r < 16; ++r) wg[r] = p.w_gate_up[r * 512 + h * 128 + (tid & 127)];
  const float bg = p.b_gate[h * 128 + (tid & 127)];
  const float gn0 = p.gla_norm_g[h * 256 + 32 * (tid >> 6) + (tid & 15)], gn1 = p.gla_norm_g[h * 256 + 32 * (tid >> 6) + 16 + (tid & 15)];
  u32x4_t rq[2], rk[2], rv[4], rg = (u32x4_t){0u, 0u, 0u, 0u};
#define GLA_LOAD(ch)                                                                                      \
  {                                                                                                       \
    const size_t tb = tokb + (size_t)(ch) * 64;                                                           \
    _Pragma("unroll") for (int i = 0; i < 2; ++i) {                                                       \
      const int id = tid + 512 * i, tk = id >> 4, part = id & 15;                                         \
      rq[i] = *(const u32x4_t*)(Qg + (tb + tk) * 512 + h * 128 + part * 8);                               \
      rk[i] = *(const u32x4_t*)(Kg + (tb + tk) * 512 + h * 128 + part * 8);                               \
    }                                                                                                     \
    _Pragma("unroll") for (int i = 0; i < 4; ++i) {                                                       \
      const int id = tid + 512 * i, tk = id >> 5, part = id & 31;                                         \
      rv[i] = *(const u32x4_t*)(Vg + (tb + tk) * 1024 + h * 256 + part * 8);                              \
    }                                                                                                     \
    if (tid < 256) rg = *(const u32x4_t*)(GLOWg + (tb + (tid >> 2)) * 16 + (tid & 3) * 4);                \
  }
  f32x4 S[8][2];
#pragma unroll
  for (int a = 0; a < 8; ++a) { S[a][0] = (f32x4){0.f, 0.f, 0.f, 0.f}; S[a][1] = (f32x4){0.f, 0.f, 0.f, 0.f}; }
  GLA_LOAD(0);
#pragma unroll 1
  for (int ch = 0; ch < SEQ / 64; ++ch) {
    asm volatile("" : "+v"(tid));
    const int wave = __builtin_amdgcn_readfirstlane(tid >> 6), lane = tid & 63, g = lane >> 4, c = lane & 15;
    const int d = tid & 127, tq = __builtin_amdgcn_readfirstlane(tid >> 7);
    const unsigned vtr = lds0 + GL_V + (unsigned)((8 * g + (c >> 2)) * 544 + (32 * wave + 4 * (c & 3)) * 2);
    const unsigned ketr = lds0 + GL_KE + (unsigned)((8 * g + (c >> 2)) * 288 + (4 * (c & 3)) * 2);
    const size_t tb = tokb + (size_t)ch * 64;
#pragma unroll
    for (int i = 0; i < 2; ++i) {
      const int id = tid + 512 * i, tk = id >> 4, part = id & 15;
      *(LAS u32x4_t*)(lds + GL_QD + tk * 288 + part * 16) = rq[i];
      *(LAS u32x4_t*)(lds + GL_KI + tk * 288 + part * 16) = rk[i];
    }
#pragma unroll
    for (int i = 0; i < 4; ++i) {
      const int id = tid + 512 * i, tk = id >> 5, part = id & 31;
      *(LAS u32x4_t*)(lds + GL_V + tk * 544 + part * 16) = rv[i];
    }
    if (tid < 256) *(LAS u32x4_t*)(lds + GL_GLOW + (tid >> 2) * 64 + (tid & 3) * 16) = rg;
    GLA_BAR();
    if (ch + 1 < SEQ / 64) GLA_LOAD(ch + 1);
    u32x4_t rs[4];
#pragma unroll
    for (int i = 0; i < 4; ++i) {
      const int id = tid + 512 * i, tk = id >> 5, part = id & 31;
      rs[i] = *(const u32x4_t*)(SGR + (tb + tk) * 1024 + h * 256 + part * 8);
    }
    LAS float* LB = (LAS float*)(lds + GL_LB);
    float run = 0.f;
#pragma unroll 2
    for (int i = 0; i < 16; ++i) {
      const LAS f32x4* gp = (const LAS f32x4*)(lds + GL_GLOW + (16 * tq + i) * 64);
      const f32x4 g0 = gp[0], g1 = gp[1], g2 = gp[2], g3 = gp[3];
      float gl = bg;
      gl += g0[0] * wg[0] + g0[1] * wg[1] + g0[2] * wg[2] + g0[3] * wg[3];
      gl += g1[0] * wg[4] + g1[1] * wg[5] + g1[2] * wg[6] + g1[3] * wg[7];
      gl += g2[0] * wg[8] + g2[1] * wg[9] + g2[2] * wg[10] + g2[3] * wg[11];
      gl += g3[0] * wg[12] + g3[1] * wg[13] + g3[2] * wg[14] + g3[3] * wg[15];
      const float ls = fminf(gl, 0.f) - __logf(1.f + __expf(-fabsf(gl)));
      run += ls * (1.f / 16.f);
      LB[(16 * tq + i) * 128 + d] = run;
    }
    QT[tq * 128 + d] = run;
    GLA_BAR();
    {
      float off = 0.f, tot = 0.f;
#pragma unroll
      for (int k = 0; k < 4; ++k) { const float v = QT[k * 128 + d]; tot += v; off += (k < tq) ? v : 0.f; }
      const float eb = __expf(tot);
#pragma unroll 2
      for (int i = 0; i < 16; ++i) {
        const int t = 16 * tq + i;
        const float bb = LB[t * 128 + d] + off;
        const float e = __expf(bb), r = __expf(-bb);
        LAS bf16* qp = (LAS bf16*)(lds + GL_QD + t * 288) + d;
        LAS bf16* kp = (LAS bf16*)(lds + GL_KI + t * 288) + d;
        LAS bf16* ep = (LAS bf16*)(lds + GL_KE + t * 288) + d;
        const float q = bf2f(*qp), k = bf2f(*kp);
        *qp = f2bf(q * e);
        *kp = f2bf(k * r);
        *ep = f2bf(k * (eb * r));
      }
      if (tq == 0) DEC[d] = eb;
    }
    GLA_BAR();
    {
      const int ti = wave >> 1;
#pragma unroll
      for (int u = 0; u < 2; ++u) {
        const int tj = 2 * (wave & 1) + u;
        f32x4 acc = (f32x4){0.f, 0.f, 0.f, 0.f};
        if (tj <= ti) {
#pragma unroll
          for (int ks = 0; ks < 4; ++ks) {
            const bf16x8_t a = *(const LAS bf16x8_t*)(lds + GL_QD + (16 * ti + c) * 288 + (32 * ks + 8 * g) * 2);
            const bf16x8_t bb = *(const LAS bf16x8_t*)(lds + GL_KI + (16 * tj + c) * 288 + (32 * ks + 8 * g) * 2);
            acc = __builtin_amdgcn_mfma_f32_16x16x32_bf16(a, bb, acc, 0, 0, 0);
          }
        }
#pragma unroll
        for (int r = 0; r < 4; ++r) {
          const int i = 16 * ti + 4 * g + r, j = 16 * tj + c;
          *((LAS bf16*)(lds + GL_AT + i * 144) + j) = f2bf((j <= i) ? acc[r] : 0.f);
        }
      }
    }
    GLA_BAR();
    f32x4 o[4][2];
    {
      bf16x8_t vf[2][2];
      {
        s16x4_t lo[4], hi[4];
#pragma unroll
        for (int ks = 0; ks < 2; ++ks)
#pragma unroll
          for (int tn = 0; tn < 2; ++tn) {
            lo[ks * 2 + tn] = tr_read_b64(vtr + (32 * ks) * 544 + tn * 32);
            hi[ks * 2 + tn] = tr_read_b64(vtr + (32 * ks + 4) * 544 + tn * 32);
          }
        asm volatile("s_waitcnt lgkmcnt(0)" ::: "memory");
        __builtin_amdgcn_sched_barrier(0);
#pragma unroll
        for (int u = 0; u < 4; ++u)
          vf[u >> 1][u & 1] = (bf16x8_t){lo[u][0], lo[u][1], lo[u][2], lo[u][3], hi[u][0], hi[u][1], hi[u][2], hi[u][3]};
      }
#pragma unroll
      for (int tm = 0; tm < 4; ++tm) { o[tm][0] = (f32x4){0.f, 0.f, 0.f, 0.f}; o[tm][1] = (f32x4){0.f, 0.f, 0.f, 0.f}; }
#pragma unroll
      for (int tm = 0; tm < 4; ++tm)
#pragma unroll
        for (int ks = 0; ks < 2; ++ks) {
          if (ks == 1 && tm < 2) continue;
          const bf16x8_t a = *(const LAS bf16x8_t*)(lds + GL_AT + (16 * tm + c) * 144 + (32 * ks + 8 * g) * 2);
          o[tm][0] = __builtin_amdgcn_mfma_f32_16x16x32_bf16(a, vf[ks][0], o[tm][0], 0, 0, 0);
          o[tm][1] = __builtin_amdgcn_mfma_f32_16x16x32_bf16(a, vf[ks][1], o[tm][1], 0, 0, 0);
          __builtin_amdgcn_sched_barrier(0);
        }
#pragma unroll
      for (int u = 0; u < 4; ++u) {
        union { bf16x8_t v; unsigned w[4]; } s0, s1;
        s0.w[0] = pk2(S[2 * u][0][0], S[2 * u][0][1]); s0.w[1] = pk2(S[2 * u][0][2], S[2 * u][0][3]);
        s0.w[2] = pk2(S[2 * u + 1][0][0], S[2 * u + 1][0][1]); s0.w[3] = pk2(S[2 * u + 1][0][2], S[2 * u + 1][0][3]);
        s1.w[0] = pk2(S[2 * u][1][0], S[2 * u][1][1]); s1.w[1] = pk2(S[2 * u][1][2], S[2 * u][1][3]);
        s1.w[2] = pk2(S[2 * u + 1][1][0], S[2 * u + 1][1][1]); s1.w[3] = pk2(S[2 * u + 1][1][2], S[2 * u + 1][1][3]);
#pragma unroll
        for (int tm = 0; tm < 4; ++tm) {
          const LAS unsigned char* qrow = lds + GL_QD + (16 * tm + c) * 288 + (32 * u + 4 * g) * 2;
          const s16x4_t q0 = *(const LAS s16x4_t*)qrow, q1 = *(const LAS s16x4_t*)(qrow + 32);
          const bf16x8_t a = (bf16x8_t){q0[0], q0[1], q0[2], q0[3], q1[0], q1[1], q1[2], q1[3]};
          o[tm][0] = __builtin_amdgcn_mfma_f32_16x16x32_bf16(a, s0.v, o[tm][0], 0, 0, 0);
          o[tm][1] = __builtin_amdgcn_mfma_f32_16x16x32_bf16(a, s1.v, o[tm][1], 0, 0, 0);
        }
        __builtin_amdgcn_sched_barrier(0);
      }
#pragma unroll
      for (int tk = 0; tk < 8; ++tk) {
        const f32x4 dec4 = *(const LAS f32x4*)(DEC + 16 * tk + 4 * g);
        S[tk][0] *= dec4; S[tk][1] *= dec4;
        s16x4_t lo0 = tr_read_b64(ketr + tk * 32), hi0 = tr_read_b64(ketr + 4 * 288 + tk * 32);
        s16x4_t lo1 = tr_read_b64(ketr + 32 * 288 + tk * 32), hi1 = tr_read_b64(ketr + 36 * 288 + tk * 32);
        asm volatile("s_waitcnt lgkmcnt(0)" ::: "memory");
        __builtin_amdgcn_sched_barrier(0);
        const bf16x8_t a0 = (bf16x8_t){lo0[0], lo0[1], lo0[2], lo0[3], hi0[0], hi0[1], hi0[2], hi0[3]};
        const bf16x8_t a1 = (bf16x8_t){lo1[0], lo1[1], lo1[2], lo1[3], hi1[0], hi1[1], hi1[2], hi1[3]};
        S[tk][0] = __builtin_amdgcn_mfma_f32_16x16x32_bf16(a0, vf[0][0], S[tk][0], 0, 0, 0);
        S[tk][1] = __builtin_amdgcn_mfma_f32_16x16x32_bf16(a0, vf[0][1], S[tk][1], 0, 0, 0);
        S[tk][0] = __builtin_amdgcn_mfma_f32_16x16x32_bf16(a1, vf[1][0], S[tk][0], 0, 0, 0);
        S[tk][1] = __builtin_amdgcn_mfma_f32_16x16x32_bf16(a1, vf[1][1], S[tk][1], 0, 0, 0);
        __builtin_amdgcn_sched_barrier(0);
      }
#pragma unroll
      for (int tm = 0; tm < 4; ++tm)
#pragma unroll
        for (int r = 0; r < 4; ++r) {
          float ss = o[tm][0][r] * o[tm][0][r] + o[tm][1][r] * o[tm][1][r];
          ss = row16_sum(ss);
          if (c == 0) SSQ[(16 * tm + 4 * g + r) * 8 + wave] = ss;
        }
    }
    GLA_BAR();
    {
      LAS bf16* OB = (LAS bf16*)(lds + GL_LB);
#pragma unroll
      for (int tm = 0; tm < 4; ++tm)
#pragma unroll
        for (int r = 0; r < 4; ++r) {
          const int t = 16 * tm + 4 * g + r;
          const f32x4 p0 = *(const LAS f32x4*)(SSQ + t * 8), p1 = *(const LAS f32x4*)(SSQ + t * 8 + 4);
          const float tot = ((p0[0] + p0[1]) + (p0[2] + p0[3])) + ((p1[0] + p1[1]) + (p1[2] + p1[3]));
          const float rstd = rsqrtf(tot * (1.f / 256.f) + 1e-6f);
          OB[t * 256 + 32 * wave + c] = f2bf(o[tm][0][r] * rstd * gn0);
          OB[t * 256 + 32 * wave + 16 + c] = f2bf(o[tm][1][r] * rstd * gn1);
        }
    }
    GLA_BAR();
#pragma unroll
    for (int i = 0; i < 4; ++i) {
      const int id = tid + 512 * i, tk = id >> 5, part = id & 31;
      const u32x4_t ov = *(const LAS u32x4_t*)(lds + GL_LB + tk * 512 + part * 16);
      const u32x4_t sv = rs[i];
      u32x4_t gv;
      gv[0] = pk2(bflo(ov[0]) * bflo(sv[0]), bfhi(ov[0]) * bfhi(sv[0]));
      gv[1] = pk2(bflo(ov[1]) * bflo(sv[1]), bfhi(ov[1]) * bfhi(sv[1]));
      gv[2] = pk2(bflo(ov[2]) * bflo(sv[2]), bfhi(ov[2]) * bfhi(sv[2]));
      gv[3] = pk2(bflo(ov[3]) * bflo(sv[3]), bfhi(ov[3]) * bfhi(sv[3]));
      *(u32x4_t*)(Vg + (tb + tk) * 1024 + h * 256 + part * 8) = gv;
    }
  }
#undef GLA_LOAD
  __syncthreads();
}

#define LDS_BYTES 155712
#define OFF_CTR (200ull * 1024)

__device__ __forceinline__ unsigned xcc_id() { return (unsigned)__builtin_amdgcn_s_getreg((3 << 11) | 20) & 0x7u; }
__device__ __forceinline__ void ph_mixer(const P& p, unsigned char* lds_raw, bool do_gla) {
  if (do_gla && blockIdx.x < 32) { gla_item(p, lds_raw, blockIdx.x); if (blockIdx.x == 0) TS_SET(p, 20); }
  unsigned* ctr = (unsigned*)(p.ws + OFF_CTR);
  LAS unsigned* slot = (LAS unsigned*)((LAS unsigned char*)lds_raw + DS_TOTAL);
  const unsigned home = xcc_id();
  unsigned k = 0;
  for (;;) {
    if (tid_fresh() == 0) {
      unsigned qi = 0xffffffffu;
      while (k < 8) {
        const unsigned b = (home + k) & 7u;
        const unsigned v = __hip_atomic_fetch_add(ctr + 64 * b, 1u, __ATOMIC_RELAXED, __HIP_MEMORY_SCOPE_AGENT);
        if (v < 256u) { qi = (b << 8) | v; break; }
        ++k;
      }
      slot[0] = qi; slot[1] = k;
    }
    __syncthreads();
    const unsigned qi = slot[0];
    k = slot[1];
    __syncthreads();
    if (qi == 0xffffffffu) break;
    dsa_batch(p, lds_raw, (int)(qi >> 8), 255 - (int)(qi & 255u));
  }
}

__global__ void __launch_bounds__(512, 2) mega(P p) {
  extern __shared__ __attribute__((aligned(16))) unsigned char lds_raw[];
  LAS unsigned char* lds = (LAS unsigned char*)lds_raw;
  cg::grid_group grid = cg::this_grid();
  char* ws = p.ws;
  const int bid = blockIdx.x, nb = gridDim.x;
  if (bid == 0 && threadIdx.x < 8) *(unsigned*)(ws + OFF_CTR + 256 * threadIdx.x) = 0u;
#if PROBE_TS
  if (bid == 0 && threadIdx.x < 64) ((unsigned long long*)(ws + OFF_TS))[threadIdx.x] = 0ull;
  __syncthreads();
  if (bid == 0) TS_SET(p, 0);
#endif
  ph_prep(p, (float*)lds_raw);
  grid.sync();
  if (bid == 0) TS_SET(p, 1);
  ph_mod(p, p.x, p.norm1_g, 0, 1024, (bf16*)(ws + OFF_H), bid, nb);
  grid.sync();
  if (bid == 0) TS_SET(p, 2);
  gemm_run(lds, (const bf16*)(ws + OFF_H), (const bf16*)(ws + OFF_WT_IN), TT, 7168, 1024, EpiIn{ws, p.out});
  grid.sync();
  if (bid == 0) TS_SET(p, 3);
  ph_mixer(p, lds_raw, true);
  if (bid == 0) TS_SET(p, 21);
  grid.sync();
  if (bid == 0) TS_SET(p, 4);
  gemm_run(lds, (const bf16*)(ws + OFF_V), (const bf16*)(ws + OFF_WT_A), TT, 1024, 1024,
           EpiMix<false>{(const bf16*)p.out, (bf16*)(ws + OFF_MIX)});
  gemm_run(lds, (const bf16*)(ws + OFF_ODSA), (const bf16*)(ws + OFF_WT_B), TT, 1024, 1024,
           EpiMix<true>{(const bf16*)p.out + (size_t)TT * 1024, (bf16*)(ws + OFF_MIX)});
  grid.sync();
  if (bid == 0) TS_SET(p, 5);
  gemm_run(lds, (const bf16*)(ws + OFF_MIX), (const bf16*)(ws + OFF_WT_OUT), TT, 1024, 1024,
           EpiX1{p.x, (const float*)(ws + OFF_ADA), p.out});
  grid.sync();
  if (bid == 0) TS_SET(p, 6);
  ph_mod(p, p.out, p.norm2_g, 3072, 4096, (bf16*)(ws + OFF_H), bid, nb);
  grid.sync();
  if (bid == 0) TS_SET(p, 7);
  gemm_run(lds, (const bf16*)(ws + OFF_H), (const bf16*)(ws + OFF_WT_Q), TT, 2048, 1024, EpiPlain{(bf16*)(ws + OFF_PQ), 2048});
  grid.sync();
  if (bid == 0) TS_SET(p, 8);
  ph_peer512(p, lds_raw, p.out);
#if PROBE_TS
  if (bid == 0) TS_SET(p, 18);
  grid.sync();
  if (bid == 0) TS_SET(p, 9);
  grid.sync();
  {
    const unsigned long long* T = (const unsigned long long*)(ws + OFF_TS);
    const float va = 0.01f * (float)(PROBE_A), vb = 0.01f * (float)(PROBE_B);
    for (size_t i = (size_t)bid * 512 + threadIdx.x; i < (size_t)TT * 1024; i += (size_t)nb * 512) p.out[i] = (i == 0) ? 30.f * va : vb;
  }
#endif
}

extern "C" void kernel_launch(void* const* d_in, const int* in_sizes, int n_in, void* d_out, int out_size, void* d_ws,
                              size_t ws_size, hipStream_t stream) {
  P p{};
  const float** f = (const float**)&p;
  for (int i = 0; i < 22; ++i) f[i] = (const float*)d_in[i];
  p.out = (float*)d_out;
  p.ws = (char*)d_ws;
  if (ws_size < WS_NEED) { fprintf(stderr, "workspace too small: %zu\n", ws_size); return; }
  static int grid_blocks = 0;
  if (!grid_blocks) {
    int dev = 0, cus = 0, per_cu = 0;
    (void)hipGetDevice(&dev);
    (void)hipDeviceGetAttribute(&cus, hipDeviceAttributeMultiprocessorCount, dev);
    if (hipFuncSetAttribute((const void*)mega, hipFuncAttributeMaxDynamicSharedMemorySize, LDS_BYTES) != hipSuccess) {
      fprintf(stderr, "hipFuncSetAttribute failed\n"); grid_blocks = -1; return;
    }
    if (hipOccupancyMaxActiveBlocksPerMultiprocessor(&per_cu, (const void*)mega, 512, LDS_BYTES) != hipSuccess || per_cu < 1) {
      fprintf(stderr, "occupancy query failed\n"); grid_blocks = -1; return;
    }
    grid_blocks = cus;
  }
  if (grid_blocks <= 0) return;
  void* args[] = {&p};
  hipError_t e = hipLaunchCooperativeKernel((void*)mega, dim3(grid_blocks), dim3(512), args, LDS_BYTES, stream);
  if (e != hipSuccess) fprintf(stderr, "cooperative launch failed: %s (grid %d)\n", hipGetErrorString(e), grid_blocks);
}
```

```cpp
#include <hip/hip_runtime.h>
#include <hip/hip_cooperative_groups.h>
#include <cstdio>
#include <cstdint>
namespace cg = cooperative_groups;

#define TT 32768
#define SEQ 4096
#define DM 1024
#define NIN 7000
typedef unsigned short bf16;
#define LAS __attribute__((address_space(3)))

struct P {
  const float *x, *c, *w_ada, *b_ada, *norm1_g, *w_in, *w_gate_up, *b_gate, *gla_norm_g, *kv_norm_g,
      *w_uk, *w_uv, *w_a, *w_b, *w_out, *norm2_g, *w_q, *sk1, *sk2, *peer_u, *peer_v, *final_g;
  float* out;
  char* ws;
};

#define MB (1ull << 20)
#define OFF_ADA   (0ull)
#define OFF_H     (1 * MB)
#define OFF_ODSA  (1 * MB)
#define OFF_Q     (65 * MB)
#define OFF_K     (97 * MB)
#define OFF_MIX   (65 * MB)
#define OFF_V     (129 * MB)
#define OFF_DQ    (193 * MB)
#define OFF_PQ    (129 * MB)
#define OFF_DSCR  (257 * MB)
#define OFF_SSP   (256ull * 1024)
#define OFF_CKV   (289 * MB)
#define OFF_IQ    (305 * MB)
#define OFF_IK    (337 * MB)
#define OFF_IW    (341 * MB)
#define OFF_GLOW  (342 * MB)
#define OFF_SGR   (344 * MB)
#define OFF_WT    (408 * MB)
#define OFF_WT_IN  (OFF_WT)
#define OFF_WT_A   (OFF_WT + 7168ull * 2048)
#define OFF_WT_B   (OFF_WT_A + 1024ull * 2048)
#define OFF_WT_OUT (OFF_WT_B + 1024ull * 2048)
#define OFF_WT_Q   (OFF_WT_OUT + 1024ull * 2048)
#define OFF_PU    (432 * MB)
#define OFF_PV    (464 * MB)
#define OFF_SK    (496 * MB)
#define OFF_PSC   (496 * MB + 128 * 1024)
#define OFF_WUK   (497 * MB)
#define OFF_WUV   (497 * MB + 512 * 1024)
#define WS_NEED   (498 * MB)

__device__ __forceinline__ bf16 f2bf(float f) {
  unsigned u = __float_as_uint(f);
  u += 0x7fffu + ((u >> 16) & 1u);
  return (bf16)(u >> 16);
}
__device__ __forceinline__ unsigned pk2(float lo, float hi) { return (unsigned)f2bf(lo) | ((unsigned)f2bf(hi) << 16); }
__device__ __forceinline__ float bf2f(bf16 h) { return __uint_as_float(((unsigned)h) << 16); }
__device__ __forceinline__ float bflo(unsigned u) { return __uint_as_float(u << 16); }
__device__ __forceinline__ float bfhi(unsigned u) { return __uint_as_float(u & 0xffff0000u); }
__device__ __forceinline__ float wave_sum(float v) {
#pragma unroll
  for (int o = 32; o > 0; o >>= 1) v += __shfl_xor(v, o);
  return v;
}
__device__ __forceinline__ float wave_max(float v) {
#pragma unroll
  for (int o = 32; o > 0; o >>= 1) v = fmaxf(v, __shfl_xor(v, o));
  return v;
}
#ifndef PROBE_TS
#define PROBE_TS 0
#endif
#define OFF_PRM (800ull * 1024)
#define PRM_WGU   0
#define PRM_BG    8192
#define PRM_GNG   8704
#define PRM_N2G   9728
#define PRM_FG    10752
#define PRM_TOTAL 11776
#define OFF_TS (208ull * 1024)
#if PROBE_TS
#define TS_SET(p, k) do { if (tid_fresh() == 0) ((unsigned long long*)((p).ws + OFF_TS))[k] = __builtin_amdgcn_s_memrealtime(); } while (0)
#define TS_ADD(p, k, t0) do { if (tid_fresh() == 0) ((unsigned long long*)((p).ws + OFF_TS))[k] += __builtin_amdgcn_s_memrealtime() - (t0); } while (0)
#define TS_NOW() __builtin_amdgcn_s_memrealtime()
#else
#define TS_SET(p, k) do {} while (0)
#define TS_ADD(p, k, t0) do {} while (0)
#define TS_NOW() 0ull
#endif
__device__ __forceinline__ int tid_fresh() { int t = threadIdx.x; asm volatile("" : "+v"(t)); return t; }
__device__ __forceinline__ float sigmoidf_(float v) { return 1.f / (1.f + __expf(-v)); }
__device__ __forceinline__ float siluf_(float v) { return v / (1.f + __expf(-v)); }

#include <hip/hip_runtime.h>
namespace pg8 {
#define PG8_LAS __attribute__((address_space(3)))
typedef unsigned short bf16_t;
typedef short bf16x8 __attribute__((ext_vector_type(8)));
typedef float f32x4 __attribute__((ext_vector_type(4)));
typedef unsigned u32x4 __attribute__((ext_vector_type(4)));
constexpr int BM = 256, BK = 64, HALF = 128, HTB = HALF * BK * 2  , STAGE_BYTES = 8 * HTB, NXCD = 8, WGM = 8;

__host__ __device__ __forceinline__ int lds_byte(int r, int c) { const int st = (r >> 4) * 2 + (c >> 5), rr = r & 15, cc = c & 31, ob = rr * 64 + cc * 2; return st * 1024 + (ob ^ (((ob >> 9) & 1) << 5)); }
__host__ __device__ __forceinline__ void stage_rc(int b, int& R, int& C) { const int st = b / 1024, sb = b % 1024, swz = sb ^ (((sb >> 9) & 1) << 5); R = (st >> 1) * 16 + swz / 64; C = (st & 1) * 32 + (swz % 64) / 2; }
__host__ __device__ __forceinline__ int perm32(int rho) { const int n = rho >> 4, i = rho & 15; return 8 * (i >> 2) + 4 * n + (i & 3); }

struct Unit { int pm, pn; };
struct Gemm { const bf16_t* A; const bf16_t* Bt; int M, N, K; };

struct StaticOrder {
    int nM, nN, nwg, G, c;
    __host__ __device__ void init(int M, int N, int G_, int c_) { nM = M / BM; nN = N / BM; nwg = nM * nN; G = G_; c = c_; }
    __host__ __device__ bool next(int i, Unit& u) const {
        const long L = (long)i * G + c; if (L >= nwg) return false;
        int wgid = (int)L; { const int q = nwg / NXCD, r = nwg % NXCD, xcd = wgid % NXCD, off = wgid / NXCD; wgid = (xcd < r ? xcd * (q + 1) : r * (q + 1) + (xcd - r) * q) + off; }
        const int nig = WGM * nN, gid = wgid / nig, fm = gid * WGM, gsz = (nM - fm) < WGM ? (nM - fm) : WGM;
        u.pm = fm + ((wgid % nig) % gsz); u.pn = (wgid % nig) / gsz; return true;
    }
    __device__ __forceinline__ void a_ready(const Unit&) const {}
    __device__ __forceinline__ void done(const Unit&) const {}
};
__device__ __forceinline__ unsigned cvt_pk_bf16(float lo, float hi) { unsigned r; asm volatile("v_cvt_pk_bf16_f32 %0, %1, %2" : "=v"(r) : "v"(lo), "v"(hi)); return r; }

template <class Epi, class Sched, bool STAMP = false>
__device__ __forceinline__ void gemm_phase(PG8_LAS unsigned char* lds, const Gemm g, const Sched& S, const Epi& E, unsigned long long* stamps) {
    const int tid = ::tid_fresh(), wid = __builtin_amdgcn_readfirstlane(tid >> 6), lane = tid & 63, wr = wid >> 2, wc = wid & 3, fr = lane & 15, fq = lane >> 4;
    const int K = g.K, nt = K / BK;
    int ts_lo = 0, ts_hi = 0, nts = 0; const unsigned long long rt_entry = STAMP ? (unsigned long long)wall_clock64() : 0ull;
#define PG8_STAMP() do { if (STAMP && wid == 0 && nts < 64) { const unsigned long long _c = (unsigned long long)clock64(); \
        ts_lo = (lane == nts) ? (int)(unsigned)_c : ts_lo; ts_hi = (lane == nts) ? (int)(unsigned)(_c >> 32) : ts_hi; ++nts; } } while (0)
    PG8_STAMP();
    unsigned voffA[2], voffB[2];
#pragma unroll
    for (int i = 0; i < 2; ++i) { int R, C; stage_rc(tid * 16 + i * 8192, R, C); const int Rb = Epi::PERM ? ((R & ~31) + perm32(R & 31)) : R;
        voffA[i] = (unsigned)(R * K + C) * 2u; voffB[i] = (unsigned)(Rb * K + C) * 2u; }
    const size_t kstep = (size_t)(BK * 2);
    const size_t hstep = (size_t)HALF * K * 2;
    const size_t tstep = 2 * hstep;
    const unsigned ldsw = (unsigned)wid * 1024u;
    const int aoff = lds_byte(wr * 64 + fr, fq * 8), boff = lds_byte(wc * 32 + fr, fq * 8);
#define PG8_SA(b, h) (((b) * 2 + (h)) * HTB)
#define PG8_SB(b, h) ((4 + (b) * 2 + (h)) * HTB)
#define PG8_STAGE(bufoff, gbase, voff) do { _Pragma("unroll") for (int _i = 0; _i < 2; ++_i) \
        __builtin_amdgcn_global_load_lds((const unsigned*)((const char*)(gbase) + (voff)[_i]), (PG8_LAS unsigned*)(lds + (bufoff) + ldsw + _i * 8192), 16, 0, 0); } while (0)
#define PG8_LDA(dst, b, h) do { _Pragma("unroll") for (int m = 0; m < 4; ++m) _Pragma("unroll") for (int k = 0; k < 2; ++k) dst[m][k] = *(const PG8_LAS bf16x8*)(lds + PG8_SA(b, h) + aoff + m * 2048 + k * 1024); } while (0)
#define PG8_LDB(dst, b, h) do { _Pragma("unroll") for (int n = 0; n < 2; ++n) _Pragma("unroll") for (int k = 0; k < 2; ++k) dst[n][k] = *(const PG8_LAS bf16x8*)(lds + PG8_SB(b, h) + boff + n * 2048 + k * 1024); } while (0)
#define PG8_MMA(ai, bj, At, Bt) do { __builtin_amdgcn_s_setprio(1); _Pragma("unroll") for (int m = 0; m < 4; ++m) _Pragma("unroll") for (int n = 0; n < 2; ++n) _Pragma("unroll") for (int k = 0; k < 2; ++k) \
        acc[ai][bj][m][n] = __builtin_amdgcn_mfma_f32_16x16x32_bf16(Bt[n][k], At[m][k], acc[ai][bj][m][n], 0, 0, 0); __builtin_amdgcn_s_setprio(0); } while (0)
#define PG8_WAIT_V(n) asm volatile("s_waitcnt vmcnt(" #n ")" ::: "memory")
#define PG8_WAIT_L(n) asm volatile("s_waitcnt lgkmcnt(" #n ")" ::: "memory")
#define PG8_BAR __builtin_amdgcn_s_barrier()
#define PG8_SCHED __builtin_amdgcn_sched_barrier(0)
    Unit cur, nxt; int ui = 0;
    if (!S.next(0, cur)) return;
    f32x4 acc[2][2][4][2];
#pragma unroll
    for (int a = 0; a < 2; ++a)
#pragma unroll
        for (int b = 0; b < 2; ++b)
#pragma unroll
            for (int m = 0; m < 4; ++m)
#pragma unroll
                for (int n = 0; n < 2; ++n) acc[a][b][m][n] = (f32x4){0.f, 0.f, 0.f, 0.f};
    bf16x8 At[4][2], B0[2][2], B1[2][2];
    const char* cA = (const char*)g.A + (size_t)cur.pm * tstep; const char* cB = (const char*)g.Bt + (size_t)cur.pn * tstep;
    S.a_ready(cur);
    PG8_STAGE(PG8_SB(0, 0), cB, voffB); PG8_STAGE(PG8_SA(0, 0), cA, voffA); PG8_STAGE(PG8_SB(0, 1), cB + hstep, voffB); PG8_STAGE(PG8_SA(0, 1), cA + hstep, voffA);
    if (wr == 1) PG8_BAR;
    PG8_WAIT_V(4); PG8_BAR;
    PG8_STAGE(PG8_SB(1, 0), cB + kstep, voffB); PG8_STAGE(PG8_SA(1, 0), cA + kstep, voffA); PG8_STAGE(PG8_SB(1, 1), cB + hstep + kstep, voffB);
    PG8_WAIT_V(6); PG8_BAR;
    PG8_STAMP();
    for (;;) {
        const bool has_next = S.next(ui + 1, nxt);
        const char* nA = has_next ? (const char*)g.A + (size_t)nxt.pm * tstep : cA; const char* nB = has_next ? (const char*)g.Bt + (size_t)nxt.pn * tstep : cB;
        for (int t = 0; t < nt; t += 2) {
            const bool last = (t == nt - 2);
            const char* a1 = cA + (size_t)(t + 1) * kstep;
            const char* a2 = last ? nA : cA + (size_t)(t + 2) * kstep; const char* b2 = last ? nB : cB + (size_t)(t + 2) * kstep;
            const char* a3 = a2 + kstep; const char* b3 = b2 + kstep;
            if (last && has_next) S.a_ready(nxt);
            PG8_LDB(B0, 0, 0); PG8_SCHED; PG8_LDA(At, 0, 0); PG8_STAGE(PG8_SA(1, 1), a1 + hstep, voffA);
            PG8_WAIT_L(8); PG8_BAR; PG8_WAIT_L(0); PG8_MMA(0, 0, At, B0); PG8_BAR; PG8_SCHED;
            PG8_LDB(B1, 0, 1); PG8_STAGE(PG8_SB(0, 0), b2, voffB);
            PG8_BAR; PG8_WAIT_L(0); PG8_MMA(0, 1, At, B1); PG8_BAR;
            PG8_LDA(At, 0, 1); PG8_STAGE(PG8_SA(0, 0), a2, voffA);
            PG8_BAR; PG8_WAIT_L(0); PG8_MMA(1, 0, At, B0); PG8_BAR; PG8_SCHED;
            PG8_STAGE(PG8_SB(0, 1), b2 + hstep, voffB);
            PG8_WAIT_V(6); PG8_BAR; PG8_MMA(1, 1, At, B1); PG8_BAR;
            PG8_LDB(B0, 1, 0); PG8_SCHED; PG8_LDA(At, 1, 0); PG8_STAGE(PG8_SA(0, 1), a2 + hstep, voffA);
            PG8_WAIT_L(8); PG8_BAR; PG8_WAIT_L(0); PG8_MMA(0, 0, At, B0); PG8_BAR; PG8_SCHED;
            PG8_LDB(B1, 1, 1); PG8_STAGE(PG8_SB(1, 0), b3, voffB);
            PG8_BAR; PG8_WAIT_L(0); PG8_MMA(0, 1, At, B1); PG8_BAR;
            PG8_LDA(At, 1, 1); PG8_STAGE(PG8_SA(1, 0), a3, voffA);
            PG8_BAR; PG8_WAIT_L(0); PG8_MMA(1, 0, At, B0); PG8_BAR; PG8_SCHED;
            PG8_STAGE(PG8_SB(1, 1), b3 + hstep, voffB);
            PG8_WAIT_V(6); PG8_BAR; PG8_MMA(1, 1, At, B1); PG8_BAR;
        }
        PG8_STAMP();
        if constexpr (!Epi::AFTER_DRAIN) { E(acc, cur, wr, wc, fr, fq); S.done(cur); }
        PG8_STAMP();
        if (!has_next) break;
#pragma unroll
        for (int a = 0; a < 2; ++a)
#pragma unroll
            for (int b = 0; b < 2; ++b)
#pragma unroll
                for (int m = 0; m < 4; ++m)
#pragma unroll
                    for (int n = 0; n < 2; ++n) acc[a][b][m][n] = (f32x4){0.f, 0.f, 0.f, 0.f};
        cur = nxt; cA = nA; cB = nB; ++ui;
    }
    PG8_WAIT_V(0);
    if (wr == 0) PG8_BAR;
    PG8_BAR;
    if constexpr (Epi::AFTER_DRAIN) { E.fused(acc, cur, wr, wc, fr, fq, lds, wid, lane); S.done(cur); }
    PG8_STAMP();
    if (STAMP && wid == 0) { stamps[lane] = lane < nts ? (((unsigned long long)(unsigned)ts_hi << 32) | (unsigned)ts_lo) : 0ull;
        if (lane == 62) stamps[62] = rt_entry; if (lane == 63) stamps[63] = (unsigned long long)wall_clock64(); }
#undef PG8_STAMP
#undef PG8_SA
#undef PG8_SB
#undef PG8_STAGE
#undef PG8_LDA
#undef PG8_LDB
#undef PG8_MMA
#undef PG8_WAIT_V
#undef PG8_WAIT_L
#undef PG8_BAR
#undef PG8_SCHED
}
}
#define XB_TMO      128
#define XB_XCNT(j)  (256  + 64 * (j))
#define XB_XSUB(j)  (1280 + 64 * (j))
#define XB_XGEN(j)  (2304 + 64 * (j))
#define XB_TOP      3328
#define XB_TOPGEN   3392
#define XCD_BAR_WORDS 3456
#define XB_SPIN_CAP (1u << 18)

__device__ __forceinline__ unsigned xb_ld(unsigned* p)              { return __hip_atomic_load(p, __ATOMIC_RELAXED, __HIP_MEMORY_SCOPE_AGENT); }
__device__ __forceinline__ unsigned xb_add(unsigned* p, unsigned v) { return __hip_atomic_fetch_add(p, v, __ATOMIC_RELAXED, __HIP_MEMORY_SCOPE_AGENT); }
__device__ __forceinline__ unsigned xb_xcc_id() { return (unsigned)__builtin_amdgcn_s_getreg((3 << 11) | 20) & 0xFu; }
#define XB_SPIN(cond, bar) do { unsigned _sp = 0; while (cond) { __builtin_amdgcn_s_sleep(1); \
    if ((++_sp & 255u) == 0u) { if (xb_ld(&(bar)[XB_TMO])) break; if (_sp > XB_SPIN_CAP) { atomicAdd(&(bar)[XB_TMO], 1u); break; } } } } while (0)

struct XcdBarrier {
    unsigned* bar; unsigned x;
    volatile LAS unsigned* st;
};

__device__ __forceinline__ XcdBarrier xcd_barrier_post(unsigned* bar, volatile LAS unsigned* st) {
    XcdBarrier b; b.bar = bar; b.x = xb_xcc_id(); b.st = st;
    if (threadIdx.x == 0) (void)xb_add(&bar[XB_XCNT(b.x)], 1u);
    return b;
}
__device__ __forceinline__ void xcd_barrier_complete(unsigned* bar, unsigned x, unsigned& nloc, unsigned& nx) {
    const unsigned G = gridDim.x * gridDim.y * gridDim.z;
    unsigned sum, cnt, mine, sp = 0u;
    for (;;) {
        sum = 0u; cnt = 0u; mine = 0u;
#pragma unroll
        for (unsigned j = 0; j < 16; ++j) { const unsigned c = xb_ld(&bar[XB_XCNT(j)]); sum += c; cnt += (c > 0u) ? 1u : 0u; mine = (j == x) ? c : mine; }
        if (sum == G) break;
        __builtin_amdgcn_s_sleep(1);
        if ((++sp & 255u) == 0u) { if (xb_ld(&bar[XB_TMO])) break; if (sp > XB_SPIN_CAP) { atomicAdd(&bar[XB_TMO], 1u); break; } }
    }
    nloc = mine > 0u ? mine : 1u; nx = cnt > 0u ? cnt : 1u;
}

__device__ __forceinline__ void xcd_barrier(const XcdBarrier& b) {
    asm volatile("s_waitcnt vmcnt(0)" ::: "memory");
    __syncthreads();
    if (threadIdx.x == 0) {
        unsigned* bar = b.bar;
        __builtin_amdgcn_s_waitcnt(0);
        unsigned nloc = b.st[0], nx = b.st[1];
        if (nloc == 0u) { xcd_barrier_complete(bar, b.x, nloc, nx); b.st[0] = nloc; b.st[1] = nx; }
        const unsigned old = xb_add(&bar[XB_XSUB(b.x)], 1u);
        const unsigned gen = old / nloc;
        if (old + 1u == (gen + 1u) * nloc) {
            __builtin_amdgcn_fence(__ATOMIC_RELEASE, "agent");
            asm volatile("s_waitcnt vmcnt(0)" ::: "memory");
            const unsigned og = xb_add(&bar[XB_TOP], 1u);
            const unsigned tg = og / nx;
            if (og + 1u == (tg + 1u) * nx) xb_add(&bar[XB_TOPGEN], 1u);
            else XB_SPIN(xb_ld(&bar[XB_TOPGEN]) == tg, bar);
            __builtin_amdgcn_fence(__ATOMIC_ACQUIRE, "agent");
            xb_add(&bar[XB_XGEN(b.x)], 1u);
            asm volatile("s_waitcnt vmcnt(0)" ::: "memory");
        } else {
            XB_SPIN(xb_ld(&bar[XB_XGEN(b.x)]) == gen, bar);
            __builtin_amdgcn_fence(__ATOMIC_ACQUIRE, "agent");
            asm volatile("s_waitcnt vmcnt(0)" ::: "memory");
        }
    }
    __syncthreads();
}

__device__ __forceinline__ void ph_mod(const P& p, const float* X, const float* g, int shift_off, int scale_off, bf16* H, int bid, int nb) {
  const float* ada = (const float*)(p.ws + OFF_ADA);
  const int tidm = tid_fresh(); int wave = tidm >> 6, lane = tidm & 63;
  for (int row = bid * (int)(blockDim.x >> 6) + wave; row < TT; row += nb * (int)(blockDim.x >> 6)) {
    const float4* xr = (const float4*)(X + (size_t)row * DM);
    float4 v[4];
    float ss = 0.f;
#pragma unroll
    for (int i = 0; i < 4; ++i) {
      v[i] = xr[lane + i * 64];
      ss += v[i].x * v[i].x + v[i].y * v[i].y + v[i].z * v[i].z + v[i].w * v[i].w;
    }
    ss = wave_sum(ss);
    float rstd = rsqrtf(ss * (1.f / DM) + 1e-6f);
    int b = row >> 12;
    const float* sh = ada + b * 6144 + shift_off;
    const float* sc = ada + b * 6144 + scale_off;
#pragma unroll
    for (int i = 0; i < 4; ++i) {
      int c0 = (lane + i * 64) * 4;
      float4 gg = *(const float4*)(g + c0);
      float4 s4 = *(const float4*)(sc + c0);
      float4 h4 = *(const float4*)(sh + c0);
      ushort4 o;
      o.x = f2bf(v[i].x * rstd * gg.x * (1.f + s4.x) + h4.x);
      o.y = f2bf(v[i].y * rstd * gg.y * (1.f + s4.y) + h4.y);
      o.z = f2bf(v[i].z * rstd * gg.z * (1.f + s4.z) + h4.z);
      o.w = f2bf(v[i].w * rstd * gg.w * (1.f + s4.w) + h4.w);
      *(ushort4*)(H + (size_t)row * DM + c0) = o;
    }
  }
}

using pg8::f32x4;
using pg8::u32x4;
using pg8::Unit;
using pg8::cvt_pk_bf16;
typedef short s16x4_t __attribute__((ext_vector_type(4)));
typedef unsigned u32x4_t __attribute__((ext_vector_type(4)));
typedef unsigned short u16x4_t __attribute__((ext_vector_type(4)));

__device__ __forceinline__ int in_srcmap(int d) {
  if (d < 2048) return d;
  if (d < 3072) return 3088 + (d - 2048);
  if (d < 3328) return 4112 + (d - 3072);
  if (d < 3840) return 4368 + (d - 3328);
  if (d < 3904) return 4880 + (d - 3840);
  if (d < 3912) return 4944 + (d - 3904);
  if (d < 3928) return 3072 + (d - 3912);
  if (d < 4096) return -1;
  if (d < 5120) return 2048 + (d - 4096);
  return 4952 + (d - 5120);
}
template <bool MAP>
__device__ __forceinline__ void transpose_item(const float* W, int ldw, int K, bf16* WT, int item, int nblk, float* scr, int lane) {
  const int kb = item / nblk, nbk = item % nblk, k0 = 64 * kb, n0 = 32 * nbk;
  const int d = n0 + (lane & 31);
  const int src = MAP ? in_srcmap(d) : d;
#pragma unroll 8
  for (int i = 0; i < 32; ++i) {
    const int kk = 2 * i + (lane >> 5);
    scr[kk * 33 + (lane & 31)] = (src >= 0) ? W[(size_t)(k0 + kk) * ldw + src] : 0.f;
  }
  asm volatile("s_waitcnt lgkmcnt(0)" ::: "memory");
  const int c = lane & 7;
#pragma unroll
  for (int j = 0; j < 4; ++j) {
    const int n = (lane >> 3) + 8 * j;
    const float* s = scr + (8 * c) * 33 + n;
    uint4 o;
    o.x = pk2(s[0 * 33], s[1 * 33]); o.y = pk2(s[2 * 33], s[3 * 33]); o.z = pk2(s[4 * 33], s[5 * 33]); o.w = pk2(s[6 * 33], s[7 * 33]);
    *(uint4*)(WT + (size_t)(n0 + n) * K + k0 + 8 * c) = o;
  }
  asm volatile("s_waitcnt lgkmcnt(0)" ::: "memory");
}

__device__ __forceinline__ void ph_prep(const P& p, float* sm) {
  const int tid = tid_fresh(), wave = tid >> 6, lane = tid & 63;
  const int bid = blockIdx.x, nb = gridDim.x;
  float* silc = sm + 8 * 2112 + 64;
  float* red = silc + 8192;
  float* ada = (float*)(p.ws + OFF_ADA);
  if (bid < 192) {
    for (int i = tid; i < 8192; i += 512) silc[i] = siluf_(p.c[i]);
    __syncthreads();
    for (int it = bid; it < 192; it += nb) {
      const int kg = tid >> 5, cn = tid & 31, n = it * 32 + cn;
      float acc[8];
#pragma unroll
      for (int b = 0; b < 8; ++b) acc[b] = 0.f;
      for (int k = kg * 64; k < kg * 64 + 64; ++k) {
        const float w = p.w_ada[(size_t)k * 6144 + n];
#pragma unroll
        for (int b = 0; b < 8; ++b) acc[b] += silc[b * 1024 + k] * w;
      }
#pragma unroll
      for (int b = 0; b < 8; ++b) red[(kg * 8 + b) * 32 + cn] = acc[b];
      __syncthreads();
      if (tid < 256) {
        const int b = tid >> 5, c2 = tid & 31;
        float s = 0.f;
#pragma unroll
        for (int g = 0; g < 16; ++g) s += red[(g * 8 + b) * 32 + c2];
        ada[b * 6144 + it * 32 + c2] = s + p.b_ada[it * 32 + c2];
      }
      __syncthreads();
    }
  }
  {
    unsigned char* PU8 = (unsigned char*)(p.ws + OFF_PU);
    unsigned char* PV8 = (unsigned char*)(p.ws + OFF_PV);
    float* PSC = (float*)(p.ws + OFF_PSC);
    for (int row = bid * 8 + wave; row < 2 * 16384; row += nb * 8) {
      const float* src = (row < 16384 ? p.peer_u : p.peer_v) + (size_t)(row & 16383) * 1024 + lane * 16;
      f32x4 v[4];
      float mx = 0.f;
#pragma unroll
      for (int q = 0; q < 4; ++q) {
        v[q] = *(const f32x4*)(src + q * 4);
        mx = fmaxf(mx, fmaxf(fmaxf(fabsf(v[q][0]), fabsf(v[q][1])), fmaxf(fabsf(v[q][2]), fabsf(v[q][3]))));
      }
      mx = wave_max(mx);
      const float sc = (mx > 0.f) ? exp2f(floorf(log2f(448.f / mx))) : 1.f;
      u32x4 o;
#pragma unroll
      for (int q = 0; q < 4; ++q) {
        int w = __builtin_amdgcn_cvt_pk_fp8_f32(v[q][0] * sc, v[q][1] * sc, 0, false);
        w = __builtin_amdgcn_cvt_pk_fp8_f32(v[q][2] * sc, v[q][3] * sc, w, true);
        o[q] = (unsigned)w;
      }
      *(u32x4*)((row < 16384 ? PU8 : PV8) + (size_t)(row & 16383) * 1024 + lane * 16) = o;
      if (lane == 0) PSC[row] = 1.f / sc;
    }
    for (int i = bid * 512 + tid; i < 2 * 2048; i += nb * 512) {
      const float* src = (i < 2048) ? p.sk1 : p.sk2;
      const int j = i & 2047;
      const float4 v0 = *(const float4*)(src + j * 8), v1 = *(const float4*)(src + j * 8 + 4);
      uint4 o; o.x = pk2(v0.x, v0.y); o.y = pk2(v0.z, v0.w); o.z = pk2(v1.x, v1.y); o.w = pk2(v1.z, v1.w);
      *(uint4*)((bf16*)(p.ws + OFF_SK) + (size_t)i * 8) = o;
    }
  }
  {
    float* prm = (float*)(p.ws + OFF_PRM);
    for (int i = bid * 512 + tid; i < PRM_TOTAL; i += nb * 512) {
      float v;
      if (i < PRM_BG) v = p.w_gate_up[i];
      else if (i < PRM_GNG) v = p.b_gate[i - PRM_BG];
      else if (i < PRM_N2G) v = p.gla_norm_g[i - PRM_GNG];
      else if (i < PRM_FG) v = p.norm2_g[i - PRM_N2G];
      else v = p.final_g[i - PRM_FG];
      prm[i] = v;
    }
  }
  {
    bf16* WUK = (bf16*)(p.ws + OFF_WUK);
    bf16* WUV = (bf16*)(p.ws + OFF_WUV);
    for (int i = bid * 512 + tid; i < 2 * 262144; i += nb * 512) {
      if (i < 262144) {
        const int d = i & 127, cc = (i >> 7) & 255, h = i >> 15;
        WUK[i] = f2bf(p.w_uk[((size_t)h * 128 + d) * 256 + cc] * p.kv_norm_g[cc] * 0.08838834764831845f);
      } else {
        const int k = i - 262144;
        const int cc = k & 255, d = (k >> 8) & 127, h = k >> 15;
        WUV[k] = f2bf(p.w_uv[((size_t)h * 256 + cc) * 128 + d] * p.kv_norm_g[cc]);
      }
    }
  }
  float* scr = sm + wave * 2112;
  const int gw = bid * 8 + wave, ngw = nb * 8;
  constexpr int I_IN = 16 * 224, I_SQ = 16 * 32, I_Q = 16 * 64;
  for (int it = gw; it < I_IN + 3 * I_SQ + I_Q; it += ngw) {
    int r = it;
    if (r < I_IN) { transpose_item<true>(p.w_in, NIN, 1024, (bf16*)(p.ws + OFF_WT_IN), r, 224, scr, lane); continue; }
    r -= I_IN;
    if (r < I_SQ) { transpose_item<false>(p.w_a, 1024, 1024, (bf16*)(p.ws + OFF_WT_A), r, 32, scr, lane); continue; }
    r -= I_SQ;
    if (r < I_SQ) { transpose_item<false>(p.w_b, 1024, 1024, (bf16*)(p.ws + OFF_WT_B), r, 32, scr, lane); continue; }
    r -= I_SQ;
    if (r < I_SQ) { transpose_item<false>(p.w_out, 1024, 1024, (bf16*)(p.ws + OFF_WT_OUT), r, 32, scr, lane); continue; }
    r -= I_SQ;
    transpose_item<false>(p.w_q, 2048, 1024, (bf16*)(p.ws + OFF_WT_Q), r, 64, scr, lane);
  }
}


struct EpiIn {
  static constexpr bool PERM = true, AFTER_DRAIN = false;
  char* ws; float* out;
  __device__ __forceinline__ void operator()(const f32x4 (&acc)[2][2][4][2], const Unit& u, int wr, int wc, int fr, int fq) const {
    const int pn = u.pn;
    const int row0 = u.pm * 256 + wr * 64 + fr, cl0 = wc * 32 + 8 * fq;
    if (pn == 12) {
      bf16* dst = (bf16*)(ws + OFF_CKV);
      float* ssp = (float*)(ws + OFF_SSP);
#pragma unroll
      for (int ai = 0; ai < 2; ++ai)
#pragma unroll
        for (int m = 0; m < 4; ++m) {
          const size_t row = row0 + ai * 128 + m * 16;
          float ss = 0.f;
#pragma unroll
          for (int bj = 0; bj < 2; ++bj) {
            const f32x4 v0 = acc[ai][bj][m][0], v1 = acc[ai][bj][m][1];
            ss += (v0[0] * v0[0] + v0[1] * v0[1]) + (v0[2] * v0[2] + v0[3] * v0[3]) + (v1[0] * v1[0] + v1[1] * v1[1]) + (v1[2] * v1[2] + v1[3] * v1[3]);
            u32x4 w; w.x = cvt_pk_bf16(v0[0], v0[1]); w.y = cvt_pk_bf16(v0[2], v0[3]); w.z = cvt_pk_bf16(v1[0], v1[1]); w.w = cvt_pk_bf16(v1[2], v1[3]);
            *(u32x4*)(dst + row * 256 + cl0 + bj * 128) = w;
          }
          ss += __shfl_xor(ss, 16); ss += __shfl_xor(ss, 32);
          if (fq == 0) ssp[row * 4 + wc] = ss;
        }
    } else if (pn == 15) {
      bf16* IK = (bf16*)(ws + OFF_IK);
      float* IW = (float*)(ws + OFF_IW);
      float* GLOW = (float*)(ws + OFF_GLOW);
#pragma unroll
      for (int ai = 0; ai < 2; ++ai)
#pragma unroll
        for (int m = 0; m < 4; ++m) {
          const size_t row = row0 + ai * 128 + m * 16;
          const int cl = cl0;
          const f32x4 v0 = acc[ai][0][m][0], v1 = acc[ai][0][m][1];
          if (cl < 64) {
            u32x4 w; w.x = cvt_pk_bf16(v0[0], v0[1]); w.y = cvt_pk_bf16(v0[2], v0[3]); w.z = cvt_pk_bf16(v1[0], v1[1]); w.w = cvt_pk_bf16(v1[2], v1[3]);
            *(u32x4*)(IK + row * 64 + cl) = w;
          } else if (cl < 72) {
            *(f32x4*)(IW + row * 8) = v0 * 0.35355339059327373f;
            *(f32x4*)(IW + row * 8 + 4) = v1 * 0.35355339059327373f;
          } else if (cl < 88) {
            *(f32x4*)(GLOW + row * 16 + (cl - 72)) = v0;
            *(f32x4*)(GLOW + row * 16 + (cl - 72) + 4) = v1;
          }
        }
    } else {
      bf16* dst; int ld; float scale = 1.f; int act = 0; int coff;
      if (pn < 2) { dst = (bf16*)(ws + OFF_Q); ld = 512; coff = pn * 256; scale = 0.08838834764831845f; }
      else if (pn < 4) { dst = (bf16*)(ws + OFF_K); ld = 512; coff = (pn - 2) * 256; }
      else if (pn < 8) { dst = (bf16*)(ws + OFF_V); ld = 1024; coff = (pn - 4) * 256; }
      else if (pn < 12) { dst = (bf16*)(ws + OFF_DQ); ld = 1024; coff = (pn - 8) * 256; }
      else if (pn < 15) { dst = (bf16*)(ws + OFF_IQ); ld = 512; coff = (pn - 13) * 256; scale = 0.125f; }
      else if (pn < 20) { dst = (bf16*)(ws + OFF_SGR); ld = 1024; coff = (pn - 16) * 256; act = 1; }
      else if (pn < 24) { dst = (bf16*)out; ld = 1024; coff = (pn - 20) * 256; act = 2; }
      else { dst = (bf16*)out + (size_t)TT * 1024; ld = 1024; coff = (pn - 24) * 256; act = 2; }
#pragma unroll
      for (int ai = 0; ai < 2; ++ai)
#pragma unroll
        for (int m = 0; m < 4; ++m) {
          bf16* rowp = dst + (size_t)(row0 + ai * 128 + m * 16) * ld + coff + cl0;
#pragma unroll
          for (int bj = 0; bj < 2; ++bj) {
            f32x4 v0 = acc[ai][bj][m][0] * scale, v1 = acc[ai][bj][m][1] * scale;
            if (act == 1) {
#pragma unroll
              for (int j = 0; j < 4; ++j) { v0[j] = siluf_(v0[j]); v1[j] = siluf_(v1[j]); }
            } else if (act == 2) {
#pragma unroll
              for (int j = 0; j < 4; ++j) { v0[j] = sigmoidf_(v0[j]); v1[j] = sigmoidf_(v1[j]); }
            }
            u32x4 w; w.x = cvt_pk_bf16(v0[0], v0[1]); w.y = cvt_pk_bf16(v0[2], v0[3]); w.z = cvt_pk_bf16(v1[0], v1[1]); w.w = cvt_pk_bf16(v1[2], v1[3]);
            *(u32x4*)(rowp + bj * 128) = w;
          }
        }
    }
  }
};

template <bool ADD> struct EpiMix {
  static constexpr bool PERM = true, AFTER_DRAIN = false;
  const bf16* SZ; bf16* MIX;
  __device__ __forceinline__ void operator()(const f32x4 (&acc)[2][2][4][2], const Unit& u, int wr, int wc, int fr, int fq) const {
    const int row0 = u.pm * 256 + wr * 64 + fr, col0 = u.pn * 256 + wc * 32 + 8 * fq;
#pragma unroll
    for (int ai = 0; ai < 2; ++ai)
#pragma unroll
      for (int m = 0; m < 4; ++m)
#pragma unroll
        for (int bj = 0; bj < 2; ++bj) {
          const size_t idx = (size_t)(row0 + ai * 128 + m * 16) * 1024 + col0 + bj * 128;
          const u32x4 s = *(const u32x4*)(SZ + idx);
          f32x4 v0 = acc[ai][bj][m][0], v1 = acc[ai][bj][m][1];
          v0[0] *= bflo(s.x); v0[1] *= bfhi(s.x); v0[2] *= bflo(s.y); v0[3] *= bfhi(s.y);
          v1[0] *= bflo(s.z); v1[1] *= bfhi(s.z); v1[2] *= bflo(s.w); v1[3] *= bfhi(s.w);
          if (ADD) {
            const u32x4 o = *(const u32x4*)(MIX + idx);
            v0[0] += bflo(o.x); v0[1] += bfhi(o.x); v0[2] += bflo(o.y); v0[3] += bfhi(o.y);
            v1[0] += bflo(o.z); v1[1] += bfhi(o.z); v1[2] += bflo(o.w); v1[3] += bfhi(o.w);
          }
          u32x4 w; w.x = cvt_pk_bf16(v0[0], v0[1]); w.y = cvt_pk_bf16(v0[2], v0[3]); w.z = cvt_pk_bf16(v1[0], v1[1]); w.w = cvt_pk_bf16(v1[2], v1[3]);
          *(u32x4*)(MIX + idx) = w;
        }
  }
};

struct EpiX1 {
  static constexpr bool PERM = true, AFTER_DRAIN = false;
  const float* x; const float* ada; float* out;
  __device__ __forceinline__ void operator()(const f32x4 (&acc)[2][2][4][2], const Unit& u, int wr, int wc, int fr, int fq) const {
    const int row0 = u.pm * 256 + wr * 64 + fr, col0 = u.pn * 256 + wc * 32 + 8 * fq;
    const int b = (u.pm * 256) >> 12;
    f32x4 g[2][2];
#pragma unroll
    for (int bj = 0; bj < 2; ++bj) {
      g[bj][0] = *(const f32x4*)(ada + b * 6144 + 2048 + col0 + bj * 128);
      g[bj][1] = *(const f32x4*)(ada + b * 6144 + 2048 + col0 + bj * 128 + 4);
    }
#pragma unroll
    for (int ai = 0; ai < 2; ++ai)
#pragma unroll
      for (int m = 0; m < 4; ++m)
#pragma unroll
        for (int bj = 0; bj < 2; ++bj) {
          const size_t idx = (size_t)(row0 + ai * 128 + m * 16) * 1024 + col0 + bj * 128;
          const f32x4 x0 = *(const f32x4*)(x + idx), x1 = *(const f32x4*)(x + idx + 4);
          *(f32x4*)(out + idx) = x0 + g[bj][0] * acc[ai][bj][m][0];
          *(f32x4*)(out + idx + 4) = x1 + g[bj][1] * acc[ai][bj][m][1];
        }
  }
};

struct EpiPlain {
  static constexpr bool PERM = true, AFTER_DRAIN = false;
  bf16* O; int ld;
  __device__ __forceinline__ void operator()(const f32x4 (&acc)[2][2][4][2], const Unit& u, int wr, int wc, int fr, int fq) const {
    const int row0 = u.pm * 256 + wr * 64 + fr, col0 = u.pn * 256 + wc * 32 + 8 * fq;
#pragma unroll
    for (int ai = 0; ai < 2; ++ai)
#pragma unroll
      for (int m = 0; m < 4; ++m)
#pragma unroll
        for (int bj = 0; bj < 2; ++bj) {
          const f32x4 v0 = acc[ai][bj][m][0], v1 = acc[ai][bj][m][1];
          u32x4 w; w.x = cvt_pk_bf16(v0[0], v0[1]); w.y = cvt_pk_bf16(v0[2], v0[3]); w.z = cvt_pk_bf16(v1[0], v1[1]); w.w = cvt_pk_bf16(v1[2], v1[3]);
          *(u32x4*)(O + (size_t)(row0 + ai * 128 + m * 16) * ld + col0 + bj * 128) = w;
        }
  }
};

template <class Epi>
__device__ __forceinline__ void gemm_run(LAS unsigned char* lds, const bf16* A, const bf16* Bt, int M, int N, int K, const Epi& E) {
  pg8::Gemm g{A, Bt, M, N, K};
  pg8::StaticOrder S;
  S.init(M, N, gridDim.x, blockIdx.x);
  pg8::gemm_phase<Epi, pg8::StaticOrder, false>(lds, g, S, E, nullptr);
}

typedef short bf16x8_t __attribute__((ext_vector_type(8)));
typedef __bf16 bf16x2_t __attribute__((ext_vector_type(2)));
__device__ __forceinline__ float dot2bf(unsigned a, unsigned b, float acc) {
  return __builtin_amdgcn_fdot2_f32_bf16(__builtin_bit_cast(bf16x2_t, a), __builtin_bit_cast(bf16x2_t, b), acc, false);
}
__device__ __forceinline__ void wave_lds_fence() { asm volatile("s_waitcnt lgkmcnt(0)" ::: "memory"); }
template <int N> __device__ __forceinline__ float row_ror(float x) {
  return __int_as_float(__builtin_amdgcn_update_dpp(0, __float_as_int(x), 0x120 + N, 0xf, 0xf, false));
}
__device__ __forceinline__ float row16_max(float m) {
  m = fmaxf(m, row_ror<8>(m)); m = fmaxf(m, row_ror<4>(m)); m = fmaxf(m, row_ror<2>(m)); m = fmaxf(m, row_ror<1>(m));
  return m;
}
__device__ __forceinline__ float row16_sum(float m) {
  m += row_ror<8>(m); m += row_ror<4>(m); m += row_ror<2>(m); m += row_ror<1>(m);
  return m;
}
__device__ __forceinline__ float wave_sum_dpp(float s) {
  s = row16_sum(s);
  const int si = __float_as_int(s);
  return __int_as_float(__builtin_amdgcn_readlane(si, 0)) + __int_as_float(__builtin_amdgcn_readlane(si, 16)) +
         (__int_as_float(__builtin_amdgcn_readlane(si, 32)) + __int_as_float(__builtin_amdgcn_readlane(si, 48)));
}
__device__ __forceinline__ constexpr int cand_i(int L) {
  return L < 16 ? 0 : L < 24 ? 1 : L < 29 ? 2 : L < 33 ? 3 : L < 36 ? 4 : L < 38 ? 5 : L < 40 ? 6 : L < 42 ? 7 : (L - 42 + 8);
}
__device__ __forceinline__ constexpr int cand_j(int L) {
  return L < 16 ? L : L < 24 ? L - 16 : L < 29 ? L - 24 : L < 33 ? L - 29 : L < 36 ? L - 33 : L < 38 ? L - 36 : L < 40 ? L - 38 : L < 42 ? L - 40 : 0;
}
template <int K> struct CandRank {
  static __device__ __forceinline__ void run(int vi, float val, int myflat, int& rank) {
    const float o = __int_as_float(__builtin_amdgcn_readlane(vi, K));
    rank += ((o > val) || (o == val && K < myflat)) ? 1 : 0;
    CandRank<K + 1>::run(vi, val, myflat, rank);
  }
};
template <> struct CandRank<50> { static __device__ __forceinline__ void run(int, float, int, int&) {} };

__device__ __forceinline__ float gelu_exact(float v) { return 0.5f * v * (1.f + erff(v * 0.7071067811865476f)); }

typedef float f32x2_t __attribute__((ext_vector_type(2)));
#define PEER_NB 6
#define PEER_LOAD(buf, TAB, e0)                                                                   \
  _Pragma("unroll") for (int j = 0; j < PEER_NB; ++j) {                                                 \
    const int e = ((e0) + j < 128) ? __builtin_amdgcn_readfirstlane((int)ridx[tt * 128 + (e0) + j]) : 0;   \
    buf[j] = *(const u32x4_t*)((TAB) + (size_t)e * 1024 + lane * 16);                             \
  }
#define PEER_UDOT(buf, e0)                                                                        \
  _Pragma("unroll") for (int j = 0; j < PEER_NB; ++j) {                                                 \
    float s0 = 0.f, s1 = 0.f;                                                                     \
    _Pragma("unroll") for (int w = 0; w < 4; ++w) {                                               \
      const f32x2_t lo = __builtin_amdgcn_cvt_pk_f32_fp8((int)buf[j][w], false);                  \
      const f32x2_t hi = __builtin_amdgcn_cvt_pk_f32_fp8((int)buf[j][w], true);                   \
      s0 += lo.x * hf[4 * w] + hi.x * hf[4 * w + 2];                                              \
      s1 += lo.y * hf[4 * w + 1] + hi.y * hf[4 * w + 3];                                          \
    }                                                                                             \
    const float s = wave_sum_dpp(s0 + s1);                                                        \
    const int ee = (e0) + j;                                                                      \
    if (ee < 64) dotA = (lane == ee) ? s : dotA; else if (ee < 128) dotB = (lane == ee - 64) ? s : dotB; \
    __builtin_amdgcn_sched_barrier(0);                                                           \
  }
#define PEER_VACC(buf, e0)                                                                        \
  _Pragma("unroll") for (int j = 0; j < PEER_NB; ++j) {                                                 \
    const int ee = (e0) + j;                                                                      \
    const float a = (ee < 128) ? __int_as_float(__builtin_amdgcn_readlane(__float_as_int(ee < 64 ? aA : aB), ee & 63)) : 0.f; \
    _Pragma("unroll") for (int w = 0; w < 4; ++w) {                                               \
      const f32x2_t lo = __builtin_amdgcn_cvt_pk_f32_fp8((int)buf[j][w], false);                  \
      const f32x2_t hi = __builtin_amdgcn_cvt_pk_f32_fp8((int)buf[j][w], true);                   \
      acc[4 * w] += a * lo.x; acc[4 * w + 1] += a * lo.y; acc[4 * w + 2] += a * hi.x; acc[4 * w + 3] += a * hi.y; \
    }                                                                                             \
    __builtin_amdgcn_sched_barrier(0);                                                           \
  }

__device__ __forceinline__ void ph_peer512(const P& p, unsigned char* lds_raw, float* dst_base) {
  const int tid = tid_fresh(), wave = tid >> 6, lane = tid & 63, g = lane >> 4, c = lane & 15;
  const bf16* PQ = (const bf16*)(p.ws + OFF_PQ);
  const bf16* SK = (const bf16*)(p.ws + OFF_SK);
  float* tv = (float*)(lds_raw + wave * 16384);
  int* ti = (int*)(tv + 512);
  float* rgate = (float*)(ti + 512);
  unsigned short* ridx = (unsigned short*)(rgate + 2048);
  for (int tile = blockIdx.x * 8 + wave; tile < TT / 16; tile += gridDim.x * 8) {
    const int tok0 = tile * 16;
#pragma unroll 1
    for (int hd = 0; hd < 8; ++hd) {
#pragma unroll 1
      for (int hf = 0; hf < 2; ++hf) {
        f32x4 acc[8];
#pragma unroll
        for (int nt = 0; nt < 8; ++nt) acc[nt] = (f32x4){0.f, 0.f, 0.f, 0.f};
#pragma unroll
        for (int ks = 0; ks < 4; ++ks) {
          const bf16x8_t a = *(const bf16x8_t*)(PQ + (size_t)(tok0 + c) * 2048 + hd * 256 + hf * 128 + ks * 32 + 8 * g);
#pragma unroll
          for (int nt = 0; nt < 8; ++nt) {
            const bf16x8_t b = *(const bf16x8_t*)(SK + hf * 16384 + (nt * 16 + c) * 128 + ks * 32 + 8 * g);
            acc[nt] = __builtin_amdgcn_mfma_f32_16x16x32_bf16(a, b, acc[nt], 0, 0, 0);
          }
        }
#pragma unroll
        for (int i = 0; i < 4; ++i) {
          float v[8];
#pragma unroll
          for (int nt = 0; nt < 8; ++nt) v[nt] = acc[nt][i];
          const int row = 4 * g + i;
#pragma unroll 1
          for (int r = 0; r < 16; ++r) {
            const float m = fmaxf(fmaxf(fmaxf(v[0], v[1]), fmaxf(v[2], v[3])), fmaxf(fmaxf(v[4], v[5]), fmaxf(v[6], v[7])));
            const float gm = row16_max(m);
            const unsigned long long bal = __ballot(m == gm);
            const unsigned gb = (unsigned)(bal >> (16 * g)) & 0xffffu;
            const bool win = (c == (__ffs(gb) - 1));
            int sel = -1;
#pragma unroll
            for (int nt = 0; nt < 8; ++nt) {
              const bool hit = win && (sel < 0) && (v[nt] == gm);
              sel = hit ? nt : sel;
              v[nt] = hit ? -INFINITY : v[nt];
            }
            if (win) { tv[(hf * 16 + row) * 16 + r] = gm; ti[(hf * 16 + row) * 16 + r] = sel * 16 + c; }
          }
        }
      }
      wave_lds_fence();
      const int ci = cand_i(lane < 50 ? lane : 0), cj = cand_j(lane < 50 ? lane : 0);
      const int myflat = ci * 16 + cj;
#pragma unroll 1
      for (int row = 0; row < 16; ++row) {
        const float val = (lane < 50) ? (tv[row * 16 + ci] + tv[(16 + row) * 16 + cj]) : -INFINITY;
        int rank = 0;
        int lane_l = lane; asm volatile("" : "+v"(lane_l));
        CandRank<0>::run(__float_as_int(val), val, lane_l, rank);
        if (lane < 50 && rank < 16) {
          rgate[row * 128 + hd * 16 + rank] = val;
          ridx[row * 128 + hd * 16 + rank] = (unsigned short)(ti[row * 16 + ci] * 128 + ti[(16 + row) * 16 + cj]);
        }
      }
      wave_lds_fence();
      {
        const int row = lane >> 2, q = lane & 3;
        float* gp = rgate + row * 128 + hd * 16;
        const float mx = gp[0];
        const f32x4 b4 = *(const f32x4*)(gp + q * 4);
        f32x4 e4;
        e4[0] = __expf(b4[0] - mx); e4[1] = __expf(b4[1] - mx); e4[2] = __expf(b4[2] - mx); e4[3] = __expf(b4[3] - mx);
        float s = (e4[0] + e4[1]) + (e4[2] + e4[3]);
        s += __shfl_xor(s, 1); s += __shfl_xor(s, 2);
        const float inv = 1.f / s;
        wave_lds_fence();
        *(f32x4*)(gp + q * 4) = e4 * inv;
      }
      wave_lds_fence();
    }
    char* wsl = p.ws;
    asm volatile("" : "+s"(wsl));
    const bf16* H2 = (const bf16*)(wsl + OFF_H);
    const unsigned char* PU = (const unsigned char*)(wsl + OFF_PU);
    const unsigned char* PV = (const unsigned char*)(wsl + OFF_PV);
    const float* USC = (const float*)(wsl + OFF_PSC);
    const float* VSC = USC + 16384;
    const float* ada = (const float*)(wsl + OFF_ADA);
#pragma unroll 1
    for (int tt = 0; tt < 16; ++tt) {
      const int tidx = tid_fresh(), lane = tidx & 63, wv = __builtin_amdgcn_readfirstlane(tidx >> 6);
      const float* rgate = (const float*)(lds_raw + wv * 16384 + 4096);
      const unsigned short* ridx = (const unsigned short*)(lds_raw + wv * 16384 + 4096 + 8192);
      const size_t tok = (size_t)tok0 + tt;
      float hf[16];
      {
        const u32x4_t h0 = *(const u32x4_t*)(H2 + tok * 1024 + lane * 16), h1 = *(const u32x4_t*)(H2 + tok * 1024 + lane * 16 + 8);
#pragma unroll
        for (int w = 0; w < 4; ++w) { hf[2 * w] = bflo(h0[w]); hf[2 * w + 1] = bfhi(h0[w]); hf[8 + 2 * w] = bflo(h1[w]); hf[8 + 2 * w + 1] = bfhi(h1[w]); }
      }
      const int eA = (int)ridx[tt * 128 + lane], eB = (int)ridx[tt * 128 + 64 + lane];
      const float usA = USC[eA], usB = USC[eB];
      float dotA = 0.f, dotB = 0.f;
      u32x4_t a0[PEER_NB], a1[PEER_NB];
#define PSB() __builtin_amdgcn_sched_barrier(0)
#define PEER_ROWS (((128 + 2 * PEER_NB - 1) / (2 * PEER_NB)) * 2 * PEER_NB)
      PEER_LOAD(a0, PU, 0); PSB();
      PEER_LOAD(a1, PU, PEER_NB); PSB();
#pragma unroll 1
      for (int e0 = 0; e0 < PEER_ROWS; e0 += 2 * PEER_NB) {
        PEER_UDOT(a0, e0); PSB();
        if (e0 + 2 * PEER_NB < PEER_ROWS) { PEER_LOAD(a0, PU, e0 + 2 * PEER_NB); } else { PEER_LOAD(a0, PV, 0); }
        PSB();
        PEER_UDOT(a1, e0 + PEER_NB); PSB();
        if (e0 + 3 * PEER_NB < PEER_ROWS) { PEER_LOAD(a1, PU, e0 + 3 * PEER_NB); } else { PEER_LOAD(a1, PV, PEER_NB); }
        PSB();
      }
      const float aA = gelu_exact(dotA * usA) * rgate[tt * 128 + lane] * VSC[(int)ridx[tt * 128 + lane]],
                  aB = gelu_exact(dotB * usB) * rgate[tt * 128 + 64 + lane] * VSC[(int)ridx[tt * 128 + 64 + lane]];
      float acc[16];
#pragma unroll
      for (int k = 0; k < 16; ++k) acc[k] = 0.f;
      PSB();
#pragma unroll 1
      for (int e0 = 0; e0 < PEER_ROWS; e0 += 2 * PEER_NB) {
        PEER_VACC(a0, e0); PSB();
        if (e0 + 2 * PEER_NB < PEER_ROWS) { PEER_LOAD(a0, PV, e0 + 2 * PEER_NB); }
        PSB();
        PEER_VACC(a1, e0 + PEER_NB); PSB();
        if (e0 + 3 * PEER_NB < PEER_ROWS) { PEER_LOAD(a1, PV, e0 + 3 * PEER_NB); }
        PSB();
      }
#undef PSB
      const int b = (int)(tok >> 12);
      const float* xrow = p.out + tok * 1024;
      float* orow = dst_base + tok * 1024;
      const float* g2 = ada + b * 6144 + 5120;
      float x2[16];
      float ss = 0.f;
#pragma unroll
      for (int q = 0; q < 4; ++q) {
        const int col = lane * 16 + q * 4;
        const f32x4 xv = *(const f32x4*)(xrow + col), gv = *(const f32x4*)(g2 + col);
#pragma unroll
        for (int k = 0; k < 4; ++k) { const float t = xv[k] + gv[k] * acc[q * 4 + k]; x2[q * 4 + k] = t; ss += t * t; }
      }
      ss = wave_sum_dpp(ss);
      const float rstd = rsqrtf(ss * (1.f / 1024.f) + 1e-6f);
#pragma unroll
      for (int q = 0; q < 4; ++q) {
        const int col = lane * 16 + q * 4;
        const f32x4 fg = *(const f32x4*)((const float*)(wsl + OFF_PRM) + PRM_FG + col);
        f32x4 o;
#pragma unroll
        for (int k = 0; k < 4; ++k) o[k] = x2[q * 4 + k] * rstd * fg[k];
        *(f32x4*)(orow + col) = o;
      }
    }
    wave_lds_fence();
  }
}

#define DS_KEY16   0
#define DS_CHUNK   17408
#define DS_SEL     139264
#define DS_WAVE    147456
#define DS_TOTAL   155648
#define DS_RS      544

__device__ __forceinline__ unsigned f2ord(float f) {
  if (f == 0.f) f = 0.f;
  unsigned u = __float_as_uint(f);
  return (u & 0x80000000u) ? ~u : (u | 0x80000000u);
}
__device__ __forceinline__ int wave_scan_incl(int v, int lane) {
#pragma unroll
  for (int o = 1; o < 64; o <<= 1) { const int t = __shfl_up(v, o); v += (lane >= o) ? t : 0; }
  return v;
}
__device__ __forceinline__ void find_digit(const LAS unsigned* hist, int K, int lane, int& digit, int& above) {
  const u32x4_t h4 = *(const LAS u32x4_t*)(hist + 252 - 4 * lane);
  const int c0 = (int)h4.w, c1 = (int)h4.z, c2 = (int)h4.y, c3 = (int)h4.x;
  const int tot = c0 + c1 + c2 + c3;
  int run = wave_scan_incl(tot, lane) - tot;
  int found = -1, ab = 0;
  if (run < K && run + c0 >= K) { found = 255 - 4 * lane; ab = run; } run += c0;
  if (run < K && run + c1 >= K) { found = 254 - 4 * lane; ab = run; } run += c1;
  if (run < K && run + c2 >= K) { found = 253 - 4 * lane; ab = run; } run += c2;
  if (run < K && run + c3 >= K) { found = 252 - 4 * lane; ab = run; }
  const unsigned long long mk = __ballot(found >= 0);
  const int src = (int)__ffsll((unsigned long long)mk) - 1;
  digit = __builtin_amdgcn_readlane(found, src);
  above = __builtin_amdgcn_readlane(ab, src);
}

__device__ __forceinline__ s16x4_t tr_read_b64(unsigned addr) {
  s16x4_t r; asm volatile("ds_read_b64_tr_b16 %0, %1" : "=&v"(r) : "v"(addr) : "memory"); return r;
}

#ifndef PROBE_DSA
#define PROBE_DSA 0
#endif
#if PROBE_DSA
#define DSA_MARK(k) do { const unsigned long long n_ = __builtin_amdgcn_s_memrealtime(); if (PROBE_DSA == (k)) { const unsigned long long q_ = n_ - tmark; \
    while (__builtin_amdgcn_s_memrealtime() - n_ < q_) __builtin_amdgcn_s_sleep(2); } tmark = __builtin_amdgcn_s_memrealtime(); } while (0)
#else
#define DSA_MARK(k) do {} while (0)
#endif
__device__ __forceinline__ void dsa_batch(const P& p, unsigned char* lds_raw, int b, int pos) {
  const int t0 = pos * 16;
#define DSA_IDS const int tid = tid_fresh(), wave = __builtin_amdgcn_readfirstlane(tid >> 6), lane = tid & 63, g = lane >> 4, c = lane & 15; (void)wave; (void)g; (void)c;
  const size_t tokb = (size_t)b * SEQ, tok0 = tokb + t0;
  const bf16* DQ = (const bf16*)(p.ws + OFF_DQ);
  const bf16* CKV = (const bf16*)(p.ws + OFF_CKV);
  const float* SSP = (const float*)(p.ws + OFF_SSP);
  const bf16* IQ = (const bf16*)(p.ws + OFF_IQ);
  const bf16* IK = (const bf16*)(p.ws + OFF_IK);
  const float* IW = (const float*)(p.ws + OFF_IW);
  const bf16* WUK = (const bf16*)(p.ws + OFF_WUK);
  const bf16* WUV = (const bf16*)(p.ws + OFF_WUV);
  bf16* ODSA = (bf16*)(p.ws + OFF_ODSA);
  bf16* QL = (bf16*)(p.ws + OFF_DSCR + (size_t)blockIdx.x * 65536);
  bf16* OL = QL;
  LAS unsigned char* lds = (LAS unsigned char*)lds_raw;
  LAS unsigned short* key16 = (LAS unsigned short*)(lds + DS_KEY16);
  LAS unsigned short* sel = (LAS unsigned short*)(lds + DS_SEL);

#if PROBE_DSA
  unsigned long long tmark = __builtin_amdgcn_s_memrealtime();
#endif
  {
    DSA_IDS
    const int h = wave;
    bf16x8_t dqf[4];
#pragma unroll
    for (int ks = 0; ks < 4; ++ks) dqf[ks] = *(const bf16x8_t*)(DQ + (tok0 + c) * 1024 + h * 128 + ks * 32 + 8 * g);
#pragma unroll 8
    for (int nt = 0; nt < 16; ++nt) {
      f32x4 a = (f32x4){0.f, 0.f, 0.f, 0.f};
#pragma unroll
      for (int ks = 0; ks < 4; ++ks) {
        const bf16x8_t wf = *(const bf16x8_t*)(WUK + (size_t)(h * 256 + nt * 16 + c) * 128 + ks * 32 + 8 * g);
        a = __builtin_amdgcn_mfma_f32_16x16x32_bf16(wf, dqf[ks], a, 0, 0, 0);
      }
      uint2 o; o.x = pk2(a[0], a[1]); o.y = pk2(a[2], a[3]);
      *(uint2*)(QL + c * 2048 + h * 256 + nt * 16 + 4 * g) = o;
    }
  }
  DSA_MARK(1);
  if (t0 >= 256) {
    DSA_IDS
    bf16x8_t qf[8][2];
    float iw[8];
#pragma unroll
    for (int h = 0; h < 8; ++h) {
      qf[h][0] = *(const bf16x8_t*)(IQ + (tok0 + c) * 512 + h * 64 + 8 * g);
      qf[h][1] = *(const bf16x8_t*)(IQ + (tok0 + c) * 512 + h * 64 + 32 + 8 * g);
      iw[h] = IW[(tok0 + c) * 8 + h];
    }
    const int ntile = pos + 1;
    bf16x8_t k0n = (bf16x8_t){0, 0, 0, 0, 0, 0, 0, 0}, k1n = k0n;
    if (wave < ntile) { const bf16* kr = IK + (tokb + wave * 16 + c) * 64 + 8 * g; k0n = *(const bf16x8_t*)kr; k1n = *(const bf16x8_t*)(kr + 32); }
    for (int kt = wave; kt < ntile; kt += 8) {
      const bf16x8_t k0 = k0n, k1 = k1n;
      if (kt + 8 < ntile) { const bf16* kr = IK + (tokb + (kt + 8) * 16 + c) * 64 + 8 * g; k0n = *(const bf16x8_t*)kr; k1n = *(const bf16x8_t*)(kr + 32); }
      f32x4 sc = (f32x4){0.f, 0.f, 0.f, 0.f};
#pragma unroll
      for (int h = 0; h < 8; ++h) {
        f32x4 d = __builtin_amdgcn_mfma_f32_16x16x32_bf16(k0, qf[h][0], (f32x4){0.f, 0.f, 0.f, 0.f}, 0, 0, 0);
        d = __builtin_amdgcn_mfma_f32_16x16x32_bf16(k1, qf[h][1], d, 0, 0, 0);
#pragma unroll
        for (int i = 0; i < 4; ++i) sc[i] += iw[h] * fmaxf(d[i], 0.f);
      }
      u16x4_t o;
      const int sb = kt * 16 + 4 * g, tq = t0 + c;
      o.x = (sb + 0 <= tq) ? (unsigned short)(f2ord(sc[0]) >> 16) : (unsigned short)0;
      o.y = (sb + 1 <= tq) ? (unsigned short)(f2ord(sc[1]) >> 16) : (unsigned short)0;
      o.z = (sb + 2 <= tq) ? (unsigned short)(f2ord(sc[2]) >> 16) : (unsigned short)0;
      o.w = (sb + 3 <= tq) ? (unsigned short)(f2ord(sc[3]) >> 16) : (unsigned short)0;
      *(LAS u16x4_t*)(key16 + c * 4096 + sb) = o;
    }
  }
  DSA_MARK(2);
  __syncthreads();
#pragma unroll 1
  for (int qq = 0; qq < 2; ++qq) {
    DSA_IDS
    const int q = wave + 8 * qq, t = t0 + q;
    LAS unsigned short* selq = sel + q * 256;
    if (t < 256) {
      for (int j = lane; j < 256; j += 64) selq[j] = (unsigned short)((j <= t) ? j : 0);
    } else {
      const LAS unsigned short* kq = key16 + q * 4096;
      unsigned kk[8][8];
#pragma unroll
      for (int it = 0; it < 8; ++it) {
        const int s0 = 512 * it + 8 * lane;
        u32x4_t v = (u32x4_t){0u, 0u, 0u, 0u};
        if (s0 <= t) v = *(const LAS u32x4_t*)(kq + s0);
#pragma unroll
        for (int j = 0; j < 4; ++j) {
          kk[it][2 * j] = (s0 + 2 * j <= t) ? (v[j] & 0xffffu) : 0u;
          kk[it][2 * j + 1] = (s0 + 2 * j + 1 <= t) ? (v[j] >> 16) : 0u;
        }
      }
      unsigned B = 0u;
#pragma unroll 1
      for (int bit = 15; bit >= 0; --bit) {
        const unsigned cand = B | (1u << bit);
        int cnt = 0;
#pragma unroll
        for (int it = 0; it < 8; ++it)
#pragma unroll
          for (int j = 0; j < 8; ++j) cnt += (kk[it][j] >= cand) ? 1 : 0;
        const int tot = (int)wave_sum_dpp((float)cnt);
        if (tot >= 256) B = cand;
      }
      int cgt = 0;
#pragma unroll
      for (int it = 0; it < 8; ++it)
#pragma unroll
        for (int j = 0; j < 8; ++j) cgt += (kk[it][j] > B) ? 1 : 0;
      const int m = 256 - (int)wave_sum_dpp((float)cgt);
      int ceq[8], eqi[8];
#pragma unroll
      for (int it = 0; it < 8; ++it) {
        int c0 = 0;
#pragma unroll
        for (int j = 0; j < 8; ++j) c0 += (kk[it][j] == B) ? 1 : 0;
        ceq[it] = c0;
      }
#pragma unroll
      for (int it = 0; it < 8; ++it) eqi[it] = wave_scan_incl(ceq[it], lane);
      int ct[8], pi[8]; unsigned tmask[8];
      int eqbase = 0;
#pragma unroll
      for (int it = 0; it < 8; ++it) {
        int eqr = eqbase + eqi[it] - ceq[it];
        unsigned tm = 0u; int c1 = 0;
#pragma unroll
        for (int j = 0; j < 8; ++j) {
          const bool eq = kk[it][j] == B;
          const bool take = (kk[it][j] > B) || (eq && eqr < m);
          eqr += eq ? 1 : 0;
          tm |= take ? (1u << j) : 0u;
          c1 += take ? 1 : 0;
        }
        tmask[it] = tm; ct[it] = c1;
        eqbase += __builtin_amdgcn_readlane(eqi[it], 63);
      }
#pragma unroll
      for (int it = 0; it < 8; ++it) pi[it] = wave_scan_incl(ct[it], lane);
      int base = 0;
#pragma unroll
      for (int it = 0; it < 8; ++it) {
        int ps = base + pi[it] - ct[it];
#pragma unroll
        for (int j = 0; j < 8; ++j) {
          if ((tmask[it] >> j) & 1u) { if (ps < 256) selq[ps] = (unsigned short)(512 * it + 8 * lane + j); ++ps; }
        }
        base += __builtin_amdgcn_readlane(pi[it], 63);
      }
    }
  }
  DSA_MARK(3);
  __syncthreads();
  {
    DSA_IDS
    const int wave_b = wave;
    const float slope = (c < 8) ? exp2f(-(float)(c + 1)) : 0.f;
#pragma unroll 1
    for (int qq = 0; qq < 2; ++qq) {
      const int q = wave + 8 * qq, t = t0 + q;
      const int nsel = (t + 1 < 256) ? (t + 1) : 256, nch = (nsel + 31) >> 5;
      const LAS unsigned short* selq = sel + q * 256;
      bf16x8_t qf[8];
      {
        const int lq = tid_fresh() & 63;
        const bf16* qlp = QL + q * 2048 + (lq & 7) * 256 + 8 * (lq >> 4);
#pragma unroll
        for (int ks = 0; ks < 8; ++ks) qf[ks] = *(const bf16x8_t*)(qlp + ks * 32);
      }
      float mrun = -1e30f, lrun = 0.f;
      f32x4 o[16];
#pragma unroll
      for (int nt = 0; nt < 16; ++nt) o[nt] = (f32x4){0.f, 0.f, 0.f, 0.f};
      u32x4_t st[16];
      float st_r = 0.f, st_d = -1.f;
#define DSA_ISSUE(ch)                                                                                   \
      {                                                                                                 \
        _Pragma("unroll") for (int r = 0; r < 16; ++r) {                                                \
          const int j = (ch) * 32 + 2 * r + (lane >> 5);                                                \
          const int idx = (j < nsel) ? (int)selq[j] : 0;                                                \
          st[r] = *(const u32x4_t*)(CKV + (tokb + idx) * 256 + (lane & 31) * 8);                          \
        }                                                                                               \
        const int j2 = (ch) * 32 + (lane & 31);                                                         \
        const int idx2 = (j2 < nsel) ? (int)selq[j2] : 0;                                               \
        const float4 ss = *(const float4*)(SSP + (tokb + idx2) * 4);                                    \
        st_r = rsqrtf(((ss.x + ss.y) + (ss.z + ss.w)) * (1.f / 256.f) + 1e-6f);                         \
        st_d = (j2 < nsel) ? (float)(t - idx2) : -1.f;                                                  \
      }
      DSA_ISSUE(0);
#pragma unroll 1
      for (int ch = 0; ch < nch; ++ch) {
        const int lane = tid_fresh() & 63, g = lane >> 4, c = lane & 15;
        LAS unsigned char* buf = lds + DS_KEY16 + wave_b * DS_CHUNK;
        LAS float* kr = (LAS float*)(lds + DS_WAVE + wave_b * 1024);
        LAS float* kd = kr + 32;
        const unsigned vb = (unsigned)(uintptr_t)buf + (unsigned)((4 * g + (c >> 2)) * DS_RS + 8 * (c & 3));
#pragma unroll
        for (int r = 0; r < 16; ++r) *(LAS u32x4_t*)(buf + (2 * r + (lane >> 5)) * DS_RS + (lane & 31) * 16) = st[r];
        if (lane < 32) { kr[lane] = st_r; kd[lane] = st_d; }
        wave_lds_fence();
        DSA_MARK(11);
        f32x4 s0 = (f32x4){0.f, 0.f, 0.f, 0.f}, s1 = (f32x4){0.f, 0.f, 0.f, 0.f};
#pragma unroll
        for (int ks = 0; ks < 8; ++ks) {
          const bf16x8_t a0 = *(const LAS bf16x8_t*)(buf + c * DS_RS + (ks * 32 + 8 * g) * 2);
          const bf16x8_t a1 = *(const LAS bf16x8_t*)(buf + (16 + c) * DS_RS + (ks * 32 + 8 * g) * 2);
          s0 = __builtin_amdgcn_mfma_f32_16x16x32_bf16(a0, qf[ks], s0, 0, 0, 0);
          s1 = __builtin_amdgcn_mfma_f32_16x16x32_bf16(a1, qf[ks], s1, 0, 0, 0);
        }
        asm volatile("" :: "v"(s0[0]), "v"(s1[0]));
        DSA_MARK(12);
        if (ch + 1 < nch) DSA_ISSUE(ch + 1);
        const f32x4 r0 = *(const LAS f32x4*)(kr + 4 * g), r1 = *(const LAS f32x4*)(kr + 16 + 4 * g);
        const f32x4 d0 = *(const LAS f32x4*)(kd + 4 * g), d1 = *(const LAS f32x4*)(kd + 16 + 4 * g);
        float x[8];
#pragma unroll
        for (int i = 0; i < 4; ++i) {
          x[i] = (d0[i] < 0.f) ? -1e30f : (s0[i] * r0[i] - slope * d0[i]);
          x[4 + i] = (d1[i] < 0.f) ? -1e30f : (s1[i] * r1[i] - slope * d1[i]);
        }
        float mx = fmaxf(fmaxf(fmaxf(x[0], x[1]), fmaxf(x[2], x[3])), fmaxf(fmaxf(x[4], x[5]), fmaxf(x[6], x[7])));
        mx = fmaxf(mx, __shfl_xor(mx, 16)); mx = fmaxf(mx, __shfl_xor(mx, 32));
        const float mn = fmaxf(mrun, mx);
        const float alpha = __expf(mrun - mn);
        mrun = mn;
        float pr[8], ps = 0.f;
#pragma unroll
        for (int i = 0; i < 8; ++i) { pr[i] = (x[i] <= -1e29f) ? 0.f : __expf(x[i] - mn); ps += pr[i]; }
        ps += __shfl_xor(ps, 16); ps += __shfl_xor(ps, 32);
        lrun = lrun * alpha + ps;
#pragma unroll
        for (int nt = 0; nt < 16; ++nt) o[nt] *= alpha;
        union { bf16x8_t v; unsigned u[4]; } pf;
        pf.u[0] = pk2(pr[0] * r0[0], pr[1] * r0[1]); pf.u[1] = pk2(pr[2] * r0[2], pr[3] * r0[3]);
        pf.u[2] = pk2(pr[4] * r1[0], pr[5] * r1[1]); pf.u[3] = pk2(pr[6] * r1[2], pr[7] * r1[3]);
        asm volatile("" :: "v"(pf.u[0]));
        DSA_MARK(13);
#pragma unroll
        for (int nt = 0; nt < 16; nt += 4) {
          s16x4_t lo[4], hi[4];
#pragma unroll
          for (int u = 0; u < 4; ++u) { lo[u] = tr_read_b64(vb + (nt + u) * 32); hi[u] = tr_read_b64(vb + (nt + u) * 32 + 16 * DS_RS); }
          asm volatile("s_waitcnt lgkmcnt(0)" ::: "memory");
          __builtin_amdgcn_sched_barrier(0);
#pragma unroll
          for (int u = 0; u < 4; ++u) {
            const bf16x8_t af = (bf16x8_t){lo[u][0], lo[u][1], lo[u][2], lo[u][3], hi[u][0], hi[u][1], hi[u][2], hi[u][3]};
            o[nt + u] = __builtin_amdgcn_mfma_f32_16x16x32_bf16(af, pf.v, o[nt + u], 0, 0, 0);
          }
        }
        wave_lds_fence();
        asm volatile("" :: "v"(o[0][0]), "v"(o[15][0]));
        DSA_MARK(14);
      }
#undef DSA_ISSUE
      if (c < 8) {
        const float inv = 1.f / lrun;
#pragma unroll
        for (int nt = 0; nt < 16; ++nt) {
          uint2 w; w.x = pk2(o[nt][0] * inv, o[nt][1] * inv); w.y = pk2(o[nt][2] * inv, o[nt][3] * inv);
          *(uint2*)(OL + q * 2048 + c * 256 + nt * 16 + 4 * g) = w;
        }
      }
    }
  }
  DSA_MARK(4);
  __syncthreads();
  {
    DSA_IDS
    const int h = wave;
    bf16x8_t of[8];
#pragma unroll
    for (int ks = 0; ks < 8; ++ks) of[ks] = *(const bf16x8_t*)(OL + c * 2048 + h * 256 + ks * 32 + 8 * g);
#pragma unroll 4
    for (int nt = 0; nt < 8; ++nt) {
      f32x4 a = (f32x4){0.f, 0.f, 0.f, 0.f};
#pragma unroll
      for (int ks = 0; ks < 8; ++ks) {
        const bf16x8_t wf = *(const bf16x8_t*)(WUV + (size_t)(h * 128 + nt * 16 + c) * 256 + ks * 32 + 8 * g);
        a = __builtin_amdgcn_mfma_f32_16x16x32_bf16(wf, of[ks], a, 0, 0, 0);
      }
      uint2 w; w.x = pk2(a[0], a[1]); w.y = pk2(a[2], a[3]);
      *(uint2*)(ODSA + (tok0 + c) * 1024 + h * 128 + nt * 16 + 4 * g) = w;
    }
  }
  DSA_MARK(5);
  __syncthreads();
}

#undef DSA_IDS
__device__ __forceinline__ void ph_dsa512(const P& p, unsigned char* lds_raw) {
  for (int it = blockIdx.x; it < TT / 16; it += gridDim.x) {
    const int k = it >> 8, j = it & 255;
    dsa_batch(p, lds_raw, k, (k & 1) ? 255 - j : j);
  }
}

#define GL_QD    0
#define GL_KI    18432
#define GL_KE    36864
#define GL_V     55296
#define GL_AT    90112
#define GL_GLOW  99328
#define GL_QT    103424
#define GL_DEC   105472
#define GL_SSQ   105984
#define GL_LB    108032
#define GL_TOTAL 140800

#define GLA_BAR() do { asm volatile("s_waitcnt lgkmcnt(0)" ::: "memory"); __builtin_amdgcn_s_barrier(); asm volatile("" ::: "memory"); } while (0)
#ifndef PROBE_GLA
#define PROBE_GLA 0
#endif
#if PROBE_GLA
#define GLA_MARK(k) do { const unsigned long long n_ = __builtin_amdgcn_s_memrealtime(); if (PROBE_GLA == (k)) { const unsigned long long q_ = n_ - tmark; \
    while (__builtin_amdgcn_s_memrealtime() - n_ < q_) __builtin_amdgcn_s_sleep(2); } tmark = __builtin_amdgcn_s_memrealtime(); } while (0)
#else
#define GLA_MARK(k) do {} while (0)
#endif
__device__ __forceinline__ void gla_item(const P& p, unsigned char* lds_raw, int item) {
  int tid = tid_fresh();
  const int b = item >> 2, h = item & 3;
  const size_t tokb = (size_t)b * SEQ;
  const bf16* Qg = (const bf16*)(p.ws + OFF_Q);
  const bf16* Kg = (const bf16*)(p.ws + OFF_K);
  bf16* Vg = (bf16*)(p.ws + OFF_V);
  const float* GLOWg = (const float*)(p.ws + OFF_GLOW);
  const bf16* SGR = (const bf16*)(p.ws + OFF_SGR);
  LAS unsigned char* lds = (LAS unsigned char*)lds_raw;
  const unsigned lds0 = (unsigned)(uintptr_t)lds;
  LAS float* QT = (LAS float*)(lds + GL_QT);
  LAS float* DEC = (LAS float*)(lds + GL_DEC);
  LAS float* SSQ = (LAS float*)(lds + GL_SSQ);
  float wg[16];
  const float* prm = (const float*)(p.ws + OFF_PRM);
#pragma unroll
  for (int r = 0; r < 16; ++r) wg[r] = prm[PRM_WGU + r * 512 + h * 128 + (tid & 127)];
  const float bg = prm[PRM_BG + h * 128 + (tid & 127)];
  const float gn0 = prm[PRM_GNG + h * 256 + 32 * (tid >> 6) + (tid & 15)], gn1 = prm[PRM_GNG + h * 256 + 32 * (tid >> 6) + 16 + (tid & 15)];
  u32x4_t rq[2], rk[2], rv[4], rg = (u32x4_t){0u, 0u, 0u, 0u};
#define GLA_LOAD(ch)                                                                                      \
  {                                                                                                       \
    const size_t tb = tokb + (size_t)(ch) * 64;                                                           \
    _Pragma("unroll") for (int i = 0; i < 2; ++i) {                                                       \
      const int id = tid + 512 * i, tk = id >> 4, part = id & 15;                                         \
      rq[i] = *(const u32x4_t*)(Qg + (tb + tk) * 512 + h * 128 + part * 8);                               \
      rk[i] = *(const u32x4_t*)(Kg + (tb + tk) * 512 + h * 128 + part * 8);                               \
    }                                                                                                     \
    _Pragma("unroll") for (int i = 0; i < 4; ++i) {                                                       \
      const int id = tid + 512 * i, tk = id >> 5, part = id & 31;                                         \
      rv[i] = *(const u32x4_t*)(Vg + (tb + tk) * 1024 + h * 256 + part * 8);                              \
    }                                                                                                     \
    if (tid < 256) rg = *(const u32x4_t*)(GLOWg + (tb + (tid >> 2)) * 16 + (tid & 3) * 4);                \
  }
  f32x4 S[8][2];
#pragma unroll
  for (int a = 0; a < 8; ++a) { S[a][0] = (f32x4){0.f, 0.f, 0.f, 0.f}; S[a][1] = (f32x4){0.f, 0.f, 0.f, 0.f}; }
  GLA_LOAD(0);
#if PROBE_GLA
  unsigned long long tmark = __builtin_amdgcn_s_memrealtime();
#endif
#pragma unroll 1
  for (int ch = 0; ch < SEQ / 64; ++ch) {
    asm volatile("" : "+v"(tid));
    const int wave = __builtin_amdgcn_readfirstlane(tid >> 6), lane = tid & 63, g = lane >> 4, c = lane & 15;
    const int d = tid & 127, tq = __builtin_amdgcn_readfirstlane(tid >> 7);
    const unsigned vtr = lds0 + GL_V + (unsigned)((8 * g + (c >> 2)) * 544 + (32 * wave + 4 * (c & 3)) * 2);
    const unsigned ketr = lds0 + GL_KE + (unsigned)((8 * g + (c >> 2)) * 288 + (4 * (c & 3)) * 2);
    const size_t tb = tokb + (size_t)ch * 64;
#pragma unroll
    for (int i = 0; i < 2; ++i) {
      const int id = tid + 512 * i, tk = id >> 4, part = id & 15;
      *(LAS u32x4_t*)(lds + GL_QD + tk * 288 + part * 16) = rq[i];
      *(LAS u32x4_t*)(lds + GL_KI + tk * 288 + part * 16) = rk[i];
    }
#pragma unroll
    for (int i = 0; i < 4; ++i) {
      const int id = tid + 512 * i, tk = id >> 5, part = id & 31;
      *(LAS u32x4_t*)(lds + GL_V + tk * 544 + part * 16) = rv[i];
    }
    if (tid < 256) *(LAS u32x4_t*)(lds + GL_GLOW + (tid >> 2) * 64 + (tid & 3) * 16) = rg;
    GLA_MARK(1); GLA_BAR();
    if (ch + 1 < SEQ / 64) GLA_LOAD(ch + 1);
    u32x4_t rs[4];
#pragma unroll
    for (int i = 0; i < 4; ++i) {
      const int id = tid + 512 * i, tk = id >> 5, part = id & 31;
      rs[i] = *(const u32x4_t*)(SGR + (tb + tk) * 1024 + h * 256 + part * 8);
    }
    LAS float* LB = (LAS float*)(lds + GL_LB);
    float run = 0.f;
#pragma unroll 2
    for (int i = 0; i < 16; ++i) {
      const LAS f32x4* gp = (const LAS f32x4*)(lds + GL_GLOW + (16 * tq + i) * 64);
      const f32x4 g0 = gp[0], g1 = gp[1], g2 = gp[2], g3 = gp[3];
      float gl = bg;
      gl += g0[0] * wg[0] + g0[1] * wg[1] + g0[2] * wg[2] + g0[3] * wg[3];
      gl += g1[0] * wg[4] + g1[1] * wg[5] + g1[2] * wg[6] + g1[3] * wg[7];
      gl += g2[0] * wg[8] + g2[1] * wg[9] + g2[2] * wg[10] + g2[3] * wg[11];
      gl += g3[0] * wg[12] + g3[1] * wg[13] + g3[2] * wg[14] + g3[3] * wg[15];
      const float ls = fminf(gl, 0.f) - __logf(1.f + __expf(-fabsf(gl)));
      run += ls * (1.f / 16.f);
      LB[(16 * tq + i) * 128 + d] = run;
    }
    QT[tq * 128 + d] = run;
    GLA_MARK(2); GLA_BAR();
    {
      float off = 0.f, tot = 0.f;
#pragma unroll
      for (int k = 0; k < 4; ++k) { const float v = QT[k * 128 + d]; tot += v; off += (k < tq) ? v : 0.f; }
      const float eb = __expf(tot);
#pragma unroll 2
      for (int i = 0; i < 16; ++i) {
        const int t = 16 * tq + i;
        const float bb = LB[t * 128 + d] + off;
        const float e = __expf(bb), r = __expf(-bb);
        LAS bf16* qp = (LAS bf16*)(lds + GL_QD + t * 288) + d;
        LAS bf16* kp = (LAS bf16*)(lds + GL_KI + t * 288) + d;
        LAS bf16* ep = (LAS bf16*)(lds + GL_KE + t * 288) + d;
        const float q = bf2f(*qp), k = bf2f(*kp);
        *qp = f2bf(q * e);
        *kp = f2bf(k * r);
        *ep = f2bf(k * (eb * r));
      }
      if (tq == 0) DEC[d] = eb;
    }
    GLA_MARK(3); GLA_BAR();
    {
      const int ti = wave >> 1;
#pragma unroll
      for (int u = 0; u < 2; ++u) {
        const int tj = 2 * (wave & 1) + u;
        f32x4 acc = (f32x4){0.f, 0.f, 0.f, 0.f};
        if (tj <= ti) {
#pragma unroll
          for (int ks = 0; ks < 4; ++ks) {
            const bf16x8_t a = *(const LAS bf16x8_t*)(lds + GL_QD + (16 * ti + c) * 288 + (32 * ks + 8 * g) * 2);
            const bf16x8_t bb = *(const LAS bf16x8_t*)(lds + GL_KI + (16 * tj + c) * 288 + (32 * ks + 8 * g) * 2);
            acc = __builtin_amdgcn_mfma_f32_16x16x32_bf16(a, bb, acc, 0, 0, 0);
          }
        }
#pragma unroll
        for (int r = 0; r < 4; ++r) {
          const int i = 16 * ti + 4 * g + r, j = 16 * tj + c;
          *((LAS bf16*)(lds + GL_AT + i * 144) + j) = f2bf((j <= i) ? acc[r] : 0.f);
        }
      }
    }
    GLA_MARK(4); GLA_BAR();
    f32x4 o[4][2];
    {
      bf16x8_t vf[2][2];
      {
        s16x4_t lo[4], hi[4];
#pragma unroll
        for (int ks = 0; ks < 2; ++ks)
#pragma unroll
          for (int tn = 0; tn < 2; ++tn) {
            lo[ks * 2 + tn] = tr_read_b64(vtr + (32 * ks) * 544 + tn * 32);
            hi[ks * 2 + tn] = tr_read_b64(vtr + (32 * ks + 4) * 544 + tn * 32);
          }
        asm volatile("s_waitcnt lgkmcnt(0)" ::: "memory");
        __builtin_amdgcn_sched_barrier(0);
#pragma unroll
        for (int u = 0; u < 4; ++u)
          vf[u >> 1][u & 1] = (bf16x8_t){lo[u][0], lo[u][1], lo[u][2], lo[u][3], hi[u][0], hi[u][1], hi[u][2], hi[u][3]};
      }
#pragma unroll
      for (int tm = 0; tm < 4; ++tm) { o[tm][0] = (f32x4){0.f, 0.f, 0.f, 0.f}; o[tm][1] = (f32x4){0.f, 0.f, 0.f, 0.f}; }
#pragma unroll
      for (int tm = 0; tm < 4; ++tm)
#pragma unroll
        for (int ks = 0; ks < 2; ++ks) {
          if (ks == 1 && tm < 2) continue;
          const bf16x8_t a = *(const LAS bf16x8_t*)(lds + GL_AT + (16 * tm + c) * 144 + (32 * ks + 8 * g) * 2);
          o[tm][0] = __builtin_amdgcn_mfma_f32_16x16x32_bf16(a, vf[ks][0], o[tm][0], 0, 0, 0);
          o[tm][1] = __builtin_amdgcn_mfma_f32_16x16x32_bf16(a, vf[ks][1], o[tm][1], 0, 0, 0);
          __builtin_amdgcn_sched_barrier(0);
        }
#pragma unroll
      for (int u = 0; u < 4; ++u) {
        union { bf16x8_t v; unsigned w[4]; } s0, s1;
        s0.w[0] = pk2(S[2 * u][0][0], S[2 * u][0][1]); s0.w[1] = pk2(S[2 * u][0][2], S[2 * u][0][3]);
        s0.w[2] = pk2(S[2 * u + 1][0][0], S[2 * u + 1][0][1]); s0.w[3] = pk2(S[2 * u + 1][0][2], S[2 * u + 1][0][3]);
        s1.w[0] = pk2(S[2 * u][1][0], S[2 * u][1][1]); s1.w[1] = pk2(S[2 * u][1][2], S[2 * u][1][3]);
        s1.w[2] = pk2(S[2 * u + 1][1][0], S[2 * u + 1][1][1]); s1.w[3] = pk2(S[2 * u + 1][1][2], S[2 * u + 1][1][3]);
#pragma unroll
        for (int tm = 0; tm < 4; ++tm) {
          const LAS unsigned char* qrow = lds + GL_QD + (16 * tm + c) * 288 + (32 * u + 4 * g) * 2;
          const s16x4_t q0 = *(const LAS s16x4_t*)qrow, q1 = *(const LAS s16x4_t*)(qrow + 32);
          const bf16x8_t a = (bf16x8_t){q0[0], q0[1], q0[2], q0[3], q1[0], q1[1], q1[2], q1[3]};
          o[tm][0] = __builtin_amdgcn_mfma_f32_16x16x32_bf16(a, s0.v, o[tm][0], 0, 0, 0);
          o[tm][1] = __builtin_amdgcn_mfma_f32_16x16x32_bf16(a, s1.v, o[tm][1], 0, 0, 0);
        }
        __builtin_amdgcn_sched_barrier(0);
      }
#pragma unroll
      for (int tk = 0; tk < 8; ++tk) {
        const f32x4 dec4 = *(const LAS f32x4*)(DEC + 16 * tk + 4 * g);
        S[tk][0] *= dec4; S[tk][1] *= dec4;
        s16x4_t lo0 = tr_read_b64(ketr + tk * 32), hi0 = tr_read_b64(ketr + 4 * 288 + tk * 32);
        s16x4_t lo1 = tr_read_b64(ketr + 32 * 288 + tk * 32), hi1 = tr_read_b64(ketr + 36 * 288 + tk * 32);
        asm volatile("s_waitcnt lgkmcnt(0)" ::: "memory");
        __builtin_amdgcn_sched_barrier(0);
        const bf16x8_t a0 = (bf16x8_t){lo0[0], lo0[1], lo0[2], lo0[3], hi0[0], hi0[1], hi0[2], hi0[3]};
        const bf16x8_t a1 = (bf16x8_t){lo1[0], lo1[1], lo1[2], lo1[3], hi1[0], hi1[1], hi1[2], hi1[3]};
        S[tk][0] = __builtin_amdgcn_mfma_f32_16x16x32_bf16(a0, vf[0][0], S[tk][0], 0, 0, 0);
        S[tk][1] = __builtin_amdgcn_mfma_f32_16x16x32_bf16(a0, vf[0][1], S[tk][1], 0, 0, 0);
        S[tk][0] = __builtin_amdgcn_mfma_f32_16x16x32_bf16(a1, vf[1][0], S[tk][0], 0, 0, 0);
        S[tk][1] = __builtin_amdgcn_mfma_f32_16x16x32_bf16(a1, vf[1][1], S[tk][1], 0, 0, 0);
        __builtin_amdgcn_sched_barrier(0);
      }
#pragma unroll
      for (int tm = 0; tm < 4; ++tm)
#pragma unroll
        for (int r = 0; r < 4; ++r) {
          float ss = o[tm][0][r] * o[tm][0][r] + o[tm][1][r] * o[tm][1][r];
          ss = row16_sum(ss);
          if (c == 0) SSQ[(16 * tm + 4 * g + r) * 8 + wave] = ss;
        }
    }
    GLA_MARK(5); GLA_BAR();
    {
      LAS bf16* OB = (LAS bf16*)(lds + GL_LB);
#pragma unroll
      for (int tm = 0; tm < 4; ++tm)
#pragma unroll
        for (int r = 0; r < 4; ++r) {
          const int t = 16 * tm + 4 * g + r;
          const f32x4 p0 = *(const LAS f32x4*)(SSQ + t * 8), p1 = *(const LAS f32x4*)(SSQ + t * 8 + 4);
          const float tot = ((p0[0] + p0[1]) + (p0[2] + p0[3])) + ((p1[0] + p1[1]) + (p1[2] + p1[3]));
          const float rstd = rsqrtf(tot * (1.f / 256.f) + 1e-6f);
          OB[t * 256 + 32 * wave + c] = f2bf(o[tm][0][r] * rstd * gn0);
          OB[t * 256 + 32 * wave + 16 + c] = f2bf(o[tm][1][r] * rstd * gn1);
        }
    }
    GLA_MARK(6); GLA_BAR();
#pragma unroll
    for (int i = 0; i < 4; ++i) {
      const int id = tid + 512 * i, tk = id >> 5, part = id & 31;
      const u32x4_t ov = *(const LAS u32x4_t*)(lds + GL_LB + tk * 512 + part * 16);
      const u32x4_t sv = rs[i];
      u32x4_t gv;
      gv[0] = pk2(bflo(ov[0]) * bflo(sv[0]), bfhi(ov[0]) * bfhi(sv[0]));
      gv[1] = pk2(bflo(ov[1]) * bflo(sv[1]), bfhi(ov[1]) * bfhi(sv[1]));
      gv[2] = pk2(bflo(ov[2]) * bflo(sv[2]), bfhi(ov[2]) * bfhi(sv[2]));
      gv[3] = pk2(bflo(ov[3]) * bflo(sv[3]), bfhi(ov[3]) * bfhi(sv[3]));
      *(u32x4_t*)(Vg + (tb + tk) * 1024 + h * 256 + part * 8) = gv;
    }
    GLA_MARK(7);
  }
#undef GLA_LOAD
  __syncthreads();
}

#define LDS_BYTES 155712
#define OFF_XBAR (224ull * 1024)
#define OFF_CTR (200ull * 1024)

__device__ __forceinline__ unsigned xcc_id() { return (unsigned)__builtin_amdgcn_s_getreg((3 << 11) | 20) & 0x7u; }
__device__ __forceinline__ void ph_mixer(const P& p, unsigned char* lds_raw, bool do_gla) {
  if (do_gla && blockIdx.x < 32) { gla_item(p, lds_raw, blockIdx.x); if (blockIdx.x == 0) TS_SET(p, 20); }
  unsigned* ctr = (unsigned*)(p.ws + OFF_CTR);
  LAS unsigned* slot = (LAS unsigned*)((LAS unsigned char*)lds_raw + DS_TOTAL);
  const unsigned home = xcc_id();
  unsigned k = 0;
  for (;;) {
    if (tid_fresh() == 0) {
      unsigned qi = 0xffffffffu;
      while (k < 8) {
        const unsigned b = (home + k) & 7u;
        const unsigned v = __hip_atomic_fetch_add(ctr + 64 * b, 1u, __ATOMIC_RELAXED, __HIP_MEMORY_SCOPE_AGENT);
        if (v < 256u) { qi = (b << 8) | v; break; }
        ++k;
      }
      slot[0] = qi; slot[1] = k;
    }
    __syncthreads();
    const unsigned qi = slot[0];
    k = slot[1];
    __syncthreads();
    if (qi == 0xffffffffu) break;
    dsa_batch(p, lds_raw, (int)(qi >> 8), 255 - (int)(qi & 255u));
  }
}

__global__ void __launch_bounds__(512, 2) mega(P p) {
  extern __shared__ __attribute__((aligned(16))) unsigned char lds_raw[];
  LAS unsigned char* lds = (LAS unsigned char*)lds_raw;
  cg::grid_group grid = cg::this_grid();
  char* ws = p.ws;
  const int bid = blockIdx.x, nb = gridDim.x;
  if (bid == 0 && threadIdx.x < 8) *(unsigned*)(ws + OFF_CTR + 256 * threadIdx.x) = 0u;
  if (bid == 0) { for (int i = threadIdx.x; i < XCD_BAR_WORDS; i += 512) ((unsigned*)(ws + OFF_XBAR))[i] = 0u; }
  volatile LAS unsigned* xst = (volatile LAS unsigned*)(lds + DS_TOTAL + 16);
  if (threadIdx.x < 4) xst[threadIdx.x] = 0u;
#if PROBE_TS
  { const int t_ = tid_fresh(); if (bid == 0 && t_ < 64) ((unsigned long long*)(ws + OFF_TS))[t_] = 0ull; }
  __syncthreads();
  if (bid == 0) TS_SET(p, 0);
#endif
  ph_prep(p, (float*)lds_raw);
  grid.sync();
  const XcdBarrier xb = xcd_barrier_post((unsigned*)(ws + OFF_XBAR), xst);
  if (bid == 0) TS_SET(p, 1);
  ph_mod(p, p.x, p.norm1_g, 0, 1024, (bf16*)(ws + OFF_H), bid, nb);
  xcd_barrier(xb);
  if (bid == 0) TS_SET(p, 2);
  gemm_run(lds, (const bf16*)(ws + OFF_H), (const bf16*)(ws + OFF_WT_IN), TT, 7168, 1024, EpiIn{ws, p.out});
  xcd_barrier(xb);
  if (bid == 0) TS_SET(p, 3);
  ph_mixer(p, lds_raw, true);
  if (bid == 0) TS_SET(p, 21);
  xcd_barrier(xb);
  if (bid == 0) TS_SET(p, 4);
  gemm_run(lds, (const bf16*)(ws + OFF_V), (const bf16*)(ws + OFF_WT_A), TT, 1024, 1024,
           EpiMix<false>{(const bf16*)p.out, (bf16*)(ws + OFF_MIX)});
  gemm_run(lds, (const bf16*)(ws + OFF_ODSA), (const bf16*)(ws + OFF_WT_B), TT, 1024, 1024,
           EpiMix<true>{(const bf16*)p.out + (size_t)TT * 1024, (bf16*)(ws + OFF_MIX)});
  xcd_barrier(xb);
  if (bid == 0) TS_SET(p, 5);
  gemm_run(lds, (const bf16*)(ws + OFF_MIX), (const bf16*)(ws + OFF_WT_OUT), TT, 1024, 1024,
           EpiX1{p.x, (const float*)(ws + OFF_ADA), p.out});
  xcd_barrier(xb);
  if (bid == 0) TS_SET(p, 6);
  ph_mod(p, p.out, (const float*)(ws + OFF_PRM) + PRM_N2G, 3072, 4096, (bf16*)(ws + OFF_H), bid, nb);
  xcd_barrier(xb);
  if (bid == 0) TS_SET(p, 7);
  gemm_run(lds, (const bf16*)(ws + OFF_H), (const bf16*)(ws + OFF_WT_Q), TT, 2048, 1024, EpiPlain{(bf16*)(ws + OFF_PQ), 2048});
  xcd_barrier(xb);
  if (bid == 0) TS_SET(p, 8);
  ph_peer512(p, lds_raw, p.out);
#if PROBE_TS
  if (bid == 0) TS_SET(p, 18);
  xcd_barrier(xb);
  {
    const unsigned long long* T = (const unsigned long long*)(ws + OFF_TS);
    const unsigned long long q = (unsigned long long)(PROBE_Q), t0 = __builtin_amdgcn_s_memrealtime();
    while (__builtin_amdgcn_s_memrealtime() - t0 < q) __builtin_amdgcn_s_sleep(8);
  }
#endif
}

extern "C" void kernel_launch(void* const* d_in, const int* in_sizes, int n_in, void* d_out, int out_size, void* d_ws,
                              size_t ws_size, hipStream_t stream) {
  P p{};
  const float** f = (const float**)&p;
  for (int i = 0; i < 22; ++i) f[i] = (const float*)d_in[i];
  p.out = (float*)d_out;
  p.ws = (char*)d_ws;
  if (ws_size < WS_NEED) { fprintf(stderr, "workspace too small: %zu\n", ws_size); return; }
  static int grid_blocks = 0;
  if (!grid_blocks) {
    int dev = 0, cus = 0, per_cu = 0;
    (void)hipGetDevice(&dev);
    (void)hipDeviceGetAttribute(&cus, hipDeviceAttributeMultiprocessorCount, dev);
    if (hipFuncSetAttribute((const void*)mega, hipFuncAttributeMaxDynamicSharedMemorySize, LDS_BYTES) != hipSuccess) {
      fprintf(stderr, "hipFuncSetAttribute failed\n"); grid_blocks = -1; return;
    }
    if (hipOccupancyMaxActiveBlocksPerMultiprocessor(&per_cu, (const void*)mega, 512, LDS_BYTES) != hipSuccess || per_cu < 1) {
      fprintf(stderr, "occupancy query failed\n"); grid_blocks = -1; return;
    }
    grid_blocks = cus;
  }
  if (grid_blocks <= 0) return;
  void* args[] = {&p};
  hipError_t e = hipLaunchCooperativeKernel((void*)mega, dim3(grid_blocks), dim3(512), args, LDS_BYTES, stream);
  if (e != hipSuccess) fprintf(stderr, "cooperative launch failed: %s (grid %d)\n", hipGetErrorString(e), grid_blocks);
}
```

```cpp
#include <hip/hip_runtime.h>
#include <hip/hip_cooperative_groups.h>
#include <cstdio>
#include <cstdint>
namespace cg = cooperative_groups;

#define TT 32768
#define SEQ 4096
#define DM 1024
#define NIN 7000
typedef unsigned short bf16;
#define LAS __attribute__((address_space(3)))

struct P {
  const float *x, *c, *w_ada, *b_ada, *norm1_g, *w_in, *w_gate_up, *b_gate, *gla_norm_g, *kv_norm_g,
      *w_uk, *w_uv, *w_a, *w_b, *w_out, *norm2_g, *w_q, *sk1, *sk2, *peer_u, *peer_v, *final_g;
  float* out;
  char* ws;
};

#define MB (1ull << 20)
#define OFF_ADA   (0ull)
#define OFF_H     (1 * MB)
#define OFF_ODSA  (1 * MB)
#define OFF_Q     (65 * MB)
#define OFF_K     (97 * MB)
#define OFF_MIX   (65 * MB)
#define OFF_V     (129 * MB)
#define OFF_DQ    (193 * MB)
#define OFF_PQ    (129 * MB)
#define OFF_DSCR  (257 * MB)
#define OFF_SSP   (256ull * 1024)
#define OFF_CKV   (289 * MB)
#define OFF_IQ    (305 * MB)
#define OFF_IK    (337 * MB)
#define OFF_IW    (341 * MB)
#define OFF_GLOW  (342 * MB)
#define OFF_SGR   (344 * MB)
#define OFF_WT    (408 * MB)
#define OFF_WT_IN  (OFF_WT)
#define OFF_WT_A   (OFF_WT + 7168ull * 2048)
#define OFF_WT_B   (OFF_WT_A + 1024ull * 2048)
#define OFF_WT_OUT (OFF_WT_B + 1024ull * 2048)
#define OFF_WT_Q   (OFF_WT_OUT + 1024ull * 2048)
#define OFF_PU    (432 * MB)
#define OFF_PV    (464 * MB)
#define OFF_SK    (496 * MB)
#define OFF_PSC   (496 * MB + 128 * 1024)
#define OFF_WUK   (497 * MB)
#define OFF_WUV   (497 * MB + 512 * 1024)
#define WS_NEED   (498 * MB)

__device__ __forceinline__ bf16 f2bf(float f) {
  unsigned u = __float_as_uint(f);
  u += 0x7fffu + ((u >> 16) & 1u);
  return (bf16)(u >> 16);
}
__device__ __forceinline__ unsigned pk2(float lo, float hi) { return (unsigned)f2bf(lo) | ((unsigned)f2bf(hi) << 16); }
__device__ __forceinline__ float bf2f(bf16 h) { return __uint_as_float(((unsigned)h) << 16); }
__device__ __forceinline__ float bflo(unsigned u) { return __uint_as_float(u << 16); }
__device__ __forceinline__ float bfhi(unsigned u) { return __uint_as_float(u & 0xffff0000u); }
__device__ __forceinline__ float wave_sum(float v) {
#pragma unroll
  for (int o = 32; o > 0; o >>= 1) v += __shfl_xor(v, o);
  return v;
}
__device__ __forceinline__ float wave_max(float v) {
#pragma unroll
  for (int o = 32; o > 0; o >>= 1) v = fmaxf(v, __shfl_xor(v, o));
  return v;
}
#ifndef PROBE_TS
#define PROBE_TS 0
#endif
#define OFF_PRM (800ull * 1024)
#define PRM_WGU   0
#define PRM_BG    8192
#define PRM_GNG   8704
#define PRM_N2G   9728
#define PRM_FG    10752
#define PRM_TOTAL 11776
#define OFF_TS (208ull * 1024)
#if PROBE_TS
#define TS_SET(p, k) do { if (tid_fresh() == 0) ((unsigned long long*)((p).ws + OFF_TS))[k] = __builtin_amdgcn_s_memrealtime(); } while (0)
#define TS_ADD(p, k, t0) do { if (tid_fresh() == 0) ((unsigned long long*)((p).ws + OFF_TS))[k] += __builtin_amdgcn_s_memrealtime() - (t0); } while (0)
#define TS_NOW() __builtin_amdgcn_s_memrealtime()
#else
#define TS_SET(p, k) do {} while (0)
#define TS_ADD(p, k, t0) do {} while (0)
#define TS_NOW() 0ull
#endif
__device__ __forceinline__ int tid_fresh() { int t = threadIdx.x; asm volatile("" : "+v"(t)); return t; }
__device__ __forceinline__ float sigmoidf_(float v) { return 1.f / (1.f + __expf(-v)); }
__device__ __forceinline__ float siluf_(float v) { return v / (1.f + __expf(-v)); }

#include <hip/hip_runtime.h>
namespace pg8 {
#define PG8_LAS __attribute__((address_space(3)))
typedef unsigned short bf16_t;
typedef short bf16x8 __attribute__((ext_vector_type(8)));
typedef float f32x4 __attribute__((ext_vector_type(4)));
typedef unsigned u32x4 __attribute__((ext_vector_type(4)));
constexpr int BM = 256, BK = 64, HALF = 128, HTB = HALF * BK * 2  , STAGE_BYTES = 8 * HTB, NXCD = 8, WGM = 8;

__host__ __device__ __forceinline__ int lds_byte(int r, int c) { const int st = (r >> 4) * 2 + (c >> 5), rr = r & 15, cc = c & 31, ob = rr * 64 + cc * 2; return st * 1024 + (ob ^ (((ob >> 9) & 1) << 5)); }
__host__ __device__ __forceinline__ void stage_rc(int b, int& R, int& C) { const int st = b / 1024, sb = b % 1024, swz = sb ^ (((sb >> 9) & 1) << 5); R = (st >> 1) * 16 + swz / 64; C = (st & 1) * 32 + (swz % 64) / 2; }
__host__ __device__ __forceinline__ int perm32(int rho) { const int n = rho >> 4, i = rho & 15; return 8 * (i >> 2) + 4 * n + (i & 3); }

struct Unit { int pm, pn; };
struct Gemm { const bf16_t* A; const bf16_t* Bt; int M, N, K; };

struct StaticOrder {
    int nM, nN, nwg, G, c;
    __host__ __device__ void init(int M, int N, int G_, int c_) { nM = M / BM; nN = N / BM; nwg = nM * nN; G = G_; c = c_; }
    __host__ __device__ bool next(int i, Unit& u) const {
        const long L = (long)i * G + c; if (L >= nwg) return false;
        int wgid = (int)L; { const int q = nwg / NXCD, r = nwg % NXCD, xcd = wgid % NXCD, off = wgid / NXCD; wgid = (xcd < r ? xcd * (q + 1) : r * (q + 1) + (xcd - r) * q) + off; }
        const int nig = WGM * nN, gid = wgid / nig, fm = gid * WGM, gsz = (nM - fm) < WGM ? (nM - fm) : WGM;
        u.pm = fm + ((wgid % nig) % gsz); u.pn = (wgid % nig) / gsz; return true;
    }
    __device__ __forceinline__ void a_ready(const Unit&) const {}
    __device__ __forceinline__ void done(const Unit&) const {}
};
__device__ __forceinline__ unsigned cvt_pk_bf16(float lo, float hi) { unsigned r; asm volatile("v_cvt_pk_bf16_f32 %0, %1, %2" : "=v"(r) : "v"(lo), "v"(hi)); return r; }

template <class Epi, class Sched, bool STAMP = false>
__device__ __forceinline__ void gemm_phase(PG8_LAS unsigned char* lds, const Gemm g, const Sched& S, const Epi& E, unsigned long long* stamps) {
    const int tid = ::tid_fresh(), wid = __builtin_amdgcn_readfirstlane(tid >> 6), lane = tid & 63, wr = wid >> 2, wc = wid & 3, fr = lane & 15, fq = lane >> 4;
    const int K = g.K, nt = K / BK;
    int ts_lo = 0, ts_hi = 0, nts = 0; const unsigned long long rt_entry = STAMP ? (unsigned long long)wall_clock64() : 0ull;
#define PG8_STAMP() do { if (STAMP && wid == 0 && nts < 64) { const unsigned long long _c = (unsigned long long)clock64(); \
        ts_lo = (lane == nts) ? (int)(unsigned)_c : ts_lo; ts_hi = (lane == nts) ? (int)(unsigned)(_c >> 32) : ts_hi; ++nts; } } while (0)
    PG8_STAMP();
    unsigned voffA[2], voffB[2];
#pragma unroll
    for (int i = 0; i < 2; ++i) { int R, C; stage_rc(tid * 16 + i * 8192, R, C); const int Rb = Epi::PERM ? ((R & ~31) + perm32(R & 31)) : R;
        voffA[i] = (unsigned)(R * K + C) * 2u; voffB[i] = (unsigned)(Rb * K + C) * 2u; }
    const size_t kstep = (size_t)(BK * 2);
    const size_t hstep = (size_t)HALF * K * 2;
    const size_t tstep = 2 * hstep;
    const unsigned ldsw = (unsigned)wid * 1024u;
    const int aoff = lds_byte(wr * 64 + fr, fq * 8), boff = lds_byte(wc * 32 + fr, fq * 8);
#define PG8_SA(b, h) (((b) * 2 + (h)) * HTB)
#define PG8_SB(b, h) ((4 + (b) * 2 + (h)) * HTB)
#define PG8_STAGE(bufoff, gbase, voff) do { _Pragma("unroll") for (int _i = 0; _i < 2; ++_i) \
        __builtin_amdgcn_global_load_lds((const unsigned*)((const char*)(gbase) + (voff)[_i]), (PG8_LAS unsigned*)(lds + (bufoff) + ldsw + _i * 8192), 16, 0, 0); } while (0)
#define PG8_LDA(dst, b, h) do { _Pragma("unroll") for (int m = 0; m < 4; ++m) _Pragma("unroll") for (int k = 0; k < 2; ++k) dst[m][k] = *(const PG8_LAS bf16x8*)(lds + PG8_SA(b, h) + aoff + m * 2048 + k * 1024); } while (0)
#define PG8_LDB(dst, b, h) do { _Pragma("unroll") for (int n = 0; n < 2; ++n) _Pragma("unroll") for (int k = 0; k < 2; ++k) dst[n][k] = *(const PG8_LAS bf16x8*)(lds + PG8_SB(b, h) + boff + n * 2048 + k * 1024); } while (0)
#define PG8_MMA(ai, bj, At, Bt) do { __builtin_amdgcn_s_setprio(1); _Pragma("unroll") for (int m = 0; m < 4; ++m) _Pragma("unroll") for (int n = 0; n < 2; ++n) _Pragma("unroll") for (int k = 0; k < 2; ++k) \
        acc[ai][bj][m][n] = __builtin_amdgcn_mfma_f32_16x16x32_bf16(Bt[n][k], At[m][k], acc[ai][bj][m][n], 0, 0, 0); __builtin_amdgcn_s_setprio(0); } while (0)
#define PG8_WAIT_V(n) asm volatile("s_waitcnt vmcnt(" #n ")" ::: "memory")
#define PG8_WAIT_L(n) asm volatile("s_waitcnt lgkmcnt(" #n ")" ::: "memory")
#define PG8_BAR __builtin_amdgcn_s_barrier()
#define PG8_SCHED __builtin_amdgcn_sched_barrier(0)
    Unit cur, nxt; int ui = 0;
    if (!S.next(0, cur)) return;
    f32x4 acc[2][2][4][2];
#pragma unroll
    for (int a = 0; a < 2; ++a)
#pragma unroll
        for (int b = 0; b < 2; ++b)
#pragma unroll
            for (int m = 0; m < 4; ++m)
#pragma unroll
                for (int n = 0; n < 2; ++n) acc[a][b][m][n] = (f32x4){0.f, 0.f, 0.f, 0.f};
    bf16x8 At[4][2], B0[2][2], B1[2][2];
    const char* cA = (const char*)g.A + (size_t)cur.pm * tstep; const char* cB = (const char*)g.Bt + (size_t)cur.pn * tstep;
    S.a_ready(cur);
    PG8_STAGE(PG8_SB(0, 0), cB, voffB); PG8_STAGE(PG8_SA(0, 0), cA, voffA); PG8_STAGE(PG8_SB(0, 1), cB + hstep, voffB); PG8_STAGE(PG8_SA(0, 1), cA + hstep, voffA);
    if (wr == 1) PG8_BAR;
    PG8_WAIT_V(4); PG8_BAR;
    PG8_STAGE(PG8_SB(1, 0), cB + kstep, voffB); PG8_STAGE(PG8_SA(1, 0), cA + kstep, voffA); PG8_STAGE(PG8_SB(1, 1), cB + hstep + kstep, voffB);
    PG8_WAIT_V(6); PG8_BAR;
    PG8_STAMP();
    for (;;) {
        const bool has_next = S.next(ui + 1, nxt);
        const char* nA = has_next ? (const char*)g.A + (size_t)nxt.pm * tstep : cA; const char* nB = has_next ? (const char*)g.Bt + (size_t)nxt.pn * tstep : cB;
        for (int t = 0; t < nt; t += 2) {
            const bool last = (t == nt - 2);
            const char* a1 = cA + (size_t)(t + 1) * kstep;
            const char* a2 = last ? nA : cA + (size_t)(t + 2) * kstep; const char* b2 = last ? nB : cB + (size_t)(t + 2) * kstep;
            const char* a3 = a2 + kstep; const char* b3 = b2 + kstep;
            if (last && has_next) S.a_ready(nxt);
            PG8_LDB(B0, 0, 0); PG8_SCHED; PG8_LDA(At, 0, 0); PG8_STAGE(PG8_SA(1, 1), a1 + hstep, voffA);
            PG8_WAIT_L(8); PG8_BAR; PG8_WAIT_L(0); PG8_MMA(0, 0, At, B0); PG8_BAR; PG8_SCHED;
            PG8_LDB(B1, 0, 1); PG8_STAGE(PG8_SB(0, 0), b2, voffB);
            PG8_BAR; PG8_WAIT_L(0); PG8_MMA(0, 1, At, B1); PG8_BAR;
            PG8_LDA(At, 0, 1); PG8_STAGE(PG8_SA(0, 0), a2, voffA);
            PG8_BAR; PG8_WAIT_L(0); PG8_MMA(1, 0, At, B0); PG8_BAR; PG8_SCHED;
            PG8_STAGE(PG8_SB(0, 1), b2 + hstep, voffB);
            PG8_WAIT_V(6); PG8_BAR; PG8_MMA(1, 1, At, B1); PG8_BAR;
            PG8_LDB(B0, 1, 0); PG8_SCHED; PG8_LDA(At, 1, 0); PG8_STAGE(PG8_SA(0, 1), a2 + hstep, voffA);
            PG8_WAIT_L(8); PG8_BAR; PG8_WAIT_L(0); PG8_MMA(0, 0, At, B0); PG8_BAR; PG8_SCHED;
            PG8_LDB(B1, 1, 1); PG8_STAGE(PG8_SB(1, 0), b3, voffB);
            PG8_BAR; PG8_WAIT_L(0); PG8_MMA(0, 1, At, B1); PG8_BAR;
            PG8_LDA(At, 1, 1); PG8_STAGE(PG8_SA(1, 0), a3, voffA);
            PG8_BAR; PG8_WAIT_L(0); PG8_MMA(1, 0, At, B0); PG8_BAR; PG8_SCHED;
            PG8_STAGE(PG8_SB(1, 1), b3 + hstep, voffB);
            PG8_WAIT_V(6); PG8_BAR; PG8_MMA(1, 1, At, B1); PG8_BAR;
        }
        PG8_STAMP();
        if constexpr (!Epi::AFTER_DRAIN) { E(acc, cur, wr, wc, fr, fq); S.done(cur); }
        PG8_STAMP();
        if (!has_next) break;
#pragma unroll
        for (int a = 0; a < 2; ++a)
#pragma unroll
            for (int b = 0; b < 2; ++b)
#pragma unroll
                for (int m = 0; m < 4; ++m)
#pragma unroll
                    for (int n = 0; n < 2; ++n) acc[a][b][m][n] = (f32x4){0.f, 0.f, 0.f, 0.f};
        cur = nxt; cA = nA; cB = nB; ++ui;
    }
    PG8_WAIT_V(0);
    if (wr == 0) PG8_BAR;
    PG8_BAR;
    if constexpr (Epi::AFTER_DRAIN) { E.fused(acc, cur, wr, wc, fr, fq, lds, wid, lane); S.done(cur); }
    PG8_STAMP();
    if (STAMP && wid == 0) { stamps[lane] = lane < nts ? (((unsigned long long)(unsigned)ts_hi << 32) | (unsigned)ts_lo) : 0ull;
        if (lane == 62) stamps[62] = rt_entry; if (lane == 63) stamps[63] = (unsigned long long)wall_clock64(); }
#undef PG8_STAMP
#undef PG8_SA
#undef PG8_SB
#undef PG8_STAGE
#undef PG8_LDA
#undef PG8_LDB
#undef PG8_MMA
#undef PG8_WAIT_V
#undef PG8_WAIT_L
#undef PG8_BAR
#undef PG8_SCHED
}
}
#define XB_TMO      128
#define XB_XCNT(j)  (256  + 64 * (j))
#define XB_XSUB(j)  (1280 + 64 * (j))
#define XB_XGEN(j)  (2304 + 64 * (j))
#define XB_TOP      3328
#define XB_TOPGEN   3392
#define XCD_BAR_WORDS 3456
#define XB_SPIN_CAP (1u << 18)

__device__ __forceinline__ unsigned xb_ld(unsigned* p)              { return __hip_atomic_load(p, __ATOMIC_RELAXED, __HIP_MEMORY_SCOPE_AGENT); }
__device__ __forceinline__ unsigned xb_add(unsigned* p, unsigned v) { return __hip_atomic_fetch_add(p, v, __ATOMIC_RELAXED, __HIP_MEMORY_SCOPE_AGENT); }
__device__ __forceinline__ unsigned xb_xcc_id() { return (unsigned)__builtin_amdgcn_s_getreg((3 << 11) | 20) & 0xFu; }
#define XB_SPIN(cond, bar) do { unsigned _sp = 0; while (cond) { __builtin_amdgcn_s_sleep(1); \
    if ((++_sp & 255u) == 0u) { if (xb_ld(&(bar)[XB_TMO])) break; if (_sp > XB_SPIN_CAP) { atomicAdd(&(bar)[XB_TMO], 1u); break; } } } } while (0)

struct XcdBarrier {
    unsigned* bar; unsigned x;
    volatile LAS unsigned* st;
};

__device__ __forceinline__ XcdBarrier xcd_barrier_post(unsigned* bar, volatile LAS unsigned* st) {
    XcdBarrier b; b.bar = bar; b.x = xb_xcc_id(); b.st = st;
    if (threadIdx.x == 0) (void)xb_add(&bar[XB_XCNT(b.x)], 1u);
    return b;
}
__device__ __forceinline__ void xcd_barrier_complete(unsigned* bar, unsigned x, unsigned& nloc, unsigned& nx) {
    const unsigned G = gridDim.x * gridDim.y * gridDim.z;
    unsigned sum, cnt, mine, sp = 0u;
    for (;;) {
        sum = 0u; cnt = 0u; mine = 0u;
#pragma unroll
        for (unsigned j = 0; j < 16; ++j) { const unsigned c = xb_ld(&bar[XB_XCNT(j)]); sum += c; cnt += (c > 0u) ? 1u : 0u; mine = (j == x) ? c : mine; }
        if (sum == G) break;
        __builtin_amdgcn_s_sleep(1);
        if ((++sp & 255u) == 0u) { if (xb_ld(&bar[XB_TMO])) break; if (sp > XB_SPIN_CAP) { atomicAdd(&bar[XB_TMO], 1u); break; } }
    }
    nloc = mine > 0u ? mine : 1u; nx = cnt > 0u ? cnt : 1u;
}

__device__ __forceinline__ void xcd_barrier(const XcdBarrier& b) {
    asm volatile("s_waitcnt vmcnt(0)" ::: "memory");
    __syncthreads();
    if (threadIdx.x == 0) {
        unsigned* bar = b.bar;
        __builtin_amdgcn_s_waitcnt(0);
        unsigned nloc = b.st[0], nx = b.st[1];
        if (nloc == 0u) { xcd_barrier_complete(bar, b.x, nloc, nx); b.st[0] = nloc; b.st[1] = nx; }
        const unsigned old = xb_add(&bar[XB_XSUB(b.x)], 1u);
        const unsigned gen = old / nloc;
        if (old + 1u == (gen + 1u) * nloc) {
            __builtin_amdgcn_fence(__ATOMIC_RELEASE, "agent");
            asm volatile("s_waitcnt vmcnt(0)" ::: "memory");
            const unsigned og = xb_add(&bar[XB_TOP], 1u);
            const unsigned tg = og / nx;
            if (og + 1u == (tg + 1u) * nx) xb_add(&bar[XB_TOPGEN], 1u);
            else XB_SPIN(xb_ld(&bar[XB_TOPGEN]) == tg, bar);
            __builtin_amdgcn_fence(__ATOMIC_ACQUIRE, "agent");
            xb_add(&bar[XB_XGEN(b.x)], 1u);
            asm volatile("s_waitcnt vmcnt(0)" ::: "memory");
        } else {
            XB_SPIN(xb_ld(&bar[XB_XGEN(b.x)]) == gen, bar);
            __builtin_amdgcn_fence(__ATOMIC_ACQUIRE, "agent");
            asm volatile("s_waitcnt vmcnt(0)" ::: "memory");
        }
    }
    __syncthreads();
}

__device__ __forceinline__ void ph_mod(const P& p, const float* X, const float* g, int shift_off, int scale_off, bf16* H, int bid, int nb) {
  const float* ada = (const float*)(p.ws + OFF_ADA);
  const int tidm = tid_fresh(); int wave = tidm >> 6, lane = tidm & 63;
  const int rstride = nb * (int)(blockDim.x >> 6);
  int row = bid * (int)(blockDim.x >> 6) + wave;
  float4 v[4];
  if (row < TT) {
    const float4* xr = (const float4*)(X + (size_t)row * DM);
#pragma unroll
    for (int i = 0; i < 4; ++i) v[i] = xr[lane + i * 64];
  }
  for (; row < TT; row += rstride) {
    float4 vn[4];
    const int nrow = row + rstride;
    {
      const float4* xn = (const float4*)(X + (size_t)((nrow < TT) ? nrow : row) * DM);
#pragma unroll
      for (int i = 0; i < 4; ++i) vn[i] = xn[lane + i * 64];
    }
    float ss = 0.f;
#pragma unroll
    for (int i = 0; i < 4; ++i) ss += v[i].x * v[i].x + v[i].y * v[i].y + v[i].z * v[i].z + v[i].w * v[i].w;
    ss = wave_sum(ss);
    float rstd = rsqrtf(ss * (1.f / DM) + 1e-6f);
    int b = row >> 12;
    const float* sh = ada + b * 6144 + shift_off;
    const float* sc = ada + b * 6144 + scale_off;
#pragma unroll
    for (int i = 0; i < 4; ++i) {
      int c0 = (lane + i * 64) * 4;
      float4 gg = *(const float4*)(g + c0);
      float4 s4 = *(const float4*)(sc + c0);
      float4 h4 = *(const float4*)(sh + c0);
      ushort4 o;
      o.x = f2bf(v[i].x * rstd * gg.x * (1.f + s4.x) + h4.x);
      o.y = f2bf(v[i].y * rstd * gg.y * (1.f + s4.y) + h4.y);
      o.z = f2bf(v[i].z * rstd * gg.z * (1.f + s4.z) + h4.z);
      o.w = f2bf(v[i].w * rstd * gg.w * (1.f + s4.w) + h4.w);
      *(ushort4*)(H + (size_t)row * DM + c0) = o;
    }
#pragma unroll
    for (int i = 0; i < 4; ++i) v[i] = vn[i];
  }
}

using pg8::f32x4;
using pg8::u32x4;
using pg8::Unit;
using pg8::cvt_pk_bf16;
typedef short s16x4_t __attribute__((ext_vector_type(4)));
typedef unsigned u32x4_t __attribute__((ext_vector_type(4)));
typedef unsigned short u16x4_t __attribute__((ext_vector_type(4)));

__device__ __forceinline__ int in_srcmap(int d) {
  if (d < 2048) return d;
  if (d < 3072) return 3088 + (d - 2048);
  if (d < 3328) return 4112 + (d - 3072);
  if (d < 3840) return 4368 + (d - 3328);
  if (d < 3904) return 4880 + (d - 3840);
  if (d < 3912) return 4944 + (d - 3904);
  if (d < 3928) return 3072 + (d - 3912);
  if (d < 4096) return -1;
  if (d < 5120) return 2048 + (d - 4096);
  return 4952 + (d - 5120);
}
template <bool MAP>
__device__ __forceinline__ void transpose_item(const float* W, int ldw, int K, bf16* WT, int item, int nblk, float* scr, int lane) {
  const int kb = item / nblk, nbk = item % nblk, k0 = 64 * kb, n0 = 32 * nbk;
  const int d = n0 + (lane & 31);
  const int src = MAP ? in_srcmap(d) : d;
#pragma unroll 8
  for (int i = 0; i < 32; ++i) {
    const int kk = 2 * i + (lane >> 5);
    scr[kk * 33 + (lane & 31)] = (src >= 0) ? W[(size_t)(k0 + kk) * ldw + src] : 0.f;
  }
  asm volatile("s_waitcnt lgkmcnt(0)" ::: "memory");
  const int c = lane & 7;
#pragma unroll
  for (int j = 0; j < 4; ++j) {
    const int n = (lane >> 3) + 8 * j;
    const float* s = scr + (8 * c) * 33 + n;
    uint4 o;
    o.x = pk2(s[0 * 33], s[1 * 33]); o.y = pk2(s[2 * 33], s[3 * 33]); o.z = pk2(s[4 * 33], s[5 * 33]); o.w = pk2(s[6 * 33], s[7 * 33]);
    *(uint4*)(WT + (size_t)(n0 + n) * K + k0 + 8 * c) = o;
  }
  asm volatile("s_waitcnt lgkmcnt(0)" ::: "memory");
}

__device__ __forceinline__ void ph_prep(const P& p, float* sm) {
  const int tid = tid_fresh(), wave = tid >> 6, lane = tid & 63;
  const int bid = blockIdx.x, nb = gridDim.x;
  float* silc = sm + 8 * 2112 + 64;
  float* red = silc + 8192;
  float* ada = (float*)(p.ws + OFF_ADA);
  if (bid < 192) {
    for (int i = tid; i < 8192; i += 512) silc[i] = siluf_(p.c[i]);
    __syncthreads();
    for (int it = bid; it < 192; it += nb) {
      const int kg = tid >> 5, cn = tid & 31, n = it * 32 + cn;
      float acc[8];
#pragma unroll
      for (int b = 0; b < 8; ++b) acc[b] = 0.f;
      for (int k = kg * 64; k < kg * 64 + 64; ++k) {
        const float w = p.w_ada[(size_t)k * 6144 + n];
#pragma unroll
        for (int b = 0; b < 8; ++b) acc[b] += silc[b * 1024 + k] * w;
      }
#pragma unroll
      for (int b = 0; b < 8; ++b) red[(kg * 8 + b) * 32 + cn] = acc[b];
      __syncthreads();
      if (tid < 256) {
        const int b = tid >> 5, c2 = tid & 31;
        float s = 0.f;
#pragma unroll
        for (int g = 0; g < 16; ++g) s += red[(g * 8 + b) * 32 + c2];
        ada[b * 6144 + it * 32 + c2] = s + p.b_ada[it * 32 + c2];
      }
      __syncthreads();
    }
  }
  {
    unsigned char* PU8 = (unsigned char*)(p.ws + OFF_PU);
    unsigned char* PV8 = (unsigned char*)(p.ws + OFF_PV);
    float* PSC = (float*)(p.ws + OFF_PSC);
    for (int row = bid * 8 + wave; row < 2 * 16384; row += nb * 8) {
      const float* src = (row < 16384 ? p.peer_u : p.peer_v) + (size_t)(row & 16383) * 1024 + lane * 16;
      f32x4 v[4];
      float mx = 0.f;
#pragma unroll
      for (int q = 0; q < 4; ++q) {
        v[q] = *(const f32x4*)(src + q * 4);
        mx = fmaxf(mx, fmaxf(fmaxf(fabsf(v[q][0]), fabsf(v[q][1])), fmaxf(fabsf(v[q][2]), fabsf(v[q][3]))));
      }
      mx = wave_max(mx);
      const float sc = (mx > 0.f) ? exp2f(floorf(log2f(448.f / mx))) : 1.f;
      u32x4 o;
#pragma unroll
      for (int q = 0; q < 4; ++q) {
        int w = __builtin_amdgcn_cvt_pk_fp8_f32(v[q][0] * sc, v[q][1] * sc, 0, false);
        w = __builtin_amdgcn_cvt_pk_fp8_f32(v[q][2] * sc, v[q][3] * sc, w, true);
        o[q] = (unsigned)w;
      }
      *(u32x4*)((row < 16384 ? PU8 : PV8) + (size_t)(row & 16383) * 1024 + lane * 16) = o;
      if (lane == 0) PSC[row] = 1.f / sc;
    }
    for (int i = bid * 512 + tid; i < 2 * 2048; i += nb * 512) {
      const float* src = (i < 2048) ? p.sk1 : p.sk2;
      const int j = i & 2047;
      const float4 v0 = *(const float4*)(src + j * 8), v1 = *(const float4*)(src + j * 8 + 4);
      uint4 o; o.x = pk2(v0.x, v0.y); o.y = pk2(v0.z, v0.w); o.z = pk2(v1.x, v1.y); o.w = pk2(v1.z, v1.w);
      *(uint4*)((bf16*)(p.ws + OFF_SK) + (size_t)i * 8) = o;
    }
  }
  {
    float* prm = (float*)(p.ws + OFF_PRM);
    for (int i = bid * 512 + tid; i < PRM_TOTAL; i += nb * 512) {
      float v;
      if (i < PRM_BG) v = p.w_gate_up[i];
      else if (i < PRM_GNG) v = p.b_gate[i - PRM_BG];
      else if (i < PRM_N2G) v = p.gla_norm_g[i - PRM_GNG];
      else if (i < PRM_FG) v = p.norm2_g[i - PRM_N2G];
      else v = p.final_g[i - PRM_FG];
      prm[i] = v;
    }
  }
  {
    bf16* WUK = (bf16*)(p.ws + OFF_WUK);
    bf16* WUV = (bf16*)(p.ws + OFF_WUV);
    for (int i = bid * 512 + tid; i < 2 * 262144; i += nb * 512) {
      if (i < 262144) {
        const int d = i & 127, cc = (i >> 7) & 255, h = i >> 15;
        WUK[i] = f2bf(p.w_uk[((size_t)h * 128 + d) * 256 + cc] * p.kv_norm_g[cc] * 0.08838834764831845f);
      } else {
        const int k = i - 262144;
        const int cc = k & 255, d = (k >> 8) & 127, h = k >> 15;
        WUV[k] = f2bf(p.w_uv[((size_t)h * 256 + cc) * 128 + d] * p.kv_norm_g[cc]);
      }
    }
  }
  float* scr = sm + wave * 2112;
  const int gw = bid * 8 + wave, ngw = nb * 8;
  constexpr int I_IN = 16 * 224, I_SQ = 16 * 32, I_Q = 16 * 64;
  for (int it = gw; it < I_IN + 3 * I_SQ + I_Q; it += ngw) {
    int r = it;
    if (r < I_IN) { transpose_item<true>(p.w_in, NIN, 1024, (bf16*)(p.ws + OFF_WT_IN), r, 224, scr, lane); continue; }
    r -= I_IN;
    if (r < I_SQ) { transpose_item<false>(p.w_a, 1024, 1024, (bf16*)(p.ws + OFF_WT_A), r, 32, scr, lane); continue; }
    r -= I_SQ;
    if (r < I_SQ) { transpose_item<false>(p.w_b, 1024, 1024, (bf16*)(p.ws + OFF_WT_B), r, 32, scr, lane); continue; }
    r -= I_SQ;
    if (r < I_SQ) { transpose_item<false>(p.w_out, 1024, 1024, (bf16*)(p.ws + OFF_WT_OUT), r, 32, scr, lane); continue; }
    r -= I_SQ;
    transpose_item<false>(p.w_q, 2048, 1024, (bf16*)(p.ws + OFF_WT_Q), r, 64, scr, lane);
  }
}


struct EpiIn {
  static constexpr bool PERM = true, AFTER_DRAIN = false;
  char* ws; float* out;
  __device__ __forceinline__ void operator()(const f32x4 (&acc)[2][2][4][2], const Unit& u, int wr, int wc, int fr, int fq) const {
    const int pn = u.pn;
    const int row0 = u.pm * 256 + wr * 64 + fr, cl0 = wc * 32 + 8 * fq;
    if (pn == 12) {
      bf16* dst = (bf16*)(ws + OFF_CKV);
      float* ssp = (float*)(ws + OFF_SSP);
#pragma unroll
      for (int ai = 0; ai < 2; ++ai)
#pragma unroll
        for (int m = 0; m < 4; ++m) {
          const size_t row = row0 + ai * 128 + m * 16;
          float ss = 0.f;
#pragma unroll
          for (int bj = 0; bj < 2; ++bj) {
            const f32x4 v0 = acc[ai][bj][m][0], v1 = acc[ai][bj][m][1];
            ss += (v0[0] * v0[0] + v0[1] * v0[1]) + (v0[2] * v0[2] + v0[3] * v0[3]) + (v1[0] * v1[0] + v1[1] * v1[1]) + (v1[2] * v1[2] + v1[3] * v1[3]);
            u32x4 w; w.x = cvt_pk_bf16(v0[0], v0[1]); w.y = cvt_pk_bf16(v0[2], v0[3]); w.z = cvt_pk_bf16(v1[0], v1[1]); w.w = cvt_pk_bf16(v1[2], v1[3]);
            *(u32x4*)(dst + row * 256 + cl0 + bj * 128) = w;
          }
          ss += __shfl_xor(ss, 16); ss += __shfl_xor(ss, 32);
          if (fq == 0) ssp[row * 4 + wc] = ss;
        }
    } else if (pn == 15) {
      bf16* IK = (bf16*)(ws + OFF_IK);
      float* IW = (float*)(ws + OFF_IW);
      float* GLOW = (float*)(ws + OFF_GLOW);
#pragma unroll
      for (int ai = 0; ai < 2; ++ai)
#pragma unroll
        for (int m = 0; m < 4; ++m) {
          const size_t row = row0 + ai * 128 + m * 16;
          const int cl = cl0;
          const f32x4 v0 = acc[ai][0][m][0], v1 = acc[ai][0][m][1];
          if (cl < 64) {
            u32x4 w; w.x = cvt_pk_bf16(v0[0], v0[1]); w.y = cvt_pk_bf16(v0[2], v0[3]); w.z = cvt_pk_bf16(v1[0], v1[1]); w.w = cvt_pk_bf16(v1[2], v1[3]);
            *(u32x4*)(IK + row * 64 + cl) = w;
          } else if (cl < 72) {
            *(f32x4*)(IW + row * 8) = v0 * 0.35355339059327373f;
            *(f32x4*)(IW + row * 8 + 4) = v1 * 0.35355339059327373f;
          } else if (cl < 88) {
            *(f32x4*)(GLOW + row * 16 + (cl - 72)) = v0;
            *(f32x4*)(GLOW + row * 16 + (cl - 72) + 4) = v1;
          }
        }
    } else {
      bf16* dst; int ld; float scale = 1.f; int act = 0; int coff;
      if (pn < 2) { dst = (bf16*)(ws + OFF_Q); ld = 512; coff = pn * 256; scale = 0.08838834764831845f; }
      else if (pn < 4) { dst = (bf16*)(ws + OFF_K); ld = 512; coff = (pn - 2) * 256; }
      else if (pn < 8) { dst = (bf16*)(ws + OFF_V); ld = 1024; coff = (pn - 4) * 256; }
      else if (pn < 12) { dst = (bf16*)(ws + OFF_DQ); ld = 1024; coff = (pn - 8) * 256; }
      else if (pn < 15) { dst = (bf16*)(ws + OFF_IQ); ld = 512; coff = (pn - 13) * 256; scale = 0.125f; }
      else if (pn < 20) { dst = (bf16*)(ws + OFF_SGR); ld = 1024; coff = (pn - 16) * 256; act = 1; }
      else if (pn < 24) { dst = (bf16*)out; ld = 1024; coff = (pn - 20) * 256; act = 2; }
      else { dst = (bf16*)out + (size_t)TT * 1024; ld = 1024; coff = (pn - 24) * 256; act = 2; }
#pragma unroll
      for (int ai = 0; ai < 2; ++ai)
#pragma unroll
        for (int m = 0; m < 4; ++m) {
          bf16* rowp = dst + (size_t)(row0 + ai * 128 + m * 16) * ld + coff + cl0;
#pragma unroll
          for (int bj = 0; bj < 2; ++bj) {
            f32x4 v0 = acc[ai][bj][m][0] * scale, v1 = acc[ai][bj][m][1] * scale;
            if (act == 1) {
#pragma unroll
              for (int j = 0; j < 4; ++j) { v0[j] = siluf_(v0[j]); v1[j] = siluf_(v1[j]); }
            } else if (act == 2) {
#pragma unroll
              for (int j = 0; j < 4; ++j) { v0[j] = sigmoidf_(v0[j]); v1[j] = sigmoidf_(v1[j]); }
            }
            u32x4 w; w.x = cvt_pk_bf16(v0[0], v0[1]); w.y = cvt_pk_bf16(v0[2], v0[3]); w.z = cvt_pk_bf16(v1[0], v1[1]); w.w = cvt_pk_bf16(v1[2], v1[3]);
            *(u32x4*)(rowp + bj * 128) = w;
          }
        }
    }
  }
};

template <bool ADD> struct EpiMix {
  static constexpr bool PERM = true, AFTER_DRAIN = false;
  const bf16* SZ; bf16* MIX;
  __device__ __forceinline__ void operator()(const f32x4 (&acc)[2][2][4][2], const Unit& u, int wr, int wc, int fr, int fq) const {
    const int row0 = u.pm * 256 + wr * 64 + fr, col0 = u.pn * 256 + wc * 32 + 8 * fq;
    u32x4 sc[2], oc[2], sn[2], on[2];
    {
      const size_t idx = (size_t)row0 * 1024 + col0;
      sc[0] = *(const u32x4*)(SZ + idx); sc[1] = *(const u32x4*)(SZ + idx + 128);
      if (ADD) { oc[0] = *(const u32x4*)(MIX + idx); oc[1] = *(const u32x4*)(MIX + idx + 128); }
    }
#pragma unroll
    for (int s = 0; s < 8; ++s) {
      const int ai = s >> 2, m = s & 3;
      const size_t idx = (size_t)(row0 + ai * 128 + m * 16) * 1024 + col0;
      if (s < 7) {
        const int ai2 = (s + 1) >> 2, m2 = (s + 1) & 3;
        const size_t idn = (size_t)(row0 + ai2 * 128 + m2 * 16) * 1024 + col0;
        sn[0] = *(const u32x4*)(SZ + idn); sn[1] = *(const u32x4*)(SZ + idn + 128);
        if (ADD) { on[0] = *(const u32x4*)(MIX + idn); on[1] = *(const u32x4*)(MIX + idn + 128); }
      }
#pragma unroll
      for (int bj = 0; bj < 2; ++bj) {
        const u32x4 sv = sc[bj];
        f32x4 v0 = acc[ai][bj][m][0], v1 = acc[ai][bj][m][1];
        v0[0] *= bflo(sv.x); v0[1] *= bfhi(sv.x); v0[2] *= bflo(sv.y); v0[3] *= bfhi(sv.y);
        v1[0] *= bflo(sv.z); v1[1] *= bfhi(sv.z); v1[2] *= bflo(sv.w); v1[3] *= bfhi(sv.w);
        if (ADD) {
          const u32x4 o = oc[bj];
          v0[0] += bflo(o.x); v0[1] += bfhi(o.x); v0[2] += bflo(o.y); v0[3] += bfhi(o.y);
          v1[0] += bflo(o.z); v1[1] += bfhi(o.z); v1[2] += bflo(o.w); v1[3] += bfhi(o.w);
        }
        u32x4 w; w.x = cvt_pk_bf16(v0[0], v0[1]); w.y = cvt_pk_bf16(v0[2], v0[3]); w.z = cvt_pk_bf16(v1[0], v1[1]); w.w = cvt_pk_bf16(v1[2], v1[3]);
        *(u32x4*)(MIX + idx + bj * 128) = w;
      }
      if (s < 7) { sc[0] = sn[0]; sc[1] = sn[1]; if (ADD) { oc[0] = on[0]; oc[1] = on[1]; } }
    }
  }
};

struct EpiX1 {
  static constexpr bool PERM = true, AFTER_DRAIN = false;
  const float* x; const float* ada; float* out;
  __device__ __forceinline__ void operator()(const f32x4 (&acc)[2][2][4][2], const Unit& u, int wr, int wc, int fr, int fq) const {
    const int row0 = u.pm * 256 + wr * 64 + fr, col0 = u.pn * 256 + wc * 32 + 8 * fq;
    const int b = (u.pm * 256) >> 12;
    f32x4 g[2][2];
#pragma unroll
    for (int bj = 0; bj < 2; ++bj) {
      g[bj][0] = *(const f32x4*)(ada + b * 6144 + 2048 + col0 + bj * 128);
      g[bj][1] = *(const f32x4*)(ada + b * 6144 + 2048 + col0 + bj * 128 + 4);
    }
    f32x4 xc[4], xn[4];
    {
      const size_t idx = (size_t)row0 * 1024 + col0;
      xc[0] = *(const f32x4*)(x + idx); xc[1] = *(const f32x4*)(x + idx + 4);
      xc[2] = *(const f32x4*)(x + idx + 128); xc[3] = *(const f32x4*)(x + idx + 132);
    }
#pragma unroll
    for (int s = 0; s < 8; ++s) {
      const int ai = s >> 2, m = s & 3;
      const size_t idx = (size_t)(row0 + ai * 128 + m * 16) * 1024 + col0;
      if (s < 7) {
        const int ai2 = (s + 1) >> 2, m2 = (s + 1) & 3;
        const size_t idn = (size_t)(row0 + ai2 * 128 + m2 * 16) * 1024 + col0;
        xn[0] = *(const f32x4*)(x + idn); xn[1] = *(const f32x4*)(x + idn + 4);
        xn[2] = *(const f32x4*)(x + idn + 128); xn[3] = *(const f32x4*)(x + idn + 132);
      }
#pragma unroll
      for (int bj = 0; bj < 2; ++bj) {
        *(f32x4*)(out + idx + bj * 128) = xc[2 * bj] + g[bj][0] * acc[ai][bj][m][0];
        *(f32x4*)(out + idx + bj * 128 + 4) = xc[2 * bj + 1] + g[bj][1] * acc[ai][bj][m][1];
      }
      if (s < 7) { xc[0] = xn[0]; xc[1] = xn[1]; xc[2] = xn[2]; xc[3] = xn[3]; }
    }
  }
};

struct EpiPlain {
  static constexpr bool PERM = true, AFTER_DRAIN = false;
  bf16* O; int ld;
  __device__ __forceinline__ void operator()(const f32x4 (&acc)[2][2][4][2], const Unit& u, int wr, int wc, int fr, int fq) const {
    const int row0 = u.pm * 256 + wr * 64 + fr, col0 = u.pn * 256 + wc * 32 + 8 * fq;
#pragma unroll
    for (int ai = 0; ai < 2; ++ai)
#pragma unroll
      for (int m = 0; m < 4; ++m)
#pragma unroll
        for (int bj = 0; bj < 2; ++bj) {
          const f32x4 v0 = acc[ai][bj][m][0], v1 = acc[ai][bj][m][1];
          u32x4 w; w.x = cvt_pk_bf16(v0[0], v0[1]); w.y = cvt_pk_bf16(v0[2], v0[3]); w.z = cvt_pk_bf16(v1[0], v1[1]); w.w = cvt_pk_bf16(v1[2], v1[3]);
          *(u32x4*)(O + (size_t)(row0 + ai * 128 + m * 16) * ld + col0 + bj * 128) = w;
        }
  }
};

template <class Epi>
__device__ __forceinline__ void gemm_run(LAS unsigned char* lds, const bf16* A, const bf16* Bt, int M, int N, int K, const Epi& E) {
  pg8::Gemm g{A, Bt, M, N, K};
  pg8::StaticOrder S;
  S.init(M, N, gridDim.x, blockIdx.x);
  pg8::gemm_phase<Epi, pg8::StaticOrder, false>(lds, g, S, E, nullptr);
}

typedef short bf16x8_t __attribute__((ext_vector_type(8)));
typedef __bf16 bf16x2_t __attribute__((ext_vector_type(2)));
__device__ __forceinline__ float dot2bf(unsigned a, unsigned b, float acc) {
  return __builtin_amdgcn_fdot2_f32_bf16(__builtin_bit_cast(bf16x2_t, a), __builtin_bit_cast(bf16x2_t, b), acc, false);
}
__device__ __forceinline__ void wave_lds_fence() { asm volatile("s_waitcnt lgkmcnt(0)" ::: "memory"); }
template <int N> __device__ __forceinline__ float row_ror(float x) {
  return __int_as_float(__builtin_amdgcn_update_dpp(0, __float_as_int(x), 0x120 + N, 0xf, 0xf, false));
}
__device__ __forceinline__ float row16_max(float m) {
  m = fmaxf(m, row_ror<8>(m)); m = fmaxf(m, row_ror<4>(m)); m = fmaxf(m, row_ror<2>(m)); m = fmaxf(m, row_ror<1>(m));
  return m;
}
__device__ __forceinline__ float row16_sum(float m) {
  m += row_ror<8>(m); m += row_ror<4>(m); m += row_ror<2>(m); m += row_ror<1>(m);
  return m;
}
__device__ __forceinline__ float wave_sum_dpp(float s) {
  s = row16_sum(s);
  const int si = __float_as_int(s);
  return __int_as_float(__builtin_amdgcn_readlane(si, 0)) + __int_as_float(__builtin_amdgcn_readlane(si, 16)) +
         (__int_as_float(__builtin_amdgcn_readlane(si, 32)) + __int_as_float(__builtin_amdgcn_readlane(si, 48)));
}
__device__ __forceinline__ constexpr int cand_i(int L) {
  return L < 16 ? 0 : L < 24 ? 1 : L < 29 ? 2 : L < 33 ? 3 : L < 36 ? 4 : L < 38 ? 5 : L < 40 ? 6 : L < 42 ? 7 : (L - 42 + 8);
}
__device__ __forceinline__ constexpr int cand_j(int L) {
  return L < 16 ? L : L < 24 ? L - 16 : L < 29 ? L - 24 : L < 33 ? L - 29 : L < 36 ? L - 33 : L < 38 ? L - 36 : L < 40 ? L - 38 : L < 42 ? L - 40 : 0;
}
template <int K> struct CandRank {
  static __device__ __forceinline__ void run(int ki, unsigned key, int& rank) {
    const unsigned o = (unsigned)__builtin_amdgcn_readlane(ki, K);
    rank += (o > key) ? 1 : 0;
    CandRank<K + 1>::run(ki, key, rank);
  }
};
template <> struct CandRank<50> { static __device__ __forceinline__ void run(int, unsigned, int&) {} };
__device__ __forceinline__ unsigned peer_f2ord(float f) {
  if (f == 0.f) f = 0.f;
  const unsigned u = __float_as_uint(f);
  return (u & 0x80000000u) ? ~u : (u | 0x80000000u);
}
__device__ __forceinline__ float peer_ord2f(unsigned u) { return __uint_as_float((u & 0x80000000u) ? (u ^ 0x80000000u) : ~u); }
__device__ __forceinline__ unsigned umax3(unsigned a, unsigned b, unsigned c) { const unsigned t = a > b ? a : b; return t > c ? t : c; }
template <int N> __device__ __forceinline__ unsigned row_ror_u(unsigned x) {
  return (unsigned)__builtin_amdgcn_update_dpp(0, (int)x, 0x120 + N, 0xf, 0xf, false);
}
__device__ __forceinline__ unsigned row16_umax(unsigned m) {
  unsigned t;
  t = row_ror_u<8>(m); m = t > m ? t : m; t = row_ror_u<4>(m); m = t > m ? t : m;
  t = row_ror_u<2>(m); m = t > m ? t : m; t = row_ror_u<1>(m); m = t > m ? t : m;
  return m;
}
__device__ __forceinline__ float gelu_exact(float v) { return 0.5f * v * (1.f + erff(v * 0.7071067811865476f)); }

typedef float f32x2_t __attribute__((ext_vector_type(2)));
#define PEER_NB 6
#define PEER_LOAD(buf, TAB, e0)                                                                   \
  _Pragma("unroll") for (int j = 0; j < PEER_NB; ++j) {                                                 \
    const int e = ((e0) + j < 128) ? __builtin_amdgcn_readfirstlane((int)ridx[tt * 128 + (e0) + j]) : 0;   \
    buf[j] = *(const u32x4_t*)((TAB) + (size_t)e * 1024 + lane * 16);                             \
  }
#define PEER_UDOT(buf, e0)                                                                        \
  _Pragma("unroll") for (int j = 0; j < PEER_NB; ++j) {                                                 \
    float s0 = 0.f, s1 = 0.f;                                                                     \
    _Pragma("unroll") for (int w = 0; w < 4; ++w) {                                               \
      const f32x2_t lo = __builtin_amdgcn_cvt_pk_f32_fp8((int)buf[j][w], false);                  \
      const f32x2_t hi = __builtin_amdgcn_cvt_pk_f32_fp8((int)buf[j][w], true);                   \
      s0 += lo.x * hf[4 * w] + hi.x * hf[4 * w + 2];                                              \
      s1 += lo.y * hf[4 * w + 1] + hi.y * hf[4 * w + 3];                                          \
    }                                                                                             \
    const float s = wave_sum_dpp(s0 + s1);                                                        \
    const int ee = (e0) + j;                                                                      \
    if (ee < 64) dotA = (lane == ee) ? s : dotA; else if (ee < 128) dotB = (lane == ee - 64) ? s : dotB; \
    __builtin_amdgcn_sched_barrier(0);                                                           \
  }
#define PEER_VACC(buf, e0)                                                                        \
  _Pragma("unroll") for (int j = 0; j < PEER_NB; ++j) {                                                 \
    const int ee = (e0) + j;                                                                      \
    const float a = (ee < 128) ? __int_as_float(__builtin_amdgcn_readlane(__float_as_int(ee < 64 ? aA : aB), ee & 63)) : 0.f; \
    _Pragma("unroll") for (int w = 0; w < 4; ++w) {                                               \
      const f32x2_t lo = __builtin_amdgcn_cvt_pk_f32_fp8((int)buf[j][w], false);                  \
      const f32x2_t hi = __builtin_amdgcn_cvt_pk_f32_fp8((int)buf[j][w], true);                   \
      acc[4 * w] += a * lo.x; acc[4 * w + 1] += a * lo.y; acc[4 * w + 2] += a * hi.x; acc[4 * w + 3] += a * hi.y; \
    }                                                                                             \
    __builtin_amdgcn_sched_barrier(0);                                                           \
  }

__device__ __forceinline__ void ph_peer512(const P& p, unsigned char* lds_raw, float* dst_base) {
  const int tid = tid_fresh(), wave = tid >> 6, lane = tid & 63, g = lane >> 4, c = lane & 15;
  const bf16* PQ = (const bf16*)(p.ws + OFF_PQ);
  const bf16* SK = (const bf16*)(p.ws + OFF_SK);
  float* tv = (float*)(lds_raw + wave * 16384);
  int* ti = (int*)(tv + 512);
  float* rgate = (float*)(ti + 512);
  unsigned short* ridx = (unsigned short*)(rgate + 2048);
  for (int tile = blockIdx.x * 8 + wave; tile < TT / 16; tile += gridDim.x * 8) {
    const int tok0 = tile * 16;
#pragma unroll 1
    for (int hd = 0; hd < 8; ++hd) {
#pragma unroll 1
      for (int hf = 0; hf < 2; ++hf) {
        f32x4 acc[8];
#pragma unroll
        for (int nt = 0; nt < 8; ++nt) acc[nt] = (f32x4){0.f, 0.f, 0.f, 0.f};
#pragma unroll
        for (int ks = 0; ks < 4; ++ks) {
          const bf16x8_t a = *(const bf16x8_t*)(PQ + (size_t)(tok0 + c) * 2048 + hd * 256 + hf * 128 + ks * 32 + 8 * g);
#pragma unroll
          for (int nt = 0; nt < 8; ++nt) {
            const bf16x8_t b = *(const bf16x8_t*)(SK + hf * 16384 + (nt * 16 + c) * 128 + ks * 32 + 8 * g);
            acc[nt] = __builtin_amdgcn_mfma_f32_16x16x32_bf16(a, b, acc[nt], 0, 0, 0);
          }
        }
        unsigned kq[4][8], res[4];
#pragma unroll
        for (int i = 0; i < 4; ++i) {
          res[i] = 0u;
#pragma unroll
          for (int nt = 0; nt < 8; ++nt) kq[i][nt] = (peer_f2ord(acc[nt][i]) & ~127u) | (unsigned)(127 - (16 * nt + c));
        }
#pragma unroll 1
        for (int r = 0; r < 16; ++r) {
#pragma unroll
          for (int i = 0; i < 4; ++i) {
            unsigned m = umax3(umax3(kq[i][0], kq[i][1], kq[i][2]), umax3(kq[i][3], kq[i][4], kq[i][5]), (kq[i][6] > kq[i][7]) ? kq[i][6] : kq[i][7]);
            m = row16_umax(m);
#pragma unroll
            for (int nt = 0; nt < 8; ++nt) kq[i][nt] = (kq[i][nt] == m) ? 0u : kq[i][nt];
            res[i] = (c == r) ? m : res[i];
          }
        }
#pragma unroll
        for (int i = 0; i < 4; ++i) {
          const int row = 4 * g + i;
          tv[(hf * 16 + row) * 16 + c] = peer_ord2f(res[i] & ~127u);
          ti[(hf * 16 + row) * 16 + c] = 127 - (int)(res[i] & 127u);
        }
      }
      wave_lds_fence();
      const int ci = cand_i(lane < 50 ? lane : 0), cj = cand_j(lane < 50 ? lane : 0);
#pragma unroll 1
      for (int row = 0; row < 16; ++row) {
        const float val = tv[row * 16 + ci] + tv[(16 + row) * 16 + cj];
        const unsigned key = (lane < 50) ? ((peer_f2ord(val) & ~63u) | (unsigned)(63 - lane)) : 0u;
        int rank = 0;
        CandRank<0>::run((int)key, key, rank);
        if (lane < 50 && rank < 16) {
          rgate[row * 128 + hd * 16 + rank] = val;
          ridx[row * 128 + hd * 16 + rank] = (unsigned short)(ti[row * 16 + ci] * 128 + ti[(16 + row) * 16 + cj]);
        }
      }
      wave_lds_fence();
      {
        const int row = lane >> 2, q = lane & 3;
        float* gp = rgate + row * 128 + hd * 16;
        const float mx = gp[0];
        const f32x4 b4 = *(const f32x4*)(gp + q * 4);
        f32x4 e4;
        e4[0] = __expf(b4[0] - mx); e4[1] = __expf(b4[1] - mx); e4[2] = __expf(b4[2] - mx); e4[3] = __expf(b4[3] - mx);
        float s = (e4[0] + e4[1]) + (e4[2] + e4[3]);
        s += __shfl_xor(s, 1); s += __shfl_xor(s, 2);
        const float inv = 1.f / s;
        wave_lds_fence();
        *(f32x4*)(gp + q * 4) = e4 * inv;
      }
      wave_lds_fence();
    }
    char* wsl = p.ws;
    asm volatile("" : "+s"(wsl));
    const bf16* H2 = (const bf16*)(wsl + OFF_H);
    const unsigned char* PU = (const unsigned char*)(wsl + OFF_PU);
    const unsigned char* PV = (const unsigned char*)(wsl + OFF_PV);
    const float* USC = (const float*)(wsl + OFF_PSC);
    const float* VSC = USC + 16384;
    const float* ada = (const float*)(wsl + OFF_ADA);
#pragma unroll 1
    for (int tt = 0; tt < 16; ++tt) {
      const int tidx = tid_fresh(), lane = tidx & 63, wv = __builtin_amdgcn_readfirstlane(tidx >> 6);
      const float* rgate = (const float*)(lds_raw + wv * 16384 + 4096);
      const unsigned short* ridx = (const unsigned short*)(lds_raw + wv * 16384 + 4096 + 8192);
      const size_t tok = (size_t)tok0 + tt;
      float hf[16];
      {
        const u32x4_t h0 = *(const u32x4_t*)(H2 + tok * 1024 + lane * 16), h1 = *(const u32x4_t*)(H2 + tok * 1024 + lane * 16 + 8);
#pragma unroll
        for (int w = 0; w < 4; ++w) { hf[2 * w] = bflo(h0[w]); hf[2 * w + 1] = bfhi(h0[w]); hf[8 + 2 * w] = bflo(h1[w]); hf[8 + 2 * w + 1] = bfhi(h1[w]); }
      }
      const int eA = (int)ridx[tt * 128 + lane], eB = (int)ridx[tt * 128 + 64 + lane];
      const float usA = USC[eA], usB = USC[eB];
      float dotA = 0.f, dotB = 0.f;
      u32x4_t a0[PEER_NB], a1[PEER_NB];
#define PSB() __builtin_amdgcn_sched_barrier(0)
#define PEER_ROWS (((128 + 2 * PEER_NB - 1) / (2 * PEER_NB)) * 2 * PEER_NB)
      PEER_LOAD(a0, PU, 0); PSB();
      PEER_LOAD(a1, PU, PEER_NB); PSB();
#pragma unroll 1
      for (int e0 = 0; e0 < PEER_ROWS; e0 += 2 * PEER_NB) {
        PEER_UDOT(a0, e0); PSB();
        if (e0 + 2 * PEER_NB < PEER_ROWS) { PEER_LOAD(a0, PU, e0 + 2 * PEER_NB); } else { PEER_LOAD(a0, PV, 0); }
        PSB();
        PEER_UDOT(a1, e0 + PEER_NB); PSB();
        if (e0 + 3 * PEER_NB < PEER_ROWS) { PEER_LOAD(a1, PU, e0 + 3 * PEER_NB); } else { PEER_LOAD(a1, PV, PEER_NB); }
        PSB();
      }
      const float aA = gelu_exact(dotA * usA) * rgate[tt * 128 + lane] * VSC[(int)ridx[tt * 128 + lane]],
                  aB = gelu_exact(dotB * usB) * rgate[tt * 128 + 64 + lane] * VSC[(int)ridx[tt * 128 + 64 + lane]];
      float acc[16];
#pragma unroll
      for (int k = 0; k < 16; ++k) acc[k] = 0.f;
      PSB();
#pragma unroll 1
      for (int e0 = 0; e0 < PEER_ROWS; e0 += 2 * PEER_NB) {
        PEER_VACC(a0, e0); PSB();
        if (e0 + 2 * PEER_NB < PEER_ROWS) { PEER_LOAD(a0, PV, e0 + 2 * PEER_NB); }
        PSB();
        PEER_VACC(a1, e0 + PEER_NB); PSB();
        if (e0 + 3 * PEER_NB < PEER_ROWS) { PEER_LOAD(a1, PV, e0 + 3 * PEER_NB); }
        PSB();
      }
#undef PSB
      const int b = (int)(tok >> 12);
      const float* xrow = p.out + tok * 1024;
      float* orow = dst_base + tok * 1024;
      const float* g2 = ada + b * 6144 + 5120;
      float x2[16];
      float ss = 0.f;
#pragma unroll
      for (int q = 0; q < 4; ++q) {
        const int col = lane * 16 + q * 4;
        const f32x4 xv = *(const f32x4*)(xrow + col), gv = *(const f32x4*)(g2 + col);
#pragma unroll
        for (int k = 0; k < 4; ++k) { const float t = xv[k] + gv[k] * acc[q * 4 + k]; x2[q * 4 + k] = t; ss += t * t; }
      }
      ss = wave_sum_dpp(ss);
      const float rstd = rsqrtf(ss * (1.f / 1024.f) + 1e-6f);
#pragma unroll
      for (int q = 0; q < 4; ++q) {
        const int col = lane * 16 + q * 4;
        const f32x4 fg = *(const f32x4*)((const float*)(wsl + OFF_PRM) + PRM_FG + col);
        f32x4 o;
#pragma unroll
        for (int k = 0; k < 4; ++k) o[k] = x2[q * 4 + k] * rstd * fg[k];
        *(f32x4*)(orow + col) = o;
      }
    }
    wave_lds_fence();
  }
}

#define DS_KEY16   0
#define DS_CHUNK   17408
#define DS_SEL     139264
#define DS_WAVE    147456
#define DS_TOTAL   155648
#define DS_RS      544

__device__ __forceinline__ unsigned f2ord(float f) {
  if (f == 0.f) f = 0.f;
  unsigned u = __float_as_uint(f);
  return (u & 0x80000000u) ? ~u : (u | 0x80000000u);
}
__device__ __forceinline__ int wave_scan_incl(int v, int lane) {
#pragma unroll
  for (int o = 1; o < 64; o <<= 1) { const int t = __shfl_up(v, o); v += (lane >= o) ? t : 0; }
  return v;
}
__device__ __forceinline__ void find_digit(const LAS unsigned* hist, int K, int lane, int& digit, int& above) {
  const u32x4_t h4 = *(const LAS u32x4_t*)(hist + 252 - 4 * lane);
  const int c0 = (int)h4.w, c1 = (int)h4.z, c2 = (int)h4.y, c3 = (int)h4.x;
  const int tot = c0 + c1 + c2 + c3;
  int run = wave_scan_incl(tot, lane) - tot;
  int found = -1, ab = 0;
  if (run < K && run + c0 >= K) { found = 255 - 4 * lane; ab = run; } run += c0;
  if (run < K && run + c1 >= K) { found = 254 - 4 * lane; ab = run; } run += c1;
  if (run < K && run + c2 >= K) { found = 253 - 4 * lane; ab = run; } run += c2;
  if (run < K && run + c3 >= K) { found = 252 - 4 * lane; ab = run; }
  const unsigned long long mk = __ballot(found >= 0);
  const int src = (int)__ffsll((unsigned long long)mk) - 1;
  digit = __builtin_amdgcn_readlane(found, src);
  above = __builtin_amdgcn_readlane(ab, src);
}

typedef unsigned u32x2_t __attribute__((ext_vector_type(2)));
__device__ __forceinline__ float xrow_max(float x) {
  u32x2_t r = __builtin_amdgcn_permlane16_swap(__float_as_uint(x), __float_as_uint(x), false, false);
  x = fmaxf(__uint_as_float(r.x), __uint_as_float(r.y));
  r = __builtin_amdgcn_permlane32_swap(__float_as_uint(x), __float_as_uint(x), false, false);
  return fmaxf(__uint_as_float(r.x), __uint_as_float(r.y));
}
__device__ __forceinline__ float xrow_sum(float x) {
  u32x2_t r = __builtin_amdgcn_permlane16_swap(__float_as_uint(x), __float_as_uint(x), false, false);
  x = __uint_as_float(r.x) + __uint_as_float(r.y);
  r = __builtin_amdgcn_permlane32_swap(__float_as_uint(x), __float_as_uint(x), false, false);
  return __uint_as_float(r.x) + __uint_as_float(r.y);
}
__device__ __forceinline__ s16x4_t tr_read_b64(unsigned addr) {
  s16x4_t r; asm volatile("ds_read_b64_tr_b16 %0, %1" : "=&v"(r) : "v"(addr) : "memory"); return r;
}

#ifndef PROBE_DSA
#define PROBE_DSA 0
#endif
#if PROBE_DSA
#define DSA_MARK(k) do { const unsigned long long n_ = __builtin_amdgcn_s_memrealtime(); if (PROBE_DSA == (k)) { const unsigned long long q_ = n_ - tmark; \
    while (__builtin_amdgcn_s_memrealtime() - n_ < q_) __builtin_amdgcn_s_sleep(2); } tmark = __builtin_amdgcn_s_memrealtime(); } while (0)
#else
#define DSA_MARK(k) do {} while (0)
#endif
#if PROBE_DSA >= 10
#define DSA_MARKI(k) DSA_MARK(k)
#else
#define DSA_MARKI(k) do {} while (0)
#endif
__device__ __forceinline__ void dsa_batch(const P& p, unsigned char* lds_raw, int b, int pos) {
  const int t0 = pos * 16;
#define DSA_IDS const int tid = tid_fresh(), wave = __builtin_amdgcn_readfirstlane(tid >> 6), lane = tid & 63, g = lane >> 4, c = lane & 15; (void)wave; (void)g; (void)c;
  const size_t tokb = (size_t)b * SEQ, tok0 = tokb + t0;
  const bf16* DQ = (const bf16*)(p.ws + OFF_DQ);
  const bf16* CKV = (const bf16*)(p.ws + OFF_CKV);
  const float* SSP = (const float*)(p.ws + OFF_SSP);
  const bf16* IQ = (const bf16*)(p.ws + OFF_IQ);
  const bf16* IK = (const bf16*)(p.ws + OFF_IK);
  const float* IW = (const float*)(p.ws + OFF_IW);
  const bf16* WUK = (const bf16*)(p.ws + OFF_WUK);
  const bf16* WUV = (const bf16*)(p.ws + OFF_WUV);
  bf16* ODSA = (bf16*)(p.ws + OFF_ODSA);
  bf16* QL = (bf16*)(p.ws + OFF_DSCR + (size_t)blockIdx.x * 65536);
  bf16* OL = QL;
  LAS unsigned char* lds = (LAS unsigned char*)lds_raw;
  LAS unsigned short* key16 = (LAS unsigned short*)(lds + DS_KEY16);
  LAS unsigned short* sel = (LAS unsigned short*)(lds + DS_SEL);

#if PROBE_DSA
  unsigned long long tmark = __builtin_amdgcn_s_memrealtime();
#endif
  {
    DSA_IDS
    const int h = wave;
    bf16x8_t dqf[4];
#pragma unroll
    for (int ks = 0; ks < 4; ++ks) dqf[ks] = *(const bf16x8_t*)(DQ + (tok0 + c) * 1024 + h * 128 + ks * 32 + 8 * g);
    f32x4 ares[16];
#pragma unroll
    for (int nt = 0; nt < 16; ++nt) {
      f32x4 a = (f32x4){0.f, 0.f, 0.f, 0.f};
#pragma unroll
      for (int ks = 0; ks < 4; ++ks) {
        const bf16x8_t wf = *(const bf16x8_t*)(WUK + (size_t)(h * 256 + nt * 16 + c) * 128 + ks * 32 + 8 * g);
        a = __builtin_amdgcn_mfma_f32_16x16x32_bf16(wf, dqf[ks], a, 0, 0, 0);
      }
      ares[nt] = a;
    }
#pragma unroll
    for (int nt = 0; nt < 16; ++nt) {
      uint2 o; o.x = pk2(ares[nt][0], ares[nt][1]); o.y = pk2(ares[nt][2], ares[nt][3]);
      *(uint2*)(QL + c * 2048 + h * 256 + nt * 16 + 4 * g) = o;
    }
  }
  DSA_MARK(1);
  if (t0 >= 256) {
    DSA_IDS
    bf16x8_t qf[8][2];
    float iw[8];
#pragma unroll
    for (int h = 0; h < 8; ++h) {
      qf[h][0] = *(const bf16x8_t*)(IQ + (tok0 + c) * 512 + h * 64 + 8 * g);
      qf[h][1] = *(const bf16x8_t*)(IQ + (tok0 + c) * 512 + h * 64 + 32 + 8 * g);
      iw[h] = IW[(tok0 + c) * 8 + h];
    }
    const int ntile = pos + 1;
    bf16x8_t k0n = (bf16x8_t){0, 0, 0, 0, 0, 0, 0, 0}, k1n = k0n;
    if (wave < ntile) { const bf16* kr = IK + (tokb + wave * 16 + c) * 64 + 8 * g; k0n = *(const bf16x8_t*)kr; k1n = *(const bf16x8_t*)(kr + 32); }
    for (int kt = wave; kt < ntile; kt += 8) {
      const bf16x8_t k0 = k0n, k1 = k1n;
      { const int ktn = (kt + 8 < ntile) ? kt + 8 : kt; const bf16* kr = IK + (tokb + ktn * 16 + c) * 64 + 8 * g; k0n = *(const bf16x8_t*)kr; k1n = *(const bf16x8_t*)(kr + 32); }
      f32x4 sc = (f32x4){0.f, 0.f, 0.f, 0.f};
#pragma unroll
      for (int h = 0; h < 8; ++h) {
        f32x4 d = __builtin_amdgcn_mfma_f32_16x16x32_bf16(k0, qf[h][0], (f32x4){0.f, 0.f, 0.f, 0.f}, 0, 0, 0);
        d = __builtin_amdgcn_mfma_f32_16x16x32_bf16(k1, qf[h][1], d, 0, 0, 0);
#pragma unroll
        for (int i = 0; i < 4; ++i) sc[i] += iw[h] * fmaxf(d[i], 0.f);
      }
      u16x4_t o;
      const int sb = kt * 16 + 4 * g, tq = t0 + c;
      o.x = (sb + 0 <= tq) ? (unsigned short)(f2ord(sc[0]) >> 16) : (unsigned short)0;
      o.y = (sb + 1 <= tq) ? (unsigned short)(f2ord(sc[1]) >> 16) : (unsigned short)0;
      o.z = (sb + 2 <= tq) ? (unsigned short)(f2ord(sc[2]) >> 16) : (unsigned short)0;
      o.w = (sb + 3 <= tq) ? (unsigned short)(f2ord(sc[3]) >> 16) : (unsigned short)0;
      *(LAS u16x4_t*)(key16 + c * 4096 + sb) = o;
    }
  }
  DSA_MARK(2);
  __syncthreads();
#pragma unroll 1
  for (int qq = 0; qq < 2; ++qq) {
    DSA_IDS
    const int q = wave + 8 * qq, t = t0 + q;
    LAS unsigned short* selq = sel + q * 256;
    if (t < 256) {
      for (int j = lane; j < 256; j += 64) selq[j] = (unsigned short)((j <= t) ? j : 0);
    } else {
      const LAS unsigned short* kq = key16 + q * 4096;
      const int nit = (t >> 9) + 1;
      unsigned kp[8][4];
#pragma unroll
      for (int it = 0; it < 8; ++it) {
        const int s0 = 512 * it + 8 * lane;
        u32x4_t v = (u32x4_t){0u, 0u, 0u, 0u};
        if (s0 <= t) v = *(const LAS u32x4_t*)(kq + s0);
#pragma unroll
        for (int j = 0; j < 4; ++j) {
          const unsigned lo = (s0 + 2 * j <= t) ? (v[j] & 0xffffu) : 0u, hi = (s0 + 2 * j + 1 <= t) ? (v[j] & 0xffff0000u) : 0u;
          kp[it][j] = lo | hi;
        }
      }
      unsigned B = 0u;
#pragma unroll 1
      for (int bit = 15; bit >= 0; --bit) {
        const unsigned cand = B | (1u << bit);
        const unsigned c2 = (cand - 1u) * 0x00010001u;
        unsigned cnt2 = 0u;
#pragma unroll
        for (int it = 0; it < 8; ++it) {
          if (it < nit) {
#pragma unroll
            for (int j = 0; j < 4; ++j) {
              unsigned dd;
              asm("v_pk_sub_u16 %0, %1, %2 clamp\n\tv_pk_min_u16 %0, %0, %3" : "=&v"(dd) : "v"(kp[it][j]), "v"(c2), "v"(0x00010001u));
              cnt2 += dd;
            }
          }
        }
        const int tot = (int)wave_sum_dpp((float)((cnt2 & 0xffffu) + (cnt2 >> 16)));
        if (tot >= 256) B = cand;
      }
      int cgt = 0;
#pragma unroll
      for (int it = 0; it < 8; ++it)
#pragma unroll
        for (int j = 0; j < 4; ++j) cgt += (((kp[it][j] & 0xffffu) > B) ? 1 : 0) + (((kp[it][j] >> 16) > B) ? 1 : 0);
      const int m = 256 - (int)wave_sum_dpp((float)cgt);
      int base = 0, eqbase = 0;
#pragma unroll
      for (int it = 0; it < 8; ++it) {
        if (it < nit) {
          unsigned kk[8];
#pragma unroll
          for (int j = 0; j < 4; ++j) { kk[2 * j] = kp[it][j] & 0xffffu; kk[2 * j + 1] = kp[it][j] >> 16; }
          int ceq = 0;
#pragma unroll
          for (int j = 0; j < 8; ++j) ceq += (kk[j] == B) ? 1 : 0;
          const int eqi = wave_scan_incl(ceq, lane);
          int eqr = eqbase + eqi - ceq;
          unsigned tmask = 0u; int ct = 0;
#pragma unroll
          for (int j = 0; j < 8; ++j) {
            const bool eq = kk[j] == B;
            const bool take = (kk[j] > B) || (eq && eqr < m);
            eqr += eq ? 1 : 0;
            tmask |= take ? (1u << j) : 0u;
            ct += take ? 1 : 0;
          }
          const int pi = wave_scan_incl(ct, lane);
          int ps = base + pi - ct;
#pragma unroll
          for (int j = 0; j < 8; ++j) {
            if ((tmask >> j) & 1u) { if (ps < 256) selq[ps] = (unsigned short)(512 * it + 8 * lane + j); ++ps; }
          }
          base += __builtin_amdgcn_readlane(pi, 63);
          eqbase += __builtin_amdgcn_readlane(eqi, 63);
        }
      }
    }
  }
  DSA_MARK(3);
  __syncthreads();
  {
    DSA_IDS
    const int wave_b = wave;
    const float slope = (c < 8) ? exp2f(-(float)(c + 1)) : 0.f;
#pragma unroll 1
    for (int qq = 0; qq < 2; ++qq) {
      const int q = wave + 8 * qq, t = t0 + q;
      const int nsel = (t + 1 < 256) ? (t + 1) : 256, nch = (nsel + 31) >> 5;
      const LAS unsigned short* selq = sel + q * 256;
      bf16x8_t qf[8];
      {
        const int lq = tid_fresh() & 63;
        const bf16* qlp = QL + q * 2048 + (lq & 7) * 256 + 8 * (lq >> 4);
#pragma unroll
        for (int ks = 0; ks < 8; ++ks) qf[ks] = *(const bf16x8_t*)(qlp + ks * 32);
      }
      float mrun = -1e30f, lrun = 0.f;
      f32x4 o[16];
#pragma unroll
      for (int nt = 0; nt < 16; ++nt) o[nt] = (f32x4){0.f, 0.f, 0.f, 0.f};
      u32x4_t st[16];
      f32x4 st_ss = (f32x4){0.f, 0.f, 0.f, 0.f}; float st_d = -1.f;
#define DSA_ISSUE(ch)                                                                                   \
      {          \
        _Pragma("unroll") for (int r = 0; r < 16; ++r) {                                                \
          const int idx = (int)selq[(ch) * 32 + 2 * r + (lane >> 5)];                                   \
          st[r] = *(const u32x4_t*)(CKV + (tokb + idx) * 256 + (lane & 31) * 8);                        \
        }                                                                                               \
        const int j2 = (ch) * 32 + (lane & 31);                                                         \
        const int idx2 = (int)selq[j2];                                                                 \
        st_ss = *(const f32x4*)(SSP + (tokb + idx2) * 4);                                               \
        st_d = (j2 < nsel) ? (float)(t - idx2) : -1.f;                                                  \
      }
      DSA_ISSUE(0);
#pragma unroll 1
      for (int ch = 0; ch < nch; ++ch) {
        const int lane = tid_fresh() & 63, g = lane >> 4, c = lane & 15;
        LAS unsigned char* buf = lds + DS_KEY16 + wave_b * DS_CHUNK;
        LAS float* kr = (LAS float*)(lds + DS_WAVE + wave_b * 1024);
        LAS float* kd = kr + 32;
        const unsigned vb = (unsigned)(uintptr_t)buf + (unsigned)((4 * g + (c >> 2)) * DS_RS + 8 * (c & 3));
#pragma unroll
        for (int r = 0; r < 16; ++r) *(LAS u32x4_t*)(buf + (2 * r + (lane >> 5)) * DS_RS + (lane & 31) * 16) = st[r];
        if (lane < 32) { kr[lane] = rsqrtf(((st_ss[0] + st_ss[1]) + (st_ss[2] + st_ss[3])) * (1.f / 256.f) + 1e-6f); kd[lane] = st_d; }
        wave_lds_fence();
        DSA_MARKI(11);
        DSA_ISSUE((ch + 1 < nch) ? ch + 1 : ch);
        f32x4 s0 = (f32x4){0.f, 0.f, 0.f, 0.f}, s1 = (f32x4){0.f, 0.f, 0.f, 0.f};
#pragma unroll
        for (int ks = 0; ks < 8; ++ks) {
          const bf16x8_t a0 = *(const LAS bf16x8_t*)(buf + c * DS_RS + (ks * 32 + 8 * g) * 2);
          const bf16x8_t a1 = *(const LAS bf16x8_t*)(buf + (16 + c) * DS_RS + (ks * 32 + 8 * g) * 2);
          s0 = __builtin_amdgcn_mfma_f32_16x16x32_bf16(a0, qf[ks], s0, 0, 0, 0);
          s1 = __builtin_amdgcn_mfma_f32_16x16x32_bf16(a1, qf[ks], s1, 0, 0, 0);
        }
        asm volatile("" :: "v"(s0[0]), "v"(s1[0]));
        DSA_MARKI(12);
        const f32x4 r0 = *(const LAS f32x4*)(kr + 4 * g), r1 = *(const LAS f32x4*)(kr + 16 + 4 * g);
        const f32x4 d0 = *(const LAS f32x4*)(kd + 4 * g), d1 = *(const LAS f32x4*)(kd + 16 + 4 * g);
        float x[8];
#pragma unroll
        for (int i = 0; i < 4; ++i) {
          x[i] = (d0[i] < 0.f) ? -1e30f : (s0[i] * r0[i] - slope * d0[i]);
          x[4 + i] = (d1[i] < 0.f) ? -1e30f : (s1[i] * r1[i] - slope * d1[i]);
        }
        float mx = fmaxf(fmaxf(fmaxf(x[0], x[1]), fmaxf(x[2], x[3])), fmaxf(fmaxf(x[4], x[5]), fmaxf(x[6], x[7])));
        mx = xrow_max(mx);
        const float mn = fmaxf(mrun, mx);
        const float alpha = __expf(mrun - mn);
        mrun = mn;
        float pr[8], ps = 0.f;
#pragma unroll
        for (int i = 0; i < 8; ++i) { pr[i] = (x[i] <= -1e29f) ? 0.f : __expf(x[i] - mn); ps += pr[i]; }
        ps = xrow_sum(ps);
        lrun = lrun * alpha + ps;
        if (__builtin_amdgcn_ballot_w64(alpha != 1.f) != 0ull) {
#pragma unroll
          for (int nt = 0; nt < 16; ++nt) o[nt] *= alpha;
        }
        union { bf16x8_t v; unsigned u[4]; } pf;
        pf.u[0] = pk2(pr[0] * r0[0], pr[1] * r0[1]); pf.u[1] = pk2(pr[2] * r0[2], pr[3] * r0[3]);
        pf.u[2] = pk2(pr[4] * r1[0], pr[5] * r1[1]); pf.u[3] = pk2(pr[6] * r1[2], pr[7] * r1[3]);
        asm volatile("" :: "v"(pf.u[0]));
        DSA_MARKI(13);
        {
          s16x4_t loA[4], hiA[4], loB[4], hiB[4];
#define PV_READ(L, H, nt0) _Pragma("unroll") for (int u = 0; u < 4; ++u) { L[u] = tr_read_b64(vb + ((nt0) + u) * 32); H[u] = tr_read_b64(vb + ((nt0) + u) * 32 + 16 * DS_RS); }
#define PV_MMA(L, H, nt0) _Pragma("unroll") for (int u = 0; u < 4; ++u) { \
            const bf16x8_t af = (bf16x8_t){L[u][0], L[u][1], L[u][2], L[u][3], H[u][0], H[u][1], H[u][2], H[u][3]}; \
            o[(nt0) + u] = __builtin_amdgcn_mfma_f32_16x16x32_bf16(af, pf.v, o[(nt0) + u], 0, 0, 0); }
          PV_READ(loA, hiA, 0);
          PV_READ(loB, hiB, 4);
          asm volatile("s_waitcnt lgkmcnt(8)" ::: "memory"); __builtin_amdgcn_sched_barrier(0);
          PV_MMA(loA, hiA, 0); __builtin_amdgcn_sched_barrier(0);
          PV_READ(loA, hiA, 8);
          asm volatile("s_waitcnt lgkmcnt(8)" ::: "memory"); __builtin_amdgcn_sched_barrier(0);
          PV_MMA(loB, hiB, 4); __builtin_amdgcn_sched_barrier(0);
          PV_READ(loB, hiB, 12);
          asm volatile("s_waitcnt lgkmcnt(8)" ::: "memory"); __builtin_amdgcn_sched_barrier(0);
          PV_MMA(loA, hiA, 8); __builtin_amdgcn_sched_barrier(0);
          asm volatile("s_waitcnt lgkmcnt(0)" ::: "memory"); __builtin_amdgcn_sched_barrier(0);
          PV_MMA(loB, hiB, 12);
#undef PV_READ
#undef PV_MMA
        }
        wave_lds_fence();
        asm volatile("" :: "v"(o[0][0]), "v"(o[15][0]));
        DSA_MARKI(14);
      }
#undef DSA_ISSUE
      if (c < 8) {
        const float inv = 1.f / lrun;
#pragma unroll
        for (int nt = 0; nt < 16; ++nt) {
          uint2 w; w.x = pk2(o[nt][0] * inv, o[nt][1] * inv); w.y = pk2(o[nt][2] * inv, o[nt][3] * inv);
          *(uint2*)(OL + q * 2048 + c * 256 + nt * 16 + 4 * g) = w;
        }
      }
    }
  }
  DSA_MARK(4);
  __syncthreads();
  {
    DSA_IDS
    const int h = wave;
    bf16x8_t of[8];
#pragma unroll
    for (int ks = 0; ks < 8; ++ks) of[ks] = *(const bf16x8_t*)(OL + c * 2048 + h * 256 + ks * 32 + 8 * g);
    f32x4 cres[8];
#pragma unroll
    for (int nt = 0; nt < 8; ++nt) {
      f32x4 a = (f32x4){0.f, 0.f, 0.f, 0.f};
#pragma unroll
      for (int ks = 0; ks < 8; ++ks) {
        const bf16x8_t wf = *(const bf16x8_t*)(WUV + (size_t)(h * 128 + nt * 16 + c) * 256 + ks * 32 + 8 * g);
        a = __builtin_amdgcn_mfma_f32_16x16x32_bf16(wf, of[ks], a, 0, 0, 0);
      }
      cres[nt] = a;
    }
#pragma unroll
    for (int nt = 0; nt < 8; ++nt) {
      uint2 w; w.x = pk2(cres[nt][0], cres[nt][1]); w.y = pk2(cres[nt][2], cres[nt][3]);
      *(uint2*)(ODSA + (tok0 + c) * 1024 + h * 128 + nt * 16 + 4 * g) = w;
    }
  }
  DSA_MARK(5);
  __syncthreads();
}

#undef DSA_IDS
__device__ __forceinline__ void ph_dsa512(const P& p, unsigned char* lds_raw) {
  for (int it = blockIdx.x; it < TT / 16; it += gridDim.x) {
    const int k = it >> 8, j = it & 255;
    dsa_batch(p, lds_raw, k, (k & 1) ? 255 - j : j);
  }
}

#define GL_QD    0
#define GL_KI    18432
#define GL_KE    36864
#define GL_V     55296
#define GL_AT    90112
#define GL_GLOW  99328
#define GL_QT    103424
#define GL_DEC   105472
#define GL_SSQ   105984
#define GL_LB    108032
#define GL_TOTAL 140800

#define GLA_BAR() do { asm volatile("s_waitcnt lgkmcnt(0)" ::: "memory"); __builtin_amdgcn_s_barrier(); asm volatile("" ::: "memory"); } while (0)
#ifndef PROBE_GLA
#define PROBE_GLA 0
#endif
#if PROBE_GLA
#define GLA_MARK(k) do { const unsigned long long n_ = __builtin_amdgcn_s_memrealtime(); if (PROBE_GLA == (k)) { const unsigned long long q_ = n_ - tmark; \
    while (__builtin_amdgcn_s_memrealtime() - n_ < q_) __builtin_amdgcn_s_sleep(2); } tmark = __builtin_amdgcn_s_memrealtime(); } while (0)
#else
#define GLA_MARK(k) do {} while (0)
#endif
__device__ __forceinline__ void gla_item(const P& p, unsigned char* lds_raw, int item) {
  int tid = tid_fresh();
  const int b = item >> 2, h = item & 3;
  const size_t tokb = (size_t)b * SEQ;
  const bf16* Qg = (const bf16*)(p.ws + OFF_Q);
  const bf16* Kg = (const bf16*)(p.ws + OFF_K);
  bf16* Vg = (bf16*)(p.ws + OFF_V);
  const float* GLOWg = (const float*)(p.ws + OFF_GLOW);
  const bf16* SGR = (const bf16*)(p.ws + OFF_SGR);
  LAS unsigned char* lds = (LAS unsigned char*)lds_raw;
  const unsigned lds0 = (unsigned)(uintptr_t)lds;
  LAS float* QT = (LAS float*)(lds + GL_QT);
  LAS float* DEC = (LAS float*)(lds + GL_DEC);
  LAS float* SSQ = (LAS float*)(lds + GL_SSQ);
  float wg[16];
  const float* prm = (const float*)(p.ws + OFF_PRM);
#pragma unroll
  for (int r = 0; r < 16; ++r) wg[r] = prm[PRM_WGU + r * 512 + h * 128 + (tid & 127)];
  const float bg = prm[PRM_BG + h * 128 + (tid & 127)];
  const float gn0 = prm[PRM_GNG + h * 256 + 32 * (tid >> 6) + (tid & 15)], gn1 = prm[PRM_GNG + h * 256 + 32 * (tid >> 6) + 16 + (tid & 15)];
  u32x4_t rq[2], rk[2], rv[4], rg = (u32x4_t){0u, 0u, 0u, 0u};
#define GLA_LOAD(ch)                                                                                      \
  {                                                                                                       \
    const size_t tb = tokb + (size_t)(ch) * 64;                                                           \
    _Pragma("unroll") for (int i = 0; i < 2; ++i) {                                                       \
      const int id = tid + 512 * i, tk = id >> 4, part = id & 15;                                         \
      rq[i] = *(const u32x4_t*)(Qg + (tb + tk) * 512 + h * 128 + part * 8);                               \
      rk[i] = *(const u32x4_t*)(Kg + (tb + tk) * 512 + h * 128 + part * 8);                               \
    }                                                                                                     \
    _Pragma("unroll") for (int i = 0; i < 4; ++i) {                                                       \
      const int id = tid + 512 * i, tk = id >> 5, part = id & 31;                                         \
      rv[i] = *(const u32x4_t*)(Vg + (tb + tk) * 1024 + h * 256 + part * 8);                              \
    }                                                                                                     \
    if (tid < 256) rg = *(const u32x4_t*)(GLOWg + (tb + (tid >> 2)) * 16 + (tid & 3) * 4);                \
  }
  f32x4 S[8][2];
#pragma unroll
  for (int a = 0; a < 8; ++a) { S[a][0] = (f32x4){0.f, 0.f, 0.f, 0.f}; S[a][1] = (f32x4){0.f, 0.f, 0.f, 0.f}; }
  GLA_LOAD(0);
#if PROBE_GLA
  unsigned long long tmark = __builtin_amdgcn_s_memrealtime();
#endif
#pragma unroll 1
  for (int ch = 0; ch < SEQ / 64; ++ch) {
    asm volatile("" : "+v"(tid));
    const int wave = __builtin_amdgcn_readfirstlane(tid >> 6), lane = tid & 63, g = lane >> 4, c = lane & 15;
    const int d = tid & 127, tq = __builtin_amdgcn_readfirstlane(tid >> 7);
    const unsigned vtr = lds0 + GL_V + (unsigned)((8 * g + (c >> 2)) * 544 + (32 * wave + 4 * (c & 3)) * 2);
    const unsigned ketr = lds0 + GL_KE + (unsigned)((8 * g + (c >> 2)) * 288 + (4 * (c & 3)) * 2);
    const size_t tb = tokb + (size_t)ch * 64;
#pragma unroll
    for (int i = 0; i < 2; ++i) {
      const int id = tid + 512 * i, tk = id >> 4, part = id & 15;
      *(LAS u32x4_t*)(lds + GL_QD + tk * 288 + part * 16) = rq[i];
      *(LAS u32x4_t*)(lds + GL_KI + tk * 288 + part * 16) = rk[i];
    }
#pragma unroll
    for (int i = 0; i < 4; ++i) {
      const int id = tid + 512 * i, tk = id >> 5, part = id & 31;
      *(LAS u32x4_t*)(lds + GL_V + tk * 544 + part * 16) = rv[i];
    }
    if (tid < 256) *(LAS u32x4_t*)(lds + GL_GLOW + (tid >> 2) * 64 + (tid & 3) * 16) = rg;
    GLA_MARK(1); GLA_BAR();
    GLA_LOAD((ch + 1 < SEQ / 64) ? ch + 1 : ch);
    u32x4_t rs[4];
#pragma unroll
    for (int i = 0; i < 4; ++i) {
      const int id = tid + 512 * i, tk = id >> 5, part = id & 31;
      rs[i] = *(const u32x4_t*)(SGR + (tb + tk) * 1024 + h * 256 + part * 8);
    }
    LAS float* LB = (LAS float*)(lds + GL_LB);
    float run = 0.f;
#pragma unroll 2
    for (int i = 0; i < 16; ++i) {
      const LAS f32x4* gp = (const LAS f32x4*)(lds + GL_GLOW + (16 * tq + i) * 64);
      const f32x4 g0 = gp[0], g1 = gp[1], g2 = gp[2], g3 = gp[3];
      float gl = bg;
      gl += g0[0] * wg[0] + g0[1] * wg[1] + g0[2] * wg[2] + g0[3] * wg[3];
      gl += g1[0] * wg[4] + g1[1] * wg[5] + g1[2] * wg[6] + g1[3] * wg[7];
      gl += g2[0] * wg[8] + g2[1] * wg[9] + g2[2] * wg[10] + g2[3] * wg[11];
      gl += g3[0] * wg[12] + g3[1] * wg[13] + g3[2] * wg[14] + g3[3] * wg[15];
      const float ls = fminf(gl, 0.f) - __logf(1.f + __expf(-fabsf(gl)));
      run += ls * (1.f / 16.f);
      LB[(16 * tq + i) * 128 + d] = run;
    }
    QT[tq * 128 + d] = run;
    GLA_MARK(2); GLA_BAR();
    {
      float off = 0.f, tot = 0.f;
#pragma unroll
      for (int k = 0; k < 4; ++k) { const float v = QT[k * 128 + d]; tot += v; off += (k < tq) ? v : 0.f; }
      const float eb = __expf(tot);
#pragma unroll 2
      for (int i = 0; i < 16; ++i) {
        const int t = 16 * tq + i;
        const float bb = LB[t * 128 + d] + off;
        const float e = __expf(bb), r = __expf(-bb);
        LAS bf16* qp = (LAS bf16*)(lds + GL_QD + t * 288) + d;
        LAS bf16* kp = (LAS bf16*)(lds + GL_KI + t * 288) + d;
        LAS bf16* ep = (LAS bf16*)(lds + GL_KE + t * 288) + d;
        const float q = bf2f(*qp), k = bf2f(*kp);
        *qp = f2bf(q * e);
        *kp = f2bf(k * r);
        *ep = f2bf(k * (eb * r));
      }
      if (tq == 0) DEC[d] = eb;
    }
    GLA_MARK(3); GLA_BAR();
    {
      const int ti = wave >> 1;
#pragma unroll
      for (int u = 0; u < 2; ++u) {
        const int tj = 2 * (wave & 1) + u;
        f32x4 acc = (f32x4){0.f, 0.f, 0.f, 0.f};
        if (tj <= ti) {
#pragma unroll
          for (int ks = 0; ks < 4; ++ks) {
            const bf16x8_t a = *(const LAS bf16x8_t*)(lds + GL_QD + (16 * ti + c) * 288 + (32 * ks + 8 * g) * 2);
            const bf16x8_t bb = *(const LAS bf16x8_t*)(lds + GL_KI + (16 * tj + c) * 288 + (32 * ks + 8 * g) * 2);
            acc = __builtin_amdgcn_mfma_f32_16x16x32_bf16(a, bb, acc, 0, 0, 0);
          }
        }
#pragma unroll
        for (int r = 0; r < 4; ++r) {
          const int i = 16 * ti + 4 * g + r, j = 16 * tj + c;
          *((LAS bf16*)(lds + GL_AT + i * 144) + j) = f2bf((j <= i) ? acc[r] : 0.f);
        }
      }
    }
    GLA_MARK(4); GLA_BAR();
    f32x4 o[4][2];
    {
      bf16x8_t vf[2][2];
      {
        s16x4_t lo[4], hi[4];
#pragma unroll
        for (int ks = 0; ks < 2; ++ks)
#pragma unroll
          for (int tn = 0; tn < 2; ++tn) {
            lo[ks * 2 + tn] = tr_read_b64(vtr + (32 * ks) * 544 + tn * 32);
            hi[ks * 2 + tn] = tr_read_b64(vtr + (32 * ks + 4) * 544 + tn * 32);
          }
        asm volatile("s_waitcnt lgkmcnt(0)" ::: "memory");
        __builtin_amdgcn_sched_barrier(0);
#pragma unroll
        for (int u = 0; u < 4; ++u)
          vf[u >> 1][u & 1] = (bf16x8_t){lo[u][0], lo[u][1], lo[u][2], lo[u][3], hi[u][0], hi[u][1], hi[u][2], hi[u][3]};
      }
#pragma unroll
      for (int tm = 0; tm < 4; ++tm) { o[tm][0] = (f32x4){0.f, 0.f, 0.f, 0.f}; o[tm][1] = (f32x4){0.f, 0.f, 0.f, 0.f}; }
#pragma unroll
      for (int tm = 0; tm < 4; ++tm)
#pragma unroll
        for (int ks = 0; ks < 2; ++ks) {
          if (ks == 1 && tm < 2) continue;
          const bf16x8_t a = *(const LAS bf16x8_t*)(lds + GL_AT + (16 * tm + c) * 144 + (32 * ks + 8 * g) * 2);
          o[tm][0] = __builtin_amdgcn_mfma_f32_16x16x32_bf16(a, vf[ks][0], o[tm][0], 0, 0, 0);
          o[tm][1] = __builtin_amdgcn_mfma_f32_16x16x32_bf16(a, vf[ks][1], o[tm][1], 0, 0, 0);
          __builtin_amdgcn_sched_barrier(0);
        }
#pragma unroll
      for (int u = 0; u < 4; ++u) {
        union { bf16x8_t v; unsigned w[4]; } s0, s1;
        s0.w[0] = pk2(S[2 * u][0][0], S[2 * u][0][1]); s0.w[1] = pk2(S[2 * u][0][2], S[2 * u][0][3]);
        s0.w[2] = pk2(S[2 * u + 1][0][0], S[2 * u + 1][0][1]); s0.w[3] = pk2(S[2 * u + 1][0][2], S[2 * u + 1][0][3]);
        s1.w[0] = pk2(S[2 * u][1][0], S[2 * u][1][1]); s1.w[1] = pk2(S[2 * u][1][2], S[2 * u][1][3]);
        s1.w[2] = pk2(S[2 * u + 1][1][0], S[2 * u + 1][1][1]); s1.w[3] = pk2(S[2 * u + 1][1][2], S[2 * u + 1][1][3]);
#pragma unroll
        for (int tm = 0; tm < 4; ++tm) {
          const LAS unsigned char* qrow = lds + GL_QD + (16 * tm + c) * 288 + (32 * u + 4 * g) * 2;
          const s16x4_t q0 = *(const LAS s16x4_t*)qrow, q1 = *(const LAS s16x4_t*)(qrow + 32);
          const bf16x8_t a = (bf16x8_t){q0[0], q0[1], q0[2], q0[3], q1[0], q1[1], q1[2], q1[3]};
          o[tm][0] = __builtin_amdgcn_mfma_f32_16x16x32_bf16(a, s0.v, o[tm][0], 0, 0, 0);
          o[tm][1] = __builtin_amdgcn_mfma_f32_16x16x32_bf16(a, s1.v, o[tm][1], 0, 0, 0);
        }
        __builtin_amdgcn_sched_barrier(0);
      }
#pragma unroll
      for (int tk = 0; tk < 8; ++tk) {
        const f32x4 dec4 = *(const LAS f32x4*)(DEC + 16 * tk + 4 * g);
        S[tk][0] *= dec4; S[tk][1] *= dec4;
        s16x4_t lo0 = tr_read_b64(ketr + tk * 32), hi0 = tr_read_b64(ketr + 4 * 288 + tk * 32);
        s16x4_t lo1 = tr_read_b64(ketr + 32 * 288 + tk * 32), hi1 = tr_read_b64(ketr + 36 * 288 + tk * 32);
        asm volatile("s_waitcnt lgkmcnt(0)" ::: "memory");
        __builtin_amdgcn_sched_barrier(0);
        const bf16x8_t a0 = (bf16x8_t){lo0[0], lo0[1], lo0[2], lo0[3], hi0[0], hi0[1], hi0[2], hi0[3]};
        const bf16x8_t a1 = (bf16x8_t){lo1[0], lo1[1], lo1[2], lo1[3], hi1[0], hi1[1], hi1[2], hi1[3]};
        S[tk][0] = __builtin_amdgcn_mfma_f32_16x16x32_bf16(a0, vf[0][0], S[tk][0], 0, 0, 0);
        S[tk][1] = __builtin_amdgcn_mfma_f32_16x16x32_bf16(a0, vf[0][1], S[tk][1], 0, 0, 0);
        S[tk][0] = __builtin_amdgcn_mfma_f32_16x16x32_bf16(a1, vf[1][0], S[tk][0], 0, 0, 0);
        S[tk][1] = __builtin_amdgcn_mfma_f32_16x16x32_bf16(a1, vf[1][1], S[tk][1], 0, 0, 0);
        __builtin_amdgcn_sched_barrier(0);
      }
#pragma unroll
      for (int tm = 0; tm < 4; ++tm)
#pragma unroll
        for (int r = 0; r < 4; ++r) {
          float ss = o[tm][0][r] * o[tm][0][r] + o[tm][1][r] * o[tm][1][r];
          ss = row16_sum(ss);
          if (c == 0) SSQ[(16 * tm + 4 * g + r) * 8 + wave] = ss;
        }
    }
    GLA_MARK(5); GLA_BAR();
    {
      LAS bf16* OB = (LAS bf16*)(lds + GL_LB);
#pragma unroll
      for (int tm = 0; tm < 4; ++tm)
#pragma unroll
        for (int r = 0; r < 4; ++r) {
          const int t = 16 * tm + 4 * g + r;
          const f32x4 p0 = *(const LAS f32x4*)(SSQ + t * 8), p1 = *(const LAS f32x4*)(SSQ + t * 8 + 4);
          const float tot = ((p0[0] + p0[1]) + (p0[2] + p0[3])) + ((p1[0] + p1[1]) + (p1[2] + p1[3]));
          const float rstd = rsqrtf(tot * (1.f / 256.f) + 1e-6f);
          OB[t * 256 + 32 * wave + c] = f2bf(o[tm][0][r] * rstd * gn0);
          OB[t * 256 + 32 * wave + 16 + c] = f2bf(o[tm][1][r] * rstd * gn1);
        }
    }
    GLA_MARK(6); GLA_BAR();
#pragma unroll
    for (int i = 0; i < 4; ++i) {
      const int id = tid + 512 * i, tk = id >> 5, part = id & 31;
      const u32x4_t ov = *(const LAS u32x4_t*)(lds + GL_LB + tk * 512 + part * 16);
      const u32x4_t sv = rs[i];
      u32x4_t gv;
      gv[0] = pk2(bflo(ov[0]) * bflo(sv[0]), bfhi(ov[0]) * bfhi(sv[0]));
      gv[1] = pk2(bflo(ov[1]) * bflo(sv[1]), bfhi(ov[1]) * bfhi(sv[1]));
      gv[2] = pk2(bflo(ov[2]) * bflo(sv[2]), bfhi(ov[2]) * bfhi(sv[2]));
      gv[3] = pk2(bflo(ov[3]) * bflo(sv[3]), bfhi(ov[3]) * bfhi(sv[3]));
      *(u32x4_t*)(Vg + (tb + tk) * 1024 + h * 256 + part * 8) = gv;
    }
    GLA_MARK(7);
  }
#undef GLA_LOAD
  __syncthreads();
}

#define LDS_BYTES 155712
#define OFF_XBAR (224ull * 1024)
#define OFF_CTR (200ull * 1024)

__device__ __forceinline__ unsigned xcc_id() { return (unsigned)__builtin_amdgcn_s_getreg((3 << 11) | 20) & 0x7u; }
__device__ __forceinline__ void ph_mixer(const P& p, unsigned char* lds_raw, bool do_gla) {
  if (do_gla && blockIdx.x < 32) { gla_item(p, lds_raw, blockIdx.x); if (blockIdx.x == 0) TS_SET(p, 20); }
  unsigned* ctr = (unsigned*)(p.ws + OFF_CTR);
  LAS unsigned* slot = (LAS unsigned*)((LAS unsigned char*)lds_raw + DS_TOTAL);
  const unsigned home = xcc_id();
  unsigned k = 0;
  for (;;) {
    if (tid_fresh() == 0) {
      unsigned qi = 0xffffffffu;
      while (k < 8) {
        const unsigned b = (home + k) & 7u;
        const unsigned v = __hip_atomic_fetch_add(ctr + 64 * b, 1u, __ATOMIC_RELAXED, __HIP_MEMORY_SCOPE_AGENT);
        if (v < 256u) { qi = (b << 8) | v; break; }
        ++k;
      }
      slot[0] = qi; slot[1] = k;
    }
    __syncthreads();
    const unsigned qi = slot[0];
    k = slot[1];
    __syncthreads();
    if (qi == 0xffffffffu) break;
    dsa_batch(p, lds_raw, (int)(qi >> 8), 255 - (int)(qi & 255u));
  }
}

__global__ void __launch_bounds__(512, 2) mega(P p) {
  extern __shared__ __attribute__((aligned(16))) unsigned char lds_raw[];
  LAS unsigned char* lds = (LAS unsigned char*)lds_raw;
  cg::grid_group grid = cg::this_grid();
  char* ws = p.ws;
  const int bid = blockIdx.x, nb = gridDim.x;
  if (bid == 0 && threadIdx.x < 8) *(unsigned*)(ws + OFF_CTR + 256 * threadIdx.x) = 0u;
  if (bid == 0) { for (int i = threadIdx.x; i < XCD_BAR_WORDS; i += 512) ((unsigned*)(ws + OFF_XBAR))[i] = 0u; }
  volatile LAS unsigned* xst = (volatile LAS unsigned*)(lds + DS_TOTAL + 16);
  if (threadIdx.x < 4) xst[threadIdx.x] = 0u;
#if PROBE_TS
  { const int t_ = tid_fresh(); if (bid == 0 && t_ < 64) ((unsigned long long*)(ws + OFF_TS))[t_] = 0ull; }
  __syncthreads();
  if (bid == 0) TS_SET(p, 0);
#endif
  ph_prep(p, (float*)lds_raw);
  grid.sync();
  const XcdBarrier xb = xcd_barrier_post((unsigned*)(ws + OFF_XBAR), xst);
  if (bid == 0) TS_SET(p, 1);
  ph_mod(p, p.x, p.norm1_g, 0, 1024, (bf16*)(ws + OFF_H), bid, nb);
  xcd_barrier(xb);
  if (bid == 0) TS_SET(p, 2);
  gemm_run(lds, (const bf16*)(ws + OFF_H), (const bf16*)(ws + OFF_WT_IN), TT, 7168, 1024, EpiIn{ws, p.out});
  xcd_barrier(xb);
  if (bid == 0) TS_SET(p, 3);
  ph_mixer(p, lds_raw, true);
  if (bid == 0) TS_SET(p, 21);
  xcd_barrier(xb);
  if (bid == 0) TS_SET(p, 4);
  gemm_run(lds, (const bf16*)(ws + OFF_V), (const bf16*)(ws + OFF_WT_A), TT, 1024, 1024,
           EpiMix<false>{(const bf16*)p.out, (bf16*)(ws + OFF_MIX)});
  gemm_run(lds, (const bf16*)(ws + OFF_ODSA), (const bf16*)(ws + OFF_WT_B), TT, 1024, 1024,
           EpiMix<true>{(const bf16*)p.out + (size_t)TT * 1024, (bf16*)(ws + OFF_MIX)});
  xcd_barrier(xb);
  if (bid == 0) TS_SET(p, 5);
  gemm_run(lds, (const bf16*)(ws + OFF_MIX), (const bf16*)(ws + OFF_WT_OUT), TT, 1024, 1024,
           EpiX1{p.x, (const float*)(ws + OFF_ADA), p.out});
  xcd_barrier(xb);
  if (bid == 0) TS_SET(p, 6);
  ph_mod(p, p.out, (const float*)(ws + OFF_PRM) + PRM_N2G, 3072, 4096, (bf16*)(ws + OFF_H), bid, nb);
  xcd_barrier(xb);
  if (bid == 0) TS_SET(p, 7);
  gemm_run(lds, (const bf16*)(ws + OFF_H), (const bf16*)(ws + OFF_WT_Q), TT, 2048, 1024, EpiPlain{(bf16*)(ws + OFF_PQ), 2048});
  xcd_barrier(xb);
  if (bid == 0) TS_SET(p, 8);
  ph_peer512(p, lds_raw, p.out);
#if PROBE_TS
  if (bid == 0) TS_SET(p, 18);
  xcd_barrier(xb);
  {
    const unsigned long long* T = (const unsigned long long*)(ws + OFF_TS);
    const unsigned long long q = (unsigned long long)(PROBE_Q), t0 = __builtin_amdgcn_s_memrealtime();
    while (__builtin_amdgcn_s_memrealtime() - t0 < q) __builtin_amdgcn_s_sleep(8);
  }
#endif
}

extern "C" void kernel_launch(void* const* d_in, const int* in_sizes, int n_in, void* d_out, int out_size, void* d_ws,
                              size_t ws_size, hipStream_t stream) {
  P p{};
  const float** f = (const float**)&p;
  for (int i = 0; i < 22; ++i) f[i] = (const float*)d_in[i];
  p.out = (float*)d_out;
  p.ws = (char*)d_ws;
  if (ws_size < WS_NEED) { fprintf(stderr, "workspace too small: %zu\n", ws_size); return; }
  static int grid_blocks = 0;
  if (!grid_blocks) {
    int dev = 0, cus = 0, per_cu = 0;
    (void)hipGetDevice(&dev);
    (void)hipDeviceGetAttribute(&cus, hipDeviceAttributeMultiprocessorCount, dev);
    if (hipFuncSetAttribute((const void*)mega, hipFuncAttributeMaxDynamicSharedMemorySize, LDS_BYTES) != hipSuccess) {
      fprintf(stderr, "hipFuncSetAttribute failed\n"); grid_blocks = -1; return;
    }
    if (hipOccupancyMaxActiveBlocksPerMultiprocessor(&per_cu, (const void*)mega, 512, LDS_BYTES) != hipSuccess || per_cu < 1) {
      fprintf(stderr, "occupancy query failed\n"); grid_blocks = -1; return;
    }
    grid_blocks = cus;
  }
  if (grid_blocks <= 0) return;
  void* args[] = {&p};
  hipError_t e = hipLaunchCooperativeKernel((void*)mega, dim3(grid_blocks), dim3(512), args, LDS_BYTES, stream);
  if (e != hipSuccess) fprintf(stderr, "cooperative launch failed: %s (grid %d)\n", hipGetErrorString(e), grid_blocks);
}
```

```cpp
#include <hip/hip_runtime.h>
#include <hip/hip_cooperative_groups.h>
#include <cstdio>
#include <cstdint>
namespace cg = cooperative_groups;

#define TT 32768
#define SEQ 4096
#define DM 1024
#define NIN 7000
typedef unsigned short bf16;
#define LAS __attribute__((address_space(3)))

struct P {
  const float *x, *c, *w_ada, *b_ada, *norm1_g, *w_in, *w_gate_up, *b_gate, *gla_norm_g, *kv_norm_g,
      *w_uk, *w_uv, *w_a, *w_b, *w_out, *norm2_g, *w_q, *sk1, *sk2, *peer_u, *peer_v, *final_g;
  float* out;
  char* ws;
};

#define MB (1ull << 20)
#define OFF_ADA   (0ull)
#define OFF_H     (1 * MB)
#define OFF_ODSA  (1 * MB)
#define OFF_Q     (65 * MB)
#define OFF_K     (97 * MB)
#define OFF_MIX   (65 * MB)
#define OFF_V     (129 * MB)
#define OFF_DQ    (193 * MB)
#define OFF_PQ    (129 * MB)
#define OFF_DSCR  (257 * MB)
#define OFF_SSP   (256ull * 1024)
#define OFF_CKV   (289 * MB)
#define OFF_IQ    (305 * MB)
#define OFF_IK    (337 * MB)
#define OFF_IW    (341 * MB)
#define OFF_GLOW  (342 * MB)
#define OFF_SGR   (344 * MB)
#define OFF_WT    (408 * MB)
#define OFF_WT_IN  (OFF_WT)
#define OFF_WT_A   (OFF_WT + 7168ull * 2048)
#define OFF_WT_B   (OFF_WT_A + 1024ull * 2048)
#define OFF_WT_OUT (OFF_WT_B + 1024ull * 2048)
#define OFF_WT_Q   (OFF_WT_OUT + 1024ull * 2048)
#define OFF_PU    (432 * MB)
#define OFF_PV    (464 * MB)
#define OFF_SK    (496 * MB)
#define OFF_PSC   (496 * MB + 128 * 1024)
#define OFF_WUK   (497 * MB)
#define OFF_WUV   (497 * MB + 512 * 1024)
#define WS_NEED   (498 * MB)

__device__ __forceinline__ bf16 f2bf(float f) {
  unsigned u = __float_as_uint(f);
  u += 0x7fffu + ((u >> 16) & 1u);
  return (bf16)(u >> 16);
}
__device__ __forceinline__ unsigned pk2(float lo, float hi) { return (unsigned)f2bf(lo) | ((unsigned)f2bf(hi) << 16); }
__device__ __forceinline__ float bf2f(bf16 h) { return __uint_as_float(((unsigned)h) << 16); }
__device__ __forceinline__ float bflo(unsigned u) { return __uint_as_float(u << 16); }
__device__ __forceinline__ float bfhi(unsigned u) { return __uint_as_float(u & 0xffff0000u); }
__device__ __forceinline__ float wave_sum(float v) {
#pragma unroll
  for (int o = 32; o > 0; o >>= 1) v += __shfl_xor(v, o);
  return v;
}
__device__ __forceinline__ float wave_max(float v) {
#pragma unroll
  for (int o = 32; o > 0; o >>= 1) v = fmaxf(v, __shfl_xor(v, o));
  return v;
}
#ifndef PROBE_TS
#define PROBE_TS 0
#endif
#define OFF_PRM (800ull * 1024)
#define PRM_WGU   0
#define PRM_BG    8192
#define PRM_GNG   8704
#define PRM_N2G   9728
#define PRM_FG    10752
#define PRM_TOTAL 11776
#define OFF_TS (208ull * 1024)
#if PROBE_TS
#define TS_SET(p, k) do { if (tid_fresh() == 0) ((unsigned long long*)((p).ws + OFF_TS))[k] = __builtin_amdgcn_s_memrealtime(); } while (0)
#define TS_ADD(p, k, t0) do { if (tid_fresh() == 0) ((unsigned long long*)((p).ws + OFF_TS))[k] += __builtin_amdgcn_s_memrealtime() - (t0); } while (0)
#define TS_NOW() __builtin_amdgcn_s_memrealtime()
#else
#define TS_SET(p, k) do {} while (0)
#define TS_ADD(p, k, t0) do {} while (0)
#define TS_NOW() 0ull
#endif
__device__ __forceinline__ int tid_fresh() { int t = threadIdx.x; asm volatile("" : "+v"(t)); return t; }
__device__ __forceinline__ float sigmoidf_(float v) { return 1.f / (1.f + __expf(-v)); }
__device__ __forceinline__ float siluf_(float v) { return v / (1.f + __expf(-v)); }

#include <hip/hip_runtime.h>
namespace pg8 {
#define PG8_LAS __attribute__((address_space(3)))
typedef unsigned short bf16_t;
typedef short bf16x8 __attribute__((ext_vector_type(8)));
typedef float f32x4 __attribute__((ext_vector_type(4)));
typedef unsigned u32x4 __attribute__((ext_vector_type(4)));
constexpr int BM = 256, BK = 64, HALF = 128, HTB = HALF * BK * 2  , STAGE_BYTES = 8 * HTB, NXCD = 8, WGM = 8;

__host__ __device__ __forceinline__ int lds_byte(int r, int c) { const int st = (r >> 4) * 2 + (c >> 5), rr = r & 15, cc = c & 31, ob = rr * 64 + cc * 2; return st * 1024 + (ob ^ (((ob >> 9) & 1) << 5)); }
__host__ __device__ __forceinline__ void stage_rc(int b, int& R, int& C) { const int st = b / 1024, sb = b % 1024, swz = sb ^ (((sb >> 9) & 1) << 5); R = (st >> 1) * 16 + swz / 64; C = (st & 1) * 32 + (swz % 64) / 2; }
__host__ __device__ __forceinline__ int perm32(int rho) { const int n = rho >> 4, i = rho & 15; return 8 * (i >> 2) + 4 * n + (i & 3); }

struct Unit { int pm, pn; };
struct Gemm { const bf16_t* A; const bf16_t* Bt; int M, N, K; };

struct StaticOrder {
    int nM, nN, nwg, G, c;
    __host__ __device__ void init(int M, int N, int G_, int c_) { nM = M / BM; nN = N / BM; nwg = nM * nN; G = G_; c = c_; }
    __host__ __device__ bool next(int i, Unit& u) const {
        const long L = (long)i * G + c; if (L >= nwg) return false;
        int wgid = (int)L; { const int q = nwg / NXCD, r = nwg % NXCD, xcd = wgid % NXCD, off = wgid / NXCD; wgid = (xcd < r ? xcd * (q + 1) : r * (q + 1) + (xcd - r) * q) + off; }
        const int nig = WGM * nN, gid = wgid / nig, fm = gid * WGM, gsz = (nM - fm) < WGM ? (nM - fm) : WGM;
        u.pm = fm + ((wgid % nig) % gsz); u.pn = (wgid % nig) / gsz; return true;
    }
    __device__ __forceinline__ void a_ready(const Unit&) const {}
    __device__ __forceinline__ void done(const Unit&) const {}
};
__device__ __forceinline__ unsigned cvt_pk_bf16(float lo, float hi) { unsigned r; asm volatile("v_cvt_pk_bf16_f32 %0, %1, %2" : "=v"(r) : "v"(lo), "v"(hi)); return r; }

template <class Epi, class Sched, bool STAMP = false>
__device__ __forceinline__ void gemm_phase(PG8_LAS unsigned char* lds, const Gemm g, const Sched& S, const Epi& E, unsigned long long* stamps) {
    const int tid = ::tid_fresh(), wid = __builtin_amdgcn_readfirstlane(tid >> 6), lane = tid & 63, wr = wid >> 2, wc = wid & 3, fr = lane & 15, fq = lane >> 4;
    const int K = g.K, nt = K / BK;
    int ts_lo = 0, ts_hi = 0, nts = 0; const unsigned long long rt_entry = STAMP ? (unsigned long long)wall_clock64() : 0ull;
#define PG8_STAMP() do { if (STAMP && wid == 0 && nts < 64) { const unsigned long long _c = (unsigned long long)clock64(); \
        ts_lo = (lane == nts) ? (int)(unsigned)_c : ts_lo; ts_hi = (lane == nts) ? (int)(unsigned)(_c >> 32) : ts_hi; ++nts; } } while (0)
    PG8_STAMP();
    unsigned voffA[2], voffB[2];
#pragma unroll
    for (int i = 0; i < 2; ++i) { int R, C; stage_rc(tid * 16 + i * 8192, R, C); const int Rb = Epi::PERM ? ((R & ~31) + perm32(R & 31)) : R;
        voffA[i] = (unsigned)(R * K + C) * 2u; voffB[i] = (unsigned)(Rb * K + C) * 2u; }
    const size_t kstep = (size_t)(BK * 2);
    const size_t hstep = (size_t)HALF * K * 2;
    const size_t tstep = 2 * hstep;
    const unsigned ldsw = (unsigned)wid * 1024u;
    const int aoff = lds_byte(wr * 64 + fr, fq * 8), boff = lds_byte(wc * 32 + fr, fq * 8);
#define PG8_SA(b, h) (((b) * 2 + (h)) * HTB)
#define PG8_SB(b, h) ((4 + (b) * 2 + (h)) * HTB)
#define PG8_STAGE(bufoff, gbase, voff) do { _Pragma("unroll") for (int _i = 0; _i < 2; ++_i) \
        __builtin_amdgcn_global_load_lds((const unsigned*)((const char*)(gbase) + (voff)[_i]), (PG8_LAS unsigned*)(lds + (bufoff) + ldsw + _i * 8192), 16, 0, 0); } while (0)
#define PG8_LDA(dst, b, h) do { _Pragma("unroll") for (int m = 0; m < 4; ++m) _Pragma("unroll") for (int k = 0; k < 2; ++k) dst[m][k] = *(const PG8_LAS bf16x8*)(lds + PG8_SA(b, h) + aoff + m * 2048 + k * 1024); } while (0)
#define PG8_LDB(dst, b, h) do { _Pragma("unroll") for (int n = 0; n < 2; ++n) _Pragma("unroll") for (int k = 0; k < 2; ++k) dst[n][k] = *(const PG8_LAS bf16x8*)(lds + PG8_SB(b, h) + boff + n * 2048 + k * 1024); } while (0)
#define PG8_MMA(ai, bj, At, Bt) do { __builtin_amdgcn_s_setprio(1); _Pragma("unroll") for (int m = 0; m < 4; ++m) _Pragma("unroll") for (int n = 0; n < 2; ++n) _Pragma("unroll") for (int k = 0; k < 2; ++k) \
        acc[ai][bj][m][n] = __builtin_amdgcn_mfma_f32_16x16x32_bf16(Bt[n][k], At[m][k], acc[ai][bj][m][n], 0, 0, 0); __builtin_amdgcn_s_setprio(0); } while (0)
#define PG8_WAIT_V(n) asm volatile("s_waitcnt vmcnt(" #n ")" ::: "memory")
#define PG8_WAIT_L(n) asm volatile("s_waitcnt lgkmcnt(" #n ")" ::: "memory")
#define PG8_BAR __builtin_amdgcn_s_barrier()
#define PG8_SCHED __builtin_amdgcn_sched_barrier(0)
    Unit cur, nxt; int ui = 0;
    if (!S.next(0, cur)) return;
    f32x4 acc[2][2][4][2];
#pragma unroll
    for (int a = 0; a < 2; ++a)
#pragma unroll
        for (int b = 0; b < 2; ++b)
#pragma unroll
            for (int m = 0; m < 4; ++m)
#pragma unroll
                for (int n = 0; n < 2; ++n) acc[a][b][m][n] = (f32x4){0.f, 0.f, 0.f, 0.f};
    bf16x8 At[4][2], B0[2][2], B1[2][2];
    const char* cA = (const char*)g.A + (size_t)cur.pm * tstep; const char* cB = (const char*)g.Bt + (size_t)cur.pn * tstep;
    S.a_ready(cur);
    PG8_STAGE(PG8_SB(0, 0), cB, voffB); PG8_STAGE(PG8_SA(0, 0), cA, voffA); PG8_STAGE(PG8_SB(0, 1), cB + hstep, voffB); PG8_STAGE(PG8_SA(0, 1), cA + hstep, voffA);
    if (wr == 1) PG8_BAR;
    PG8_WAIT_V(4); PG8_BAR;
    PG8_STAGE(PG8_SB(1, 0), cB + kstep, voffB); PG8_STAGE(PG8_SA(1, 0), cA + kstep, voffA); PG8_STAGE(PG8_SB(1, 1), cB + hstep + kstep, voffB);
    PG8_WAIT_V(6); PG8_BAR;
    PG8_STAMP();
    for (;;) {
        const bool has_next = S.next(ui + 1, nxt);
        const char* nA = has_next ? (const char*)g.A + (size_t)nxt.pm * tstep : cA; const char* nB = has_next ? (const char*)g.Bt + (size_t)nxt.pn * tstep : cB;
        for (int t = 0; t < nt; t += 2) {
            const bool last = (t == nt - 2);
            const char* a1 = cA + (size_t)(t + 1) * kstep;
            const char* a2 = last ? nA : cA + (size_t)(t + 2) * kstep; const char* b2 = last ? nB : cB + (size_t)(t + 2) * kstep;
            const char* a3 = a2 + kstep; const char* b3 = b2 + kstep;
            if (last && has_next) S.a_ready(nxt);
            PG8_LDB(B0, 0, 0); PG8_SCHED; PG8_LDA(At, 0, 0); PG8_STAGE(PG8_SA(1, 1), a1 + hstep, voffA);
            PG8_WAIT_L(8); PG8_BAR; PG8_WAIT_L(0); PG8_MMA(0, 0, At, B0); PG8_BAR; PG8_SCHED;
            PG8_LDB(B1, 0, 1); PG8_STAGE(PG8_SB(0, 0), b2, voffB);
            PG8_BAR; PG8_WAIT_L(0); PG8_MMA(0, 1, At, B1); PG8_BAR;
            PG8_LDA(At, 0, 1); PG8_STAGE(PG8_SA(0, 0), a2, voffA);
            PG8_BAR; PG8_WAIT_L(0); PG8_MMA(1, 0, At, B0); PG8_BAR; PG8_SCHED;
            PG8_STAGE(PG8_SB(0, 1), b2 + hstep, voffB);
            PG8_WAIT_V(6); PG8_BAR; PG8_MMA(1, 1, At, B1); PG8_BAR;
            PG8_LDB(B0, 1, 0); PG8_SCHED; PG8_LDA(At, 1, 0); PG8_STAGE(PG8_SA(0, 1), a2 + hstep, voffA);
            PG8_WAIT_L(8); PG8_BAR; PG8_WAIT_L(0); PG8_MMA(0, 0, At, B0); PG8_BAR; PG8_SCHED;
            PG8_LDB(B1, 1, 1); PG8_STAGE(PG8_SB(1, 0), b3, voffB);
            PG8_BAR; PG8_WAIT_L(0); PG8_MMA(0, 1, At, B1); PG8_BAR;
            PG8_LDA(At, 1, 1); PG8_STAGE(PG8_SA(1, 0), a3, voffA);
            PG8_BAR; PG8_WAIT_L(0); PG8_MMA(1, 0, At, B0); PG8_BAR; PG8_SCHED;
            PG8_STAGE(PG8_SB(1, 1), b3 + hstep, voffB);
            PG8_WAIT_V(6); PG8_BAR; PG8_MMA(1, 1, At, B1); PG8_BAR;
        }
        PG8_STAMP();
        if constexpr (!Epi::AFTER_DRAIN) { E(acc, cur, wr, wc, fr, fq); S.done(cur); }
        PG8_STAMP();
        if (!has_next) break;
#pragma unroll
        for (int a = 0; a < 2; ++a)
#pragma unroll
            for (int b = 0; b < 2; ++b)
#pragma unroll
                for (int m = 0; m < 4; ++m)
#pragma unroll
                    for (int n = 0; n < 2; ++n) acc[a][b][m][n] = (f32x4){0.f, 0.f, 0.f, 0.f};
        cur = nxt; cA = nA; cB = nB; ++ui;
    }
    PG8_WAIT_V(0);
    if (wr == 0) PG8_BAR;
    PG8_BAR;
    if constexpr (Epi::AFTER_DRAIN) { E.fused(acc, cur, wr, wc, fr, fq, lds, wid, lane); S.done(cur); }
    PG8_STAMP();
    if (STAMP && wid == 0) { stamps[lane] = lane < nts ? (((unsigned long long)(unsigned)ts_hi << 32) | (unsigned)ts_lo) : 0ull;
        if (lane == 62) stamps[62] = rt_entry; if (lane == 63) stamps[63] = (unsigned long long)wall_clock64(); }
#undef PG8_STAMP
#undef PG8_SA
#undef PG8_SB
#undef PG8_STAGE
#undef PG8_LDA
#undef PG8_LDB
#undef PG8_MMA
#undef PG8_WAIT_V
#undef PG8_WAIT_L
#undef PG8_BAR
#undef PG8_SCHED
}
}
#define XB_TMO      128
#define XB_XCNT(j)  (256  + 64 * (j))
#define XB_XSUB(j)  (1280 + 64 * (j))
#define XB_XGEN(j)  (2304 + 64 * (j))
#define XB_TOP      3328
#define XB_TOPGEN   3392
#define XCD_BAR_WORDS 3456
#define XB_SPIN_CAP (1u << 18)

__device__ __forceinline__ unsigned xb_ld(unsigned* p)              { return __hip_atomic_load(p, __ATOMIC_RELAXED, __HIP_MEMORY_SCOPE_AGENT); }
__device__ __forceinline__ unsigned xb_add(unsigned* p, unsigned v) { return __hip_atomic_fetch_add(p, v, __ATOMIC_RELAXED, __HIP_MEMORY_SCOPE_AGENT); }
__device__ __forceinline__ unsigned xb_xcc_id() { return (unsigned)__builtin_amdgcn_s_getreg((3 << 11) | 20) & 0xFu; }
#define XB_SPIN(cond, bar) do { unsigned _sp = 0; while (cond) { __builtin_amdgcn_s_sleep(1); \
    if ((++_sp & 255u) == 0u) { if (xb_ld(&(bar)[XB_TMO])) break; if (_sp > XB_SPIN_CAP) { atomicAdd(&(bar)[XB_TMO], 1u); break; } } } } while (0)

struct XcdBarrier {
    unsigned* bar; unsigned x;
    volatile LAS unsigned* st;
};

__device__ __forceinline__ XcdBarrier xcd_barrier_post(unsigned* bar, volatile LAS unsigned* st) {
    XcdBarrier b; b.bar = bar; b.x = xb_xcc_id(); b.st = st;
    if (threadIdx.x == 0) (void)xb_add(&bar[XB_XCNT(b.x)], 1u);
    return b;
}
__device__ __forceinline__ void xcd_barrier_complete(unsigned* bar, unsigned x, unsigned& nloc, unsigned& nx) {
    const unsigned G = gridDim.x * gridDim.y * gridDim.z;
    unsigned sum, cnt, mine, sp = 0u;
    for (;;) {
        sum = 0u; cnt = 0u; mine = 0u;
#pragma unroll
        for (unsigned j = 0; j < 16; ++j) { const unsigned c = xb_ld(&bar[XB_XCNT(j)]); sum += c; cnt += (c > 0u) ? 1u : 0u; mine = (j == x) ? c : mine; }
        if (sum == G) break;
        __builtin_amdgcn_s_sleep(1);
        if ((++sp & 255u) == 0u) { if (xb_ld(&bar[XB_TMO])) break; if (sp > XB_SPIN_CAP) { atomicAdd(&bar[XB_TMO], 1u); break; } }
    }
    nloc = mine > 0u ? mine : 1u; nx = cnt > 0u ? cnt : 1u;
}

__device__ __forceinline__ void xcd_barrier(const XcdBarrier& b) {
    asm volatile("s_waitcnt vmcnt(0)" ::: "memory");
    __syncthreads();
    if (threadIdx.x == 0) {
        unsigned* bar = b.bar;
        __builtin_amdgcn_s_waitcnt(0);
        unsigned nloc = b.st[0], nx = b.st[1];
        if (nloc == 0u) { xcd_barrier_complete(bar, b.x, nloc, nx); b.st[0] = nloc; b.st[1] = nx; }
        const unsigned old = xb_add(&bar[XB_XSUB(b.x)], 1u);
        const unsigned gen = old / nloc;
        if (old + 1u == (gen + 1u) * nloc) {
            __builtin_amdgcn_fence(__ATOMIC_RELEASE, "agent");
            asm volatile("s_waitcnt vmcnt(0)" ::: "memory");
            const unsigned og = xb_add(&bar[XB_TOP], 1u);
            const unsigned tg = og / nx;
            if (og + 1u == (tg + 1u) * nx) xb_add(&bar[XB_TOPGEN], 1u);
            else XB_SPIN(xb_ld(&bar[XB_TOPGEN]) == tg, bar);
            __builtin_amdgcn_fence(__ATOMIC_ACQUIRE, "agent");
            xb_add(&bar[XB_XGEN(b.x)], 1u);
            asm volatile("s_waitcnt vmcnt(0)" ::: "memory");
        } else {
            XB_SPIN(xb_ld(&bar[XB_XGEN(b.x)]) == gen, bar);
            __builtin_amdgcn_fence(__ATOMIC_ACQUIRE, "agent");
            asm volatile("s_waitcnt vmcnt(0)" ::: "memory");
        }
    }
    __syncthreads();
}

__device__ __forceinline__ void ph_mod(const P& p, const float* X, const float* g, int shift_off, int scale_off, bf16* H, int bid, int nb) {
  const float* ada = (const float*)(p.ws + OFF_ADA);
  const int tidm = tid_fresh(); int wave = tidm >> 6, lane = tidm & 63;
  const int rstride = nb * (int)(blockDim.x >> 6);
  int row = bid * (int)(blockDim.x >> 6) + wave;
  float4 v[4];
  if (row < TT) {
    const float4* xr = (const float4*)(X + (size_t)row * DM);
#pragma unroll
    for (int i = 0; i < 4; ++i) v[i] = xr[lane + i * 64];
  }
  for (; row < TT; row += rstride) {
    float4 vn[4];
    const int nrow = row + rstride;
    {
      const float4* xn = (const float4*)(X + (size_t)((nrow < TT) ? nrow : row) * DM);
#pragma unroll
      for (int i = 0; i < 4; ++i) vn[i] = xn[lane + i * 64];
    }
    float ss = 0.f;
#pragma unroll
    for (int i = 0; i < 4; ++i) ss += v[i].x * v[i].x + v[i].y * v[i].y + v[i].z * v[i].z + v[i].w * v[i].w;
    ss = wave_sum(ss);
    float rstd = rsqrtf(ss * (1.f / DM) + 1e-6f);
    int b = row >> 12;
    const float* sh = ada + b * 6144 + shift_off;
    const float* sc = ada + b * 6144 + scale_off;
#pragma unroll
    for (int i = 0; i < 4; ++i) {
      int c0 = (lane + i * 64) * 4;
      float4 gg = *(const float4*)(g + c0);
      float4 s4 = *(const float4*)(sc + c0);
      float4 h4 = *(const float4*)(sh + c0);
      ushort4 o;
      o.x = f2bf(v[i].x * rstd * gg.x * (1.f + s4.x) + h4.x);
      o.y = f2bf(v[i].y * rstd * gg.y * (1.f + s4.y) + h4.y);
      o.z = f2bf(v[i].z * rstd * gg.z * (1.f + s4.z) + h4.z);
      o.w = f2bf(v[i].w * rstd * gg.w * (1.f + s4.w) + h4.w);
      *(ushort4*)(H + (size_t)row * DM + c0) = o;
    }
#pragma unroll
    for (int i = 0; i < 4; ++i) v[i] = vn[i];
  }
}

using pg8::f32x4;
using pg8::u32x4;
using pg8::Unit;
using pg8::cvt_pk_bf16;
typedef short s16x4_t __attribute__((ext_vector_type(4)));
typedef unsigned u32x4_t __attribute__((ext_vector_type(4)));
typedef unsigned short u16x4_t __attribute__((ext_vector_type(4)));

__device__ __forceinline__ int in_srcmap(int d) {
  if (d < 2048) return d;
  if (d < 3072) return 3088 + (d - 2048);
  if (d < 3328) return 4112 + (d - 3072);
  if (d < 3840) return 4368 + (d - 3328);
  if (d < 3904) return 4880 + (d - 3840);
  if (d < 3912) return 4944 + (d - 3904);
  if (d < 3928) return 3072 + (d - 3912);
  if (d < 4096) return -1;
  if (d < 5120) return 2048 + (d - 4096);
  return 4952 + (d - 5120);
}
template <bool MAP>
__device__ __forceinline__ void transpose_item(const float* W, int ldw, int K, bf16* WT, int item, int nblk, float* scr, int lane) {
  const int kb = item / nblk, nbk = item % nblk, k0 = 64 * kb, n0 = 32 * nbk;
  const int d = n0 + (lane & 31);
  const int src = MAP ? in_srcmap(d) : d;
#pragma unroll 8
  for (int i = 0; i < 32; ++i) {
    const int kk = 2 * i + (lane >> 5);
    scr[kk * 33 + (lane & 31)] = (src >= 0) ? W[(size_t)(k0 + kk) * ldw + src] : 0.f;
  }
  asm volatile("s_waitcnt lgkmcnt(0)" ::: "memory");
  const int c = lane & 7;
#pragma unroll
  for (int j = 0; j < 4; ++j) {
    const int n = (lane >> 3) + 8 * j;
    const float* s = scr + (8 * c) * 33 + n;
    uint4 o;
    o.x = pk2(s[0 * 33], s[1 * 33]); o.y = pk2(s[2 * 33], s[3 * 33]); o.z = pk2(s[4 * 33], s[5 * 33]); o.w = pk2(s[6 * 33], s[7 * 33]);
    *(uint4*)(WT + (size_t)(n0 + n) * K + k0 + 8 * c) = o;
  }
  asm volatile("s_waitcnt lgkmcnt(0)" ::: "memory");
}

__device__ __forceinline__ void ph_prep(const P& p, float* sm) {
  const int tid = tid_fresh(), wave = tid >> 6, lane = tid & 63;
  const int bid = blockIdx.x, nb = gridDim.x;
  float* silc = sm + 8 * 2112 + 64;
  float* red = silc + 8192;
  float* ada = (float*)(p.ws + OFF_ADA);
  if (bid < 192) {
    for (int i = tid; i < 8192; i += 512) silc[i] = siluf_(p.c[i]);
    __syncthreads();
    for (int it = bid; it < 192; it += nb) {
      const int kg = tid >> 5, cn = tid & 31, n = it * 32 + cn;
      float acc[8];
#pragma unroll
      for (int b = 0; b < 8; ++b) acc[b] = 0.f;
      for (int k = kg * 64; k < kg * 64 + 64; ++k) {
        const float w = p.w_ada[(size_t)k * 6144 + n];
#pragma unroll
        for (int b = 0; b < 8; ++b) acc[b] += silc[b * 1024 + k] * w;
      }
#pragma unroll
      for (int b = 0; b < 8; ++b) red[(kg * 8 + b) * 32 + cn] = acc[b];
      __syncthreads();
      if (tid < 256) {
        const int b = tid >> 5, c2 = tid & 31;
        float s = 0.f;
#pragma unroll
        for (int g = 0; g < 16; ++g) s += red[(g * 8 + b) * 32 + c2];
        ada[b * 6144 + it * 32 + c2] = s + p.b_ada[it * 32 + c2];
      }
      __syncthreads();
    }
  }
  {
    unsigned char* PU8 = (unsigned char*)(p.ws + OFF_PU);
    unsigned char* PV8 = (unsigned char*)(p.ws + OFF_PV);
    float* PSC = (float*)(p.ws + OFF_PSC);
    for (int row = bid * 8 + wave; row < 2 * 16384; row += nb * 8) {
      const float* src = (row < 16384 ? p.peer_u : p.peer_v) + (size_t)(row & 16383) * 1024 + lane * 16;
      f32x4 v[4];
      float mx = 0.f;
#pragma unroll
      for (int q = 0; q < 4; ++q) {
        v[q] = *(const f32x4*)(src + q * 4);
        mx = fmaxf(mx, fmaxf(fmaxf(fabsf(v[q][0]), fabsf(v[q][1])), fmaxf(fabsf(v[q][2]), fabsf(v[q][3]))));
      }
      mx = wave_max(mx);
      const float sc = (mx > 0.f) ? exp2f(floorf(log2f(448.f / mx))) : 1.f;
      u32x4 o;
#pragma unroll
      for (int q = 0; q < 4; ++q) {
        int w = __builtin_amdgcn_cvt_pk_fp8_f32(v[q][0] * sc, v[q][1] * sc, 0, false);
        w = __builtin_amdgcn_cvt_pk_fp8_f32(v[q][2] * sc, v[q][3] * sc, w, true);
        o[q] = (unsigned)w;
      }
      *(u32x4*)((row < 16384 ? PU8 : PV8) + (size_t)(row & 16383) * 1024 + lane * 16) = o;
      if (lane == 0) PSC[row] = 1.f / sc;
    }
    for (int i = bid * 512 + tid; i < 2 * 2048; i += nb * 512) {
      const float* src = (i < 2048) ? p.sk1 : p.sk2;
      const int j = i & 2047;
      const float4 v0 = *(const float4*)(src + j * 8), v1 = *(const float4*)(src + j * 8 + 4);
      uint4 o; o.x = pk2(v0.x, v0.y); o.y = pk2(v0.z, v0.w); o.z = pk2(v1.x, v1.y); o.w = pk2(v1.z, v1.w);
      *(uint4*)((bf16*)(p.ws + OFF_SK) + (size_t)i * 8) = o;
    }
  }
  {
    float* prm = (float*)(p.ws + OFF_PRM);
    for (int i = bid * 512 + tid; i < PRM_TOTAL; i += nb * 512) {
      float v;
      if (i < PRM_BG) v = p.w_gate_up[i];
      else if (i < PRM_GNG) v = p.b_gate[i - PRM_BG];
      else if (i < PRM_N2G) v = p.gla_norm_g[i - PRM_GNG];
      else if (i < PRM_FG) v = p.norm2_g[i - PRM_N2G];
      else v = p.final_g[i - PRM_FG];
      prm[i] = v;
    }
  }
  {
    bf16* WUK = (bf16*)(p.ws + OFF_WUK);
    bf16* WUV = (bf16*)(p.ws + OFF_WUV);
    for (int i = bid * 512 + tid; i < 2 * 262144; i += nb * 512) {
      if (i < 262144) {
        const int d = i & 127, cc = (i >> 7) & 255, h = i >> 15;
        WUK[i] = f2bf(p.w_uk[((size_t)h * 128 + d) * 256 + cc] * p.kv_norm_g[cc] * 0.08838834764831845f);
      } else {
        const int k = i - 262144;
        const int cc = k & 255, d = (k >> 8) & 127, h = k >> 15;
        WUV[k] = f2bf(p.w_uv[((size_t)h * 256 + cc) * 128 + d] * p.kv_norm_g[cc]);
      }
    }
  }
  float* scr = sm + wave * 2112;
  const int gw = bid * 8 + wave, ngw = nb * 8;
  constexpr int I_IN = 16 * 224, I_SQ = 16 * 32, I_Q = 16 * 64;
  for (int it = gw; it < I_IN + 3 * I_SQ + I_Q; it += ngw) {
    int r = it;
    if (r < I_IN) { transpose_item<true>(p.w_in, NIN, 1024, (bf16*)(p.ws + OFF_WT_IN), r, 224, scr, lane); continue; }
    r -= I_IN;
    if (r < I_SQ) { transpose_item<false>(p.w_a, 1024, 1024, (bf16*)(p.ws + OFF_WT_A), r, 32, scr, lane); continue; }
    r -= I_SQ;
    if (r < I_SQ) { transpose_item<false>(p.w_b, 1024, 1024, (bf16*)(p.ws + OFF_WT_B), r, 32, scr, lane); continue; }
    r -= I_SQ;
    if (r < I_SQ) { transpose_item<false>(p.w_out, 1024, 1024, (bf16*)(p.ws + OFF_WT_OUT), r, 32, scr, lane); continue; }
    r -= I_SQ;
    transpose_item<false>(p.w_q, 2048, 1024, (bf16*)(p.ws + OFF_WT_Q), r, 64, scr, lane);
  }
}


struct EpiIn {
  static constexpr bool PERM = true, AFTER_DRAIN = false;
  char* ws; float* out;
  __device__ __forceinline__ void operator()(const f32x4 (&acc)[2][2][4][2], const Unit& u, int wr, int wc, int fr, int fq) const {
    const int pn = u.pn;
    const int row0 = u.pm * 256 + wr * 64 + fr, cl0 = wc * 32 + 8 * fq;
    if (pn == 12) {
      bf16* dst = (bf16*)(ws + OFF_CKV);
      float* ssp = (float*)(ws + OFF_SSP);
#pragma unroll
      for (int ai = 0; ai < 2; ++ai)
#pragma unroll
        for (int m = 0; m < 4; ++m) {
          const size_t row = row0 + ai * 128 + m * 16;
          float ss = 0.f;
#pragma unroll
          for (int bj = 0; bj < 2; ++bj) {
            const f32x4 v0 = acc[ai][bj][m][0], v1 = acc[ai][bj][m][1];
            ss += (v0[0] * v0[0] + v0[1] * v0[1]) + (v0[2] * v0[2] + v0[3] * v0[3]) + (v1[0] * v1[0] + v1[1] * v1[1]) + (v1[2] * v1[2] + v1[3] * v1[3]);
            u32x4 w; w.x = cvt_pk_bf16(v0[0], v0[1]); w.y = cvt_pk_bf16(v0[2], v0[3]); w.z = cvt_pk_bf16(v1[0], v1[1]); w.w = cvt_pk_bf16(v1[2], v1[3]);
            *(u32x4*)(dst + row * 256 + cl0 + bj * 128) = w;
          }
          ss += __shfl_xor(ss, 16); ss += __shfl_xor(ss, 32);
          if (fq == 0) ssp[row * 4 + wc] = ss;
        }
    } else if (pn == 15) {
      bf16* IK = (bf16*)(ws + OFF_IK);
      float* IW = (float*)(ws + OFF_IW);
      float* GLOW = (float*)(ws + OFF_GLOW);
#pragma unroll
      for (int ai = 0; ai < 2; ++ai)
#pragma unroll
        for (int m = 0; m < 4; ++m) {
          const size_t row = row0 + ai * 128 + m * 16;
          const int cl = cl0;
          const f32x4 v0 = acc[ai][0][m][0], v1 = acc[ai][0][m][1];
          if (cl < 64) {
            u32x4 w; w.x = cvt_pk_bf16(v0[0], v0[1]); w.y = cvt_pk_bf16(v0[2], v0[3]); w.z = cvt_pk_bf16(v1[0], v1[1]); w.w = cvt_pk_bf16(v1[2], v1[3]);
            *(u32x4*)(IK + row * 64 + cl) = w;
          } else if (cl < 72) {
            *(f32x4*)(IW + row * 8) = v0 * 0.35355339059327373f;
            *(f32x4*)(IW + row * 8 + 4) = v1 * 0.35355339059327373f;
          } else if (cl < 88) {
            *(f32x4*)(GLOW + row * 16 + (cl - 72)) = v0;
            *(f32x4*)(GLOW + row * 16 + (cl - 72) + 4) = v1;
          }
        }
    } else {
      bf16* dst; int ld; float scale = 1.f; int act = 0; int coff;
      if (pn < 2) { dst = (bf16*)(ws + OFF_Q); ld = 512; coff = pn * 256; scale = 0.08838834764831845f; }
      else if (pn < 4) { dst = (bf16*)(ws + OFF_K); ld = 512; coff = (pn - 2) * 256; }
      else if (pn < 8) { dst = (bf16*)(ws + OFF_V); ld = 1024; coff = (pn - 4) * 256; }
      else if (pn < 12) { dst = (bf16*)(ws + OFF_DQ); ld = 1024; coff = (pn - 8) * 256; }
      else if (pn < 15) { dst = (bf16*)(ws + OFF_IQ); ld = 512; coff = (pn - 13) * 256; scale = 0.125f; }
      else if (pn < 20) { dst = (bf16*)(ws + OFF_SGR); ld = 1024; coff = (pn - 16) * 256; act = 1; }
      else if (pn < 24) { dst = (bf16*)out; ld = 1024; coff = (pn - 20) * 256; act = 2; }
      else { dst = (bf16*)out + (size_t)TT * 1024; ld = 1024; coff = (pn - 24) * 256; act = 2; }
#pragma unroll
      for (int ai = 0; ai < 2; ++ai)
#pragma unroll
        for (int m = 0; m < 4; ++m) {
          bf16* rowp = dst + (size_t)(row0 + ai * 128 + m * 16) * ld + coff + cl0;
#pragma unroll
          for (int bj = 0; bj < 2; ++bj) {
            f32x4 v0 = acc[ai][bj][m][0] * scale, v1 = acc[ai][bj][m][1] * scale;
            if (act == 1) {
#pragma unroll
              for (int j = 0; j < 4; ++j) { v0[j] = siluf_(v0[j]); v1[j] = siluf_(v1[j]); }
            } else if (act == 2) {
#pragma unroll
              for (int j = 0; j < 4; ++j) { v0[j] = sigmoidf_(v0[j]); v1[j] = sigmoidf_(v1[j]); }
            }
            u32x4 w; w.x = cvt_pk_bf16(v0[0], v0[1]); w.y = cvt_pk_bf16(v0[2], v0[3]); w.z = cvt_pk_bf16(v1[0], v1[1]); w.w = cvt_pk_bf16(v1[2], v1[3]);
            *(u32x4*)(rowp + bj * 128) = w;
          }
        }
    }
  }
};

template <bool ADD> struct EpiMix {
  static constexpr bool PERM = true, AFTER_DRAIN = false;
  const bf16* SZ; bf16* MIX;
  __device__ __forceinline__ void operator()(const f32x4 (&acc)[2][2][4][2], const Unit& u, int wr, int wc, int fr, int fq) const {
    const int row0 = u.pm * 256 + wr * 64 + fr, col0 = u.pn * 256 + wc * 32 + 8 * fq;
    u32x4 sc[2], oc[2], sn[2], on[2];
    {
      const size_t idx = (size_t)row0 * 1024 + col0;
      sc[0] = *(const u32x4*)(SZ + idx); sc[1] = *(const u32x4*)(SZ + idx + 128);
      if (ADD) { oc[0] = *(const u32x4*)(MIX + idx); oc[1] = *(const u32x4*)(MIX + idx + 128); }
    }
#pragma unroll
    for (int s = 0; s < 8; ++s) {
      const int ai = s >> 2, m = s & 3;
      const size_t idx = (size_t)(row0 + ai * 128 + m * 16) * 1024 + col0;
      if (s < 7) {
        const int ai2 = (s + 1) >> 2, m2 = (s + 1) & 3;
        const size_t idn = (size_t)(row0 + ai2 * 128 + m2 * 16) * 1024 + col0;
        sn[0] = *(const u32x4*)(SZ + idn); sn[1] = *(const u32x4*)(SZ + idn + 128);
        if (ADD) { on[0] = *(const u32x4*)(MIX + idn); on[1] = *(const u32x4*)(MIX + idn + 128); }
      }
#pragma unroll
      for (int bj = 0; bj < 2; ++bj) {
        const u32x4 sv = sc[bj];
        f32x4 v0 = acc[ai][bj][m][0], v1 = acc[ai][bj][m][1];
        v0[0] *= bflo(sv.x); v0[1] *= bfhi(sv.x); v0[2] *= bflo(sv.y); v0[3] *= bfhi(sv.y);
        v1[0] *= bflo(sv.z); v1[1] *= bfhi(sv.z); v1[2] *= bflo(sv.w); v1[3] *= bfhi(sv.w);
        if (ADD) {
          const u32x4 o = oc[bj];
          v0[0] += bflo(o.x); v0[1] += bfhi(o.x); v0[2] += bflo(o.y); v0[3] += bfhi(o.y);
          v1[0] += bflo(o.z); v1[1] += bfhi(o.z); v1[2] += bflo(o.w); v1[3] += bfhi(o.w);
        }
        u32x4 w; w.x = cvt_pk_bf16(v0[0], v0[1]); w.y = cvt_pk_bf16(v0[2], v0[3]); w.z = cvt_pk_bf16(v1[0], v1[1]); w.w = cvt_pk_bf16(v1[2], v1[3]);
        *(u32x4*)(MIX + idx + bj * 128) = w;
      }
      if (s < 7) { sc[0] = sn[0]; sc[1] = sn[1]; if (ADD) { oc[0] = on[0]; oc[1] = on[1]; } }
    }
  }
};

struct EpiX1 {
  static constexpr bool PERM = true, AFTER_DRAIN = false;
  const float* x; const float* ada; float* out;
  __device__ __forceinline__ void operator()(const f32x4 (&acc)[2][2][4][2], const Unit& u, int wr, int wc, int fr, int fq) const {
    const int row0 = u.pm * 256 + wr * 64 + fr, col0 = u.pn * 256 + wc * 32 + 8 * fq;
    const int b = (u.pm * 256) >> 12;
    f32x4 g[2][2];
#pragma unroll
    for (int bj = 0; bj < 2; ++bj) {
      g[bj][0] = *(const f32x4*)(ada + b * 6144 + 2048 + col0 + bj * 128);
      g[bj][1] = *(const f32x4*)(ada + b * 6144 + 2048 + col0 + bj * 128 + 4);
    }
    f32x4 xc[4], xn[4];
    {
      const size_t idx = (size_t)row0 * 1024 + col0;
      xc[0] = *(const f32x4*)(x + idx); xc[1] = *(const f32x4*)(x + idx + 4);
      xc[2] = *(const f32x4*)(x + idx + 128); xc[3] = *(const f32x4*)(x + idx + 132);
    }
#pragma unroll
    for (int s = 0; s < 8; ++s) {
      const int ai = s >> 2, m = s & 3;
      const size_t idx = (size_t)(row0 + ai * 128 + m * 16) * 1024 + col0;
      if (s < 7) {
        const int ai2 = (s + 1) >> 2, m2 = (s + 1) & 3;
        const size_t idn = (size_t)(row0 + ai2 * 128 + m2 * 16) * 1024 + col0;
        xn[0] = *(const f32x4*)(x + idn); xn[1] = *(const f32x4*)(x + idn + 4);
        xn[2] = *(const f32x4*)(x + idn + 128); xn[3] = *(const f32x4*)(x + idn + 132);
      }
#pragma unroll
      for (int bj = 0; bj < 2; ++bj) {
        *(f32x4*)(out + idx + bj * 128) = xc[2 * bj] + g[bj][0] * acc[ai][bj][m][0];
        *(f32x4*)(out + idx + bj * 128 + 4) = xc[2 * bj + 1] + g[bj][1] * acc[ai][bj][m][1];
      }
      if (s < 7) { xc[0] = xn[0]; xc[1] = xn[1]; xc[2] = xn[2]; xc[3] = xn[3]; }
    }
  }
};

struct EpiPlain {
  static constexpr bool PERM = true, AFTER_DRAIN = false;
  bf16* O; int ld;
  __device__ __forceinline__ void operator()(const f32x4 (&acc)[2][2][4][2], const Unit& u, int wr, int wc, int fr, int fq) const {
    const int row0 = u.pm * 256 + wr * 64 + fr, col0 = u.pn * 256 + wc * 32 + 8 * fq;
#pragma unroll
    for (int ai = 0; ai < 2; ++ai)
#pragma unroll
      for (int m = 0; m < 4; ++m)
#pragma unroll
        for (int bj = 0; bj < 2; ++bj) {
          const f32x4 v0 = acc[ai][bj][m][0], v1 = acc[ai][bj][m][1];
          u32x4 w; w.x = cvt_pk_bf16(v0[0], v0[1]); w.y = cvt_pk_bf16(v0[2], v0[3]); w.z = cvt_pk_bf16(v1[0], v1[1]); w.w = cvt_pk_bf16(v1[2], v1[3]);
          *(u32x4*)(O + (size_t)(row0 + ai * 128 + m * 16) * ld + col0 + bj * 128) = w;
        }
  }
};

template <class Epi>
__device__ __forceinline__ void gemm_run(LAS unsigned char* lds, const bf16* A, const bf16* Bt, int M, int N, int K, const Epi& E) {
  pg8::Gemm g{A, Bt, M, N, K};
  pg8::StaticOrder S;
  S.init(M, N, gridDim.x, blockIdx.x);
  pg8::gemm_phase<Epi, pg8::StaticOrder, false>(lds, g, S, E, nullptr);
}

typedef short bf16x8_t __attribute__((ext_vector_type(8)));
typedef __bf16 bf16x2_t __attribute__((ext_vector_type(2)));
__device__ __forceinline__ float dot2bf(unsigned a, unsigned b, float acc) {
  return __builtin_amdgcn_fdot2_f32_bf16(__builtin_bit_cast(bf16x2_t, a), __builtin_bit_cast(bf16x2_t, b), acc, false);
}
__device__ __forceinline__ void wave_lds_fence() { asm volatile("s_waitcnt lgkmcnt(0)" ::: "memory"); }
template <int N> __device__ __forceinline__ float row_ror(float x) {
  return __int_as_float(__builtin_amdgcn_update_dpp(0, __float_as_int(x), 0x120 + N, 0xf, 0xf, false));
}
__device__ __forceinline__ float row16_max(float m) {
  m = fmaxf(m, row_ror<8>(m)); m = fmaxf(m, row_ror<4>(m)); m = fmaxf(m, row_ror<2>(m)); m = fmaxf(m, row_ror<1>(m));
  return m;
}
__device__ __forceinline__ float row16_sum(float m) {
  m += row_ror<8>(m); m += row_ror<4>(m); m += row_ror<2>(m); m += row_ror<1>(m);
  return m;
}
__device__ __forceinline__ float wave_sum_dpp(float s) {
  s = row16_sum(s);
  const int si = __float_as_int(s);
  return __int_as_float(__builtin_amdgcn_readlane(si, 0)) + __int_as_float(__builtin_amdgcn_readlane(si, 16)) +
         (__int_as_float(__builtin_amdgcn_readlane(si, 32)) + __int_as_float(__builtin_amdgcn_readlane(si, 48)));
}
__device__ __forceinline__ constexpr int cand_i(int L) {
  return L < 16 ? 0 : L < 24 ? 1 : L < 29 ? 2 : L < 33 ? 3 : L < 36 ? 4 : L < 38 ? 5 : L < 40 ? 6 : L < 42 ? 7 : (L - 42 + 8);
}
__device__ __forceinline__ constexpr int cand_j(int L) {
  return L < 16 ? L : L < 24 ? L - 16 : L < 29 ? L - 24 : L < 33 ? L - 29 : L < 36 ? L - 33 : L < 38 ? L - 36 : L < 40 ? L - 38 : L < 42 ? L - 40 : 0;
}
template <int K> struct CandRank {
  static __device__ __forceinline__ void run(int ki, unsigned key, int& rank) {
    const unsigned o = (unsigned)__builtin_amdgcn_readlane(ki, K);
    rank += (o > key) ? 1 : 0;
    CandRank<K + 1>::run(ki, key, rank);
  }
};
template <> struct CandRank<50> { static __device__ __forceinline__ void run(int, unsigned, int&) {} };
__device__ __forceinline__ unsigned peer_f2ord(float f) {
  if (f == 0.f) f = 0.f;
  const unsigned u = __float_as_uint(f);
  return (u & 0x80000000u) ? ~u : (u | 0x80000000u);
}
__device__ __forceinline__ float peer_ord2f(unsigned u) { return __uint_as_float((u & 0x80000000u) ? (u ^ 0x80000000u) : ~u); }
__device__ __forceinline__ unsigned umax3(unsigned a, unsigned b, unsigned c) { const unsigned t = a > b ? a : b; return t > c ? t : c; }
template <int N> __device__ __forceinline__ unsigned row_ror_u(unsigned x) {
  return (unsigned)__builtin_amdgcn_update_dpp(0, (int)x, 0x120 + N, 0xf, 0xf, false);
}
__device__ __forceinline__ unsigned row16_umax(unsigned m) {
  unsigned t;
  t = row_ror_u<8>(m); m = t > m ? t : m; t = row_ror_u<4>(m); m = t > m ? t : m;
  t = row_ror_u<2>(m); m = t > m ? t : m; t = row_ror_u<1>(m); m = t > m ? t : m;
  return m;
}
__device__ __forceinline__ float gelu_exact(float v) { return 0.5f * v * (1.f + erff(v * 0.7071067811865476f)); }

typedef float f32x2_t __attribute__((ext_vector_type(2)));
#define PEER_NB 6
#define PEER_LOAD(buf, TAB, e0)                                                                   \
  _Pragma("unroll") for (int j = 0; j < PEER_NB; ++j) {                                                 \
    const int e = ((e0) + j < 128) ? __builtin_amdgcn_readfirstlane((int)ridx[tt * 128 + (e0) + j]) : 0;   \
    buf[j] = *(const u32x4_t*)((TAB) + (size_t)e * 1024 + lane * 16);                             \
  }
#define PEER_UDOT(buf, e0)                                                                        \
  _Pragma("unroll") for (int j = 0; j < PEER_NB; ++j) {                                                 \
    float s0 = 0.f, s1 = 0.f;                                                                     \
    _Pragma("unroll") for (int w = 0; w < 4; ++w) {                                               \
      const f32x2_t lo = __builtin_amdgcn_cvt_pk_f32_fp8((int)buf[j][w], false);                  \
      const f32x2_t hi = __builtin_amdgcn_cvt_pk_f32_fp8((int)buf[j][w], true);                   \
      s0 += lo.x * hf[4 * w] + hi.x * hf[4 * w + 2];                                              \
      s1 += lo.y * hf[4 * w + 1] + hi.y * hf[4 * w + 3];                                          \
    }                                                                                             \
    const float s = wave_sum_dpp(s0 + s1);                                                        \
    const int ee = (e0) + j;                                                                      \
    if (ee < 64) dotA = (lane == ee) ? s : dotA; else if (ee < 128) dotB = (lane == ee - 64) ? s : dotB; \
    __builtin_amdgcn_sched_barrier(0);                                                           \
  }
#define PEER_VACC(buf, e0)                                                                        \
  _Pragma("unroll") for (int j = 0; j < PEER_NB; ++j) {                                                 \
    const int ee = (e0) + j;                                                                      \
    const float a = (ee < 128) ? __int_as_float(__builtin_amdgcn_readlane(__float_as_int(ee < 64 ? aA : aB), ee & 63)) : 0.f; \
    _Pragma("unroll") for (int w = 0; w < 4; ++w) {                                               \
      const f32x2_t lo = __builtin_amdgcn_cvt_pk_f32_fp8((int)buf[j][w], false);                  \
      const f32x2_t hi = __builtin_amdgcn_cvt_pk_f32_fp8((int)buf[j][w], true);                   \
      acc[4 * w] += a * lo.x; acc[4 * w + 1] += a * lo.y; acc[4 * w + 2] += a * hi.x; acc[4 * w + 3] += a * hi.y; \
    }                                                                                             \
    __builtin_amdgcn_sched_barrier(0);                                                           \
  }

__device__ __forceinline__ void ph_peer512(const P& p, unsigned char* lds_raw, float* dst_base) {
  const int tid = tid_fresh(), wave = tid >> 6, lane = tid & 63, g = lane >> 4, c = lane & 15;
  const bf16* PQ = (const bf16*)(p.ws + OFF_PQ);
  const bf16* SK = (const bf16*)(p.ws + OFF_SK);
  float* tv = (float*)(lds_raw + wave * 16384);
  int* ti = (int*)(tv + 512);
  float* rgate = (float*)(ti + 512);
  unsigned short* ridx = (unsigned short*)(rgate + 2048);
  for (int tile = blockIdx.x * 8 + wave; tile < TT / 16; tile += gridDim.x * 8) {
    const int tok0 = tile * 16;
#pragma unroll 1
    for (int hd = 0; hd < 8; ++hd) {
#pragma unroll 1
      for (int hf = 0; hf < 2; ++hf) {
        f32x4 acc[8];
#pragma unroll
        for (int nt = 0; nt < 8; ++nt) acc[nt] = (f32x4){0.f, 0.f, 0.f, 0.f};
#pragma unroll
        for (int ks = 0; ks < 4; ++ks) {
          const bf16x8_t a = *(const bf16x8_t*)(PQ + (size_t)(tok0 + c) * 2048 + hd * 256 + hf * 128 + ks * 32 + 8 * g);
#pragma unroll
          for (int nt = 0; nt < 8; ++nt) {
            const bf16x8_t b = *(const bf16x8_t*)(SK + hf * 16384 + (nt * 16 + c) * 128 + ks * 32 + 8 * g);
            acc[nt] = __builtin_amdgcn_mfma_f32_16x16x32_bf16(a, b, acc[nt], 0, 0, 0);
          }
        }
        unsigned kq[4][8], res[4];
#pragma unroll
        for (int i = 0; i < 4; ++i) {
          res[i] = 0u;
#pragma unroll
          for (int nt = 0; nt < 8; ++nt) kq[i][nt] = (peer_f2ord(acc[nt][i]) & ~127u) | (unsigned)(127 - (16 * nt + c));
        }
#pragma unroll 1
        for (int r = 0; r < 16; ++r) {
#pragma unroll
          for (int i = 0; i < 4; ++i) {
            unsigned m = umax3(umax3(kq[i][0], kq[i][1], kq[i][2]), umax3(kq[i][3], kq[i][4], kq[i][5]), (kq[i][6] > kq[i][7]) ? kq[i][6] : kq[i][7]);
            m = row16_umax(m);
#pragma unroll
            for (int nt = 0; nt < 8; ++nt) kq[i][nt] = (kq[i][nt] == m) ? 0u : kq[i][nt];
            res[i] = (c == r) ? m : res[i];
          }
        }
#pragma unroll
        for (int i = 0; i < 4; ++i) {
          const int row = 4 * g + i;
          tv[(hf * 16 + row) * 16 + c] = peer_ord2f(res[i] & ~127u);
          ti[(hf * 16 + row) * 16 + c] = 127 - (int)(res[i] & 127u);
        }
      }
      wave_lds_fence();
      const int ci = cand_i(lane < 50 ? lane : 0), cj = cand_j(lane < 50 ? lane : 0);
#pragma unroll 1
      for (int row = 0; row < 16; ++row) {
        const float val = tv[row * 16 + ci] + tv[(16 + row) * 16 + cj];
        const unsigned key = (lane < 50) ? ((peer_f2ord(val) & ~63u) | (unsigned)(63 - lane)) : 0u;
        int rank = 0;
        CandRank<0>::run((int)key, key, rank);
        if (lane < 50 && rank < 16) {
          rgate[row * 128 + hd * 16 + rank] = val;
          ridx[row * 128 + hd * 16 + rank] = (unsigned short)(ti[row * 16 + ci] * 128 + ti[(16 + row) * 16 + cj]);
        }
      }
      wave_lds_fence();
      {
        const int row = lane >> 2, q = lane & 3;
        float* gp = rgate + row * 128 + hd * 16;
        const float mx = gp[0];
        const f32x4 b4 = *(const f32x4*)(gp + q * 4);
        f32x4 e4;
        e4[0] = __expf(b4[0] - mx); e4[1] = __expf(b4[1] - mx); e4[2] = __expf(b4[2] - mx); e4[3] = __expf(b4[3] - mx);
        float s = (e4[0] + e4[1]) + (e4[2] + e4[3]);
        s += __shfl_xor(s, 1); s += __shfl_xor(s, 2);
        const float inv = 1.f / s;
        wave_lds_fence();
        *(f32x4*)(gp + q * 4) = e4 * inv;
      }
      wave_lds_fence();
    }
    char* wsl = p.ws;
    asm volatile("" : "+s"(wsl));
    const bf16* H2 = (const bf16*)(wsl + OFF_H);
    const unsigned char* PU = (const unsigned char*)(wsl + OFF_PU);
    const unsigned char* PV = (const unsigned char*)(wsl + OFF_PV);
    const float* USC = (const float*)(wsl + OFF_PSC);
    const float* VSC = USC + 16384;
    const float* ada = (const float*)(wsl + OFF_ADA);
#pragma unroll 1
    for (int tt = 0; tt < 16; ++tt) {
      const int tidx = tid_fresh(), lane = tidx & 63, wv = __builtin_amdgcn_readfirstlane(tidx >> 6);
      const float* rgate = (const float*)(lds_raw + wv * 16384 + 4096);
      const unsigned short* ridx = (const unsigned short*)(lds_raw + wv * 16384 + 4096 + 8192);
      const size_t tok = (size_t)tok0 + tt;
      float hf[16];
      {
        const u32x4_t h0 = *(const u32x4_t*)(H2 + tok * 1024 + lane * 16), h1 = *(const u32x4_t*)(H2 + tok * 1024 + lane * 16 + 8);
#pragma unroll
        for (int w = 0; w < 4; ++w) { hf[2 * w] = bflo(h0[w]); hf[2 * w + 1] = bfhi(h0[w]); hf[8 + 2 * w] = bflo(h1[w]); hf[8 + 2 * w + 1] = bfhi(h1[w]); }
      }
      const int eA = (int)ridx[tt * 128 + lane], eB = (int)ridx[tt * 128 + 64 + lane];
      const float usA = USC[eA], usB = USC[eB];
      float dotA = 0.f, dotB = 0.f;
      u32x4_t a0[PEER_NB], a1[PEER_NB];
#define PSB() __builtin_amdgcn_sched_barrier(0)
#define PEER_ROWS (((128 + 2 * PEER_NB - 1) / (2 * PEER_NB)) * 2 * PEER_NB)
      PEER_LOAD(a0, PU, 0); PSB();
      PEER_LOAD(a1, PU, PEER_NB); PSB();
#pragma unroll 1
      for (int e0 = 0; e0 < PEER_ROWS; e0 += 2 * PEER_NB) {
        PEER_UDOT(a0, e0); PSB();
        if (e0 + 2 * PEER_NB < PEER_ROWS) { PEER_LOAD(a0, PU, e0 + 2 * PEER_NB); } else { PEER_LOAD(a0, PV, 0); }
        PSB();
        PEER_UDOT(a1, e0 + PEER_NB); PSB();
        if (e0 + 3 * PEER_NB < PEER_ROWS) { PEER_LOAD(a1, PU, e0 + 3 * PEER_NB); } else { PEER_LOAD(a1, PV, PEER_NB); }
        PSB();
      }
      const float aA = gelu_exact(dotA * usA) * rgate[tt * 128 + lane] * VSC[(int)ridx[tt * 128 + lane]],
                  aB = gelu_exact(dotB * usB) * rgate[tt * 128 + 64 + lane] * VSC[(int)ridx[tt * 128 + 64 + lane]];
      float acc[16];
#pragma unroll
      for (int k = 0; k < 16; ++k) acc[k] = 0.f;
      PSB();
#pragma unroll 1
      for (int e0 = 0; e0 < PEER_ROWS; e0 += 2 * PEER_NB) {
        PEER_VACC(a0, e0); PSB();
        if (e0 + 2 * PEER_NB < PEER_ROWS) { PEER_LOAD(a0, PV, e0 + 2 * PEER_NB); }
        PSB();
        PEER_VACC(a1, e0 + PEER_NB); PSB();
        if (e0 + 3 * PEER_NB < PEER_ROWS) { PEER_LOAD(a1, PV, e0 + 3 * PEER_NB); }
        PSB();
      }
#undef PSB
      const int b = (int)(tok >> 12);
      const float* xrow = p.out + tok * 1024;
      float* orow = dst_base + tok * 1024;
      const float* g2 = ada + b * 6144 + 5120;
      float x2[16];
      float ss = 0.f;
#pragma unroll
      for (int q = 0; q < 4; ++q) {
        const int col = lane * 16 + q * 4;
        const f32x4 xv = *(const f32x4*)(xrow + col), gv = *(const f32x4*)(g2 + col);
#pragma unroll
        for (int k = 0; k < 4; ++k) { const float t = xv[k] + gv[k] * acc[q * 4 + k]; x2[q * 4 + k] = t; ss += t * t; }
      }
      ss = wave_sum_dpp(ss);
      const float rstd = rsqrtf(ss * (1.f / 1024.f) + 1e-6f);
#pragma unroll
      for (int q = 0; q < 4; ++q) {
        const int col = lane * 16 + q * 4;
        const f32x4 fg = *(const f32x4*)((const float*)(wsl + OFF_PRM) + PRM_FG + col);
        f32x4 o;
#pragma unroll
        for (int k = 0; k < 4; ++k) o[k] = x2[q * 4 + k] * rstd * fg[k];
        *(f32x4*)(orow + col) = o;
      }
    }
    wave_lds_fence();
  }
}

#define DS_KEY16   0
#define DS_CHUNK   17408
#define DS_SEL     139264
#define DS_WAVE    147456
#define DS_TOTAL   155648
#define DS_RS      544

__device__ __forceinline__ unsigned f2ord(float f) {
  if (f == 0.f) f = 0.f;
  unsigned u = __float_as_uint(f);
  return (u & 0x80000000u) ? ~u : (u | 0x80000000u);
}
__device__ __forceinline__ int wave_scan_incl(int v, int lane) {
#pragma unroll
  for (int o = 1; o < 64; o <<= 1) { const int t = __shfl_up(v, o); v += (lane >= o) ? t : 0; }
  return v;
}
__device__ __forceinline__ void find_digit(const LAS unsigned* hist, int K, int lane, int& digit, int& above) {
  const u32x4_t h4 = *(const LAS u32x4_t*)(hist + 252 - 4 * lane);
  const int c0 = (int)h4.w, c1 = (int)h4.z, c2 = (int)h4.y, c3 = (int)h4.x;
  const int tot = c0 + c1 + c2 + c3;
  int run = wave_scan_incl(tot, lane) - tot;
  int found = -1, ab = 0;
  if (run < K && run + c0 >= K) { found = 255 - 4 * lane; ab = run; } run += c0;
  if (run < K && run + c1 >= K) { found = 254 - 4 * lane; ab = run; } run += c1;
  if (run < K && run + c2 >= K) { found = 253 - 4 * lane; ab = run; } run += c2;
  if (run < K && run + c3 >= K) { found = 252 - 4 * lane; ab = run; }
  const unsigned long long mk = __ballot(found >= 0);
  const int src = (int)__ffsll((unsigned long long)mk) - 1;
  digit = __builtin_amdgcn_readlane(found, src);
  above = __builtin_amdgcn_readlane(ab, src);
}

typedef unsigned u32x2_t __attribute__((ext_vector_type(2)));
__device__ __forceinline__ float xrow_max(float x) {
  u32x2_t r = __builtin_amdgcn_permlane16_swap(__float_as_uint(x), __float_as_uint(x), false, false);
  x = fmaxf(__uint_as_float(r.x), __uint_as_float(r.y));
  r = __builtin_amdgcn_permlane32_swap(__float_as_uint(x), __float_as_uint(x), false, false);
  return fmaxf(__uint_as_float(r.x), __uint_as_float(r.y));
}
__device__ __forceinline__ float xrow_sum(float x) {
  u32x2_t r = __builtin_amdgcn_permlane16_swap(__float_as_uint(x), __float_as_uint(x), false, false);
  x = __uint_as_float(r.x) + __uint_as_float(r.y);
  r = __builtin_amdgcn_permlane32_swap(__float_as_uint(x), __float_as_uint(x), false, false);
  return __uint_as_float(r.x) + __uint_as_float(r.y);
}
__device__ __forceinline__ s16x4_t tr_read_b64(unsigned addr) {
  s16x4_t r; asm volatile("ds_read_b64_tr_b16 %0, %1" : "=&v"(r) : "v"(addr) : "memory"); return r;
}

#ifndef PROBE_DSA
#define PROBE_DSA 0
#endif
#if PROBE_DSA
#define DSA_MARK(k) do { const unsigned long long n_ = __builtin_amdgcn_s_memrealtime(); if (PROBE_DSA == (k)) { const unsigned long long q_ = n_ - tmark; \
    while (__builtin_amdgcn_s_memrealtime() - n_ < q_) __builtin_amdgcn_s_sleep(2); } tmark = __builtin_amdgcn_s_memrealtime(); } while (0)
#else
#define DSA_MARK(k) do {} while (0)
#endif
#if PROBE_DSA >= 10
#define DSA_MARKI(k) DSA_MARK(k)
#else
#define DSA_MARKI(k) do {} while (0)
#endif
__device__ __forceinline__ void dsa_batch(const P& p, unsigned char* lds_raw, int b, int pos2) {
  const int t00 = pos2 * 32;
#define DSA_IDS const int tid = tid_fresh(), wave = __builtin_amdgcn_readfirstlane(tid >> 6), lane = tid & 63, g = lane >> 4, c = lane & 15; (void)wave; (void)g; (void)c;
  const size_t tokb = (size_t)b * SEQ, tok00 = tokb + t00;
  const bf16* DQ = (const bf16*)(p.ws + OFF_DQ);
  const bf16* CKV = (const bf16*)(p.ws + OFF_CKV);
  const float* SSP = (const float*)(p.ws + OFF_SSP);
  const bf16* IQ = (const bf16*)(p.ws + OFF_IQ);
  const bf16* IK = (const bf16*)(p.ws + OFF_IK);
  const float* IW = (const float*)(p.ws + OFF_IW);
  const bf16* WUK = (const bf16*)(p.ws + OFF_WUK);
  const bf16* WUV = (const bf16*)(p.ws + OFF_WUV);
  bf16* ODSA = (bf16*)(p.ws + OFF_ODSA);
  bf16* QL = (bf16*)(p.ws + OFF_DSCR + (size_t)blockIdx.x * 131072);
  bf16* OL = QL;
  LAS unsigned char* lds = (LAS unsigned char*)lds_raw;
  LAS unsigned short* key16 = (LAS unsigned short*)(lds + DS_KEY16);
  LAS unsigned short* sel = (LAS unsigned short*)(lds + DS_SEL);

#if PROBE_DSA
  unsigned long long tmark = __builtin_amdgcn_s_memrealtime();
#endif
  {
    DSA_IDS
    const int h = wave;
    bf16x8_t dq0[4], dq1[4];
#pragma unroll
    for (int ks = 0; ks < 4; ++ks) {
      dq0[ks] = *(const bf16x8_t*)(DQ + (tok00 + c) * 1024 + h * 128 + ks * 32 + 8 * g);
      dq1[ks] = *(const bf16x8_t*)(DQ + (tok00 + 16 + c) * 1024 + h * 128 + ks * 32 + 8 * g);
    }
#pragma unroll 1
    for (int hn = 0; hn < 2; ++hn) {
      f32x4 r0[8], r1[8];
#pragma unroll
      for (int n8 = 0; n8 < 8; ++n8) {
        const int nt = hn * 8 + n8;
        f32x4 a0 = (f32x4){0.f, 0.f, 0.f, 0.f}, a1 = a0;
#pragma unroll
        for (int ks = 0; ks < 4; ++ks) {
          const bf16x8_t wf = *(const bf16x8_t*)(WUK + (size_t)(h * 256 + nt * 16 + c) * 128 + ks * 32 + 8 * g);
          a0 = __builtin_amdgcn_mfma_f32_16x16x32_bf16(wf, dq0[ks], a0, 0, 0, 0);
          a1 = __builtin_amdgcn_mfma_f32_16x16x32_bf16(wf, dq1[ks], a1, 0, 0, 0);
        }
        r0[n8] = a0; r1[n8] = a1;
      }
#pragma unroll
      for (int n8 = 0; n8 < 8; ++n8) {
        const int nt = hn * 8 + n8;
        uint2 o; o.x = pk2(r0[n8][0], r0[n8][1]); o.y = pk2(r0[n8][2], r0[n8][3]);
        *(uint2*)(QL + c * 2048 + h * 256 + nt * 16 + 4 * g) = o;
        o.x = pk2(r1[n8][0], r1[n8][1]); o.y = pk2(r1[n8][2], r1[n8][3]);
        *(uint2*)(QL + (16 + c) * 2048 + h * 256 + nt * 16 + 4 * g) = o;
      }
    }
  }
  DSA_MARK(1);
#pragma unroll 1
  for (int half = 0; half < 2; ++half) {
  const int t0 = t00 + 16 * half;
  const size_t tok0 = tokb + t0;
  bf16* QLh = QL + half * 16 * 2048;
  bf16* OLh = QLh;
  if (t0 >= 256) {
    DSA_IDS
    bf16x8_t qf[8][2];
    float iw[8];
#pragma unroll
    for (int h = 0; h < 8; ++h) {
      qf[h][0] = *(const bf16x8_t*)(IQ + (tok0 + c) * 512 + h * 64 + 8 * g);
      qf[h][1] = *(const bf16x8_t*)(IQ + (tok0 + c) * 512 + h * 64 + 32 + 8 * g);
      iw[h] = IW[(tok0 + c) * 8 + h];
    }
    const int ntile = (t0 >> 4) + 1;
    bf16x8_t k0n = (bf16x8_t){0, 0, 0, 0, 0, 0, 0, 0}, k1n = k0n;
    if (wave < ntile) { const bf16* kr = IK + (tokb + wave * 16 + c) * 64 + 8 * g; k0n = *(const bf16x8_t*)kr; k1n = *(const bf16x8_t*)(kr + 32); }
    for (int kt = wave; kt < ntile; kt += 8) {
      const bf16x8_t k0 = k0n, k1 = k1n;
      { const int ktn = (kt + 8 < ntile) ? kt + 8 : kt; const bf16* kr = IK + (tokb + ktn * 16 + c) * 64 + 8 * g; k0n = *(const bf16x8_t*)kr; k1n = *(const bf16x8_t*)(kr + 32); }
      f32x4 sc = (f32x4){0.f, 0.f, 0.f, 0.f};
#pragma unroll
      for (int h = 0; h < 8; ++h) {
        f32x4 d = __builtin_amdgcn_mfma_f32_16x16x32_bf16(k0, qf[h][0], (f32x4){0.f, 0.f, 0.f, 0.f}, 0, 0, 0);
        d = __builtin_amdgcn_mfma_f32_16x16x32_bf16(k1, qf[h][1], d, 0, 0, 0);
#pragma unroll
        for (int i = 0; i < 4; ++i) sc[i] += iw[h] * fmaxf(d[i], 0.f);
      }
      u16x4_t o;
      const int sb = kt * 16 + 4 * g, tq = t0 + c;
      o.x = (sb + 0 <= tq) ? (unsigned short)(f2ord(sc[0]) >> 16) : (unsigned short)0;
      o.y = (sb + 1 <= tq) ? (unsigned short)(f2ord(sc[1]) >> 16) : (unsigned short)0;
      o.z = (sb + 2 <= tq) ? (unsigned short)(f2ord(sc[2]) >> 16) : (unsigned short)0;
      o.w = (sb + 3 <= tq) ? (unsigned short)(f2ord(sc[3]) >> 16) : (unsigned short)0;
      *(LAS u16x4_t*)(key16 + c * 4096 + sb) = o;
    }
  }
  DSA_MARK(2);
  __syncthreads();
#pragma unroll 1
  for (int qq = 0; qq < 2; ++qq) {
    DSA_IDS
    const int q = wave + 8 * qq, t = t0 + q;
    LAS unsigned short* selq = sel + q * 256;
    if (t < 256) {
      for (int j = lane; j < 256; j += 64) selq[j] = (unsigned short)((j <= t) ? j : 0);
    } else {
      const LAS unsigned short* kq = key16 + q * 4096;
      const int nit = (t >> 9) + 1;
      unsigned kp[8][4];
#pragma unroll
      for (int it = 0; it < 8; ++it) {
        const int s0 = 512 * it + 8 * lane;
        u32x4_t v = (u32x4_t){0u, 0u, 0u, 0u};
        if (s0 <= t) v = *(const LAS u32x4_t*)(kq + s0);
#pragma unroll
        for (int j = 0; j < 4; ++j) {
          const unsigned lo = (s0 + 2 * j <= t) ? (v[j] & 0xffffu) : 0u, hi = (s0 + 2 * j + 1 <= t) ? (v[j] & 0xffff0000u) : 0u;
          kp[it][j] = lo | hi;
        }
      }
      unsigned B = 0u;
#pragma unroll 1
      for (int bit = 15; bit >= 0; --bit) {
        const unsigned cand = B | (1u << bit);
        const unsigned c2 = (cand - 1u) * 0x00010001u;
        unsigned cnt2 = 0u;
#pragma unroll
        for (int it = 0; it < 8; ++it) {
          if (it < nit) {
#pragma unroll
            for (int j = 0; j < 4; ++j) {
              unsigned dd;
              asm("v_pk_sub_u16 %0, %1, %2 clamp\n\tv_pk_min_u16 %0, %0, %3" : "=&v"(dd) : "v"(kp[it][j]), "v"(c2), "v"(0x00010001u));
              cnt2 += dd;
            }
          }
        }
        const int tot = (int)wave_sum_dpp((float)((cnt2 & 0xffffu) + (cnt2 >> 16)));
        if (tot >= 256) B = cand;
      }
      int cgt = 0;
#pragma unroll
      for (int it = 0; it < 8; ++it)
#pragma unroll
        for (int j = 0; j < 4; ++j) cgt += (((kp[it][j] & 0xffffu) > B) ? 1 : 0) + (((kp[it][j] >> 16) > B) ? 1 : 0);
      const int m = 256 - (int)wave_sum_dpp((float)cgt);
      int base = 0, eqbase = 0;
#pragma unroll
      for (int it = 0; it < 8; ++it) {
        if (it < nit) {
          unsigned kk[8];
#pragma unroll
          for (int j = 0; j < 4; ++j) { kk[2 * j] = kp[it][j] & 0xffffu; kk[2 * j + 1] = kp[it][j] >> 16; }
          int ceq = 0;
#pragma unroll
          for (int j = 0; j < 8; ++j) ceq += (kk[j] == B) ? 1 : 0;
          const int eqi = wave_scan_incl(ceq, lane);
          int eqr = eqbase + eqi - ceq;
          unsigned tmask = 0u; int ct = 0;
#pragma unroll
          for (int j = 0; j < 8; ++j) {
            const bool eq = kk[j] == B;
            const bool take = (kk[j] > B) || (eq && eqr < m);
            eqr += eq ? 1 : 0;
            tmask |= take ? (1u << j) : 0u;
            ct += take ? 1 : 0;
          }
          const int pi = wave_scan_incl(ct, lane);
          int ps = base + pi - ct;
#pragma unroll
          for (int j = 0; j < 8; ++j) {
            if ((tmask >> j) & 1u) { if (ps < 256) selq[ps] = (unsigned short)(512 * it + 8 * lane + j); ++ps; }
          }
          base += __builtin_amdgcn_readlane(pi, 63);
          eqbase += __builtin_amdgcn_readlane(eqi, 63);
        }
      }
    }
  }
  DSA_MARK(3);
  __syncthreads();
  {
    DSA_IDS
    const int wave_b = wave;
    const float slope = (c < 8) ? exp2f(-(float)(c + 1)) : 0.f;
#pragma unroll 1
    for (int qq = 0; qq < 2; ++qq) {
      const int q = wave + 8 * qq, t = t0 + q;
      const int nsel = (t + 1 < 256) ? (t + 1) : 256, nch = (nsel + 31) >> 5;
      const LAS unsigned short* selq = sel + q * 256;
      bf16x8_t qf[8];
      {
        const int lq = tid_fresh() & 63;
        const bf16* qlp = QLh + q * 2048 + (lq & 7) * 256 + 8 * (lq >> 4);
#pragma unroll
        for (int ks = 0; ks < 8; ++ks) qf[ks] = *(const bf16x8_t*)(qlp + ks * 32);
      }
      float mrun = -1e30f, lrun = 0.f;
      f32x4 o[16];
#pragma unroll
      for (int nt = 0; nt < 16; ++nt) o[nt] = (f32x4){0.f, 0.f, 0.f, 0.f};
      u32x4_t st[16];
      f32x4 st_ss = (f32x4){0.f, 0.f, 0.f, 0.f}; float st_d = -1.f;
#define DSA_ISSUE(ch)                                                                                   \
      {          \
        _Pragma("unroll") for (int r = 0; r < 16; ++r) {                                                \
          const int idx = (int)selq[(ch) * 32 + 2 * r + (lane >> 5)];                                   \
          st[r] = *(const u32x4_t*)(CKV + (tokb + idx) * 256 + (lane & 31) * 8);                        \
        }                                                                                               \
        const int j2 = (ch) * 32 + (lane & 31);                                                         \
        const int idx2 = (int)selq[j2];                                                                 \
        st_ss = *(const f32x4*)(SSP + (tokb + idx2) * 4);                                               \
        st_d = (j2 < nsel) ? (float)(t - idx2) : -1.f;                                                  \
      }
      DSA_ISSUE(0);
#pragma unroll 1
      for (int ch = 0; ch < nch; ++ch) {
        const int lane = tid_fresh() & 63, g = lane >> 4, c = lane & 15;
        LAS unsigned char* buf = lds + DS_KEY16 + wave_b * DS_CHUNK;
        LAS float* kr = (LAS float*)(lds + DS_WAVE + wave_b * 1024);
        LAS float* kd = kr + 32;
        const unsigned vb = (unsigned)(uintptr_t)buf + (unsigned)((4 * g + (c >> 2)) * DS_RS + 8 * (c & 3));
#pragma unroll
        for (int r = 0; r < 16; ++r) *(LAS u32x4_t*)(buf + (2 * r + (lane >> 5)) * DS_RS + (lane & 31) * 16) = st[r];
        if (lane < 32) { kr[lane] = rsqrtf(((st_ss[0] + st_ss[1]) + (st_ss[2] + st_ss[3])) * (1.f / 256.f) + 1e-6f); kd[lane] = st_d; }
        wave_lds_fence();
        DSA_MARKI(11);
        DSA_ISSUE((ch + 1 < nch) ? ch + 1 : ch);
        f32x4 s0 = (f32x4){0.f, 0.f, 0.f, 0.f}, s1 = (f32x4){0.f, 0.f, 0.f, 0.f};
#pragma unroll
        for (int ks = 0; ks < 8; ++ks) {
          const bf16x8_t a0 = *(const LAS bf16x8_t*)(buf + c * DS_RS + (ks * 32 + 8 * g) * 2);
          const bf16x8_t a1 = *(const LAS bf16x8_t*)(buf + (16 + c) * DS_RS + (ks * 32 + 8 * g) * 2);
          s0 = __builtin_amdgcn_mfma_f32_16x16x32_bf16(a0, qf[ks], s0, 0, 0, 0);
          s1 = __builtin_amdgcn_mfma_f32_16x16x32_bf16(a1, qf[ks], s1, 0, 0, 0);
        }
        asm volatile("" :: "v"(s0[0]), "v"(s1[0]));
        DSA_MARKI(12);
        const f32x4 r0 = *(const LAS f32x4*)(kr + 4 * g), r1 = *(const LAS f32x4*)(kr + 16 + 4 * g);
        const f32x4 d0 = *(const LAS f32x4*)(kd + 4 * g), d1 = *(const LAS f32x4*)(kd + 16 + 4 * g);
        float x[8];
#pragma unroll
        for (int i = 0; i < 4; ++i) {
          x[i] = (d0[i] < 0.f) ? -1e30f : (s0[i] * r0[i] - slope * d0[i]);
          x[4 + i] = (d1[i] < 0.f) ? -1e30f : (s1[i] * r1[i] - slope * d1[i]);
        }
        float mx = fmaxf(fmaxf(fmaxf(x[0], x[1]), fmaxf(x[2], x[3])), fmaxf(fmaxf(x[4], x[5]), fmaxf(x[6], x[7])));
        mx = xrow_max(mx);
        const float mn = fmaxf(mrun, mx);
        const float alpha = __expf(mrun - mn);
        mrun = mn;
        float pr[8], ps = 0.f;
#pragma unroll
        for (int i = 0; i < 8; ++i) { pr[i] = (x[i] <= -1e29f) ? 0.f : __expf(x[i] - mn); ps += pr[i]; }
        ps = xrow_sum(ps);
        lrun = lrun * alpha + ps;
        if (__builtin_amdgcn_ballot_w64(alpha != 1.f) != 0ull) {
#pragma unroll
          for (int nt = 0; nt < 16; ++nt) o[nt] *= alpha;
        }
        union { bf16x8_t v; unsigned u[4]; } pf;
        pf.u[0] = pk2(pr[0] * r0[0], pr[1] * r0[1]); pf.u[1] = pk2(pr[2] * r0[2], pr[3] * r0[3]);
        pf.u[2] = pk2(pr[4] * r1[0], pr[5] * r1[1]); pf.u[3] = pk2(pr[6] * r1[2], pr[7] * r1[3]);
        asm volatile("" :: "v"(pf.u[0]));
        DSA_MARKI(13);
        {
          s16x4_t loA[4], hiA[4], loB[4], hiB[4];
#define PV_READ(L, H, nt0) _Pragma("unroll") for (int u = 0; u < 4; ++u) { L[u] = tr_read_b64(vb + ((nt0) + u) * 32); H[u] = tr_read_b64(vb + ((nt0) + u) * 32 + 16 * DS_RS); }
#define PV_MMA(L, H, nt0) _Pragma("unroll") for (int u = 0; u < 4; ++u) { \
            const bf16x8_t af = (bf16x8_t){L[u][0], L[u][1], L[u][2], L[u][3], H[u][0], H[u][1], H[u][2], H[u][3]}; \
            o[(nt0) + u] = __builtin_amdgcn_mfma_f32_16x16x32_bf16(af, pf.v, o[(nt0) + u], 0, 0, 0); }
          PV_READ(loA, hiA, 0);
          PV_READ(loB, hiB, 4);
          asm volatile("s_waitcnt lgkmcnt(8)" ::: "memory"); __builtin_amdgcn_sched_barrier(0);
          PV_MMA(loA, hiA, 0); __builtin_amdgcn_sched_barrier(0);
          PV_READ(loA, hiA, 8);
          asm volatile("s_waitcnt lgkmcnt(8)" ::: "memory"); __builtin_amdgcn_sched_barrier(0);
          PV_MMA(loB, hiB, 4); __builtin_amdgcn_sched_barrier(0);
          PV_READ(loB, hiB, 12);
          asm volatile("s_waitcnt lgkmcnt(8)" ::: "memory"); __builtin_amdgcn_sched_barrier(0);
          PV_MMA(loA, hiA, 8); __builtin_amdgcn_sched_barrier(0);
          asm volatile("s_waitcnt lgkmcnt(0)" ::: "memory"); __builtin_amdgcn_sched_barrier(0);
          PV_MMA(loB, hiB, 12);
#undef PV_READ
#undef PV_MMA
        }
        wave_lds_fence();
        asm volatile("" :: "v"(o[0][0]), "v"(o[15][0]));
        DSA_MARKI(14);
      }
#undef DSA_ISSUE
      if (c < 8) {
        const float inv = 1.f / lrun;
#pragma unroll
        for (int nt = 0; nt < 16; ++nt) {
          uint2 w; w.x = pk2(o[nt][0] * inv, o[nt][1] * inv); w.y = pk2(o[nt][2] * inv, o[nt][3] * inv);
          *(uint2*)(OLh + q * 2048 + c * 256 + nt * 16 + 4 * g) = w;
        }
      }
    }
  }
  DSA_MARK(4);
  __syncthreads();
  }
  {
    DSA_IDS
    const int h = wave;
    bf16x8_t of0[8], of1[8];
#pragma unroll
    for (int ks = 0; ks < 8; ++ks) {
      of0[ks] = *(const bf16x8_t*)(OL + c * 2048 + h * 256 + ks * 32 + 8 * g);
      of1[ks] = *(const bf16x8_t*)(OL + (16 + c) * 2048 + h * 256 + ks * 32 + 8 * g);
    }
    f32x4 c0[8], c1[8];
#pragma unroll
    for (int nt = 0; nt < 8; ++nt) {
      f32x4 a0 = (f32x4){0.f, 0.f, 0.f, 0.f}, a1 = a0;
#pragma unroll
      for (int ks = 0; ks < 8; ++ks) {
        const bf16x8_t wf = *(const bf16x8_t*)(WUV + (size_t)(h * 128 + nt * 16 + c) * 256 + ks * 32 + 8 * g);
        a0 = __builtin_amdgcn_mfma_f32_16x16x32_bf16(wf, of0[ks], a0, 0, 0, 0);
        a1 = __builtin_amdgcn_mfma_f32_16x16x32_bf16(wf, of1[ks], a1, 0, 0, 0);
      }
      c0[nt] = a0; c1[nt] = a1;
    }
#pragma unroll
    for (int nt = 0; nt < 8; ++nt) {
      uint2 w; w.x = pk2(c0[nt][0], c0[nt][1]); w.y = pk2(c0[nt][2], c0[nt][3]);
      *(uint2*)(ODSA + (tok00 + c) * 1024 + h * 128 + nt * 16 + 4 * g) = w;
      w.x = pk2(c1[nt][0], c1[nt][1]); w.y = pk2(c1[nt][2], c1[nt][3]);
      *(uint2*)(ODSA + (tok00 + 16 + c) * 1024 + h * 128 + nt * 16 + 4 * g) = w;
    }
  }
  DSA_MARK(5);
  __syncthreads();
}

#undef DSA_IDS
__device__ __forceinline__ void ph_dsa512(const P& p, unsigned char* lds_raw) {
  for (int it = blockIdx.x; it < TT / 16; it += gridDim.x) {
    const int k = it >> 8, j = it & 255;
    dsa_batch(p, lds_raw, k, ((k & 1) ? 255 - j : j) >> 1);
  }
}

#define GL_QD    0
#define GL_KI    18432
#define GL_KE    36864
#define GL_V     55296
#define GL_AT    90112
#define GL_GLOW  99328
#define GL_QT    103424
#define GL_DEC   105472
#define GL_SSQ   105984
#define GL_LB    108032
#define GL_TOTAL 140800

#define GLA_BAR() do { asm volatile("s_waitcnt lgkmcnt(0)" ::: "memory"); __builtin_amdgcn_s_barrier(); asm volatile("" ::: "memory"); } while (0)
#ifndef PROBE_GLA
#define PROBE_GLA 0
#endif
#if PROBE_GLA
#define GLA_MARK(k) do { const unsigned long long n_ = __builtin_amdgcn_s_memrealtime(); if (PROBE_GLA == (k)) { const unsigned long long q_ = n_ - tmark; \
    while (__builtin_amdgcn_s_memrealtime() - n_ < q_) __builtin_amdgcn_s_sleep(2); } tmark = __builtin_amdgcn_s_memrealtime(); } while (0)
#else
#define GLA_MARK(k) do {} while (0)
#endif
__device__ __forceinline__ void gla_item(const P& p, unsigned char* lds_raw, int item) {
  int tid = tid_fresh();
  const int b = item >> 2, h = item & 3;
  const size_t tokb = (size_t)b * SEQ;
  const bf16* Qg = (const bf16*)(p.ws + OFF_Q);
  const bf16* Kg = (const bf16*)(p.ws + OFF_K);
  bf16* Vg = (bf16*)(p.ws + OFF_V);
  const float* GLOWg = (const float*)(p.ws + OFF_GLOW);
  const bf16* SGR = (const bf16*)(p.ws + OFF_SGR);
  LAS unsigned char* lds = (LAS unsigned char*)lds_raw;
  const unsigned lds0 = (unsigned)(uintptr_t)lds;
  LAS float* QT = (LAS float*)(lds + GL_QT);
  LAS float* DEC = (LAS float*)(lds + GL_DEC);
  LAS float* SSQ = (LAS float*)(lds + GL_SSQ);
  float wg[16];
  const float* prm = (const float*)(p.ws + OFF_PRM);
#pragma unroll
  for (int r = 0; r < 16; ++r) wg[r] = prm[PRM_WGU + r * 512 + h * 128 + (tid & 127)];
  const float bg = prm[PRM_BG + h * 128 + (tid & 127)];
  const float gn0 = prm[PRM_GNG + h * 256 + 32 * (tid >> 6) + (tid & 15)], gn1 = prm[PRM_GNG + h * 256 + 32 * (tid >> 6) + 16 + (tid & 15)];
  u32x4_t rq[2], rk[2], rv[4], rg = (u32x4_t){0u, 0u, 0u, 0u};
#define GLA_LOAD(ch)                                                                                      \
  {                                                                                                       \
    const size_t tb = tokb + (size_t)(ch) * 64;                                                           \
    _Pragma("unroll") for (int i = 0; i < 2; ++i) {                                                       \
      const int id = tid + 512 * i, tk = id >> 4, part = id & 15;                                         \
      rq[i] = *(const u32x4_t*)(Qg + (tb + tk) * 512 + h * 128 + part * 8);                               \
      rk[i] = *(const u32x4_t*)(Kg + (tb + tk) * 512 + h * 128 + part * 8);                               \
    }                                                                                                     \
    _Pragma("unroll") for (int i = 0; i < 4; ++i) {                                                       \
      const int id = tid + 512 * i, tk = id >> 5, part = id & 31;                                         \
      rv[i] = *(const u32x4_t*)(Vg + (tb + tk) * 1024 + h * 256 + part * 8);                              \
    }                                                                                                     \
    if (tid < 256) rg = *(const u32x4_t*)(GLOWg + (tb + (tid >> 2)) * 16 + (tid & 3) * 4);                \
  }
  f32x4 S[8][2];
#pragma unroll
  for (int a = 0; a < 8; ++a) { S[a][0] = (f32x4){0.f, 0.f, 0.f, 0.f}; S[a][1] = (f32x4){0.f, 0.f, 0.f, 0.f}; }
  GLA_LOAD(0);
#if PROBE_GLA
  unsigned long long tmark = __builtin_amdgcn_s_memrealtime();
#endif
#pragma unroll 1
  for (int ch = 0; ch < SEQ / 64; ++ch) {
    asm volatile("" : "+v"(tid));
    const int wave = __builtin_amdgcn_readfirstlane(tid >> 6), lane = tid & 63, g = lane >> 4, c = lane & 15;
    const int d = tid & 127, tq = __builtin_amdgcn_readfirstlane(tid >> 7);
    const unsigned vtr = lds0 + GL_V + (unsigned)((8 * g + (c >> 2)) * 544 + (32 * wave + 4 * (c & 3)) * 2);
    const unsigned ketr = lds0 + GL_KE + (unsigned)((8 * g + (c >> 2)) * 288 + (4 * (c & 3)) * 2);
    const size_t tb = tokb + (size_t)ch * 64;
#pragma unroll
    for (int i = 0; i < 2; ++i) {
      const int id = tid + 512 * i, tk = id >> 4, part = id & 15;
      *(LAS u32x4_t*)(lds + GL_QD + tk * 288 + part * 16) = rq[i];
      *(LAS u32x4_t*)(lds + GL_KI + tk * 288 + part * 16) = rk[i];
    }
#pragma unroll
    for (int i = 0; i < 4; ++i) {
      const int id = tid + 512 * i, tk = id >> 5, part = id & 31;
      *(LAS u32x4_t*)(lds + GL_V + tk * 544 + part * 16) = rv[i];
    }
    if (tid < 256) *(LAS u32x4_t*)(lds + GL_GLOW + (tid >> 2) * 64 + (tid & 3) * 16) = rg;
    GLA_MARK(1); GLA_BAR();
    GLA_LOAD((ch + 1 < SEQ / 64) ? ch + 1 : ch);
    u32x4_t rs[4];
#pragma unroll
    for (int i = 0; i < 4; ++i) {
      const int id = tid + 512 * i, tk = id >> 5, part = id & 31;
      rs[i] = *(const u32x4_t*)(SGR + (tb + tk) * 1024 + h * 256 + part * 8);
    }
    LAS float* LB = (LAS float*)(lds + GL_LB);
    float run = 0.f;
#pragma unroll 2
    for (int i = 0; i < 16; ++i) {
      const LAS f32x4* gp = (const LAS f32x4*)(lds + GL_GLOW + (16 * tq + i) * 64);
      const f32x4 g0 = gp[0], g1 = gp[1], g2 = gp[2], g3 = gp[3];
      float gl = bg;
      gl += g0[0] * wg[0] + g0[1] * wg[1] + g0[2] * wg[2] + g0[3] * wg[3];
      gl += g1[0] * wg[4] + g1[1] * wg[5] + g1[2] * wg[6] + g1[3] * wg[7];
      gl += g2[0] * wg[8] + g2[1] * wg[9] + g2[2] * wg[10] + g2[3] * wg[11];
      gl += g3[0] * wg[12] + g3[1] * wg[13] + g3[2] * wg[14] + g3[3] * wg[15];
      const float ls = fminf(gl, 0.f) - __logf(1.f + __expf(-fabsf(gl)));
      run += ls * (1.f / 16.f);
      LB[(16 * tq + i) * 128 + d] = run;
    }
    QT[tq * 128 + d] = run;
    GLA_MARK(2); GLA_BAR();
    {
      float off = 0.f, tot = 0.f;
#pragma unroll
      for (int k = 0; k < 4; ++k) { const float v = QT[k * 128 + d]; tot += v; off += (k < tq) ? v : 0.f; }
      const float eb = __expf(tot);
#pragma unroll 2
      for (int i = 0; i < 16; ++i) {
        const int t = 16 * tq + i;
        const float bb = LB[t * 128 + d] + off;
        const float e = __expf(bb), r = __expf(-bb);
        LAS bf16* qp = (LAS bf16*)(lds + GL_QD + t * 288) + d;
        LAS bf16* kp = (LAS bf16*)(lds + GL_KI + t * 288) + d;
        LAS bf16* ep = (LAS bf16*)(lds + GL_KE + t * 288) + d;
        const float q = bf2f(*qp), k = bf2f(*kp);
        *qp = f2bf(q * e);
        *kp = f2bf(k * r);
        *ep = f2bf(k * (eb * r));
      }
      if (tq == 0) DEC[d] = eb;
    }
    GLA_MARK(3); GLA_BAR();
    {
      const int ti = wave >> 1;
#pragma unroll
      for (int u = 0; u < 2; ++u) {
        const int tj = 2 * (wave & 1) + u;
        f32x4 acc = (f32x4){0.f, 0.f, 0.f, 0.f};
        if (tj <= ti) {
#pragma unroll
          for (int ks = 0; ks < 4; ++ks) {
            const bf16x8_t a = *(const LAS bf16x8_t*)(lds + GL_QD + (16 * ti + c) * 288 + (32 * ks + 8 * g) * 2);
            const bf16x8_t bb = *(const LAS bf16x8_t*)(lds + GL_KI + (16 * tj + c) * 288 + (32 * ks + 8 * g) * 2);
            acc = __builtin_amdgcn_mfma_f32_16x16x32_bf16(a, bb, acc, 0, 0, 0);
          }
        }
#pragma unroll
        for (int r = 0; r < 4; ++r) {
          const int i = 16 * ti + 4 * g + r, j = 16 * tj + c;
          *((LAS bf16*)(lds + GL_AT + i * 144) + j) = f2bf((j <= i) ? acc[r] : 0.f);
        }
      }
    }
    GLA_MARK(4); GLA_BAR();
    f32x4 o[4][2];
    {
      bf16x8_t vf[2][2];
      {
        s16x4_t lo[4], hi[4];
#pragma unroll
        for (int ks = 0; ks < 2; ++ks)
#pragma unroll
          for (int tn = 0; tn < 2; ++tn) {
            lo[ks * 2 + tn] = tr_read_b64(vtr + (32 * ks) * 544 + tn * 32);
            hi[ks * 2 + tn] = tr_read_b64(vtr + (32 * ks + 4) * 544 + tn * 32);
          }
        asm volatile("s_waitcnt lgkmcnt(0)" ::: "memory");
        __builtin_amdgcn_sched_barrier(0);
#pragma unroll
        for (int u = 0; u < 4; ++u)
          vf[u >> 1][u & 1] = (bf16x8_t){lo[u][0], lo[u][1], lo[u][2], lo[u][3], hi[u][0], hi[u][1], hi[u][2], hi[u][3]};
      }
#pragma unroll
      for (int tm = 0; tm < 4; ++tm) { o[tm][0] = (f32x4){0.f, 0.f, 0.f, 0.f}; o[tm][1] = (f32x4){0.f, 0.f, 0.f, 0.f}; }
#pragma unroll
      for (int tm = 0; tm < 4; ++tm)
#pragma unroll
        for (int ks = 0; ks < 2; ++ks) {
          if (ks == 1 && tm < 2) continue;
          const bf16x8_t a = *(const LAS bf16x8_t*)(lds + GL_AT + (16 * tm + c) * 144 + (32 * ks + 8 * g) * 2);
          o[tm][0] = __builtin_amdgcn_mfma_f32_16x16x32_bf16(a, vf[ks][0], o[tm][0], 0, 0, 0);
          o[tm][1] = __builtin_amdgcn_mfma_f32_16x16x32_bf16(a, vf[ks][1], o[tm][1], 0, 0, 0);
          __builtin_amdgcn_sched_barrier(0);
        }
#pragma unroll
      for (int u = 0; u < 4; ++u) {
        union { bf16x8_t v; unsigned w[4]; } s0, s1;
        s0.w[0] = pk2(S[2 * u][0][0], S[2 * u][0][1]); s0.w[1] = pk2(S[2 * u][0][2], S[2 * u][0][3]);
        s0.w[2] = pk2(S[2 * u + 1][0][0], S[2 * u + 1][0][1]); s0.w[3] = pk2(S[2 * u + 1][0][2], S[2 * u + 1][0][3]);
        s1.w[0] = pk2(S[2 * u][1][0], S[2 * u][1][1]); s1.w[1] = pk2(S[2 * u][1][2], S[2 * u][1][3]);
        s1.w[2] = pk2(S[2 * u + 1][1][0], S[2 * u + 1][1][1]); s1.w[3] = pk2(S[2 * u + 1][1][2], S[2 * u + 1][1][3]);
#pragma unroll
        for (int tm = 0; tm < 4; ++tm) {
          const LAS unsigned char* qrow = lds + GL_QD + (16 * tm + c) * 288 + (32 * u + 4 * g) * 2;
          const s16x4_t q0 = *(const LAS s16x4_t*)qrow, q1 = *(const LAS s16x4_t*)(qrow + 32);
          const bf16x8_t a = (bf16x8_t){q0[0], q0[1], q0[2], q0[3], q1[0], q1[1], q1[2], q1[3]};
          o[tm][0] = __builtin_amdgcn_mfma_f32_16x16x32_bf16(a, s0.v, o[tm][0], 0, 0, 0);
          o[tm][1] = __builtin_amdgcn_mfma_f32_16x16x32_bf16(a, s1.v, o[tm][1], 0, 0, 0);
        }
        __builtin_amdgcn_sched_barrier(0);
      }
#pragma unroll
      for (int tk = 0; tk < 8; ++tk) {
        const f32x4 dec4 = *(const LAS f32x4*)(DEC + 16 * tk + 4 * g);
        S[tk][0] *= dec4; S[tk][1] *= dec4;
        s16x4_t lo0 = tr_read_b64(ketr + tk * 32), hi0 = tr_read_b64(ketr + 4 * 288 + tk * 32);
        s16x4_t lo1 = tr_read_b64(ketr + 32 * 288 + tk * 32), hi1 = tr_read_b64(ketr + 36 * 288 + tk * 32);
        asm volatile("s_waitcnt lgkmcnt(0)" ::: "memory");
        __builtin_amdgcn_sched_barrier(0);
        const bf16x8_t a0 = (bf16x8_t){lo0[0], lo0[1], lo0[2], lo0[3], hi0[0], hi0[1], hi0[2], hi0[3]};
        const bf16x8_t a1 = (bf16x8_t){lo1[0], lo1[1], lo1[2], lo1[3], hi1[0], hi1[1], hi1[2], hi1[3]};
        S[tk][0] = __builtin_amdgcn_mfma_f32_16x16x32_bf16(a0, vf[0][0], S[tk][0], 0, 0, 0);
        S[tk][1] = __builtin_amdgcn_mfma_f32_16x16x32_bf16(a0, vf[0][1], S[tk][1], 0, 0, 0);
        S[tk][0] = __builtin_amdgcn_mfma_f32_16x16x32_bf16(a1, vf[1][0], S[tk][0], 0, 0, 0);
        S[tk][1] = __builtin_amdgcn_mfma_f32_16x16x32_bf16(a1, vf[1][1], S[tk][1], 0, 0, 0);
        __builtin_amdgcn_sched_barrier(0);
      }
#pragma unroll
      for (int tm = 0; tm < 4; ++tm)
#pragma unroll
        for (int r = 0; r < 4; ++r) {
          float ss = o[tm][0][r] * o[tm][0][r] + o[tm][1][r] * o[tm][1][r];
          ss = row16_sum(ss);
          if (c == 0) SSQ[(16 * tm + 4 * g + r) * 8 + wave] = ss;
        }
    }
    GLA_MARK(5); GLA_BAR();
    {
      LAS bf16* OB = (LAS bf16*)(lds + GL_LB);
#pragma unroll
      for (int tm = 0; tm < 4; ++tm)
#pragma unroll
        for (int r = 0; r < 4; ++r) {
          const int t = 16 * tm + 4 * g + r;
          const f32x4 p0 = *(const LAS f32x4*)(SSQ + t * 8), p1 = *(const LAS f32x4*)(SSQ + t * 8 + 4);
          const float tot = ((p0[0] + p0[1]) + (p0[2] + p0[3])) + ((p1[0] + p1[1]) + (p1[2] + p1[3]));
          const float rstd = rsqrtf(tot * (1.f / 256.f) + 1e-6f);
          OB[t * 256 + 32 * wave + c] = f2bf(o[tm][0][r] * rstd * gn0);
          OB[t * 256 + 32 * wave + 16 + c] = f2bf(o[tm][1][r] * rstd * gn1);
        }
    }
    GLA_MARK(6); GLA_BAR();
#pragma unroll
    for (int i = 0; i < 4; ++i) {
      const int id = tid + 512 * i, tk = id >> 5, part = id & 31;
      const u32x4_t ov = *(const LAS u32x4_t*)(lds + GL_LB + tk * 512 + part * 16);
      const u32x4_t sv = rs[i];
      u32x4_t gv;
      gv[0] = pk2(bflo(ov[0]) * bflo(sv[0]), bfhi(ov[0]) * bfhi(sv[0]));
      gv[1] = pk2(bflo(ov[1]) * bflo(sv[1]), bfhi(ov[1]) * bfhi(sv[1]));
      gv[2] = pk2(bflo(ov[2]) * bflo(sv[2]), bfhi(ov[2]) * bfhi(sv[2]));
      gv[3] = pk2(bflo(ov[3]) * bflo(sv[3]), bfhi(ov[3]) * bfhi(sv[3]));
      *(u32x4_t*)(Vg + (tb + tk) * 1024 + h * 256 + part * 8) = gv;
    }
    GLA_MARK(7);
  }
#undef GLA_LOAD
  __syncthreads();
}

#define LDS_BYTES 155712
#define OFF_XBAR (224ull * 1024)
#define OFF_CTR (200ull * 1024)

__device__ __forceinline__ unsigned xcc_id() { return (unsigned)__builtin_amdgcn_s_getreg((3 << 11) | 20) & 0x7u; }
__device__ __forceinline__ void ph_mixer(const P& p, unsigned char* lds_raw, bool do_gla) {
  if (do_gla && blockIdx.x < 32) { gla_item(p, lds_raw, blockIdx.x); if (blockIdx.x == 0) TS_SET(p, 20); }
  unsigned* ctr = (unsigned*)(p.ws + OFF_CTR);
  LAS unsigned* slot = (LAS unsigned*)((LAS unsigned char*)lds_raw + DS_TOTAL);
  const unsigned home = xcc_id();
  unsigned k = 0;
  for (;;) {
    if (tid_fresh() == 0) {
      unsigned qi = 0xffffffffu;
      while (k < 8) {
        const unsigned b = (home + k) & 7u;
        const unsigned v = __hip_atomic_fetch_add(ctr + 64 * b, 1u, __ATOMIC_RELAXED, __HIP_MEMORY_SCOPE_AGENT);
        if (v < 128u) { qi = (b << 8) | v; break; }
        ++k;
      }
      slot[0] = qi; slot[1] = k;
    }
    __syncthreads();
    const unsigned qi = slot[0];
    k = slot[1];
    __syncthreads();
    if (qi == 0xffffffffu) break;
    dsa_batch(p, lds_raw, (int)(qi >> 8), 127 - (int)(qi & 255u));
  }
}

__global__ void __launch_bounds__(512, 2) mega(P p) {
  extern __shared__ __attribute__((aligned(16))) unsigned char lds_raw[];
  LAS unsigned char* lds = (LAS unsigned char*)lds_raw;
  cg::grid_group grid = cg::this_grid();
  char* ws = p.ws;
  const int bid = blockIdx.x, nb = gridDim.x;
  if (bid == 0 && threadIdx.x < 8) *(unsigned*)(ws + OFF_CTR + 256 * threadIdx.x) = 0u;
  if (bid == 0) { for (int i = threadIdx.x; i < XCD_BAR_WORDS; i += 512) ((unsigned*)(ws + OFF_XBAR))[i] = 0u; }
  volatile LAS unsigned* xst = (volatile LAS unsigned*)(lds + DS_TOTAL + 16);
  if (threadIdx.x < 4) xst[threadIdx.x] = 0u;
#if PROBE_TS
  { const int t_ = tid_fresh(); if (bid == 0 && t_ < 64) ((unsigned long long*)(ws + OFF_TS))[t_] = 0ull; }
  __syncthreads();
  if (bid == 0) TS_SET(p, 0);
#endif
  ph_prep(p, (float*)lds_raw);
  grid.sync();
  const XcdBarrier xb = xcd_barrier_post((unsigned*)(ws + OFF_XBAR), xst);
  if (bid == 0) TS_SET(p, 1);
  ph_mod(p, p.x, p.norm1_g, 0, 1024, (bf16*)(ws + OFF_H), bid, nb);
  xcd_barrier(xb);
  if (bid == 0) TS_SET(p, 2);
  gemm_run(lds, (const bf16*)(ws + OFF_H), (const bf16*)(ws + OFF_WT_IN), TT, 7168, 1024, EpiIn{ws, p.out});
  xcd_barrier(xb);
  if (bid == 0) TS_SET(p, 3);
  ph_mixer(p, lds_raw, true);
  if (bid == 0) TS_SET(p, 21);
  xcd_barrier(xb);
  if (bid == 0) TS_SET(p, 4);
  gemm_run(lds, (const bf16*)(ws + OFF_V), (const bf16*)(ws + OFF_WT_A), TT, 1024, 1024,
           EpiMix<false>{(const bf16*)p.out, (bf16*)(ws + OFF_MIX)});
  gemm_run(lds, (const bf16*)(ws + OFF_ODSA), (const bf16*)(ws + OFF_WT_B), TT, 1024, 1024,
           EpiMix<true>{(const bf16*)p.out + (size_t)TT * 1024, (bf16*)(ws + OFF_MIX)});
  xcd_barrier(xb);
  if (bid == 0) TS_SET(p, 5);
  gemm_run(lds, (const bf16*)(ws + OFF_MIX), (const bf16*)(ws + OFF_WT_OUT), TT, 1024, 1024,
           EpiX1{p.x, (const float*)(ws + OFF_ADA), p.out});
  xcd_barrier(xb);
  if (bid == 0) TS_SET(p, 6);
  ph_mod(p, p.out, (const float*)(ws + OFF_PRM) + PRM_N2G, 3072, 4096, (bf16*)(ws + OFF_H), bid, nb);
  xcd_barrier(xb);
  if (bid == 0) TS_SET(p, 7);
  gemm_run(lds, (const bf16*)(ws + OFF_H), (const bf16*)(ws + OFF_WT_Q), TT, 2048, 1024, EpiPlain{(bf16*)(ws + OFF_PQ), 2048});
  xcd_barrier(xb);
  if (bid == 0) TS_SET(p, 8);
  ph_peer512(p, lds_raw, p.out);
#if PROBE_TS
  if (bid == 0) TS_SET(p, 18);
  xcd_barrier(xb);
  {
    const unsigned long long* T = (const unsigned long long*)(ws + OFF_TS);
    const unsigned long long q = (unsigned long long)(PROBE_Q), t0 = __builtin_amdgcn_s_memrealtime();
    while (__builtin_amdgcn_s_memrealtime() - t0 < q) __builtin_amdgcn_s_sleep(8);
  }
#endif
}

extern "C" void kernel_launch(void* const* d_in, const int* in_sizes, int n_in, void* d_out, int out_size, void* d_ws,
                              size_t ws_size, hipStream_t stream) {
  P p{};
  const float** f = (const float**)&p;
  for (int i = 0; i < 22; ++i) f[i] = (const float*)d_in[i];
  p.out = (float*)d_out;
  p.ws = (char*)d_ws;
  if (ws_size < WS_NEED) { fprintf(stderr, "workspace too small: %zu\n", ws_size); return; }
  static int grid_blocks = 0;
  if (!grid_blocks) {
    int dev = 0, cus = 0, per_cu = 0;
    (void)hipGetDevice(&dev);
    (void)hipDeviceGetAttribute(&cus, hipDeviceAttributeMultiprocessorCount, dev);
    if (hipFuncSetAttribute((const void*)mega, hipFuncAttributeMaxDynamicSharedMemorySize, LDS_BYTES) != hipSuccess) {
      fprintf(stderr, "hipFuncSetAttribute failed\n"); grid_blocks = -1; return;
    }
    if (hipOccupancyMaxActiveBlocksPerMultiprocessor(&per_cu, (const void*)mega, 512, LDS_BYTES) != hipSuccess || per_cu < 1) {
      fprintf(stderr, "occupancy query failed\n"); grid_blocks = -1; return;
    }
    grid_blocks = cus;
  }
  if (grid_blocks <= 0) return;
  void* args[] = {&p};
  hipError_t e = hipLaunchCooperativeKernel((void*)mega, dim3(grid_blocks), dim3(512), args, LDS_BYTES, stream);
  if (e != hipSuccess) fprintf(stderr, "cooperative launch failed: %s (grid %d)\n", hipGetErrorString(e), grid_blocks);
}
```

```cpp
#include <hip/hip_runtime.h>
#include <hip/hip_cooperative_groups.h>
#include <cstdio>
#include <cstdint>
namespace cg = cooperative_groups;

#define TT 32768
#define SEQ 4096
#define DM 1024
#define NIN 7000
typedef unsigned short bf16;
#define LAS __attribute__((address_space(3)))

struct P {
  const float *x, *c, *w_ada, *b_ada, *norm1_g, *w_in, *w_gate_up, *b_gate, *gla_norm_g, *kv_norm_g,
      *w_uk, *w_uv, *w_a, *w_b, *w_out, *norm2_g, *w_q, *sk1, *sk2, *peer_u, *peer_v, *final_g;
  float* out;
  char* ws;
};

#define MB (1ull << 20)
#define OFF_ADA   (0ull)
#define OFF_H     (1 * MB)
#define OFF_ODSA  (1 * MB)
#define OFF_Q     (65 * MB)
#define OFF_K     (97 * MB)
#define OFF_MIX   (65 * MB)
#define OFF_V     (129 * MB)
#define OFF_DQ    (193 * MB)
#define OFF_PQ    (129 * MB)
#define OFF_DSCR  (257 * MB)
#define OFF_SSP   (256ull * 1024)
#define OFF_CKV   (289 * MB)
#define OFF_IQ    (305 * MB)
#define OFF_IK    (337 * MB)
#define OFF_IW    (341 * MB)
#define OFF_GLOW  (342 * MB)
#define OFF_SGR   (344 * MB)
#define OFF_WT    (408 * MB)
#define OFF_WT_IN  (OFF_WT)
#define OFF_WT_A   (OFF_WT + 7168ull * 2048)
#define OFF_WT_B   (OFF_WT_A + 1024ull * 2048)
#define OFF_WT_OUT (OFF_WT_B + 1024ull * 2048)
#define OFF_WT_Q   (OFF_WT_OUT + 1024ull * 2048)
#define OFF_PU    (432 * MB)
#define OFF_PV    (464 * MB)
#define OFF_SK    (496 * MB)
#define OFF_PSC   (496 * MB + 128 * 1024)
#define OFF_WUK   (497 * MB)
#define OFF_WUV   (497 * MB + 512 * 1024)
#define WS_NEED   (498 * MB)

__device__ __forceinline__ bf16 f2bf(float f) {
  unsigned u = __float_as_uint(f);
  u += 0x7fffu + ((u >> 16) & 1u);
  return (bf16)(u >> 16);
}
__device__ __forceinline__ unsigned pk2(float lo, float hi) { return (unsigned)f2bf(lo) | ((unsigned)f2bf(hi) << 16); }
__device__ __forceinline__ float bf2f(bf16 h) { return __uint_as_float(((unsigned)h) << 16); }
__device__ __forceinline__ float bflo(unsigned u) { return __uint_as_float(u << 16); }
__device__ __forceinline__ float bfhi(unsigned u) { return __uint_as_float(u & 0xffff0000u); }
__device__ __forceinline__ float wave_sum(float v) {
#pragma unroll
  for (int o = 32; o > 0; o >>= 1) v += __shfl_xor(v, o);
  return v;
}
__device__ __forceinline__ float wave_max(float v) {
#pragma unroll
  for (int o = 32; o > 0; o >>= 1) v = fmaxf(v, __shfl_xor(v, o));
  return v;
}
#ifndef PROBE_TS
#define PROBE_TS 0
#endif
#define OFF_PRM (800ull * 1024)
#define PRM_WGU   0
#define PRM_BG    8192
#define PRM_GNG   8704
#define PRM_N2G   9728
#define PRM_FG    10752
#define PRM_TOTAL 11776
#define OFF_TS (208ull * 1024)
#if PROBE_TS
#define TS_SET(p, k) do { if (tid_fresh() == 0) ((unsigned long long*)((p).ws + OFF_TS))[k] = __builtin_amdgcn_s_memrealtime(); } while (0)
#define TS_ADD(p, k, t0) do { if (tid_fresh() == 0) ((unsigned long long*)((p).ws + OFF_TS))[k] += __builtin_amdgcn_s_memrealtime() - (t0); } while (0)
#define TS_NOW() __builtin_amdgcn_s_memrealtime()
#else
#define TS_SET(p, k) do {} while (0)
#define TS_ADD(p, k, t0) do {} while (0)
#define TS_NOW() 0ull
#endif
__device__ __forceinline__ int tid_fresh() { int t = threadIdx.x; asm volatile("" : "+v"(t)); return t; }
__device__ __forceinline__ float sigmoidf_(float v) { return 1.f / (1.f + __expf(-v)); }
__device__ __forceinline__ float siluf_(float v) { return v / (1.f + __expf(-v)); }

#include <hip/hip_runtime.h>
namespace pg8 {
#define PG8_LAS __attribute__((address_space(3)))
typedef unsigned short bf16_t;
typedef short bf16x8 __attribute__((ext_vector_type(8)));
typedef float f32x4 __attribute__((ext_vector_type(4)));
typedef unsigned u32x4 __attribute__((ext_vector_type(4)));
constexpr int BM = 256, BK = 64, HALF = 128, HTB = HALF * BK * 2  , STAGE_BYTES = 8 * HTB, NXCD = 8, WGM = 8;

__host__ __device__ __forceinline__ int lds_byte(int r, int c) { const int st = (r >> 4) * 2 + (c >> 5), rr = r & 15, cc = c & 31, ob = rr * 64 + cc * 2; return st * 1024 + (ob ^ (((ob >> 9) & 1) << 5)); }
__host__ __device__ __forceinline__ void stage_rc(int b, int& R, int& C) { const int st = b / 1024, sb = b % 1024, swz = sb ^ (((sb >> 9) & 1) << 5); R = (st >> 1) * 16 + swz / 64; C = (st & 1) * 32 + (swz % 64) / 2; }
__host__ __device__ __forceinline__ int perm32(int rho) { const int n = rho >> 4, i = rho & 15; return 8 * (i >> 2) + 4 * n + (i & 3); }

struct Unit { int pm, pn; };
struct Gemm { const bf16_t* A; const bf16_t* Bt; int M, N, K; };

struct StaticOrder {
    int nM, nN, nwg, G, c;
    __host__ __device__ void init(int M, int N, int G_, int c_) { nM = M / BM; nN = N / BM; nwg = nM * nN; G = G_; c = c_; }
    __host__ __device__ bool next(int i, Unit& u) const {
        const long L = (long)i * G + c; if (L >= nwg) return false;
        int wgid = (int)L; { const int q = nwg / NXCD, r = nwg % NXCD, xcd = wgid % NXCD, off = wgid / NXCD; wgid = (xcd < r ? xcd * (q + 1) : r * (q + 1) + (xcd - r) * q) + off; }
        const int nig = WGM * nN, gid = wgid / nig, fm = gid * WGM, gsz = (nM - fm) < WGM ? (nM - fm) : WGM;
        u.pm = fm + ((wgid % nig) % gsz); u.pn = (wgid % nig) / gsz; return true;
    }
    __device__ __forceinline__ void a_ready(const Unit&) const {}
    __device__ __forceinline__ void done(const Unit&) const {}
};
__device__ __forceinline__ unsigned cvt_pk_bf16(float lo, float hi) { unsigned r; asm volatile("v_cvt_pk_bf16_f32 %0, %1, %2" : "=v"(r) : "v"(lo), "v"(hi)); return r; }

template <class Epi, class Sched, bool STAMP = false>
__device__ __forceinline__ void gemm_phase(PG8_LAS unsigned char* lds, const Gemm g, const Sched& S, const Epi& E, unsigned long long* stamps) {
    const int tid = ::tid_fresh(), wid = __builtin_amdgcn_readfirstlane(tid >> 6), lane = tid & 63, wr = wid >> 2, wc = wid & 3, fr = lane & 15, fq = lane >> 4;
    const int K = g.K, nt = K / BK;
    int ts_lo = 0, ts_hi = 0, nts = 0; const unsigned long long rt_entry = STAMP ? (unsigned long long)wall_clock64() : 0ull;
#define PG8_STAMP() do { if (STAMP && wid == 0 && nts < 64) { const unsigned long long _c = (unsigned long long)clock64(); \
        ts_lo = (lane == nts) ? (int)(unsigned)_c : ts_lo; ts_hi = (lane == nts) ? (int)(unsigned)(_c >> 32) : ts_hi; ++nts; } } while (0)
    PG8_STAMP();
    unsigned voffA[2], voffB[2];
#pragma unroll
    for (int i = 0; i < 2; ++i) { int R, C; stage_rc(tid * 16 + i * 8192, R, C); const int Rb = Epi::PERM ? ((R & ~31) + perm32(R & 31)) : R;
        voffA[i] = (unsigned)(R * K + C) * 2u; voffB[i] = (unsigned)(Rb * K + C) * 2u; }
    const size_t kstep = (size_t)(BK * 2);
    const size_t hstep = (size_t)HALF * K * 2;
    const size_t tstep = 2 * hstep;
    const unsigned ldsw = (unsigned)wid * 1024u;
    const int aoff = lds_byte(wr * 64 + fr, fq * 8), boff = lds_byte(wc * 32 + fr, fq * 8);
#define PG8_SA(b, h) (((b) * 2 + (h)) * HTB)
#define PG8_SB(b, h) ((4 + (b) * 2 + (h)) * HTB)
#define PG8_STAGE(bufoff, gbase, voff) do { _Pragma("unroll") for (int _i = 0; _i < 2; ++_i) \
        __builtin_amdgcn_global_load_lds((const unsigned*)((const char*)(gbase) + (voff)[_i]), (PG8_LAS unsigned*)(lds + (bufoff) + ldsw + _i * 8192), 16, 0, 0); } while (0)
#define PG8_LDA(dst, b, h) do { _Pragma("unroll") for (int m = 0; m < 4; ++m) _Pragma("unroll") for (int k = 0; k < 2; ++k) dst[m][k] = *(const PG8_LAS bf16x8*)(lds + PG8_SA(b, h) + aoff + m * 2048 + k * 1024); } while (0)
#define PG8_LDB(dst, b, h) do { _Pragma("unroll") for (int n = 0; n < 2; ++n) _Pragma("unroll") for (int k = 0; k < 2; ++k) dst[n][k] = *(const PG8_LAS bf16x8*)(lds + PG8_SB(b, h) + boff + n * 2048 + k * 1024); } while (0)
#define PG8_MMA(ai, bj, At, Bt) do { __builtin_amdgcn_s_setprio(1); _Pragma("unroll") for (int m = 0; m < 4; ++m) _Pragma("unroll") for (int n = 0; n < 2; ++n) _Pragma("unroll") for (int k = 0; k < 2; ++k) \
        acc[ai][bj][m][n] = __builtin_amdgcn_mfma_f32_16x16x32_bf16(Bt[n][k], At[m][k], acc[ai][bj][m][n], 0, 0, 0); __builtin_amdgcn_s_setprio(0); } while (0)
#define PG8_WAIT_V(n) asm volatile("s_waitcnt vmcnt(" #n ")" ::: "memory")
#define PG8_WAIT_L(n) asm volatile("s_waitcnt lgkmcnt(" #n ")" ::: "memory")
#define PG8_BAR __builtin_amdgcn_s_barrier()
#define PG8_SCHED __builtin_amdgcn_sched_barrier(0)
    Unit cur, nxt; int ui = 0;
    if (!S.next(0, cur)) return;
    f32x4 acc[2][2][4][2];
#pragma unroll
    for (int a = 0; a < 2; ++a)
#pragma unroll
        for (int b = 0; b < 2; ++b)
#pragma unroll
            for (int m = 0; m < 4; ++m)
#pragma unroll
                for (int n = 0; n < 2; ++n) acc[a][b][m][n] = (f32x4){0.f, 0.f, 0.f, 0.f};
    bf16x8 At[4][2], B0[2][2], B1[2][2];
    const char* cA = (const char*)g.A + (size_t)cur.pm * tstep; const char* cB = (const char*)g.Bt + (size_t)cur.pn * tstep;
    S.a_ready(cur);
    PG8_STAGE(PG8_SB(0, 0), cB, voffB); PG8_STAGE(PG8_SA(0, 0), cA, voffA); PG8_STAGE(PG8_SB(0, 1), cB + hstep, voffB); PG8_STAGE(PG8_SA(0, 1), cA + hstep, voffA);
    if (wr == 1) PG8_BAR;
    PG8_WAIT_V(4); PG8_BAR;
    PG8_STAGE(PG8_SB(1, 0), cB + kstep, voffB); PG8_STAGE(PG8_SA(1, 0), cA + kstep, voffA); PG8_STAGE(PG8_SB(1, 1), cB + hstep + kstep, voffB);
    PG8_WAIT_V(6); PG8_BAR;
    PG8_STAMP();
    for (;;) {
        const bool has_next = S.next(ui + 1, nxt);
        const char* nA = has_next ? (const char*)g.A + (size_t)nxt.pm * tstep : cA; const char* nB = has_next ? (const char*)g.Bt + (size_t)nxt.pn * tstep : cB;
        for (int t = 0; t < nt; t += 2) {
            const bool last = (t == nt - 2);
            const char* a1 = cA + (size_t)(t + 1) * kstep;
            const char* a2 = last ? nA : cA + (size_t)(t + 2) * kstep; const char* b2 = last ? nB : cB + (size_t)(t + 2) * kstep;
            const char* a3 = a2 + kstep; const char* b3 = b2 + kstep;
            if (last && has_next) S.a_ready(nxt);
            PG8_LDB(B0, 0, 0); PG8_SCHED; PG8_LDA(At, 0, 0); PG8_STAGE(PG8_SA(1, 1), a1 + hstep, voffA);
            PG8_WAIT_L(8); PG8_BAR; PG8_WAIT_L(0); PG8_MMA(0, 0, At, B0); PG8_BAR; PG8_SCHED;
            PG8_LDB(B1, 0, 1); PG8_STAGE(PG8_SB(0, 0), b2, voffB);
            PG8_BAR; PG8_WAIT_L(0); PG8_MMA(0, 1, At, B1); PG8_BAR;
            PG8_LDA(At, 0, 1); PG8_STAGE(PG8_SA(0, 0), a2, voffA);
            PG8_BAR; PG8_WAIT_L(0); PG8_MMA(1, 0, At, B0); PG8_BAR; PG8_SCHED;
            PG8_STAGE(PG8_SB(0, 1), b2 + hstep, voffB);
            PG8_WAIT_V(6); PG8_BAR; PG8_MMA(1, 1, At, B1); PG8_BAR;
            PG8_LDB(B0, 1, 0); PG8_SCHED; PG8_LDA(At, 1, 0); PG8_STAGE(PG8_SA(0, 1), a2 + hstep, voffA);
            PG8_WAIT_L(8); PG8_BAR; PG8_WAIT_L(0); PG8_MMA(0, 0, At, B0); PG8_BAR; PG8_SCHED;
            PG8_LDB(B1, 1, 1); PG8_STAGE(PG8_SB(1, 0), b3, voffB);
            PG8_BAR; PG8_WAIT_L(0); PG8_MMA(0, 1, At, B1); PG8_BAR;
            PG8_LDA(At, 1, 1); PG8_STAGE(PG8_SA(1, 0), a3, voffA);
            PG8_BAR; PG8_WAIT_L(0); PG8_MMA(1, 0, At, B0); PG8_BAR; PG8_SCHED;
            PG8_STAGE(PG8_SB(1, 1), b3 + hstep, voffB);
            PG8_WAIT_V(6); PG8_BAR; PG8_MMA(1, 1, At, B1); PG8_BAR;
        }
        PG8_STAMP();
        if constexpr (!Epi::AFTER_DRAIN) { E(acc, cur, wr, wc, fr, fq); S.done(cur); }
        PG8_STAMP();
        if (!has_next) break;
#pragma unroll
        for (int a = 0; a < 2; ++a)
#pragma unroll
            for (int b = 0; b < 2; ++b)
#pragma unroll
                for (int m = 0; m < 4; ++m)
#pragma unroll
                    for (int n = 0; n < 2; ++n) acc[a][b][m][n] = (f32x4){0.f, 0.f, 0.f, 0.f};
        cur = nxt; cA = nA; cB = nB; ++ui;
    }
    PG8_WAIT_V(0);
    if (wr == 0) PG8_BAR;
    PG8_BAR;
    if constexpr (Epi::AFTER_DRAIN) { E.fused(acc, cur, wr, wc, fr, fq, lds, wid, lane); S.done(cur); }
    PG8_STAMP();
    if (STAMP && wid == 0) { stamps[lane] = lane < nts ? (((unsigned long long)(unsigned)ts_hi << 32) | (unsigned)ts_lo) : 0ull;
        if (lane == 62) stamps[62] = rt_entry; if (lane == 63) stamps[63] = (unsigned long long)wall_clock64(); }
#undef PG8_STAMP
#undef PG8_SA
#undef PG8_SB
#undef PG8_STAGE
#undef PG8_LDA
#undef PG8_LDB
#undef PG8_MMA
#undef PG8_WAIT_V
#undef PG8_WAIT_L
#undef PG8_BAR
#undef PG8_SCHED
}
}
#define XB_TMO      128
#define XB_XCNT(j)  (256  + 64 * (j))
#define XB_XSUB(j)  (1280 + 64 * (j))
#define XB_XGEN(j)  (2304 + 64 * (j))
#define XB_TOP      3328
#define XB_TOPGEN   3392
#define XCD_BAR_WORDS 3456
#define XB_SPIN_CAP (1u << 18)

__device__ __forceinline__ unsigned xb_ld(unsigned* p)              { return __hip_atomic_load(p, __ATOMIC_RELAXED, __HIP_MEMORY_SCOPE_AGENT); }
__device__ __forceinline__ unsigned xb_add(unsigned* p, unsigned v) { return __hip_atomic_fetch_add(p, v, __ATOMIC_RELAXED, __HIP_MEMORY_SCOPE_AGENT); }
__device__ __forceinline__ unsigned xb_xcc_id() { return (unsigned)__builtin_amdgcn_s_getreg((3 << 11) | 20) & 0xFu; }
#define XB_SPIN(cond, bar) do { unsigned _sp = 0; while (cond) { __builtin_amdgcn_s_sleep(1); \
    if ((++_sp & 255u) == 0u) { if (xb_ld(&(bar)[XB_TMO])) break; if (_sp > XB_SPIN_CAP) { atomicAdd(&(bar)[XB_TMO], 1u); break; } } } } while (0)

struct XcdBarrier {
    unsigned* bar; unsigned x;
    volatile LAS unsigned* st;
};

__device__ __forceinline__ XcdBarrier xcd_barrier_post(unsigned* bar, volatile LAS unsigned* st) {
    XcdBarrier b; b.bar = bar; b.x = xb_xcc_id(); b.st = st;
    if (threadIdx.x == 0) (void)xb_add(&bar[XB_XCNT(b.x)], 1u);
    return b;
}
__device__ __forceinline__ void xcd_barrier_complete(unsigned* bar, unsigned x, unsigned& nloc, unsigned& nx) {
    const unsigned G = gridDim.x * gridDim.y * gridDim.z;
    unsigned sum, cnt, mine, sp = 0u;
    for (;;) {
        sum = 0u; cnt = 0u; mine = 0u;
#pragma unroll
        for (unsigned j = 0; j < 16; ++j) { const unsigned c = xb_ld(&bar[XB_XCNT(j)]); sum += c; cnt += (c > 0u) ? 1u : 0u; mine = (j == x) ? c : mine; }
        if (sum == G) break;
        __builtin_amdgcn_s_sleep(1);
        if ((++sp & 255u) == 0u) { if (xb_ld(&bar[XB_TMO])) break; if (sp > XB_SPIN_CAP) { atomicAdd(&bar[XB_TMO], 1u); break; } }
    }
    nloc = mine > 0u ? mine : 1u; nx = cnt > 0u ? cnt : 1u;
}

__device__ __forceinline__ void xcd_barrier(const XcdBarrier& b) {
    asm volatile("s_waitcnt vmcnt(0)" ::: "memory");
    __syncthreads();
    if (threadIdx.x == 0) {
        unsigned* bar = b.bar;
        __builtin_amdgcn_s_waitcnt(0);
        unsigned nloc = b.st[0], nx = b.st[1];
        if (nloc == 0u) { xcd_barrier_complete(bar, b.x, nloc, nx); b.st[0] = nloc; b.st[1] = nx; }
        const unsigned old = xb_add(&bar[XB_XSUB(b.x)], 1u);
        const unsigned gen = old / nloc;
        if (old + 1u == (gen + 1u) * nloc) {
            __builtin_amdgcn_fence(__ATOMIC_RELEASE, "agent");
            asm volatile("s_waitcnt vmcnt(0)" ::: "memory");
            const unsigned og = xb_add(&bar[XB_TOP], 1u);
            const unsigned tg = og / nx;
            if (og + 1u == (tg + 1u) * nx) xb_add(&bar[XB_TOPGEN], 1u);
            else XB_SPIN(xb_ld(&bar[XB_TOPGEN]) == tg, bar);
            __builtin_amdgcn_fence(__ATOMIC_ACQUIRE, "agent");
            xb_add(&bar[XB_XGEN(b.x)], 1u);
            asm volatile("s_waitcnt vmcnt(0)" ::: "memory");
        } else {
            XB_SPIN(xb_ld(&bar[XB_XGEN(b.x)]) == gen, bar);
            __builtin_amdgcn_fence(__ATOMIC_ACQUIRE, "agent");
            asm volatile("s_waitcnt vmcnt(0)" ::: "memory");
        }
    }
    __syncthreads();
}

__device__ __forceinline__ void ph_mod(const P& p, const float* X, const float* g, int shift_off, int scale_off, bf16* H, int bid, int nb) {
  const float* ada = (const float*)(p.ws + OFF_ADA);
  const int tidm = tid_fresh(); int wave = tidm >> 6, lane = tidm & 63;
  const int rstride = nb * (int)(blockDim.x >> 6);
  int row = bid * (int)(blockDim.x >> 6) + wave;
  float4 v[4];
  if (row < TT) {
    const float4* xr = (const float4*)(X + (size_t)row * DM);
#pragma unroll
    for (int i = 0; i < 4; ++i) v[i] = xr[lane + i * 64];
  }
  for (; row < TT; row += rstride) {
    float4 vn[4];
    const int nrow = row + rstride;
    {
      const float4* xn = (const float4*)(X + (size_t)((nrow < TT) ? nrow : row) * DM);
#pragma unroll
      for (int i = 0; i < 4; ++i) vn[i] = xn[lane + i * 64];
    }
    float ss = 0.f;
#pragma unroll
    for (int i = 0; i < 4; ++i) ss += v[i].x * v[i].x + v[i].y * v[i].y + v[i].z * v[i].z + v[i].w * v[i].w;
    ss = wave_sum(ss);
    float rstd = rsqrtf(ss * (1.f / DM) + 1e-6f);
    int b = row >> 12;
    const float* sh = ada + b * 6144 + shift_off;
    const float* sc = ada + b * 6144 + scale_off;
#pragma unroll
    for (int i = 0; i < 4; ++i) {
      int c0 = (lane + i * 64) * 4;
      float4 gg = *(const float4*)(g + c0);
      float4 s4 = *(const float4*)(sc + c0);
      float4 h4 = *(const float4*)(sh + c0);
      ushort4 o;
      o.x = f2bf(v[i].x * rstd * gg.x * (1.f + s4.x) + h4.x);
      o.y = f2bf(v[i].y * rstd * gg.y * (1.f + s4.y) + h4.y);
      o.z = f2bf(v[i].z * rstd * gg.z * (1.f + s4.z) + h4.z);
      o.w = f2bf(v[i].w * rstd * gg.w * (1.f + s4.w) + h4.w);
      *(ushort4*)(H + (size_t)row * DM + c0) = o;
    }
#pragma unroll
    for (int i = 0; i < 4; ++i) v[i] = vn[i];
  }
}

using pg8::f32x4;
using pg8::u32x4;
using pg8::Unit;
using pg8::cvt_pk_bf16;
typedef short s16x4_t __attribute__((ext_vector_type(4)));
typedef unsigned u32x4_t __attribute__((ext_vector_type(4)));
typedef unsigned short u16x4_t __attribute__((ext_vector_type(4)));

__device__ __forceinline__ int in_srcmap(int d) {
  if (d < 2048) return d;
  if (d < 3072) return 3088 + (d - 2048);
  if (d < 3328) return 4112 + (d - 3072);
  if (d < 3840) return 4368 + (d - 3328);
  if (d < 3904) return 4880 + (d - 3840);
  if (d < 3912) return 4944 + (d - 3904);
  if (d < 3928) return 3072 + (d - 3912);
  if (d < 4096) return -1;
  if (d < 5120) return 2048 + (d - 4096);
  return 4952 + (d - 5120);
}
template <bool MAP>
__device__ __forceinline__ void transpose_item(const float* W, int ldw, int K, bf16* WT, int item, int nblk, float* scr, int lane) {
  const int kb = item / nblk, nbk = item % nblk, k0 = 64 * kb, n0 = 32 * nbk;
  const int d = n0 + (lane & 31);
  const int src = MAP ? in_srcmap(d) : d;
#pragma unroll 8
  for (int i = 0; i < 32; ++i) {
    const int kk = 2 * i + (lane >> 5);
    scr[kk * 33 + (lane & 31)] = (src >= 0) ? W[(size_t)(k0 + kk) * ldw + src] : 0.f;
  }
  asm volatile("s_waitcnt lgkmcnt(0)" ::: "memory");
  const int c = lane & 7;
#pragma unroll
  for (int j = 0; j < 4; ++j) {
    const int n = (lane >> 3) + 8 * j;
    const float* s = scr + (8 * c) * 33 + n;
    uint4 o;
    o.x = pk2(s[0 * 33], s[1 * 33]); o.y = pk2(s[2 * 33], s[3 * 33]); o.z = pk2(s[4 * 33], s[5 * 33]); o.w = pk2(s[6 * 33], s[7 * 33]);
    *(uint4*)(WT + (size_t)(n0 + n) * K + k0 + 8 * c) = o;
  }
  asm volatile("s_waitcnt lgkmcnt(0)" ::: "memory");
}

__device__ __forceinline__ void ph_prep(const P& p, float* sm) {
  const int tid = tid_fresh(), wave = tid >> 6, lane = tid & 63;
  const int bid = blockIdx.x, nb = gridDim.x;
  float* silc = sm + 8 * 2112 + 64;
  float* red = silc + 8192;
  float* ada = (float*)(p.ws + OFF_ADA);
  if (bid < 192) {
    for (int i = tid; i < 8192; i += 512) silc[i] = siluf_(p.c[i]);
    __syncthreads();
    for (int it = bid; it < 192; it += nb) {
      const int kg = tid >> 5, cn = tid & 31, n = it * 32 + cn;
      float acc[8];
#pragma unroll
      for (int b = 0; b < 8; ++b) acc[b] = 0.f;
      for (int k = kg * 64; k < kg * 64 + 64; ++k) {
        const float w = p.w_ada[(size_t)k * 6144 + n];
#pragma unroll
        for (int b = 0; b < 8; ++b) acc[b] += silc[b * 1024 + k] * w;
      }
#pragma unroll
      for (int b = 0; b < 8; ++b) red[(kg * 8 + b) * 32 + cn] = acc[b];
      __syncthreads();
      if (tid < 256) {
        const int b = tid >> 5, c2 = tid & 31;
        float s = 0.f;
#pragma unroll
        for (int g = 0; g < 16; ++g) s += red[(g * 8 + b) * 32 + c2];
        ada[b * 6144 + it * 32 + c2] = s + p.b_ada[it * 32 + c2];
      }
      __syncthreads();
    }
  }
  {
    unsigned char* PU8 = (unsigned char*)(p.ws + OFF_PU);
    unsigned char* PV8 = (unsigned char*)(p.ws + OFF_PV);
    float* PSC = (float*)(p.ws + OFF_PSC);
    for (int row = bid * 8 + wave; row < 2 * 16384; row += nb * 8) {
      const float* src = (row < 16384 ? p.peer_u : p.peer_v) + (size_t)(row & 16383) * 1024 + lane * 16;
      f32x4 v[4];
      float mx = 0.f;
#pragma unroll
      for (int q = 0; q < 4; ++q) {
        v[q] = *(const f32x4*)(src + q * 4);
        mx = fmaxf(mx, fmaxf(fmaxf(fabsf(v[q][0]), fabsf(v[q][1])), fmaxf(fabsf(v[q][2]), fabsf(v[q][3]))));
      }
      mx = wave_max(mx);
      const float sc = (mx > 0.f) ? exp2f(floorf(log2f(448.f / mx))) : 1.f;
      u32x4 o;
#pragma unroll
      for (int q = 0; q < 4; ++q) {
        int w = __builtin_amdgcn_cvt_pk_fp8_f32(v[q][0] * sc, v[q][1] * sc, 0, false);
        w = __builtin_amdgcn_cvt_pk_fp8_f32(v[q][2] * sc, v[q][3] * sc, w, true);
        o[q] = (unsigned)w;
      }
      *(u32x4*)((row < 16384 ? PU8 : PV8) + (size_t)(row & 16383) * 1024 + lane * 16) = o;
      if (lane == 0) PSC[row] = 1.f / sc;
    }
    for (int i = bid * 512 + tid; i < 2 * 2048; i += nb * 512) {
      const float* src = (i < 2048) ? p.sk1 : p.sk2;
      const int j = i & 2047;
      const float4 v0 = *(const float4*)(src + j * 8), v1 = *(const float4*)(src + j * 8 + 4);
      uint4 o; o.x = pk2(v0.x, v0.y); o.y = pk2(v0.z, v0.w); o.z = pk2(v1.x, v1.y); o.w = pk2(v1.z, v1.w);
      *(uint4*)((bf16*)(p.ws + OFF_SK) + (size_t)i * 8) = o;
    }
  }
  {
    float* prm = (float*)(p.ws + OFF_PRM);
    for (int i = bid * 512 + tid; i < PRM_TOTAL; i += nb * 512) {
      float v;
      if (i < PRM_BG) v = p.w_gate_up[i];
      else if (i < PRM_GNG) v = p.b_gate[i - PRM_BG];
      else if (i < PRM_N2G) v = p.gla_norm_g[i - PRM_GNG];
      else if (i < PRM_FG) v = p.norm2_g[i - PRM_N2G];
      else v = p.final_g[i - PRM_FG];
      prm[i] = v;
    }
  }
  {
    bf16* WUK = (bf16*)(p.ws + OFF_WUK);
    bf16* WUV = (bf16*)(p.ws + OFF_WUV);
    for (int i = bid * 512 + tid; i < 2 * 262144; i += nb * 512) {
      if (i < 262144) {
        const int d = i & 127, cc = (i >> 7) & 255, h = i >> 15;
        WUK[i] = f2bf(p.w_uk[((size_t)h * 128 + d) * 256 + cc] * p.kv_norm_g[cc] * 0.08838834764831845f);
      } else {
        const int k = i - 262144;
        const int cc = k & 255, d = (k >> 8) & 127, h = k >> 15;
        WUV[k] = f2bf(p.w_uv[((size_t)h * 256 + cc) * 128 + d] * p.kv_norm_g[cc]);
      }
    }
  }
  float* scr = sm + wave * 2112;
  const int gw = bid * 8 + wave, ngw = nb * 8;
  constexpr int I_IN = 16 * 224, I_SQ = 16 * 32, I_Q = 16 * 64;
  for (int it = gw; it < I_IN + 3 * I_SQ + I_Q; it += ngw) {
    int r = it;
    if (r < I_IN) { transpose_item<true>(p.w_in, NIN, 1024, (bf16*)(p.ws + OFF_WT_IN), r, 224, scr, lane); continue; }
    r -= I_IN;
    if (r < I_SQ) { transpose_item<false>(p.w_a, 1024, 1024, (bf16*)(p.ws + OFF_WT_A), r, 32, scr, lane); continue; }
    r -= I_SQ;
    if (r < I_SQ) { transpose_item<false>(p.w_b, 1024, 1024, (bf16*)(p.ws + OFF_WT_B), r, 32, scr, lane); continue; }
    r -= I_SQ;
    if (r < I_SQ) { transpose_item<false>(p.w_out, 1024, 1024, (bf16*)(p.ws + OFF_WT_OUT), r, 32, scr, lane); continue; }
    r -= I_SQ;
    transpose_item<false>(p.w_q, 2048, 1024, (bf16*)(p.ws + OFF_WT_Q), r, 64, scr, lane);
  }
}


struct EpiIn {
  static constexpr bool PERM = true, AFTER_DRAIN = false;
  char* ws; float* out;
  __device__ __forceinline__ void operator()(const f32x4 (&acc)[2][2][4][2], const Unit& u, int wr, int wc, int fr, int fq) const {
    const int pn = u.pn;
    const int row0 = u.pm * 256 + wr * 64 + fr, cl0 = wc * 32 + 8 * fq;
    if (pn == 12) {
      bf16* dst = (bf16*)(ws + OFF_CKV);
      float* ssp = (float*)(ws + OFF_SSP);
#pragma unroll
      for (int ai = 0; ai < 2; ++ai)
#pragma unroll
        for (int m = 0; m < 4; ++m) {
          const size_t row = row0 + ai * 128 + m * 16;
          float ss = 0.f;
#pragma unroll
          for (int bj = 0; bj < 2; ++bj) {
            const f32x4 v0 = acc[ai][bj][m][0], v1 = acc[ai][bj][m][1];
            ss += (v0[0] * v0[0] + v0[1] * v0[1]) + (v0[2] * v0[2] + v0[3] * v0[3]) + (v1[0] * v1[0] + v1[1] * v1[1]) + (v1[2] * v1[2] + v1[3] * v1[3]);
            u32x4 w; w.x = cvt_pk_bf16(v0[0], v0[1]); w.y = cvt_pk_bf16(v0[2], v0[3]); w.z = cvt_pk_bf16(v1[0], v1[1]); w.w = cvt_pk_bf16(v1[2], v1[3]);
            *(u32x4*)(dst + row * 256 + cl0 + bj * 128) = w;
          }
          ss += __shfl_xor(ss, 16); ss += __shfl_xor(ss, 32);
          if (fq == 0) ssp[row * 4 + wc] = ss;
        }
    } else if (pn == 15) {
      bf16* IK = (bf16*)(ws + OFF_IK);
      float* IW = (float*)(ws + OFF_IW);
      float* GLOW = (float*)(ws + OFF_GLOW);
#pragma unroll
      for (int ai = 0; ai < 2; ++ai)
#pragma unroll
        for (int m = 0; m < 4; ++m) {
          const size_t row = row0 + ai * 128 + m * 16;
          const int cl = cl0;
          const f32x4 v0 = acc[ai][0][m][0], v1 = acc[ai][0][m][1];
          if (cl < 64) {
            u32x4 w; w.x = cvt_pk_bf16(v0[0], v0[1]); w.y = cvt_pk_bf16(v0[2], v0[3]); w.z = cvt_pk_bf16(v1[0], v1[1]); w.w = cvt_pk_bf16(v1[2], v1[3]);
            *(u32x4*)(IK + row * 64 + cl) = w;
          } else if (cl < 72) {
            *(f32x4*)(IW + row * 8) = v0 * 0.35355339059327373f;
            *(f32x4*)(IW + row * 8 + 4) = v1 * 0.35355339059327373f;
          } else if (cl < 88) {
            *(f32x4*)(GLOW + row * 16 + (cl - 72)) = v0;
            *(f32x4*)(GLOW + row * 16 + (cl - 72) + 4) = v1;
          }
        }
    } else {
      bf16* dst; int ld; float scale = 1.f; int act = 0; int coff;
      if (pn < 2) { dst = (bf16*)(ws + OFF_Q); ld = 512; coff = pn * 256; scale = 0.08838834764831845f; }
      else if (pn < 4) { dst = (bf16*)(ws + OFF_K); ld = 512; coff = (pn - 2) * 256; }
      else if (pn < 8) { dst = (bf16*)(ws + OFF_V); ld = 1024; coff = (pn - 4) * 256; }
      else if (pn < 12) { dst = (bf16*)(ws + OFF_DQ); ld = 1024; coff = (pn - 8) * 256; }
      else if (pn < 15) { dst = (bf16*)(ws + OFF_IQ); ld = 512; coff = (pn - 13) * 256; scale = 0.125f; }
      else if (pn < 20) { dst = (bf16*)(ws + OFF_SGR); ld = 1024; coff = (pn - 16) * 256; act = 1; }
      else if (pn < 24) { dst = (bf16*)out; ld = 1024; coff = (pn - 20) * 256; act = 2; }
      else { dst = (bf16*)out + (size_t)TT * 1024; ld = 1024; coff = (pn - 24) * 256; act = 2; }
#pragma unroll
      for (int ai = 0; ai < 2; ++ai)
#pragma unroll
        for (int m = 0; m < 4; ++m) {
          bf16* rowp = dst + (size_t)(row0 + ai * 128 + m * 16) * ld + coff + cl0;
#pragma unroll
          for (int bj = 0; bj < 2; ++bj) {
            f32x4 v0 = acc[ai][bj][m][0] * scale, v1 = acc[ai][bj][m][1] * scale;
            if (act == 1) {
#pragma unroll
              for (int j = 0; j < 4; ++j) { v0[j] = siluf_(v0[j]); v1[j] = siluf_(v1[j]); }
            } else if (act == 2) {
#pragma unroll
              for (int j = 0; j < 4; ++j) { v0[j] = sigmoidf_(v0[j]); v1[j] = sigmoidf_(v1[j]); }
            }
            u32x4 w; w.x = cvt_pk_bf16(v0[0], v0[1]); w.y = cvt_pk_bf16(v0[2], v0[3]); w.z = cvt_pk_bf16(v1[0], v1[1]); w.w = cvt_pk_bf16(v1[2], v1[3]);
            *(u32x4*)(rowp + bj * 128) = w;
          }
        }
    }
  }
};

template <bool ADD> struct EpiMix {
  static constexpr bool PERM = true, AFTER_DRAIN = false;
  const bf16* SZ; bf16* MIX;
  __device__ __forceinline__ void operator()(const f32x4 (&acc)[2][2][4][2], const Unit& u, int wr, int wc, int fr, int fq) const {
    const int row0 = u.pm * 256 + wr * 64 + fr, col0 = u.pn * 256 + wc * 32 + 8 * fq;
    u32x4 sc[2], oc[2], sn[2], on[2];
    {
      const size_t idx = (size_t)row0 * 1024 + col0;
      sc[0] = *(const u32x4*)(SZ + idx); sc[1] = *(const u32x4*)(SZ + idx + 128);
      if (ADD) { oc[0] = *(const u32x4*)(MIX + idx); oc[1] = *(const u32x4*)(MIX + idx + 128); }
    }
#pragma unroll
    for (int s = 0; s < 8; ++s) {
      const int ai = s >> 2, m = s & 3;
      const size_t idx = (size_t)(row0 + ai * 128 + m * 16) * 1024 + col0;
      if (s < 7) {
        const int ai2 = (s + 1) >> 2, m2 = (s + 1) & 3;
        const size_t idn = (size_t)(row0 + ai2 * 128 + m2 * 16) * 1024 + col0;
        sn[0] = *(const u32x4*)(SZ + idn); sn[1] = *(const u32x4*)(SZ + idn + 128);
        if (ADD) { on[0] = *(const u32x4*)(MIX + idn); on[1] = *(const u32x4*)(MIX + idn + 128); }
      }
#pragma unroll
      for (int bj = 0; bj < 2; ++bj) {
        const u32x4 sv = sc[bj];
        f32x4 v0 = acc[ai][bj][m][0], v1 = acc[ai][bj][m][1];
        v0[0] *= bflo(sv.x); v0[1] *= bfhi(sv.x); v0[2] *= bflo(sv.y); v0[3] *= bfhi(sv.y);
        v1[0] *= bflo(sv.z); v1[1] *= bfhi(sv.z); v1[2] *= bflo(sv.w); v1[3] *= bfhi(sv.w);
        if (ADD) {
          const u32x4 o = oc[bj];
          v0[0] += bflo(o.x); v0[1] += bfhi(o.x); v0[2] += bflo(o.y); v0[3] += bfhi(o.y);
          v1[0] += bflo(o.z); v1[1] += bfhi(o.z); v1[2] += bflo(o.w); v1[3] += bfhi(o.w);
        }
        u32x4 w; w.x = cvt_pk_bf16(v0[0], v0[1]); w.y = cvt_pk_bf16(v0[2], v0[3]); w.z = cvt_pk_bf16(v1[0], v1[1]); w.w = cvt_pk_bf16(v1[2], v1[3]);
        *(u32x4*)(MIX + idx + bj * 128) = w;
      }
      if (s < 7) { sc[0] = sn[0]; sc[1] = sn[1]; if (ADD) { oc[0] = on[0]; oc[1] = on[1]; } }
    }
  }
};

struct EpiX1 {
  static constexpr bool PERM = true, AFTER_DRAIN = false;
  const float* x; const float* ada; float* out;
  __device__ __forceinline__ void operator()(const f32x4 (&acc)[2][2][4][2], const Unit& u, int wr, int wc, int fr, int fq) const {
    const int row0 = u.pm * 256 + wr * 64 + fr, col0 = u.pn * 256 + wc * 32 + 8 * fq;
    const int b = (u.pm * 256) >> 12;
    f32x4 g[2][2];
#pragma unroll
    for (int bj = 0; bj < 2; ++bj) {
      g[bj][0] = *(const f32x4*)(ada + b * 6144 + 2048 + col0 + bj * 128);
      g[bj][1] = *(const f32x4*)(ada + b * 6144 + 2048 + col0 + bj * 128 + 4);
    }
    f32x4 xc[4], xn[4];
    {
      const size_t idx = (size_t)row0 * 1024 + col0;
      xc[0] = *(const f32x4*)(x + idx); xc[1] = *(const f32x4*)(x + idx + 4);
      xc[2] = *(const f32x4*)(x + idx + 128); xc[3] = *(const f32x4*)(x + idx + 132);
    }
#pragma unroll
    for (int s = 0; s < 8; ++s) {
      const int ai = s >> 2, m = s & 3;
      const size_t idx = (size_t)(row0 + ai * 128 + m * 16) * 1024 + col0;
      if (s < 7) {
        const int ai2 = (s + 1) >> 2, m2 = (s + 1) & 3;
        const size_t idn = (size_t)(row0 + ai2 * 128 + m2 * 16) * 1024 + col0;
        xn[0] = *(const f32x4*)(x + idn); xn[1] = *(const f32x4*)(x + idn + 4);
        xn[2] = *(const f32x4*)(x + idn + 128); xn[3] = *(const f32x4*)(x + idn + 132);
      }
#pragma unroll
      for (int bj = 0; bj < 2; ++bj) {
        *(f32x4*)(out + idx + bj * 128) = xc[2 * bj] + g[bj][0] * acc[ai][bj][m][0];
        *(f32x4*)(out + idx + bj * 128 + 4) = xc[2 * bj + 1] + g[bj][1] * acc[ai][bj][m][1];
      }
      if (s < 7) { xc[0] = xn[0]; xc[1] = xn[1]; xc[2] = xn[2]; xc[3] = xn[3]; }
    }
  }
};

struct EpiPlain {
  static constexpr bool PERM = true, AFTER_DRAIN = false;
  bf16* O; int ld;
  __device__ __forceinline__ void operator()(const f32x4 (&acc)[2][2][4][2], const Unit& u, int wr, int wc, int fr, int fq) const {
    const int row0 = u.pm * 256 + wr * 64 + fr, col0 = u.pn * 256 + wc * 32 + 8 * fq;
#pragma unroll
    for (int ai = 0; ai < 2; ++ai)
#pragma unroll
      for (int m = 0; m < 4; ++m)
#pragma unroll
        for (int bj = 0; bj < 2; ++bj) {
          const f32x4 v0 = acc[ai][bj][m][0], v1 = acc[ai][bj][m][1];
          u32x4 w; w.x = cvt_pk_bf16(v0[0], v0[1]); w.y = cvt_pk_bf16(v0[2], v0[3]); w.z = cvt_pk_bf16(v1[0], v1[1]); w.w = cvt_pk_bf16(v1[2], v1[3]);
          *(u32x4*)(O + (size_t)(row0 + ai * 128 + m * 16) * ld + col0 + bj * 128) = w;
        }
  }
};

template <class Epi>
__device__ __forceinline__ void gemm_run(LAS unsigned char* lds, const bf16* A, const bf16* Bt, int M, int N, int K, const Epi& E) {
  pg8::Gemm g{A, Bt, M, N, K};
  pg8::StaticOrder S;
  S.init(M, N, gridDim.x, blockIdx.x);
  pg8::gemm_phase<Epi, pg8::StaticOrder, false>(lds, g, S, E, nullptr);
}

typedef short bf16x8_t __attribute__((ext_vector_type(8)));
typedef __bf16 bf16x2_t __attribute__((ext_vector_type(2)));
__device__ __forceinline__ float dot2bf(unsigned a, unsigned b, float acc) {
  return __builtin_amdgcn_fdot2_f32_bf16(__builtin_bit_cast(bf16x2_t, a), __builtin_bit_cast(bf16x2_t, b), acc, false);
}
__device__ __forceinline__ void wave_lds_fence() { asm volatile("s_waitcnt lgkmcnt(0)" ::: "memory"); }
template <int N> __device__ __forceinline__ float row_ror(float x) {
  return __int_as_float(__builtin_amdgcn_update_dpp(0, __float_as_int(x), 0x120 + N, 0xf, 0xf, false));
}
__device__ __forceinline__ float row16_max(float m) {
  m = fmaxf(m, row_ror<8>(m)); m = fmaxf(m, row_ror<4>(m)); m = fmaxf(m, row_ror<2>(m)); m = fmaxf(m, row_ror<1>(m));
  return m;
}
__device__ __forceinline__ float row16_sum(float m) {
  m += row_ror<8>(m); m += row_ror<4>(m); m += row_ror<2>(m); m += row_ror<1>(m);
  return m;
}
__device__ __forceinline__ float wave_sum_dpp(float s) {
  s = row16_sum(s);
  const int si = __float_as_int(s);
  return __int_as_float(__builtin_amdgcn_readlane(si, 0)) + __int_as_float(__builtin_amdgcn_readlane(si, 16)) +
         (__int_as_float(__builtin_amdgcn_readlane(si, 32)) + __int_as_float(__builtin_amdgcn_readlane(si, 48)));
}
__device__ __forceinline__ constexpr int cand_i(int L) {
  return L < 16 ? 0 : L < 24 ? 1 : L < 29 ? 2 : L < 33 ? 3 : L < 36 ? 4 : L < 38 ? 5 : L < 40 ? 6 : L < 42 ? 7 : (L - 42 + 8);
}
__device__ __forceinline__ constexpr int cand_j(int L) {
  return L < 16 ? L : L < 24 ? L - 16 : L < 29 ? L - 24 : L < 33 ? L - 29 : L < 36 ? L - 33 : L < 38 ? L - 36 : L < 40 ? L - 38 : L < 42 ? L - 40 : 0;
}
template <int K> struct CandRank {
  static __device__ __forceinline__ void run(int ki, unsigned key, int& rank) {
    const unsigned o = (unsigned)__builtin_amdgcn_readlane(ki, K);
    rank += (o > key) ? 1 : 0;
    CandRank<K + 1>::run(ki, key, rank);
  }
};
template <> struct CandRank<50> { static __device__ __forceinline__ void run(int, unsigned, int&) {} };
__device__ __forceinline__ unsigned peer_f2ord(float f) {
  if (f == 0.f) f = 0.f;
  const unsigned u = __float_as_uint(f);
  return (u & 0x80000000u) ? ~u : (u | 0x80000000u);
}
__device__ __forceinline__ float peer_ord2f(unsigned u) { return __uint_as_float((u & 0x80000000u) ? (u ^ 0x80000000u) : ~u); }
__device__ __forceinline__ unsigned umax3(unsigned a, unsigned b, unsigned c) { const unsigned t = a > b ? a : b; return t > c ? t : c; }
template <int N> __device__ __forceinline__ unsigned row_ror_u(unsigned x) {
  return (unsigned)__builtin_amdgcn_update_dpp(0, (int)x, 0x120 + N, 0xf, 0xf, false);
}
__device__ __forceinline__ unsigned row16_umax(unsigned m) {
  unsigned t;
  t = row_ror_u<8>(m); m = t > m ? t : m; t = row_ror_u<4>(m); m = t > m ? t : m;
  t = row_ror_u<2>(m); m = t > m ? t : m; t = row_ror_u<1>(m); m = t > m ? t : m;
  return m;
}
__device__ __forceinline__ float gelu_exact(float v) { return 0.5f * v * (1.f + erff(v * 0.7071067811865476f)); }

typedef float f32x2_t __attribute__((ext_vector_type(2)));
typedef unsigned peer_u32x2 __attribute__((ext_vector_type(2)));
__device__ __forceinline__ float peer_fold32(float a, float b) {
  const peer_u32x2 r = __builtin_amdgcn_permlane32_swap(__float_as_uint(a), __float_as_uint(b), false, false);
  return __uint_as_float(r.x) + __uint_as_float(r.y);
}
__device__ __forceinline__ float peer_fold16(float a, float b) {
  const peer_u32x2 r = __builtin_amdgcn_permlane16_swap(__float_as_uint(a), __float_as_uint(b), false, false);
  return __uint_as_float(r.x) + __uint_as_float(r.y);
}
#define PEER_NB 6
#define PEER_LOAD(buf, TAB, e0)                                                                   \
  _Pragma("unroll") for (int j = 0; j < PEER_NB; ++j) {                                                 \
    const int e = ((e0) + j < 128) ? __builtin_amdgcn_readfirstlane((int)ridx[tt * 128 + (e0) + j]) : 0;   \
    buf[j] = *(const u32x4_t*)((TAB) + (size_t)e * 1024 + lane * 16);                             \
  }
#define PEER_UDOT(buf, e0)                                                                        \
  {                                                                                               \
    float sp[6];                                                                                  \
    _Pragma("unroll") for (int j = 0; j < 6; ++j) {                                               \
      float s0 = 0.f, s1 = 0.f;                                                                   \
      _Pragma("unroll") for (int w = 0; w < 4; ++w) {                                             \
        const f32x2_t lo = __builtin_amdgcn_cvt_pk_f32_fp8((int)buf[j][w], false);                \
        const f32x2_t hi = __builtin_amdgcn_cvt_pk_f32_fp8((int)buf[j][w], true);                 \
        s0 = __builtin_fmaf(lo.x, hf[4 * w], s0); s1 = __builtin_fmaf(lo.y, hf[4 * w + 1], s1);   \
        s0 = __builtin_fmaf(hi.x, hf[4 * w + 2], s0); s1 = __builtin_fmaf(hi.y, hf[4 * w + 3], s1); \
      }                                                                                           \
      sp[j] = s0 + s1;                                                                            \
    }                                                                                             \
    const float u01 = peer_fold32(sp[0], sp[1]), u23 = peer_fold32(sp[2], sp[3]), u45 = peer_fold32(sp[4], sp[5]); \
    const float wq = row16_sum(peer_fold16(u01, u23));     \
    const float wr = row16_sum(peer_fold16(u45, u45));         \
    const int wqi = __float_as_int(wq), wri = __float_as_int(wr);                                 \
    PEER_PUT((e0) + 0, __builtin_amdgcn_readlane(wqi, 0));                                        \
    PEER_PUT((e0) + 1, __builtin_amdgcn_readlane(wqi, 32));                                       \
    PEER_PUT((e0) + 2, __builtin_amdgcn_readlane(wqi, 16));                                       \
    PEER_PUT((e0) + 3, __builtin_amdgcn_readlane(wqi, 48));                                       \
    PEER_PUT((e0) + 4, __builtin_amdgcn_readlane(wri, 0));                                        \
    PEER_PUT((e0) + 5, __builtin_amdgcn_readlane(wri, 32));                                       \
  }
#define PEER_PUT(ee_, vi_)                                                                        \
  {                                                                                               \
    const int ee = (ee_); const float sv = __int_as_float(vi_);                                   \
    const bool mine = (lane == (ee & 63));                                                        \
    dotA = (mine && ee < 64) ? sv : dotA;                                                         \
    dotB = (mine && ee >= 64 && ee < 128) ? sv : dotB;                                            \
  }
#define PEER_VACC(buf, e0)                                                                        \
  _Pragma("unroll") for (int j = 0; j < PEER_NB; ++j) {                                                 \
    const int ee = (e0) + j;                                                                      \
    const float a = (ee < 128) ? __int_as_float(__builtin_amdgcn_readlane(__float_as_int(ee < 64 ? aA : aB), ee & 63)) : 0.f; \
    _Pragma("unroll") for (int w = 0; w < 4; ++w) {                                               \
      const f32x2_t lo = __builtin_amdgcn_cvt_pk_f32_fp8((int)buf[j][w], false);                  \
      const f32x2_t hi = __builtin_amdgcn_cvt_pk_f32_fp8((int)buf[j][w], true);                   \
      acc[4 * w] += a * lo.x; acc[4 * w + 1] += a * lo.y; acc[4 * w + 2] += a * hi.x; acc[4 * w + 3] += a * hi.y; \
    }                                                                                             \
    __builtin_amdgcn_sched_barrier(0);                                                           \
  }

__device__ __forceinline__ void ph_peer512(const P& p, unsigned char* lds_raw, float* dst_base) {
  const int tid = tid_fresh(), wave = tid >> 6, lane = tid & 63, g = lane >> 4, c = lane & 15;
  const bf16* PQ = (const bf16*)(p.ws + OFF_PQ);
  const bf16* SK = (const bf16*)(p.ws + OFF_SK);
  float* tv = (float*)(lds_raw + wave * 16384);
  int* ti = (int*)(tv + 512);
  float* rgate = (float*)(ti + 512);
  unsigned short* ridx = (unsigned short*)(rgate + 2048);
  for (int tile = blockIdx.x * 8 + wave; tile < TT / 16; tile += gridDim.x * 8) {
    const int tok0 = tile * 16;
#pragma unroll 1
    for (int hd = 0; hd < 8; ++hd) {
#pragma unroll 1
      for (int hf = 0; hf < 2; ++hf) {
        f32x4 acc[8];
#pragma unroll
        for (int nt = 0; nt < 8; ++nt) acc[nt] = (f32x4){0.f, 0.f, 0.f, 0.f};
#pragma unroll
        for (int ks = 0; ks < 4; ++ks) {
          const bf16x8_t a = *(const bf16x8_t*)(PQ + (size_t)(tok0 + c) * 2048 + hd * 256 + hf * 128 + ks * 32 + 8 * g);
#pragma unroll
          for (int nt = 0; nt < 8; ++nt) {
            const bf16x8_t b = *(const bf16x8_t*)(SK + hf * 16384 + (nt * 16 + c) * 128 + ks * 32 + 8 * g);
            acc[nt] = __builtin_amdgcn_mfma_f32_16x16x32_bf16(a, b, acc[nt], 0, 0, 0);
          }
        }
        unsigned kq[4][8], res[4];
#pragma unroll
        for (int i = 0; i < 4; ++i) {
          res[i] = 0u;
#pragma unroll
          for (int nt = 0; nt < 8; ++nt) kq[i][nt] = (peer_f2ord(acc[nt][i]) & ~127u) | (unsigned)(127 - (16 * nt + c));
        }
#pragma unroll 1
        for (int r = 0; r < 16; ++r) {
#pragma unroll
          for (int i = 0; i < 4; ++i) {
            unsigned m = umax3(umax3(kq[i][0], kq[i][1], kq[i][2]), umax3(kq[i][3], kq[i][4], kq[i][5]), (kq[i][6] > kq[i][7]) ? kq[i][6] : kq[i][7]);
            m = row16_umax(m);
#pragma unroll
            for (int nt = 0; nt < 8; ++nt) kq[i][nt] = (kq[i][nt] == m) ? 0u : kq[i][nt];
            res[i] = (c == r) ? m : res[i];
          }
        }
#pragma unroll
        for (int i = 0; i < 4; ++i) {
          const int row = 4 * g + i;
          tv[(hf * 16 + row) * 16 + c] = peer_ord2f(res[i] & ~127u);
          ti[(hf * 16 + row) * 16 + c] = 127 - (int)(res[i] & 127u);
        }
      }
      wave_lds_fence();
      const int ci = cand_i(lane < 50 ? lane : 0), cj = cand_j(lane < 50 ? lane : 0);
#pragma unroll 1
      for (int row = 0; row < 16; ++row) {
        const float val = tv[row * 16 + ci] + tv[(16 + row) * 16 + cj];
        const unsigned key = (lane < 50) ? ((peer_f2ord(val) & ~63u) | (unsigned)(63 - lane)) : 0u;
        int rank = 0;
        CandRank<0>::run((int)key, key, rank);
        if (lane < 50 && rank < 16) {
          rgate[row * 128 + hd * 16 + rank] = val;
          ridx[row * 128 + hd * 16 + rank] = (unsigned short)(ti[row * 16 + ci] * 128 + ti[(16 + row) * 16 + cj]);
        }
      }
      wave_lds_fence();
      {
        const int row = lane >> 2, q = lane & 3;
        float* gp = rgate + row * 128 + hd * 16;
        const float mx = gp[0];
        const f32x4 b4 = *(const f32x4*)(gp + q * 4);
        f32x4 e4;
        e4[0] = __expf(b4[0] - mx); e4[1] = __expf(b4[1] - mx); e4[2] = __expf(b4[2] - mx); e4[3] = __expf(b4[3] - mx);
        float s = (e4[0] + e4[1]) + (e4[2] + e4[3]);
        s += __shfl_xor(s, 1); s += __shfl_xor(s, 2);
        const float inv = 1.f / s;
        wave_lds_fence();
        *(f32x4*)(gp + q * 4) = e4 * inv;
      }
      wave_lds_fence();
    }
    char* wsl = p.ws;
    asm volatile("" : "+s"(wsl));
    const bf16* H2 = (const bf16*)(wsl + OFF_H);
    const unsigned char* PU = (const unsigned char*)(wsl + OFF_PU);
    const unsigned char* PV = (const unsigned char*)(wsl + OFF_PV);
    const float* USC = (const float*)(wsl + OFF_PSC);
    const float* VSC = USC + 16384;
    const float* ada = (const float*)(wsl + OFF_ADA);
#pragma unroll 1
    for (int tt = 0; tt < 16; ++tt) {
      const int tidx = tid_fresh(), lane = tidx & 63, wv = __builtin_amdgcn_readfirstlane(tidx >> 6);
      const float* rgate = (const float*)(lds_raw + wv * 16384 + 4096);
      const unsigned short* ridx = (const unsigned short*)(lds_raw + wv * 16384 + 4096 + 8192);
      const size_t tok = (size_t)tok0 + tt;
      float hf[16];
      {
        const u32x4_t h0 = *(const u32x4_t*)(H2 + tok * 1024 + lane * 16), h1 = *(const u32x4_t*)(H2 + tok * 1024 + lane * 16 + 8);
#pragma unroll
        for (int w = 0; w < 4; ++w) { hf[2 * w] = bflo(h0[w]); hf[2 * w + 1] = bfhi(h0[w]); hf[8 + 2 * w] = bflo(h1[w]); hf[8 + 2 * w + 1] = bfhi(h1[w]); }
      }
      const int eA = (int)ridx[tt * 128 + lane], eB = (int)ridx[tt * 128 + 64 + lane];
      const float usA = USC[eA], usB = USC[eB];
      float dotA = 0.f, dotB = 0.f;
      u32x4_t a0[PEER_NB], a1[PEER_NB];
#define PSB() __builtin_amdgcn_sched_barrier(0)
#define PEER_ROWS (((128 + 2 * PEER_NB - 1) / (2 * PEER_NB)) * 2 * PEER_NB)
      PEER_LOAD(a0, PU, 0); PSB();
      PEER_LOAD(a1, PU, PEER_NB); PSB();
#pragma unroll 1
      for (int e0 = 0; e0 < PEER_ROWS; e0 += 2 * PEER_NB) {
        PEER_UDOT(a0, e0); PSB();
        if (e0 + 2 * PEER_NB < PEER_ROWS) { PEER_LOAD(a0, PU, e0 + 2 * PEER_NB); } else { PEER_LOAD(a0, PV, 0); }
        PSB();
        PEER_UDOT(a1, e0 + PEER_NB); PSB();
        if (e0 + 3 * PEER_NB < PEER_ROWS) { PEER_LOAD(a1, PU, e0 + 3 * PEER_NB); } else { PEER_LOAD(a1, PV, PEER_NB); }
        PSB();
      }
      const float aA = gelu_exact(dotA * usA) * rgate[tt * 128 + lane] * VSC[(int)ridx[tt * 128 + lane]],
                  aB = gelu_exact(dotB * usB) * rgate[tt * 128 + 64 + lane] * VSC[(int)ridx[tt * 128 + 64 + lane]];
      float acc[16];
#pragma unroll
      for (int k = 0; k < 16; ++k) acc[k] = 0.f;
      PSB();
#pragma unroll 1
      for (int e0 = 0; e0 < PEER_ROWS; e0 += 2 * PEER_NB) {
        PEER_VACC(a0, e0); PSB();
        if (e0 + 2 * PEER_NB < PEER_ROWS) { PEER_LOAD(a0, PV, e0 + 2 * PEER_NB); }
        PSB();
        PEER_VACC(a1, e0 + PEER_NB); PSB();
        if (e0 + 3 * PEER_NB < PEER_ROWS) { PEER_LOAD(a1, PV, e0 + 3 * PEER_NB); }
        PSB();
      }
#undef PSB
      const int b = (int)(tok >> 12);
      const float* xrow = p.out + tok * 1024;
      float* orow = dst_base + tok * 1024;
      const float* g2 = ada + b * 6144 + 5120;
      float x2[16];
      float ss = 0.f;
#pragma unroll
      for (int q = 0; q < 4; ++q) {
        const int col = lane * 16 + q * 4;
        const f32x4 xv = *(const f32x4*)(xrow + col), gv = *(const f32x4*)(g2 + col);
#pragma unroll
        for (int k = 0; k < 4; ++k) { const float t = xv[k] + gv[k] * acc[q * 4 + k]; x2[q * 4 + k] = t; ss += t * t; }
      }
      ss = wave_sum_dpp(ss);
      const float rstd = rsqrtf(ss * (1.f / 1024.f) + 1e-6f);
#pragma unroll
      for (int q = 0; q < 4; ++q) {
        const int col = lane * 16 + q * 4;
        const f32x4 fg = *(const f32x4*)((const float*)(wsl + OFF_PRM) + PRM_FG + col);
        f32x4 o;
#pragma unroll
        for (int k = 0; k < 4; ++k) o[k] = x2[q * 4 + k] * rstd * fg[k];
        *(f32x4*)(orow + col) = o;
      }
    }
    wave_lds_fence();
  }
}

#define DS_KEY16   0
#define DS_CHUNK   17408
#define DS_SEL     139264
#define DS_WAVE    147456
#define DS_TOTAL   155648
#define DS_RS      544

__device__ __forceinline__ unsigned f2ord(float f) {
  if (f == 0.f) f = 0.f;
  unsigned u = __float_as_uint(f);
  return (u & 0x80000000u) ? ~u : (u | 0x80000000u);
}
__device__ __forceinline__ int wave_scan_incl(int v, int lane) {
#pragma unroll
  for (int o = 1; o < 64; o <<= 1) { const int t = __shfl_up(v, o); v += (lane >= o) ? t : 0; }
  return v;
}
__device__ __forceinline__ void find_digit(const LAS unsigned* hist, int K, int lane, int& digit, int& above) {
  const u32x4_t h4 = *(const LAS u32x4_t*)(hist + 252 - 4 * lane);
  const int c0 = (int)h4.w, c1 = (int)h4.z, c2 = (int)h4.y, c3 = (int)h4.x;
  const int tot = c0 + c1 + c2 + c3;
  int run = wave_scan_incl(tot, lane) - tot;
  int found = -1, ab = 0;
  if (run < K && run + c0 >= K) { found = 255 - 4 * lane; ab = run; } run += c0;
  if (run < K && run + c1 >= K) { found = 254 - 4 * lane; ab = run; } run += c1;
  if (run < K && run + c2 >= K) { found = 253 - 4 * lane; ab = run; } run += c2;
  if (run < K && run + c3 >= K) { found = 252 - 4 * lane; ab = run; }
  const unsigned long long mk = __ballot(found >= 0);
  const int src = (int)__ffsll((unsigned long long)mk) - 1;
  digit = __builtin_amdgcn_readlane(found, src);
  above = __builtin_amdgcn_readlane(ab, src);
}

typedef unsigned u32x2_t __attribute__((ext_vector_type(2)));
__device__ __forceinline__ float xrow_max(float x) {
  u32x2_t r = __builtin_amdgcn_permlane16_swap(__float_as_uint(x), __float_as_uint(x), false, false);
  x = fmaxf(__uint_as_float(r.x), __uint_as_float(r.y));
  r = __builtin_amdgcn_permlane32_swap(__float_as_uint(x), __float_as_uint(x), false, false);
  return fmaxf(__uint_as_float(r.x), __uint_as_float(r.y));
}
__device__ __forceinline__ float xrow_sum(float x) {
  u32x2_t r = __builtin_amdgcn_permlane16_swap(__float_as_uint(x), __float_as_uint(x), false, false);
  x = __uint_as_float(r.x) + __uint_as_float(r.y);
  r = __builtin_amdgcn_permlane32_swap(__float_as_uint(x), __float_as_uint(x), false, false);
  return __uint_as_float(r.x) + __uint_as_float(r.y);
}
__device__ __forceinline__ s16x4_t tr_read_b64(unsigned addr) {
  s16x4_t r; asm volatile("ds_read_b64_tr_b16 %0, %1" : "=&v"(r) : "v"(addr) : "memory"); return r;
}

#ifndef PROBE_DSA
#define PROBE_DSA 0
#endif
#if PROBE_DSA
#define DSA_MARK(k) do { const unsigned long long n_ = __builtin_amdgcn_s_memrealtime(); if (PROBE_DSA == (k)) { const unsigned long long q_ = n_ - tmark; \
    while (__builtin_amdgcn_s_memrealtime() - n_ < q_) __builtin_amdgcn_s_sleep(2); } tmark = __builtin_amdgcn_s_memrealtime(); } while (0)
#else
#define DSA_MARK(k) do {} while (0)
#endif
#if PROBE_DSA >= 10
#define DSA_MARKI(k) DSA_MARK(k)
#else
#define DSA_MARKI(k) do {} while (0)
#endif
__device__ __forceinline__ void dsa_batch(const P& p, unsigned char* lds_raw, int b, int pos2) {
  const int t00 = pos2 * 32;
#define DSA_IDS const int tid = tid_fresh(), wave = __builtin_amdgcn_readfirstlane(tid >> 6), lane = tid & 63, g = lane >> 4, c = lane & 15; (void)wave; (void)g; (void)c;
  const size_t tokb = (size_t)b * SEQ, tok00 = tokb + t00;
  const bf16* DQ = (const bf16*)(p.ws + OFF_DQ);
  const bf16* CKV = (const bf16*)(p.ws + OFF_CKV);
  const float* SSP = (const float*)(p.ws + OFF_SSP);
  const bf16* IQ = (const bf16*)(p.ws + OFF_IQ);
  const bf16* IK = (const bf16*)(p.ws + OFF_IK);
  const float* IW = (const float*)(p.ws + OFF_IW);
  const bf16* WUK = (const bf16*)(p.ws + OFF_WUK);
  const bf16* WUV = (const bf16*)(p.ws + OFF_WUV);
  bf16* ODSA = (bf16*)(p.ws + OFF_ODSA);
  bf16* QL = (bf16*)(p.ws + OFF_DSCR + (size_t)blockIdx.x * 131072);
  bf16* OL = QL;
  LAS unsigned char* lds = (LAS unsigned char*)lds_raw;
  LAS unsigned short* key16 = (LAS unsigned short*)(lds + DS_KEY16);
  LAS unsigned short* sel = (LAS unsigned short*)(lds + DS_SEL);

#if PROBE_DSA
  unsigned long long tmark = __builtin_amdgcn_s_memrealtime();
#endif
  {
    DSA_IDS
    const int h = wave;
    bf16x8_t dq0[4], dq1[4];
#pragma unroll
    for (int ks = 0; ks < 4; ++ks) {
      dq0[ks] = *(const bf16x8_t*)(DQ + (tok00 + c) * 1024 + h * 128 + ks * 32 + 8 * g);
      dq1[ks] = *(const bf16x8_t*)(DQ + (tok00 + 16 + c) * 1024 + h * 128 + ks * 32 + 8 * g);
    }
#pragma unroll 1
    for (int hn = 0; hn < 2; ++hn) {
      f32x4 r0[8], r1[8];
#pragma unroll
      for (int n8 = 0; n8 < 8; ++n8) {
        const int nt = hn * 8 + n8;
        f32x4 a0 = (f32x4){0.f, 0.f, 0.f, 0.f}, a1 = a0;
#pragma unroll
        for (int ks = 0; ks < 4; ++ks) {
          const bf16x8_t wf = *(const bf16x8_t*)(WUK + (size_t)(h * 256 + nt * 16 + c) * 128 + ks * 32 + 8 * g);
          a0 = __builtin_amdgcn_mfma_f32_16x16x32_bf16(wf, dq0[ks], a0, 0, 0, 0);
          a1 = __builtin_amdgcn_mfma_f32_16x16x32_bf16(wf, dq1[ks], a1, 0, 0, 0);
        }
        r0[n8] = a0; r1[n8] = a1;
      }
#pragma unroll
      for (int n8 = 0; n8 < 8; ++n8) {
        const int nt = hn * 8 + n8;
        uint2 o; o.x = pk2(r0[n8][0], r0[n8][1]); o.y = pk2(r0[n8][2], r0[n8][3]);
        *(uint2*)(QL + c * 2048 + h * 256 + nt * 16 + 4 * g) = o;
        o.x = pk2(r1[n8][0], r1[n8][1]); o.y = pk2(r1[n8][2], r1[n8][3]);
        *(uint2*)(QL + (16 + c) * 2048 + h * 256 + nt * 16 + 4 * g) = o;
      }
    }
  }
  DSA_MARK(1);
#pragma unroll 1
  for (int half = 0; half < 2; ++half) {
  const int t0 = t00 + 16 * half;
  const size_t tok0 = tokb + t0;
  bf16* QLh = QL + half * 16 * 2048;
  bf16* OLh = QLh;
  if (t0 >= 256) {
    DSA_IDS
    bf16x8_t qf[8][2];
    float iw[8];
#pragma unroll
    for (int h = 0; h < 8; ++h) {
      qf[h][0] = *(const bf16x8_t*)(IQ + (tok0 + c) * 512 + h * 64 + 8 * g);
      qf[h][1] = *(const bf16x8_t*)(IQ + (tok0 + c) * 512 + h * 64 + 32 + 8 * g);
      iw[h] = IW[(tok0 + c) * 8 + h];
    }
    const int ntile = (t0 >> 4) + 1;
    bf16x8_t k0n = (bf16x8_t){0, 0, 0, 0, 0, 0, 0, 0}, k1n = k0n;
    if (wave < ntile) { const bf16* kr = IK + (tokb + wave * 16 + c) * 64 + 8 * g; k0n = *(const bf16x8_t*)kr; k1n = *(const bf16x8_t*)(kr + 32); }
    for (int kt = wave; kt < ntile; kt += 8) {
      const bf16x8_t k0 = k0n, k1 = k1n;
      { const int ktn = (kt + 8 < ntile) ? kt + 8 : kt; const bf16* kr = IK + (tokb + ktn * 16 + c) * 64 + 8 * g; k0n = *(const bf16x8_t*)kr; k1n = *(const bf16x8_t*)(kr + 32); }
      f32x4 sc = (f32x4){0.f, 0.f, 0.f, 0.f};
#pragma unroll
      for (int h = 0; h < 8; ++h) {
        f32x4 d = __builtin_amdgcn_mfma_f32_16x16x32_bf16(k0, qf[h][0], (f32x4){0.f, 0.f, 0.f, 0.f}, 0, 0, 0);
        d = __builtin_amdgcn_mfma_f32_16x16x32_bf16(k1, qf[h][1], d, 0, 0, 0);
#pragma unroll
        for (int i = 0; i < 4; ++i) sc[i] += iw[h] * fmaxf(d[i], 0.f);
      }
      u16x4_t o;
      const int sb = kt * 16 + 4 * g, tq = t0 + c;
      o.x = (sb + 0 <= tq) ? (unsigned short)(f2ord(sc[0]) >> 16) : (unsigned short)0;
      o.y = (sb + 1 <= tq) ? (unsigned short)(f2ord(sc[1]) >> 16) : (unsigned short)0;
      o.z = (sb + 2 <= tq) ? (unsigned short)(f2ord(sc[2]) >> 16) : (unsigned short)0;
      o.w = (sb + 3 <= tq) ? (unsigned short)(f2ord(sc[3]) >> 16) : (unsigned short)0;
      *(LAS u16x4_t*)(key16 + c * 4096 + sb) = o;
    }
  }
  DSA_MARK(2);
  __syncthreads();
#pragma unroll 1
  for (int qq = 0; qq < 2; ++qq) {
    DSA_IDS
    const int q = wave + 8 * qq, t = t0 + q;
    LAS unsigned short* selq = sel + q * 256;
    if (t < 256) {
      for (int j = lane; j < 256; j += 64) selq[j] = (unsigned short)((j <= t) ? j : 0);
    } else {
      const LAS unsigned short* kq = key16 + q * 4096;
      const int nit = (t >> 9) + 1;
      unsigned kp[8][4];
#pragma unroll
      for (int it = 0; it < 8; ++it) {
        const int s0 = 512 * it + 8 * lane;
        u32x4_t v = (u32x4_t){0u, 0u, 0u, 0u};
        if (s0 <= t) v = *(const LAS u32x4_t*)(kq + s0);
#pragma unroll
        for (int j = 0; j < 4; ++j) {
          const unsigned lo = (s0 + 2 * j <= t) ? (v[j] & 0xffffu) : 0u, hi = (s0 + 2 * j + 1 <= t) ? (v[j] & 0xffff0000u) : 0u;
          kp[it][j] = lo | hi;
        }
      }
      asm volatile("" :: "v"(kp[0][0]), "v"(kp[7][3]));
      DSA_MARKI(21);
      unsigned B = 0u;
#pragma unroll 1
      for (int bit = 15; bit >= 0; --bit) {
        const unsigned cand = B | (1u << bit);
        const unsigned c2 = (cand - 1u) * 0x00010001u;
        unsigned cnt2 = 0u;
#pragma unroll
        for (int it = 0; it < 8; ++it) {
          if (it < nit) {
#pragma unroll
            for (int j = 0; j < 4; ++j) {
              unsigned dd;
              asm("v_pk_sub_u16 %0, %1, %2 clamp\n\tv_pk_min_u16 %0, %0, %3" : "=&v"(dd) : "v"(kp[it][j]), "v"(c2), "v"(0x00010001u));
              cnt2 += dd;
            }
          }
        }
        const int tot = (int)wave_sum_dpp((float)((cnt2 & 0xffffu) + (cnt2 >> 16)));
        if (tot >= 256) B = cand;
      }
      int cgt = 0;
#pragma unroll
      for (int it = 0; it < 8; ++it)
#pragma unroll
        for (int j = 0; j < 4; ++j) cgt += (((kp[it][j] & 0xffffu) > B) ? 1 : 0) + (((kp[it][j] >> 16) > B) ? 1 : 0);
      const int m = 256 - (int)wave_sum_dpp((float)cgt);
      DSA_MARKI(22);
      int base = 0, eqbase = 0;
#pragma unroll
      for (int it = 0; it < 8; ++it) {
        if (it < nit) {
          unsigned kk[8];
#pragma unroll
          for (int j = 0; j < 4; ++j) { kk[2 * j] = kp[it][j] & 0xffffu; kk[2 * j + 1] = kp[it][j] >> 16; }
          unsigned anyeq = 0u;
#pragma unroll
          for (int j = 0; j < 8; ++j) anyeq |= (kk[j] == B) ? 1u : 0u;
          int eqlow = 0, eqtot = 0;
          if (__builtin_amdgcn_ballot_w64(anyeq != 0u) != 0ull) {
#pragma unroll
            for (int j = 0; j < 8; ++j) {
              const unsigned long long mk = __builtin_amdgcn_ballot_w64(kk[j] == B);
              eqlow += (int)__builtin_amdgcn_mbcnt_hi((unsigned)(mk >> 32), __builtin_amdgcn_mbcnt_lo((unsigned)mk, 0u));
              eqtot += __builtin_popcountll(mk);
            }
          }
          int eqr = eqbase + eqlow;
          int ps = base, tot = 0;
          bool tk[8];
#pragma unroll
          for (int j = 0; j < 8; ++j) {
            const bool eq = kk[j] == B;
            tk[j] = (kk[j] > B) || (eq && eqr < m);
            eqr += eq ? 1 : 0;
          }
#pragma unroll
          for (int j = 0; j < 8; ++j) {
            const unsigned long long mk = __builtin_amdgcn_ballot_w64(tk[j]);
            ps += (int)__builtin_amdgcn_mbcnt_hi((unsigned)(mk >> 32), __builtin_amdgcn_mbcnt_lo((unsigned)mk, 0u));
            tot += __builtin_popcountll(mk);
          }
#pragma unroll
          for (int j = 0; j < 8; ++j) {
            if (tk[j]) { if (ps < 256) selq[ps] = (unsigned short)(512 * it + 8 * lane + j); ++ps; }
          }
          base += tot;
          eqbase += eqtot;
        }
      }
    }
  }
  DSA_MARK(3);
  __syncthreads();
  {
    DSA_IDS
    const int wave_b = wave;
    const float slope = (c < 8) ? exp2f(-(float)(c + 1)) : 0.f;
#pragma unroll 1
    for (int qq = 0; qq < 2; ++qq) {
      const int q = wave + 8 * qq, t = t0 + q;
      const int nsel = (t + 1 < 256) ? (t + 1) : 256, nch = (nsel + 31) >> 5;
      const LAS unsigned short* selq = sel + q * 256;
      bf16x8_t qf[8];
      {
        const int lq = tid_fresh() & 63;
        const bf16* qlp = QLh + q * 2048 + (lq & 7) * 256 + 8 * (lq >> 4);
#pragma unroll
        for (int ks = 0; ks < 8; ++ks) qf[ks] = *(const bf16x8_t*)(qlp + ks * 32);
      }
      float mrun = -1e30f, lrun = 0.f;
      f32x4 o[16];
#pragma unroll
      for (int nt = 0; nt < 16; ++nt) o[nt] = (f32x4){0.f, 0.f, 0.f, 0.f};
      u32x4_t st[16];
      f32x4 st_ss = (f32x4){0.f, 0.f, 0.f, 0.f}; float st_d = -1.f;
#define DSA_ISSUE(ch)                                                                                   \
      {          \
        _Pragma("unroll") for (int r = 0; r < 16; ++r) {                                                \
          const int idx = (int)selq[(ch) * 32 + 2 * r + (lane >> 5)];                                   \
          st[r] = *(const u32x4_t*)(CKV + (tokb + idx) * 256 + (lane & 31) * 8);                        \
        }                                                                                               \
        const int j2 = (ch) * 32 + (lane & 31);                                                         \
        const int idx2 = (int)selq[j2];                                                                 \
        st_ss = *(const f32x4*)(SSP + (tokb + idx2) * 4);                                               \
        st_d = (j2 < nsel) ? (float)(t - idx2) : -1.f;                                                  \
      }
      DSA_ISSUE(0);
#pragma unroll 1
      for (int ch = 0; ch < nch; ++ch) {
        const int lane = tid_fresh() & 63, g = lane >> 4, c = lane & 15;
        LAS unsigned char* buf = lds + DS_KEY16 + wave_b * DS_CHUNK;
        LAS float* kr = (LAS float*)(lds + DS_WAVE + wave_b * 1024);
        LAS float* kd = kr + 32;
        const unsigned vb = (unsigned)(uintptr_t)buf + (unsigned)((4 * g + (c >> 2)) * DS_RS + 8 * (c & 3));
#pragma unroll
        for (int r = 0; r < 16; ++r) *(LAS u32x4_t*)(buf + (2 * r + (lane >> 5)) * DS_RS + (lane & 31) * 16) = st[r];
        if (lane < 32) { kr[lane] = rsqrtf(((st_ss[0] + st_ss[1]) + (st_ss[2] + st_ss[3])) * (1.f / 256.f) + 1e-6f); kd[lane] = st_d; }
        wave_lds_fence();
        DSA_MARKI(11);
        DSA_ISSUE((ch + 1 < nch) ? ch + 1 : ch);
        f32x4 s0 = (f32x4){0.f, 0.f, 0.f, 0.f}, s1 = (f32x4){0.f, 0.f, 0.f, 0.f};
#pragma unroll
        for (int ks = 0; ks < 8; ++ks) {
          const bf16x8_t a0 = *(const LAS bf16x8_t*)(buf + c * DS_RS + (ks * 32 + 8 * g) * 2);
          const bf16x8_t a1 = *(const LAS bf16x8_t*)(buf + (16 + c) * DS_RS + (ks * 32 + 8 * g) * 2);
          s0 = __builtin_amdgcn_mfma_f32_16x16x32_bf16(a0, qf[ks], s0, 0, 0, 0);
          s1 = __builtin_amdgcn_mfma_f32_16x16x32_bf16(a1, qf[ks], s1, 0, 0, 0);
        }
        asm volatile("" :: "v"(s0[0]), "v"(s1[0]));
        DSA_MARKI(12);
        const f32x4 r0 = *(const LAS f32x4*)(kr + 4 * g), r1 = *(const LAS f32x4*)(kr + 16 + 4 * g);
        const f32x4 d0 = *(const LAS f32x4*)(kd + 4 * g), d1 = *(const LAS f32x4*)(kd + 16 + 4 * g);
        float x[8];
#pragma unroll
        for (int i = 0; i < 4; ++i) {
          x[i] = (d0[i] < 0.f) ? -1e30f : (s0[i] * r0[i] - slope * d0[i]);
          x[4 + i] = (d1[i] < 0.f) ? -1e30f : (s1[i] * r1[i] - slope * d1[i]);
        }
        float mx = fmaxf(fmaxf(fmaxf(x[0], x[1]), fmaxf(x[2], x[3])), fmaxf(fmaxf(x[4], x[5]), fmaxf(x[6], x[7])));
        mx = xrow_max(mx);
        const float mn = fmaxf(mrun, mx);
        const float alpha = __expf(mrun - mn);
        mrun = mn;
        float pr[8], ps = 0.f;
#pragma unroll
        for (int i = 0; i < 8; ++i) { pr[i] = (x[i] <= -1e29f) ? 0.f : __expf(x[i] - mn); ps += pr[i]; }
        ps = xrow_sum(ps);
        lrun = lrun * alpha + ps;
        if (__builtin_amdgcn_ballot_w64(alpha != 1.f) != 0ull) {
#pragma unroll
          for (int nt = 0; nt < 16; ++nt) o[nt] *= alpha;
        }
        union { bf16x8_t v; unsigned u[4]; } pf;
        pf.u[0] = pk2(pr[0] * r0[0], pr[1] * r0[1]); pf.u[1] = pk2(pr[2] * r0[2], pr[3] * r0[3]);
        pf.u[2] = pk2(pr[4] * r1[0], pr[5] * r1[1]); pf.u[3] = pk2(pr[6] * r1[2], pr[7] * r1[3]);
        asm volatile("" :: "v"(pf.u[0]));
        DSA_MARKI(13);
        {
          s16x4_t loA[4], hiA[4], loB[4], hiB[4];
#define PV_READ(L, H, nt0) _Pragma("unroll") for (int u = 0; u < 4; ++u) { L[u] = tr_read_b64(vb + ((nt0) + u) * 32); H[u] = tr_read_b64(vb + ((nt0) + u) * 32 + 16 * DS_RS); }
#define PV_MMA(L, H, nt0) _Pragma("unroll") for (int u = 0; u < 4; ++u) { \
            const bf16x8_t af = (bf16x8_t){L[u][0], L[u][1], L[u][2], L[u][3], H[u][0], H[u][1], H[u][2], H[u][3]}; \
            o[(nt0) + u] = __builtin_amdgcn_mfma_f32_16x16x32_bf16(af, pf.v, o[(nt0) + u], 0, 0, 0); }
          PV_READ(loA, hiA, 0);
          PV_READ(loB, hiB, 4);
          asm volatile("s_waitcnt lgkmcnt(8)" ::: "memory"); __builtin_amdgcn_sched_barrier(0);
          PV_MMA(loA, hiA, 0); __builtin_amdgcn_sched_barrier(0);
          PV_READ(loA, hiA, 8);
          asm volatile("s_waitcnt lgkmcnt(8)" ::: "memory"); __builtin_amdgcn_sched_barrier(0);
          PV_MMA(loB, hiB, 4); __builtin_amdgcn_sched_barrier(0);
          PV_READ(loB, hiB, 12);
          asm volatile("s_waitcnt lgkmcnt(8)" ::: "memory"); __builtin_amdgcn_sched_barrier(0);
          PV_MMA(loA, hiA, 8); __builtin_amdgcn_sched_barrier(0);
          asm volatile("s_waitcnt lgkmcnt(0)" ::: "memory"); __builtin_amdgcn_sched_barrier(0);
          PV_MMA(loB, hiB, 12);
#undef PV_READ
#undef PV_MMA
        }
        wave_lds_fence();
        asm volatile("" :: "v"(o[0][0]), "v"(o[15][0]));
        DSA_MARKI(14);
      }
#undef DSA_ISSUE
      if (c < 8) {
        const float inv = 1.f / lrun;
#pragma unroll
        for (int nt = 0; nt < 16; ++nt) {
          uint2 w; w.x = pk2(o[nt][0] * inv, o[nt][1] * inv); w.y = pk2(o[nt][2] * inv, o[nt][3] * inv);
          *(uint2*)(OLh + q * 2048 + c * 256 + nt * 16 + 4 * g) = w;
        }
      }
    }
  }
  DSA_MARK(4);
  __syncthreads();
  }
  {
    DSA_IDS
    const int h = wave;
    bf16x8_t of0[8], of1[8];
#pragma unroll
    for (int ks = 0; ks < 8; ++ks) {
      of0[ks] = *(const bf16x8_t*)(OL + c * 2048 + h * 256 + ks * 32 + 8 * g);
      of1[ks] = *(const bf16x8_t*)(OL + (16 + c) * 2048 + h * 256 + ks * 32 + 8 * g);
    }
    f32x4 c0[8], c1[8];
#pragma unroll
    for (int nt = 0; nt < 8; ++nt) {
      f32x4 a0 = (f32x4){0.f, 0.f, 0.f, 0.f}, a1 = a0;
#pragma unroll
      for (int ks = 0; ks < 8; ++ks) {
        const bf16x8_t wf = *(const bf16x8_t*)(WUV + (size_t)(h * 128 + nt * 16 + c) * 256 + ks * 32 + 8 * g);
        a0 = __builtin_amdgcn_mfma_f32_16x16x32_bf16(wf, of0[ks], a0, 0, 0, 0);
        a1 = __builtin_amdgcn_mfma_f32_16x16x32_bf16(wf, of1[ks], a1, 0, 0, 0);
      }
      c0[nt] = a0; c1[nt] = a1;
    }
#pragma unroll
    for (int nt = 0; nt < 8; ++nt) {
      uint2 w; w.x = pk2(c0[nt][0], c0[nt][1]); w.y = pk2(c0[nt][2], c0[nt][3]);
      *(uint2*)(ODSA + (tok00 + c) * 1024 + h * 128 + nt * 16 + 4 * g) = w;
      w.x = pk2(c1[nt][0], c1[nt][1]); w.y = pk2(c1[nt][2], c1[nt][3]);
      *(uint2*)(ODSA + (tok00 + 16 + c) * 1024 + h * 128 + nt * 16 + 4 * g) = w;
    }
  }
  DSA_MARK(5);
  __syncthreads();
}

#undef DSA_IDS
__device__ __forceinline__ void ph_dsa512(const P& p, unsigned char* lds_raw) {
  for (int it = blockIdx.x; it < TT / 16; it += gridDim.x) {
    const int k = it >> 8, j = it & 255;
    dsa_batch(p, lds_raw, k, ((k & 1) ? 255 - j : j) >> 1);
  }
}

#define GL_QD    0
#define GL_KI    18432
#define GL_KE    36864
#define GL_V     55296
#define GL_AT    90112
#define GL_GLOW  99328
#define GL_QT    103424
#define GL_DEC   105472
#define GL_SSQ   105984
#define GL_LB    108032
#define GL_TOTAL 140800

#define GLA_BAR() do { asm volatile("s_waitcnt lgkmcnt(0)" ::: "memory"); __builtin_amdgcn_s_barrier(); asm volatile("" ::: "memory"); } while (0)
#ifndef PROBE_GLA
#define PROBE_GLA 0
#endif
#if PROBE_GLA
#define GLA_MARK(k) do { const unsigned long long n_ = __builtin_amdgcn_s_memrealtime(); if (PROBE_GLA == (k)) { const unsigned long long q_ = n_ - tmark; \
    while (__builtin_amdgcn_s_memrealtime() - n_ < q_) __builtin_amdgcn_s_sleep(2); } tmark = __builtin_amdgcn_s_memrealtime(); } while (0)
#else
#define GLA_MARK(k) do {} while (0)
#endif
__device__ __forceinline__ void gla_item(const P& p, unsigned char* lds_raw, int item) {
  int tid = tid_fresh();
  const int b = item >> 2, h = item & 3;
  const size_t tokb = (size_t)b * SEQ;
  const bf16* Qg = (const bf16*)(p.ws + OFF_Q);
  const bf16* Kg = (const bf16*)(p.ws + OFF_K);
  bf16* Vg = (bf16*)(p.ws + OFF_V);
  const float* GLOWg = (const float*)(p.ws + OFF_GLOW);
  const bf16* SGR = (const bf16*)(p.ws + OFF_SGR);
  LAS unsigned char* lds = (LAS unsigned char*)lds_raw;
  const unsigned lds0 = (unsigned)(uintptr_t)lds;
  LAS float* QT = (LAS float*)(lds + GL_QT);
  LAS float* DEC = (LAS float*)(lds + GL_DEC);
  LAS float* SSQ = (LAS float*)(lds + GL_SSQ);
  float wg[16];
  const float* prm = (const float*)(p.ws + OFF_PRM);
#pragma unroll
  for (int r = 0; r < 16; ++r) wg[r] = prm[PRM_WGU + r * 512 + h * 128 + (tid & 127)];
  const float bg = prm[PRM_BG + h * 128 + (tid & 127)];
  const float gn0 = prm[PRM_GNG + h * 256 + 32 * (tid >> 6) + (tid & 15)], gn1 = prm[PRM_GNG + h * 256 + 32 * (tid >> 6) + 16 + (tid & 15)];
  u32x4_t rq[2], rk[2], rv[4], rg = (u32x4_t){0u, 0u, 0u, 0u};
#define GLA_LOAD(ch)                                                                                      \
  {                                                                                                       \
    const size_t tb = tokb + (size_t)(ch) * 64;                                                           \
    _Pragma("unroll") for (int i = 0; i < 2; ++i) {                                                       \
      const int id = tid + 512 * i, tk = id >> 4, part = id & 15;                                         \
      rq[i] = *(const u32x4_t*)(Qg + (tb + tk) * 512 + h * 128 + part * 8);                               \
      rk[i] = *(const u32x4_t*)(Kg + (tb + tk) * 512 + h * 128 + part * 8);                               \
    }                                                                                                     \
    _Pragma("unroll") for (int i = 0; i < 4; ++i) {                                                       \
      const int id = tid + 512 * i, tk = id >> 5, part = id & 31;                                         \
      rv[i] = *(const u32x4_t*)(Vg + (tb + tk) * 1024 + h * 256 + part * 8);                              \
    }                                                                                                     \
    if (tid < 256) rg = *(const u32x4_t*)(GLOWg + (tb + (tid >> 2)) * 16 + (tid & 3) * 4);                \
  }
  f32x4 S[8][2];
#pragma unroll
  for (int a = 0; a < 8; ++a) { S[a][0] = (f32x4){0.f, 0.f, 0.f, 0.f}; S[a][1] = (f32x4){0.f, 0.f, 0.f, 0.f}; }
  GLA_LOAD(0);
#if PROBE_GLA
  unsigned long long tmark = __builtin_amdgcn_s_memrealtime();
#endif
#pragma unroll 1
  for (int ch = 0; ch < SEQ / 64; ++ch) {
    asm volatile("" : "+v"(tid));
    const int wave = __builtin_amdgcn_readfirstlane(tid >> 6), lane = tid & 63, g = lane >> 4, c = lane & 15;
    const int d = tid & 127, tq = __builtin_amdgcn_readfirstlane(tid >> 7);
    const unsigned vtr = lds0 + GL_V + (unsigned)((8 * g + (c >> 2)) * 544 + (32 * wave + 4 * (c & 3)) * 2);
    const unsigned ketr = lds0 + GL_KE + (unsigned)((8 * g + (c >> 2)) * 288 + (4 * (c & 3)) * 2);
    const size_t tb = tokb + (size_t)ch * 64;
#pragma unroll
    for (int i = 0; i < 2; ++i) {
      const int id = tid + 512 * i, tk = id >> 4, part = id & 15;
      *(LAS u32x4_t*)(lds + GL_QD + tk * 288 + part * 16) = rq[i];
      *(LAS u32x4_t*)(lds + GL_KI + tk * 288 + part * 16) = rk[i];
    }
#pragma unroll
    for (int i = 0; i < 4; ++i) {
      const int id = tid + 512 * i, tk = id >> 5, part = id & 31;
      *(LAS u32x4_t*)(lds + GL_V + tk * 544 + part * 16) = rv[i];
    }
    if (tid < 256) *(LAS u32x4_t*)(lds + GL_GLOW + (tid >> 2) * 64 + (tid & 3) * 16) = rg;
    GLA_MARK(1); GLA_BAR();
    GLA_LOAD((ch + 1 < SEQ / 64) ? ch + 1 : ch);
    u32x4_t rs[4];
#pragma unroll
    for (int i = 0; i < 4; ++i) {
      const int id = tid + 512 * i, tk = id >> 5, part = id & 31;
      rs[i] = *(const u32x4_t*)(SGR + (tb + tk) * 1024 + h * 256 + part * 8);
    }
    LAS float* LB = (LAS float*)(lds + GL_LB);
    float run = 0.f;
#pragma unroll 2
    for (int i = 0; i < 16; ++i) {
      const LAS f32x4* gp = (const LAS f32x4*)(lds + GL_GLOW + (16 * tq + i) * 64);
      const f32x4 g0 = gp[0], g1 = gp[1], g2 = gp[2], g3 = gp[3];
      float gl = bg;
      gl += g0[0] * wg[0] + g0[1] * wg[1] + g0[2] * wg[2] + g0[3] * wg[3];
      gl += g1[0] * wg[4] + g1[1] * wg[5] + g1[2] * wg[6] + g1[3] * wg[7];
      gl += g2[0] * wg[8] + g2[1] * wg[9] + g2[2] * wg[10] + g2[3] * wg[11];
      gl += g3[0] * wg[12] + g3[1] * wg[13] + g3[2] * wg[14] + g3[3] * wg[15];
      const float ls = fminf(gl, 0.f) - __logf(1.f + __expf(-fabsf(gl)));
      run += ls * (1.f / 16.f);
      LB[(16 * tq + i) * 128 + d] = run;
    }
    QT[tq * 128 + d] = run;
    GLA_MARK(2); GLA_BAR();
    {
      float off = 0.f, tot = 0.f;
#pragma unroll
      for (int k = 0; k < 4; ++k) { const float v = QT[k * 128 + d]; tot += v; off += (k < tq) ? v : 0.f; }
      const float eb = __expf(tot);
#pragma unroll 2
      for (int i = 0; i < 16; ++i) {
        const int t = 16 * tq + i;
        const float bb = LB[t * 128 + d] + off;
        const float e = __expf(bb), r = __expf(-bb);
        LAS bf16* qp = (LAS bf16*)(lds + GL_QD + t * 288) + d;
        LAS bf16* kp = (LAS bf16*)(lds + GL_KI + t * 288) + d;
        LAS bf16* ep = (LAS bf16*)(lds + GL_KE + t * 288) + d;
        const float q = bf2f(*qp), k = bf2f(*kp);
        *qp = f2bf(q * e);
        *kp = f2bf(k * r);
        *ep = f2bf(k * (eb * r));
      }
      if (tq == 0) DEC[d] = eb;
    }
    GLA_MARK(3); GLA_BAR();
    {
      const int ti = wave >> 1;
#pragma unroll
      for (int u = 0; u < 2; ++u) {
        const int tj = 2 * (wave & 1) + u;
        f32x4 acc = (f32x4){0.f, 0.f, 0.f, 0.f};
        if (tj <= ti) {
#pragma unroll
          for (int ks = 0; ks < 4; ++ks) {
            const bf16x8_t a = *(const LAS bf16x8_t*)(lds + GL_QD + (16 * ti + c) * 288 + (32 * ks + 8 * g) * 2);
            const bf16x8_t bb = *(const LAS bf16x8_t*)(lds + GL_KI + (16 * tj + c) * 288 + (32 * ks + 8 * g) * 2);
            acc = __builtin_amdgcn_mfma_f32_16x16x32_bf16(a, bb, acc, 0, 0, 0);
          }
        }
#pragma unroll
        for (int r = 0; r < 4; ++r) {
          const int i = 16 * ti + 4 * g + r, j = 16 * tj + c;
          *((LAS bf16*)(lds + GL_AT + i * 144) + j) = f2bf((j <= i) ? acc[r] : 0.f);
        }
      }
    }
    GLA_MARK(4); GLA_BAR();
    f32x4 o[4][2];
    {
      bf16x8_t vf[2][2];
      {
        s16x4_t lo[4], hi[4];
#pragma unroll
        for (int ks = 0; ks < 2; ++ks)
#pragma unroll
          for (int tn = 0; tn < 2; ++tn) {
            lo[ks * 2 + tn] = tr_read_b64(vtr + (32 * ks) * 544 + tn * 32);
            hi[ks * 2 + tn] = tr_read_b64(vtr + (32 * ks + 4) * 544 + tn * 32);
          }
        asm volatile("s_waitcnt lgkmcnt(0)" ::: "memory");
        __builtin_amdgcn_sched_barrier(0);
#pragma unroll
        for (int u = 0; u < 4; ++u)
          vf[u >> 1][u & 1] = (bf16x8_t){lo[u][0], lo[u][1], lo[u][2], lo[u][3], hi[u][0], hi[u][1], hi[u][2], hi[u][3]};
      }
#pragma unroll
      for (int tm = 0; tm < 4; ++tm) { o[tm][0] = (f32x4){0.f, 0.f, 0.f, 0.f}; o[tm][1] = (f32x4){0.f, 0.f, 0.f, 0.f}; }
#pragma unroll
      for (int tm = 0; tm < 4; ++tm)
#pragma unroll
        for (int ks = 0; ks < 2; ++ks) {
          if (ks == 1 && tm < 2) continue;
          const bf16x8_t a = *(const LAS bf16x8_t*)(lds + GL_AT + (16 * tm + c) * 144 + (32 * ks + 8 * g) * 2);
          o[tm][0] = __builtin_amdgcn_mfma_f32_16x16x32_bf16(a, vf[ks][0], o[tm][0], 0, 0, 0);
          o[tm][1] = __builtin_amdgcn_mfma_f32_16x16x32_bf16(a, vf[ks][1], o[tm][1], 0, 0, 0);
          __builtin_amdgcn_sched_barrier(0);
        }
#pragma unroll
      for (int u = 0; u < 4; ++u) {
        union { bf16x8_t v; unsigned w[4]; } s0, s1;
        s0.w[0] = pk2(S[2 * u][0][0], S[2 * u][0][1]); s0.w[1] = pk2(S[2 * u][0][2], S[2 * u][0][3]);
        s0.w[2] = pk2(S[2 * u + 1][0][0], S[2 * u + 1][0][1]); s0.w[3] = pk2(S[2 * u + 1][0][2], S[2 * u + 1][0][3]);
        s1.w[0] = pk2(S[2 * u][1][0], S[2 * u][1][1]); s1.w[1] = pk2(S[2 * u][1][2], S[2 * u][1][3]);
        s1.w[2] = pk2(S[2 * u + 1][1][0], S[2 * u + 1][1][1]); s1.w[3] = pk2(S[2 * u + 1][1][2], S[2 * u + 1][1][3]);
#pragma unroll
        for (int tm = 0; tm < 4; ++tm) {
          const LAS unsigned char* qrow = lds + GL_QD + (16 * tm + c) * 288 + (32 * u + 4 * g) * 2;
          const s16x4_t q0 = *(const LAS s16x4_t*)qrow, q1 = *(const LAS s16x4_t*)(qrow + 32);
          const bf16x8_t a = (bf16x8_t){q0[0], q0[1], q0[2], q0[3], q1[0], q1[1], q1[2], q1[3]};
          o[tm][0] = __builtin_amdgcn_mfma_f32_16x16x32_bf16(a, s0.v, o[tm][0], 0, 0, 0);
          o[tm][1] = __builtin_amdgcn_mfma_f32_16x16x32_bf16(a, s1.v, o[tm][1], 0, 0, 0);
        }
        __builtin_amdgcn_sched_barrier(0);
      }
#pragma unroll
      for (int tk = 0; tk < 8; ++tk) {
        const f32x4 dec4 = *(const LAS f32x4*)(DEC + 16 * tk + 4 * g);
        S[tk][0] *= dec4; S[tk][1] *= dec4;
        s16x4_t lo0 = tr_read_b64(ketr + tk * 32), hi0 = tr_read_b64(ketr + 4 * 288 + tk * 32);
        s16x4_t lo1 = tr_read_b64(ketr + 32 * 288 + tk * 32), hi1 = tr_read_b64(ketr + 36 * 288 + tk * 32);
        asm volatile("s_waitcnt lgkmcnt(0)" ::: "memory");
        __builtin_amdgcn_sched_barrier(0);
        const bf16x8_t a0 = (bf16x8_t){lo0[0], lo0[1], lo0[2], lo0[3], hi0[0], hi0[1], hi0[2], hi0[3]};
        const bf16x8_t a1 = (bf16x8_t){lo1[0], lo1[1], lo1[2], lo1[3], hi1[0], hi1[1], hi1[2], hi1[3]};
        S[tk][0] = __builtin_amdgcn_mfma_f32_16x16x32_bf16(a0, vf[0][0], S[tk][0], 0, 0, 0);
        S[tk][1] = __builtin_amdgcn_mfma_f32_16x16x32_bf16(a0, vf[0][1], S[tk][1], 0, 0, 0);
        S[tk][0] = __builtin_amdgcn_mfma_f32_16x16x32_bf16(a1, vf[1][0], S[tk][0], 0, 0, 0);
        S[tk][1] = __builtin_amdgcn_mfma_f32_16x16x32_bf16(a1, vf[1][1], S[tk][1], 0, 0, 0);
        __builtin_amdgcn_sched_barrier(0);
      }
#pragma unroll
      for (int tm = 0; tm < 4; ++tm)
#pragma unroll
        for (int r = 0; r < 4; ++r) {
          float ss = o[tm][0][r] * o[tm][0][r] + o[tm][1][r] * o[tm][1][r];
          ss = row16_sum(ss);
          if (c == 0) SSQ[(16 * tm + 4 * g + r) * 8 + wave] = ss;
        }
    }
    GLA_MARK(5); GLA_BAR();
    {
      LAS bf16* OB = (LAS bf16*)(lds + GL_LB);
#pragma unroll
      for (int tm = 0; tm < 4; ++tm)
#pragma unroll
        for (int r = 0; r < 4; ++r) {
          const int t = 16 * tm + 4 * g + r;
          const f32x4 p0 = *(const LAS f32x4*)(SSQ + t * 8), p1 = *(const LAS f32x4*)(SSQ + t * 8 + 4);
          const float tot = ((p0[0] + p0[1]) + (p0[2] + p0[3])) + ((p1[0] + p1[1]) + (p1[2] + p1[3]));
          const float rstd = rsqrtf(tot * (1.f / 256.f) + 1e-6f);
          OB[t * 256 + 32 * wave + c] = f2bf(o[tm][0][r] * rstd * gn0);
          OB[t * 256 + 32 * wave + 16 + c] = f2bf(o[tm][1][r] * rstd * gn1);
        }
    }
    GLA_MARK(6); GLA_BAR();
#pragma unroll
    for (int i = 0; i < 4; ++i) {
      const int id = tid + 512 * i, tk = id >> 5, part = id & 31;
      const u32x4_t ov = *(const LAS u32x4_t*)(lds + GL_LB + tk * 512 + part * 16);
      const u32x4_t sv = rs[i];
      u32x4_t gv;
      gv[0] = pk2(bflo(ov[0]) * bflo(sv[0]), bfhi(ov[0]) * bfhi(sv[0]));
      gv[1] = pk2(bflo(ov[1]) * bflo(sv[1]), bfhi(ov[1]) * bfhi(sv[1]));
      gv[2] = pk2(bflo(ov[2]) * bflo(sv[2]), bfhi(ov[2]) * bfhi(sv[2]));
      gv[3] = pk2(bflo(ov[3]) * bflo(sv[3]), bfhi(ov[3]) * bfhi(sv[3]));
      *(u32x4_t*)(Vg + (tb + tk) * 1024 + h * 256 + part * 8) = gv;
    }
    GLA_MARK(7);
  }
#undef GLA_LOAD
  __syncthreads();
}

#define LDS_BYTES 155712
#define OFF_XBAR (224ull * 1024)
#define OFF_CTR (200ull * 1024)

__device__ __forceinline__ unsigned xcc_id() { return (unsigned)__builtin_amdgcn_s_getreg((3 << 11) | 20) & 0x7u; }
__device__ __forceinline__ void ph_mixer(const P& p, unsigned char* lds_raw, bool do_gla) {
  if (do_gla && blockIdx.x < 32) { gla_item(p, lds_raw, blockIdx.x); if (blockIdx.x == 0) TS_SET(p, 20); }
  unsigned* ctr = (unsigned*)(p.ws + OFF_CTR);
  LAS unsigned* slot = (LAS unsigned*)((LAS unsigned char*)lds_raw + DS_TOTAL);
  const unsigned home = xcc_id();
  unsigned k = 0;
  for (;;) {
    if (tid_fresh() == 0) {
      unsigned qi = 0xffffffffu;
      while (k < 8) {
        const unsigned b = (home + k) & 7u;
        const unsigned v = __hip_atomic_fetch_add(ctr + 64 * b, 1u, __ATOMIC_RELAXED, __HIP_MEMORY_SCOPE_AGENT);
        if (v < 128u) { qi = (b << 8) | v; break; }
        ++k;
      }
      slot[0] = qi; slot[1] = k;
    }
    __syncthreads();
    const unsigned qi = slot[0];
    k = slot[1];
    __syncthreads();
    if (qi == 0xffffffffu) break;
    dsa_batch(p, lds_raw, (int)(qi >> 8), 127 - (int)(qi & 255u));
  }
}

__global__ void __launch_bounds__(512, 2) mega(P p) {
  extern __shared__ __attribute__((aligned(16))) unsigned char lds_raw[];
  LAS unsigned char* lds = (LAS unsigned char*)lds_raw;
  cg::grid_group grid = cg::this_grid();
  char* ws = p.ws;
  const int bid = blockIdx.x, nb = gridDim.x;
  if (bid == 0 && threadIdx.x < 8) *(unsigned*)(ws + OFF_CTR + 256 * threadIdx.x) = 0u;
  if (bid == 0) { for (int i = threadIdx.x; i < XCD_BAR_WORDS; i += 512) ((unsigned*)(ws + OFF_XBAR))[i] = 0u; }
  volatile LAS unsigned* xst = (volatile LAS unsigned*)(lds + DS_TOTAL + 16);
  if (threadIdx.x < 4) xst[threadIdx.x] = 0u;
#if PROBE_TS
  { const int t_ = tid_fresh(); if (bid == 0 && t_ < 64) ((unsigned long long*)(ws + OFF_TS))[t_] = 0ull; }
  __syncthreads();
  if (bid == 0) TS_SET(p, 0);
#endif
  ph_prep(p, (float*)lds_raw);
  grid.sync();
  const XcdBarrier xb = xcd_barrier_post((unsigned*)(ws + OFF_XBAR), xst);
  if (bid == 0) TS_SET(p, 1);
  ph_mod(p, p.x, p.norm1_g, 0, 1024, (bf16*)(ws + OFF_H), bid, nb);
  xcd_barrier(xb);
  if (bid == 0) TS_SET(p, 2);
  gemm_run(lds, (const bf16*)(ws + OFF_H), (const bf16*)(ws + OFF_WT_IN), TT, 7168, 1024, EpiIn{ws, p.out});
  xcd_barrier(xb);
  if (bid == 0) TS_SET(p, 3);
  ph_mixer(p, lds_raw, true);
  if (bid == 0) TS_SET(p, 21);
  xcd_barrier(xb);
  if (bid == 0) TS_SET(p, 4);
  gemm_run(lds, (const bf16*)(ws + OFF_V), (const bf16*)(ws + OFF_WT_A), TT, 1024, 1024,
           EpiMix<false>{(const bf16*)p.out, (bf16*)(ws + OFF_MIX)});
  gemm_run(lds, (const bf16*)(ws + OFF_ODSA), (const bf16*)(ws + OFF_WT_B), TT, 1024, 1024,
           EpiMix<true>{(const bf16*)p.out + (size_t)TT * 1024, (bf16*)(ws + OFF_MIX)});
  xcd_barrier(xb);
  if (bid == 0) TS_SET(p, 5);
  gemm_run(lds, (const bf16*)(ws + OFF_MIX), (const bf16*)(ws + OFF_WT_OUT), TT, 1024, 1024,
           EpiX1{p.x, (const float*)(ws + OFF_ADA), p.out});
  xcd_barrier(xb);
  if (bid == 0) TS_SET(p, 6);
  ph_mod(p, p.out, (const float*)(ws + OFF_PRM) + PRM_N2G, 3072, 4096, (bf16*)(ws + OFF_H), bid, nb);
  xcd_barrier(xb);
  if (bid == 0) TS_SET(p, 7);
  gemm_run(lds, (const bf16*)(ws + OFF_H), (const bf16*)(ws + OFF_WT_Q), TT, 2048, 1024, EpiPlain{(bf16*)(ws + OFF_PQ), 2048});
  xcd_barrier(xb);
  if (bid == 0) TS_SET(p, 8);
  ph_peer512(p, lds_raw, p.out);
#if PROBE_TS
  if (bid == 0) TS_SET(p, 18);
  xcd_barrier(xb);
  {
    const unsigned long long* T = (const unsigned long long*)(ws + OFF_TS);
    const unsigned long long q = (unsigned long long)(PROBE_Q), t0 = __builtin_amdgcn_s_memrealtime();
    while (__builtin_amdgcn_s_memrealtime() - t0 < q) __builtin_amdgcn_s_sleep(8);
  }
#endif
}

extern "C" void kernel_launch(void* const* d_in, const int* in_sizes, int n_in, void* d_out, int out_size, void* d_ws,
                              size_t ws_size, hipStream_t stream) {
  P p{};
  const float** f = (const float**)&p;
  for (int i = 0; i < 22; ++i) f[i] = (const float*)d_in[i];
  p.out = (float*)d_out;
  p.ws = (char*)d_ws;
  if (ws_size < WS_NEED) { fprintf(stderr, "workspace too small: %zu\n", ws_size); return; }
  static int grid_blocks = 0;
  if (!grid_blocks) {
    int dev = 0, cus = 0, per_cu = 0;
    (void)hipGetDevice(&dev);
    (void)hipDeviceGetAttribute(&cus, hipDeviceAttributeMultiprocessorCount, dev);
    if (hipFuncSetAttribute((const void*)mega, hipFuncAttributeMaxDynamicSharedMemorySize, LDS_BYTES) != hipSuccess) {
      fprintf(stderr, "hipFuncSetAttribute failed\n"); grid_blocks = -1; return;
    }
    if (hipOccupancyMaxActiveBlocksPerMultiprocessor(&per_cu, (const void*)mega, 512, LDS_BYTES) != hipSuccess || per_cu < 1) {
      fprintf(stderr, "occupancy query failed\n"); grid_blocks = -1; return;
    }
    grid_blocks = cus;
  }
  if (grid_blocks <= 0) return;
  void* args[] = {&p};
  hipError_t e = hipLaunchCooperativeKernel((void*)mega, dim3(grid_blocks), dim3(512), args, LDS_BYTES, stream);
  if (e != hipSuccess) fprintf(stderr, "cooperative launch failed: %s (grid %d)\n", hipGetErrorString(e), grid_blocks);
}
```

```cpp
#include <hip/hip_runtime.h>
#include <hip/hip_cooperative_groups.h>
#include <cstdio>
#include <cstdint>
namespace cg = cooperative_groups;

#define TT 32768
#define SEQ 4096
#define DM 1024
#define NIN 7000
typedef unsigned short bf16;
#define LAS __attribute__((address_space(3)))

struct P {
  const float *x, *c, *w_ada, *b_ada, *norm1_g, *w_in, *w_gate_up, *b_gate, *gla_norm_g, *kv_norm_g,
      *w_uk, *w_uv, *w_a, *w_b, *w_out, *norm2_g, *w_q, *sk1, *sk2, *peer_u, *peer_v, *final_g;
  float* out;
  char* ws;
};

#define MB (1ull << 20)
#define OFF_ADA   (0ull)
#define OFF_H     (1 * MB)
#define OFF_ODSA  (1 * MB)
#define OFF_Q     (65 * MB)
#define OFF_K     (97 * MB)
#define OFF_MIX   (65 * MB)
#define OFF_V     (129 * MB)
#define OFF_DQ    (193 * MB)
#define OFF_PQ    (129 * MB)
#define OFF_DSCR  (257 * MB)
#define OFF_SSP   (256ull * 1024)
#define OFF_CKV   (289 * MB)
#define OFF_IQ    (305 * MB)
#define OFF_IK    (337 * MB)
#define OFF_IW    (341 * MB)
#define OFF_GLOW  (342 * MB)
#define OFF_SGR   (344 * MB)
#define OFF_WT    (408 * MB)
#define OFF_WT_IN  (OFF_WT)
#define OFF_WT_A   (OFF_WT + 7168ull * 2048)
#define OFF_WT_B   (OFF_WT_A + 1024ull * 2048)
#define OFF_WT_OUT (OFF_WT_B + 1024ull * 2048)
#define OFF_WT_Q   (OFF_WT_OUT + 1024ull * 2048)
#define OFF_PU    (432 * MB)
#define OFF_PV    (464 * MB)
#define OFF_SK    (496 * MB)
#define OFF_PSC   (496 * MB + 128 * 1024)
#define OFF_WUK   (497 * MB)
#define OFF_WUV   (497 * MB + 512 * 1024)
#define WS_NEED   (498 * MB)

__device__ __forceinline__ bf16 f2bf(float f) {
  unsigned u = __float_as_uint(f);
  u += 0x7fffu + ((u >> 16) & 1u);
  return (bf16)(u >> 16);
}
__device__ __forceinline__ unsigned pk2(float lo, float hi) { return (unsigned)f2bf(lo) | ((unsigned)f2bf(hi) << 16); }
__device__ __forceinline__ float bf2f(bf16 h) { return __uint_as_float(((unsigned)h) << 16); }
__device__ __forceinline__ float bflo(unsigned u) { return __uint_as_float(u << 16); }
__device__ __forceinline__ float bfhi(unsigned u) { return __uint_as_float(u & 0xffff0000u); }
__device__ __forceinline__ float wave_sum(float v) {
#pragma unroll
  for (int o = 32; o > 0; o >>= 1) v += __shfl_xor(v, o);
  return v;
}
__device__ __forceinline__ float wave_max(float v) {
#pragma unroll
  for (int o = 32; o > 0; o >>= 1) v = fmaxf(v, __shfl_xor(v, o));
  return v;
}
#ifndef PROBE_TS
#define PROBE_TS 0
#endif
#define OFF_PRM (800ull * 1024)
#define PRM_WGU   0
#define PRM_BG    8192
#define PRM_GNG   8704
#define PRM_N2G   9728
#define PRM_FG    10752
#define PRM_TOTAL 11776
#define OFF_TS (208ull * 1024)
#if PROBE_TS
#define TS_SET(p, k) do { if (tid_fresh() == 0) ((unsigned long long*)((p).ws + OFF_TS))[k] = __builtin_amdgcn_s_memrealtime(); } while (0)
#define TS_ADD(p, k, t0) do { if (tid_fresh() == 0) ((unsigned long long*)((p).ws + OFF_TS))[k] += __builtin_amdgcn_s_memrealtime() - (t0); } while (0)
#define TS_NOW() __builtin_amdgcn_s_memrealtime()
#else
#define TS_SET(p, k) do {} while (0)
#define TS_ADD(p, k, t0) do {} while (0)
#define TS_NOW() 0ull
#endif
__device__ __forceinline__ int tid_fresh() { int t = threadIdx.x; asm volatile("" : "+v"(t)); return t; }
__device__ __forceinline__ float sigmoidf_(float v) { return 1.f / (1.f + __expf(-v)); }
__device__ __forceinline__ float siluf_(float v) { return v / (1.f + __expf(-v)); }

#include <hip/hip_runtime.h>
namespace pg8 {
#define PG8_LAS __attribute__((address_space(3)))
typedef unsigned short bf16_t;
typedef short bf16x8 __attribute__((ext_vector_type(8)));
typedef float f32x4 __attribute__((ext_vector_type(4)));
typedef unsigned u32x4 __attribute__((ext_vector_type(4)));
constexpr int BM = 256, BK = 64, HALF = 128, HTB = HALF * BK * 2  , STAGE_BYTES = 8 * HTB, NXCD = 8, WGM = 8;

__host__ __device__ __forceinline__ int lds_byte(int r, int c) { const int st = (r >> 4) * 2 + (c >> 5), rr = r & 15, cc = c & 31, ob = rr * 64 + cc * 2; return st * 1024 + (ob ^ (((ob >> 9) & 1) << 5)); }
__host__ __device__ __forceinline__ void stage_rc(int b, int& R, int& C) { const int st = b / 1024, sb = b % 1024, swz = sb ^ (((sb >> 9) & 1) << 5); R = (st >> 1) * 16 + swz / 64; C = (st & 1) * 32 + (swz % 64) / 2; }
__host__ __device__ __forceinline__ int perm32(int rho) { const int n = rho >> 4, i = rho & 15; return 8 * (i >> 2) + 4 * n + (i & 3); }

struct Unit { int pm, pn; };
struct Gemm { const bf16_t* A; const bf16_t* Bt; int M, N, K; };

struct StaticOrder {
    int nM, nN, nwg, G, c;
    __host__ __device__ void init(int M, int N, int G_, int c_) { nM = M / BM; nN = N / BM; nwg = nM * nN; G = G_; c = c_; }
    __host__ __device__ bool next(int i, Unit& u) const {
        const long L = (long)i * G + c; if (L >= nwg) return false;
        int wgid = (int)L; { const int q = nwg / NXCD, r = nwg % NXCD, xcd = wgid % NXCD, off = wgid / NXCD; wgid = (xcd < r ? xcd * (q + 1) : r * (q + 1) + (xcd - r) * q) + off; }
        const int nig = WGM * nN, gid = wgid / nig, fm = gid * WGM, gsz = (nM - fm) < WGM ? (nM - fm) : WGM;
        u.pm = fm + ((wgid % nig) % gsz); u.pn = (wgid % nig) / gsz; return true;
    }
    __device__ __forceinline__ void a_ready(const Unit&) const {}
    __device__ __forceinline__ void done(const Unit&) const {}
};
__device__ __forceinline__ unsigned cvt_pk_bf16(float lo, float hi) { unsigned r; asm volatile("v_cvt_pk_bf16_f32 %0, %1, %2" : "=v"(r) : "v"(lo), "v"(hi)); return r; }

template <class Epi, class Sched, bool STAMP = false>
__device__ __forceinline__ void gemm_phase(PG8_LAS unsigned char* lds, const Gemm g, const Sched& S, const Epi& E, unsigned long long* stamps) {
    const int tid = ::tid_fresh(), wid = __builtin_amdgcn_readfirstlane(tid >> 6), lane = tid & 63, wr = wid >> 2, wc = wid & 3, fr = lane & 15, fq = lane >> 4;
    const int K = g.K, nt = K / BK;
    int ts_lo = 0, ts_hi = 0, nts = 0; const unsigned long long rt_entry = STAMP ? (unsigned long long)wall_clock64() : 0ull;
#define PG8_STAMP() do { if (STAMP && wid == 0 && nts < 64) { const unsigned long long _c = (unsigned long long)clock64(); \
        ts_lo = (lane == nts) ? (int)(unsigned)_c : ts_lo; ts_hi = (lane == nts) ? (int)(unsigned)(_c >> 32) : ts_hi; ++nts; } } while (0)
    PG8_STAMP();
    unsigned voffA[2], voffB[2];
#pragma unroll
    for (int i = 0; i < 2; ++i) { int R, C; stage_rc(tid * 16 + i * 8192, R, C); const int Rb = Epi::PERM ? ((R & ~31) + perm32(R & 31)) : R;
        voffA[i] = (unsigned)(R * K + C) * 2u; voffB[i] = (unsigned)(Rb * K + C) * 2u; }
    const size_t kstep = (size_t)(BK * 2);
    const size_t hstep = (size_t)HALF * K * 2;
    const size_t tstep = 2 * hstep;
    const unsigned ldsw = (unsigned)wid * 1024u;
    const int aoff = lds_byte(wr * 64 + fr, fq * 8), boff = lds_byte(wc * 32 + fr, fq * 8);
#define PG8_SA(b, h) (((b) * 2 + (h)) * HTB)
#define PG8_SB(b, h) ((4 + (b) * 2 + (h)) * HTB)
#define PG8_STAGE(bufoff, gbase, voff) do { _Pragma("unroll") for (int _i = 0; _i < 2; ++_i) \
        __builtin_amdgcn_global_load_lds((const unsigned*)((const char*)(gbase) + (voff)[_i]), (PG8_LAS unsigned*)(lds + (bufoff) + ldsw + _i * 8192), 16, 0, 0); } while (0)
#define PG8_LDA(dst, b, h) do { _Pragma("unroll") for (int m = 0; m < 4; ++m) _Pragma("unroll") for (int k = 0; k < 2; ++k) dst[m][k] = *(const PG8_LAS bf16x8*)(lds + PG8_SA(b, h) + aoff + m * 2048 + k * 1024); } while (0)
#define PG8_LDB(dst, b, h) do { _Pragma("unroll") for (int n = 0; n < 2; ++n) _Pragma("unroll") for (int k = 0; k < 2; ++k) dst[n][k] = *(const PG8_LAS bf16x8*)(lds + PG8_SB(b, h) + boff + n * 2048 + k * 1024); } while (0)
#define PG8_MMA(ai, bj, At, Bt) do { __builtin_amdgcn_s_setprio(1); _Pragma("unroll") for (int m = 0; m < 4; ++m) _Pragma("unroll") for (int n = 0; n < 2; ++n) _Pragma("unroll") for (int k = 0; k < 2; ++k) \
        acc[ai][bj][m][n] = __builtin_amdgcn_mfma_f32_16x16x32_bf16(Bt[n][k], At[m][k], acc[ai][bj][m][n], 0, 0, 0); __builtin_amdgcn_s_setprio(0); } while (0)
#define PG8_WAIT_V(n) asm volatile("s_waitcnt vmcnt(" #n ")" ::: "memory")
#define PG8_WAIT_L(n) asm volatile("s_waitcnt lgkmcnt(" #n ")" ::: "memory")
#define PG8_BAR __builtin_amdgcn_s_barrier()
#define PG8_SCHED __builtin_amdgcn_sched_barrier(0)
    Unit cur, nxt; int ui = 0;
    if (!S.next(0, cur)) return;
    f32x4 acc[2][2][4][2];
#pragma unroll
    for (int a = 0; a < 2; ++a)
#pragma unroll
        for (int b = 0; b < 2; ++b)
#pragma unroll
            for (int m = 0; m < 4; ++m)
#pragma unroll
                for (int n = 0; n < 2; ++n) acc[a][b][m][n] = (f32x4){0.f, 0.f, 0.f, 0.f};
    bf16x8 At[4][2], B0[2][2], B1[2][2];
    const char* cA = (const char*)g.A + (size_t)cur.pm * tstep; const char* cB = (const char*)g.Bt + (size_t)cur.pn * tstep;
    S.a_ready(cur);
    PG8_STAGE(PG8_SB(0, 0), cB, voffB); PG8_STAGE(PG8_SA(0, 0), cA, voffA); PG8_STAGE(PG8_SB(0, 1), cB + hstep, voffB); PG8_STAGE(PG8_SA(0, 1), cA + hstep, voffA);
    if (wr == 1) PG8_BAR;
    PG8_WAIT_V(4); PG8_BAR;
    PG8_STAGE(PG8_SB(1, 0), cB + kstep, voffB); PG8_STAGE(PG8_SA(1, 0), cA + kstep, voffA); PG8_STAGE(PG8_SB(1, 1), cB + hstep + kstep, voffB);
    PG8_WAIT_V(6); PG8_BAR;
    PG8_STAMP();
    for (;;) {
        const bool has_next = S.next(ui + 1, nxt);
        const char* nA = has_next ? (const char*)g.A + (size_t)nxt.pm * tstep : cA; const char* nB = has_next ? (const char*)g.Bt + (size_t)nxt.pn * tstep : cB;
        for (int t = 0; t < nt; t += 2) {
            const bool last = (t == nt - 2);
            const char* a1 = cA + (size_t)(t + 1) * kstep;
            const char* a2 = last ? nA : cA + (size_t)(t + 2) * kstep; const char* b2 = last ? nB : cB + (size_t)(t + 2) * kstep;
            const char* a3 = a2 + kstep; const char* b3 = b2 + kstep;
            if (last && has_next) S.a_ready(nxt);
            PG8_LDB(B0, 0, 0); PG8_SCHED; PG8_LDA(At, 0, 0); PG8_STAGE(PG8_SA(1, 1), a1 + hstep, voffA);
            PG8_WAIT_L(8); PG8_BAR; PG8_WAIT_L(0); PG8_MMA(0, 0, At, B0); PG8_BAR; PG8_SCHED;
            PG8_LDB(B1, 0, 1); PG8_STAGE(PG8_SB(0, 0), b2, voffB);
            PG8_BAR; PG8_WAIT_L(0); PG8_MMA(0, 1, At, B1); PG8_BAR;
            PG8_LDA(At, 0, 1); PG8_STAGE(PG8_SA(0, 0), a2, voffA);
            PG8_BAR; PG8_WAIT_L(0); PG8_MMA(1, 0, At, B0); PG8_BAR; PG8_SCHED;
            PG8_STAGE(PG8_SB(0, 1), b2 + hstep, voffB);
            PG8_WAIT_V(6); PG8_BAR; PG8_MMA(1, 1, At, B1); PG8_BAR;
            PG8_LDB(B0, 1, 0); PG8_SCHED; PG8_LDA(At, 1, 0); PG8_STAGE(PG8_SA(0, 1), a2 + hstep, voffA);
            PG8_WAIT_L(8); PG8_BAR; PG8_WAIT_L(0); PG8_MMA(0, 0, At, B0); PG8_BAR; PG8_SCHED;
            PG8_LDB(B1, 1, 1); PG8_STAGE(PG8_SB(1, 0), b3, voffB);
            PG8_BAR; PG8_WAIT_L(0); PG8_MMA(0, 1, At, B1); PG8_BAR;
            PG8_LDA(At, 1, 1); PG8_STAGE(PG8_SA(1, 0), a3, voffA);
            PG8_BAR; PG8_WAIT_L(0); PG8_MMA(1, 0, At, B0); PG8_BAR; PG8_SCHED;
            PG8_STAGE(PG8_SB(1, 1), b3 + hstep, voffB);
            PG8_WAIT_V(6); PG8_BAR; PG8_MMA(1, 1, At, B1); PG8_BAR;
        }
        PG8_STAMP();
        if constexpr (!Epi::AFTER_DRAIN) { E(acc, cur, wr, wc, fr, fq); S.done(cur); }
        PG8_STAMP();
        if (!has_next) break;
#pragma unroll
        for (int a = 0; a < 2; ++a)
#pragma unroll
            for (int b = 0; b < 2; ++b)
#pragma unroll
                for (int m = 0; m < 4; ++m)
#pragma unroll
                    for (int n = 0; n < 2; ++n) acc[a][b][m][n] = (f32x4){0.f, 0.f, 0.f, 0.f};
        cur = nxt; cA = nA; cB = nB; ++ui;
    }
    PG8_WAIT_V(0);
    if (wr == 0) PG8_BAR;
    PG8_BAR;
    if constexpr (Epi::AFTER_DRAIN) { E.fused(acc, cur, wr, wc, fr, fq, lds, wid, lane); S.done(cur); }
    PG8_STAMP();
    if (STAMP && wid == 0) { stamps[lane] = lane < nts ? (((unsigned long long)(unsigned)ts_hi << 32) | (unsigned)ts_lo) : 0ull;
        if (lane == 62) stamps[62] = rt_entry; if (lane == 63) stamps[63] = (unsigned long long)wall_clock64(); }
#undef PG8_STAMP
#undef PG8_SA
#undef PG8_SB
#undef PG8_STAGE
#undef PG8_LDA
#undef PG8_LDB
#undef PG8_MMA
#undef PG8_WAIT_V
#undef PG8_WAIT_L
#undef PG8_BAR
#undef PG8_SCHED
}
}
#define XB_TMO      128
#define XB_XCNT(j)  (256  + 64 * (j))
#define XB_XSUB(j)  (1280 + 64 * (j))
#define XB_XGEN(j)  (2304 + 64 * (j))
#define XB_TOP      3328
#define XB_TOPGEN   3392
#define XCD_BAR_WORDS 3456
#define XB_SPIN_CAP (1u << 18)

__device__ __forceinline__ unsigned xb_ld(unsigned* p)              { return __hip_atomic_load(p, __ATOMIC_RELAXED, __HIP_MEMORY_SCOPE_AGENT); }
__device__ __forceinline__ unsigned xb_add(unsigned* p, unsigned v) { return __hip_atomic_fetch_add(p, v, __ATOMIC_RELAXED, __HIP_MEMORY_SCOPE_AGENT); }
__device__ __forceinline__ unsigned xb_xcc_id() { return (unsigned)__builtin_amdgcn_s_getreg((3 << 11) | 20) & 0xFu; }
#define XB_SPIN(cond, bar) do { unsigned _sp = 0; while (cond) { __builtin_amdgcn_s_sleep(1); \
    if ((++_sp & 255u) == 0u) { if (xb_ld(&(bar)[XB_TMO])) break; if (_sp > XB_SPIN_CAP) { atomicAdd(&(bar)[XB_TMO], 1u); break; } } } } while (0)

struct XcdBarrier {
    unsigned* bar; unsigned x;
    volatile LAS unsigned* st;
};

__device__ __forceinline__ XcdBarrier xcd_barrier_post(unsigned* bar, volatile LAS unsigned* st) {
    XcdBarrier b; b.bar = bar; b.x = xb_xcc_id(); b.st = st;
    if (threadIdx.x == 0) (void)xb_add(&bar[XB_XCNT(b.x)], 1u);
    return b;
}
__device__ __forceinline__ void xcd_barrier_complete(unsigned* bar, unsigned x, unsigned& nloc, unsigned& nx) {
    const unsigned G = gridDim.x * gridDim.y * gridDim.z;
    unsigned sum, cnt, mine, sp = 0u;
    for (;;) {
        sum = 0u; cnt = 0u; mine = 0u;
#pragma unroll
        for (unsigned j = 0; j < 16; ++j) { const unsigned c = xb_ld(&bar[XB_XCNT(j)]); sum += c; cnt += (c > 0u) ? 1u : 0u; mine = (j == x) ? c : mine; }
        if (sum == G) break;
        __builtin_amdgcn_s_sleep(1);
        if ((++sp & 255u) == 0u) { if (xb_ld(&bar[XB_TMO])) break; if (sp > XB_SPIN_CAP) { atomicAdd(&bar[XB_TMO], 1u); break; } }
    }
    nloc = mine > 0u ? mine : 1u; nx = cnt > 0u ? cnt : 1u;
}

__device__ __forceinline__ void xcd_barrier(const XcdBarrier& b) {
    asm volatile("s_waitcnt vmcnt(0)" ::: "memory");
    __syncthreads();
    if (threadIdx.x == 0) {
        unsigned* bar = b.bar;
        __builtin_amdgcn_s_waitcnt(0);
        unsigned nloc = b.st[0], nx = b.st[1];
        if (nloc == 0u) { xcd_barrier_complete(bar, b.x, nloc, nx); b.st[0] = nloc; b.st[1] = nx; }
        const unsigned old = xb_add(&bar[XB_XSUB(b.x)], 1u);
        const unsigned gen = old / nloc;
        if (old + 1u == (gen + 1u) * nloc) {
            __builtin_amdgcn_fence(__ATOMIC_RELEASE, "agent");
            asm volatile("s_waitcnt vmcnt(0)" ::: "memory");
            const unsigned og = xb_add(&bar[XB_TOP], 1u);
            const unsigned tg = og / nx;
            if (og + 1u == (tg + 1u) * nx) xb_add(&bar[XB_TOPGEN], 1u);
            else XB_SPIN(xb_ld(&bar[XB_TOPGEN]) == tg, bar);
            __builtin_amdgcn_fence(__ATOMIC_ACQUIRE, "agent");
            xb_add(&bar[XB_XGEN(b.x)], 1u);
            asm volatile("s_waitcnt vmcnt(0)" ::: "memory");
        } else {
            XB_SPIN(xb_ld(&bar[XB_XGEN(b.x)]) == gen, bar);
            __builtin_amdgcn_fence(__ATOMIC_ACQUIRE, "agent");
            asm volatile("s_waitcnt vmcnt(0)" ::: "memory");
        }
    }
    __syncthreads();
}

__device__ __forceinline__ void ph_mod(const P& p, const float* X, const float* g, int shift_off, int scale_off, bf16* H, int bid, int nb) {
  const float* ada = (const float*)(p.ws + OFF_ADA);
  const int tidm = tid_fresh(); int wave = tidm >> 6, lane = tidm & 63;
  const int rstride = nb * (int)(blockDim.x >> 6);
  int row = bid * (int)(blockDim.x >> 6) + wave;
  float4 v[4];
  if (row < TT) {
    const float4* xr = (const float4*)(X + (size_t)row * DM);
#pragma unroll
    for (int i = 0; i < 4; ++i) v[i] = xr[lane + i * 64];
  }
  for (; row < TT; row += rstride) {
    float4 vn[4];
    const int nrow = row + rstride;
    {
      const float4* xn = (const float4*)(X + (size_t)((nrow < TT) ? nrow : row) * DM);
#pragma unroll
      for (int i = 0; i < 4; ++i) vn[i] = xn[lane + i * 64];
    }
    float ss = 0.f;
#pragma unroll
    for (int i = 0; i < 4; ++i) ss += v[i].x * v[i].x + v[i].y * v[i].y + v[i].z * v[i].z + v[i].w * v[i].w;
    ss = wave_sum(ss);
    float rstd = rsqrtf(ss * (1.f / DM) + 1e-6f);
    int b = row >> 12;
    const float* sh = ada + b * 6144 + shift_off;
    const float* sc = ada + b * 6144 + scale_off;
#pragma unroll
    for (int i = 0; i < 4; ++i) {
      int c0 = (lane + i * 64) * 4;
      float4 gg = *(const float4*)(g + c0);
      float4 s4 = *(const float4*)(sc + c0);
      float4 h4 = *(const float4*)(sh + c0);
      ushort4 o;
      o.x = f2bf(v[i].x * rstd * gg.x * (1.f + s4.x) + h4.x);
      o.y = f2bf(v[i].y * rstd * gg.y * (1.f + s4.y) + h4.y);
      o.z = f2bf(v[i].z * rstd * gg.z * (1.f + s4.z) + h4.z);
      o.w = f2bf(v[i].w * rstd * gg.w * (1.f + s4.w) + h4.w);
      *(ushort4*)(H + (size_t)row * DM + c0) = o;
    }
#pragma unroll
    for (int i = 0; i < 4; ++i) v[i] = vn[i];
  }
}

using pg8::f32x4;
using pg8::u32x4;
using pg8::Unit;
using pg8::cvt_pk_bf16;
typedef short s16x4_t __attribute__((ext_vector_type(4)));
typedef unsigned u32x4_t __attribute__((ext_vector_type(4)));
typedef unsigned short u16x4_t __attribute__((ext_vector_type(4)));

__device__ __forceinline__ int in_srcmap(int d) {
  if (d < 2048) return d;
  if (d < 3072) return 3088 + (d - 2048);
  if (d < 3328) return 4112 + (d - 3072);
  if (d < 3840) return 4368 + (d - 3328);
  if (d < 3904) return 4880 + (d - 3840);
  if (d < 3912) return 4944 + (d - 3904);
  if (d < 3928) return 3072 + (d - 3912);
  if (d < 4096) return -1;
  if (d < 5120) return 2048 + (d - 4096);
  return 4952 + (d - 5120);
}
template <bool MAP>
__device__ __forceinline__ void transpose_item(const float* W, int ldw, int K, bf16* WT, int item, int nblk, float* scr, int lane) {
  const int kb = item / nblk, nbk = item % nblk, k0 = 64 * kb, n0 = 32 * nbk;
  const int d = n0 + (lane & 31);
  const int src = MAP ? in_srcmap(d) : d;
#pragma unroll 8
  for (int i = 0; i < 32; ++i) {
    const int kk = 2 * i + (lane >> 5);
    scr[kk * 33 + (lane & 31)] = (src >= 0) ? W[(size_t)(k0 + kk) * ldw + src] : 0.f;
  }
  asm volatile("s_waitcnt lgkmcnt(0)" ::: "memory");
  const int c = lane & 7;
#pragma unroll
  for (int j = 0; j < 4; ++j) {
    const int n = (lane >> 3) + 8 * j;
    const float* s = scr + (8 * c) * 33 + n;
    uint4 o;
    o.x = pk2(s[0 * 33], s[1 * 33]); o.y = pk2(s[2 * 33], s[3 * 33]); o.z = pk2(s[4 * 33], s[5 * 33]); o.w = pk2(s[6 * 33], s[7 * 33]);
    *(uint4*)(WT + (size_t)(n0 + n) * K + k0 + 8 * c) = o;
  }
  asm volatile("s_waitcnt lgkmcnt(0)" ::: "memory");
}

__device__ __forceinline__ void ph_prep(const P& p, float* sm) {
  const int tid = tid_fresh(), wave = tid >> 6, lane = tid & 63;
  const int bid = blockIdx.x, nb = gridDim.x;
  float* silc = sm + 8 * 2112 + 64;
  float* red = silc + 8192;
  float* ada = (float*)(p.ws + OFF_ADA);
  if (bid < 192) {
    for (int i = tid; i < 8192; i += 512) silc[i] = siluf_(p.c[i]);
    __syncthreads();
    for (int it = bid; it < 192; it += nb) {
      const int kg = tid >> 5, cn = tid & 31, n = it * 32 + cn;
      float acc[8];
#pragma unroll
      for (int b = 0; b < 8; ++b) acc[b] = 0.f;
      for (int k = kg * 64; k < kg * 64 + 64; ++k) {
        const float w = p.w_ada[(size_t)k * 6144 + n];
#pragma unroll
        for (int b = 0; b < 8; ++b) acc[b] += silc[b * 1024 + k] * w;
      }
#pragma unroll
      for (int b = 0; b < 8; ++b) red[(kg * 8 + b) * 32 + cn] = acc[b];
      __syncthreads();
      if (tid < 256) {
        const int b = tid >> 5, c2 = tid & 31;
        float s = 0.f;
#pragma unroll
        for (int g = 0; g < 16; ++g) s += red[(g * 8 + b) * 32 + c2];
        ada[b * 6144 + it * 32 + c2] = s + p.b_ada[it * 32 + c2];
      }
      __syncthreads();
    }
  }
  {
    unsigned char* PU8 = (unsigned char*)(p.ws + OFF_PU);
    unsigned char* PV8 = (unsigned char*)(p.ws + OFF_PV);
    float* PSC = (float*)(p.ws + OFF_PSC);
    for (int row = bid * 8 + wave; row < 2 * 16384; row += nb * 8) {
      const float* src = (row < 16384 ? p.peer_u : p.peer_v) + (size_t)(row & 16383) * 1024 + lane * 16;
      f32x4 v[4];
      float mx = 0.f;
#pragma unroll
      for (int q = 0; q < 4; ++q) {
        v[q] = *(const f32x4*)(src + q * 4);
        mx = fmaxf(mx, fmaxf(fmaxf(fabsf(v[q][0]), fabsf(v[q][1])), fmaxf(fabsf(v[q][2]), fabsf(v[q][3]))));
      }
      mx = wave_max(mx);
      const float sc = (mx > 0.f) ? exp2f(floorf(log2f(448.f / mx))) : 1.f;
      u32x4 o;
#pragma unroll
      for (int q = 0; q < 4; ++q) {
        int w = __builtin_amdgcn_cvt_pk_fp8_f32(v[q][0] * sc, v[q][1] * sc, 0, false);
        w = __builtin_amdgcn_cvt_pk_fp8_f32(v[q][2] * sc, v[q][3] * sc, w, true);
        o[q] = (unsigned)w;
      }
      *(u32x4*)((row < 16384 ? PU8 : PV8) + (size_t)(row & 16383) * 1024 + lane * 16) = o;
      if (lane == 0) PSC[row] = 1.f / sc;
    }
    for (int i = bid * 512 + tid; i < 2 * 2048; i += nb * 512) {
      const float* src = (i < 2048) ? p.sk1 : p.sk2;
      const int j = i & 2047;
      const float4 v0 = *(const float4*)(src + j * 8), v1 = *(const float4*)(src + j * 8 + 4);
      uint4 o; o.x = pk2(v0.x, v0.y); o.y = pk2(v0.z, v0.w); o.z = pk2(v1.x, v1.y); o.w = pk2(v1.z, v1.w);
      *(uint4*)((bf16*)(p.ws + OFF_SK) + (size_t)i * 8) = o;
    }
  }
  {
    float* prm = (float*)(p.ws + OFF_PRM);
    for (int i = bid * 512 + tid; i < PRM_TOTAL; i += nb * 512) {
      float v;
      if (i < PRM_BG) v = p.w_gate_up[i];
      else if (i < PRM_GNG) v = p.b_gate[i - PRM_BG];
      else if (i < PRM_N2G) v = p.gla_norm_g[i - PRM_GNG];
      else if (i < PRM_FG) v = p.norm2_g[i - PRM_N2G];
      else v = p.final_g[i - PRM_FG];
      prm[i] = v;
    }
  }
  {
    bf16* WUK = (bf16*)(p.ws + OFF_WUK);
    bf16* WUV = (bf16*)(p.ws + OFF_WUV);
    for (int i = bid * 512 + tid; i < 2 * 262144; i += nb * 512) {
      if (i < 262144) {
        const int d = i & 127, cc = (i >> 7) & 255, h = i >> 15;
        WUK[i] = f2bf(p.w_uk[((size_t)h * 128 + d) * 256 + cc] * p.kv_norm_g[cc] * 0.08838834764831845f);
      } else {
        const int k = i - 262144;
        const int cc = k & 255, d = (k >> 8) & 127, h = k >> 15;
        WUV[k] = f2bf(p.w_uv[((size_t)h * 256 + cc) * 128 + d] * p.kv_norm_g[cc]);
      }
    }
  }
  float* scr = sm + wave * 2112;
  const int gw = bid * 8 + wave, ngw = nb * 8;
  constexpr int I_IN = 16 * 224, I_SQ = 16 * 32, I_Q = 16 * 64;
  for (int it = gw; it < I_IN + 3 * I_SQ + I_Q; it += ngw) {
    int r = it;
    if (r < I_IN) { transpose_item<true>(p.w_in, NIN, 1024, (bf16*)(p.ws + OFF_WT_IN), r, 224, scr, lane); continue; }
    r -= I_IN;
    if (r < I_SQ) { transpose_item<false>(p.w_a, 1024, 1024, (bf16*)(p.ws + OFF_WT_A), r, 32, scr, lane); continue; }
    r -= I_SQ;
    if (r < I_SQ) { transpose_item<false>(p.w_b, 1024, 1024, (bf16*)(p.ws + OFF_WT_B), r, 32, scr, lane); continue; }
    r -= I_SQ;
    if (r < I_SQ) { transpose_item<false>(p.w_out, 1024, 1024, (bf16*)(p.ws + OFF_WT_OUT), r, 32, scr, lane); continue; }
    r -= I_SQ;
    transpose_item<false>(p.w_q, 2048, 1024, (bf16*)(p.ws + OFF_WT_Q), r, 64, scr, lane);
  }
}


struct EpiIn {
  static constexpr bool PERM = true, AFTER_DRAIN = false;
  char* ws; float* out;
  __device__ __forceinline__ void operator()(const f32x4 (&acc)[2][2][4][2], const Unit& u, int wr, int wc, int fr, int fq) const {
    const int pn = u.pn;
    const int row0 = u.pm * 256 + wr * 64 + fr, cl0 = wc * 32 + 8 * fq;
    if (pn == 12) {
      bf16* dst = (bf16*)(ws + OFF_CKV);
      float* ssp = (float*)(ws + OFF_SSP);
#pragma unroll
      for (int ai = 0; ai < 2; ++ai)
#pragma unroll
        for (int m = 0; m < 4; ++m) {
          const size_t row = row0 + ai * 128 + m * 16;
          float ss = 0.f;
#pragma unroll
          for (int bj = 0; bj < 2; ++bj) {
            const f32x4 v0 = acc[ai][bj][m][0], v1 = acc[ai][bj][m][1];
            ss += (v0[0] * v0[0] + v0[1] * v0[1]) + (v0[2] * v0[2] + v0[3] * v0[3]) + (v1[0] * v1[0] + v1[1] * v1[1]) + (v1[2] * v1[2] + v1[3] * v1[3]);
            u32x4 w; w.x = cvt_pk_bf16(v0[0], v0[1]); w.y = cvt_pk_bf16(v0[2], v0[3]); w.z = cvt_pk_bf16(v1[0], v1[1]); w.w = cvt_pk_bf16(v1[2], v1[3]);
            *(u32x4*)(dst + row * 256 + cl0 + bj * 128) = w;
          }
          ss += __shfl_xor(ss, 16); ss += __shfl_xor(ss, 32);
          if (fq == 0) ssp[row * 4 + wc] = ss;
        }
    } else if (pn == 15) {
      bf16* IK = (bf16*)(ws + OFF_IK);
      float* IW = (float*)(ws + OFF_IW);
      float* GLOW = (float*)(ws + OFF_GLOW);
#pragma unroll
      for (int ai = 0; ai < 2; ++ai)
#pragma unroll
        for (int m = 0; m < 4; ++m) {
          const size_t row = row0 + ai * 128 + m * 16;
          const int cl = cl0;
          const f32x4 v0 = acc[ai][0][m][0], v1 = acc[ai][0][m][1];
          if (cl < 64) {
            u32x4 w; w.x = cvt_pk_bf16(v0[0], v0[1]); w.y = cvt_pk_bf16(v0[2], v0[3]); w.z = cvt_pk_bf16(v1[0], v1[1]); w.w = cvt_pk_bf16(v1[2], v1[3]);
            *(u32x4*)(IK + row * 64 + cl) = w;
          } else if (cl < 72) {
            *(f32x4*)(IW + row * 8) = v0 * 0.35355339059327373f;
            *(f32x4*)(IW + row * 8 + 4) = v1 * 0.35355339059327373f;
          } else if (cl < 88) {
            *(f32x4*)(GLOW + row * 16 + (cl - 72)) = v0;
            *(f32x4*)(GLOW + row * 16 + (cl - 72) + 4) = v1;
          }
        }
    } else {
      bf16* dst; int ld; float scale = 1.f; int act = 0; int coff;
      if (pn < 2) { dst = (bf16*)(ws + OFF_Q); ld = 512; coff = pn * 256; scale = 0.08838834764831845f; }
      else if (pn < 4) { dst = (bf16*)(ws + OFF_K); ld = 512; coff = (pn - 2) * 256; }
      else if (pn < 8) { dst = (bf16*)(ws + OFF_V); ld = 1024; coff = (pn - 4) * 256; }
      else if (pn < 12) { dst = (bf16*)(ws + OFF_DQ); ld = 1024; coff = (pn - 8) * 256; }
      else if (pn < 15) { dst = (bf16*)(ws + OFF_IQ); ld = 512; coff = (pn - 13) * 256; scale = 0.125f; }
      else if (pn < 20) { dst = (bf16*)(ws + OFF_SGR); ld = 1024; coff = (pn - 16) * 256; act = 1; }
      else if (pn < 24) { dst = (bf16*)out; ld = 1024; coff = (pn - 20) * 256; act = 2; }
      else { dst = (bf16*)out + (size_t)TT * 1024; ld = 1024; coff = (pn - 24) * 256; act = 2; }
#pragma unroll
      for (int ai = 0; ai < 2; ++ai)
#pragma unroll
        for (int m = 0; m < 4; ++m) {
          bf16* rowp = dst + (size_t)(row0 + ai * 128 + m * 16) * ld + coff + cl0;
#pragma unroll
          for (int bj = 0; bj < 2; ++bj) {
            f32x4 v0 = acc[ai][bj][m][0] * scale, v1 = acc[ai][bj][m][1] * scale;
            if (act == 1) {
#pragma unroll
              for (int j = 0; j < 4; ++j) { v0[j] = siluf_(v0[j]); v1[j] = siluf_(v1[j]); }
            } else if (act == 2) {
#pragma unroll
              for (int j = 0; j < 4; ++j) { v0[j] = sigmoidf_(v0[j]); v1[j] = sigmoidf_(v1[j]); }
            }
            u32x4 w; w.x = cvt_pk_bf16(v0[0], v0[1]); w.y = cvt_pk_bf16(v0[2], v0[3]); w.z = cvt_pk_bf16(v1[0], v1[1]); w.w = cvt_pk_bf16(v1[2], v1[3]);
            *(u32x4*)(rowp + bj * 128) = w;
          }
        }
    }
  }
};

template <bool ADD> struct EpiMix {
  static constexpr bool PERM = true, AFTER_DRAIN = false;
  const bf16* SZ; bf16* MIX;
  __device__ __forceinline__ void operator()(const f32x4 (&acc)[2][2][4][2], const Unit& u, int wr, int wc, int fr, int fq) const {
    const int row0 = u.pm * 256 + wr * 64 + fr, col0 = u.pn * 256 + wc * 32 + 8 * fq;
    u32x4 sc[2], oc[2], sn[2], on[2];
    {
      const size_t idx = (size_t)row0 * 1024 + col0;
      sc[0] = *(const u32x4*)(SZ + idx); sc[1] = *(const u32x4*)(SZ + idx + 128);
      if (ADD) { oc[0] = *(const u32x4*)(MIX + idx); oc[1] = *(const u32x4*)(MIX + idx + 128); }
    }
#pragma unroll
    for (int s = 0; s < 8; ++s) {
      const int ai = s >> 2, m = s & 3;
      const size_t idx = (size_t)(row0 + ai * 128 + m * 16) * 1024 + col0;
      if (s < 7) {
        const int ai2 = (s + 1) >> 2, m2 = (s + 1) & 3;
        const size_t idn = (size_t)(row0 + ai2 * 128 + m2 * 16) * 1024 + col0;
        sn[0] = *(const u32x4*)(SZ + idn); sn[1] = *(const u32x4*)(SZ + idn + 128);
        if (ADD) { on[0] = *(const u32x4*)(MIX + idn); on[1] = *(const u32x4*)(MIX + idn + 128); }
      }
#pragma unroll
      for (int bj = 0; bj < 2; ++bj) {
        const u32x4 sv = sc[bj];
        f32x4 v0 = acc[ai][bj][m][0], v1 = acc[ai][bj][m][1];
        v0[0] *= bflo(sv.x); v0[1] *= bfhi(sv.x); v0[2] *= bflo(sv.y); v0[3] *= bfhi(sv.y);
        v1[0] *= bflo(sv.z); v1[1] *= bfhi(sv.z); v1[2] *= bflo(sv.w); v1[3] *= bfhi(sv.w);
        if (ADD) {
          const u32x4 o = oc[bj];
          v0[0] += bflo(o.x); v0[1] += bfhi(o.x); v0[2] += bflo(o.y); v0[3] += bfhi(o.y);
          v1[0] += bflo(o.z); v1[1] += bfhi(o.z); v1[2] += bflo(o.w); v1[3] += bfhi(o.w);
        }
        u32x4 w; w.x = cvt_pk_bf16(v0[0], v0[1]); w.y = cvt_pk_bf16(v0[2], v0[3]); w.z = cvt_pk_bf16(v1[0], v1[1]); w.w = cvt_pk_bf16(v1[2], v1[3]);
        *(u32x4*)(MIX + idx + bj * 128) = w;
      }
      if (s < 7) { sc[0] = sn[0]; sc[1] = sn[1]; if (ADD) { oc[0] = on[0]; oc[1] = on[1]; } }
    }
  }
};

struct EpiX1 {
  static constexpr bool PERM = true, AFTER_DRAIN = false;
  const float* x; const float* ada; float* out;
  __device__ __forceinline__ void operator()(const f32x4 (&acc)[2][2][4][2], const Unit& u, int wr, int wc, int fr, int fq) const {
    const int row0 = u.pm * 256 + wr * 64 + fr, col0 = u.pn * 256 + wc * 32 + 8 * fq;
    const int b = (u.pm * 256) >> 12;
    f32x4 g[2][2];
#pragma unroll
    for (int bj = 0; bj < 2; ++bj) {
      g[bj][0] = *(const f32x4*)(ada + b * 6144 + 2048 + col0 + bj * 128);
      g[bj][1] = *(const f32x4*)(ada + b * 6144 + 2048 + col0 + bj * 128 + 4);
    }
    f32x4 xc[4], xn[4];
    {
      const size_t idx = (size_t)row0 * 1024 + col0;
      xc[0] = *(const f32x4*)(x + idx); xc[1] = *(const f32x4*)(x + idx + 4);
      xc[2] = *(const f32x4*)(x + idx + 128); xc[3] = *(const f32x4*)(x + idx + 132);
    }
#pragma unroll
    for (int s = 0; s < 8; ++s) {
      const int ai = s >> 2, m = s & 3;
      const size_t idx = (size_t)(row0 + ai * 128 + m * 16) * 1024 + col0;
      if (s < 7) {
        const int ai2 = (s + 1) >> 2, m2 = (s + 1) & 3;
        const size_t idn = (size_t)(row0 + ai2 * 128 + m2 * 16) * 1024 + col0;
        xn[0] = *(const f32x4*)(x + idn); xn[1] = *(const f32x4*)(x + idn + 4);
        xn[2] = *(const f32x4*)(x + idn + 128); xn[3] = *(const f32x4*)(x + idn + 132);
      }
#pragma unroll
      for (int bj = 0; bj < 2; ++bj) {
        *(f32x4*)(out + idx + bj * 128) = xc[2 * bj] + g[bj][0] * acc[ai][bj][m][0];
        *(f32x4*)(out + idx + bj * 128 + 4) = xc[2 * bj + 1] + g[bj][1] * acc[ai][bj][m][1];
      }
      if (s < 7) { xc[0] = xn[0]; xc[1] = xn[1]; xc[2] = xn[2]; xc[3] = xn[3]; }
    }
  }
};

struct EpiPlain {
  static constexpr bool PERM = true, AFTER_DRAIN = false;
  bf16* O; int ld;
  __device__ __forceinline__ void operator()(const f32x4 (&acc)[2][2][4][2], const Unit& u, int wr, int wc, int fr, int fq) const {
    const int row0 = u.pm * 256 + wr * 64 + fr, col0 = u.pn * 256 + wc * 32 + 8 * fq;
#pragma unroll
    for (int ai = 0; ai < 2; ++ai)
#pragma unroll
      for (int m = 0; m < 4; ++m)
#pragma unroll
        for (int bj = 0; bj < 2; ++bj) {
          const f32x4 v0 = acc[ai][bj][m][0], v1 = acc[ai][bj][m][1];
          u32x4 w; w.x = cvt_pk_bf16(v0[0], v0[1]); w.y = cvt_pk_bf16(v0[2], v0[3]); w.z = cvt_pk_bf16(v1[0], v1[1]); w.w = cvt_pk_bf16(v1[2], v1[3]);
          *(u32x4*)(O + (size_t)(row0 + ai * 128 + m * 16) * ld + col0 + bj * 128) = w;
        }
  }
};

template <class Epi>
__device__ __forceinline__ void gemm_run(LAS unsigned char* lds, const bf16* A, const bf16* Bt, int M, int N, int K, const Epi& E) {
  pg8::Gemm g{A, Bt, M, N, K};
  pg8::StaticOrder S;
  S.init(M, N, gridDim.x, blockIdx.x);
  pg8::gemm_phase<Epi, pg8::StaticOrder, false>(lds, g, S, E, nullptr);
}

typedef short bf16x8_t __attribute__((ext_vector_type(8)));
typedef __bf16 bf16x2_t __attribute__((ext_vector_type(2)));
__device__ __forceinline__ float dot2bf(unsigned a, unsigned b, float acc) {
  return __builtin_amdgcn_fdot2_f32_bf16(__builtin_bit_cast(bf16x2_t, a), __builtin_bit_cast(bf16x2_t, b), acc, false);
}
__device__ __forceinline__ void wave_lds_fence() { asm volatile("s_waitcnt lgkmcnt(0)" ::: "memory"); }
template <int N> __device__ __forceinline__ float row_ror(float x) {
  return __int_as_float(__builtin_amdgcn_update_dpp(0, __float_as_int(x), 0x120 + N, 0xf, 0xf, false));
}
__device__ __forceinline__ float row16_max(float m) {
  m = fmaxf(m, row_ror<8>(m)); m = fmaxf(m, row_ror<4>(m)); m = fmaxf(m, row_ror<2>(m)); m = fmaxf(m, row_ror<1>(m));
  return m;
}
__device__ __forceinline__ float row16_sum(float m) {
  m += row_ror<8>(m); m += row_ror<4>(m); m += row_ror<2>(m); m += row_ror<1>(m);
  return m;
}
__device__ __forceinline__ float wave_sum_dpp(float s) {
  s = row16_sum(s);
  const int si = __float_as_int(s);
  return __int_as_float(__builtin_amdgcn_readlane(si, 0)) + __int_as_float(__builtin_amdgcn_readlane(si, 16)) +
         (__int_as_float(__builtin_amdgcn_readlane(si, 32)) + __int_as_float(__builtin_amdgcn_readlane(si, 48)));
}
__device__ __forceinline__ constexpr int cand_i(int L) {
  return L < 16 ? 0 : L < 24 ? 1 : L < 29 ? 2 : L < 33 ? 3 : L < 36 ? 4 : L < 38 ? 5 : L < 40 ? 6 : L < 42 ? 7 : (L - 42 + 8);
}
__device__ __forceinline__ constexpr int cand_j(int L) {
  return L < 16 ? L : L < 24 ? L - 16 : L < 29 ? L - 24 : L < 33 ? L - 29 : L < 36 ? L - 33 : L < 38 ? L - 36 : L < 40 ? L - 38 : L < 42 ? L - 40 : 0;
}
template <int K> struct CandRank {
  static __device__ __forceinline__ void run(int ki, unsigned key, int& rank) {
    const unsigned o = (unsigned)__builtin_amdgcn_readlane(ki, K);
    rank += (o > key) ? 1 : 0;
    CandRank<K + 1>::run(ki, key, rank);
  }
};
template <> struct CandRank<50> { static __device__ __forceinline__ void run(int, unsigned, int&) {} };
__device__ __forceinline__ unsigned peer_f2ord(float f) {
  if (f == 0.f) f = 0.f;
  const unsigned u = __float_as_uint(f);
  return (u & 0x80000000u) ? ~u : (u | 0x80000000u);
}
__device__ __forceinline__ float peer_ord2f(unsigned u) { return __uint_as_float((u & 0x80000000u) ? (u ^ 0x80000000u) : ~u); }
__device__ __forceinline__ unsigned umax3(unsigned a, unsigned b, unsigned c) { const unsigned t = a > b ? a : b; return t > c ? t : c; }
template <int N> __device__ __forceinline__ unsigned row_ror_u(unsigned x) {
  return (unsigned)__builtin_amdgcn_update_dpp(0, (int)x, 0x120 + N, 0xf, 0xf, false);
}
__device__ __forceinline__ unsigned row16_umax(unsigned m) {
  unsigned t;
  t = row_ror_u<8>(m); m = t > m ? t : m; t = row_ror_u<4>(m); m = t > m ? t : m;
  t = row_ror_u<2>(m); m = t > m ? t : m; t = row_ror_u<1>(m); m = t > m ? t : m;
  return m;
}
__device__ __forceinline__ float gelu_exact(float v) { return 0.5f * v * (1.f + erff(v * 0.7071067811865476f)); }

typedef float f32x2_t __attribute__((ext_vector_type(2)));
typedef unsigned peer_u32x2 __attribute__((ext_vector_type(2)));
__device__ __forceinline__ float peer_fold32(float a, float b) {
  const peer_u32x2 r = __builtin_amdgcn_permlane32_swap(__float_as_uint(a), __float_as_uint(b), false, false);
  return __uint_as_float(r.x) + __uint_as_float(r.y);
}
__device__ __forceinline__ float peer_fold16(float a, float b) {
  const peer_u32x2 r = __builtin_amdgcn_permlane16_swap(__float_as_uint(a), __float_as_uint(b), false, false);
  return __uint_as_float(r.x) + __uint_as_float(r.y);
}
#define PEER_NB 6
#define PEER_LOAD(buf, TAB, tk, e0)                                                               \
  _Pragma("unroll") for (int j = 0; j < PEER_NB; ++j) {                                                 \
    const int e = ((e0) + j < 128) ? __builtin_amdgcn_readfirstlane((int)ridx[(tk) * 128 + (e0) + j]) : 0;   \
    buf[j] = *(const u32x4_t*)((TAB) + (size_t)e * 1024 + lane * 16);                             \
  }
#define PEER_UDOT(buf, e0)                                                                        \
  {                                                                                               \
    float sp[6];                                                                                  \
    _Pragma("unroll") for (int j = 0; j < 6; ++j) {                                               \
      float s0 = 0.f, s1 = 0.f;                                                                   \
      _Pragma("unroll") for (int w = 0; w < 4; ++w) {                                             \
        const f32x2_t lo = __builtin_amdgcn_cvt_pk_f32_fp8((int)buf[j][w], false);                \
        const f32x2_t hi = __builtin_amdgcn_cvt_pk_f32_fp8((int)buf[j][w], true);                 \
        s0 = __builtin_fmaf(lo.x, hf[4 * w], s0); s1 = __builtin_fmaf(lo.y, hf[4 * w + 1], s1);   \
        s0 = __builtin_fmaf(hi.x, hf[4 * w + 2], s0); s1 = __builtin_fmaf(hi.y, hf[4 * w + 3], s1); \
      }                                                                                           \
      sp[j] = s0 + s1;                                                                            \
    }                                                                                             \
    const float u01 = peer_fold32(sp[0], sp[1]), u23 = peer_fold32(sp[2], sp[3]), u45 = peer_fold32(sp[4], sp[5]); \
    const float wq = row16_sum(peer_fold16(u01, u23));     \
    const float wr = row16_sum(peer_fold16(u45, u45));         \
    const int wqi = __float_as_int(wq), wri = __float_as_int(wr);                                 \
    PEER_PUT((e0) + 0, __builtin_amdgcn_readlane(wqi, 0));                                        \
    PEER_PUT((e0) + 1, __builtin_amdgcn_readlane(wqi, 32));                                       \
    PEER_PUT((e0) + 2, __builtin_amdgcn_readlane(wqi, 16));                                       \
    PEER_PUT((e0) + 3, __builtin_amdgcn_readlane(wqi, 48));                                       \
    PEER_PUT((e0) + 4, __builtin_amdgcn_readlane(wri, 0));                                        \
    PEER_PUT((e0) + 5, __builtin_amdgcn_readlane(wri, 32));                                       \
  }
#define PEER_PUT(ee_, vi_)                                                                        \
  {                                                                                               \
    const int ee = (ee_); const float sv = __int_as_float(vi_);                                   \
    const bool mine = (lane == (ee & 63));                                                        \
    dotA = (mine && ee < 64) ? sv : dotA;                                                         \
    dotB = (mine && ee >= 64 && ee < 128) ? sv : dotB;                                            \
  }
#define PEER_VACC(buf, e0)                                                                        \
  _Pragma("unroll") for (int j = 0; j < PEER_NB; ++j) {                                                 \
    const int ee = (e0) + j;                                                                      \
    const float a = (ee < 128) ? __int_as_float(__builtin_amdgcn_readlane(__float_as_int(ee < 64 ? aA : aB), ee & 63)) : 0.f; \
    _Pragma("unroll") for (int w = 0; w < 4; ++w) {                                               \
      const f32x2_t lo = __builtin_amdgcn_cvt_pk_f32_fp8((int)buf[j][w], false);                  \
      const f32x2_t hi = __builtin_amdgcn_cvt_pk_f32_fp8((int)buf[j][w], true);                   \
      acc[4 * w] += a * lo.x; acc[4 * w + 1] += a * lo.y; acc[4 * w + 2] += a * hi.x; acc[4 * w + 3] += a * hi.y; \
    }                                                                                             \
    __builtin_amdgcn_sched_barrier(0);                                                           \
  }

__device__ __forceinline__ void ph_peer512(const P& p, unsigned char* lds_raw, float* dst_base) {
  const int tid = tid_fresh(), wave = tid >> 6, lane = tid & 63, g = lane >> 4, c = lane & 15;
  const bf16* PQ = (const bf16*)(p.ws + OFF_PQ);
  const bf16* SK = (const bf16*)(p.ws + OFF_SK);
  float* tv = (float*)(lds_raw + wave * 16384);
  int* ti = (int*)(tv + 512);
  float* rgate = (float*)(ti + 512);
  unsigned short* ridx = (unsigned short*)(rgate + 2048);
  for (int tile = blockIdx.x * 8 + wave; tile < TT / 16; tile += gridDim.x * 8) {
    const int tok0 = tile * 16;
#pragma unroll 1
    for (int hd = 0; hd < 8; ++hd) {
#pragma unroll 1
      for (int hf = 0; hf < 2; ++hf) {
        f32x4 acc[8];
#pragma unroll
        for (int nt = 0; nt < 8; ++nt) acc[nt] = (f32x4){0.f, 0.f, 0.f, 0.f};
#pragma unroll
        for (int ks = 0; ks < 4; ++ks) {
          const bf16x8_t a = *(const bf16x8_t*)(PQ + (size_t)(tok0 + c) * 2048 + hd * 256 + hf * 128 + ks * 32 + 8 * g);
#pragma unroll
          for (int nt = 0; nt < 8; ++nt) {
            const bf16x8_t b = *(const bf16x8_t*)(SK + hf * 16384 + (nt * 16 + c) * 128 + ks * 32 + 8 * g);
            acc[nt] = __builtin_amdgcn_mfma_f32_16x16x32_bf16(a, b, acc[nt], 0, 0, 0);
          }
        }
        unsigned kq[4][8], res[4];
#pragma unroll
        for (int i = 0; i < 4; ++i) {
          res[i] = 0u;
#pragma unroll
          for (int nt = 0; nt < 8; ++nt) kq[i][nt] = (peer_f2ord(acc[nt][i]) & ~127u) | (unsigned)(127 - (16 * nt + c));
        }
#pragma unroll 1
        for (int r = 0; r < 16; ++r) {
#pragma unroll
          for (int i = 0; i < 4; ++i) {
            unsigned m = umax3(umax3(kq[i][0], kq[i][1], kq[i][2]), umax3(kq[i][3], kq[i][4], kq[i][5]), (kq[i][6] > kq[i][7]) ? kq[i][6] : kq[i][7]);
            m = row16_umax(m);
#pragma unroll
            for (int nt = 0; nt < 8; ++nt) kq[i][nt] = (kq[i][nt] == m) ? 0u : kq[i][nt];
            res[i] = (c == r) ? m : res[i];
          }
        }
#pragma unroll
        for (int i = 0; i < 4; ++i) {
          const int row = 4 * g + i;
          tv[(hf * 16 + row) * 16 + c] = peer_ord2f(res[i] & ~127u);
          ti[(hf * 16 + row) * 16 + c] = 127 - (int)(res[i] & 127u);
        }
      }
      wave_lds_fence();
      const int ci = cand_i(lane < 50 ? lane : 0), cj = cand_j(lane < 50 ? lane : 0);
#pragma unroll 1
      for (int row = 0; row < 16; ++row) {
        const float val = tv[row * 16 + ci] + tv[(16 + row) * 16 + cj];
        const unsigned key = (lane < 50) ? ((peer_f2ord(val) & ~63u) | (unsigned)(63 - lane)) : 0u;
        int rank = 0;
        CandRank<0>::run((int)key, key, rank);
        if (lane < 50 && rank < 16) {
          rgate[row * 128 + hd * 16 + rank] = val;
          ridx[row * 128 + hd * 16 + rank] = (unsigned short)(ti[row * 16 + ci] * 128 + ti[(16 + row) * 16 + cj]);
        }
      }
      wave_lds_fence();
      {
        const int row = lane >> 2, q = lane & 3;
        float* gp = rgate + row * 128 + hd * 16;
        const float mx = gp[0];
        const f32x4 b4 = *(const f32x4*)(gp + q * 4);
        f32x4 e4;
        e4[0] = __expf(b4[0] - mx); e4[1] = __expf(b4[1] - mx); e4[2] = __expf(b4[2] - mx); e4[3] = __expf(b4[3] - mx);
        float s = (e4[0] + e4[1]) + (e4[2] + e4[3]);
        s += __shfl_xor(s, 1); s += __shfl_xor(s, 2);
        const float inv = 1.f / s;
        wave_lds_fence();
        *(f32x4*)(gp + q * 4) = e4 * inv;
      }
      wave_lds_fence();
    }
    char* wsl = p.ws;
    asm volatile("" : "+s"(wsl));
    const bf16* H2 = (const bf16*)(wsl + OFF_H);
    const unsigned char* PU = (const unsigned char*)(wsl + OFF_PU);
    const unsigned char* PV = (const unsigned char*)(wsl + OFF_PV);
    const float* USC = (const float*)(wsl + OFF_PSC);
    const float* VSC = USC + 16384;
    const float* ada = (const float*)(wsl + OFF_ADA);
    u32x4_t a0[PEER_NB], a1[PEER_NB], hn0, hn1;
#define PSB() __builtin_amdgcn_sched_barrier(0)
#define PEER_ROWS (((128 + 2 * PEER_NB - 1) / (2 * PEER_NB)) * 2 * PEER_NB)
    {
      const int tidx = tid_fresh(), lane = tidx & 63, wv = __builtin_amdgcn_readfirstlane(tidx >> 6);
      const unsigned short* ridx = (const unsigned short*)(lds_raw + wv * 16384 + 4096 + 8192);
      hn0 = *(const u32x4_t*)(H2 + (size_t)tok0 * 1024 + lane * 16); hn1 = *(const u32x4_t*)(H2 + (size_t)tok0 * 1024 + lane * 16 + 8);
      PEER_LOAD(a0, PU, 0, 0); PSB();
      PEER_LOAD(a1, PU, 0, PEER_NB); PSB();
    }
#pragma unroll 1
    for (int tt = 0; tt < 16; ++tt) {
      const int tidx = tid_fresh(), lane = tidx & 63, wv = __builtin_amdgcn_readfirstlane(tidx >> 6);
      const float* rgate = (const float*)(lds_raw + wv * 16384 + 4096);
      const unsigned short* ridx = (const unsigned short*)(lds_raw + wv * 16384 + 4096 + 8192);
      const size_t tok = (size_t)tok0 + tt;
      const int ttn = (tt < 15) ? tt + 1 : tt;
      float hf[16];
#pragma unroll
      for (int w = 0; w < 4; ++w) { hf[2 * w] = bflo(hn0[w]); hf[2 * w + 1] = bfhi(hn0[w]); hf[8 + 2 * w] = bflo(hn1[w]); hf[8 + 2 * w + 1] = bfhi(hn1[w]); }
      const int eA = (int)ridx[tt * 128 + lane], eB = (int)ridx[tt * 128 + 64 + lane];
      const float usA = USC[eA], usB = USC[eB];
      float dotA = 0.f, dotB = 0.f;
#pragma unroll 1
      for (int e0 = 0; e0 < PEER_ROWS; e0 += 2 * PEER_NB) {
        PEER_UDOT(a0, e0); PSB();
        if (e0 + 2 * PEER_NB < PEER_ROWS) { PEER_LOAD(a0, PU, tt, e0 + 2 * PEER_NB); } else { PEER_LOAD(a0, PV, tt, 0); }
        PSB();
        PEER_UDOT(a1, e0 + PEER_NB); PSB();
        if (e0 + 3 * PEER_NB < PEER_ROWS) { PEER_LOAD(a1, PU, tt, e0 + 3 * PEER_NB); } else { PEER_LOAD(a1, PV, tt, PEER_NB); }
        PSB();
      }
      const float aA = gelu_exact(dotA * usA) * rgate[tt * 128 + lane] * VSC[(int)ridx[tt * 128 + lane]],
                  aB = gelu_exact(dotB * usB) * rgate[tt * 128 + 64 + lane] * VSC[(int)ridx[tt * 128 + 64 + lane]];
      float acc[16];
#pragma unroll
      for (int k = 0; k < 16; ++k) acc[k] = 0.f;
      hn0 = *(const u32x4_t*)(H2 + ((size_t)tok0 + ttn) * 1024 + lane * 16); hn1 = *(const u32x4_t*)(H2 + ((size_t)tok0 + ttn) * 1024 + lane * 16 + 8);
      PSB();
#pragma unroll 1
      for (int e0 = 0; e0 < PEER_ROWS; e0 += 2 * PEER_NB) {
        PEER_VACC(a0, e0); PSB();
        if (e0 + 2 * PEER_NB < PEER_ROWS) { PEER_LOAD(a0, PV, tt, e0 + 2 * PEER_NB); } else { PEER_LOAD(a0, PU, ttn, 0); }
        PSB();
        PEER_VACC(a1, e0 + PEER_NB); PSB();
        if (e0 + 3 * PEER_NB < PEER_ROWS) { PEER_LOAD(a1, PV, tt, e0 + 3 * PEER_NB); } else { PEER_LOAD(a1, PU, ttn, PEER_NB); }
        PSB();
      }
      const int b = (int)(tok >> 12);
      const float* xrow = p.out + tok * 1024;
      float* orow = dst_base + tok * 1024;
      const float* g2 = ada + b * 6144 + 5120;
      float x2[16];
      float ss = 0.f;
#pragma unroll
      for (int q = 0; q < 4; ++q) {
        const int col = lane * 16 + q * 4;
        const f32x4 xv = *(const f32x4*)(xrow + col), gv = *(const f32x4*)(g2 + col);
#pragma unroll
        for (int k = 0; k < 4; ++k) { const float t = xv[k] + gv[k] * acc[q * 4 + k]; x2[q * 4 + k] = t; ss += t * t; }
      }
      ss = wave_sum_dpp(ss);
      const float rstd = rsqrtf(ss * (1.f / 1024.f) + 1e-6f);
#pragma unroll
      for (int q = 0; q < 4; ++q) {
        const int col = lane * 16 + q * 4;
        const f32x4 fg = *(const f32x4*)((const float*)(wsl + OFF_PRM) + PRM_FG + col);
        f32x4 o;
#pragma unroll
        for (int k = 0; k < 4; ++k) o[k] = x2[q * 4 + k] * rstd * fg[k];
        *(f32x4*)(orow + col) = o;
      }
    }
    wave_lds_fence();
  }
}

#define DS_KEY16   0
#define DS_CHUNK   17408
#define DS_SEL     139264
#define DS_WAVE    147456
#define DS_TOTAL   155648
#define DS_RS      544

__device__ __forceinline__ unsigned f2ord(float f) {
  if (f == 0.f) f = 0.f;
  unsigned u = __float_as_uint(f);
  return (u & 0x80000000u) ? ~u : (u | 0x80000000u);
}
__device__ __forceinline__ int wave_scan_incl(int v, int lane) {
#pragma unroll
  for (int o = 1; o < 64; o <<= 1) { const int t = __shfl_up(v, o); v += (lane >= o) ? t : 0; }
  return v;
}
__device__ __forceinline__ void find_digit(const LAS unsigned* hist, int K, int lane, int& digit, int& above) {
  const u32x4_t h4 = *(const LAS u32x4_t*)(hist + 252 - 4 * lane);
  const int c0 = (int)h4.w, c1 = (int)h4.z, c2 = (int)h4.y, c3 = (int)h4.x;
  const int tot = c0 + c1 + c2 + c3;
  int run = wave_scan_incl(tot, lane) - tot;
  int found = -1, ab = 0;
  if (run < K && run + c0 >= K) { found = 255 - 4 * lane; ab = run; } run += c0;
  if (run < K && run + c1 >= K) { found = 254 - 4 * lane; ab = run; } run += c1;
  if (run < K && run + c2 >= K) { found = 253 - 4 * lane; ab = run; } run += c2;
  if (run < K && run + c3 >= K) { found = 252 - 4 * lane; ab = run; }
  const unsigned long long mk = __ballot(found >= 0);
  const int src = (int)__ffsll((unsigned long long)mk) - 1;
  digit = __builtin_amdgcn_readlane(found, src);
  above = __builtin_amdgcn_readlane(ab, src);
}

typedef unsigned u32x2_t __attribute__((ext_vector_type(2)));
__device__ __forceinline__ float xrow_max(float x) {
  u32x2_t r = __builtin_amdgcn_permlane16_swap(__float_as_uint(x), __float_as_uint(x), false, false);
  x = fmaxf(__uint_as_float(r.x), __uint_as_float(r.y));
  r = __builtin_amdgcn_permlane32_swap(__float_as_uint(x), __float_as_uint(x), false, false);
  return fmaxf(__uint_as_float(r.x), __uint_as_float(r.y));
}
__device__ __forceinline__ float xrow_sum(float x) {
  u32x2_t r = __builtin_amdgcn_permlane16_swap(__float_as_uint(x), __float_as_uint(x), false, false);
  x = __uint_as_float(r.x) + __uint_as_float(r.y);
  r = __builtin_amdgcn_permlane32_swap(__float_as_uint(x), __float_as_uint(x), false, false);
  return __uint_as_float(r.x) + __uint_as_float(r.y);
}
__device__ __forceinline__ s16x4_t tr_read_b64(unsigned addr) {
  s16x4_t r; asm volatile("ds_read_b64_tr_b16 %0, %1" : "=&v"(r) : "v"(addr) : "memory"); return r;
}

#ifndef PROBE_DSA
#define PROBE_DSA 0
#endif
#if PROBE_DSA
#define DSA_MARK(k) do { const unsigned long long n_ = __builtin_amdgcn_s_memrealtime(); if (PROBE_DSA == (k)) { const unsigned long long q_ = n_ - tmark; \
    while (__builtin_amdgcn_s_memrealtime() - n_ < q_) __builtin_amdgcn_s_sleep(2); } tmark = __builtin_amdgcn_s_memrealtime(); } while (0)
#else
#define DSA_MARK(k) do {} while (0)
#endif
#if PROBE_DSA >= 10
#define DSA_MARKI(k) DSA_MARK(k)
#else
#define DSA_MARKI(k) do {} while (0)
#endif
__device__ __forceinline__ void dsa_batch(const P& p, unsigned char* lds_raw, int b, int pos2) {
  const int t00 = pos2 * 32;
#define DSA_IDS const int tid = tid_fresh(), wave = __builtin_amdgcn_readfirstlane(tid >> 6), lane = tid & 63, g = lane >> 4, c = lane & 15; (void)wave; (void)g; (void)c;
  const size_t tokb = (size_t)b * SEQ, tok00 = tokb + t00;
  const bf16* DQ = (const bf16*)(p.ws + OFF_DQ);
  const bf16* CKV = (const bf16*)(p.ws + OFF_CKV);
  const float* SSP = (const float*)(p.ws + OFF_SSP);
  const bf16* IQ = (const bf16*)(p.ws + OFF_IQ);
  const bf16* IK = (const bf16*)(p.ws + OFF_IK);
  const float* IW = (const float*)(p.ws + OFF_IW);
  const bf16* WUK = (const bf16*)(p.ws + OFF_WUK);
  const bf16* WUV = (const bf16*)(p.ws + OFF_WUV);
  bf16* ODSA = (bf16*)(p.ws + OFF_ODSA);
  bf16* QL = (bf16*)(p.ws + OFF_DSCR + (size_t)blockIdx.x * 131072);
  bf16* OL = QL;
  LAS unsigned char* lds = (LAS unsigned char*)lds_raw;
  LAS unsigned short* key16 = (LAS unsigned short*)(lds + DS_KEY16);
  LAS unsigned short* sel = (LAS unsigned short*)(lds + DS_SEL);

#if PROBE_DSA
  unsigned long long tmark = __builtin_amdgcn_s_memrealtime();
#endif
  {
    DSA_IDS
    const int h = wave;
    bf16x8_t dq0[4], dq1[4];
#pragma unroll
    for (int ks = 0; ks < 4; ++ks) {
      dq0[ks] = *(const bf16x8_t*)(DQ + (tok00 + c) * 1024 + h * 128 + ks * 32 + 8 * g);
      dq1[ks] = *(const bf16x8_t*)(DQ + (tok00 + 16 + c) * 1024 + h * 128 + ks * 32 + 8 * g);
    }
#pragma unroll 1
    for (int hn = 0; hn < 2; ++hn) {
      f32x4 r0[8], r1[8];
#pragma unroll
      for (int n8 = 0; n8 < 8; ++n8) {
        const int nt = hn * 8 + n8;
        f32x4 a0 = (f32x4){0.f, 0.f, 0.f, 0.f}, a1 = a0;
#pragma unroll
        for (int ks = 0; ks < 4; ++ks) {
          const bf16x8_t wf = *(const bf16x8_t*)(WUK + (size_t)(h * 256 + nt * 16 + c) * 128 + ks * 32 + 8 * g);
          a0 = __builtin_amdgcn_mfma_f32_16x16x32_bf16(wf, dq0[ks], a0, 0, 0, 0);
          a1 = __builtin_amdgcn_mfma_f32_16x16x32_bf16(wf, dq1[ks], a1, 0, 0, 0);
        }
        r0[n8] = a0; r1[n8] = a1;
      }
#pragma unroll
      for (int n8 = 0; n8 < 8; ++n8) {
        const int nt = hn * 8 + n8;
        uint2 o; o.x = pk2(r0[n8][0], r0[n8][1]); o.y = pk2(r0[n8][2], r0[n8][3]);
        *(uint2*)(QL + c * 2048 + h * 256 + nt * 16 + 4 * g) = o;
        o.x = pk2(r1[n8][0], r1[n8][1]); o.y = pk2(r1[n8][2], r1[n8][3]);
        *(uint2*)(QL + (16 + c) * 2048 + h * 256 + nt * 16 + 4 * g) = o;
      }
    }
  }
  DSA_MARK(1);
#pragma unroll 1
  for (int half = 0; half < 2; ++half) {
  const int t0 = t00 + 16 * half;
  const size_t tok0 = tokb + t0;
  bf16* QLh = QL + half * 16 * 2048;
  bf16* OLh = QLh;
  if (t0 >= 256) {
    DSA_IDS
    bf16x8_t qf[8][2];
    float iw[8];
#pragma unroll
    for (int h = 0; h < 8; ++h) {
      qf[h][0] = *(const bf16x8_t*)(IQ + (tok0 + c) * 512 + h * 64 + 8 * g);
      qf[h][1] = *(const bf16x8_t*)(IQ + (tok0 + c) * 512 + h * 64 + 32 + 8 * g);
      iw[h] = IW[(tok0 + c) * 8 + h];
    }
    const int ntile = (t0 >> 4) + 1;
    bf16x8_t k0n = (bf16x8_t){0, 0, 0, 0, 0, 0, 0, 0}, k1n = k0n;
    if (wave < ntile) { const bf16* kr = IK + (tokb + wave * 16 + c) * 64 + 8 * g; k0n = *(const bf16x8_t*)kr; k1n = *(const bf16x8_t*)(kr + 32); }
    for (int kt = wave; kt < ntile; kt += 8) {
      const bf16x8_t k0 = k0n, k1 = k1n;
      { const int ktn = (kt + 8 < ntile) ? kt + 8 : kt; const bf16* kr = IK + (tokb + ktn * 16 + c) * 64 + 8 * g; k0n = *(const bf16x8_t*)kr; k1n = *(const bf16x8_t*)(kr + 32); }
      f32x4 sc = (f32x4){0.f, 0.f, 0.f, 0.f};
#pragma unroll
      for (int h = 0; h < 8; ++h) {
        f32x4 d = __builtin_amdgcn_mfma_f32_16x16x32_bf16(k0, qf[h][0], (f32x4){0.f, 0.f, 0.f, 0.f}, 0, 0, 0);
        d = __builtin_amdgcn_mfma_f32_16x16x32_bf16(k1, qf[h][1], d, 0, 0, 0);
#pragma unroll
        for (int i = 0; i < 4; ++i) sc[i] += iw[h] * fmaxf(d[i], 0.f);
      }
      u16x4_t o;
      const int sb = kt * 16 + 4 * g, tq = t0 + c;
      o.x = (sb + 0 <= tq) ? (unsigned short)(f2ord(sc[0]) >> 16) : (unsigned short)0;
      o.y = (sb + 1 <= tq) ? (unsigned short)(f2ord(sc[1]) >> 16) : (unsigned short)0;
      o.z = (sb + 2 <= tq) ? (unsigned short)(f2ord(sc[2]) >> 16) : (unsigned short)0;
      o.w = (sb + 3 <= tq) ? (unsigned short)(f2ord(sc[3]) >> 16) : (unsigned short)0;
      *(LAS u16x4_t*)(key16 + c * 4096 + sb) = o;
    }
  }
  DSA_MARK(2);
  __syncthreads();
#pragma unroll 1
  for (int qq = 0; qq < 2; ++qq) {
    DSA_IDS
    const int q = wave + 8 * qq, t = t0 + q;
    LAS unsigned short* selq = sel + q * 256;
    if (t < 256) {
      for (int j = lane; j < 256; j += 64) selq[j] = (unsigned short)((j <= t) ? j : 0);
    } else {
      const LAS unsigned short* kq = key16 + q * 4096;
      const int nit = (t >> 9) + 1;
      unsigned kp[8][4];
#pragma unroll
      for (int it = 0; it < 8; ++it) {
        const int s0 = 512 * it + 8 * lane;
        u32x4_t v = (u32x4_t){0u, 0u, 0u, 0u};
        if (s0 <= t) v = *(const LAS u32x4_t*)(kq + s0);
#pragma unroll
        for (int j = 0; j < 4; ++j) {
          const unsigned lo = (s0 + 2 * j <= t) ? (v[j] & 0xffffu) : 0u, hi = (s0 + 2 * j + 1 <= t) ? (v[j] & 0xffff0000u) : 0u;
          kp[it][j] = lo | hi;
        }
      }
      asm volatile("" :: "v"(kp[0][0]), "v"(kp[7][3]));
      DSA_MARKI(21);
      unsigned B = 0u;
#pragma unroll 1
      for (int bit = 15; bit >= 0; --bit) {
        const unsigned cand = B | (1u << bit);
        const unsigned c2 = (cand - 1u) * 0x00010001u;
        unsigned cnt2 = 0u;
#pragma unroll
        for (int it = 0; it < 8; ++it) {
          if (it < nit) {
#pragma unroll
            for (int j = 0; j < 4; ++j) {
              unsigned dd;
              asm("v_pk_sub_u16 %0, %1, %2 clamp\n\tv_pk_min_u16 %0, %0, %3" : "=&v"(dd) : "v"(kp[it][j]), "v"(c2), "v"(0x00010001u));
              cnt2 += dd;
            }
          }
        }
        const int tot = (int)wave_sum_dpp((float)((cnt2 & 0xffffu) + (cnt2 >> 16)));
        if (tot >= 256) B = cand;
      }
      int cgt = 0;
#pragma unroll
      for (int it = 0; it < 8; ++it)
#pragma unroll
        for (int j = 0; j < 4; ++j) cgt += (((kp[it][j] & 0xffffu) > B) ? 1 : 0) + (((kp[it][j] >> 16) > B) ? 1 : 0);
      const int m = 256 - (int)wave_sum_dpp((float)cgt);
      DSA_MARKI(22);
      int base = 0, eqbase = 0;
#pragma unroll
      for (int it = 0; it < 8; ++it) {
        if (it < nit) {
          unsigned kk[8];
#pragma unroll
          for (int j = 0; j < 4; ++j) { kk[2 * j] = kp[it][j] & 0xffffu; kk[2 * j + 1] = kp[it][j] >> 16; }
          unsigned anyeq = 0u;
#pragma unroll
          for (int j = 0; j < 8; ++j) anyeq |= (kk[j] == B) ? 1u : 0u;
          int eqlow = 0, eqtot = 0;
          if (__builtin_amdgcn_ballot_w64(anyeq != 0u) != 0ull) {
#pragma unroll
            for (int j = 0; j < 8; ++j) {
              const unsigned long long mk = __builtin_amdgcn_ballot_w64(kk[j] == B);
              eqlow += (int)__builtin_amdgcn_mbcnt_hi((unsigned)(mk >> 32), __builtin_amdgcn_mbcnt_lo((unsigned)mk, 0u));
              eqtot += __builtin_popcountll(mk);
            }
          }
          int eqr = eqbase + eqlow;
          int ps = base, tot = 0;
          bool tk[8];
#pragma unroll
          for (int j = 0; j < 8; ++j) {
            const bool eq = kk[j] == B;
            tk[j] = (kk[j] > B) || (eq && eqr < m);
            eqr += eq ? 1 : 0;
          }
#pragma unroll
          for (int j = 0; j < 8; ++j) {
            const unsigned long long mk = __builtin_amdgcn_ballot_w64(tk[j]);
            ps += (int)__builtin_amdgcn_mbcnt_hi((unsigned)(mk >> 32), __builtin_amdgcn_mbcnt_lo((unsigned)mk, 0u));
            tot += __builtin_popcountll(mk);
          }
#pragma unroll
          for (int j = 0; j < 8; ++j) {
            if (tk[j]) { if (ps < 256) selq[ps] = (unsigned short)(512 * it + 8 * lane + j); ++ps; }
          }
          base += tot;
          eqbase += eqtot;
        }
      }
    }
  }
  DSA_MARK(3);
  __syncthreads();
  {
    DSA_IDS
    const int wave_b = wave;
    const float slope = (c < 8) ? exp2f(-(float)(c + 1)) : 0.f;
#pragma unroll 1
    for (int qq = 0; qq < 2; ++qq) {
      const int q = wave + 8 * qq, t = t0 + q;
      const int nsel = (t + 1 < 256) ? (t + 1) : 256, nch = (nsel + 31) >> 5;
      const LAS unsigned short* selq = sel + q * 256;
      bf16x8_t qf[8];
      {
        const int lq = tid_fresh() & 63;
        const bf16* qlp = QLh + q * 2048 + (lq & 7) * 256 + 8 * (lq >> 4);
#pragma unroll
        for (int ks = 0; ks < 8; ++ks) qf[ks] = *(const bf16x8_t*)(qlp + ks * 32);
      }
      float mrun = -1e30f, lrun = 0.f;
      f32x4 o[16];
#pragma unroll
      for (int nt = 0; nt < 16; ++nt) o[nt] = (f32x4){0.f, 0.f, 0.f, 0.f};
      u32x4_t st[16];
      f32x4 st_ss = (f32x4){0.f, 0.f, 0.f, 0.f}; float st_d = -1.f;
#define DSA_ISSUE(ch)                                                                                   \
      {          \
        _Pragma("unroll") for (int r = 0; r < 16; ++r) {                                                \
          const int idx = (int)selq[(ch) * 32 + 2 * r + (lane >> 5)];                                   \
          st[r] = *(const u32x4_t*)(CKV + (tokb + idx) * 256 + (lane & 31) * 8);                        \
        }                                                                                               \
        const int j2 = (ch) * 32 + (lane & 31);                                                         \
        const int idx2 = (int)selq[j2];                                                                 \
        st_ss = *(const f32x4*)(SSP + (tokb + idx2) * 4);                                               \
        st_d = (j2 < nsel) ? (float)(t - idx2) : -1.f;                                                  \
      }
      DSA_ISSUE(0);
#pragma unroll 1
      for (int ch = 0; ch < nch; ++ch) {
        const int lane = tid_fresh() & 63, g = lane >> 4, c = lane & 15;
        LAS unsigned char* buf = lds + DS_KEY16 + wave_b * DS_CHUNK;
        LAS float* kr = (LAS float*)(lds + DS_WAVE + wave_b * 1024);
        LAS float* kd = kr + 32;
        const unsigned vb = (unsigned)(uintptr_t)buf + (unsigned)((4 * g + (c >> 2)) * DS_RS + 8 * (c & 3));
#pragma unroll
        for (int r = 0; r < 16; ++r) *(LAS u32x4_t*)(buf + (2 * r + (lane >> 5)) * DS_RS + (lane & 31) * 16) = st[r];
        if (lane < 32) { kr[lane] = rsqrtf(((st_ss[0] + st_ss[1]) + (st_ss[2] + st_ss[3])) * (1.f / 256.f) + 1e-6f); kd[lane] = st_d; }
        wave_lds_fence();
        DSA_MARKI(11);
        DSA_ISSUE((ch + 1 < nch) ? ch + 1 : ch);
        f32x4 s0 = (f32x4){0.f, 0.f, 0.f, 0.f}, s1 = (f32x4){0.f, 0.f, 0.f, 0.f};
#pragma unroll
        for (int ks = 0; ks < 8; ++ks) {
          const bf16x8_t a0 = *(const LAS bf16x8_t*)(buf + c * DS_RS + (ks * 32 + 8 * g) * 2);
          const bf16x8_t a1 = *(const LAS bf16x8_t*)(buf + (16 + c) * DS_RS + (ks * 32 + 8 * g) * 2);
          s0 = __builtin_amdgcn_mfma_f32_16x16x32_bf16(a0, qf[ks], s0, 0, 0, 0);
          s1 = __builtin_amdgcn_mfma_f32_16x16x32_bf16(a1, qf[ks], s1, 0, 0, 0);
        }
        asm volatile("" :: "v"(s0[0]), "v"(s1[0]));
        DSA_MARKI(12);
        const f32x4 r0 = *(const LAS f32x4*)(kr + 4 * g), r1 = *(const LAS f32x4*)(kr + 16 + 4 * g);
        const f32x4 d0 = *(const LAS f32x4*)(kd + 4 * g), d1 = *(const LAS f32x4*)(kd + 16 + 4 * g);
        float x[8];
#pragma unroll
        for (int i = 0; i < 4; ++i) {
          x[i] = (d0[i] < 0.f) ? -1e30f : (s0[i] * r0[i] - slope * d0[i]);
          x[4 + i] = (d1[i] < 0.f) ? -1e30f : (s1[i] * r1[i] - slope * d1[i]);
        }
        float mx = fmaxf(fmaxf(fmaxf(x[0], x[1]), fmaxf(x[2], x[3])), fmaxf(fmaxf(x[4], x[5]), fmaxf(x[6], x[7])));
        mx = xrow_max(mx);
        const float mn = fmaxf(mrun, mx);
        const float alpha = __expf(mrun - mn);
        mrun = mn;
        float pr[8], ps = 0.f;
#pragma unroll
        for (int i = 0; i < 8; ++i) { pr[i] = (x[i] <= -1e29f) ? 0.f : __expf(x[i] - mn); ps += pr[i]; }
        ps = xrow_sum(ps);
        lrun = lrun * alpha + ps;
        if (__builtin_amdgcn_ballot_w64(alpha != 1.f) != 0ull) {
#pragma unroll
          for (int nt = 0; nt < 16; ++nt) o[nt] *= alpha;
        }
        union { bf16x8_t v; unsigned u[4]; } pf;
        pf.u[0] = pk2(pr[0] * r0[0], pr[1] * r0[1]); pf.u[1] = pk2(pr[2] * r0[2], pr[3] * r0[3]);
        pf.u[2] = pk2(pr[4] * r1[0], pr[5] * r1[1]); pf.u[3] = pk2(pr[6] * r1[2], pr[7] * r1[3]);
        asm volatile("" :: "v"(pf.u[0]));
        DSA_MARKI(13);
        {
          s16x4_t loA[4], hiA[4], loB[4], hiB[4];
#define PV_READ(L, H, nt0) _Pragma("unroll") for (int u = 0; u < 4; ++u) { L[u] = tr_read_b64(vb + ((nt0) + u) * 32); H[u] = tr_read_b64(vb + ((nt0) + u) * 32 + 16 * DS_RS); }
#define PV_MMA(L, H, nt0) _Pragma("unroll") for (int u = 0; u < 4; ++u) { \
            const bf16x8_t af = (bf16x8_t){L[u][0], L[u][1], L[u][2], L[u][3], H[u][0], H[u][1], H[u][2], H[u][3]}; \
            o[(nt0) + u] = __builtin_amdgcn_mfma_f32_16x16x32_bf16(af, pf.v, o[(nt0) + u], 0, 0, 0); }
          PV_READ(loA, hiA, 0);
          PV_READ(loB, hiB, 4);
          asm volatile("s_waitcnt lgkmcnt(8)" ::: "memory"); __builtin_amdgcn_sched_barrier(0);
          PV_MMA(loA, hiA, 0); __builtin_amdgcn_sched_barrier(0);
          PV_READ(loA, hiA, 8);
          asm volatile("s_waitcnt lgkmcnt(8)" ::: "memory"); __builtin_amdgcn_sched_barrier(0);
          PV_MMA(loB, hiB, 4); __builtin_amdgcn_sched_barrier(0);
          PV_READ(loB, hiB, 12);
          asm volatile("s_waitcnt lgkmcnt(8)" ::: "memory"); __builtin_amdgcn_sched_barrier(0);
          PV_MMA(loA, hiA, 8); __builtin_amdgcn_sched_barrier(0);
          asm volatile("s_waitcnt lgkmcnt(0)" ::: "memory"); __builtin_amdgcn_sched_barrier(0);
          PV_MMA(loB, hiB, 12);
#undef PV_READ
#undef PV_MMA
        }
        wave_lds_fence();
        asm volatile("" :: "v"(o[0][0]), "v"(o[15][0]));
        DSA_MARKI(14);
      }
#undef DSA_ISSUE
      if (c < 8) {
        const float inv = 1.f / lrun;
#pragma unroll
        for (int nt = 0; nt < 16; ++nt) {
          uint2 w; w.x = pk2(o[nt][0] * inv, o[nt][1] * inv); w.y = pk2(o[nt][2] * inv, o[nt][3] * inv);
          *(uint2*)(OLh + q * 2048 + c * 256 + nt * 16 + 4 * g) = w;
        }
      }
    }
  }
  DSA_MARK(4);
  __syncthreads();
  }
  {
    DSA_IDS
    const int h = wave;
    bf16x8_t of0[8], of1[8];
#pragma unroll
    for (int ks = 0; ks < 8; ++ks) {
      of0[ks] = *(const bf16x8_t*)(OL + c * 2048 + h * 256 + ks * 32 + 8 * g);
      of1[ks] = *(const bf16x8_t*)(OL + (16 + c) * 2048 + h * 256 + ks * 32 + 8 * g);
    }
    f32x4 c0[8], c1[8];
#pragma unroll
    for (int nt = 0; nt < 8; ++nt) {
      f32x4 a0 = (f32x4){0.f, 0.f, 0.f, 0.f}, a1 = a0;
#pragma unroll
      for (int ks = 0; ks < 8; ++ks) {
        const bf16x8_t wf = *(const bf16x8_t*)(WUV + (size_t)(h * 128 + nt * 16 + c) * 256 + ks * 32 + 8 * g);
        a0 = __builtin_amdgcn_mfma_f32_16x16x32_bf16(wf, of0[ks], a0, 0, 0, 0);
        a1 = __builtin_amdgcn_mfma_f32_16x16x32_bf16(wf, of1[ks], a1, 0, 0, 0);
      }
      c0[nt] = a0; c1[nt] = a1;
    }
#pragma unroll
    for (int nt = 0; nt < 8; ++nt) {
      uint2 w; w.x = pk2(c0[nt][0], c0[nt][1]); w.y = pk2(c0[nt][2], c0[nt][3]);
      *(uint2*)(ODSA + (tok00 + c) * 1024 + h * 128 + nt * 16 + 4 * g) = w;
      w.x = pk2(c1[nt][0], c1[nt][1]); w.y = pk2(c1[nt][2], c1[nt][3]);
      *(uint2*)(ODSA + (tok00 + 16 + c) * 1024 + h * 128 + nt * 16 + 4 * g) = w;
    }
  }
  DSA_MARK(5);
  __syncthreads();
}

#undef DSA_IDS
__device__ __forceinline__ void ph_dsa512(const P& p, unsigned char* lds_raw) {
  for (int it = blockIdx.x; it < TT / 16; it += gridDim.x) {
    const int k = it >> 8, j = it & 255;
    dsa_batch(p, lds_raw, k, ((k & 1) ? 255 - j : j) >> 1);
  }
}

#define GL_QD    0
#define GL_KI    18432
#define GL_KE    36864
#define GL_V     55296
#define GL_AT    90112
#define GL_GLOW  99328
#define GL_QT    103424
#define GL_DEC   105472
#define GL_SSQ   105984
#define GL_LB    108032
#define GL_TOTAL 140800

#define GLA_BAR() do { asm volatile("s_waitcnt lgkmcnt(0)" ::: "memory"); __builtin_amdgcn_s_barrier(); asm volatile("" ::: "memory"); } while (0)
#ifndef PROBE_GLA
#define PROBE_GLA 0
#endif
#if PROBE_GLA
#define GLA_MARK(k) do { const unsigned long long n_ = __builtin_amdgcn_s_memrealtime(); if (PROBE_GLA == (k)) { const unsigned long long q_ = n_ - tmark; \
    while (__builtin_amdgcn_s_memrealtime() - n_ < q_) __builtin_amdgcn_s_sleep(2); } tmark = __builtin_amdgcn_s_memrealtime(); } while (0)
#else
#define GLA_MARK(k) do {} while (0)
#endif
__device__ __forceinline__ void gla_item(const P& p, unsigned char* lds_raw, int item) {
  int tid = tid_fresh();
  const int b = item >> 2, h = item & 3;
  const size_t tokb = (size_t)b * SEQ;
  const bf16* Qg = (const bf16*)(p.ws + OFF_Q);
  const bf16* Kg = (const bf16*)(p.ws + OFF_K);
  bf16* Vg = (bf16*)(p.ws + OFF_V);
  const float* GLOWg = (const float*)(p.ws + OFF_GLOW);
  const bf16* SGR = (const bf16*)(p.ws + OFF_SGR);
  LAS unsigned char* lds = (LAS unsigned char*)lds_raw;
  const unsigned lds0 = (unsigned)(uintptr_t)lds;
  LAS float* QT = (LAS float*)(lds + GL_QT);
  LAS float* DEC = (LAS float*)(lds + GL_DEC);
  LAS float* SSQ = (LAS float*)(lds + GL_SSQ);
  float wg[16];
  const float* prm = (const float*)(p.ws + OFF_PRM);
#pragma unroll
  for (int r = 0; r < 16; ++r) wg[r] = prm[PRM_WGU + r * 512 + h * 128 + (tid & 127)];
  const float bg = prm[PRM_BG + h * 128 + (tid & 127)];
  const float gn0 = prm[PRM_GNG + h * 256 + 32 * (tid >> 6) + (tid & 15)], gn1 = prm[PRM_GNG + h * 256 + 32 * (tid >> 6) + 16 + (tid & 15)];
  u32x4_t rq[2], rk[2], rv[4], rg = (u32x4_t){0u, 0u, 0u, 0u};
#define GLA_LOAD(ch)                                                                                      \
  {                                                                                                       \
    const size_t tb = tokb + (size_t)(ch) * 64;                                                           \
    _Pragma("unroll") for (int i = 0; i < 2; ++i) {                                                       \
      const int id = tid + 512 * i, tk = id >> 4, part = id & 15;                                         \
      rq[i] = *(const u32x4_t*)(Qg + (tb + tk) * 512 + h * 128 + part * 8);                               \
      rk[i] = *(const u32x4_t*)(Kg + (tb + tk) * 512 + h * 128 + part * 8);                               \
    }                                                                                                     \
    _Pragma("unroll") for (int i = 0; i < 4; ++i) {                                                       \
      const int id = tid + 512 * i, tk = id >> 5, part = id & 31;                                         \
      rv[i] = *(const u32x4_t*)(Vg + (tb + tk) * 1024 + h * 256 + part * 8);                              \
    }                                                                                                     \
    if (tid < 256) rg = *(const u32x4_t*)(GLOWg + (tb + (tid >> 2)) * 16 + (tid & 3) * 4);                \
  }
  f32x4 S[8][2];
#pragma unroll
  for (int a = 0; a < 8; ++a) { S[a][0] = (f32x4){0.f, 0.f, 0.f, 0.f}; S[a][1] = (f32x4){0.f, 0.f, 0.f, 0.f}; }
  GLA_LOAD(0);
#if PROBE_GLA
  unsigned long long tmark = __builtin_amdgcn_s_memrealtime();
#endif
#pragma unroll 1
  for (int ch = 0; ch < SEQ / 64; ++ch) {
    asm volatile("" : "+v"(tid));
    const int wave = __builtin_amdgcn_readfirstlane(tid >> 6), lane = tid & 63, g = lane >> 4, c = lane & 15;
    const int d = tid & 127, tq = __builtin_amdgcn_readfirstlane(tid >> 7);
    const unsigned vtr = lds0 + GL_V + (unsigned)((8 * g + (c >> 2)) * 544 + (32 * wave + 4 * (c & 3)) * 2);
    const unsigned ketr = lds0 + GL_KE + (unsigned)((8 * g + (c >> 2)) * 288 + (4 * (c & 3)) * 2);
    const size_t tb = tokb + (size_t)ch * 64;
#pragma unroll
    for (int i = 0; i < 2; ++i) {
      const int id = tid + 512 * i, tk = id >> 4, part = id & 15;
      *(LAS u32x4_t*)(lds + GL_QD + tk * 288 + part * 16) = rq[i];
      *(LAS u32x4_t*)(lds + GL_KI + tk * 288 + part * 16) = rk[i];
    }
#pragma unroll
    for (int i = 0; i < 4; ++i) {
      const int id = tid + 512 * i, tk = id >> 5, part = id & 31;
      *(LAS u32x4_t*)(lds + GL_V + tk * 544 + part * 16) = rv[i];
    }
    if (tid < 256) *(LAS u32x4_t*)(lds + GL_GLOW + (tid >> 2) * 64 + (tid & 3) * 16) = rg;
    GLA_MARK(1); GLA_BAR();
    GLA_LOAD((ch + 1 < SEQ / 64) ? ch + 1 : ch);
    u32x4_t rs[4];
#pragma unroll
    for (int i = 0; i < 4; ++i) {
      const int id = tid + 512 * i, tk = id >> 5, part = id & 31;
      rs[i] = *(const u32x4_t*)(SGR + (tb + tk) * 1024 + h * 256 + part * 8);
    }
    LAS float* LB = (LAS float*)(lds + GL_LB);
    float run = 0.f;
#pragma unroll 2
    for (int i = 0; i < 16; ++i) {
      const LAS f32x4* gp = (const LAS f32x4*)(lds + GL_GLOW + (16 * tq + i) * 64);
      const f32x4 g0 = gp[0], g1 = gp[1], g2 = gp[2], g3 = gp[3];
      float gl = bg;
      gl += g0[0] * wg[0] + g0[1] * wg[1] + g0[2] * wg[2] + g0[3] * wg[3];
      gl += g1[0] * wg[4] + g1[1] * wg[5] + g1[2] * wg[6] + g1[3] * wg[7];
      gl += g2[0] * wg[8] + g2[1] * wg[9] + g2[2] * wg[10] + g2[3] * wg[11];
      gl += g3[0] * wg[12] + g3[1] * wg[13] + g3[2] * wg[14] + g3[3] * wg[15];
      const float ls = fminf(gl, 0.f) - __logf(1.f + __expf(-fabsf(gl)));
      run += ls * (1.f / 16.f);
      LB[(16 * tq + i) * 128 + d] = run;
    }
    QT[tq * 128 + d] = run;
    GLA_MARK(2); GLA_BAR();
    {
      float off = 0.f, tot = 0.f;
#pragma unroll
      for (int k = 0; k < 4; ++k) { const float v = QT[k * 128 + d]; tot += v; off += (k < tq) ? v : 0.f; }
      const float eb = __expf(tot);
#pragma unroll 2
      for (int i = 0; i < 16; ++i) {
        const int t = 16 * tq + i;
        const float bb = LB[t * 128 + d] + off;
        const float e = __expf(bb), r = __expf(-bb);
        LAS bf16* qp = (LAS bf16*)(lds + GL_QD + t * 288) + d;
        LAS bf16* kp = (LAS bf16*)(lds + GL_KI + t * 288) + d;
        LAS bf16* ep = (LAS bf16*)(lds + GL_KE + t * 288) + d;
        const float q = bf2f(*qp), k = bf2f(*kp);
        *qp = f2bf(q * e);
        *kp = f2bf(k * r);
        *ep = f2bf(k * (eb * r));
      }
      if (tq == 0) DEC[d] = eb;
    }
    GLA_MARK(3); GLA_BAR();
    {
      const int ti = wave >> 1;
#pragma unroll
      for (int u = 0; u < 2; ++u) {
        const int tj = 2 * (wave & 1) + u;
        f32x4 acc = (f32x4){0.f, 0.f, 0.f, 0.f};
        if (tj <= ti) {
#pragma unroll
          for (int ks = 0; ks < 4; ++ks) {
            const bf16x8_t a = *(const LAS bf16x8_t*)(lds + GL_QD + (16 * ti + c) * 288 + (32 * ks + 8 * g) * 2);
            const bf16x8_t bb = *(const LAS bf16x8_t*)(lds + GL_KI + (16 * tj + c) * 288 + (32 * ks + 8 * g) * 2);
            acc = __builtin_amdgcn_mfma_f32_16x16x32_bf16(a, bb, acc, 0, 0, 0);
          }
        }
#pragma unroll
        for (int r = 0; r < 4; ++r) {
          const int i = 16 * ti + 4 * g + r, j = 16 * tj + c;
          *((LAS bf16*)(lds + GL_AT + i * 144) + j) = f2bf((j <= i) ? acc[r] : 0.f);
        }
      }
    }
    GLA_MARK(4); GLA_BAR();
    f32x4 o[4][2];
    {
      bf16x8_t vf[2][2];
      {
        s16x4_t lo[4], hi[4];
#pragma unroll
        for (int ks = 0; ks < 2; ++ks)
#pragma unroll
          for (int tn = 0; tn < 2; ++tn) {
            lo[ks * 2 + tn] = tr_read_b64(vtr + (32 * ks) * 544 + tn * 32);
            hi[ks * 2 + tn] = tr_read_b64(vtr + (32 * ks + 4) * 544 + tn * 32);
          }
        asm volatile("s_waitcnt lgkmcnt(0)" ::: "memory");
        __builtin_amdgcn_sched_barrier(0);
#pragma unroll
        for (int u = 0; u < 4; ++u)
          vf[u >> 1][u & 1] = (bf16x8_t){lo[u][0], lo[u][1], lo[u][2], lo[u][3], hi[u][0], hi[u][1], hi[u][2], hi[u][3]};
      }
#pragma unroll
      for (int tm = 0; tm < 4; ++tm) { o[tm][0] = (f32x4){0.f, 0.f, 0.f, 0.f}; o[tm][1] = (f32x4){0.f, 0.f, 0.f, 0.f}; }
#pragma unroll
      for (int tm = 0; tm < 4; ++tm)
#pragma unroll
        for (int ks = 0; ks < 2; ++ks) {
          if (ks == 1 && tm < 2) continue;
          const bf16x8_t a = *(const LAS bf16x8_t*)(lds + GL_AT + (16 * tm + c) * 144 + (32 * ks + 8 * g) * 2);
          o[tm][0] = __builtin_amdgcn_mfma_f32_16x16x32_bf16(a, vf[ks][0], o[tm][0], 0, 0, 0);
          o[tm][1] = __builtin_amdgcn_mfma_f32_16x16x32_bf16(a, vf[ks][1], o[tm][1], 0, 0, 0);
          __builtin_amdgcn_sched_barrier(0);
        }
#pragma unroll
      for (int u = 0; u < 4; ++u) {
        union { bf16x8_t v; unsigned w[4]; } s0, s1;
        s0.w[0] = pk2(S[2 * u][0][0], S[2 * u][0][1]); s0.w[1] = pk2(S[2 * u][0][2], S[2 * u][0][3]);
        s0.w[2] = pk2(S[2 * u + 1][0][0], S[2 * u + 1][0][1]); s0.w[3] = pk2(S[2 * u + 1][0][2], S[2 * u + 1][0][3]);
        s1.w[0] = pk2(S[2 * u][1][0], S[2 * u][1][1]); s1.w[1] = pk2(S[2 * u][1][2], S[2 * u][1][3]);
        s1.w[2] = pk2(S[2 * u + 1][1][0], S[2 * u + 1][1][1]); s1.w[3] = pk2(S[2 * u + 1][1][2], S[2 * u + 1][1][3]);
#pragma unroll
        for (int tm = 0; tm < 4; ++tm) {
          const LAS unsigned char* qrow = lds + GL_QD + (16 * tm + c) * 288 + (32 * u + 4 * g) * 2;
          const s16x4_t q0 = *(const LAS s16x4_t*)qrow, q1 = *(const LAS s16x4_t*)(qrow + 32);
          const bf16x8_t a = (bf16x8_t){q0[0], q0[1], q0[2], q0[3], q1[0], q1[1], q1[2], q1[3]};
          o[tm][0] = __builtin_amdgcn_mfma_f32_16x16x32_bf16(a, s0.v, o[tm][0], 0, 0, 0);
          o[tm][1] = __builtin_amdgcn_mfma_f32_16x16x32_bf16(a, s1.v, o[tm][1], 0, 0, 0);
        }
        __builtin_amdgcn_sched_barrier(0);
      }
#pragma unroll
      for (int tk = 0; tk < 8; ++tk) {
        const f32x4 dec4 = *(const LAS f32x4*)(DEC + 16 * tk + 4 * g);
        S[tk][0] *= dec4; S[tk][1] *= dec4;
        s16x4_t lo0 = tr_read_b64(ketr + tk * 32), hi0 = tr_read_b64(ketr + 4 * 288 + tk * 32);
        s16x4_t lo1 = tr_read_b64(ketr + 32 * 288 + tk * 32), hi1 = tr_read_b64(ketr + 36 * 288 + tk * 32);
        asm volatile("s_waitcnt lgkmcnt(0)" ::: "memory");
        __builtin_amdgcn_sched_barrier(0);
        const bf16x8_t a0 = (bf16x8_t){lo0[0], lo0[1], lo0[2], lo0[3], hi0[0], hi0[1], hi0[2], hi0[3]};
        const bf16x8_t a1 = (bf16x8_t){lo1[0], lo1[1], lo1[2], lo1[3], hi1[0], hi1[1], hi1[2], hi1[3]};
        S[tk][0] = __builtin_amdgcn_mfma_f32_16x16x32_bf16(a0, vf[0][0], S[tk][0], 0, 0, 0);
        S[tk][1] = __builtin_amdgcn_mfma_f32_16x16x32_bf16(a0, vf[0][1], S[tk][1], 0, 0, 0);
        S[tk][0] = __builtin_amdgcn_mfma_f32_16x16x32_bf16(a1, vf[1][0], S[tk][0], 0, 0, 0);
        S[tk][1] = __builtin_amdgcn_mfma_f32_16x16x32_bf16(a1, vf[1][1], S[tk][1], 0, 0, 0);
        __builtin_amdgcn_sched_barrier(0);
      }
#pragma unroll
      for (int tm = 0; tm < 4; ++tm)
#pragma unroll
        for (int r = 0; r < 4; ++r) {
          float ss = o[tm][0][r] * o[tm][0][r] + o[tm][1][r] * o[tm][1][r];
          ss = row16_sum(ss);
          if (c == 0) SSQ[(16 * tm + 4 * g + r) * 8 + wave] = ss;
        }
    }
    GLA_MARK(5); GLA_BAR();
    {
      LAS bf16* OB = (LAS bf16*)(lds + GL_LB);
#pragma unroll
      for (int tm = 0; tm < 4; ++tm)
#pragma unroll
        for (int r = 0; r < 4; ++r) {
          const int t = 16 * tm + 4 * g + r;
          const f32x4 p0 = *(const LAS f32x4*)(SSQ + t * 8), p1 = *(const LAS f32x4*)(SSQ + t * 8 + 4);
          const float tot = ((p0[0] + p0[1]) + (p0[2] + p0[3])) + ((p1[0] + p1[1]) + (p1[2] + p1[3]));
          const float rstd = rsqrtf(tot * (1.f / 256.f) + 1e-6f);
          OB[t * 256 + 32 * wave + c] = f2bf(o[tm][0][r] * rstd * gn0);
          OB[t * 256 + 32 * wave + 16 + c] = f2bf(o[tm][1][r] * rstd * gn1);
        }
    }
    GLA_MARK(6); GLA_BAR();
#pragma unroll
    for (int i = 0; i < 4; ++i) {
      const int id = tid + 512 * i, tk = id >> 5, part = id & 31;
      const u32x4_t ov = *(const LAS u32x4_t*)(lds + GL_LB + tk * 512 + part * 16);
      const u32x4_t sv = rs[i];
      u32x4_t gv;
      gv[0] = pk2(bflo(ov[0]) * bflo(sv[0]), bfhi(ov[0]) * bfhi(sv[0]));
      gv[1] = pk2(bflo(ov[1]) * bflo(sv[1]), bfhi(ov[1]) * bfhi(sv[1]));
      gv[2] = pk2(bflo(ov[2]) * bflo(sv[2]), bfhi(ov[2]) * bfhi(sv[2]));
      gv[3] = pk2(bflo(ov[3]) * bflo(sv[3]), bfhi(ov[3]) * bfhi(sv[3]));
      *(u32x4_t*)(Vg + (tb + tk) * 1024 + h * 256 + part * 8) = gv;
    }
    GLA_MARK(7);
  }
#undef GLA_LOAD
  __syncthreads();
}

#define LDS_BYTES 155712
#define OFF_XBAR (224ull * 1024)
#define OFF_CTR (200ull * 1024)

__device__ __forceinline__ unsigned xcc_id() { return (unsigned)__builtin_amdgcn_s_getreg((3 << 11) | 20) & 0x7u; }
__device__ __forceinline__ void ph_mixer(const P& p, unsigned char* lds_raw, bool do_gla) {
  if (do_gla && blockIdx.x < 32) { gla_item(p, lds_raw, blockIdx.x); if (blockIdx.x == 0) TS_SET(p, 20); }
  unsigned* ctr = (unsigned*)(p.ws + OFF_CTR);
  LAS unsigned* slot = (LAS unsigned*)((LAS unsigned char*)lds_raw + DS_TOTAL);
  const unsigned home = xcc_id();
  unsigned k = 0;
  for (;;) {
    if (tid_fresh() == 0) {
      unsigned qi = 0xffffffffu;
      while (k < 8) {
        const unsigned b = (home + k) & 7u;
        const unsigned v = __hip_atomic_fetch_add(ctr + 64 * b, 1u, __ATOMIC_RELAXED, __HIP_MEMORY_SCOPE_AGENT);
        if (v < 128u) { qi = (b << 8) | v; break; }
        ++k;
      }
      slot[0] = qi; slot[1] = k;
    }
    __syncthreads();
    const unsigned qi = slot[0];
    k = slot[1];
    __syncthreads();
    if (qi == 0xffffffffu) break;
    dsa_batch(p, lds_raw, (int)(qi >> 8), 127 - (int)(qi & 255u));
  }
}

__global__ void __launch_bounds__(512, 2) mega(P p) {
  extern __shared__ __attribute__((aligned(16))) unsigned char lds_raw[];
  LAS unsigned char* lds = (LAS unsigned char*)lds_raw;
  cg::grid_group grid = cg::this_grid();
  char* ws = p.ws;
  const int bid = blockIdx.x, nb = gridDim.x;
  if (bid == 0 && threadIdx.x < 8) *(unsigned*)(ws + OFF_CTR + 256 * threadIdx.x) = 0u;
  if (bid == 0) { for (int i = threadIdx.x; i < XCD_BAR_WORDS; i += 512) ((unsigned*)(ws + OFF_XBAR))[i] = 0u; }
  volatile LAS unsigned* xst = (volatile LAS unsigned*)(lds + DS_TOTAL + 16);
  if (threadIdx.x < 4) xst[threadIdx.x] = 0u;
#if PROBE_TS
  { const int t_ = tid_fresh(); if (bid == 0 && t_ < 64) ((unsigned long long*)(ws + OFF_TS))[t_] = 0ull; }
  __syncthreads();
  if (bid == 0) TS_SET(p, 0);
#endif
  ph_prep(p, (float*)lds_raw);
  grid.sync();
  const XcdBarrier xb = xcd_barrier_post((unsigned*)(ws + OFF_XBAR), xst);
  if (bid == 0) TS_SET(p, 1);
  ph_mod(p, p.x, p.norm1_g, 0, 1024, (bf16*)(ws + OFF_H), bid, nb);
  xcd_barrier(xb);
  if (bid == 0) TS_SET(p, 2);
  gemm_run(lds, (const bf16*)(ws + OFF_H), (const bf16*)(ws + OFF_WT_IN), TT, 7168, 1024, EpiIn{ws, p.out});
  xcd_barrier(xb);
  if (bid == 0) TS_SET(p, 3);
  ph_mixer(p, lds_raw, true);
  if (bid == 0) TS_SET(p, 21);
  xcd_barrier(xb);
  if (bid == 0) TS_SET(p, 4);
  gemm_run(lds, (const bf16*)(ws + OFF_V), (const bf16*)(ws + OFF_WT_A), TT, 1024, 1024,
           EpiMix<false>{(const bf16*)p.out, (bf16*)(ws + OFF_MIX)});
  gemm_run(lds, (const bf16*)(ws + OFF_ODSA), (const bf16*)(ws + OFF_WT_B), TT, 1024, 1024,
           EpiMix<true>{(const bf16*)p.out + (size_t)TT * 1024, (bf16*)(ws + OFF_MIX)});
  xcd_barrier(xb);
  if (bid == 0) TS_SET(p, 5);
  gemm_run(lds, (const bf16*)(ws + OFF_MIX), (const bf16*)(ws + OFF_WT_OUT), TT, 1024, 1024,
           EpiX1{p.x, (const float*)(ws + OFF_ADA), p.out});
  xcd_barrier(xb);
  if (bid == 0) TS_SET(p, 6);
  ph_mod(p, p.out, (const float*)(ws + OFF_PRM) + PRM_N2G, 3072, 4096, (bf16*)(ws + OFF_H), bid, nb);
  xcd_barrier(xb);
  if (bid == 0) TS_SET(p, 7);
  gemm_run(lds, (const bf16*)(ws + OFF_H), (const bf16*)(ws + OFF_WT_Q), TT, 2048, 1024, EpiPlain{(bf16*)(ws + OFF_PQ), 2048});
  xcd_barrier(xb);
  if (bid == 0) TS_SET(p, 8);
  ph_peer512(p, lds_raw, p.out);
#if PROBE_TS
  if (bid == 0) TS_SET(p, 18);
  xcd_barrier(xb);
  {
    const unsigned long long* T = (const unsigned long long*)(ws + OFF_TS);
    const unsigned long long q = (unsigned long long)(PROBE_Q), t0 = __builtin_amdgcn_s_memrealtime();
    while (__builtin_amdgcn_s_memrealtime() - t0 < q) __builtin_amdgcn_s_sleep(8);
  }
#endif
}

extern "C" void kernel_launch(void* const* d_in, const int* in_sizes, int n_in, void* d_out, int out_size, void* d_ws,
                              size_t ws_size, hipStream_t stream) {
  P p{};
  const float** f = (const float**)&p;
  for (int i = 0; i < 22; ++i) f[i] = (const float*)d_in[i];
  p.out = (float*)d_out;
  p.ws = (char*)d_ws;
  if (ws_size < WS_NEED) { fprintf(stderr, "workspace too small: %zu\n", ws_size); return; }
  static int grid_blocks = 0;
  if (!grid_blocks) {
    int dev = 0, cus = 0, per_cu = 0;
    (void)hipGetDevice(&dev);
    (void)hipDeviceGetAttribute(&cus, hipDeviceAttributeMultiprocessorCount, dev);
    if (hipFuncSetAttribute((const void*)mega, hipFuncAttributeMaxDynamicSharedMemorySize, LDS_BYTES) != hipSuccess) {
      fprintf(stderr, "hipFuncSetAttribute failed\n"); grid_blocks = -1; return;
    }
    if (hipOccupancyMaxActiveBlocksPerMultiprocessor(&per_cu, (const void*)mega, 512, LDS_BYTES) != hipSuccess || per_cu < 1) {
      fprintf(stderr, "occupancy query failed\n"); grid_blocks = -1; return;
    }
    grid_blocks = cus;
  }
  if (grid_blocks <= 0) return;
  void* args[] = {&p};
  hipError_t e = hipLaunchCooperativeKernel((void*)mega, dim3(grid_blocks), dim3(512), args, LDS_BYTES, stream);
  if (e != hipSuccess) fprintf(stderr, "cooperative launch failed: %s (grid %d)\n", hipGetErrorString(e), grid_blocks);
}
```

```cpp
#include <hip/hip_runtime.h>
#include <hip/hip_cooperative_groups.h>
#include <cstdio>
#include <cstdint>
namespace cg = cooperative_groups;

#define TT 32768
#define SEQ 4096
#define DM 1024
#define NIN 7000
typedef unsigned short bf16;
#define LAS __attribute__((address_space(3)))

struct P {
  const float *x, *c, *w_ada, *b_ada, *norm1_g, *w_in, *w_gate_up, *b_gate, *gla_norm_g, *kv_norm_g,
      *w_uk, *w_uv, *w_a, *w_b, *w_out, *norm2_g, *w_q, *sk1, *sk2, *peer_u, *peer_v, *final_g;
  float* out;
  char* ws;
};

#define MB (1ull << 20)
#define OFF_ADA   (0ull)
#define OFF_H     (1 * MB)
#define OFF_ODSA  (1 * MB)
#define OFF_Q     (65 * MB)
#define OFF_K     (97 * MB)
#define OFF_MIX   (65 * MB)
#define OFF_V     (129 * MB)
#define OFF_DQ    (193 * MB)
#define OFF_PQ    (129 * MB)
#define OFF_DSCR  (257 * MB)
#define OFF_SSP   (256ull * 1024)
#define OFF_CKV   (289 * MB)
#define OFF_IQ    (305 * MB)
#define OFF_IK    (337 * MB)
#define OFF_IW    (341 * MB)
#define OFF_GLOW  (342 * MB)
#define OFF_SGR   (344 * MB)
#define OFF_WT    (408 * MB)
#define OFF_WT_IN  (OFF_WT)
#define OFF_WT_A   (OFF_WT + 7168ull * 2048)
#define OFF_WT_B   (OFF_WT_A + 1024ull * 2048)
#define OFF_WT_OUT (OFF_WT_B + 1024ull * 2048)
#define OFF_WT_Q   (OFF_WT_OUT + 1024ull * 2048)
#define OFF_PU    (432 * MB)
#define OFF_PV    (464 * MB)
#define OFF_SK    (496 * MB)
#define OFF_PSC   (496 * MB + 128 * 1024)
#define OFF_WUK   (497 * MB)
#define OFF_WUV   (497 * MB + 512 * 1024)
#define WS_NEED   (498 * MB)

__device__ __forceinline__ bf16 f2bf(float f) {
  unsigned u = __float_as_uint(f);
  u += 0x7fffu + ((u >> 16) & 1u);
  return (bf16)(u >> 16);
}
__device__ __forceinline__ unsigned pk2(float lo, float hi) { return (unsigned)f2bf(lo) | ((unsigned)f2bf(hi) << 16); }
__device__ __forceinline__ float bf2f(bf16 h) { return __uint_as_float(((unsigned)h) << 16); }
__device__ __forceinline__ float bflo(unsigned u) { return __uint_as_float(u << 16); }
__device__ __forceinline__ float bfhi(unsigned u) { return __uint_as_float(u & 0xffff0000u); }
__device__ __forceinline__ float wave_sum(float v) {
#pragma unroll
  for (int o = 32; o > 0; o >>= 1) v += __shfl_xor(v, o);
  return v;
}
__device__ __forceinline__ float wave_max(float v) {
#pragma unroll
  for (int o = 32; o > 0; o >>= 1) v = fmaxf(v, __shfl_xor(v, o));
  return v;
}
#ifndef PROBE_TS
#define PROBE_TS 0
#endif
#define OFF_PRM (800ull * 1024)
#define PRM_WGU   0
#define PRM_BG    8192
#define PRM_GNG   8704
#define PRM_N2G   9728
#define PRM_FG    10752
#define PRM_TOTAL 11776
#define OFF_TS (208ull * 1024)
#if PROBE_TS
#define TS_SET(p, k) do { if (tid_fresh() == 0) ((unsigned long long*)((p).ws + OFF_TS))[k] = __builtin_amdgcn_s_memrealtime(); } while (0)
#define TS_ADD(p, k, t0) do { if (tid_fresh() == 0) ((unsigned long long*)((p).ws + OFF_TS))[k] += __builtin_amdgcn_s_memrealtime() - (t0); } while (0)
#define TS_NOW() __builtin_amdgcn_s_memrealtime()
#else
#define TS_SET(p, k) do {} while (0)
#define TS_ADD(p, k, t0) do {} while (0)
#define TS_NOW() 0ull
#endif
__device__ __forceinline__ int tid_fresh() { int t = threadIdx.x; asm volatile("" : "+v"(t)); return t; }
__device__ __forceinline__ float sigmoidf_(float v) { return 1.f / (1.f + __expf(-v)); }
__device__ __forceinline__ float siluf_(float v) { return v / (1.f + __expf(-v)); }

#include <hip/hip_runtime.h>
namespace pg8 {
#define PG8_LAS __attribute__((address_space(3)))
typedef unsigned short bf16_t;
typedef short bf16x8 __attribute__((ext_vector_type(8)));
typedef float f32x4 __attribute__((ext_vector_type(4)));
typedef unsigned u32x4 __attribute__((ext_vector_type(4)));
constexpr int BM = 256, BK = 64, HALF = 128, HTB = HALF * BK * 2  , STAGE_BYTES = 8 * HTB, NXCD = 8, WGM = 8;

__host__ __device__ __forceinline__ int lds_byte(int r, int c) { const int st = (r >> 4) * 2 + (c >> 5), rr = r & 15, cc = c & 31, ob = rr * 64 + cc * 2; return st * 1024 + (ob ^ (((ob >> 9) & 1) << 5)); }
__host__ __device__ __forceinline__ void stage_rc(int b, int& R, int& C) { const int st = b / 1024, sb = b % 1024, swz = sb ^ (((sb >> 9) & 1) << 5); R = (st >> 1) * 16 + swz / 64; C = (st & 1) * 32 + (swz % 64) / 2; }
__host__ __device__ __forceinline__ int perm32(int rho) { const int n = rho >> 4, i = rho & 15; return 8 * (i >> 2) + 4 * n + (i & 3); }

struct Unit { int pm, pn; };
struct Gemm { const bf16_t* A; const bf16_t* Bt; int M, N, K; };

struct StaticOrder {
    int nM, nN, nwg, G, c;
    __host__ __device__ void init(int M, int N, int G_, int c_) { nM = M / BM; nN = N / BM; nwg = nM * nN; G = G_; c = c_; }
    __host__ __device__ bool next(int i, Unit& u) const {
        const long L = (long)i * G + c; if (L >= nwg) return false;
        int wgid = (int)L; { const int q = nwg / NXCD, r = nwg % NXCD, xcd = wgid % NXCD, off = wgid / NXCD; wgid = (xcd < r ? xcd * (q + 1) : r * (q + 1) + (xcd - r) * q) + off; }
        const int nig = WGM * nN, gid = wgid / nig, fm = gid * WGM, gsz = (nM - fm) < WGM ? (nM - fm) : WGM;
        u.pm = fm + ((wgid % nig) % gsz); u.pn = (wgid % nig) / gsz; return true;
    }
    __device__ __forceinline__ void a_ready(const Unit&) const {}
    __device__ __forceinline__ void done(const Unit&) const {}
};
__device__ __forceinline__ unsigned cvt_pk_bf16(float lo, float hi) { unsigned r; asm volatile("v_cvt_pk_bf16_f32 %0, %1, %2" : "=v"(r) : "v"(lo), "v"(hi)); return r; }

template <class Epi, class Sched, bool STAMP = false>
__device__ __forceinline__ void gemm_phase(PG8_LAS unsigned char* lds, const Gemm g, const Sched& S, const Epi& E, unsigned long long* stamps) {
    const int tid = ::tid_fresh(), wid = __builtin_amdgcn_readfirstlane(tid >> 6), lane = tid & 63, wr = wid >> 2, wc = wid & 3, fr = lane & 15, fq = lane >> 4;
    const int K = g.K, nt = K / BK;
    int ts_lo = 0, ts_hi = 0, nts = 0; const unsigned long long rt_entry = STAMP ? (unsigned long long)wall_clock64() : 0ull;
#define PG8_STAMP() do { if (STAMP && wid == 0 && nts < 64) { const unsigned long long _c = (unsigned long long)clock64(); \
        ts_lo = (lane == nts) ? (int)(unsigned)_c : ts_lo; ts_hi = (lane == nts) ? (int)(unsigned)(_c >> 32) : ts_hi; ++nts; } } while (0)
    PG8_STAMP();
    unsigned voffA[2], voffB[2];
#pragma unroll
    for (int i = 0; i < 2; ++i) { int R, C; stage_rc(tid * 16 + i * 8192, R, C); const int Rb = Epi::PERM ? ((R & ~31) + perm32(R & 31)) : R;
        voffA[i] = (unsigned)(R * K + C) * 2u; voffB[i] = (unsigned)(Rb * K + C) * 2u; }
    const size_t kstep = (size_t)(BK * 2);
    const size_t hstep = (size_t)HALF * K * 2;
    const size_t tstep = 2 * hstep;
    const unsigned ldsw = (unsigned)wid * 1024u;
    const int aoff = lds_byte(wr * 64 + fr, fq * 8), boff = lds_byte(wc * 32 + fr, fq * 8);
#define PG8_SA(b, h) (((b) * 2 + (h)) * HTB)
#define PG8_SB(b, h) ((4 + (b) * 2 + (h)) * HTB)
#define PG8_STAGE(bufoff, gbase, voff) do { _Pragma("unroll") for (int _i = 0; _i < 2; ++_i) \
        __builtin_amdgcn_global_load_lds((const unsigned*)((const char*)(gbase) + (voff)[_i]), (PG8_LAS unsigned*)(lds + (bufoff) + ldsw + _i * 8192), 16, 0, 0); } while (0)
#define PG8_LDA(dst, b, h) do { _Pragma("unroll") for (int m = 0; m < 4; ++m) _Pragma("unroll") for (int k = 0; k < 2; ++k) dst[m][k] = *(const PG8_LAS bf16x8*)(lds + PG8_SA(b, h) + aoff + m * 2048 + k * 1024); } while (0)
#define PG8_LDB(dst, b, h) do { _Pragma("unroll") for (int n = 0; n < 2; ++n) _Pragma("unroll") for (int k = 0; k < 2; ++k) dst[n][k] = *(const PG8_LAS bf16x8*)(lds + PG8_SB(b, h) + boff + n * 2048 + k * 1024); } while (0)
#define PG8_MMA(ai, bj, At, Bt) do { __builtin_amdgcn_s_setprio(1); _Pragma("unroll") for (int m = 0; m < 4; ++m) _Pragma("unroll") for (int n = 0; n < 2; ++n) _Pragma("unroll") for (int k = 0; k < 2; ++k) \
        acc[ai][bj][m][n] = __builtin_amdgcn_mfma_f32_16x16x32_bf16(Bt[n][k], At[m][k], acc[ai][bj][m][n], 0, 0, 0); __builtin_amdgcn_s_setprio(0); } while (0)
#define PG8_WAIT_V(n) asm volatile("s_waitcnt vmcnt(" #n ")" ::: "memory")
#define PG8_WAIT_L(n) asm volatile("s_waitcnt lgkmcnt(" #n ")" ::: "memory")
#define PG8_BAR __builtin_amdgcn_s_barrier()
#define PG8_SCHED __builtin_amdgcn_sched_barrier(0)
    Unit cur, nxt; int ui = 0;
    if (!S.next(0, cur)) return;
    f32x4 acc[2][2][4][2];
#pragma unroll
    for (int a = 0; a < 2; ++a)
#pragma unroll
        for (int b = 0; b < 2; ++b)
#pragma unroll
            for (int m = 0; m < 4; ++m)
#pragma unroll
                for (int n = 0; n < 2; ++n) acc[a][b][m][n] = (f32x4){0.f, 0.f, 0.f, 0.f};
    bf16x8 At[4][2], B0[2][2], B1[2][2];
    const char* cA = (const char*)g.A + (size_t)cur.pm * tstep; const char* cB = (const char*)g.Bt + (size_t)cur.pn * tstep;
    S.a_ready(cur);
    PG8_STAGE(PG8_SB(0, 0), cB, voffB); PG8_STAGE(PG8_SA(0, 0), cA, voffA); PG8_STAGE(PG8_SB(0, 1), cB + hstep, voffB); PG8_STAGE(PG8_SA(0, 1), cA + hstep, voffA);
    if (wr == 1) PG8_BAR;
    PG8_WAIT_V(4); PG8_BAR;
    PG8_STAGE(PG8_SB(1, 0), cB + kstep, voffB); PG8_STAGE(PG8_SA(1, 0), cA + kstep, voffA); PG8_STAGE(PG8_SB(1, 1), cB + hstep + kstep, voffB);
    PG8_WAIT_V(6); PG8_BAR;
    PG8_STAMP();
    for (;;) {
        const bool has_next = S.next(ui + 1, nxt);
        const char* nA = has_next ? (const char*)g.A + (size_t)nxt.pm * tstep : cA; const char* nB = has_next ? (const char*)g.Bt + (size_t)nxt.pn * tstep : cB;
        for (int t = 0; t < nt; t += 2) {
            const bool last = (t == nt - 2);
            const char* a1 = cA + (size_t)(t + 1) * kstep;
            const char* a2 = last ? nA : cA + (size_t)(t + 2) * kstep; const char* b2 = last ? nB : cB + (size_t)(t + 2) * kstep;
            const char* a3 = a2 + kstep; const char* b3 = b2 + kstep;
            if (last && has_next) S.a_ready(nxt);
            PG8_LDB(B0, 0, 0); PG8_SCHED; PG8_LDA(At, 0, 0); PG8_STAGE(PG8_SA(1, 1), a1 + hstep, voffA);
            PG8_WAIT_L(8); PG8_BAR; PG8_WAIT_L(0); PG8_MMA(0, 0, At, B0); PG8_BAR; PG8_SCHED;
            PG8_LDB(B1, 0, 1); PG8_STAGE(PG8_SB(0, 0), b2, voffB);
            PG8_BAR; PG8_WAIT_L(0); PG8_MMA(0, 1, At, B1); PG8_BAR;
            PG8_LDA(At, 0, 1); PG8_STAGE(PG8_SA(0, 0), a2, voffA);
            PG8_BAR; PG8_WAIT_L(0); PG8_MMA(1, 0, At, B0); PG8_BAR; PG8_SCHED;
            PG8_STAGE(PG8_SB(0, 1), b2 + hstep, voffB);
            PG8_WAIT_V(6); PG8_BAR; PG8_MMA(1, 1, At, B1); PG8_BAR;
            PG8_LDB(B0, 1, 0); PG8_SCHED; PG8_LDA(At, 1, 0); PG8_STAGE(PG8_SA(0, 1), a2 + hstep, voffA);
            PG8_WAIT_L(8); PG8_BAR; PG8_WAIT_L(0); PG8_MMA(0, 0, At, B0); PG8_BAR; PG8_SCHED;
            PG8_LDB(B1, 1, 1); PG8_STAGE(PG8_SB(1, 0), b3, voffB);
            PG8_BAR; PG8_WAIT_L(0); PG8_MMA(0, 1, At, B1); PG8_BAR;
            PG8_LDA(At, 1, 1); PG8_STAGE(PG8_SA(1, 0), a3, voffA);
            PG8_BAR; PG8_WAIT_L(0); PG8_MMA(1, 0, At, B0); PG8_BAR; PG8_SCHED;
            PG8_STAGE(PG8_SB(1, 1), b3 + hstep, voffB);
            PG8_WAIT_V(6); PG8_BAR; PG8_MMA(1, 1, At, B1); PG8_BAR;
        }
        PG8_STAMP();
        if constexpr (!Epi::AFTER_DRAIN) { E(acc, cur, wr, wc, fr, fq); S.done(cur); }
        PG8_STAMP();
        if (!has_next) break;
#pragma unroll
        for (int a = 0; a < 2; ++a)
#pragma unroll
            for (int b = 0; b < 2; ++b)
#pragma unroll
                for (int m = 0; m < 4; ++m)
#pragma unroll
                    for (int n = 0; n < 2; ++n) acc[a][b][m][n] = (f32x4){0.f, 0.f, 0.f, 0.f};
        cur = nxt; cA = nA; cB = nB; ++ui;
    }
    PG8_WAIT_V(0);
    if (wr == 0) PG8_BAR;
    PG8_BAR;
    if constexpr (Epi::AFTER_DRAIN) { E.fused(acc, cur, wr, wc, fr, fq, lds, wid, lane); S.done(cur); }
    PG8_STAMP();
    if (STAMP && wid == 0) { stamps[lane] = lane < nts ? (((unsigned long long)(unsigned)ts_hi << 32) | (unsigned)ts_lo) : 0ull;
        if (lane == 62) stamps[62] = rt_entry; if (lane == 63) stamps[63] = (unsigned long long)wall_clock64(); }
#undef PG8_STAMP
#undef PG8_SA
#undef PG8_SB
#undef PG8_STAGE
#undef PG8_LDA
#undef PG8_LDB
#undef PG8_MMA
#undef PG8_WAIT_V
#undef PG8_WAIT_L
#undef PG8_BAR
#undef PG8_SCHED
}
}
#define XB_TMO      128
#define XB_XCNT(j)  (256  + 64 * (j))
#define XB_XSUB(j)  (1280 + 64 * (j))
#define XB_XGEN(j)  (2304 + 64 * (j))
#define XB_TOP      3328
#define XB_TOPGEN   3392
#define XCD_BAR_WORDS 3456
#define XB_SPIN_CAP (1u << 18)

__device__ __forceinline__ unsigned xb_ld(unsigned* p)              { return __hip_atomic_load(p, __ATOMIC_RELAXED, __HIP_MEMORY_SCOPE_AGENT); }
__device__ __forceinline__ unsigned xb_add(unsigned* p, unsigned v) { return __hip_atomic_fetch_add(p, v, __ATOMIC_RELAXED, __HIP_MEMORY_SCOPE_AGENT); }
__device__ __forceinline__ unsigned xb_xcc_id() { return (unsigned)__builtin_amdgcn_s_getreg((3 << 11) | 20) & 0xFu; }
#define XB_SPIN(cond, bar) do { unsigned _sp = 0; while (cond) { __builtin_amdgcn_s_sleep(1); \
    if ((++_sp & 255u) == 0u) { if (xb_ld(&(bar)[XB_TMO])) break; if (_sp > XB_SPIN_CAP) { atomicAdd(&(bar)[XB_TMO], 1u); break; } } } } while (0)

struct XcdBarrier {
    unsigned* bar; unsigned x;
    volatile LAS unsigned* st;
};

__device__ __forceinline__ XcdBarrier xcd_barrier_post(unsigned* bar, volatile LAS unsigned* st) {
    XcdBarrier b; b.bar = bar; b.x = xb_xcc_id(); b.st = st;
    if (threadIdx.x == 0) (void)xb_add(&bar[XB_XCNT(b.x)], 1u);
    return b;
}
__device__ __forceinline__ void xcd_barrier_complete(unsigned* bar, unsigned x, unsigned& nloc, unsigned& nx) {
    const unsigned G = gridDim.x * gridDim.y * gridDim.z;
    unsigned sum, cnt, mine, sp = 0u;
    for (;;) {
        sum = 0u; cnt = 0u; mine = 0u;
#pragma unroll
        for (unsigned j = 0; j < 16; ++j) { const unsigned c = xb_ld(&bar[XB_XCNT(j)]); sum += c; cnt += (c > 0u) ? 1u : 0u; mine = (j == x) ? c : mine; }
        if (sum == G) break;
        __builtin_amdgcn_s_sleep(1);
        if ((++sp & 255u) == 0u) { if (xb_ld(&bar[XB_TMO])) break; if (sp > XB_SPIN_CAP) { atomicAdd(&bar[XB_TMO], 1u); break; } }
    }
    nloc = mine > 0u ? mine : 1u; nx = cnt > 0u ? cnt : 1u;
}

__device__ __forceinline__ void xcd_barrier(const XcdBarrier& b) {
    asm volatile("s_waitcnt vmcnt(0)" ::: "memory");
    __syncthreads();
    if (threadIdx.x == 0) {
        unsigned* bar = b.bar;
        __builtin_amdgcn_s_waitcnt(0);
        unsigned nloc = b.st[0], nx = b.st[1];
        if (nloc == 0u) { xcd_barrier_complete(bar, b.x, nloc, nx); b.st[0] = nloc; b.st[1] = nx; }
        const unsigned old = xb_add(&bar[XB_XSUB(b.x)], 1u);
        const unsigned gen = old / nloc;
        if (old + 1u == (gen + 1u) * nloc) {
            __builtin_amdgcn_fence(__ATOMIC_RELEASE, "agent");
            asm volatile("s_waitcnt vmcnt(0)" ::: "memory");
            const unsigned og = xb_add(&bar[XB_TOP], 1u);
            const unsigned tg = og / nx;
            if (og + 1u == (tg + 1u) * nx) xb_add(&bar[XB_TOPGEN], 1u);
            else XB_SPIN(xb_ld(&bar[XB_TOPGEN]) == tg, bar);
            __builtin_amdgcn_fence(__ATOMIC_ACQUIRE, "agent");
            xb_add(&bar[XB_XGEN(b.x)], 1u);
            asm volatile("s_waitcnt vmcnt(0)" ::: "memory");
        } else {
            XB_SPIN(xb_ld(&bar[XB_XGEN(b.x)]) == gen, bar);
            __builtin_amdgcn_fence(__ATOMIC_ACQUIRE, "agent");
            asm volatile("s_waitcnt vmcnt(0)" ::: "memory");
        }
    }
    __syncthreads();
}

__device__ __forceinline__ void ph_mod(const P& p, const float* X, const float* g, int shift_off, int scale_off, bf16* H, int bid, int nb) {
  const float* ada = (const float*)(p.ws + OFF_ADA);
  const int tidm = tid_fresh(); int wave = tidm >> 6, lane = tidm & 63;
  const int rstride = nb * (int)(blockDim.x >> 6);
  int row = bid * (int)(blockDim.x >> 6) + wave;
  float4 v[4];
  if (row < TT) {
    const float4* xr = (const float4*)(X + (size_t)row * DM);
#pragma unroll
    for (int i = 0; i < 4; ++i) v[i] = xr[lane + i * 64];
  }
  for (; row < TT; row += rstride) {
    float4 vn[4];
    const int nrow = row + rstride;
    {
      const float4* xn = (const float4*)(X + (size_t)((nrow < TT) ? nrow : row) * DM);
#pragma unroll
      for (int i = 0; i < 4; ++i) vn[i] = xn[lane + i * 64];
    }
    float ss = 0.f;
#pragma unroll
    for (int i = 0; i < 4; ++i) ss += v[i].x * v[i].x + v[i].y * v[i].y + v[i].z * v[i].z + v[i].w * v[i].w;
    ss = wave_sum(ss);
    float rstd = rsqrtf(ss * (1.f / DM) + 1e-6f);
    int b = row >> 12;
    const float* sh = ada + b * 6144 + shift_off;
    const float* sc = ada + b * 6144 + scale_off;
#pragma unroll
    for (int i = 0; i < 4; ++i) {
      int c0 = (lane + i * 64) * 4;
      float4 gg = *(const float4*)(g + c0);
      float4 s4 = *(const float4*)(sc + c0);
      float4 h4 = *(const float4*)(sh + c0);
      ushort4 o;
      o.x = f2bf(v[i].x * rstd * gg.x * (1.f + s4.x) + h4.x);
      o.y = f2bf(v[i].y * rstd * gg.y * (1.f + s4.y) + h4.y);
      o.z = f2bf(v[i].z * rstd * gg.z * (1.f + s4.z) + h4.z);
      o.w = f2bf(v[i].w * rstd * gg.w * (1.f + s4.w) + h4.w);
      *(ushort4*)(H + (size_t)row * DM + c0) = o;
    }
#pragma unroll
    for (int i = 0; i < 4; ++i) v[i] = vn[i];
  }
}

using pg8::f32x4;
using pg8::u32x4;
using pg8::Unit;
using pg8::cvt_pk_bf16;
typedef short s16x4_t __attribute__((ext_vector_type(4)));
typedef unsigned u32x4_t __attribute__((ext_vector_type(4)));
typedef unsigned short u16x4_t __attribute__((ext_vector_type(4)));

__device__ __forceinline__ int in_srcmap(int d) {
  if (d < 2048) return d;
  if (d < 3072) return 3088 + (d - 2048);
  if (d < 3328) return 4112 + (d - 3072);
  if (d < 3840) return 4368 + (d - 3328);
  if (d < 3904) return 4880 + (d - 3840);
  if (d < 3912) return 4944 + (d - 3904);
  if (d < 3928) return 3072 + (d - 3912);
  if (d < 4096) return -1;
  if (d < 5120) return 2048 + (d - 4096);
  return 4952 + (d - 5120);
}
template <bool MAP>
__device__ __forceinline__ void transpose_item(const float* W, int ldw, int K, bf16* WT, int item, int nblk, float* scr, int lane) {
  const int kb = item / nblk, nbk = item % nblk, k0 = 64 * kb, n0 = 32 * nbk;
  const int d = n0 + (lane & 31);
  const int src = MAP ? in_srcmap(d) : d;
#pragma unroll 8
  for (int i = 0; i < 32; ++i) {
    const int kk = 2 * i + (lane >> 5);
    scr[kk * 33 + (lane & 31)] = (src >= 0) ? W[(size_t)(k0 + kk) * ldw + src] : 0.f;
  }
  asm volatile("s_waitcnt lgkmcnt(0)" ::: "memory");
  const int c = lane & 7;
#pragma unroll
  for (int j = 0; j < 4; ++j) {
    const int n = (lane >> 3) + 8 * j;
    const float* s = scr + (8 * c) * 33 + n;
    uint4 o;
    o.x = pk2(s[0 * 33], s[1 * 33]); o.y = pk2(s[2 * 33], s[3 * 33]); o.z = pk2(s[4 * 33], s[5 * 33]); o.w = pk2(s[6 * 33], s[7 * 33]);
    *(uint4*)(WT + (size_t)(n0 + n) * K + k0 + 8 * c) = o;
  }
  asm volatile("s_waitcnt lgkmcnt(0)" ::: "memory");
}

__device__ __forceinline__ void ph_prep(const P& p, float* sm) {
  const int tid = tid_fresh(), wave = tid >> 6, lane = tid & 63;
  const int bid = blockIdx.x, nb = gridDim.x;
  float* silc = sm + 8 * 2112 + 64;
  float* red = silc + 8192;
  float* ada = (float*)(p.ws + OFF_ADA);
  if (bid < 192) {
    for (int i = tid; i < 8192; i += 512) silc[i] = siluf_(p.c[i]);
    __syncthreads();
    for (int it = bid; it < 192; it += nb) {
      const int kg = tid >> 5, cn = tid & 31, n = it * 32 + cn;
      float acc[8];
#pragma unroll
      for (int b = 0; b < 8; ++b) acc[b] = 0.f;
      for (int k = kg * 64; k < kg * 64 + 64; ++k) {
        const float w = p.w_ada[(size_t)k * 6144 + n];
#pragma unroll
        for (int b = 0; b < 8; ++b) acc[b] += silc[b * 1024 + k] * w;
      }
#pragma unroll
      for (int b = 0; b < 8; ++b) red[(kg * 8 + b) * 32 + cn] = acc[b];
      __syncthreads();
      if (tid < 256) {
        const int b = tid >> 5, c2 = tid & 31;
        float s = 0.f;
#pragma unroll
        for (int g = 0; g < 16; ++g) s += red[(g * 8 + b) * 32 + c2];
        ada[b * 6144 + it * 32 + c2] = s + p.b_ada[it * 32 + c2];
      }
      __syncthreads();
    }
  }
  {
    unsigned char* PU8 = (unsigned char*)(p.ws + OFF_PU);
    unsigned char* PV8 = (unsigned char*)(p.ws + OFF_PV);
    float* PSC = (float*)(p.ws + OFF_PSC);
    for (int row = bid * 8 + wave; row < 2 * 16384; row += nb * 8) {
      const float* src = (row < 16384 ? p.peer_u : p.peer_v) + (size_t)(row & 16383) * 1024 + lane * 16;
      f32x4 v[4];
      float mx = 0.f;
#pragma unroll
      for (int q = 0; q < 4; ++q) {
        v[q] = *(const f32x4*)(src + q * 4);
        mx = fmaxf(mx, fmaxf(fmaxf(fabsf(v[q][0]), fabsf(v[q][1])), fmaxf(fabsf(v[q][2]), fabsf(v[q][3]))));
      }
      mx = wave_max(mx);
      const float sc = (mx > 0.f) ? exp2f(floorf(log2f(448.f / mx))) : 1.f;
      u32x4 o;
#pragma unroll
      for (int q = 0; q < 4; ++q) {
        int w = __builtin_amdgcn_cvt_pk_fp8_f32(v[q][0] * sc, v[q][1] * sc, 0, false);
        w = __builtin_amdgcn_cvt_pk_fp8_f32(v[q][2] * sc, v[q][3] * sc, w, true);
        o[q] = (unsigned)w;
      }
      *(u32x4*)((row < 16384 ? PU8 : PV8) + (size_t)(row & 16383) * 1024 + lane * 16) = o;
      if (lane == 0) PSC[row] = 1.f / sc;
    }
    for (int i = bid * 512 + tid; i < 2 * 2048; i += nb * 512) {
      const float* src = (i < 2048) ? p.sk1 : p.sk2;
      const int j = i & 2047;
      const float4 v0 = *(const float4*)(src + j * 8), v1 = *(const float4*)(src + j * 8 + 4);
      uint4 o; o.x = pk2(v0.x, v0.y); o.y = pk2(v0.z, v0.w); o.z = pk2(v1.x, v1.y); o.w = pk2(v1.z, v1.w);
      *(uint4*)((bf16*)(p.ws + OFF_SK) + (size_t)i * 8) = o;
    }
  }
  {
    float* prm = (float*)(p.ws + OFF_PRM);
    for (int i = bid * 512 + tid; i < PRM_TOTAL; i += nb * 512) {
      float v;
      if (i < PRM_BG) v = p.w_gate_up[i];
      else if (i < PRM_GNG) v = p.b_gate[i - PRM_BG];
      else if (i < PRM_N2G) v = p.gla_norm_g[i - PRM_GNG];
      else if (i < PRM_FG) v = p.norm2_g[i - PRM_N2G];
      else v = p.final_g[i - PRM_FG];
      prm[i] = v;
    }
  }
  {
    bf16* WUK = (bf16*)(p.ws + OFF_WUK);
    bf16* WUV = (bf16*)(p.ws + OFF_WUV);
    for (int i = bid * 512 + tid; i < 2 * 262144; i += nb * 512) {
      if (i < 262144) {
        const int d = i & 127, cc = (i >> 7) & 255, h = i >> 15;
        WUK[i] = f2bf(p.w_uk[((size_t)h * 128 + d) * 256 + cc] * p.kv_norm_g[cc] * 0.08838834764831845f);
      } else {
        const int k = i - 262144;
        const int cc = k & 255, d = (k >> 8) & 127, h = k >> 15;
        WUV[k] = f2bf(p.w_uv[((size_t)h * 256 + cc) * 128 + d] * p.kv_norm_g[cc]);
      }
    }
  }
  float* scr = sm + wave * 2112;
  const int gw = bid * 8 + wave, ngw = nb * 8;
  constexpr int I_IN = 16 * 224, I_SQ = 16 * 32, I_Q = 16 * 64;
  for (int it = gw; it < I_IN + 3 * I_SQ + I_Q; it += ngw) {
    int r = it;
    if (r < I_IN) { transpose_item<true>(p.w_in, NIN, 1024, (bf16*)(p.ws + OFF_WT_IN), r, 224, scr, lane); continue; }
    r -= I_IN;
    if (r < I_SQ) { transpose_item<false>(p.w_a, 1024, 1024, (bf16*)(p.ws + OFF_WT_A), r, 32, scr, lane); continue; }
    r -= I_SQ;
    if (r < I_SQ) { transpose_item<false>(p.w_b, 1024, 1024, (bf16*)(p.ws + OFF_WT_B), r, 32, scr, lane); continue; }
    r -= I_SQ;
    if (r < I_SQ) { transpose_item<false>(p.w_out, 1024, 1024, (bf16*)(p.ws + OFF_WT_OUT), r, 32, scr, lane); continue; }
    r -= I_SQ;
    transpose_item<false>(p.w_q, 2048, 1024, (bf16*)(p.ws + OFF_WT_Q), r, 64, scr, lane);
  }
}


struct EpiIn {
  static constexpr bool PERM = true, AFTER_DRAIN = false;
  char* ws; float* out;
  __device__ __forceinline__ void operator()(const f32x4 (&acc)[2][2][4][2], const Unit& u, int wr, int wc, int fr, int fq) const {
    const int pn = u.pn;
    const int row0 = u.pm * 256 + wr * 64 + fr, cl0 = wc * 32 + 8 * fq;
    if (pn == 12) {
      bf16* dst = (bf16*)(ws + OFF_CKV);
      float* ssp = (float*)(ws + OFF_SSP);
#pragma unroll
      for (int ai = 0; ai < 2; ++ai)
#pragma unroll
        for (int m = 0; m < 4; ++m) {
          const size_t row = row0 + ai * 128 + m * 16;
          float ss = 0.f;
#pragma unroll
          for (int bj = 0; bj < 2; ++bj) {
            const f32x4 v0 = acc[ai][bj][m][0], v1 = acc[ai][bj][m][1];
            ss += (v0[0] * v0[0] + v0[1] * v0[1]) + (v0[2] * v0[2] + v0[3] * v0[3]) + (v1[0] * v1[0] + v1[1] * v1[1]) + (v1[2] * v1[2] + v1[3] * v1[3]);
            u32x4 w; w.x = cvt_pk_bf16(v0[0], v0[1]); w.y = cvt_pk_bf16(v0[2], v0[3]); w.z = cvt_pk_bf16(v1[0], v1[1]); w.w = cvt_pk_bf16(v1[2], v1[3]);
            *(u32x4*)(dst + row * 256 + cl0 + bj * 128) = w;
          }
          ss += __shfl_xor(ss, 16); ss += __shfl_xor(ss, 32);
          if (fq == 0) ssp[row * 4 + wc] = ss;
        }
    } else if (pn == 15) {
      bf16* IK = (bf16*)(ws + OFF_IK);
      float* IW = (float*)(ws + OFF_IW);
      float* GLOW = (float*)(ws + OFF_GLOW);
#pragma unroll
      for (int ai = 0; ai < 2; ++ai)
#pragma unroll
        for (int m = 0; m < 4; ++m) {
          const size_t row = row0 + ai * 128 + m * 16;
          const int cl = cl0;
          const f32x4 v0 = acc[ai][0][m][0], v1 = acc[ai][0][m][1];
          if (cl < 64) {
            u32x4 w; w.x = cvt_pk_bf16(v0[0], v0[1]); w.y = cvt_pk_bf16(v0[2], v0[3]); w.z = cvt_pk_bf16(v1[0], v1[1]); w.w = cvt_pk_bf16(v1[2], v1[3]);
            *(u32x4*)(IK + row * 64 + cl) = w;
          } else if (cl < 72) {
            *(f32x4*)(IW + row * 8) = v0 * 0.35355339059327373f;
            *(f32x4*)(IW + row * 8 + 4) = v1 * 0.35355339059327373f;
          } else if (cl < 88) {
            *(f32x4*)(GLOW + row * 16 + (cl - 72)) = v0;
            *(f32x4*)(GLOW + row * 16 + (cl - 72) + 4) = v1;
          }
        }
    } else {
      bf16* dst; int ld; float scale = 1.f; int act = 0; int coff;
      if (pn < 2) { dst = (bf16*)(ws + OFF_Q); ld = 512; coff = pn * 256; scale = 0.08838834764831845f; }
      else if (pn < 4) { dst = (bf16*)(ws + OFF_K); ld = 512; coff = (pn - 2) * 256; }
      else if (pn < 8) { dst = (bf16*)(ws + OFF_V); ld = 1024; coff = (pn - 4) * 256; }
      else if (pn < 12) { dst = (bf16*)(ws + OFF_DQ); ld = 1024; coff = (pn - 8) * 256; }
      else if (pn < 15) { dst = (bf16*)(ws + OFF_IQ); ld = 512; coff = (pn - 13) * 256; scale = 0.125f; }
      else if (pn < 20) { dst = (bf16*)(ws + OFF_SGR); ld = 1024; coff = (pn - 16) * 256; act = 1; }
      else if (pn < 24) { dst = (bf16*)out; ld = 1024; coff = (pn - 20) * 256; act = 2; }
      else { dst = (bf16*)out + (size_t)TT * 1024; ld = 1024; coff = (pn - 24) * 256; act = 2; }
#pragma unroll
      for (int ai = 0; ai < 2; ++ai)
#pragma unroll
        for (int m = 0; m < 4; ++m) {
          bf16* rowp = dst + (size_t)(row0 + ai * 128 + m * 16) * ld + coff + cl0;
#pragma unroll
          for (int bj = 0; bj < 2; ++bj) {
            f32x4 v0 = acc[ai][bj][m][0] * scale, v1 = acc[ai][bj][m][1] * scale;
            if (act == 1) {
#pragma unroll
              for (int j = 0; j < 4; ++j) { v0[j] = siluf_(v0[j]); v1[j] = siluf_(v1[j]); }
            } else if (act == 2) {
#pragma unroll
              for (int j = 0; j < 4; ++j) { v0[j] = sigmoidf_(v0[j]); v1[j] = sigmoidf_(v1[j]); }
            }
            u32x4 w; w.x = cvt_pk_bf16(v0[0], v0[1]); w.y = cvt_pk_bf16(v0[2], v0[3]); w.z = cvt_pk_bf16(v1[0], v1[1]); w.w = cvt_pk_bf16(v1[2], v1[3]);
            *(u32x4*)(rowp + bj * 128) = w;
          }
        }
    }
  }
};

template <bool ADD> struct EpiMix {
  static constexpr bool PERM = true, AFTER_DRAIN = false;
  const bf16* SZ; bf16* MIX;
  __device__ __forceinline__ void operator()(const f32x4 (&acc)[2][2][4][2], const Unit& u, int wr, int wc, int fr, int fq) const {
    const int row0 = u.pm * 256 + wr * 64 + fr, col0 = u.pn * 256 + wc * 32 + 8 * fq;
    u32x4 sc[2], oc[2], sn[2], on[2];
    {
      const size_t idx = (size_t)row0 * 1024 + col0;
      sc[0] = *(const u32x4*)(SZ + idx); sc[1] = *(const u32x4*)(SZ + idx + 128);
      if (ADD) { oc[0] = *(const u32x4*)(MIX + idx); oc[1] = *(const u32x4*)(MIX + idx + 128); }
    }
#pragma unroll
    for (int s = 0; s < 8; ++s) {
      const int ai = s >> 2, m = s & 3;
      const size_t idx = (size_t)(row0 + ai * 128 + m * 16) * 1024 + col0;
      if (s < 7) {
        const int ai2 = (s + 1) >> 2, m2 = (s + 1) & 3;
        const size_t idn = (size_t)(row0 + ai2 * 128 + m2 * 16) * 1024 + col0;
        sn[0] = *(const u32x4*)(SZ + idn); sn[1] = *(const u32x4*)(SZ + idn + 128);
        if (ADD) { on[0] = *(const u32x4*)(MIX + idn); on[1] = *(const u32x4*)(MIX + idn + 128); }
      }
#pragma unroll
      for (int bj = 0; bj < 2; ++bj) {
        const u32x4 sv = sc[bj];
        f32x4 v0 = acc[ai][bj][m][0], v1 = acc[ai][bj][m][1];
        v0[0] *= bflo(sv.x); v0[1] *= bfhi(sv.x); v0[2] *= bflo(sv.y); v0[3] *= bfhi(sv.y);
        v1[0] *= bflo(sv.z); v1[1] *= bfhi(sv.z); v1[2] *= bflo(sv.w); v1[3] *= bfhi(sv.w);
        if (ADD) {
          const u32x4 o = oc[bj];
          v0[0] += bflo(o.x); v0[1] += bfhi(o.x); v0[2] += bflo(o.y); v0[3] += bfhi(o.y);
          v1[0] += bflo(o.z); v1[1] += bfhi(o.z); v1[2] += bflo(o.w); v1[3] += bfhi(o.w);
        }
        u32x4 w; w.x = cvt_pk_bf16(v0[0], v0[1]); w.y = cvt_pk_bf16(v0[2], v0[3]); w.z = cvt_pk_bf16(v1[0], v1[1]); w.w = cvt_pk_bf16(v1[2], v1[3]);
        *(u32x4*)(MIX + idx + bj * 128) = w;
      }
      if (s < 7) { sc[0] = sn[0]; sc[1] = sn[1]; if (ADD) { oc[0] = on[0]; oc[1] = on[1]; } }
    }
  }
};

struct EpiX1 {
  static constexpr bool PERM = true, AFTER_DRAIN = false;
  const float* x; const float* ada; float* out;
  __device__ __forceinline__ void operator()(const f32x4 (&acc)[2][2][4][2], const Unit& u, int wr, int wc, int fr, int fq) const {
    const int row0 = u.pm * 256 + wr * 64 + fr, col0 = u.pn * 256 + wc * 32 + 8 * fq;
    const int b = (u.pm * 256) >> 12;
    f32x4 g[2][2];
#pragma unroll
    for (int bj = 0; bj < 2; ++bj) {
      g[bj][0] = *(const f32x4*)(ada + b * 6144 + 2048 + col0 + bj * 128);
      g[bj][1] = *(const f32x4*)(ada + b * 6144 + 2048 + col0 + bj * 128 + 4);
    }
    f32x4 xc[4], xn[4];
    {
      const size_t idx = (size_t)row0 * 1024 + col0;
      xc[0] = *(const f32x4*)(x + idx); xc[1] = *(const f32x4*)(x + idx + 4);
      xc[2] = *(const f32x4*)(x + idx + 128); xc[3] = *(const f32x4*)(x + idx + 132);
    }
#pragma unroll
    for (int s = 0; s < 8; ++s) {
      const int ai = s >> 2, m = s & 3;
      const size_t idx = (size_t)(row0 + ai * 128 + m * 16) * 1024 + col0;
      if (s < 7) {
        const int ai2 = (s + 1) >> 2, m2 = (s + 1) & 3;
        const size_t idn = (size_t)(row0 + ai2 * 128 + m2 * 16) * 1024 + col0;
        xn[0] = *(const f32x4*)(x + idn); xn[1] = *(const f32x4*)(x + idn + 4);
        xn[2] = *(const f32x4*)(x + idn + 128); xn[3] = *(const f32x4*)(x + idn + 132);
      }
#pragma unroll
      for (int bj = 0; bj < 2; ++bj) {
        *(f32x4*)(out + idx + bj * 128) = xc[2 * bj] + g[bj][0] * acc[ai][bj][m][0];
        *(f32x4*)(out + idx + bj * 128 + 4) = xc[2 * bj + 1] + g[bj][1] * acc[ai][bj][m][1];
      }
      if (s < 7) { xc[0] = xn[0]; xc[1] = xn[1]; xc[2] = xn[2]; xc[3] = xn[3]; }
    }
  }
};

struct EpiPlain {
  static constexpr bool PERM = true, AFTER_DRAIN = false;
  bf16* O; int ld;
  __device__ __forceinline__ void operator()(const f32x4 (&acc)[2][2][4][2], const Unit& u, int wr, int wc, int fr, int fq) const {
    const int row0 = u.pm * 256 + wr * 64 + fr, col0 = u.pn * 256 + wc * 32 + 8 * fq;
#pragma unroll
    for (int ai = 0; ai < 2; ++ai)
#pragma unroll
      for (int m = 0; m < 4; ++m)
#pragma unroll
        for (int bj = 0; bj < 2; ++bj) {
          const f32x4 v0 = acc[ai][bj][m][0], v1 = acc[ai][bj][m][1];
          u32x4 w; w.x = cvt_pk_bf16(v0[0], v0[1]); w.y = cvt_pk_bf16(v0[2], v0[3]); w.z = cvt_pk_bf16(v1[0], v1[1]); w.w = cvt_pk_bf16(v1[2], v1[3]);
          *(u32x4*)(O + (size_t)(row0 + ai * 128 + m * 16) * ld + col0 + bj * 128) = w;
        }
  }
};

template <class Epi>
__device__ __forceinline__ void gemm_run(LAS unsigned char* lds, const bf16* A, const bf16* Bt, int M, int N, int K, const Epi& E) {
  pg8::Gemm g{A, Bt, M, N, K};
  pg8::StaticOrder S;
  S.init(M, N, gridDim.x, blockIdx.x);
  pg8::gemm_phase<Epi, pg8::StaticOrder, false>(lds, g, S, E, nullptr);
}

typedef short bf16x8_t __attribute__((ext_vector_type(8)));
typedef __bf16 bf16x2_t __attribute__((ext_vector_type(2)));
__device__ __forceinline__ float dot2bf(unsigned a, unsigned b, float acc) {
  return __builtin_amdgcn_fdot2_f32_bf16(__builtin_bit_cast(bf16x2_t, a), __builtin_bit_cast(bf16x2_t, b), acc, false);
}
__device__ __forceinline__ void wave_lds_fence() { asm volatile("s_waitcnt lgkmcnt(0)" ::: "memory"); }
template <int N> __device__ __forceinline__ float row_ror(float x) {
  return __int_as_float(__builtin_amdgcn_update_dpp(0, __float_as_int(x), 0x120 + N, 0xf, 0xf, false));
}
__device__ __forceinline__ float row16_max(float m) {
  m = fmaxf(m, row_ror<8>(m)); m = fmaxf(m, row_ror<4>(m)); m = fmaxf(m, row_ror<2>(m)); m = fmaxf(m, row_ror<1>(m));
  return m;
}
__device__ __forceinline__ float row16_sum(float m) {
  m += row_ror<8>(m); m += row_ror<4>(m); m += row_ror<2>(m); m += row_ror<1>(m);
  return m;
}
__device__ __forceinline__ float wave_sum_dpp(float s) {
  s = row16_sum(s);
  const int si = __float_as_int(s);
  return __int_as_float(__builtin_amdgcn_readlane(si, 0)) + __int_as_float(__builtin_amdgcn_readlane(si, 16)) +
         (__int_as_float(__builtin_amdgcn_readlane(si, 32)) + __int_as_float(__builtin_amdgcn_readlane(si, 48)));
}
__device__ __forceinline__ constexpr int cand_i(int L) {
  return L < 16 ? 0 : L < 24 ? 1 : L < 29 ? 2 : L < 33 ? 3 : L < 36 ? 4 : L < 38 ? 5 : L < 40 ? 6 : L < 42 ? 7 : (L - 42 + 8);
}
__device__ __forceinline__ constexpr int cand_j(int L) {
  return L < 16 ? L : L < 24 ? L - 16 : L < 29 ? L - 24 : L < 33 ? L - 29 : L < 36 ? L - 33 : L < 38 ? L - 36 : L < 40 ? L - 38 : L < 42 ? L - 40 : 0;
}
template <int K> struct CandRank {
  static __device__ __forceinline__ void run(int ki, unsigned key, int& rank) {
    const unsigned o = (unsigned)__builtin_amdgcn_readlane(ki, K);
    rank += (o > key) ? 1 : 0;
    CandRank<K + 1>::run(ki, key, rank);
  }
};
template <> struct CandRank<50> { static __device__ __forceinline__ void run(int, unsigned, int&) {} };
__device__ __forceinline__ unsigned peer_f2ord(float f) {
  if (f == 0.f) f = 0.f;
  const unsigned u = __float_as_uint(f);
  return (u & 0x80000000u) ? ~u : (u | 0x80000000u);
}
__device__ __forceinline__ float peer_ord2f(unsigned u) { return __uint_as_float((u & 0x80000000u) ? (u ^ 0x80000000u) : ~u); }
__device__ __forceinline__ unsigned umax3(unsigned a, unsigned b, unsigned c) { const unsigned t = a > b ? a : b; return t > c ? t : c; }
template <int N> __device__ __forceinline__ unsigned row_ror_u(unsigned x) {
  return (unsigned)__builtin_amdgcn_update_dpp(0, (int)x, 0x120 + N, 0xf, 0xf, false);
}
__device__ __forceinline__ unsigned row16_umax(unsigned m) {
  unsigned t;
  t = row_ror_u<8>(m); m = t > m ? t : m; t = row_ror_u<4>(m); m = t > m ? t : m;
  t = row_ror_u<2>(m); m = t > m ? t : m; t = row_ror_u<1>(m); m = t > m ? t : m;
  return m;
}
__device__ __forceinline__ float gelu_exact(float v) { return 0.5f * v * (1.f + erff(v * 0.7071067811865476f)); }

typedef float f32x2_t __attribute__((ext_vector_type(2)));
typedef unsigned peer_u32x2 __attribute__((ext_vector_type(2)));
__device__ __forceinline__ float peer_fold32(float a, float b) {
  const peer_u32x2 r = __builtin_amdgcn_permlane32_swap(__float_as_uint(a), __float_as_uint(b), false, false);
  return __uint_as_float(r.x) + __uint_as_float(r.y);
}
__device__ __forceinline__ float peer_fold16(float a, float b) {
  const peer_u32x2 r = __builtin_amdgcn_permlane16_swap(__float_as_uint(a), __float_as_uint(b), false, false);
  return __uint_as_float(r.x) + __uint_as_float(r.y);
}
#define PEER_NB 6
#define PEER_LOAD(buf, TAB, tk, e0)                                                               \
  _Pragma("unroll") for (int j = 0; j < PEER_NB; ++j) {                                                 \
    const int e = ((e0) + j < 128) ? __builtin_amdgcn_readfirstlane((int)ridx[(tk) * 128 + (e0) + j]) : 0;   \
    buf[j] = *(const u32x4_t*)((TAB) + (size_t)e * 1024 + lane * 16);                             \
  }
#define PEER_UDOT(buf, e0)                                                                        \
  {                                                                                               \
    float sp[6];                                                                                  \
    _Pragma("unroll") for (int j = 0; j < 6; ++j) {                                               \
      float s0 = 0.f, s1 = 0.f;                                                                   \
      _Pragma("unroll") for (int w = 0; w < 4; ++w) {                                             \
        const f32x2_t lo = __builtin_amdgcn_cvt_pk_f32_fp8((int)buf[j][w], false);                \
        const f32x2_t hi = __builtin_amdgcn_cvt_pk_f32_fp8((int)buf[j][w], true);                 \
        s0 = __builtin_fmaf(lo.x, hf[4 * w], s0); s1 = __builtin_fmaf(lo.y, hf[4 * w + 1], s1);   \
        s0 = __builtin_fmaf(hi.x, hf[4 * w + 2], s0); s1 = __builtin_fmaf(hi.y, hf[4 * w + 3], s1); \
      }                                                                                           \
      sp[j] = s0 + s1;                                                                            \
    }                                                                                             \
    const float u01 = peer_fold32(sp[0], sp[1]), u23 = peer_fold32(sp[2], sp[3]), u45 = peer_fold32(sp[4], sp[5]); \
    const float wq = row16_sum(peer_fold16(u01, u23));     \
    const float wr = row16_sum(peer_fold16(u45, u45));         \
    const int wqi = __float_as_int(wq), wri = __float_as_int(wr);                                 \
    PEER_PUT((e0) + 0, __builtin_amdgcn_readlane(wqi, 0));                                        \
    PEER_PUT((e0) + 1, __builtin_amdgcn_readlane(wqi, 32));                                       \
    PEER_PUT((e0) + 2, __builtin_amdgcn_readlane(wqi, 16));                                       \
    PEER_PUT((e0) + 3, __builtin_amdgcn_readlane(wqi, 48));                                       \
    PEER_PUT((e0) + 4, __builtin_amdgcn_readlane(wri, 0));                                        \
    PEER_PUT((e0) + 5, __builtin_amdgcn_readlane(wri, 32));                                       \
  }
#define PEER_PUT(ee_, vi_)                                                                        \
  {                                                                                               \
    const int ee = (ee_); const float sv = __int_as_float(vi_);                                   \
    const bool mine = (lane == (ee & 63));                                                        \
    dotA = (mine && ee < 64) ? sv : dotA;                                                         \
    dotB = (mine && ee >= 64 && ee < 128) ? sv : dotB;                                            \
  }
#define PEER_VACC(buf, e0)                                                                        \
  _Pragma("unroll") for (int j = 0; j < PEER_NB; ++j) {                                                 \
    const int ee = (e0) + j;                                                                      \
    const float a = (ee < 128) ? __int_as_float(__builtin_amdgcn_readlane(__float_as_int(ee < 64 ? aA : aB), ee & 63)) : 0.f; \
    _Pragma("unroll") for (int w = 0; w < 4; ++w) {                                               \
      const f32x2_t lo = __builtin_amdgcn_cvt_pk_f32_fp8((int)buf[j][w], false);                  \
      const f32x2_t hi = __builtin_amdgcn_cvt_pk_f32_fp8((int)buf[j][w], true);                   \
      acc[4 * w] += a * lo.x; acc[4 * w + 1] += a * lo.y; acc[4 * w + 2] += a * hi.x; acc[4 * w + 3] += a * hi.y; \
    }                                                                                             \
    __builtin_amdgcn_sched_barrier(0);                                                           \
  }

#ifndef PROBE_PEER
#define PROBE_PEER 0
#endif
#if PROBE_PEER
#define PEER_MARK(k) do { const unsigned long long n_ = __builtin_amdgcn_s_memrealtime(); if (PROBE_PEER == (k)) { const unsigned long long q_ = n_ - pmark; \
    while (__builtin_amdgcn_s_memrealtime() - n_ < q_) __builtin_amdgcn_s_sleep(2); } pmark = __builtin_amdgcn_s_memrealtime(); } while (0)
#else
#define PEER_MARK(k) do {} while (0)
#endif
__device__ __forceinline__ void ph_peer512(const P& p, unsigned char* lds_raw, float* dst_base) {
  const int tid = tid_fresh(), wave = tid >> 6, lane = tid & 63, g = lane >> 4, c = lane & 15;
  const bf16* PQ = (const bf16*)(p.ws + OFF_PQ);
  const bf16* SK = (const bf16*)(p.ws + OFF_SK);
  float* tv = (float*)(lds_raw + wave * 16384);
  int* ti = (int*)(tv + 512);
  float* rgate = (float*)(ti + 512);
  unsigned short* ridx = (unsigned short*)(rgate + 2048);
  for (int tile = blockIdx.x * 8 + wave; tile < TT / 16; tile += gridDim.x * 8) {
    const int tok0 = tile * 16;
#if PROBE_PEER
    unsigned long long pmark = __builtin_amdgcn_s_memrealtime();
#endif
    unsigned* tk = (unsigned*)tv;
#pragma unroll 1
    for (int hp = 0; hp < 4; ++hp) {
#pragma unroll 1
      for (int hf = 0; hf < 2; ++hf) {
        bf16x8_t bfr[4][8];
#pragma unroll
        for (int ks = 0; ks < 4; ++ks)
#pragma unroll
          for (int nt = 0; nt < 8; ++nt) bfr[ks][nt] = *(const bf16x8_t*)(SK + hf * 16384 + (nt * 16 + c) * 128 + ks * 32 + 8 * g);
#pragma unroll 1
        for (int h2 = 0; h2 < 2; ++h2) {
          const int hd = 2 * hp + h2;
          f32x4 acc[8];
#pragma unroll
          for (int nt = 0; nt < 8; ++nt) acc[nt] = (f32x4){0.f, 0.f, 0.f, 0.f};
#pragma unroll
          for (int ks = 0; ks < 4; ++ks) {
            const bf16x8_t a = *(const bf16x8_t*)(PQ + (size_t)(tok0 + c) * 2048 + hd * 256 + hf * 128 + ks * 32 + 8 * g);
#pragma unroll
            for (int nt = 0; nt < 8; ++nt) acc[nt] = __builtin_amdgcn_mfma_f32_16x16x32_bf16(a, bfr[ks][nt], acc[nt], 0, 0, 0);
          }
          asm volatile("" :: "v"(acc[0][0]), "v"(acc[7][3]));
          PEER_MARK(1);
          unsigned kq[4][8], res[4];
#pragma unroll
          for (int i = 0; i < 4; ++i) {
            res[i] = 0u;
#pragma unroll
            for (int nt = 0; nt < 8; ++nt) kq[i][nt] = (peer_f2ord(acc[nt][i]) & ~127u) | (unsigned)(127 - (16 * nt + c));
          }
#pragma unroll 1
          for (int r = 0; r < 16; ++r) {
#pragma unroll
            for (int i = 0; i < 4; ++i) {
              unsigned m = umax3(umax3(kq[i][0], kq[i][1], kq[i][2]), umax3(kq[i][3], kq[i][4], kq[i][5]), (kq[i][6] > kq[i][7]) ? kq[i][6] : kq[i][7]);
              m = row16_umax(m);
#pragma unroll
              for (int nt = 0; nt < 8; ++nt) kq[i][nt] = (kq[i][nt] == m) ? 0u : kq[i][nt];
              res[i] = (c == r) ? m : res[i];
            }
          }
#pragma unroll
          for (int i = 0; i < 4; ++i) tk[((h2 * 2 + hf) * 16 + 4 * g + i) * 16 + c] = res[i];
        }
      }
      wave_lds_fence();
      PEER_MARK(2);
      const int ci = cand_i(lane < 50 ? lane : 0), cj = cand_j(lane < 50 ? lane : 0);
#pragma unroll 1
      for (int hr = 0; hr < 32; ++hr) {
        const int h2 = hr >> 4, row = hr & 15, hd = 2 * hp + h2;
        const unsigned k1 = tk[((h2 * 2 + 0) * 16 + row) * 16 + ci], k2 = tk[((h2 * 2 + 1) * 16 + row) * 16 + cj];
        const float val = peer_ord2f(k1 & ~127u) + peer_ord2f(k2 & ~127u);
        const unsigned key = (lane < 50) ? ((peer_f2ord(val) & ~63u) | (unsigned)(63 - lane)) : 0u;
        int rank = 0;
        CandRank<0>::run((int)key, key, rank);
        if (lane < 50 && rank < 16) {
          rgate[row * 128 + hd * 16 + rank] = val;
          ridx[row * 128 + hd * 16 + rank] = (unsigned short)((127 - (int)(k1 & 127u)) * 128 + (127 - (int)(k2 & 127u)));
        }
      }
      wave_lds_fence();
      PEER_MARK(3);
#pragma unroll
      for (int h2 = 0; h2 < 2; ++h2) {
        const int hd = 2 * hp + h2;
        const int row = lane >> 2, q = lane & 3;
        float* gp = rgate + row * 128 + hd * 16;
        const float mx = gp[0];
        const f32x4 b4 = *(const f32x4*)(gp + q * 4);
        f32x4 e4;
        e4[0] = __expf(b4[0] - mx); e4[1] = __expf(b4[1] - mx); e4[2] = __expf(b4[2] - mx); e4[3] = __expf(b4[3] - mx);
        float s = (e4[0] + e4[1]) + (e4[2] + e4[3]);
        s += __shfl_xor(s, 1); s += __shfl_xor(s, 2);
        const float inv = 1.f / s;
        wave_lds_fence();
        *(f32x4*)(gp + q * 4) = e4 * inv;
      }
      wave_lds_fence();
    }
    char* wsl = p.ws;
    asm volatile("" : "+s"(wsl));
    const bf16* H2 = (const bf16*)(wsl + OFF_H);
    const unsigned char* PU = (const unsigned char*)(wsl + OFF_PU);
    const unsigned char* PV = (const unsigned char*)(wsl + OFF_PV);
    const float* USC = (const float*)(wsl + OFF_PSC);
    const float* VSC = USC + 16384;
    const float* ada = (const float*)(wsl + OFF_ADA);
    u32x4_t a0[PEER_NB], a1[PEER_NB], hn0, hn1;
#define PSB() __builtin_amdgcn_sched_barrier(0)
#define PEER_ROWS (((128 + 2 * PEER_NB - 1) / (2 * PEER_NB)) * 2 * PEER_NB)
    {
      const int tidx = tid_fresh(), lane = tidx & 63, wv = __builtin_amdgcn_readfirstlane(tidx >> 6);
      const unsigned short* ridx = (const unsigned short*)(lds_raw + wv * 16384 + 4096 + 8192);
      hn0 = *(const u32x4_t*)(H2 + (size_t)tok0 * 1024 + lane * 16); hn1 = *(const u32x4_t*)(H2 + (size_t)tok0 * 1024 + lane * 16 + 8);
      PEER_LOAD(a0, PU, 0, 0); PSB();
      PEER_LOAD(a1, PU, 0, PEER_NB); PSB();
    }
#pragma unroll 1
    for (int tt = 0; tt < 16; ++tt) {
      const int tidx = tid_fresh(), lane = tidx & 63, wv = __builtin_amdgcn_readfirstlane(tidx >> 6);
      const float* rgate = (const float*)(lds_raw + wv * 16384 + 4096);
      const unsigned short* ridx = (const unsigned short*)(lds_raw + wv * 16384 + 4096 + 8192);
      const size_t tok = (size_t)tok0 + tt;
      const int ttn = (tt < 15) ? tt + 1 : tt;
      float hf[16];
#pragma unroll
      for (int w = 0; w < 4; ++w) { hf[2 * w] = bflo(hn0[w]); hf[2 * w + 1] = bfhi(hn0[w]); hf[8 + 2 * w] = bflo(hn1[w]); hf[8 + 2 * w + 1] = bfhi(hn1[w]); }
      const int eA = (int)ridx[tt * 128 + lane], eB = (int)ridx[tt * 128 + 64 + lane];
      const float usA = USC[eA], usB = USC[eB];
      float dotA = 0.f, dotB = 0.f;
#pragma unroll 1
      for (int e0 = 0; e0 < PEER_ROWS; e0 += 2 * PEER_NB) {
        PEER_UDOT(a0, e0); PSB();
        if (e0 + 2 * PEER_NB < PEER_ROWS) { PEER_LOAD(a0, PU, tt, e0 + 2 * PEER_NB); } else { PEER_LOAD(a0, PV, tt, 0); }
        PSB();
        PEER_UDOT(a1, e0 + PEER_NB); PSB();
        if (e0 + 3 * PEER_NB < PEER_ROWS) { PEER_LOAD(a1, PU, tt, e0 + 3 * PEER_NB); } else { PEER_LOAD(a1, PV, tt, PEER_NB); }
        PSB();
      }
      const float aA = gelu_exact(dotA * usA) * rgate[tt * 128 + lane] * VSC[(int)ridx[tt * 128 + lane]],
                  aB = gelu_exact(dotB * usB) * rgate[tt * 128 + 64 + lane] * VSC[(int)ridx[tt * 128 + 64 + lane]];
      float acc[16];
#pragma unroll
      for (int k = 0; k < 16; ++k) acc[k] = 0.f;
      hn0 = *(const u32x4_t*)(H2 + ((size_t)tok0 + ttn) * 1024 + lane * 16); hn1 = *(const u32x4_t*)(H2 + ((size_t)tok0 + ttn) * 1024 + lane * 16 + 8);
      PSB();
#pragma unroll 1
      for (int e0 = 0; e0 < PEER_ROWS; e0 += 2 * PEER_NB) {
        PEER_VACC(a0, e0); PSB();
        if (e0 + 2 * PEER_NB < PEER_ROWS) { PEER_LOAD(a0, PV, tt, e0 + 2 * PEER_NB); } else { PEER_LOAD(a0, PU, ttn, 0); }
        PSB();
        PEER_VACC(a1, e0 + PEER_NB); PSB();
        if (e0 + 3 * PEER_NB < PEER_ROWS) { PEER_LOAD(a1, PV, tt, e0 + 3 * PEER_NB); } else { PEER_LOAD(a1, PU, ttn, PEER_NB); }
        PSB();
      }
      const int b = (int)(tok >> 12);
      const float* xrow = p.out + tok * 1024;
      float* orow = dst_base + tok * 1024;
      const float* g2 = ada + b * 6144 + 5120;
      float x2[16];
      float ss = 0.f;
#pragma unroll
      for (int q = 0; q < 4; ++q) {
        const int col = lane * 16 + q * 4;
        const f32x4 xv = *(const f32x4*)(xrow + col), gv = *(const f32x4*)(g2 + col);
#pragma unroll
        for (int k = 0; k < 4; ++k) { const float t = xv[k] + gv[k] * acc[q * 4 + k]; x2[q * 4 + k] = t; ss += t * t; }
      }
      ss = wave_sum_dpp(ss);
      const float rstd = rsqrtf(ss * (1.f / 1024.f) + 1e-6f);
#pragma unroll
      for (int q = 0; q < 4; ++q) {
        const int col = lane * 16 + q * 4;
        const f32x4 fg = *(const f32x4*)((const float*)(wsl + OFF_PRM) + PRM_FG + col);
        f32x4 o;
#pragma unroll
        for (int k = 0; k < 4; ++k) o[k] = x2[q * 4 + k] * rstd * fg[k];
        *(f32x4*)(orow + col) = o;
      }
    }
    wave_lds_fence();
  }
}

#define DS_KEY16   0
#define DS_CHUNK   17408
#define DS_SEL     139264
#define DS_WAVE    147456
#define DS_TOTAL   155648
#define DS_RS      544

__device__ __forceinline__ unsigned f2ord(float f) {
  if (f == 0.f) f = 0.f;
  unsigned u = __float_as_uint(f);
  return (u & 0x80000000u) ? ~u : (u | 0x80000000u);
}
__device__ __forceinline__ int wave_scan_incl(int v, int lane) {
#pragma unroll
  for (int o = 1; o < 64; o <<= 1) { const int t = __shfl_up(v, o); v += (lane >= o) ? t : 0; }
  return v;
}
__device__ __forceinline__ void find_digit(const LAS unsigned* hist, int K, int lane, int& digit, int& above) {
  const u32x4_t h4 = *(const LAS u32x4_t*)(hist + 252 - 4 * lane);
  const int c0 = (int)h4.w, c1 = (int)h4.z, c2 = (int)h4.y, c3 = (int)h4.x;
  const int tot = c0 + c1 + c2 + c3;
  int run = wave_scan_incl(tot, lane) - tot;
  int found = -1, ab = 0;
  if (run < K && run + c0 >= K) { found = 255 - 4 * lane; ab = run; } run += c0;
  if (run < K && run + c1 >= K) { found = 254 - 4 * lane; ab = run; } run += c1;
  if (run < K && run + c2 >= K) { found = 253 - 4 * lane; ab = run; } run += c2;
  if (run < K && run + c3 >= K) { found = 252 - 4 * lane; ab = run; }
  const unsigned long long mk = __ballot(found >= 0);
  const int src = (int)__ffsll((unsigned long long)mk) - 1;
  digit = __builtin_amdgcn_readlane(found, src);
  above = __builtin_amdgcn_readlane(ab, src);
}

typedef unsigned u32x2_t __attribute__((ext_vector_type(2)));
__device__ __forceinline__ float xrow_max(float x) {
  u32x2_t r = __builtin_amdgcn_permlane16_swap(__float_as_uint(x), __float_as_uint(x), false, false);
  x = fmaxf(__uint_as_float(r.x), __uint_as_float(r.y));
  r = __builtin_amdgcn_permlane32_swap(__float_as_uint(x), __float_as_uint(x), false, false);
  return fmaxf(__uint_as_float(r.x), __uint_as_float(r.y));
}
__device__ __forceinline__ float xrow_sum(float x) {
  u32x2_t r = __builtin_amdgcn_permlane16_swap(__float_as_uint(x), __float_as_uint(x), false, false);
  x = __uint_as_float(r.x) + __uint_as_float(r.y);
  r = __builtin_amdgcn_permlane32_swap(__float_as_uint(x), __float_as_uint(x), false, false);
  return __uint_as_float(r.x) + __uint_as_float(r.y);
}
__device__ __forceinline__ s16x4_t tr_read_b64(unsigned addr) {
  s16x4_t r; asm volatile("ds_read_b64_tr_b16 %0, %1" : "=&v"(r) : "v"(addr) : "memory"); return r;
}

#ifndef PROBE_DSA
#define PROBE_DSA 0
#endif
#if PROBE_DSA
#define DSA_MARK(k) do { const unsigned long long n_ = __builtin_amdgcn_s_memrealtime(); if (PROBE_DSA == (k)) { const unsigned long long q_ = n_ - tmark; \
    while (__builtin_amdgcn_s_memrealtime() - n_ < q_) __builtin_amdgcn_s_sleep(2); } tmark = __builtin_amdgcn_s_memrealtime(); } while (0)
#else
#define DSA_MARK(k) do {} while (0)
#endif
#if PROBE_DSA >= 10
#define DSA_MARKI(k) DSA_MARK(k)
#else
#define DSA_MARKI(k) do {} while (0)
#endif
__device__ __forceinline__ void dsa_batch(const P& p, unsigned char* lds_raw, int b, int pos2) {
  const int t00 = pos2 * 32;
#define DSA_IDS const int tid = tid_fresh(), wave = __builtin_amdgcn_readfirstlane(tid >> 6), lane = tid & 63, g = lane >> 4, c = lane & 15; (void)wave; (void)g; (void)c;
  const size_t tokb = (size_t)b * SEQ, tok00 = tokb + t00;
  const bf16* DQ = (const bf16*)(p.ws + OFF_DQ);
  const bf16* CKV = (const bf16*)(p.ws + OFF_CKV);
  const float* SSP = (const float*)(p.ws + OFF_SSP);
  const bf16* IQ = (const bf16*)(p.ws + OFF_IQ);
  const bf16* IK = (const bf16*)(p.ws + OFF_IK);
  const float* IW = (const float*)(p.ws + OFF_IW);
  const bf16* WUK = (const bf16*)(p.ws + OFF_WUK);
  const bf16* WUV = (const bf16*)(p.ws + OFF_WUV);
  bf16* ODSA = (bf16*)(p.ws + OFF_ODSA);
  bf16* QL = (bf16*)(p.ws + OFF_DSCR + (size_t)blockIdx.x * 131072);
  bf16* OL = QL;
  LAS unsigned char* lds = (LAS unsigned char*)lds_raw;
  LAS unsigned short* key16 = (LAS unsigned short*)(lds + DS_KEY16);
  LAS unsigned short* sel = (LAS unsigned short*)(lds + DS_SEL);

#if PROBE_DSA
  unsigned long long tmark = __builtin_amdgcn_s_memrealtime();
#endif
  {
    DSA_IDS
    const int h = wave;
    bf16x8_t dq0[4], dq1[4];
#pragma unroll
    for (int ks = 0; ks < 4; ++ks) {
      dq0[ks] = *(const bf16x8_t*)(DQ + (tok00 + c) * 1024 + h * 128 + ks * 32 + 8 * g);
      dq1[ks] = *(const bf16x8_t*)(DQ + (tok00 + 16 + c) * 1024 + h * 128 + ks * 32 + 8 * g);
    }
#pragma unroll 1
    for (int hn = 0; hn < 2; ++hn) {
      f32x4 r0[8], r1[8];
#pragma unroll
      for (int n8 = 0; n8 < 8; ++n8) {
        const int nt = hn * 8 + n8;
        f32x4 a0 = (f32x4){0.f, 0.f, 0.f, 0.f}, a1 = a0;
#pragma unroll
        for (int ks = 0; ks < 4; ++ks) {
          const bf16x8_t wf = *(const bf16x8_t*)(WUK + (size_t)(h * 256 + nt * 16 + c) * 128 + ks * 32 + 8 * g);
          a0 = __builtin_amdgcn_mfma_f32_16x16x32_bf16(wf, dq0[ks], a0, 0, 0, 0);
          a1 = __builtin_amdgcn_mfma_f32_16x16x32_bf16(wf, dq1[ks], a1, 0, 0, 0);
        }
        r0[n8] = a0; r1[n8] = a1;
      }
#pragma unroll
      for (int n8 = 0; n8 < 8; ++n8) {
        const int nt = hn * 8 + n8;
        uint2 o; o.x = pk2(r0[n8][0], r0[n8][1]); o.y = pk2(r0[n8][2], r0[n8][3]);
        *(uint2*)(QL + c * 2048 + h * 256 + nt * 16 + 4 * g) = o;
        o.x = pk2(r1[n8][0], r1[n8][1]); o.y = pk2(r1[n8][2], r1[n8][3]);
        *(uint2*)(QL + (16 + c) * 2048 + h * 256 + nt * 16 + 4 * g) = o;
      }
    }
  }
  DSA_MARK(1);
#pragma unroll 1
  for (int half = 0; half < 2; ++half) {
  const int t0 = t00 + 16 * half;
  const size_t tok0 = tokb + t0;
  bf16* QLh = QL + half * 16 * 2048;
  bf16* OLh = QLh;
  if (t0 >= 256) {
    DSA_IDS
    bf16x8_t qf[8][2];
    float iw[8];
#pragma unroll
    for (int h = 0; h < 8; ++h) {
      qf[h][0] = *(const bf16x8_t*)(IQ + (tok0 + c) * 512 + h * 64 + 8 * g);
      qf[h][1] = *(const bf16x8_t*)(IQ + (tok0 + c) * 512 + h * 64 + 32 + 8 * g);
      iw[h] = IW[(tok0 + c) * 8 + h];
    }
    const int ntile = (t0 >> 4) + 1;
    bf16x8_t k0n = (bf16x8_t){0, 0, 0, 0, 0, 0, 0, 0}, k1n = k0n;
    if (wave < ntile) { const bf16* kr = IK + (tokb + wave * 16 + c) * 64 + 8 * g; k0n = *(const bf16x8_t*)kr; k1n = *(const bf16x8_t*)(kr + 32); }
    for (int kt = wave; kt < ntile; kt += 8) {
      const bf16x8_t k0 = k0n, k1 = k1n;
      { const int ktn = (kt + 8 < ntile) ? kt + 8 : kt; const bf16* kr = IK + (tokb + ktn * 16 + c) * 64 + 8 * g; k0n = *(const bf16x8_t*)kr; k1n = *(const bf16x8_t*)(kr + 32); }
      f32x4 sc = (f32x4){0.f, 0.f, 0.f, 0.f};
#pragma unroll
      for (int h = 0; h < 8; ++h) {
        f32x4 d = __builtin_amdgcn_mfma_f32_16x16x32_bf16(k0, qf[h][0], (f32x4){0.f, 0.f, 0.f, 0.f}, 0, 0, 0);
        d = __builtin_amdgcn_mfma_f32_16x16x32_bf16(k1, qf[h][1], d, 0, 0, 0);
#pragma unroll
        for (int i = 0; i < 4; ++i) sc[i] += iw[h] * fmaxf(d[i], 0.f);
      }
      u16x4_t o;
      const int sb = kt * 16 + 4 * g, tq = t0 + c;
      o.x = (sb + 0 <= tq) ? (unsigned short)(f2ord(sc[0]) >> 16) : (unsigned short)0;
      o.y = (sb + 1 <= tq) ? (unsigned short)(f2ord(sc[1]) >> 16) : (unsigned short)0;
      o.z = (sb + 2 <= tq) ? (unsigned short)(f2ord(sc[2]) >> 16) : (unsigned short)0;
      o.w = (sb + 3 <= tq) ? (unsigned short)(f2ord(sc[3]) >> 16) : (unsigned short)0;
      *(LAS u16x4_t*)(key16 + c * 4096 + sb) = o;
    }
  }
  DSA_MARK(2);
  __syncthreads();
#pragma unroll 1
  for (int qq = 0; qq < 2; ++qq) {
    DSA_IDS
    const int q = wave + 8 * qq, t = t0 + q;
    LAS unsigned short* selq = sel + q * 256;
    if (t < 256) {
      for (int j = lane; j < 256; j += 64) selq[j] = (unsigned short)((j <= t) ? j : 0);
    } else {
      const LAS unsigned short* kq = key16 + q * 4096;
      const int nit = (t >> 9) + 1;
      unsigned kp[8][4];
#pragma unroll
      for (int it = 0; it < 8; ++it) {
        const int s0 = 512 * it + 8 * lane;
        u32x4_t v = (u32x4_t){0u, 0u, 0u, 0u};
        if (s0 <= t) v = *(const LAS u32x4_t*)(kq + s0);
#pragma unroll
        for (int j = 0; j < 4; ++j) {
          const unsigned lo = (s0 + 2 * j <= t) ? (v[j] & 0xffffu) : 0u, hi = (s0 + 2 * j + 1 <= t) ? (v[j] & 0xffff0000u) : 0u;
          kp[it][j] = lo | hi;
        }
      }
      asm volatile("" :: "v"(kp[0][0]), "v"(kp[7][3]));
      DSA_MARKI(21);
      unsigned B = 0u;
#pragma unroll 1
      for (int bit = 15; bit >= 0; --bit) {
        const unsigned cand = B | (1u << bit);
        const unsigned c2 = (cand - 1u) * 0x00010001u;
        unsigned cnt2 = 0u;
#pragma unroll
        for (int it = 0; it < 8; ++it) {
          if (it < nit) {
#pragma unroll
            for (int j = 0; j < 4; ++j) {
              unsigned dd;
              asm("v_pk_sub_u16 %0, %1, %2 clamp\n\tv_pk_min_u16 %0, %0, %3" : "=&v"(dd) : "v"(kp[it][j]), "v"(c2), "v"(0x00010001u));
              cnt2 += dd;
            }
          }
        }
        const int tot = (int)wave_sum_dpp((float)((cnt2 & 0xffffu) + (cnt2 >> 16)));
        if (tot >= 256) B = cand;
      }
      int cgt = 0;
#pragma unroll
      for (int it = 0; it < 8; ++it)
#pragma unroll
        for (int j = 0; j < 4; ++j) cgt += (((kp[it][j] & 0xffffu) > B) ? 1 : 0) + (((kp[it][j] >> 16) > B) ? 1 : 0);
      const int m = 256 - (int)wave_sum_dpp((float)cgt);
      DSA_MARKI(22);
      int base = 0, eqbase = 0;
#pragma unroll
      for (int it = 0; it < 8; ++it) {
        if (it < nit) {
          unsigned kk[8];
#pragma unroll
          for (int j = 0; j < 4; ++j) { kk[2 * j] = kp[it][j] & 0xffffu; kk[2 * j + 1] = kp[it][j] >> 16; }
          unsigned anyeq = 0u;
#pragma unroll
          for (int j = 0; j < 8; ++j) anyeq |= (kk[j] == B) ? 1u : 0u;
          int eqlow = 0, eqtot = 0;
          if (__builtin_amdgcn_ballot_w64(anyeq != 0u) != 0ull) {
#pragma unroll
            for (int j = 0; j < 8; ++j) {
              const unsigned long long mk = __builtin_amdgcn_ballot_w64(kk[j] == B);
              eqlow += (int)__builtin_amdgcn_mbcnt_hi((unsigned)(mk >> 32), __builtin_amdgcn_mbcnt_lo((unsigned)mk, 0u));
              eqtot += __builtin_popcountll(mk);
            }
          }
          int eqr = eqbase + eqlow;
          int ps = base, tot = 0;
          bool tk[8];
#pragma unroll
          for (int j = 0; j < 8; ++j) {
            const bool eq = kk[j] == B;
            tk[j] = (kk[j] > B) || (eq && eqr < m);
            eqr += eq ? 1 : 0;
          }
#pragma unroll
          for (int j = 0; j < 8; ++j) {
            const unsigned long long mk = __builtin_amdgcn_ballot_w64(tk[j]);
            ps += (int)__builtin_amdgcn_mbcnt_hi((unsigned)(mk >> 32), __builtin_amdgcn_mbcnt_lo((unsigned)mk, 0u));
            tot += __builtin_popcountll(mk);
          }
#pragma unroll
          for (int j = 0; j < 8; ++j) {
            if (tk[j]) { if (ps < 256) selq[ps] = (unsigned short)(512 * it + 8 * lane + j); ++ps; }
          }
          base += tot;
          eqbase += eqtot;
        }
      }
    }
  }
  DSA_MARK(3);
  __syncthreads();
  {
    DSA_IDS
    const int wave_b = wave;
    const float slope = (c < 8) ? exp2f(-(float)(c + 1)) : 0.f;
#pragma unroll 1
    for (int qq = 0; qq < 2; ++qq) {
      const int q = wave + 8 * qq, t = t0 + q;
      const int nsel = (t + 1 < 256) ? (t + 1) : 256, nch = (nsel + 31) >> 5;
      const LAS unsigned short* selq = sel + q * 256;
      bf16x8_t qf[8];
      {
        const int lq = tid_fresh() & 63;
        const bf16* qlp = QLh + q * 2048 + (lq & 7) * 256 + 8 * (lq >> 4);
#pragma unroll
        for (int ks = 0; ks < 8; ++ks) qf[ks] = *(const bf16x8_t*)(qlp + ks * 32);
      }
      float mrun = -1e30f, lrun = 0.f;
      f32x4 o[16];
#pragma unroll
      for (int nt = 0; nt < 16; ++nt) o[nt] = (f32x4){0.f, 0.f, 0.f, 0.f};
      u32x4_t st[16];
      f32x4 st_ss = (f32x4){0.f, 0.f, 0.f, 0.f}; float st_d = -1.f;
#define DSA_ISSUE(ch)                                                                                   \
      {          \
        _Pragma("unroll") for (int r = 0; r < 16; ++r) {                                                \
          const int idx = (int)selq[(ch) * 32 + 2 * r + (lane >> 5)];                                   \
          st[r] = *(const u32x4_t*)(CKV + (tokb + idx) * 256 + (lane & 31) * 8);                        \
        }                                                                                               \
        const int j2 = (ch) * 32 + (lane & 31);                                                         \
        const int idx2 = (int)selq[j2];                                                                 \
        st_ss = *(const f32x4*)(SSP + (tokb + idx2) * 4);                                               \
        st_d = (j2 < nsel) ? (float)(t - idx2) : -1.f;                                                  \
      }
      DSA_ISSUE(0);
#pragma unroll 1
      for (int ch = 0; ch < nch; ++ch) {
        const int lane = tid_fresh() & 63, g = lane >> 4, c = lane & 15;
        LAS unsigned char* buf = lds + DS_KEY16 + wave_b * DS_CHUNK;
        LAS float* kr = (LAS float*)(lds + DS_WAVE + wave_b * 1024);
        LAS float* kd = kr + 32;
        const unsigned vb = (unsigned)(uintptr_t)buf + (unsigned)((4 * g + (c >> 2)) * DS_RS + 8 * (c & 3));
#pragma unroll
        for (int r = 0; r < 16; ++r) *(LAS u32x4_t*)(buf + (2 * r + (lane >> 5)) * DS_RS + (lane & 31) * 16) = st[r];
        if (lane < 32) { kr[lane] = rsqrtf(((st_ss[0] + st_ss[1]) + (st_ss[2] + st_ss[3])) * (1.f / 256.f) + 1e-6f); kd[lane] = st_d; }
        wave_lds_fence();
        DSA_MARKI(11);
        DSA_ISSUE((ch + 1 < nch) ? ch + 1 : ch);
        f32x4 s0 = (f32x4){0.f, 0.f, 0.f, 0.f}, s1 = (f32x4){0.f, 0.f, 0.f, 0.f};
#pragma unroll
        for (int ks = 0; ks < 8; ++ks) {
          const bf16x8_t a0 = *(const LAS bf16x8_t*)(buf + c * DS_RS + (ks * 32 + 8 * g) * 2);
          const bf16x8_t a1 = *(const LAS bf16x8_t*)(buf + (16 + c) * DS_RS + (ks * 32 + 8 * g) * 2);
          s0 = __builtin_amdgcn_mfma_f32_16x16x32_bf16(a0, qf[ks], s0, 0, 0, 0);
          s1 = __builtin_amdgcn_mfma_f32_16x16x32_bf16(a1, qf[ks], s1, 0, 0, 0);
        }
        asm volatile("" :: "v"(s0[0]), "v"(s1[0]));
        DSA_MARKI(12);
        const f32x4 r0 = *(const LAS f32x4*)(kr + 4 * g), r1 = *(const LAS f32x4*)(kr + 16 + 4 * g);
        const f32x4 d0 = *(const LAS f32x4*)(kd + 4 * g), d1 = *(const LAS f32x4*)(kd + 16 + 4 * g);
        float x[8];
#pragma unroll
        for (int i = 0; i < 4; ++i) {
          x[i] = (d0[i] < 0.f) ? -1e30f : (s0[i] * r0[i] - slope * d0[i]);
          x[4 + i] = (d1[i] < 0.f) ? -1e30f : (s1[i] * r1[i] - slope * d1[i]);
        }
        float mx = fmaxf(fmaxf(fmaxf(x[0], x[1]), fmaxf(x[2], x[3])), fmaxf(fmaxf(x[4], x[5]), fmaxf(x[6], x[7])));
        mx = xrow_max(mx);
        const float mn = fmaxf(mrun, mx);
        const float alpha = __expf(mrun - mn);
        mrun = mn;
        float pr[8], ps = 0.f;
#pragma unroll
        for (int i = 0; i < 8; ++i) { pr[i] = (x[i] <= -1e29f) ? 0.f : __expf(x[i] - mn); ps += pr[i]; }
        ps = xrow_sum(ps);
        lrun = lrun * alpha + ps;
        if (__builtin_amdgcn_ballot_w64(alpha != 1.f) != 0ull) {
#pragma unroll
          for (int nt = 0; nt < 16; ++nt) o[nt] *= alpha;
        }
        union { bf16x8_t v; unsigned u[4]; } pf;
        pf.u[0] = pk2(pr[0] * r0[0], pr[1] * r0[1]); pf.u[1] = pk2(pr[2] * r0[2], pr[3] * r0[3]);
        pf.u[2] = pk2(pr[4] * r1[0], pr[5] * r1[1]); pf.u[3] = pk2(pr[6] * r1[2], pr[7] * r1[3]);
        asm volatile("" :: "v"(pf.u[0]));
        DSA_MARKI(13);
        {
          s16x4_t loA[4], hiA[4], loB[4], hiB[4];
#define PV_READ(L, H, nt0) _Pragma("unroll") for (int u = 0; u < 4; ++u) { L[u] = tr_read_b64(vb + ((nt0) + u) * 32); H[u] = tr_read_b64(vb + ((nt0) + u) * 32 + 16 * DS_RS); }
#define PV_MMA(L, H, nt0) _Pragma("unroll") for (int u = 0; u < 4; ++u) { \
            const bf16x8_t af = (bf16x8_t){L[u][0], L[u][1], L[u][2], L[u][3], H[u][0], H[u][1], H[u][2], H[u][3]}; \
            o[(nt0) + u] = __builtin_amdgcn_mfma_f32_16x16x32_bf16(af, pf.v, o[(nt0) + u], 0, 0, 0); }
          PV_READ(loA, hiA, 0);
          PV_READ(loB, hiB, 4);
          asm volatile("s_waitcnt lgkmcnt(8)" ::: "memory"); __builtin_amdgcn_sched_barrier(0);
          PV_MMA(loA, hiA, 0); __builtin_amdgcn_sched_barrier(0);
          PV_READ(loA, hiA, 8);
          asm volatile("s_waitcnt lgkmcnt(8)" ::: "memory"); __builtin_amdgcn_sched_barrier(0);
          PV_MMA(loB, hiB, 4); __builtin_amdgcn_sched_barrier(0);
          PV_READ(loB, hiB, 12);
          asm volatile("s_waitcnt lgkmcnt(8)" ::: "memory"); __builtin_amdgcn_sched_barrier(0);
          PV_MMA(loA, hiA, 8); __builtin_amdgcn_sched_barrier(0);
          asm volatile("s_waitcnt lgkmcnt(0)" ::: "memory"); __builtin_amdgcn_sched_barrier(0);
          PV_MMA(loB, hiB, 12);
#undef PV_READ
#undef PV_MMA
        }
        wave_lds_fence();
        asm volatile("" :: "v"(o[0][0]), "v"(o[15][0]));
        DSA_MARKI(14);
      }
#undef DSA_ISSUE
      if (c < 8) {
        const float inv = 1.f / lrun;
#pragma unroll
        for (int nt = 0; nt < 16; ++nt) {
          uint2 w; w.x = pk2(o[nt][0] * inv, o[nt][1] * inv); w.y = pk2(o[nt][2] * inv, o[nt][3] * inv);
          *(uint2*)(OLh + q * 2048 + c * 256 + nt * 16 + 4 * g) = w;
        }
      }
    }
  }
  DSA_MARK(4);
  __syncthreads();
  }
  {
    DSA_IDS
    const int h = wave;
    bf16x8_t of0[8], of1[8];
#pragma unroll
    for (int ks = 0; ks < 8; ++ks) {
      of0[ks] = *(const bf16x8_t*)(OL + c * 2048 + h * 256 + ks * 32 + 8 * g);
      of1[ks] = *(const bf16x8_t*)(OL + (16 + c) * 2048 + h * 256 + ks * 32 + 8 * g);
    }
    f32x4 c0[8], c1[8];
#pragma unroll
    for (int nt = 0; nt < 8; ++nt) {
      f32x4 a0 = (f32x4){0.f, 0.f, 0.f, 0.f}, a1 = a0;
#pragma unroll
      for (int ks = 0; ks < 8; ++ks) {
        const bf16x8_t wf = *(const bf16x8_t*)(WUV + (size_t)(h * 128 + nt * 16 + c) * 256 + ks * 32 + 8 * g);
        a0 = __builtin_amdgcn_mfma_f32_16x16x32_bf16(wf, of0[ks], a0, 0, 0, 0);
        a1 = __builtin_amdgcn_mfma_f32_16x16x32_bf16(wf, of1[ks], a1, 0, 0, 0);
      }
      c0[nt] = a0; c1[nt] = a1;
    }
#pragma unroll
    for (int nt = 0; nt < 8; ++nt) {
      uint2 w; w.x = pk2(c0[nt][0], c0[nt][1]); w.y = pk2(c0[nt][2], c0[nt][3]);
      *(uint2*)(ODSA + (tok00 + c) * 1024 + h * 128 + nt * 16 + 4 * g) = w;
      w.x = pk2(c1[nt][0], c1[nt][1]); w.y = pk2(c1[nt][2], c1[nt][3]);
      *(uint2*)(ODSA + (tok00 + 16 + c) * 1024 + h * 128 + nt * 16 + 4 * g) = w;
    }
  }
  DSA_MARK(5);
  __syncthreads();
}

#undef DSA_IDS
__device__ __forceinline__ void ph_dsa512(const P& p, unsigned char* lds_raw) {
  for (int it = blockIdx.x; it < TT / 16; it += gridDim.x) {
    const int k = it >> 8, j = it & 255;
    dsa_batch(p, lds_raw, k, ((k & 1) ? 255 - j : j) >> 1);
  }
}

#define GL_QD    0
#define GL_KI    18432
#define GL_KE    36864
#define GL_V     55296
#define GL_AT    90112
#define GL_GLOW  99328
#define GL_QT    103424
#define GL_DEC   105472
#define GL_SSQ   105984
#define GL_LB    108032
#define GL_TOTAL 140800

#define GLA_BAR() do { asm volatile("s_waitcnt lgkmcnt(0)" ::: "memory"); __builtin_amdgcn_s_barrier(); asm volatile("" ::: "memory"); } while (0)
#ifndef PROBE_GLA
#define PROBE_GLA 0
#endif
#if PROBE_GLA
#define GLA_MARK(k) do { const unsigned long long n_ = __builtin_amdgcn_s_memrealtime(); if (PROBE_GLA == (k)) { const unsigned long long q_ = n_ - tmark; \
    while (__builtin_amdgcn_s_memrealtime() - n_ < q_) __builtin_amdgcn_s_sleep(2); } tmark = __builtin_amdgcn_s_memrealtime(); } while (0)
#else
#define GLA_MARK(k) do {} while (0)
#endif
__device__ __forceinline__ void gla_item(const P& p, unsigned char* lds_raw, int item) {
  int tid = tid_fresh();
  const int b = item >> 2, h = item & 3;
  const size_t tokb = (size_t)b * SEQ;
  const bf16* Qg = (const bf16*)(p.ws + OFF_Q);
  const bf16* Kg = (const bf16*)(p.ws + OFF_K);
  bf16* Vg = (bf16*)(p.ws + OFF_V);
  const float* GLOWg = (const float*)(p.ws + OFF_GLOW);
  const bf16* SGR = (const bf16*)(p.ws + OFF_SGR);
  LAS unsigned char* lds = (LAS unsigned char*)lds_raw;
  const unsigned lds0 = (unsigned)(uintptr_t)lds;
  LAS float* QT = (LAS float*)(lds + GL_QT);
  LAS float* DEC = (LAS float*)(lds + GL_DEC);
  LAS float* SSQ = (LAS float*)(lds + GL_SSQ);
  float wg[16];
  const float* prm = (const float*)(p.ws + OFF_PRM);
#pragma unroll
  for (int r = 0; r < 16; ++r) wg[r] = prm[PRM_WGU + r * 512 + h * 128 + (tid & 127)];
  const float bg = prm[PRM_BG + h * 128 + (tid & 127)];
  const float gn0 = prm[PRM_GNG + h * 256 + 32 * (tid >> 6) + (tid & 15)], gn1 = prm[PRM_GNG + h * 256 + 32 * (tid >> 6) + 16 + (tid & 15)];
  u32x4_t rq[2], rk[2], rv[4], rg = (u32x4_t){0u, 0u, 0u, 0u};
#define GLA_LOAD(ch)                                                                                      \
  {                                                                                                       \
    const size_t tb = tokb + (size_t)(ch) * 64;                                                           \
    _Pragma("unroll") for (int i = 0; i < 2; ++i) {                                                       \
      const int id = tid + 512 * i, tk = id >> 4, part = id & 15;                                         \
      rq[i] = *(const u32x4_t*)(Qg + (tb + tk) * 512 + h * 128 + part * 8);                               \
      rk[i] = *(const u32x4_t*)(Kg + (tb + tk) * 512 + h * 128 + part * 8);                               \
    }                                                                                                     \
    _Pragma("unroll") for (int i = 0; i < 4; ++i) {                                                       \
      const int id = tid + 512 * i, tk = id >> 5, part = id & 31;                                         \
      rv[i] = *(const u32x4_t*)(Vg + (tb + tk) * 1024 + h * 256 + part * 8);                              \
    }                                                                                                     \
    if (tid < 256) rg = *(const u32x4_t*)(GLOWg + (tb + (tid >> 2)) * 16 + (tid & 3) * 4);                \
  }
  f32x4 S[8][2];
#pragma unroll
  for (int a = 0; a < 8; ++a) { S[a][0] = (f32x4){0.f, 0.f, 0.f, 0.f}; S[a][1] = (f32x4){0.f, 0.f, 0.f, 0.f}; }
  GLA_LOAD(0);
#if PROBE_GLA
  unsigned long long tmark = __builtin_amdgcn_s_memrealtime();
#endif
#pragma unroll 1
  for (int ch = 0; ch < SEQ / 64; ++ch) {
    asm volatile("" : "+v"(tid));
    const int wave = __builtin_amdgcn_readfirstlane(tid >> 6), lane = tid & 63, g = lane >> 4, c = lane & 15;
    const int d = tid & 127, tq = __builtin_amdgcn_readfirstlane(tid >> 7);
    const unsigned vtr = lds0 + GL_V + (unsigned)((8 * g + (c >> 2)) * 544 + (32 * wave + 4 * (c & 3)) * 2);
    const unsigned ketr = lds0 + GL_KE + (unsigned)((8 * g + (c >> 2)) * 288 + (4 * (c & 3)) * 2);
    const size_t tb = tokb + (size_t)ch * 64;
#pragma unroll
    for (int i = 0; i < 2; ++i) {
      const int id = tid + 512 * i, tk = id >> 4, part = id & 15;
      *(LAS u32x4_t*)(lds + GL_QD + tk * 288 + part * 16) = rq[i];
      *(LAS u32x4_t*)(lds + GL_KI + tk * 288 + part * 16) = rk[i];
    }
#pragma unroll
    for (int i = 0; i < 4; ++i) {
      const int id = tid + 512 * i, tk = id >> 5, part = id & 31;
      *(LAS u32x4_t*)(lds + GL_V + tk * 544 + part * 16) = rv[i];
    }
    if (tid < 256) *(LAS u32x4_t*)(lds + GL_GLOW + (tid >> 2) * 64 + (tid & 3) * 16) = rg;
    GLA_MARK(1); GLA_BAR();
    GLA_LOAD((ch + 1 < SEQ / 64) ? ch + 1 : ch);
    u32x4_t rs[4];
#pragma unroll
    for (int i = 0; i < 4; ++i) {
      const int id = tid + 512 * i, tk = id >> 5, part = id & 31;
      rs[i] = *(const u32x4_t*)(SGR + (tb + tk) * 1024 + h * 256 + part * 8);
    }
    LAS float* LB = (LAS float*)(lds + GL_LB);
    float run = 0.f;
#pragma unroll 2
    for (int i = 0; i < 16; ++i) {
      const LAS f32x4* gp = (const LAS f32x4*)(lds + GL_GLOW + (16 * tq + i) * 64);
      const f32x4 g0 = gp[0], g1 = gp[1], g2 = gp[2], g3 = gp[3];
      float gl = bg;
      gl += g0[0] * wg[0] + g0[1] * wg[1] + g0[2] * wg[2] + g0[3] * wg[3];
      gl += g1[0] * wg[4] + g1[1] * wg[5] + g1[2] * wg[6] + g1[3] * wg[7];
      gl += g2[0] * wg[8] + g2[1] * wg[9] + g2[2] * wg[10] + g2[3] * wg[11];
      gl += g3[0] * wg[12] + g3[1] * wg[13] + g3[2] * wg[14] + g3[3] * wg[15];
      const float ls = fminf(gl, 0.f) - __logf(1.f + __expf(-fabsf(gl)));
      run += ls * (1.f / 16.f);
      LB[(16 * tq + i) * 128 + d] = run;
    }
    QT[tq * 128 + d] = run;
    GLA_MARK(2); GLA_BAR();
    {
      float off = 0.f, tot = 0.f;
#pragma unroll
      for (int k = 0; k < 4; ++k) { const float v = QT[k * 128 + d]; tot += v; off += (k < tq) ? v : 0.f; }
      const float eb = __expf(tot);
#pragma unroll 2
      for (int i = 0; i < 16; ++i) {
        const int t = 16 * tq + i;
        const float bb = LB[t * 128 + d] + off;
        const float e = __expf(bb), r = __expf(-bb);
        LAS bf16* qp = (LAS bf16*)(lds + GL_QD + t * 288) + d;
        LAS bf16* kp = (LAS bf16*)(lds + GL_KI + t * 288) + d;
        LAS bf16* ep = (LAS bf16*)(lds + GL_KE + t * 288) + d;
        const float q = bf2f(*qp), k = bf2f(*kp);
        *qp = f2bf(q * e);
        *kp = f2bf(k * r);
        *ep = f2bf(k * (eb * r));
      }
      if (tq == 0) DEC[d] = eb;
    }
    GLA_MARK(3); GLA_BAR();
    {
      const int ti = wave >> 1;
#pragma unroll
      for (int u = 0; u < 2; ++u) {
        const int tj = 2 * (wave & 1) + u;
        f32x4 acc = (f32x4){0.f, 0.f, 0.f, 0.f};
        if (tj <= ti) {
#pragma unroll
          for (int ks = 0; ks < 4; ++ks) {
            const bf16x8_t a = *(const LAS bf16x8_t*)(lds + GL_QD + (16 * ti + c) * 288 + (32 * ks + 8 * g) * 2);
            const bf16x8_t bb = *(const LAS bf16x8_t*)(lds + GL_KI + (16 * tj + c) * 288 + (32 * ks + 8 * g) * 2);
            acc = __builtin_amdgcn_mfma_f32_16x16x32_bf16(a, bb, acc, 0, 0, 0);
          }
        }
#pragma unroll
        for (int r = 0; r < 4; ++r) {
          const int i = 16 * ti + 4 * g + r, j = 16 * tj + c;
          *((LAS bf16*)(lds + GL_AT + i * 144) + j) = f2bf((j <= i) ? acc[r] : 0.f);
        }
      }
    }
    GLA_MARK(4); GLA_BAR();
    f32x4 o[4][2];
    {
      bf16x8_t vf[2][2];
      {
        s16x4_t lo[4], hi[4];
#pragma unroll
        for (int ks = 0; ks < 2; ++ks)
#pragma unroll
          for (int tn = 0; tn < 2; ++tn) {
            lo[ks * 2 + tn] = tr_read_b64(vtr + (32 * ks) * 544 + tn * 32);
            hi[ks * 2 + tn] = tr_read_b64(vtr + (32 * ks + 4) * 544 + tn * 32);
          }
        asm volatile("s_waitcnt lgkmcnt(0)" ::: "memory");
        __builtin_amdgcn_sched_barrier(0);
#pragma unroll
        for (int u = 0; u < 4; ++u)
          vf[u >> 1][u & 1] = (bf16x8_t){lo[u][0], lo[u][1], lo[u][2], lo[u][3], hi[u][0], hi[u][1], hi[u][2], hi[u][3]};
      }
#pragma unroll
      for (int tm = 0; tm < 4; ++tm) { o[tm][0] = (f32x4){0.f, 0.f, 0.f, 0.f}; o[tm][1] = (f32x4){0.f, 0.f, 0.f, 0.f}; }
#pragma unroll
      for (int tm = 0; tm < 4; ++tm)
#pragma unroll
        for (int ks = 0; ks < 2; ++ks) {
          if (ks == 1 && tm < 2) continue;
          const bf16x8_t a = *(const LAS bf16x8_t*)(lds + GL_AT + (16 * tm + c) * 144 + (32 * ks + 8 * g) * 2);
          o[tm][0] = __builtin_amdgcn_mfma_f32_16x16x32_bf16(a, vf[ks][0], o[tm][0], 0, 0, 0);
          o[tm][1] = __builtin_amdgcn_mfma_f32_16x16x32_bf16(a, vf[ks][1], o[tm][1], 0, 0, 0);
          __builtin_amdgcn_sched_barrier(0);
        }
#pragma unroll
      for (int u = 0; u < 4; ++u) {
        union { bf16x8_t v; unsigned w[4]; } s0, s1;
        s0.w[0] = pk2(S[2 * u][0][0], S[2 * u][0][1]); s0.w[1] = pk2(S[2 * u][0][2], S[2 * u][0][3]);
        s0.w[2] = pk2(S[2 * u + 1][0][0], S[2 * u + 1][0][1]); s0.w[3] = pk2(S[2 * u + 1][0][2], S[2 * u + 1][0][3]);
        s1.w[0] = pk2(S[2 * u][1][0], S[2 * u][1][1]); s1.w[1] = pk2(S[2 * u][1][2], S[2 * u][1][3]);
        s1.w[2] = pk2(S[2 * u + 1][1][0], S[2 * u + 1][1][1]); s1.w[3] = pk2(S[2 * u + 1][1][2], S[2 * u + 1][1][3]);
#pragma unroll
        for (int tm = 0; tm < 4; ++tm) {
          const LAS unsigned char* qrow = lds + GL_QD + (16 * tm + c) * 288 + (32 * u + 4 * g) * 2;
          const s16x4_t q0 = *(const LAS s16x4_t*)qrow, q1 = *(const LAS s16x4_t*)(qrow + 32);
          const bf16x8_t a = (bf16x8_t){q0[0], q0[1], q0[2], q0[3], q1[0], q1[1], q1[2], q1[3]};
          o[tm][0] = __builtin_amdgcn_mfma_f32_16x16x32_bf16(a, s0.v, o[tm][0], 0, 0, 0);
          o[tm][1] = __builtin_amdgcn_mfma_f32_16x16x32_bf16(a, s1.v, o[tm][1], 0, 0, 0);
        }
        __builtin_amdgcn_sched_barrier(0);
      }
#pragma unroll
      for (int tk = 0; tk < 8; ++tk) {
        const f32x4 dec4 = *(const LAS f32x4*)(DEC + 16 * tk + 4 * g);
        S[tk][0] *= dec4; S[tk][1] *= dec4;
        s16x4_t lo0 = tr_read_b64(ketr + tk * 32), hi0 = tr_read_b64(ketr + 4 * 288 + tk * 32);
        s16x4_t lo1 = tr_read_b64(ketr + 32 * 288 + tk * 32), hi1 = tr_read_b64(ketr + 36 * 288 + tk * 32);
        asm volatile("s_waitcnt lgkmcnt(0)" ::: "memory");
        __builtin_amdgcn_sched_barrier(0);
        const bf16x8_t a0 = (bf16x8_t){lo0[0], lo0[1], lo0[2], lo0[3], hi0[0], hi0[1], hi0[2], hi0[3]};
        const bf16x8_t a1 = (bf16x8_t){lo1[0], lo1[1], lo1[2], lo1[3], hi1[0], hi1[1], hi1[2], hi1[3]};
        S[tk][0] = __builtin_amdgcn_mfma_f32_16x16x32_bf16(a0, vf[0][0], S[tk][0], 0, 0, 0);
        S[tk][1] = __builtin_amdgcn_mfma_f32_16x16x32_bf16(a0, vf[0][1], S[tk][1], 0, 0, 0);
        S[tk][0] = __builtin_amdgcn_mfma_f32_16x16x32_bf16(a1, vf[1][0], S[tk][0], 0, 0, 0);
        S[tk][1] = __builtin_amdgcn_mfma_f32_16x16x32_bf16(a1, vf[1][1], S[tk][1], 0, 0, 0);
        __builtin_amdgcn_sched_barrier(0);
      }
#pragma unroll
      for (int tm = 0; tm < 4; ++tm)
#pragma unroll
        for (int r = 0; r < 4; ++r) {
          float ss = o[tm][0][r] * o[tm][0][r] + o[tm][1][r] * o[tm][1][r];
          ss = row16_sum(ss);
          if (c == 0) SSQ[(16 * tm + 4 * g + r) * 8 + wave] = ss;
        }
    }
    GLA_MARK(5); GLA_BAR();
    {
      LAS bf16* OB = (LAS bf16*)(lds + GL_LB);
#pragma unroll
      for (int tm = 0; tm < 4; ++tm)
#pragma unroll
        for (int r = 0; r < 4; ++r) {
          const int t = 16 * tm + 4 * g + r;
          const f32x4 p0 = *(const LAS f32x4*)(SSQ + t * 8), p1 = *(const LAS f32x4*)(SSQ + t * 8 + 4);
          const float tot = ((p0[0] + p0[1]) + (p0[2] + p0[3])) + ((p1[0] + p1[1]) + (p1[2] + p1[3]));
          const float rstd = rsqrtf(tot * (1.f / 256.f) + 1e-6f);
          OB[t * 256 + 32 * wave + c] = f2bf(o[tm][0][r] * rstd * gn0);
          OB[t * 256 + 32 * wave + 16 + c] = f2bf(o[tm][1][r] * rstd * gn1);
        }
    }
    GLA_MARK(6); GLA_BAR();
#pragma unroll
    for (int i = 0; i < 4; ++i) {
      const int id = tid + 512 * i, tk = id >> 5, part = id & 31;
      const u32x4_t ov = *(const LAS u32x4_t*)(lds + GL_LB + tk * 512 + part * 16);
      const u32x4_t sv = rs[i];
      u32x4_t gv;
      gv[0] = pk2(bflo(ov[0]) * bflo(sv[0]), bfhi(ov[0]) * bfhi(sv[0]));
      gv[1] = pk2(bflo(ov[1]) * bflo(sv[1]), bfhi(ov[1]) * bfhi(sv[1]));
      gv[2] = pk2(bflo(ov[2]) * bflo(sv[2]), bfhi(ov[2]) * bfhi(sv[2]));
      gv[3] = pk2(bflo(ov[3]) * bflo(sv[3]), bfhi(ov[3]) * bfhi(sv[3]));
      *(u32x4_t*)(Vg + (tb + tk) * 1024 + h * 256 + part * 8) = gv;
    }
    GLA_MARK(7);
  }
#undef GLA_LOAD
  __syncthreads();
}

#define LDS_BYTES 155712
#define OFF_XBAR (224ull * 1024)
#define OFF_CTR (200ull * 1024)

__device__ __forceinline__ unsigned xcc_id() { return (unsigned)__builtin_amdgcn_s_getreg((3 << 11) | 20) & 0x7u; }
__device__ __forceinline__ void ph_mixer(const P& p, unsigned char* lds_raw, bool do_gla) {
  if (do_gla && blockIdx.x < 32) { gla_item(p, lds_raw, blockIdx.x); if (blockIdx.x == 0) TS_SET(p, 20); }
  unsigned* ctr = (unsigned*)(p.ws + OFF_CTR);
  LAS unsigned* slot = (LAS unsigned*)((LAS unsigned char*)lds_raw + DS_TOTAL);
  const unsigned home = xcc_id();
  unsigned k = 0;
  for (;;) {
    if (tid_fresh() == 0) {
      unsigned qi = 0xffffffffu;
      while (k < 8) {
        const unsigned b = (home + k) & 7u;
        const unsigned v = __hip_atomic_fetch_add(ctr + 64 * b, 1u, __ATOMIC_RELAXED, __HIP_MEMORY_SCOPE_AGENT);
        if (v < 128u) { qi = (b << 8) | v; break; }
        ++k;
      }
      slot[0] = qi; slot[1] = k;
    }
    __syncthreads();
    const unsigned qi = slot[0];
    k = slot[1];
    __syncthreads();
    if (qi == 0xffffffffu) break;
    dsa_batch(p, lds_raw, (int)(qi >> 8), 127 - (int)(qi & 255u));
  }
}

__global__ void __launch_bounds__(512, 2) mega(P p) {
  extern __shared__ __attribute__((aligned(16))) unsigned char lds_raw[];
  LAS unsigned char* lds = (LAS unsigned char*)lds_raw;
  cg::grid_group grid = cg::this_grid();
  char* ws = p.ws;
  const int bid = blockIdx.x, nb = gridDim.x;
  if (bid == 0 && threadIdx.x < 8) *(unsigned*)(ws + OFF_CTR + 256 * threadIdx.x) = 0u;
  if (bid == 0) { for (int i = threadIdx.x; i < XCD_BAR_WORDS; i += 512) ((unsigned*)(ws + OFF_XBAR))[i] = 0u; }
  volatile LAS unsigned* xst = (volatile LAS unsigned*)(lds + DS_TOTAL + 16);
  if (threadIdx.x < 4) xst[threadIdx.x] = 0u;
#if PROBE_TS
  { const int t_ = tid_fresh(); if (bid == 0 && t_ < 64) ((unsigned long long*)(ws + OFF_TS))[t_] = 0ull; }
  __syncthreads();
  if (bid == 0) TS_SET(p, 0);
#endif
  ph_prep(p, (float*)lds_raw);
  grid.sync();
  const XcdBarrier xb = xcd_barrier_post((unsigned*)(ws + OFF_XBAR), xst);
  if (bid == 0) TS_SET(p, 1);
  ph_mod(p, p.x, p.norm1_g, 0, 1024, (bf16*)(ws + OFF_H), bid, nb);
  xcd_barrier(xb);
  if (bid == 0) TS_SET(p, 2);
  gemm_run(lds, (const bf16*)(ws + OFF_H), (const bf16*)(ws + OFF_WT_IN), TT, 7168, 1024, EpiIn{ws, p.out});
  xcd_barrier(xb);
  if (bid == 0) TS_SET(p, 3);
  ph_mixer(p, lds_raw, true);
  if (bid == 0) TS_SET(p, 21);
  xcd_barrier(xb);
  if (bid == 0) TS_SET(p, 4);
  gemm_run(lds, (const bf16*)(ws + OFF_V), (const bf16*)(ws + OFF_WT_A), TT, 1024, 1024,
           EpiMix<false>{(const bf16*)p.out, (bf16*)(ws + OFF_MIX)});
  gemm_run(lds, (const bf16*)(ws + OFF_ODSA), (const bf16*)(ws + OFF_WT_B), TT, 1024, 1024,
           EpiMix<true>{(const bf16*)p.out + (size_t)TT * 1024, (bf16*)(ws + OFF_MIX)});
  xcd_barrier(xb);
  if (bid == 0) TS_SET(p, 5);
  gemm_run(lds, (const bf16*)(ws + OFF_MIX), (const bf16*)(ws + OFF_WT_OUT), TT, 1024, 1024,
           EpiX1{p.x, (const float*)(ws + OFF_ADA), p.out});
  xcd_barrier(xb);
  if (bid == 0) TS_SET(p, 6);
  ph_mod(p, p.out, (const float*)(ws + OFF_PRM) + PRM_N2G, 3072, 4096, (bf16*)(ws + OFF_H), bid, nb);
  xcd_barrier(xb);
  if (bid == 0) TS_SET(p, 7);
  gemm_run(lds, (const bf16*)(ws + OFF_H), (const bf16*)(ws + OFF_WT_Q), TT, 2048, 1024, EpiPlain{(bf16*)(ws + OFF_PQ), 2048});
  xcd_barrier(xb);
  if (bid == 0) TS_SET(p, 8);
  ph_peer512(p, lds_raw, p.out);
#if PROBE_TS
  if (bid == 0) TS_SET(p, 18);
  xcd_barrier(xb);
  {
    const unsigned long long* T = (const unsigned long long*)(ws + OFF_TS);
    const unsigned long long q = (unsigned long long)(PROBE_Q), t0 = __builtin_amdgcn_s_memrealtime();
    while (__builtin_amdgcn_s_memrealtime() - t0 < q) __builtin_amdgcn_s_sleep(8);
  }
#endif
}

extern "C" void kernel_launch(void* const* d_in, const int* in_sizes, int n_in, void* d_out, int out_size, void* d_ws,
                              size_t ws_size, hipStream_t stream) {
  P p{};
  const float** f = (const float**)&p;
  for (int i = 0; i < 22; ++i) f[i] = (const float*)d_in[i];
  p.out = (float*)d_out;
  p.ws = (char*)d_ws;
  if (ws_size < WS_NEED) { fprintf(stderr, "workspace too small: %zu\n", ws_size); return; }
  static int grid_blocks = 0;
  if (!grid_blocks) {
    int dev = 0, cus = 0, per_cu = 0;
    (void)hipGetDevice(&dev);
    (void)hipDeviceGetAttribute(&cus, hipDeviceAttributeMultiprocessorCount, dev);
    if (hipFuncSetAttribute((const void*)mega, hipFuncAttributeMaxDynamicSharedMemorySize, LDS_BYTES) != hipSuccess) {
      fprintf(stderr, "hipFuncSetAttribute failed\n"); grid_blocks = -1; return;
    }
    if (hipOccupancyMaxActiveBlocksPerMultiprocessor(&per_cu, (const void*)mega, 512, LDS_BYTES) != hipSuccess || per_cu < 1) {
      fprintf(stderr, "occupancy query failed\n"); grid_blocks = -1; return;
    }
    grid_blocks = cus;
  }
  if (grid_blocks <= 0) return;
  void* args[] = {&p};
  hipError_t e = hipLaunchCooperativeKernel((void*)mega, dim3(grid_blocks), dim3(512), args, LDS_BYTES, stream);
  if (e != hipSuccess) fprintf(stderr, "cooperative launch failed: %s (grid %d)\n", hipGetErrorString(e), grid_blocks);
}
```

```cpp
#include <hip/hip_runtime.h>
#include <hip/hip_cooperative_groups.h>
#include <cstdio>
#include <cstdint>
namespace cg = cooperative_groups;

#define TT 32768
#define SEQ 4096
#define DM 1024
#define NIN 7000
typedef unsigned short bf16;
#define LAS __attribute__((address_space(3)))

struct P {
  const float *x, *c, *w_ada, *b_ada, *norm1_g, *w_in, *w_gate_up, *b_gate, *gla_norm_g, *kv_norm_g,
      *w_uk, *w_uv, *w_a, *w_b, *w_out, *norm2_g, *w_q, *sk1, *sk2, *peer_u, *peer_v, *final_g;
  float* out;
  char* ws;
};

#define MB (1ull << 20)
#define OFF_ADA   (0ull)
#define OFF_H     (1 * MB)
#define OFF_ODSA  (1 * MB)
#define OFF_Q     (65 * MB)
#define OFF_K     (97 * MB)
#define OFF_MIX   (65 * MB)
#define OFF_V     (129 * MB)
#define OFF_DQ    (193 * MB)
#define OFF_PQ    (129 * MB)
#define OFF_DSCR  (257 * MB)
#define OFF_SSP   (256ull * 1024)
#define OFF_CKV   (289 * MB)
#define OFF_IQ    (305 * MB)
#define OFF_IK    (337 * MB)
#define OFF_IW    (341 * MB)
#define OFF_GLOW  (342 * MB)
#define OFF_SGR   (344 * MB)
#define OFF_WT    (408 * MB)
#define OFF_WT_IN  (OFF_WT)
#define OFF_WT_A   (OFF_WT + 7168ull * 2048)
#define OFF_WT_B   (OFF_WT_A + 1024ull * 2048)
#define OFF_WT_OUT (OFF_WT_B + 1024ull * 2048)
#define OFF_WT_Q   (OFF_WT_OUT + 1024ull * 2048)
#define OFF_PU    (432 * MB)
#define OFF_PV    (464 * MB)
#define OFF_SK    (496 * MB)
#define OFF_PSC   (496 * MB + 128 * 1024)
#define OFF_WUK   (497 * MB)
#define OFF_WUV   (497 * MB + 512 * 1024)
#define WS_NEED   (498 * MB)

__device__ __forceinline__ bf16 f2bf(float f) {
  unsigned u = __float_as_uint(f);
  u += 0x7fffu + ((u >> 16) & 1u);
  return (bf16)(u >> 16);
}
__device__ __forceinline__ unsigned pk2(float lo, float hi) { return (unsigned)f2bf(lo) | ((unsigned)f2bf(hi) << 16); }
__device__ __forceinline__ float bf2f(bf16 h) { return __uint_as_float(((unsigned)h) << 16); }
__device__ __forceinline__ float bflo(unsigned u) { return __uint_as_float(u << 16); }
__device__ __forceinline__ float bfhi(unsigned u) { return __uint_as_float(u & 0xffff0000u); }
__device__ __forceinline__ float wave_sum(float v) {
#pragma unroll
  for (int o = 32; o > 0; o >>= 1) v += __shfl_xor(v, o);
  return v;
}
__device__ __forceinline__ float wave_max(float v) {
#pragma unroll
  for (int o = 32; o > 0; o >>= 1) v = fmaxf(v, __shfl_xor(v, o));
  return v;
}
#ifndef PROBE_TS
#define PROBE_TS 0
#endif
#define OFF_PRM (800ull * 1024)
#define PRM_WGU   0
#define PRM_BG    8192
#define PRM_GNG   8704
#define PRM_N2G   9728
#define PRM_FG    10752
#define PRM_TOTAL 11776
#define OFF_TS (208ull * 1024)
#if PROBE_TS
#define TS_SET(p, k) do { if (tid_fresh() == 0) ((unsigned long long*)((p).ws + OFF_TS))[k] = __builtin_amdgcn_s_memrealtime(); } while (0)
#define TS_ADD(p, k, t0) do { if (tid_fresh() == 0) ((unsigned long long*)((p).ws + OFF_TS))[k] += __builtin_amdgcn_s_memrealtime() - (t0); } while (0)
#define TS_NOW() __builtin_amdgcn_s_memrealtime()
#else
#define TS_SET(p, k) do {} while (0)
#define TS_ADD(p, k, t0) do {} while (0)
#define TS_NOW() 0ull
#endif
__device__ __forceinline__ int tid_fresh() { int t = threadIdx.x; asm volatile("" : "+v"(t)); return t; }
__device__ __forceinline__ float sigmoidf_(float v) { return 1.f / (1.f + __expf(-v)); }
__device__ __forceinline__ float siluf_(float v) { return v / (1.f + __expf(-v)); }

#include <hip/hip_runtime.h>
namespace pg8 {
#define PG8_LAS __attribute__((address_space(3)))
typedef unsigned short bf16_t;
typedef short bf16x8 __attribute__((ext_vector_type(8)));
typedef float f32x4 __attribute__((ext_vector_type(4)));
typedef unsigned u32x4 __attribute__((ext_vector_type(4)));
constexpr int BM = 256, BK = 64, HALF = 128, HTB = HALF * BK * 2  , STAGE_BYTES = 8 * HTB, NXCD = 8, WGM = 8;

__host__ __device__ __forceinline__ int lds_byte(int r, int c) { const int st = (r >> 4) * 2 + (c >> 5), rr = r & 15, cc = c & 31, ob = rr * 64 + cc * 2; return st * 1024 + (ob ^ (((ob >> 9) & 1) << 5)); }
__host__ __device__ __forceinline__ void stage_rc(int b, int& R, int& C) { const int st = b / 1024, sb = b % 1024, swz = sb ^ (((sb >> 9) & 1) << 5); R = (st >> 1) * 16 + swz / 64; C = (st & 1) * 32 + (swz % 64) / 2; }
__host__ __device__ __forceinline__ int perm32(int rho) { const int n = rho >> 4, i = rho & 15; return 8 * (i >> 2) + 4 * n + (i & 3); }

struct Unit { int pm, pn; };
struct Gemm { const bf16_t* A; const bf16_t* Bt; int M, N, K; };

struct StaticOrder {
    int nM, nN, nwg, G, c;
    __host__ __device__ void init(int M, int N, int G_, int c_) { nM = M / BM; nN = N / BM; nwg = nM * nN; G = G_; c = c_; }
    __host__ __device__ bool next(int i, Unit& u) const {
        const long L = (long)i * G + c; if (L >= nwg) return false;
        int wgid = (int)L; { const int q = nwg / NXCD, r = nwg % NXCD, xcd = wgid % NXCD, off = wgid / NXCD; wgid = (xcd < r ? xcd * (q + 1) : r * (q + 1) + (xcd - r) * q) + off; }
        const int nig = WGM * nN, gid = wgid / nig, fm = gid * WGM, gsz = (nM - fm) < WGM ? (nM - fm) : WGM;
        u.pm = fm + ((wgid % nig) % gsz); u.pn = (wgid % nig) / gsz; return true;
    }
    __device__ __forceinline__ void a_ready(const Unit&) const {}
    __device__ __forceinline__ void done(const Unit&) const {}
};
__device__ __forceinline__ unsigned cvt_pk_bf16(float lo, float hi) { unsigned r; asm volatile("v_cvt_pk_bf16_f32 %0, %1, %2" : "=v"(r) : "v"(lo), "v"(hi)); return r; }

template <class Epi, class Sched, bool STAMP = false>
__device__ __forceinline__ void gemm_phase(PG8_LAS unsigned char* lds, const Gemm g, const Sched& S, const Epi& E, unsigned long long* stamps) {
    const int tid = ::tid_fresh(), wid = __builtin_amdgcn_readfirstlane(tid >> 6), lane = tid & 63, wr = wid >> 2, wc = wid & 3, fr = lane & 15, fq = lane >> 4;
    const int K = g.K, nt = K / BK;
    int ts_lo = 0, ts_hi = 0, nts = 0; const unsigned long long rt_entry = STAMP ? (unsigned long long)wall_clock64() : 0ull;
#define PG8_STAMP() do { if (STAMP && wid == 0 && nts < 64) { const unsigned long long _c = (unsigned long long)clock64(); \
        ts_lo = (lane == nts) ? (int)(unsigned)_c : ts_lo; ts_hi = (lane == nts) ? (int)(unsigned)(_c >> 32) : ts_hi; ++nts; } } while (0)
    PG8_STAMP();
    unsigned voffA[2], voffB[2];
#pragma unroll
    for (int i = 0; i < 2; ++i) { int R, C; stage_rc(tid * 16 + i * 8192, R, C); const int Rb = Epi::PERM ? ((R & ~31) + perm32(R & 31)) : R;
        voffA[i] = (unsigned)(R * K + C) * 2u; voffB[i] = (unsigned)(Rb * K + C) * 2u; }
    const size_t kstep = (size_t)(BK * 2);
    const size_t hstep = (size_t)HALF * K * 2;
    const size_t tstep = 2 * hstep;
    const unsigned ldsw = (unsigned)wid * 1024u;
    const int aoff = lds_byte(wr * 64 + fr, fq * 8), boff = lds_byte(wc * 32 + fr, fq * 8);
#define PG8_SA(b, h) (((b) * 2 + (h)) * HTB)
#define PG8_SB(b, h) ((4 + (b) * 2 + (h)) * HTB)
#define PG8_STAGE(bufoff, gbase, voff) do { _Pragma("unroll") for (int _i = 0; _i < 2; ++_i) \
        __builtin_amdgcn_global_load_lds((const unsigned*)((const char*)(gbase) + (voff)[_i]), (PG8_LAS unsigned*)(lds + (bufoff) + ldsw + _i * 8192), 16, 0, 0); } while (0)
#define PG8_LDA(dst, b, h) do { _Pragma("unroll") for (int m = 0; m < 4; ++m) _Pragma("unroll") for (int k = 0; k < 2; ++k) dst[m][k] = *(const PG8_LAS bf16x8*)(lds + PG8_SA(b, h) + aoff + m * 2048 + k * 1024); } while (0)
#define PG8_LDB(dst, b, h) do { _Pragma("unroll") for (int n = 0; n < 2; ++n) _Pragma("unroll") for (int k = 0; k < 2; ++k) dst[n][k] = *(const PG8_LAS bf16x8*)(lds + PG8_SB(b, h) + boff + n * 2048 + k * 1024); } while (0)
#define PG8_MMA(ai, bj, At, Bt) do { __builtin_amdgcn_s_setprio(1); _Pragma("unroll") for (int m = 0; m < 4; ++m) _Pragma("unroll") for (int n = 0; n < 2; ++n) _Pragma("unroll") for (int k = 0; k < 2; ++k) \
        acc[ai][bj][m][n] = __builtin_amdgcn_mfma_f32_16x16x32_bf16(Bt[n][k], At[m][k], acc[ai][bj][m][n], 0, 0, 0); __builtin_amdgcn_s_setprio(0); } while (0)
#define PG8_WAIT_V(n) asm volatile("s_waitcnt vmcnt(" #n ")" ::: "memory")
#define PG8_WAIT_L(n) asm volatile("s_waitcnt lgkmcnt(" #n ")" ::: "memory")
#define PG8_BAR __builtin_amdgcn_s_barrier()
#define PG8_SCHED __builtin_amdgcn_sched_barrier(0)
    Unit cur, nxt; int ui = 0;
    if (!S.next(0, cur)) return;
    f32x4 acc[2][2][4][2];
#pragma unroll
    for (int a = 0; a < 2; ++a)
#pragma unroll
        for (int b = 0; b < 2; ++b)
#pragma unroll
            for (int m = 0; m < 4; ++m)
#pragma unroll
                for (int n = 0; n < 2; ++n) acc[a][b][m][n] = (f32x4){0.f, 0.f, 0.f, 0.f};
    bf16x8 At[4][2], B0[2][2], B1[2][2];
    const char* cA = (const char*)g.A + (size_t)cur.pm * tstep; const char* cB = (const char*)g.Bt + (size_t)cur.pn * tstep;
    S.a_ready(cur);
    PG8_STAGE(PG8_SB(0, 0), cB, voffB); PG8_STAGE(PG8_SA(0, 0), cA, voffA); PG8_STAGE(PG8_SB(0, 1), cB + hstep, voffB); PG8_STAGE(PG8_SA(0, 1), cA + hstep, voffA);
    if (wr == 1) PG8_BAR;
    PG8_WAIT_V(4); PG8_BAR;
    PG8_STAGE(PG8_SB(1, 0), cB + kstep, voffB); PG8_STAGE(PG8_SA(1, 0), cA + kstep, voffA); PG8_STAGE(PG8_SB(1, 1), cB + hstep + kstep, voffB);
    PG8_WAIT_V(6); PG8_BAR;
    PG8_STAMP();
    for (;;) {
        const bool has_next = S.next(ui + 1, nxt);
        const char* nA = has_next ? (const char*)g.A + (size_t)nxt.pm * tstep : cA; const char* nB = has_next ? (const char*)g.Bt + (size_t)nxt.pn * tstep : cB;
        for (int t = 0; t < nt; t += 2) {
            const bool last = (t == nt - 2);
            const char* a1 = cA + (size_t)(t + 1) * kstep;
            const char* a2 = last ? nA : cA + (size_t)(t + 2) * kstep; const char* b2 = last ? nB : cB + (size_t)(t + 2) * kstep;
            const char* a3 = a2 + kstep; const char* b3 = b2 + kstep;
            if (last && has_next) S.a_ready(nxt);
            PG8_LDB(B0, 0, 0); PG8_SCHED; PG8_LDA(At, 0, 0); PG8_STAGE(PG8_SA(1, 1), a1 + hstep, voffA);
            PG8_WAIT_L(8); PG8_BAR; PG8_WAIT_L(0); PG8_MMA(0, 0, At, B0); PG8_BAR; PG8_SCHED;
            PG8_LDB(B1, 0, 1); PG8_STAGE(PG8_SB(0, 0), b2, voffB);
            PG8_BAR; PG8_WAIT_L(0); PG8_MMA(0, 1, At, B1); PG8_BAR;
            PG8_LDA(At, 0, 1); PG8_STAGE(PG8_SA(0, 0), a2, voffA);
            PG8_BAR; PG8_WAIT_L(0); PG8_MMA(1, 0, At, B0); PG8_BAR; PG8_SCHED;
            PG8_STAGE(PG8_SB(0, 1), b2 + hstep, voffB);
            PG8_WAIT_V(6); PG8_BAR; PG8_MMA(1, 1, At, B1); PG8_BAR;
            PG8_LDB(B0, 1, 0); PG8_SCHED; PG8_LDA(At, 1, 0); PG8_STAGE(PG8_SA(0, 1), a2 + hstep, voffA);
            PG8_WAIT_L(8); PG8_BAR; PG8_WAIT_L(0); PG8_MMA(0, 0, At, B0); PG8_BAR; PG8_SCHED;
            PG8_LDB(B1, 1, 1); PG8_STAGE(PG8_SB(1, 0), b3, voffB);
            PG8_BAR; PG8_WAIT_L(0); PG8_MMA(0, 1, At, B1); PG8_BAR;
            PG8_LDA(At, 1, 1); PG8_STAGE(PG8_SA(1, 0), a3, voffA);
            PG8_BAR; PG8_WAIT_L(0); PG8_MMA(1, 0, At, B0); PG8_BAR; PG8_SCHED;
            PG8_STAGE(PG8_SB(1, 1), b3 + hstep, voffB);
            PG8_WAIT_V(6); PG8_BAR; PG8_MMA(1, 1, At, B1); PG8_BAR;
        }
        PG8_STAMP();
        if constexpr (!Epi::AFTER_DRAIN) { E(acc, cur, wr, wc, fr, fq); S.done(cur); }
        PG8_STAMP();
        if (!has_next) break;
#pragma unroll
        for (int a = 0; a < 2; ++a)
#pragma unroll
            for (int b = 0; b < 2; ++b)
#pragma unroll
                for (int m = 0; m < 4; ++m)
#pragma unroll
                    for (int n = 0; n < 2; ++n) acc[a][b][m][n] = (f32x4){0.f, 0.f, 0.f, 0.f};
        cur = nxt; cA = nA; cB = nB; ++ui;
    }
    PG8_WAIT_V(0);
    if (wr == 0) PG8_BAR;
    PG8_BAR;
    if constexpr (Epi::AFTER_DRAIN) { E.fused(acc, cur, wr, wc, fr, fq, lds, wid, lane); S.done(cur); }
    PG8_STAMP();
    if (STAMP && wid == 0) { stamps[lane] = lane < nts ? (((unsigned long long)(unsigned)ts_hi << 32) | (unsigned)ts_lo) : 0ull;
        if (lane == 62) stamps[62] = rt_entry; if (lane == 63) stamps[63] = (unsigned long long)wall_clock64(); }
#undef PG8_STAMP
#undef PG8_SA
#undef PG8_SB
#undef PG8_STAGE
#undef PG8_LDA
#undef PG8_LDB
#undef PG8_MMA
#undef PG8_WAIT_V
#undef PG8_WAIT_L
#undef PG8_BAR
#undef PG8_SCHED
}
}
#define XB_TMO      128
#define XB_XCNT(j)  (256  + 64 * (j))
#define XB_XSUB(j)  (1280 + 64 * (j))
#define XB_XGEN(j)  (2304 + 64 * (j))
#define XB_TOP      3328
#define XB_TOPGEN   3392
#define XCD_BAR_WORDS 3456
#define XB_SPIN_CAP (1u << 18)

__device__ __forceinline__ unsigned xb_ld(unsigned* p)              { return __hip_atomic_load(p, __ATOMIC_RELAXED, __HIP_MEMORY_SCOPE_AGENT); }
__device__ __forceinline__ unsigned xb_add(unsigned* p, unsigned v) { return __hip_atomic_fetch_add(p, v, __ATOMIC_RELAXED, __HIP_MEMORY_SCOPE_AGENT); }
__device__ __forceinline__ unsigned xb_xcc_id() { return (unsigned)__builtin_amdgcn_s_getreg((3 << 11) | 20) & 0xFu; }
#define XB_SPIN(cond, bar) do { unsigned _sp = 0; while (cond) { __builtin_amdgcn_s_sleep(1); \
    if ((++_sp & 255u) == 0u) { if (xb_ld(&(bar)[XB_TMO])) break; if (_sp > XB_SPIN_CAP) { atomicAdd(&(bar)[XB_TMO], 1u); break; } } } } while (0)

struct XcdBarrier {
    unsigned* bar; unsigned x;
    volatile LAS unsigned* st;
};

__device__ __forceinline__ XcdBarrier xcd_barrier_post(unsigned* bar, volatile LAS unsigned* st) {
    XcdBarrier b; b.bar = bar; b.x = xb_xcc_id(); b.st = st;
    if (threadIdx.x == 0) (void)xb_add(&bar[XB_XCNT(b.x)], 1u);
    return b;
}
__device__ __forceinline__ void xcd_barrier_complete(unsigned* bar, unsigned x, unsigned& nloc, unsigned& nx) {
    const unsigned G = gridDim.x * gridDim.y * gridDim.z;
    unsigned sum, cnt, mine, sp = 0u;
    for (;;) {
        sum = 0u; cnt = 0u; mine = 0u;
#pragma unroll
        for (unsigned j = 0; j < 16; ++j) { const unsigned c = xb_ld(&bar[XB_XCNT(j)]); sum += c; cnt += (c > 0u) ? 1u : 0u; mine = (j == x) ? c : mine; }
        if (sum == G) break;
        __builtin_amdgcn_s_sleep(1);
        if ((++sp & 255u) == 0u) { if (xb_ld(&bar[XB_TMO])) break; if (sp > XB_SPIN_CAP) { atomicAdd(&bar[XB_TMO], 1u); break; } }
    }
    nloc = mine > 0u ? mine : 1u; nx = cnt > 0u ? cnt : 1u;
}

__device__ __forceinline__ void xcd_barrier(const XcdBarrier& b) {
    asm volatile("s_waitcnt vmcnt(0)" ::: "memory");
    __syncthreads();
    if (threadIdx.x == 0) {
        unsigned* bar = b.bar;
        __builtin_amdgcn_s_waitcnt(0);
        unsigned nloc = b.st[0], nx = b.st[1];
        if (nloc == 0u) { xcd_barrier_complete(bar, b.x, nloc, nx); b.st[0] = nloc; b.st[1] = nx; }
        const unsigned old = xb_add(&bar[XB_XSUB(b.x)], 1u);
        const unsigned gen = old / nloc;
        if (old + 1u == (gen + 1u) * nloc) {
            __builtin_amdgcn_fence(__ATOMIC_RELEASE, "agent");
            asm volatile("s_waitcnt vmcnt(0)" ::: "memory");
            const unsigned og = xb_add(&bar[XB_TOP], 1u);
            const unsigned tg = og / nx;
            if (og + 1u == (tg + 1u) * nx) xb_add(&bar[XB_TOPGEN], 1u);
            else XB_SPIN(xb_ld(&bar[XB_TOPGEN]) == tg, bar);
            __builtin_amdgcn_fence(__ATOMIC_ACQUIRE, "agent");
            xb_add(&bar[XB_XGEN(b.x)], 1u);
            asm volatile("s_waitcnt vmcnt(0)" ::: "memory");
        } else {
            XB_SPIN(xb_ld(&bar[XB_XGEN(b.x)]) == gen, bar);
            __builtin_amdgcn_fence(__ATOMIC_ACQUIRE, "agent");
            asm volatile("s_waitcnt vmcnt(0)" ::: "memory");
        }
    }
    __syncthreads();
}

__device__ __forceinline__ void ph_mod(const P& p, const float* X, const float* g, int shift_off, int scale_off, bf16* H, int bid, int nb) {
  const float* ada = (const float*)(p.ws + OFF_ADA);
  const int tidm = tid_fresh(); int wave = tidm >> 6, lane = tidm & 63;
  const int rstride = nb * (int)(blockDim.x >> 6);
  int row = bid * (int)(blockDim.x >> 6) + wave;
  float4 v[4];
  if (row < TT) {
    const float4* xr = (const float4*)(X + (size_t)row * DM);
#pragma unroll
    for (int i = 0; i < 4; ++i) v[i] = xr[lane + i * 64];
  }
  for (; row < TT; row += rstride) {
    float4 vn[4];
    const int nrow = row + rstride;
    {
      const float4* xn = (const float4*)(X + (size_t)((nrow < TT) ? nrow : row) * DM);
#pragma unroll
      for (int i = 0; i < 4; ++i) vn[i] = xn[lane + i * 64];
    }
    float ss = 0.f;
#pragma unroll
    for (int i = 0; i < 4; ++i) ss += v[i].x * v[i].x + v[i].y * v[i].y + v[i].z * v[i].z + v[i].w * v[i].w;
    ss = wave_sum(ss);
    float rstd = rsqrtf(ss * (1.f / DM) + 1e-6f);
    int b = row >> 12;
    const float* sh = ada + b * 6144 + shift_off;
    const float* sc = ada + b * 6144 + scale_off;
#pragma unroll
    for (int i = 0; i < 4; ++i) {
      int c0 = (lane + i * 64) * 4;
      float4 gg = *(const float4*)(g + c0);
      float4 s4 = *(const float4*)(sc + c0);
      float4 h4 = *(const float4*)(sh + c0);
      ushort4 o;
      o.x = f2bf(v[i].x * rstd * gg.x * (1.f + s4.x) + h4.x);
      o.y = f2bf(v[i].y * rstd * gg.y * (1.f + s4.y) + h4.y);
      o.z = f2bf(v[i].z * rstd * gg.z * (1.f + s4.z) + h4.z);
      o.w = f2bf(v[i].w * rstd * gg.w * (1.f + s4.w) + h4.w);
      *(ushort4*)(H + (size_t)row * DM + c0) = o;
    }
#pragma unroll
    for (int i = 0; i < 4; ++i) v[i] = vn[i];
  }
}

using pg8::f32x4;
using pg8::u32x4;
using pg8::Unit;
using pg8::cvt_pk_bf16;
typedef short s16x4_t __attribute__((ext_vector_type(4)));
typedef unsigned u32x4_t __attribute__((ext_vector_type(4)));
typedef unsigned short u16x4_t __attribute__((ext_vector_type(4)));

__device__ __forceinline__ int in_srcmap(int d) {
  if (d < 2048) return d;
  if (d < 3072) return 3088 + (d - 2048);
  if (d < 3328) return 4112 + (d - 3072);
  if (d < 3840) return 4368 + (d - 3328);
  if (d < 3904) return 4880 + (d - 3840);
  if (d < 3912) return 4944 + (d - 3904);
  if (d < 3928) return 3072 + (d - 3912);
  if (d < 4096) return -1;
  if (d < 5120) return 2048 + (d - 4096);
  return 4952 + (d - 5120);
}
template <bool MAP>
__device__ __forceinline__ void transpose_item(const float* W, int ldw, int K, bf16* WT, int item, int nblk, float* scr, int lane) {
  const int kb = item / nblk, nbk = item % nblk, k0 = 64 * kb, n0 = 32 * nbk;
  const int d = n0 + (lane & 31);
  const int src = MAP ? in_srcmap(d) : d;
#pragma unroll 8
  for (int i = 0; i < 32; ++i) {
    const int kk = 2 * i + (lane >> 5);
    scr[kk * 33 + (lane & 31)] = (src >= 0) ? W[(size_t)(k0 + kk) * ldw + src] : 0.f;
  }
  asm volatile("s_waitcnt lgkmcnt(0)" ::: "memory");
  const int c = lane & 7;
#pragma unroll
  for (int j = 0; j < 4; ++j) {
    const int n = (lane >> 3) + 8 * j;
    const float* s = scr + (8 * c) * 33 + n;
    uint4 o;
    o.x = pk2(s[0 * 33], s[1 * 33]); o.y = pk2(s[2 * 33], s[3 * 33]); o.z = pk2(s[4 * 33], s[5 * 33]); o.w = pk2(s[6 * 33], s[7 * 33]);
    *(uint4*)(WT + (size_t)(n0 + n) * K + k0 + 8 * c) = o;
  }
  asm volatile("s_waitcnt lgkmcnt(0)" ::: "memory");
}

__device__ __forceinline__ void ph_prep(const P& p, float* sm) {
  const int tid = tid_fresh(), wave = tid >> 6, lane = tid & 63;
  const int bid = blockIdx.x, nb = gridDim.x;
  float* silc = sm + 8 * 2112 + 64;
  float* red = silc + 8192;
  float* ada = (float*)(p.ws + OFF_ADA);
  if (bid < 192) {
    for (int i = tid; i < 8192; i += 512) silc[i] = siluf_(p.c[i]);
    __syncthreads();
    for (int it = bid; it < 192; it += nb) {
      const int kg = tid >> 5, cn = tid & 31, n = it * 32 + cn;
      float acc[8];
#pragma unroll
      for (int b = 0; b < 8; ++b) acc[b] = 0.f;
      for (int k = kg * 64; k < kg * 64 + 64; ++k) {
        const float w = p.w_ada[(size_t)k * 6144 + n];
#pragma unroll
        for (int b = 0; b < 8; ++b) acc[b] += silc[b * 1024 + k] * w;
      }
#pragma unroll
      for (int b = 0; b < 8; ++b) red[(kg * 8 + b) * 32 + cn] = acc[b];
      __syncthreads();
      if (tid < 256) {
        const int b = tid >> 5, c2 = tid & 31;
        float s = 0.f;
#pragma unroll
        for (int g = 0; g < 16; ++g) s += red[(g * 8 + b) * 32 + c2];
        ada[b * 6144 + it * 32 + c2] = s + p.b_ada[it * 32 + c2];
      }
      __syncthreads();
    }
  }
  {
    unsigned char* PU8 = (unsigned char*)(p.ws + OFF_PU);
    unsigned char* PV8 = (unsigned char*)(p.ws + OFF_PV);
    float* PSC = (float*)(p.ws + OFF_PSC);
    for (int row = bid * 8 + wave; row < 2 * 16384; row += nb * 8) {
      const float* src = (row < 16384 ? p.peer_u : p.peer_v) + (size_t)(row & 16383) * 1024 + lane * 16;
      f32x4 v[4];
      float mx = 0.f;
#pragma unroll
      for (int q = 0; q < 4; ++q) {
        v[q] = *(const f32x4*)(src + q * 4);
        mx = fmaxf(mx, fmaxf(fmaxf(fabsf(v[q][0]), fabsf(v[q][1])), fmaxf(fabsf(v[q][2]), fabsf(v[q][3]))));
      }
      mx = wave_max(mx);
      const float sc = (mx > 0.f) ? exp2f(floorf(log2f(448.f / mx))) : 1.f;
      u32x4 o;
#pragma unroll
      for (int q = 0; q < 4; ++q) {
        int w = __builtin_amdgcn_cvt_pk_fp8_f32(v[q][0] * sc, v[q][1] * sc, 0, false);
        w = __builtin_amdgcn_cvt_pk_fp8_f32(v[q][2] * sc, v[q][3] * sc, w, true);
        o[q] = (unsigned)w;
      }
      *(u32x4*)((row < 16384 ? PU8 : PV8) + (size_t)(row & 16383) * 1024 + lane * 16) = o;
      if (lane == 0) PSC[row] = 1.f / sc;
    }
    for (int i = bid * 512 + tid; i < 2 * 2048; i += nb * 512) {
      const float* src = (i < 2048) ? p.sk1 : p.sk2;
      const int j = i & 2047;
      const float4 v0 = *(const float4*)(src + j * 8), v1 = *(const float4*)(src + j * 8 + 4);
      uint4 o; o.x = pk2(v0.x, v0.y); o.y = pk2(v0.z, v0.w); o.z = pk2(v1.x, v1.y); o.w = pk2(v1.z, v1.w);
      *(uint4*)((bf16*)(p.ws + OFF_SK) + (size_t)i * 8) = o;
    }
  }
  {
    float* prm = (float*)(p.ws + OFF_PRM);
    for (int i = bid * 512 + tid; i < PRM_TOTAL; i += nb * 512) {
      float v;
      if (i < PRM_BG) v = p.w_gate_up[i];
      else if (i < PRM_GNG) v = p.b_gate[i - PRM_BG];
      else if (i < PRM_N2G) v = p.gla_norm_g[i - PRM_GNG];
      else if (i < PRM_FG) v = p.norm2_g[i - PRM_N2G];
      else v = p.final_g[i - PRM_FG];
      prm[i] = v;
    }
  }
  {
    bf16* WUK = (bf16*)(p.ws + OFF_WUK);
    bf16* WUV = (bf16*)(p.ws + OFF_WUV);
    for (int i = bid * 512 + tid; i < 2 * 262144; i += nb * 512) {
      if (i < 262144) {
        const int d = i & 127, cc = (i >> 7) & 255, h = i >> 15;
        WUK[((h * 16 + (cc >> 4)) * 4 + (d >> 5)) * 512 + (((d >> 3) & 3) * 16 + (cc & 15)) * 8 + (d & 7)] =
            f2bf(p.w_uk[((size_t)h * 128 + d) * 256 + cc] * p.kv_norm_g[cc] * 0.08838834764831845f);
      } else {
        const int k = i - 262144;
        const int cc = k & 255, d = (k >> 8) & 127, h = k >> 15;
        WUV[((h * 8 + (d >> 4)) * 8 + (cc >> 5)) * 512 + (((cc >> 3) & 3) * 16 + (d & 15)) * 8 + (cc & 7)] =
            f2bf(p.w_uv[((size_t)h * 256 + cc) * 128 + d] * p.kv_norm_g[cc]);
      }
    }
  }
  float* scr = sm + wave * 2112;
  const int gw = bid * 8 + wave, ngw = nb * 8;
  constexpr int I_IN = 16 * 224, I_SQ = 16 * 32, I_Q = 16 * 64;
  for (int it = gw; it < I_IN + 3 * I_SQ + I_Q; it += ngw) {
    int r = it;
    if (r < I_IN) { transpose_item<true>(p.w_in, NIN, 1024, (bf16*)(p.ws + OFF_WT_IN), r, 224, scr, lane); continue; }
    r -= I_IN;
    if (r < I_SQ) { transpose_item<false>(p.w_a, 1024, 1024, (bf16*)(p.ws + OFF_WT_A), r, 32, scr, lane); continue; }
    r -= I_SQ;
    if (r < I_SQ) { transpose_item<false>(p.w_b, 1024, 1024, (bf16*)(p.ws + OFF_WT_B), r, 32, scr, lane); continue; }
    r -= I_SQ;
    if (r < I_SQ) { transpose_item<false>(p.w_out, 1024, 1024, (bf16*)(p.ws + OFF_WT_OUT), r, 32, scr, lane); continue; }
    r -= I_SQ;
    transpose_item<false>(p.w_q, 2048, 1024, (bf16*)(p.ws + OFF_WT_Q), r, 64, scr, lane);
  }
}


struct EpiIn {
  static constexpr bool PERM = true, AFTER_DRAIN = false;
  char* ws; float* out;
  __device__ __forceinline__ void operator()(const f32x4 (&acc)[2][2][4][2], const Unit& u, int wr, int wc, int fr, int fq) const {
    const int pn = u.pn;
    const int row0 = u.pm * 256 + wr * 64 + fr, cl0 = wc * 32 + 8 * fq;
    if (pn == 12) {
      bf16* dst = (bf16*)(ws + OFF_CKV);
      float* ssp = (float*)(ws + OFF_SSP);
#pragma unroll
      for (int ai = 0; ai < 2; ++ai)
#pragma unroll
        for (int m = 0; m < 4; ++m) {
          const size_t row = row0 + ai * 128 + m * 16;
          float ss = 0.f;
#pragma unroll
          for (int bj = 0; bj < 2; ++bj) {
            const f32x4 v0 = acc[ai][bj][m][0], v1 = acc[ai][bj][m][1];
            ss += (v0[0] * v0[0] + v0[1] * v0[1]) + (v0[2] * v0[2] + v0[3] * v0[3]) + (v1[0] * v1[0] + v1[1] * v1[1]) + (v1[2] * v1[2] + v1[3] * v1[3]);
            u32x4 w; w.x = cvt_pk_bf16(v0[0], v0[1]); w.y = cvt_pk_bf16(v0[2], v0[3]); w.z = cvt_pk_bf16(v1[0], v1[1]); w.w = cvt_pk_bf16(v1[2], v1[3]);
            *(u32x4*)(dst + row * 256 + cl0 + bj * 128) = w;
          }
          ss += __shfl_xor(ss, 16); ss += __shfl_xor(ss, 32);
          if (fq == 0) ssp[row * 4 + wc] = ss;
        }
    } else if (pn == 15) {
      bf16* IK = (bf16*)(ws + OFF_IK);
      float* IW = (float*)(ws + OFF_IW);
      float* GLOW = (float*)(ws + OFF_GLOW);
#pragma unroll
      for (int ai = 0; ai < 2; ++ai)
#pragma unroll
        for (int m = 0; m < 4; ++m) {
          const size_t row = row0 + ai * 128 + m * 16;
          const int cl = cl0;
          const f32x4 v0 = acc[ai][0][m][0], v1 = acc[ai][0][m][1];
          if (cl < 64) {
            u32x4 w; w.x = cvt_pk_bf16(v0[0], v0[1]); w.y = cvt_pk_bf16(v0[2], v0[3]); w.z = cvt_pk_bf16(v1[0], v1[1]); w.w = cvt_pk_bf16(v1[2], v1[3]);
            *(u32x4*)(IK + row * 64 + cl) = w;
          } else if (cl < 72) {
            *(f32x4*)(IW + row * 8) = v0 * 0.35355339059327373f;
            *(f32x4*)(IW + row * 8 + 4) = v1 * 0.35355339059327373f;
          } else if (cl < 88) {
            *(f32x4*)(GLOW + row * 16 + (cl - 72)) = v0;
            *(f32x4*)(GLOW + row * 16 + (cl - 72) + 4) = v1;
          }
        }
    } else {
      bf16* dst; int ld; float scale = 1.f; int act = 0; int coff;
      if (pn < 2) { dst = (bf16*)(ws + OFF_Q); ld = 512; coff = pn * 256; scale = 0.08838834764831845f; }
      else if (pn < 4) { dst = (bf16*)(ws + OFF_K); ld = 512; coff = (pn - 2) * 256; }
      else if (pn < 8) { dst = (bf16*)(ws + OFF_V); ld = 1024; coff = (pn - 4) * 256; }
      else if (pn < 12) { dst = (bf16*)(ws + OFF_DQ); ld = 1024; coff = (pn - 8) * 256; }
      else if (pn < 15) { dst = (bf16*)(ws + OFF_IQ); ld = 512; coff = (pn - 13) * 256; scale = 0.125f; }
      else if (pn < 20) { dst = (bf16*)(ws + OFF_SGR); ld = 1024; coff = (pn - 16) * 256; act = 1; }
      else if (pn < 24) { dst = (bf16*)out; ld = 1024; coff = (pn - 20) * 256; act = 2; }
      else { dst = (bf16*)out + (size_t)TT * 1024; ld = 1024; coff = (pn - 24) * 256; act = 2; }
#pragma unroll
      for (int ai = 0; ai < 2; ++ai)
#pragma unroll
        for (int m = 0; m < 4; ++m) {
          bf16* rowp = dst + (size_t)(row0 + ai * 128 + m * 16) * ld + coff + cl0;
#pragma unroll
          for (int bj = 0; bj < 2; ++bj) {
            f32x4 v0 = acc[ai][bj][m][0] * scale, v1 = acc[ai][bj][m][1] * scale;
            if (act == 1) {
#pragma unroll
              for (int j = 0; j < 4; ++j) { v0[j] = siluf_(v0[j]); v1[j] = siluf_(v1[j]); }
            } else if (act == 2) {
#pragma unroll
              for (int j = 0; j < 4; ++j) { v0[j] = sigmoidf_(v0[j]); v1[j] = sigmoidf_(v1[j]); }
            }
            u32x4 w; w.x = cvt_pk_bf16(v0[0], v0[1]); w.y = cvt_pk_bf16(v0[2], v0[3]); w.z = cvt_pk_bf16(v1[0], v1[1]); w.w = cvt_pk_bf16(v1[2], v1[3]);
            *(u32x4*)(rowp + bj * 128) = w;
          }
        }
    }
  }
};

template <bool ADD> struct EpiMix {
  static constexpr bool PERM = true, AFTER_DRAIN = false;
  const bf16* SZ; bf16* MIX;
  __device__ __forceinline__ void operator()(const f32x4 (&acc)[2][2][4][2], const Unit& u, int wr, int wc, int fr, int fq) const {
    const int row0 = u.pm * 256 + wr * 64 + fr, col0 = u.pn * 256 + wc * 32 + 8 * fq;
    u32x4 sc[2], oc[2], sn[2], on[2];
    {
      const size_t idx = (size_t)row0 * 1024 + col0;
      sc[0] = *(const u32x4*)(SZ + idx); sc[1] = *(const u32x4*)(SZ + idx + 128);
      if (ADD) { oc[0] = *(const u32x4*)(MIX + idx); oc[1] = *(const u32x4*)(MIX + idx + 128); }
    }
#pragma unroll
    for (int s = 0; s < 8; ++s) {
      const int ai = s >> 2, m = s & 3;
      const size_t idx = (size_t)(row0 + ai * 128 + m * 16) * 1024 + col0;
      if (s < 7) {
        const int ai2 = (s + 1) >> 2, m2 = (s + 1) & 3;
        const size_t idn = (size_t)(row0 + ai2 * 128 + m2 * 16) * 1024 + col0;
        sn[0] = *(const u32x4*)(SZ + idn); sn[1] = *(const u32x4*)(SZ + idn + 128);
        if (ADD) { on[0] = *(const u32x4*)(MIX + idn); on[1] = *(const u32x4*)(MIX + idn + 128); }
      }
#pragma unroll
      for (int bj = 0; bj < 2; ++bj) {
        const u32x4 sv = sc[bj];
        f32x4 v0 = acc[ai][bj][m][0], v1 = acc[ai][bj][m][1];
        v0[0] *= bflo(sv.x); v0[1] *= bfhi(sv.x); v0[2] *= bflo(sv.y); v0[3] *= bfhi(sv.y);
        v1[0] *= bflo(sv.z); v1[1] *= bfhi(sv.z); v1[2] *= bflo(sv.w); v1[3] *= bfhi(sv.w);
        if (ADD) {
          const u32x4 o = oc[bj];
          v0[0] += bflo(o.x); v0[1] += bfhi(o.x); v0[2] += bflo(o.y); v0[3] += bfhi(o.y);
          v1[0] += bflo(o.z); v1[1] += bfhi(o.z); v1[2] += bflo(o.w); v1[3] += bfhi(o.w);
        }
        u32x4 w; w.x = cvt_pk_bf16(v0[0], v0[1]); w.y = cvt_pk_bf16(v0[2], v0[3]); w.z = cvt_pk_bf16(v1[0], v1[1]); w.w = cvt_pk_bf16(v1[2], v1[3]);
        *(u32x4*)(MIX + idx + bj * 128) = w;
      }
      if (s < 7) { sc[0] = sn[0]; sc[1] = sn[1]; if (ADD) { oc[0] = on[0]; oc[1] = on[1]; } }
    }
  }
};

struct EpiX1 {
  static constexpr bool PERM = true, AFTER_DRAIN = false;
  const float* x; const float* ada; float* out;
  __device__ __forceinline__ void operator()(const f32x4 (&acc)[2][2][4][2], const Unit& u, int wr, int wc, int fr, int fq) const {
    const int row0 = u.pm * 256 + wr * 64 + fr, col0 = u.pn * 256 + wc * 32 + 8 * fq;
    const int b = (u.pm * 256) >> 12;
    f32x4 g[2][2];
#pragma unroll
    for (int bj = 0; bj < 2; ++bj) {
      g[bj][0] = *(const f32x4*)(ada + b * 6144 + 2048 + col0 + bj * 128);
      g[bj][1] = *(const f32x4*)(ada + b * 6144 + 2048 + col0 + bj * 128 + 4);
    }
    f32x4 xc[4], xn[4];
    {
      const size_t idx = (size_t)row0 * 1024 + col0;
      xc[0] = *(const f32x4*)(x + idx); xc[1] = *(const f32x4*)(x + idx + 4);
      xc[2] = *(const f32x4*)(x + idx + 128); xc[3] = *(const f32x4*)(x + idx + 132);
    }
#pragma unroll
    for (int s = 0; s < 8; ++s) {
      const int ai = s >> 2, m = s & 3;
      const size_t idx = (size_t)(row0 + ai * 128 + m * 16) * 1024 + col0;
      if (s < 7) {
        const int ai2 = (s + 1) >> 2, m2 = (s + 1) & 3;
        const size_t idn = (size_t)(row0 + ai2 * 128 + m2 * 16) * 1024 + col0;
        xn[0] = *(const f32x4*)(x + idn); xn[1] = *(const f32x4*)(x + idn + 4);
        xn[2] = *(const f32x4*)(x + idn + 128); xn[3] = *(const f32x4*)(x + idn + 132);
      }
#pragma unroll
      for (int bj = 0; bj < 2; ++bj) {
        *(f32x4*)(out + idx + bj * 128) = xc[2 * bj] + g[bj][0] * acc[ai][bj][m][0];
        *(f32x4*)(out + idx + bj * 128 + 4) = xc[2 * bj + 1] + g[bj][1] * acc[ai][bj][m][1];
      }
      if (s < 7) { xc[0] = xn[0]; xc[1] = xn[1]; xc[2] = xn[2]; xc[3] = xn[3]; }
    }
  }
};

struct EpiPlain {
  static constexpr bool PERM = true, AFTER_DRAIN = false;
  bf16* O; int ld;
  __device__ __forceinline__ void operator()(const f32x4 (&acc)[2][2][4][2], const Unit& u, int wr, int wc, int fr, int fq) const {
    const int row0 = u.pm * 256 + wr * 64 + fr, col0 = u.pn * 256 + wc * 32 + 8 * fq;
#pragma unroll
    for (int ai = 0; ai < 2; ++ai)
#pragma unroll
      for (int m = 0; m < 4; ++m)
#pragma unroll
        for (int bj = 0; bj < 2; ++bj) {
          const f32x4 v0 = acc[ai][bj][m][0], v1 = acc[ai][bj][m][1];
          u32x4 w; w.x = cvt_pk_bf16(v0[0], v0[1]); w.y = cvt_pk_bf16(v0[2], v0[3]); w.z = cvt_pk_bf16(v1[0], v1[1]); w.w = cvt_pk_bf16(v1[2], v1[3]);
          *(u32x4*)(O + (size_t)(row0 + ai * 128 + m * 16) * ld + col0 + bj * 128) = w;
        }
  }
};

template <class Epi>
__device__ __forceinline__ void gemm_run(LAS unsigned char* lds, const bf16* A, const bf16* Bt, int M, int N, int K, const Epi& E) {
  pg8::Gemm g{A, Bt, M, N, K};
  pg8::StaticOrder S;
  S.init(M, N, gridDim.x, blockIdx.x);
  pg8::gemm_phase<Epi, pg8::StaticOrder, false>(lds, g, S, E, nullptr);
}

typedef short bf16x8_t __attribute__((ext_vector_type(8)));
typedef __bf16 bf16x2_t __attribute__((ext_vector_type(2)));
__device__ __forceinline__ float dot2bf(unsigned a, unsigned b, float acc) {
  return __builtin_amdgcn_fdot2_f32_bf16(__builtin_bit_cast(bf16x2_t, a), __builtin_bit_cast(bf16x2_t, b), acc, false);
}
__device__ __forceinline__ void wave_lds_fence() { asm volatile("s_waitcnt lgkmcnt(0)" ::: "memory"); }
template <int N> __device__ __forceinline__ float row_ror(float x) {
  return __int_as_float(__builtin_amdgcn_update_dpp(0, __float_as_int(x), 0x120 + N, 0xf, 0xf, false));
}
__device__ __forceinline__ float row16_max(float m) {
  m = fmaxf(m, row_ror<8>(m)); m = fmaxf(m, row_ror<4>(m)); m = fmaxf(m, row_ror<2>(m)); m = fmaxf(m, row_ror<1>(m));
  return m;
}
__device__ __forceinline__ float row16_sum(float m) {
  m += row_ror<8>(m); m += row_ror<4>(m); m += row_ror<2>(m); m += row_ror<1>(m);
  return m;
}
__device__ __forceinline__ float wave_sum_dpp(float s) {
  s = row16_sum(s);
  const int si = __float_as_int(s);
  return __int_as_float(__builtin_amdgcn_readlane(si, 0)) + __int_as_float(__builtin_amdgcn_readlane(si, 16)) +
         (__int_as_float(__builtin_amdgcn_readlane(si, 32)) + __int_as_float(__builtin_amdgcn_readlane(si, 48)));
}
__device__ __forceinline__ constexpr int cand_i(int L) {
  return L < 16 ? 0 : L < 24 ? 1 : L < 29 ? 2 : L < 33 ? 3 : L < 36 ? 4 : L < 38 ? 5 : L < 40 ? 6 : L < 42 ? 7 : (L - 42 + 8);
}
__device__ __forceinline__ constexpr int cand_j(int L) {
  return L < 16 ? L : L < 24 ? L - 16 : L < 29 ? L - 24 : L < 33 ? L - 29 : L < 36 ? L - 33 : L < 38 ? L - 36 : L < 40 ? L - 38 : L < 42 ? L - 40 : 0;
}
template <int K> struct CandRank {
  static __device__ __forceinline__ void run(int ki, unsigned key, int& rank) {
    const unsigned o = (unsigned)__builtin_amdgcn_readlane(ki, K);
    rank += (o > key) ? 1 : 0;
    CandRank<K + 1>::run(ki, key, rank);
  }
};
template <> struct CandRank<50> { static __device__ __forceinline__ void run(int, unsigned, int&) {} };
__device__ __forceinline__ unsigned peer_f2ord(float f) {
  if (f == 0.f) f = 0.f;
  const unsigned u = __float_as_uint(f);
  return (u & 0x80000000u) ? ~u : (u | 0x80000000u);
}
__device__ __forceinline__ float peer_ord2f(unsigned u) { return __uint_as_float((u & 0x80000000u) ? (u ^ 0x80000000u) : ~u); }
__device__ __forceinline__ unsigned umax3(unsigned a, unsigned b, unsigned c) { const unsigned t = a > b ? a : b; return t > c ? t : c; }
template <int N> __device__ __forceinline__ unsigned row_ror_u(unsigned x) {
  return (unsigned)__builtin_amdgcn_update_dpp(0, (int)x, 0x120 + N, 0xf, 0xf, false);
}
__device__ __forceinline__ unsigned row16_umax(unsigned m) {
  unsigned t;
  t = row_ror_u<8>(m); m = t > m ? t : m; t = row_ror_u<4>(m); m = t > m ? t : m;
  t = row_ror_u<2>(m); m = t > m ? t : m; t = row_ror_u<1>(m); m = t > m ? t : m;
  return m;
}
__device__ __forceinline__ float gelu_exact(float v) { return 0.5f * v * (1.f + erff(v * 0.7071067811865476f)); }

typedef float f32x2_t __attribute__((ext_vector_type(2)));
typedef unsigned peer_u32x2 __attribute__((ext_vector_type(2)));
__device__ __forceinline__ float peer_fold32(float a, float b) {
  const peer_u32x2 r = __builtin_amdgcn_permlane32_swap(__float_as_uint(a), __float_as_uint(b), false, false);
  return __uint_as_float(r.x) + __uint_as_float(r.y);
}
__device__ __forceinline__ float peer_fold16(float a, float b) {
  const peer_u32x2 r = __builtin_amdgcn_permlane16_swap(__float_as_uint(a), __float_as_uint(b), false, false);
  return __uint_as_float(r.x) + __uint_as_float(r.y);
}
#define GAS __attribute__((address_space(1)))
#define PEER_NB 6
#define PEER_LOAD(buf, TAB, tk, e0)                                                               \
  {                                                                                               \
    const unsigned* rp_ = (const unsigned*)(ridx + ((tk) * 128 + (e0)));                          \
    const unsigned w0_ = rp_[0], w1_ = rp_[1], w2_ = rp_[2];                                      \
    const int i0_ = __builtin_amdgcn_readfirstlane((int)(w0_ & 0x3fffu)), i1_ = __builtin_amdgcn_readfirstlane((int)((w0_ >> 16) & 0x3fffu)); \
    const int i2_ = __builtin_amdgcn_readfirstlane((int)(w1_ & 0x3fffu)), i3_ = __builtin_amdgcn_readfirstlane((int)((w1_ >> 16) & 0x3fffu)); \
    const int i4_ = __builtin_amdgcn_readfirstlane((int)(w2_ & 0x3fffu)), i5_ = __builtin_amdgcn_readfirstlane((int)((w2_ >> 16) & 0x3fffu)); \
    buf[0] = *(const GAS u32x4_t*)((TAB) + (size_t)i0_ * 1024 + lane * 16);                       \
    buf[1] = *(const GAS u32x4_t*)((TAB) + (size_t)i1_ * 1024 + lane * 16);                       \
    buf[2] = *(const GAS u32x4_t*)((TAB) + (size_t)i2_ * 1024 + lane * 16);                       \
    buf[3] = *(const GAS u32x4_t*)((TAB) + (size_t)i3_ * 1024 + lane * 16);                       \
    buf[4] = *(const GAS u32x4_t*)((TAB) + (size_t)i4_ * 1024 + lane * 16);                       \
    buf[5] = *(const GAS u32x4_t*)((TAB) + (size_t)i5_ * 1024 + lane * 16);                       \
  }
#define PEER_UDOT(buf, e0)                                                                        \
  {                                                                                               \
    float sp[6];                                                                                  \
    _Pragma("unroll") for (int j = 0; j < 6; ++j) {                                               \
      float s0 = 0.f, s1 = 0.f;                                                                   \
      _Pragma("unroll") for (int w = 0; w < 4; ++w) {                                             \
        const f32x2_t lo = __builtin_amdgcn_cvt_pk_f32_fp8((int)buf[j][w], false);                \
        const f32x2_t hi = __builtin_amdgcn_cvt_pk_f32_fp8((int)buf[j][w], true);                 \
        s0 = __builtin_fmaf(lo.x, hf[4 * w], s0); s1 = __builtin_fmaf(lo.y, hf[4 * w + 1], s1);   \
        s0 = __builtin_fmaf(hi.x, hf[4 * w + 2], s0); s1 = __builtin_fmaf(hi.y, hf[4 * w + 3], s1); \
      }                                                                                           \
      sp[j] = s0 + s1;                                                                            \
    }                                                                                             \
    const float u01 = peer_fold32(sp[0], sp[1]), u23 = peer_fold32(sp[2], sp[3]), u45 = peer_fold32(sp[4], sp[5]); \
    const float wq = row16_sum(peer_fold16(u01, u23));     \
    const float wr = row16_sum(peer_fold16(u45, u45));         \
    const int wqi = __float_as_int(wq), wri = __float_as_int(wr);                                 \
    PEER_PUT((e0) + 0, __builtin_amdgcn_readlane(wqi, 0));                                        \
    PEER_PUT((e0) + 1, __builtin_amdgcn_readlane(wqi, 32));                                       \
    PEER_PUT((e0) + 2, __builtin_amdgcn_readlane(wqi, 16));                                       \
    PEER_PUT((e0) + 3, __builtin_amdgcn_readlane(wqi, 48));                                       \
    PEER_PUT((e0) + 4, __builtin_amdgcn_readlane(wri, 0));                                        \
    PEER_PUT((e0) + 5, __builtin_amdgcn_readlane(wri, 32));                                       \
  }
#define PEER_PUT(ee_, vi_)                                                                        \
  {                                                                                               \
    const int ee = (ee_); const float sv = __int_as_float(vi_);                                   \
    const bool mine = (lane == (ee & 63));                                                        \
    dotA = (mine && ee < 64) ? sv : dotA;                                                         \
    dotB = (mine && ee >= 64 && ee < 128) ? sv : dotB;                                            \
  }
#define PEER_VACC(buf, e0)                                                                        \
  _Pragma("unroll") for (int j = 0; j < PEER_NB; ++j) {                                                 \
    const int ee = (e0) + j;                                                                      \
    const float a = (ee < 128) ? __int_as_float(__builtin_amdgcn_readlane(__float_as_int(ee < 64 ? aA : aB), ee & 63)) : 0.f; \
    _Pragma("unroll") for (int w = 0; w < 4; ++w) {                                               \
      const f32x2_t lo = __builtin_amdgcn_cvt_pk_f32_fp8((int)buf[j][w], false);                  \
      const f32x2_t hi = __builtin_amdgcn_cvt_pk_f32_fp8((int)buf[j][w], true);                   \
      acc[4 * w] += a * lo.x; acc[4 * w + 1] += a * lo.y; acc[4 * w + 2] += a * hi.x; acc[4 * w + 3] += a * hi.y; \
    }                                                                                             \
    __builtin_amdgcn_sched_barrier(0);                                                           \
  }

#ifndef PROBE_PEER
#define PROBE_PEER 0
#endif
#if PROBE_PEER
#define PEER_MARK(k) do { const unsigned long long n_ = __builtin_amdgcn_s_memrealtime(); if (PROBE_PEER == (k)) { const unsigned long long q_ = n_ - pmark; \
    while (__builtin_amdgcn_s_memrealtime() - n_ < q_) __builtin_amdgcn_s_sleep(2); } pmark = __builtin_amdgcn_s_memrealtime(); } while (0)
#else
#define PEER_MARK(k) do {} while (0)
#endif
__device__ __forceinline__ void ph_peer512(const P& p, unsigned char* lds_raw, float* dst_base) {
  const int tid = tid_fresh(), wave = tid >> 6, lane = tid & 63, g = lane >> 4, c = lane & 15;
  const bf16* PQ = (const bf16*)(p.ws + OFF_PQ);
  const bf16* SK = (const bf16*)(p.ws + OFF_SK);
  float* tv = (float*)(lds_raw + wave * 16384);
  int* ti = (int*)(tv + 512);
  float* rgate = (float*)(ti + 512);
  unsigned short* ridx = (unsigned short*)(rgate + 2048);
  for (int tile = blockIdx.x * 8 + wave; tile < TT / 16; tile += gridDim.x * 8) {
    const int tok0 = tile * 16;
#if PROBE_PEER
    unsigned long long pmark = __builtin_amdgcn_s_memrealtime();
#endif
    unsigned* tk = (unsigned*)tv;
#pragma unroll 1
    for (int hp = 0; hp < 4; ++hp) {
#pragma unroll 1
      for (int hf = 0; hf < 2; ++hf) {
        bf16x8_t bfr[4][8];
#pragma unroll
        for (int ks = 0; ks < 4; ++ks)
#pragma unroll
          for (int nt = 0; nt < 8; ++nt) bfr[ks][nt] = *(const bf16x8_t*)(SK + hf * 16384 + (nt * 16 + c) * 128 + ks * 32 + 8 * g);
#pragma unroll 1
        for (int h2 = 0; h2 < 2; ++h2) {
          const int hd = 2 * hp + h2;
          f32x4 acc[8];
#pragma unroll
          for (int nt = 0; nt < 8; ++nt) acc[nt] = (f32x4){0.f, 0.f, 0.f, 0.f};
#pragma unroll
          for (int ks = 0; ks < 4; ++ks) {
            const bf16x8_t a = *(const bf16x8_t*)(PQ + (size_t)(tok0 + c) * 2048 + hd * 256 + hf * 128 + ks * 32 + 8 * g);
#pragma unroll
            for (int nt = 0; nt < 8; ++nt) acc[nt] = __builtin_amdgcn_mfma_f32_16x16x32_bf16(a, bfr[ks][nt], acc[nt], 0, 0, 0);
          }
          asm volatile("" :: "v"(acc[0][0]), "v"(acc[7][3]));
          PEER_MARK(1);
          unsigned kq[4][8], res[4];
#pragma unroll
          for (int i = 0; i < 4; ++i) {
            res[i] = 0u;
#pragma unroll
            for (int nt = 0; nt < 8; ++nt) kq[i][nt] = (peer_f2ord(acc[nt][i]) & ~127u) | (unsigned)(127 - (16 * nt + c));
          }
#pragma unroll 1
          for (int r = 0; r < 16; ++r) {
#pragma unroll
            for (int i = 0; i < 4; ++i) {
              unsigned m = umax3(umax3(kq[i][0], kq[i][1], kq[i][2]), umax3(kq[i][3], kq[i][4], kq[i][5]), (kq[i][6] > kq[i][7]) ? kq[i][6] : kq[i][7]);
              m = row16_umax(m);
#pragma unroll
              for (int nt = 0; nt < 8; ++nt) kq[i][nt] = (kq[i][nt] == m) ? 0u : kq[i][nt];
              res[i] = (c == r) ? m : res[i];
            }
          }
#pragma unroll
          for (int i = 0; i < 4; ++i) tk[((h2 * 2 + hf) * 16 + 4 * g + i) * 16 + c] = res[i];
        }
      }
      wave_lds_fence();
      PEER_MARK(2);
      const int ci = cand_i(lane < 50 ? lane : 0), cj = cand_j(lane < 50 ? lane : 0);
#pragma unroll 1
      for (int hr = 0; hr < 32; ++hr) {
        const int h2 = hr >> 4, row = hr & 15, hd = 2 * hp + h2;
        const unsigned k1 = tk[((h2 * 2 + 0) * 16 + row) * 16 + ci], k2 = tk[((h2 * 2 + 1) * 16 + row) * 16 + cj];
        const float val = peer_ord2f(k1 & ~127u) + peer_ord2f(k2 & ~127u);
        const unsigned key = (lane < 50) ? ((peer_f2ord(val) & ~63u) | (unsigned)(63 - lane)) : 0u;
        int rank = 0;
        CandRank<0>::run((int)key, key, rank);
        if (lane < 50 && rank < 16) {
          rgate[row * 128 + hd * 16 + rank] = val;
          ridx[row * 128 + hd * 16 + rank] = (unsigned short)((127 - (int)(k1 & 127u)) * 128 + (127 - (int)(k2 & 127u)));
        }
      }
      wave_lds_fence();
      PEER_MARK(3);
#pragma unroll
      for (int h2 = 0; h2 < 2; ++h2) {
        const int hd = 2 * hp + h2;
        const int row = lane >> 2, q = lane & 3;
        float* gp = rgate + row * 128 + hd * 16;
        const float mx = gp[0];
        const f32x4 b4 = *(const f32x4*)(gp + q * 4);
        f32x4 e4;
        e4[0] = __expf(b4[0] - mx); e4[1] = __expf(b4[1] - mx); e4[2] = __expf(b4[2] - mx); e4[3] = __expf(b4[3] - mx);
        float s = (e4[0] + e4[1]) + (e4[2] + e4[3]);
        s += __shfl_xor(s, 1); s += __shfl_xor(s, 2);
        const float inv = 1.f / s;
        wave_lds_fence();
        *(f32x4*)(gp + q * 4) = e4 * inv;
      }
      wave_lds_fence();
    }
    char* wsl = p.ws;
    asm volatile("" : "+s"(wsl));
    const GAS bf16* H2 = (const GAS bf16*)(wsl + OFF_H);
    const GAS unsigned char* PU = (const GAS unsigned char*)(wsl + OFF_PU);
    const GAS unsigned char* PV = (const GAS unsigned char*)(wsl + OFF_PV);
    const GAS float* USC = (const GAS float*)(wsl + OFF_PSC);
    const GAS float* VSC = USC + 16384;
    const GAS float* ada = (const GAS float*)(wsl + OFF_ADA);
    u32x4_t a0[PEER_NB], a1[PEER_NB], hn0, hn1;
#define PSB() __builtin_amdgcn_sched_barrier(0)
#define PEER_ROWS (((128 + 2 * PEER_NB - 1) / (2 * PEER_NB)) * 2 * PEER_NB)
    {
      const int tidx = tid_fresh(), lane = tidx & 63, wv = __builtin_amdgcn_readfirstlane(tidx >> 6);
      const unsigned short* ridx = (const unsigned short*)(lds_raw + wv * 16384 + 4096 + 8192);
      hn0 = *(const GAS u32x4_t*)(H2 + (size_t)tok0 * 1024 + lane * 16); hn1 = *(const GAS u32x4_t*)(H2 + (size_t)tok0 * 1024 + lane * 16 + 8);
      PEER_LOAD(a0, PU, 0, 0); PSB();
      PEER_LOAD(a1, PU, 0, PEER_NB); PSB();
    }
#pragma unroll 1
    for (int tt = 0; tt < 16; ++tt) {
      const int tidx = tid_fresh(), lane = tidx & 63, wv = __builtin_amdgcn_readfirstlane(tidx >> 6);
      const float* rgate = (const float*)(lds_raw + wv * 16384 + 4096);
      const unsigned short* ridx = (const unsigned short*)(lds_raw + wv * 16384 + 4096 + 8192);
      const size_t tok = (size_t)tok0 + tt;
      const int ttn = (tt < 15) ? tt + 1 : tt;
      float hf[16];
#pragma unroll
      for (int w = 0; w < 4; ++w) { hf[2 * w] = bflo(hn0[w]); hf[2 * w + 1] = bfhi(hn0[w]); hf[8 + 2 * w] = bflo(hn1[w]); hf[8 + 2 * w + 1] = bfhi(hn1[w]); }
      const int eA = (int)ridx[tt * 128 + lane], eB = (int)ridx[tt * 128 + 64 + lane];
      const float usA = USC[eA], usB = USC[eB];
      float dotA = 0.f, dotB = 0.f;
#pragma unroll 1
      for (int e0 = 0; e0 < PEER_ROWS; e0 += 2 * PEER_NB) {
        const bool more = e0 + 2 * PEER_NB < PEER_ROWS;
        const GAS unsigned char* tb = more ? PU : PV;
        const int r0 = more ? e0 + 2 * PEER_NB : 0;
        PEER_UDOT(a0, e0); PSB();
        PEER_LOAD(a0, tb, tt, r0); PSB();
        PEER_UDOT(a1, e0 + PEER_NB); PSB();
        PEER_LOAD(a1, tb, tt, r0 + PEER_NB); PSB();
      }
      const float aA = gelu_exact(dotA * usA) * rgate[tt * 128 + lane] * VSC[(int)ridx[tt * 128 + lane]],
                  aB = gelu_exact(dotB * usB) * rgate[tt * 128 + 64 + lane] * VSC[(int)ridx[tt * 128 + 64 + lane]];
      float acc[16];
#pragma unroll
      for (int k = 0; k < 16; ++k) acc[k] = 0.f;
      hn0 = *(const GAS u32x4_t*)(H2 + ((size_t)tok0 + ttn) * 1024 + lane * 16); hn1 = *(const GAS u32x4_t*)(H2 + ((size_t)tok0 + ttn) * 1024 + lane * 16 + 8);
      PSB();
#pragma unroll 1
      for (int e0 = 0; e0 < PEER_ROWS; e0 += 2 * PEER_NB) {
        const bool more = e0 + 2 * PEER_NB < PEER_ROWS;
        const GAS unsigned char* tb = more ? PV : PU;
        const int r0 = more ? e0 + 2 * PEER_NB : 0, tkk = more ? tt : ttn;
        PEER_VACC(a0, e0); PSB();
        PEER_LOAD(a0, tb, tkk, r0); PSB();
        PEER_VACC(a1, e0 + PEER_NB); PSB();
        PEER_LOAD(a1, tb, tkk, r0 + PEER_NB); PSB();
      }
      const int b = (int)(tok >> 12);
      const GAS float* xrow = (const GAS float*)p.out + tok * 1024;
      GAS float* orow = (GAS float*)dst_base + tok * 1024;
      const GAS float* g2 = ada + b * 6144 + 5120;
      float x2[16];
      float ss = 0.f;
#pragma unroll
      for (int q = 0; q < 4; ++q) {
        const int col = lane * 16 + q * 4;
        const f32x4 xv = *(const GAS f32x4*)(xrow + col), gv = *(const GAS f32x4*)(g2 + col);
#pragma unroll
        for (int k = 0; k < 4; ++k) { const float t = xv[k] + gv[k] * acc[q * 4 + k]; x2[q * 4 + k] = t; ss += t * t; }
      }
      ss = wave_sum_dpp(ss);
      const float rstd = rsqrtf(ss * (1.f / 1024.f) + 1e-6f);
#pragma unroll
      for (int q = 0; q < 4; ++q) {
        const int col = lane * 16 + q * 4;
        const f32x4 fg = *(const GAS f32x4*)((const GAS float*)(wsl + OFF_PRM) + PRM_FG + col);
        f32x4 o;
#pragma unroll
        for (int k = 0; k < 4; ++k) o[k] = x2[q * 4 + k] * rstd * fg[k];
        *(GAS f32x4*)(orow + col) = o;
      }
    }
    wave_lds_fence();
  }
}

#define DS_KEY16   0
#define DS_CHUNK   17408
#define DS_SEL     139264
#define DS_WAVE    147456
#define DS_TOTAL   155648
#define DS_RS      544

__device__ __forceinline__ unsigned f2ord(float f) {
  if (f == 0.f) f = 0.f;
  unsigned u = __float_as_uint(f);
  return (u & 0x80000000u) ? ~u : (u | 0x80000000u);
}
__device__ __forceinline__ int wave_scan_incl(int v, int lane) {
#pragma unroll
  for (int o = 1; o < 64; o <<= 1) { const int t = __shfl_up(v, o); v += (lane >= o) ? t : 0; }
  return v;
}
__device__ __forceinline__ void find_digit(const LAS unsigned* hist, int K, int lane, int& digit, int& above) {
  const u32x4_t h4 = *(const LAS u32x4_t*)(hist + 252 - 4 * lane);
  const int c0 = (int)h4.w, c1 = (int)h4.z, c2 = (int)h4.y, c3 = (int)h4.x;
  const int tot = c0 + c1 + c2 + c3;
  int run = wave_scan_incl(tot, lane) - tot;
  int found = -1, ab = 0;
  if (run < K && run + c0 >= K) { found = 255 - 4 * lane; ab = run; } run += c0;
  if (run < K && run + c1 >= K) { found = 254 - 4 * lane; ab = run; } run += c1;
  if (run < K && run + c2 >= K) { found = 253 - 4 * lane; ab = run; } run += c2;
  if (run < K && run + c3 >= K) { found = 252 - 4 * lane; ab = run; }
  const unsigned long long mk = __ballot(found >= 0);
  const int src = (int)__ffsll((unsigned long long)mk) - 1;
  digit = __builtin_amdgcn_readlane(found, src);
  above = __builtin_amdgcn_readlane(ab, src);
}

typedef unsigned u32x2_t __attribute__((ext_vector_type(2)));
__device__ __forceinline__ float xrow_max(float x) {
  u32x2_t r = __builtin_amdgcn_permlane16_swap(__float_as_uint(x), __float_as_uint(x), false, false);
  x = fmaxf(__uint_as_float(r.x), __uint_as_float(r.y));
  r = __builtin_amdgcn_permlane32_swap(__float_as_uint(x), __float_as_uint(x), false, false);
  return fmaxf(__uint_as_float(r.x), __uint_as_float(r.y));
}
__device__ __forceinline__ float xrow_sum(float x) {
  u32x2_t r = __builtin_amdgcn_permlane16_swap(__float_as_uint(x), __float_as_uint(x), false, false);
  x = __uint_as_float(r.x) + __uint_as_float(r.y);
  r = __builtin_amdgcn_permlane32_swap(__float_as_uint(x), __float_as_uint(x), false, false);
  return __uint_as_float(r.x) + __uint_as_float(r.y);
}
__device__ __forceinline__ s16x4_t tr_read_b64(unsigned addr) {
  s16x4_t r; asm volatile("ds_read_b64_tr_b16 %0, %1" : "=&v"(r) : "v"(addr) : "memory"); return r;
}

#ifndef PROBE_DSA
#define PROBE_DSA 0
#endif
#if PROBE_DSA
#define DSA_MARK(k) do { const unsigned long long n_ = __builtin_amdgcn_s_memrealtime(); if (PROBE_DSA == (k)) { const unsigned long long q_ = n_ - tmark; \
    while (__builtin_amdgcn_s_memrealtime() - n_ < q_) __builtin_amdgcn_s_sleep(2); } tmark = __builtin_amdgcn_s_memrealtime(); } while (0)
#else
#define DSA_MARK(k) do {} while (0)
#endif
#if PROBE_DSA >= 10
#define DSA_MARKI(k) DSA_MARK(k)
#else
#define DSA_MARKI(k) do {} while (0)
#endif
__device__ __forceinline__ void dsa_batch(const P& p, unsigned char* lds_raw, int b, int pos2) {
  const int t00 = pos2 * 32;
#define DSA_IDS const int tid = tid_fresh(), wave = __builtin_amdgcn_readfirstlane(tid >> 6), lane = tid & 63, g = lane >> 4, c = lane & 15; (void)wave; (void)g; (void)c;
  const size_t tokb = (size_t)b * SEQ, tok00 = tokb + t00;
  const bf16* DQ = (const bf16*)(p.ws + OFF_DQ);
  const bf16* CKV = (const bf16*)(p.ws + OFF_CKV);
  const float* SSP = (const float*)(p.ws + OFF_SSP);
  const bf16* IQ = (const bf16*)(p.ws + OFF_IQ);
  const bf16* IK = (const bf16*)(p.ws + OFF_IK);
  const float* IW = (const float*)(p.ws + OFF_IW);
  const bf16* WUK = (const bf16*)(p.ws + OFF_WUK);
  const bf16* WUV = (const bf16*)(p.ws + OFF_WUV);
  bf16* ODSA = (bf16*)(p.ws + OFF_ODSA);
  bf16* QL = (bf16*)(p.ws + OFF_DSCR + (size_t)blockIdx.x * 131072);
  bf16* OL = QL;
  LAS unsigned char* lds = (LAS unsigned char*)lds_raw;
  LAS unsigned short* key16 = (LAS unsigned short*)(lds + DS_KEY16);
  LAS unsigned short* sel = (LAS unsigned short*)(lds + DS_SEL);

#if PROBE_DSA
  unsigned long long tmark = __builtin_amdgcn_s_memrealtime();
#endif
  {
    DSA_IDS
    const int h = wave;
    bf16x8_t dq0[4], dq1[4];
#pragma unroll
    for (int ks = 0; ks < 4; ++ks) {
      dq0[ks] = *(const bf16x8_t*)(DQ + (tok00 + c) * 1024 + h * 128 + ks * 32 + 8 * g);
      dq1[ks] = *(const bf16x8_t*)(DQ + (tok00 + 16 + c) * 1024 + h * 128 + ks * 32 + 8 * g);
    }
#pragma unroll 1
    for (int hn = 0; hn < 2; ++hn) {
      bf16x8_t wf[8][4];
#pragma unroll
      for (int n8 = 0; n8 < 8; ++n8)
#pragma unroll
        for (int ks = 0; ks < 4; ++ks) wf[n8][ks] = *(const bf16x8_t*)(WUK + (size_t)((h * 16 + hn * 8 + n8) * 4 + ks) * 512 + lane * 8);
      __builtin_amdgcn_sched_barrier(0);
#pragma unroll
      for (int n8 = 0; n8 < 8; ++n8) {
        const int nt = hn * 8 + n8;
        f32x4 a0 = (f32x4){0.f, 0.f, 0.f, 0.f}, a1 = a0;
#pragma unroll
        for (int ks = 0; ks < 4; ++ks) {
          a0 = __builtin_amdgcn_mfma_f32_16x16x32_bf16(wf[n8][ks], dq0[ks], a0, 0, 0, 0);
          a1 = __builtin_amdgcn_mfma_f32_16x16x32_bf16(wf[n8][ks], dq1[ks], a1, 0, 0, 0);
        }
        uint2 o; o.x = pk2(a0[0], a0[1]); o.y = pk2(a0[2], a0[3]);
        *(uint2*)(QL + c * 2048 + h * 256 + nt * 16 + 4 * g) = o;
        o.x = pk2(a1[0], a1[1]); o.y = pk2(a1[2], a1[3]);
        *(uint2*)(QL + (16 + c) * 2048 + h * 256 + nt * 16 + 4 * g) = o;
      }
      __builtin_amdgcn_sched_barrier(0);
    }
  }
  DSA_MARK(1);
#pragma unroll 1
  for (int half = 0; half < 2; ++half) {
  const int t0 = t00 + 16 * half;
  const size_t tok0 = tokb + t0;
  bf16* QLh = QL + half * 16 * 2048;
  bf16* OLh = QLh;
  if (t0 >= 256) {
    DSA_IDS
    bf16x8_t qf[8][2];
    float iw[8];
#pragma unroll
    for (int h = 0; h < 8; ++h) {
      qf[h][0] = *(const bf16x8_t*)(IQ + (tok0 + c) * 512 + h * 64 + 8 * g);
      qf[h][1] = *(const bf16x8_t*)(IQ + (tok0 + c) * 512 + h * 64 + 32 + 8 * g);
      iw[h] = IW[(tok0 + c) * 8 + h];
    }
    const int ntile = (t0 >> 4) + 1;
    bf16x8_t k0n = (bf16x8_t){0, 0, 0, 0, 0, 0, 0, 0}, k1n = k0n;
    if (wave < ntile) { const bf16* kr = IK + (tokb + wave * 16 + c) * 64 + 8 * g; k0n = *(const bf16x8_t*)kr; k1n = *(const bf16x8_t*)(kr + 32); }
    for (int kt = wave; kt < ntile; kt += 8) {
      const bf16x8_t k0 = k0n, k1 = k1n;
      { const int ktn = (kt + 8 < ntile) ? kt + 8 : kt; const bf16* kr = IK + (tokb + ktn * 16 + c) * 64 + 8 * g; k0n = *(const bf16x8_t*)kr; k1n = *(const bf16x8_t*)(kr + 32); }
      f32x4 sc = (f32x4){0.f, 0.f, 0.f, 0.f};
#pragma unroll
      for (int h = 0; h < 8; ++h) {
        f32x4 d = __builtin_amdgcn_mfma_f32_16x16x32_bf16(k0, qf[h][0], (f32x4){0.f, 0.f, 0.f, 0.f}, 0, 0, 0);
        d = __builtin_amdgcn_mfma_f32_16x16x32_bf16(k1, qf[h][1], d, 0, 0, 0);
#pragma unroll
        for (int i = 0; i < 4; ++i) sc[i] += iw[h] * fmaxf(d[i], 0.f);
      }
      u16x4_t o;
      const int sb = kt * 16 + 4 * g, tq = t0 + c;
      o.x = (sb + 0 <= tq) ? (unsigned short)(f2ord(sc[0]) >> 16) : (unsigned short)0;
      o.y = (sb + 1 <= tq) ? (unsigned short)(f2ord(sc[1]) >> 16) : (unsigned short)0;
      o.z = (sb + 2 <= tq) ? (unsigned short)(f2ord(sc[2]) >> 16) : (unsigned short)0;
      o.w = (sb + 3 <= tq) ? (unsigned short)(f2ord(sc[3]) >> 16) : (unsigned short)0;
      *(LAS u16x4_t*)(key16 + c * 4096 + sb) = o;
    }
  }
  DSA_MARK(2);
  __syncthreads();
#pragma unroll 1
  for (int qq = 0; qq < 2; ++qq) {
    DSA_IDS
    const int q = wave + 8 * qq, t = t0 + q;
    LAS unsigned short* selq = sel + q * 256;
    if (t < 256) {
      for (int j = lane; j < 256; j += 64) selq[j] = (unsigned short)((j <= t) ? j : 0);
    } else {
      const LAS unsigned short* kq = key16 + q * 4096;
      const int nit = (t >> 9) + 1;
      unsigned kp[8][4];
#pragma unroll
      for (int it = 0; it < 8; ++it) {
        const int s0 = 512 * it + 8 * lane;
        u32x4_t v = (u32x4_t){0u, 0u, 0u, 0u};
        if (s0 <= t) v = *(const LAS u32x4_t*)(kq + s0);
#pragma unroll
        for (int j = 0; j < 4; ++j) {
          const unsigned lo = (s0 + 2 * j <= t) ? (v[j] & 0xffffu) : 0u, hi = (s0 + 2 * j + 1 <= t) ? (v[j] & 0xffff0000u) : 0u;
          kp[it][j] = lo | hi;
        }
      }
      asm volatile("" :: "v"(kp[0][0]), "v"(kp[7][3]));
      DSA_MARKI(21);
      unsigned B = 0u;
#pragma unroll 1
      for (int bit = 15; bit >= 0; --bit) {
        const unsigned cand = B | (1u << bit);
        const unsigned c2 = (cand - 1u) * 0x00010001u;
        unsigned cnt2 = 0u;
#pragma unroll
        for (int it = 0; it < 8; ++it) {
          if (it < nit) {
#pragma unroll
            for (int j = 0; j < 4; ++j) {
              unsigned dd;
              asm("v_pk_sub_u16 %0, %1, %2 clamp\n\tv_pk_min_u16 %0, %0, %3" : "=&v"(dd) : "v"(kp[it][j]), "v"(c2), "v"(0x00010001u));
              cnt2 += dd;
            }
          }
        }
        const int tot = (int)wave_sum_dpp((float)((cnt2 & 0xffffu) + (cnt2 >> 16)));
        if (tot >= 256) B = cand;
      }
      int cgt = 0;
#pragma unroll
      for (int it = 0; it < 8; ++it)
#pragma unroll
        for (int j = 0; j < 4; ++j) cgt += (((kp[it][j] & 0xffffu) > B) ? 1 : 0) + (((kp[it][j] >> 16) > B) ? 1 : 0);
      const int m = 256 - (int)wave_sum_dpp((float)cgt);
      DSA_MARKI(22);
      int base = 0, eqbase = 0;
#pragma unroll
      for (int it = 0; it < 8; ++it) {
        if (it < nit) {
          unsigned kk[8];
#pragma unroll
          for (int j = 0; j < 4; ++j) { kk[2 * j] = kp[it][j] & 0xffffu; kk[2 * j + 1] = kp[it][j] >> 16; }
          unsigned anyeq = 0u;
#pragma unroll
          for (int j = 0; j < 8; ++j) anyeq |= (kk[j] == B) ? 1u : 0u;
          int eqlow = 0, eqtot = 0;
          if (__builtin_amdgcn_ballot_w64(anyeq != 0u) != 0ull) {
#pragma unroll
            for (int j = 0; j < 8; ++j) {
              const unsigned long long mk = __builtin_amdgcn_ballot_w64(kk[j] == B);
              eqlow += (int)__builtin_amdgcn_mbcnt_hi((unsigned)(mk >> 32), __builtin_amdgcn_mbcnt_lo((unsigned)mk, 0u));
              eqtot += __builtin_popcountll(mk);
            }
          }
          int eqr = eqbase + eqlow;
          int ps = base, tot = 0;
          bool tk[8];
#pragma unroll
          for (int j = 0; j < 8; ++j) {
            const bool eq = kk[j] == B;
            tk[j] = (kk[j] > B) || (eq && eqr < m);
            eqr += eq ? 1 : 0;
          }
#pragma unroll
          for (int j = 0; j < 8; ++j) {
            const unsigned long long mk = __builtin_amdgcn_ballot_w64(tk[j]);
            ps += (int)__builtin_amdgcn_mbcnt_hi((unsigned)(mk >> 32), __builtin_amdgcn_mbcnt_lo((unsigned)mk, 0u));
            tot += __builtin_popcountll(mk);
          }
#pragma unroll
          for (int j = 0; j < 8; ++j) {
            if (tk[j]) { if (ps < 256) selq[ps] = (unsigned short)(512 * it + 8 * lane + j); ++ps; }
          }
          base += tot;
          eqbase += eqtot;
        }
      }
    }
  }
  DSA_MARK(3);
  __syncthreads();
  {
    DSA_IDS
    const int wave_b = wave;
    const float slope = (c < 8) ? exp2f(-(float)(c + 1)) : 0.f;
#pragma unroll 1
    for (int qq = 0; qq < 2; ++qq) {
      const int q = wave + 8 * qq, t = t0 + q;
      const int nsel = (t + 1 < 256) ? (t + 1) : 256, nch = (nsel + 31) >> 5;
      const LAS unsigned short* selq = sel + q * 256;
      bf16x8_t qf[8];
      {
        const int lq = tid_fresh() & 63;
        const bf16* qlp = QLh + q * 2048 + (lq & 7) * 256 + 8 * (lq >> 4);
#pragma unroll
        for (int ks = 0; ks < 8; ++ks) qf[ks] = *(const bf16x8_t*)(qlp + ks * 32);
      }
      float mrun = -1e30f, lrun = 0.f;
      f32x4 o[16];
#pragma unroll
      for (int nt = 0; nt < 16; ++nt) o[nt] = (f32x4){0.f, 0.f, 0.f, 0.f};
      u32x4_t st[16];
      f32x4 st_ss = (f32x4){0.f, 0.f, 0.f, 0.f}; float st_d = -1.f;
#define DSA_ISSUE(ch)                                                                                   \
      {          \
        _Pragma("unroll") for (int r = 0; r < 16; ++r) {                                                \
          const int idx = (int)selq[(ch) * 32 + 2 * r + (lane >> 5)];                                   \
          st[r] = *(const u32x4_t*)(CKV + (tokb + idx) * 256 + (lane & 31) * 8);                        \
        }                                                                                               \
        const int j2 = (ch) * 32 + (lane & 31);                                                         \
        const int idx2 = (int)selq[j2];                                                                 \
        st_ss = *(const f32x4*)(SSP + (tokb + idx2) * 4);                                               \
        st_d = (j2 < nsel) ? (float)(t - idx2) : -1.f;                                                  \
      }
      DSA_ISSUE(0);
#pragma unroll 1
      for (int ch = 0; ch < nch; ++ch) {
        const int lane = tid_fresh() & 63, g = lane >> 4, c = lane & 15;
        LAS unsigned char* buf = lds + DS_KEY16 + wave_b * DS_CHUNK;
        LAS float* kr = (LAS float*)(lds + DS_WAVE + wave_b * 1024);
        LAS float* kd = kr + 32;
        const unsigned vb = (unsigned)(uintptr_t)buf + (unsigned)((4 * g + (c >> 2)) * DS_RS + 8 * (c & 3));
#pragma unroll
        for (int r = 0; r < 16; ++r) *(LAS u32x4_t*)(buf + (2 * r + (lane >> 5)) * DS_RS + (lane & 31) * 16) = st[r];
        if (lane < 32) { kr[lane] = rsqrtf(((st_ss[0] + st_ss[1]) + (st_ss[2] + st_ss[3])) * (1.f / 256.f) + 1e-6f); kd[lane] = st_d; }
        wave_lds_fence();
        DSA_MARKI(11);
        DSA_ISSUE((ch + 1 < nch) ? ch + 1 : ch);
        f32x4 s0 = (f32x4){0.f, 0.f, 0.f, 0.f}, s1 = (f32x4){0.f, 0.f, 0.f, 0.f};
#pragma unroll
        for (int ks = 0; ks < 8; ++ks) {
          const bf16x8_t a0 = *(const LAS bf16x8_t*)(buf + c * DS_RS + (ks * 32 + 8 * g) * 2);
          const bf16x8_t a1 = *(const LAS bf16x8_t*)(buf + (16 + c) * DS_RS + (ks * 32 + 8 * g) * 2);
          s0 = __builtin_amdgcn_mfma_f32_16x16x32_bf16(a0, qf[ks], s0, 0, 0, 0);
          s1 = __builtin_amdgcn_mfma_f32_16x16x32_bf16(a1, qf[ks], s1, 0, 0, 0);
        }
        asm volatile("" :: "v"(s0[0]), "v"(s1[0]));
        DSA_MARKI(12);
        const f32x4 r0 = *(const LAS f32x4*)(kr + 4 * g), r1 = *(const LAS f32x4*)(kr + 16 + 4 * g);
        const f32x4 d0 = *(const LAS f32x4*)(kd + 4 * g), d1 = *(const LAS f32x4*)(kd + 16 + 4 * g);
        float x[8];
#pragma unroll
        for (int i = 0; i < 4; ++i) {
          x[i] = (d0[i] < 0.f) ? -1e30f : (s0[i] * r0[i] - slope * d0[i]);
          x[4 + i] = (d1[i] < 0.f) ? -1e30f : (s1[i] * r1[i] - slope * d1[i]);
        }
        float mx = fmaxf(fmaxf(fmaxf(x[0], x[1]), fmaxf(x[2], x[3])), fmaxf(fmaxf(x[4], x[5]), fmaxf(x[6], x[7])));
        mx = xrow_max(mx);
        const float mn = fmaxf(mrun, mx);
        const float alpha = __expf(mrun - mn);
        mrun = mn;
        float pr[8], ps = 0.f;
#pragma unroll
        for (int i = 0; i < 8; ++i) { pr[i] = (x[i] <= -1e29f) ? 0.f : __expf(x[i] - mn); ps += pr[i]; }
        ps = xrow_sum(ps);
        lrun = lrun * alpha + ps;
        if (__builtin_amdgcn_ballot_w64(alpha != 1.f) != 0ull) {
#pragma unroll
          for (int nt = 0; nt < 16; ++nt) o[nt] *= alpha;
        }
        union { bf16x8_t v; unsigned u[4]; } pf;
        pf.u[0] = pk2(pr[0] * r0[0], pr[1] * r0[1]); pf.u[1] = pk2(pr[2] * r0[2], pr[3] * r0[3]);
        pf.u[2] = pk2(pr[4] * r1[0], pr[5] * r1[1]); pf.u[3] = pk2(pr[6] * r1[2], pr[7] * r1[3]);
        asm volatile("" :: "v"(pf.u[0]));
        DSA_MARKI(13);
        {
          s16x4_t loA[4], hiA[4], loB[4], hiB[4];
#define PV_READ(L, H, nt0) _Pragma("unroll") for (int u = 0; u < 4; ++u) { L[u] = tr_read_b64(vb + ((nt0) + u) * 32); H[u] = tr_read_b64(vb + ((nt0) + u) * 32 + 16 * DS_RS); }
#define PV_MMA(L, H, nt0) _Pragma("unroll") for (int u = 0; u < 4; ++u) { \
            const bf16x8_t af = (bf16x8_t){L[u][0], L[u][1], L[u][2], L[u][3], H[u][0], H[u][1], H[u][2], H[u][3]}; \
            o[(nt0) + u] = __builtin_amdgcn_mfma_f32_16x16x32_bf16(af, pf.v, o[(nt0) + u], 0, 0, 0); }
          PV_READ(loA, hiA, 0);
          PV_READ(loB, hiB, 4);
          asm volatile("s_waitcnt lgkmcnt(8)" ::: "memory"); __builtin_amdgcn_sched_barrier(0);
          PV_MMA(loA, hiA, 0); __builtin_amdgcn_sched_barrier(0);
          PV_READ(loA, hiA, 8);
          asm volatile("s_waitcnt lgkmcnt(8)" ::: "memory"); __builtin_amdgcn_sched_barrier(0);
          PV_MMA(loB, hiB, 4); __builtin_amdgcn_sched_barrier(0);
          PV_READ(loB, hiB, 12);
          asm volatile("s_waitcnt lgkmcnt(8)" ::: "memory"); __builtin_amdgcn_sched_barrier(0);
          PV_MMA(loA, hiA, 8); __builtin_amdgcn_sched_barrier(0);
          asm volatile("s_waitcnt lgkmcnt(0)" ::: "memory"); __builtin_amdgcn_sched_barrier(0);
          PV_MMA(loB, hiB, 12);
#undef PV_READ
#undef PV_MMA
        }
        wave_lds_fence();
        asm volatile("" :: "v"(o[0][0]), "v"(o[15][0]));
        DSA_MARKI(14);
      }
#undef DSA_ISSUE
      if (c < 8) {
        const float inv = 1.f / lrun;
#pragma unroll
        for (int nt = 0; nt < 16; ++nt) {
          uint2 w; w.x = pk2(o[nt][0] * inv, o[nt][1] * inv); w.y = pk2(o[nt][2] * inv, o[nt][3] * inv);
          *(uint2*)(OLh + q * 2048 + c * 256 + nt * 16 + 4 * g) = w;
        }
      }
    }
  }
  DSA_MARK(4);
  __syncthreads();
  }
  {
    DSA_IDS
    const int h = wave;
    bf16x8_t of0[8], of1[8];
#pragma unroll
    for (int ks = 0; ks < 8; ++ks) {
      of0[ks] = *(const bf16x8_t*)(OL + c * 2048 + h * 256 + ks * 32 + 8 * g);
      of1[ks] = *(const bf16x8_t*)(OL + (16 + c) * 2048 + h * 256 + ks * 32 + 8 * g);
    }
#pragma unroll 1
    for (int np = 0; np < 2; ++np) {
      bf16x8_t wf[4][8];
#pragma unroll
      for (int n4 = 0; n4 < 4; ++n4)
#pragma unroll
        for (int ks = 0; ks < 8; ++ks) wf[n4][ks] = *(const bf16x8_t*)(WUV + (size_t)((h * 8 + np * 4 + n4) * 8 + ks) * 512 + lane * 8);
      __builtin_amdgcn_sched_barrier(0);
#pragma unroll
      for (int n4 = 0; n4 < 4; ++n4) {
        const int nt = np * 4 + n4;
        f32x4 a0 = (f32x4){0.f, 0.f, 0.f, 0.f}, a1 = a0;
#pragma unroll
        for (int ks = 0; ks < 8; ++ks) {
          a0 = __builtin_amdgcn_mfma_f32_16x16x32_bf16(wf[n4][ks], of0[ks], a0, 0, 0, 0);
          a1 = __builtin_amdgcn_mfma_f32_16x16x32_bf16(wf[n4][ks], of1[ks], a1, 0, 0, 0);
        }
        uint2 w; w.x = pk2(a0[0], a0[1]); w.y = pk2(a0[2], a0[3]);
        *(uint2*)(ODSA + (tok00 + c) * 1024 + h * 128 + nt * 16 + 4 * g) = w;
        w.x = pk2(a1[0], a1[1]); w.y = pk2(a1[2], a1[3]);
        *(uint2*)(ODSA + (tok00 + 16 + c) * 1024 + h * 128 + nt * 16 + 4 * g) = w;
      }
      __builtin_amdgcn_sched_barrier(0);
    }
  }
  DSA_MARK(5);
  __syncthreads();
}

#undef DSA_IDS
__device__ __forceinline__ void ph_dsa512(const P& p, unsigned char* lds_raw) {
  for (int it = blockIdx.x; it < TT / 16; it += gridDim.x) {
    const int k = it >> 8, j = it & 255;
    dsa_batch(p, lds_raw, k, ((k & 1) ? 255 - j : j) >> 1);
  }
}

#define GL_QD    0
#define GL_KI    18432
#define GL_KE    36864
#define GL_V     55296
#define GL_AT    90112
#define GL_GLOW  99328
#define GL_QT    103424
#define GL_DEC   105472
#define GL_SSQ   105984
#define GL_LB    108032
#define GL_TOTAL 140800

#define GLA_BAR() do { asm volatile("s_waitcnt lgkmcnt(0)" ::: "memory"); __builtin_amdgcn_s_barrier(); asm volatile("" ::: "memory"); } while (0)
#ifndef PROBE_GLA
#define PROBE_GLA 0
#endif
#if PROBE_GLA
#define GLA_MARK(k) do { const unsigned long long n_ = __builtin_amdgcn_s_memrealtime(); if (PROBE_GLA == (k)) { const unsigned long long q_ = n_ - tmark; \
    while (__builtin_amdgcn_s_memrealtime() - n_ < q_) __builtin_amdgcn_s_sleep(2); } tmark = __builtin_amdgcn_s_memrealtime(); } while (0)
#else
#define GLA_MARK(k) do {} while (0)
#endif
__device__ __forceinline__ void gla_item(const P& p, unsigned char* lds_raw, int item) {
  int tid = tid_fresh();
  const int b = item >> 2, h = item & 3;
  const size_t tokb = (size_t)b * SEQ;
  const bf16* Qg = (const bf16*)(p.ws + OFF_Q);
  const bf16* Kg = (const bf16*)(p.ws + OFF_K);
  bf16* Vg = (bf16*)(p.ws + OFF_V);
  const float* GLOWg = (const float*)(p.ws + OFF_GLOW);
  const bf16* SGR = (const bf16*)(p.ws + OFF_SGR);
  LAS unsigned char* lds = (LAS unsigned char*)lds_raw;
  const unsigned lds0 = (unsigned)(uintptr_t)lds;
  LAS float* QT = (LAS float*)(lds + GL_QT);
  LAS float* DEC = (LAS float*)(lds + GL_DEC);
  LAS float* SSQ = (LAS float*)(lds + GL_SSQ);
  float wg[16];
  const float* prm = (const float*)(p.ws + OFF_PRM);
#pragma unroll
  for (int r = 0; r < 16; ++r) wg[r] = prm[PRM_WGU + r * 512 + h * 128 + (tid & 127)];
  const float bg = prm[PRM_BG + h * 128 + (tid & 127)];
  const float gn0 = prm[PRM_GNG + h * 256 + 32 * (tid >> 6) + (tid & 15)], gn1 = prm[PRM_GNG + h * 256 + 32 * (tid >> 6) + 16 + (tid & 15)];
  u32x4_t rq[2], rk[2], rv[4], rg = (u32x4_t){0u, 0u, 0u, 0u};
#define GLA_LOAD(ch)                                                                                      \
  {                                                                                                       \
    const size_t tb = tokb + (size_t)(ch) * 64;                                                           \
    _Pragma("unroll") for (int i = 0; i < 2; ++i) {                                                       \
      const int id = tid + 512 * i, tk = id >> 4, part = id & 15;                                         \
      rq[i] = *(const u32x4_t*)(Qg + (tb + tk) * 512 + h * 128 + part * 8);                               \
      rk[i] = *(const u32x4_t*)(Kg + (tb + tk) * 512 + h * 128 + part * 8);                               \
    }                                                                                                     \
    _Pragma("unroll") for (int i = 0; i < 4; ++i) {                                                       \
      const int id = tid + 512 * i, tk = id >> 5, part = id & 31;                                         \
      rv[i] = *(const u32x4_t*)(Vg + (tb + tk) * 1024 + h * 256 + part * 8);                              \
    }                                                                                                     \
    if (tid < 256) rg = *(const u32x4_t*)(GLOWg + (tb + (tid >> 2)) * 16 + (tid & 3) * 4);                \
  }
  f32x4 S[8][2];
#pragma unroll
  for (int a = 0; a < 8; ++a) { S[a][0] = (f32x4){0.f, 0.f, 0.f, 0.f}; S[a][1] = (f32x4){0.f, 0.f, 0.f, 0.f}; }
  GLA_LOAD(0);
#if PROBE_GLA
  unsigned long long tmark = __builtin_amdgcn_s_memrealtime();
#endif
#pragma unroll 1
  for (int ch = 0; ch < SEQ / 64; ++ch) {
    asm volatile("" : "+v"(tid));
    const int wave = __builtin_amdgcn_readfirstlane(tid >> 6), lane = tid & 63, g = lane >> 4, c = lane & 15;
    const int d = tid & 127, tq = __builtin_amdgcn_readfirstlane(tid >> 7);
    const unsigned vtr = lds0 + GL_V + (unsigned)((8 * g + (c >> 2)) * 544 + (32 * wave + 4 * (c & 3)) * 2);
    const unsigned ketr = lds0 + GL_KE + (unsigned)((8 * g + (c >> 2)) * 288 + (4 * (c & 3)) * 2);
    const size_t tb = tokb + (size_t)ch * 64;
#pragma unroll
    for (int i = 0; i < 2; ++i) {
      const int id = tid + 512 * i, tk = id >> 4, part = id & 15;
      *(LAS u32x4_t*)(lds + GL_QD + tk * 288 + part * 16) = rq[i];
      *(LAS u32x4_t*)(lds + GL_KI + tk * 288 + part * 16) = rk[i];
    }
#pragma unroll
    for (int i = 0; i < 4; ++i) {
      const int id = tid + 512 * i, tk = id >> 5, part = id & 31;
      *(LAS u32x4_t*)(lds + GL_V + tk * 544 + part * 16) = rv[i];
    }
    if (tid < 256) *(LAS u32x4_t*)(lds + GL_GLOW + (tid >> 2) * 64 + (tid & 3) * 16) = rg;
    GLA_MARK(1); GLA_BAR();
    GLA_LOAD((ch + 1 < SEQ / 64) ? ch + 1 : ch);
    u32x4_t rs[4];
#pragma unroll
    for (int i = 0; i < 4; ++i) {
      const int id = tid + 512 * i, tk = id >> 5, part = id & 31;
      rs[i] = *(const u32x4_t*)(SGR + (tb + tk) * 1024 + h * 256 + part * 8);
    }
    LAS float* LB = (LAS float*)(lds + GL_LB);
    float run = 0.f;
#pragma unroll 2
    for (int i = 0; i < 16; ++i) {
      const LAS f32x4* gp = (const LAS f32x4*)(lds + GL_GLOW + (16 * tq + i) * 64);
      const f32x4 g0 = gp[0], g1 = gp[1], g2 = gp[2], g3 = gp[3];
      float gl = bg;
      gl += g0[0] * wg[0] + g0[1] * wg[1] + g0[2] * wg[2] + g0[3] * wg[3];
      gl += g1[0] * wg[4] + g1[1] * wg[5] + g1[2] * wg[6] + g1[3] * wg[7];
      gl += g2[0] * wg[8] + g2[1] * wg[9] + g2[2] * wg[10] + g2[3] * wg[11];
      gl += g3[0] * wg[12] + g3[1] * wg[13] + g3[2] * wg[14] + g3[3] * wg[15];
      const float ls = fminf(gl, 0.f) - __logf(1.f + __expf(-fabsf(gl)));
      run += ls * (1.f / 16.f);
      LB[(16 * tq + i) * 128 + d] = run;
    }
    QT[tq * 128 + d] = run;
    GLA_MARK(2); GLA_BAR();
    {
      float off = 0.f, tot = 0.f;
#pragma unroll
      for (int k = 0; k < 4; ++k) { const float v = QT[k * 128 + d]; tot += v; off += (k < tq) ? v : 0.f; }
      const float eb = __expf(tot);
#pragma unroll 2
      for (int i = 0; i < 16; ++i) {
        const int t = 16 * tq + i;
        const float bb = LB[t * 128 + d] + off;
        const float e = __expf(bb), r = __expf(-bb);
        LAS bf16* qp = (LAS bf16*)(lds + GL_QD + t * 288) + d;
        LAS bf16* kp = (LAS bf16*)(lds + GL_KI + t * 288) + d;
        LAS bf16* ep = (LAS bf16*)(lds + GL_KE + t * 288) + d;
        const float q = bf2f(*qp), k = bf2f(*kp);
        *qp = f2bf(q * e);
        *kp = f2bf(k * r);
        *ep = f2bf(k * (eb * r));
      }
      if (tq == 0) DEC[d] = eb;
    }
    GLA_MARK(3); GLA_BAR();
    {
      const int ti = wave >> 1;
#pragma unroll
      for (int u = 0; u < 2; ++u) {
        const int tj = 2 * (wave & 1) + u;
        f32x4 acc = (f32x4){0.f, 0.f, 0.f, 0.f};
        if (tj <= ti) {
#pragma unroll
          for (int ks = 0; ks < 4; ++ks) {
            const bf16x8_t a = *(const LAS bf16x8_t*)(lds + GL_QD + (16 * ti + c) * 288 + (32 * ks + 8 * g) * 2);
            const bf16x8_t bb = *(const LAS bf16x8_t*)(lds + GL_KI + (16 * tj + c) * 288 + (32 * ks + 8 * g) * 2);
            acc = __builtin_amdgcn_mfma_f32_16x16x32_bf16(a, bb, acc, 0, 0, 0);
          }
        }
#pragma unroll
        for (int r = 0; r < 4; ++r) {
          const int i = 16 * ti + 4 * g + r, j = 16 * tj + c;
          *((LAS bf16*)(lds + GL_AT + i * 144) + j) = f2bf((j <= i) ? acc[r] : 0.f);
        }
      }
    }
    GLA_MARK(4); GLA_BAR();
    f32x4 o[4][2];
    {
      bf16x8_t vf[2][2];
      {
        s16x4_t lo[4], hi[4];
#pragma unroll
        for (int ks = 0; ks < 2; ++ks)
#pragma unroll
          for (int tn = 0; tn < 2; ++tn) {
            lo[ks * 2 + tn] = tr_read_b64(vtr + (32 * ks) * 544 + tn * 32);
            hi[ks * 2 + tn] = tr_read_b64(vtr + (32 * ks + 4) * 544 + tn * 32);
          }
        asm volatile("s_waitcnt lgkmcnt(0)" ::: "memory");
        __builtin_amdgcn_sched_barrier(0);
#pragma unroll
        for (int u = 0; u < 4; ++u)
          vf[u >> 1][u & 1] = (bf16x8_t){lo[u][0], lo[u][1], lo[u][2], lo[u][3], hi[u][0], hi[u][1], hi[u][2], hi[u][3]};
      }
#pragma unroll
      for (int tm = 0; tm < 4; ++tm) { o[tm][0] = (f32x4){0.f, 0.f, 0.f, 0.f}; o[tm][1] = (f32x4){0.f, 0.f, 0.f, 0.f}; }
#pragma unroll
      for (int tm = 0; tm < 4; ++tm)
#pragma unroll
        for (int ks = 0; ks < 2; ++ks) {
          if (ks == 1 && tm < 2) continue;
          const bf16x8_t a = *(const LAS bf16x8_t*)(lds + GL_AT + (16 * tm + c) * 144 + (32 * ks + 8 * g) * 2);
          o[tm][0] = __builtin_amdgcn_mfma_f32_16x16x32_bf16(a, vf[ks][0], o[tm][0], 0, 0, 0);
          o[tm][1] = __builtin_amdgcn_mfma_f32_16x16x32_bf16(a, vf[ks][1], o[tm][1], 0, 0, 0);
          __builtin_amdgcn_sched_barrier(0);
        }
#pragma unroll
      for (int u = 0; u < 4; ++u) {
        union { bf16x8_t v; unsigned w[4]; } s0, s1;
        s0.w[0] = pk2(S[2 * u][0][0], S[2 * u][0][1]); s0.w[1] = pk2(S[2 * u][0][2], S[2 * u][0][3]);
        s0.w[2] = pk2(S[2 * u + 1][0][0], S[2 * u + 1][0][1]); s0.w[3] = pk2(S[2 * u + 1][0][2], S[2 * u + 1][0][3]);
        s1.w[0] = pk2(S[2 * u][1][0], S[2 * u][1][1]); s1.w[1] = pk2(S[2 * u][1][2], S[2 * u][1][3]);
        s1.w[2] = pk2(S[2 * u + 1][1][0], S[2 * u + 1][1][1]); s1.w[3] = pk2(S[2 * u + 1][1][2], S[2 * u + 1][1][3]);
#pragma unroll
        for (int tm = 0; tm < 4; ++tm) {
          const LAS unsigned char* qrow = lds + GL_QD + (16 * tm + c) * 288 + (32 * u + 4 * g) * 2;
          const s16x4_t q0 = *(const LAS s16x4_t*)qrow, q1 = *(const LAS s16x4_t*)(qrow + 32);
          const bf16x8_t a = (bf16x8_t){q0[0], q0[1], q0[2], q0[3], q1[0], q1[1], q1[2], q1[3]};
          o[tm][0] = __builtin_amdgcn_mfma_f32_16x16x32_bf16(a, s0.v, o[tm][0], 0, 0, 0);
          o[tm][1] = __builtin_amdgcn_mfma_f32_16x16x32_bf16(a, s1.v, o[tm][1], 0, 0, 0);
        }
        __builtin_amdgcn_sched_barrier(0);
      }
#pragma unroll
      for (int tk = 0; tk < 8; ++tk) {
        const f32x4 dec4 = *(const LAS f32x4*)(DEC + 16 * tk + 4 * g);
        S[tk][0] *= dec4; S[tk][1] *= dec4;
        s16x4_t lo0 = tr_read_b64(ketr + tk * 32), hi0 = tr_read_b64(ketr + 4 * 288 + tk * 32);
        s16x4_t lo1 = tr_read_b64(ketr + 32 * 288 + tk * 32), hi1 = tr_read_b64(ketr + 36 * 288 + tk * 32);
        asm volatile("s_waitcnt lgkmcnt(0)" ::: "memory");
        __builtin_amdgcn_sched_barrier(0);
        const bf16x8_t a0 = (bf16x8_t){lo0[0], lo0[1], lo0[2], lo0[3], hi0[0], hi0[1], hi0[2], hi0[3]};
        const bf16x8_t a1 = (bf16x8_t){lo1[0], lo1[1], lo1[2], lo1[3], hi1[0], hi1[1], hi1[2], hi1[3]};
        S[tk][0] = __builtin_amdgcn_mfma_f32_16x16x32_bf16(a0, vf[0][0], S[tk][0], 0, 0, 0);
        S[tk][1] = __builtin_amdgcn_mfma_f32_16x16x32_bf16(a0, vf[0][1], S[tk][1], 0, 0, 0);
        S[tk][0] = __builtin_amdgcn_mfma_f32_16x16x32_bf16(a1, vf[1][0], S[tk][0], 0, 0, 0);
        S[tk][1] = __builtin_amdgcn_mfma_f32_16x16x32_bf16(a1, vf[1][1], S[tk][1], 0, 0, 0);
        __builtin_amdgcn_sched_barrier(0);
      }
#pragma unroll
      for (int tm = 0; tm < 4; ++tm)
#pragma unroll
        for (int r = 0; r < 4; ++r) {
          float ss = o[tm][0][r] * o[tm][0][r] + o[tm][1][r] * o[tm][1][r];
          ss = row16_sum(ss);
          if (c == 0) SSQ[(16 * tm + 4 * g + r) * 8 + wave] = ss;
        }
    }
    GLA_MARK(5); GLA_BAR();
    {
      LAS bf16* OB = (LAS bf16*)(lds + GL_LB);
#pragma unroll
      for (int tm = 0; tm < 4; ++tm)
#pragma unroll
        for (int r = 0; r < 4; ++r) {
          const int t = 16 * tm + 4 * g + r;
          const f32x4 p0 = *(const LAS f32x4*)(SSQ + t * 8), p1 = *(const LAS f32x4*)(SSQ + t * 8 + 4);
          const float tot = ((p0[0] + p0[1]) + (p0[2] + p0[3])) + ((p1[0] + p1[1]) + (p1[2] + p1[3]));
          const float rstd = rsqrtf(tot * (1.f / 256.f) + 1e-6f);
          OB[t * 256 + 32 * wave + c] = f2bf(o[tm][0][r] * rstd * gn0);
          OB[t * 256 + 32 * wave + 16 + c] = f2bf(o[tm][1][r] * rstd * gn1);
        }
    }
    GLA_MARK(6); GLA_BAR();
#pragma unroll
    for (int i = 0; i < 4; ++i) {
      const int id = tid + 512 * i, tk = id >> 5, part = id & 31;
      const u32x4_t ov = *(const LAS u32x4_t*)(lds + GL_LB + tk * 512 + part * 16);
      const u32x4_t sv = rs[i];
      u32x4_t gv;
      gv[0] = pk2(bflo(ov[0]) * bflo(sv[0]), bfhi(ov[0]) * bfhi(sv[0]));
      gv[1] = pk2(bflo(ov[1]) * bflo(sv[1]), bfhi(ov[1]) * bfhi(sv[1]));
      gv[2] = pk2(bflo(ov[2]) * bflo(sv[2]), bfhi(ov[2]) * bfhi(sv[2]));
      gv[3] = pk2(bflo(ov[3]) * bflo(sv[3]), bfhi(ov[3]) * bfhi(sv[3]));
      *(u32x4_t*)(Vg + (tb + tk) * 1024 + h * 256 + part * 8) = gv;
    }
    GLA_MARK(7);
  }
#undef GLA_LOAD
  __syncthreads();
}

#define LDS_BYTES 155712
#define OFF_XBAR (224ull * 1024)
#define OFF_CTR (200ull * 1024)

__device__ __forceinline__ unsigned xcc_id() { return (unsigned)__builtin_amdgcn_s_getreg((3 << 11) | 20) & 0x7u; }
__device__ __forceinline__ void ph_mixer(const P& p, unsigned char* lds_raw, bool do_gla) {
  if (do_gla && blockIdx.x < 32) { gla_item(p, lds_raw, blockIdx.x); if (blockIdx.x == 0) TS_SET(p, 20); }
  unsigned* ctr = (unsigned*)(p.ws + OFF_CTR);
  LAS unsigned* slot = (LAS unsigned*)((LAS unsigned char*)lds_raw + DS_TOTAL);
  const unsigned home = xcc_id();
  unsigned k = 0;
  for (;;) {
    if (tid_fresh() == 0) {
      unsigned qi = 0xffffffffu;
      while (k < 8) {
        const unsigned b = (home + k) & 7u;
        const unsigned v = __hip_atomic_fetch_add(ctr + 64 * b, 1u, __ATOMIC_RELAXED, __HIP_MEMORY_SCOPE_AGENT);
        if (v < 128u) { qi = (b << 8) | v; break; }
        ++k;
      }
      slot[0] = qi; slot[1] = k;
    }
    __syncthreads();
    const unsigned qi = slot[0];
    k = slot[1];
    __syncthreads();
    if (qi == 0xffffffffu) break;
    dsa_batch(p, lds_raw, (int)(qi >> 8), 127 - (int)(qi & 255u));
  }
}

__global__ void __launch_bounds__(512, 2) mega(P p) {
  extern __shared__ __attribute__((aligned(16))) unsigned char lds_raw[];
  LAS unsigned char* lds = (LAS unsigned char*)lds_raw;
  cg::grid_group grid = cg::this_grid();
  char* ws = p.ws;
  const int bid = blockIdx.x, nb = gridDim.x;
  if (bid == 0 && threadIdx.x < 8) *(unsigned*)(ws + OFF_CTR + 256 * threadIdx.x) = 0u;
  if (bid == 0) { for (int i = threadIdx.x; i < XCD_BAR_WORDS; i += 512) ((unsigned*)(ws + OFF_XBAR))[i] = 0u; }
  volatile LAS unsigned* xst = (volatile LAS unsigned*)(lds + DS_TOTAL + 16);
  if (threadIdx.x < 4) xst[threadIdx.x] = 0u;
#if PROBE_TS
  { const int t_ = tid_fresh(); if (bid == 0 && t_ < 64) ((unsigned long long*)(ws + OFF_TS))[t_] = 0ull; }
  __syncthreads();
  if (bid == 0) TS_SET(p, 0);
#endif
  ph_prep(p, (float*)lds_raw);
  grid.sync();
  const XcdBarrier xb = xcd_barrier_post((unsigned*)(ws + OFF_XBAR), xst);
  if (bid == 0) TS_SET(p, 1);
  ph_mod(p, p.x, p.norm1_g, 0, 1024, (bf16*)(ws + OFF_H), bid, nb);
  xcd_barrier(xb);
  if (bid == 0) TS_SET(p, 2);
  gemm_run(lds, (const bf16*)(ws + OFF_H), (const bf16*)(ws + OFF_WT_IN), TT, 7168, 1024, EpiIn{ws, p.out});
  xcd_barrier(xb);
  if (bid == 0) TS_SET(p, 3);
  ph_mixer(p, lds_raw, true);
  if (bid == 0) TS_SET(p, 21);
  xcd_barrier(xb);
  if (bid == 0) TS_SET(p, 4);
  gemm_run(lds, (const bf16*)(ws + OFF_V), (const bf16*)(ws + OFF_WT_A), TT, 1024, 1024,
           EpiMix<false>{(const bf16*)p.out, (bf16*)(ws + OFF_MIX)});
  gemm_run(lds, (const bf16*)(ws + OFF_ODSA), (const bf16*)(ws + OFF_WT_B), TT, 1024, 1024,
           EpiMix<true>{(const bf16*)p.out + (size_t)TT * 1024, (bf16*)(ws + OFF_MIX)});
  xcd_barrier(xb);
  if (bid == 0) TS_SET(p, 5);
  gemm_run(lds, (const bf16*)(ws + OFF_MIX), (const bf16*)(ws + OFF_WT_OUT), TT, 1024, 1024,
           EpiX1{p.x, (const float*)(ws + OFF_ADA), p.out});
  xcd_barrier(xb);
  if (bid == 0) TS_SET(p, 6);
  ph_mod(p, p.out, (const float*)(ws + OFF_PRM) + PRM_N2G, 3072, 4096, (bf16*)(ws + OFF_H), bid, nb);
  xcd_barrier(xb);
  if (bid == 0) TS_SET(p, 7);
  gemm_run(lds, (const bf16*)(ws + OFF_H), (const bf16*)(ws + OFF_WT_Q), TT, 2048, 1024, EpiPlain{(bf16*)(ws + OFF_PQ), 2048});
  xcd_barrier(xb);
  if (bid == 0) TS_SET(p, 8);
  ph_peer512(p, lds_raw, p.out);
#if PROBE_TS
  if (bid == 0) TS_SET(p, 18);
  xcd_barrier(xb);
  {
    const unsigned long long* T = (const unsigned long long*)(ws + OFF_TS);
    const unsigned long long q = (unsigned long long)(PROBE_Q), t0 = __builtin_amdgcn_s_memrealtime();
    while (__builtin_amdgcn_s_memrealtime() - t0 < q) __builtin_amdgcn_s_sleep(8);
  }
#endif
}

extern "C" void kernel_launch(void* const* d_in, const int* in_sizes, int n_in, void* d_out, int out_size, void* d_ws,
                              size_t ws_size, hipStream_t stream) {
  P p{};
  const float** f = (const float**)&p;
  for (int i = 0; i < 22; ++i) f[i] = (const float*)d_in[i];
  p.out = (float*)d_out;
  p.ws = (char*)d_ws;
  if (ws_size < WS_NEED) { fprintf(stderr, "workspace too small: %zu\n", ws_size); return; }
  static int grid_blocks = 0;
  if (!grid_blocks) {
    int dev = 0, cus = 0, per_cu = 0;
    (void)hipGetDevice(&dev);
    (void)hipDeviceGetAttribute(&cus, hipDeviceAttributeMultiprocessorCount, dev);
    if (hipFuncSetAttribute((const void*)mega, hipFuncAttributeMaxDynamicSharedMemorySize, LDS_BYTES) != hipSuccess) {
      fprintf(stderr, "hipFuncSetAttribute failed\n"); grid_blocks = -1; return;
    }
    if (hipOccupancyMaxActiveBlocksPerMultiprocessor(&per_cu, (const void*)mega, 512, LDS_BYTES) != hipSuccess || per_cu < 1) {
      fprintf(stderr, "occupancy query failed\n"); grid_blocks = -1; return;
    }
    grid_blocks = cus;
  }
  if (grid_blocks <= 0) return;
  void* args[] = {&p};
  hipError_t e = hipLaunchCooperativeKernel((void*)mega, dim3(grid_blocks), dim3(512), args, LDS_BYTES, stream);
  if (e != hipSuccess) fprintf(stderr, "cooperative launch failed: %s (grid %d)\n", hipGetErrorString(e), grid_blocks);
}
```

```cpp
#include <hip/hip_runtime.h>
#include <hip/hip_cooperative_groups.h>
#include <cstdio>
#include <cstdint>
namespace cg = cooperative_groups;

#define TT 32768
#define SEQ 4096
#define DM 1024
#define NIN 7000
typedef unsigned short bf16;
#define LAS __attribute__((address_space(3)))

struct P {
  const float *x, *c, *w_ada, *b_ada, *norm1_g, *w_in, *w_gate_up, *b_gate, *gla_norm_g, *kv_norm_g,
      *w_uk, *w_uv, *w_a, *w_b, *w_out, *norm2_g, *w_q, *sk1, *sk2, *peer_u, *peer_v, *final_g;
  float* out;
  char* ws;
};

#define MB (1ull << 20)
#define OFF_ADA   (0ull)
#define OFF_H     (1 * MB)
#define OFF_ODSA  (1 * MB)
#define OFF_Q     (65 * MB)
#define OFF_K     (97 * MB)
#define OFF_MIX   (65 * MB)
#define OFF_V     (129 * MB)
#define OFF_DQ    (193 * MB)
#define OFF_PQ    (129 * MB)
#define OFF_DSCR  (257 * MB)
#define OFF_SSP   (256ull * 1024)
#define OFF_CKV   (289 * MB)
#define OFF_IQ    (305 * MB)
#define OFF_IK    (337 * MB)
#define OFF_IW    (341 * MB)
#define OFF_GLOW  (342 * MB)
#define OFF_SGR   (344 * MB)
#define OFF_WT    (408 * MB)
#define OFF_WT_IN  (OFF_WT)
#define OFF_WT_A   (OFF_WT + 7168ull * 2048)
#define OFF_WT_B   (OFF_WT_A + 1024ull * 2048)
#define OFF_WT_OUT (OFF_WT_B + 1024ull * 2048)
#define OFF_WT_Q   (OFF_WT_OUT + 1024ull * 2048)
#define OFF_PU    (432 * MB)
#define OFF_PV    (464 * MB)
#define OFF_SK    (496 * MB)
#define OFF_PSC   (496 * MB + 128 * 1024)
#define OFF_WUK   (497 * MB)
#define OFF_WUV   (497 * MB + 512 * 1024)
#define WS_NEED   (498 * MB)

__device__ __forceinline__ bf16 f2bf(float f) {
  unsigned u = __float_as_uint(f);
  u += 0x7fffu + ((u >> 16) & 1u);
  return (bf16)(u >> 16);
}
__device__ __forceinline__ unsigned pk2(float lo, float hi) { return (unsigned)f2bf(lo) | ((unsigned)f2bf(hi) << 16); }
__device__ __forceinline__ float bf2f(bf16 h) { return __uint_as_float(((unsigned)h) << 16); }
__device__ __forceinline__ float bflo(unsigned u) { return __uint_as_float(u << 16); }
__device__ __forceinline__ float bfhi(unsigned u) { return __uint_as_float(u & 0xffff0000u); }
__device__ __forceinline__ float wave_sum(float v) {
#pragma unroll
  for (int o = 32; o > 0; o >>= 1) v += __shfl_xor(v, o);
  return v;
}
__device__ __forceinline__ float wave_max(float v) {
#pragma unroll
  for (int o = 32; o > 0; o >>= 1) v = fmaxf(v, __shfl_xor(v, o));
  return v;
}
#ifndef PROBE_TS
#define PROBE_TS 0
#endif
#define OFF_PRM (800ull * 1024)
#define PRM_WGU   0
#define PRM_BG    8192
#define PRM_GNG   8704
#define PRM_N2G   9728
#define PRM_FG    10752
#define PRM_TOTAL 11776
#define OFF_TS (208ull * 1024)
#if PROBE_TS
#define TS_SET(p, k) do { if (tid_fresh() == 0) ((unsigned long long*)((p).ws + OFF_TS))[k] = __builtin_amdgcn_s_memrealtime(); } while (0)
#define TS_ADD(p, k, t0) do { if (tid_fresh() == 0) ((unsigned long long*)((p).ws + OFF_TS))[k] += __builtin_amdgcn_s_memrealtime() - (t0); } while (0)
#define TS_NOW() __builtin_amdgcn_s_memrealtime()
#else
#define TS_SET(p, k) do {} while (0)
#define TS_ADD(p, k, t0) do {} while (0)
#define TS_NOW() 0ull
#endif
__device__ __forceinline__ int tid_fresh() { int t = threadIdx.x; asm volatile("" : "+v"(t)); return t; }
__device__ __forceinline__ float sigmoidf_(float v) { return 1.f / (1.f + __expf(-v)); }
__device__ __forceinline__ float siluf_(float v) { return v / (1.f + __expf(-v)); }

#include <hip/hip_runtime.h>
namespace pg8 {
#define PG8_LAS __attribute__((address_space(3)))
typedef unsigned short bf16_t;
typedef short bf16x8 __attribute__((ext_vector_type(8)));
typedef float f32x4 __attribute__((ext_vector_type(4)));
typedef unsigned u32x4 __attribute__((ext_vector_type(4)));
constexpr int BM = 256, BK = 64, HALF = 128, HTB = HALF * BK * 2  , STAGE_BYTES = 8 * HTB, NXCD = 8, WGM = 8;

__host__ __device__ __forceinline__ int lds_byte(int r, int c) { const int st = (r >> 4) * 2 + (c >> 5), rr = r & 15, cc = c & 31, ob = rr * 64 + cc * 2; return st * 1024 + (ob ^ (((ob >> 9) & 1) << 5)); }
__host__ __device__ __forceinline__ void stage_rc(int b, int& R, int& C) { const int st = b / 1024, sb = b % 1024, swz = sb ^ (((sb >> 9) & 1) << 5); R = (st >> 1) * 16 + swz / 64; C = (st & 1) * 32 + (swz % 64) / 2; }
__host__ __device__ __forceinline__ int perm32(int rho) { const int n = rho >> 4, i = rho & 15; return 8 * (i >> 2) + 4 * n + (i & 3); }

struct Unit { int pm, pn; };
struct Gemm { const bf16_t* A; const bf16_t* Bt; int M, N, K; };

struct StaticOrder {
    int nM, nN, nwg, G, c;
    __host__ __device__ void init(int M, int N, int G_, int c_) { nM = M / BM; nN = N / BM; nwg = nM * nN; G = G_; c = c_; }
    __host__ __device__ bool next(int i, Unit& u) const {
        const long L = (long)i * G + c; if (L >= nwg) return false;
        int wgid = (int)L; { const int q = nwg / NXCD, r = nwg % NXCD, xcd = wgid % NXCD, off = wgid / NXCD; wgid = (xcd < r ? xcd * (q + 1) : r * (q + 1) + (xcd - r) * q) + off; }
        const int nig = WGM * nN, gid = wgid / nig, fm = gid * WGM, gsz = (nM - fm) < WGM ? (nM - fm) : WGM;
        u.pm = fm + ((wgid % nig) % gsz); u.pn = (wgid % nig) / gsz; return true;
    }
    __device__ __forceinline__ void a_ready(const Unit&) const {}
    __device__ __forceinline__ void done(const Unit&) const {}
};
__device__ __forceinline__ unsigned cvt_pk_bf16(float lo, float hi) { unsigned r; asm volatile("v_cvt_pk_bf16_f32 %0, %1, %2" : "=v"(r) : "v"(lo), "v"(hi)); return r; }

template <class Epi, class Sched, bool STAMP = false>
__device__ __forceinline__ void gemm_phase(PG8_LAS unsigned char* lds, const Gemm g, const Sched& S, const Epi& E, unsigned long long* stamps) {
    const int tid = ::tid_fresh(), wid = __builtin_amdgcn_readfirstlane(tid >> 6), lane = tid & 63, wr = wid >> 2, wc = wid & 3, fr = lane & 15, fq = lane >> 4;
    const int K = g.K, nt = K / BK;
    int ts_lo = 0, ts_hi = 0, nts = 0; const unsigned long long rt_entry = STAMP ? (unsigned long long)wall_clock64() : 0ull;
#define PG8_STAMP() do { if (STAMP && wid == 0 && nts < 64) { const unsigned long long _c = (unsigned long long)clock64(); \
        ts_lo = (lane == nts) ? (int)(unsigned)_c : ts_lo; ts_hi = (lane == nts) ? (int)(unsigned)(_c >> 32) : ts_hi; ++nts; } } while (0)
    PG8_STAMP();
    unsigned voffA[2], voffB[2];
#pragma unroll
    for (int i = 0; i < 2; ++i) { int R, C; stage_rc(tid * 16 + i * 8192, R, C); const int Rb = Epi::PERM ? ((R & ~31) + perm32(R & 31)) : R;
        voffA[i] = (unsigned)(R * K + C) * 2u; voffB[i] = (unsigned)(Rb * K + C) * 2u; }
    const size_t kstep = (size_t)(BK * 2);
    const size_t hstep = (size_t)HALF * K * 2;
    const size_t tstep = 2 * hstep;
    const unsigned ldsw = (unsigned)wid * 1024u;
    const int aoff = lds_byte(wr * 64 + fr, fq * 8), boff = lds_byte(wc * 32 + fr, fq * 8);
#define PG8_SA(b, h) (((b) * 2 + (h)) * HTB)
#define PG8_SB(b, h) ((4 + (b) * 2 + (h)) * HTB)
#define PG8_STAGE(bufoff, gbase, voff) do { _Pragma("unroll") for (int _i = 0; _i < 2; ++_i) \
        __builtin_amdgcn_global_load_lds((const unsigned*)((const char*)(gbase) + (voff)[_i]), (PG8_LAS unsigned*)(lds + (bufoff) + ldsw + _i * 8192), 16, 0, 0); } while (0)
#define PG8_LDA(dst, b, h) do { _Pragma("unroll") for (int m = 0; m < 4; ++m) _Pragma("unroll") for (int k = 0; k < 2; ++k) dst[m][k] = *(const PG8_LAS bf16x8*)(lds + PG8_SA(b, h) + aoff + m * 2048 + k * 1024); } while (0)
#define PG8_LDB(dst, b, h) do { _Pragma("unroll") for (int n = 0; n < 2; ++n) _Pragma("unroll") for (int k = 0; k < 2; ++k) dst[n][k] = *(const PG8_LAS bf16x8*)(lds + PG8_SB(b, h) + boff + n * 2048 + k * 1024); } while (0)
#define PG8_MMA(ai, bj, At, Bt) do { __builtin_amdgcn_s_setprio(1); _Pragma("unroll") for (int m = 0; m < 4; ++m) _Pragma("unroll") for (int n = 0; n < 2; ++n) _Pragma("unroll") for (int k = 0; k < 2; ++k) \
        acc[ai][bj][m][n] = __builtin_amdgcn_mfma_f32_16x16x32_bf16(Bt[n][k], At[m][k], acc[ai][bj][m][n], 0, 0, 0); __builtin_amdgcn_s_setprio(0); } while (0)
#define PG8_WAIT_V(n) asm volatile("s_waitcnt vmcnt(" #n ")" ::: "memory")
#define PG8_WAIT_L(n) asm volatile("s_waitcnt lgkmcnt(" #n ")" ::: "memory")
#define PG8_BAR __builtin_amdgcn_s_barrier()
#define PG8_SCHED __builtin_amdgcn_sched_barrier(0)
    Unit cur, nxt; int ui = 0;
    if (!S.next(0, cur)) return;
    f32x4 acc[2][2][4][2];
#pragma unroll
    for (int a = 0; a < 2; ++a)
#pragma unroll
        for (int b = 0; b < 2; ++b)
#pragma unroll
            for (int m = 0; m < 4; ++m)
#pragma unroll
                for (int n = 0; n < 2; ++n) acc[a][b][m][n] = (f32x4){0.f, 0.f, 0.f, 0.f};
    bf16x8 At[4][2], B0[2][2], B1[2][2];
    const char* cA = (const char*)g.A + (size_t)cur.pm * tstep; const char* cB = (const char*)g.Bt + (size_t)cur.pn * tstep;
    S.a_ready(cur);
    PG8_STAGE(PG8_SB(0, 0), cB, voffB); PG8_STAGE(PG8_SA(0, 0), cA, voffA); PG8_STAGE(PG8_SB(0, 1), cB + hstep, voffB); PG8_STAGE(PG8_SA(0, 1), cA + hstep, voffA);
    if (wr == 1) PG8_BAR;
    PG8_WAIT_V(4); PG8_BAR;
    PG8_STAGE(PG8_SB(1, 0), cB + kstep, voffB); PG8_STAGE(PG8_SA(1, 0), cA + kstep, voffA); PG8_STAGE(PG8_SB(1, 1), cB + hstep + kstep, voffB);
    PG8_WAIT_V(6); PG8_BAR;
    PG8_STAMP();
    for (;;) {
        const bool has_next = S.next(ui + 1, nxt);
        const char* nA = has_next ? (const char*)g.A + (size_t)nxt.pm * tstep : cA; const char* nB = has_next ? (const char*)g.Bt + (size_t)nxt.pn * tstep : cB;
        for (int t = 0; t < nt; t += 2) {
            const bool last = (t == nt - 2);
            const char* a1 = cA + (size_t)(t + 1) * kstep;
            const char* a2 = last ? nA : cA + (size_t)(t + 2) * kstep; const char* b2 = last ? nB : cB + (size_t)(t + 2) * kstep;
            const char* a3 = a2 + kstep; const char* b3 = b2 + kstep;
            if (last && has_next) S.a_ready(nxt);
            PG8_LDB(B0, 0, 0); PG8_SCHED; PG8_LDA(At, 0, 0); PG8_STAGE(PG8_SA(1, 1), a1 + hstep, voffA);
            PG8_WAIT_L(8); PG8_BAR; PG8_WAIT_L(0); PG8_MMA(0, 0, At, B0); PG8_BAR; PG8_SCHED;
            PG8_LDB(B1, 0, 1); PG8_STAGE(PG8_SB(0, 0), b2, voffB);
            PG8_BAR; PG8_WAIT_L(0); PG8_MMA(0, 1, At, B1); PG8_BAR;
            PG8_LDA(At, 0, 1); PG8_STAGE(PG8_SA(0, 0), a2, voffA);
            PG8_BAR; PG8_WAIT_L(0); PG8_MMA(1, 0, At, B0); PG8_BAR; PG8_SCHED;
            PG8_STAGE(PG8_SB(0, 1), b2 + hstep, voffB);
            PG8_WAIT_V(6); PG8_BAR; PG8_MMA(1, 1, At, B1); PG8_BAR;
            PG8_LDB(B0, 1, 0); PG8_SCHED; PG8_LDA(At, 1, 0); PG8_STAGE(PG8_SA(0, 1), a2 + hstep, voffA);
            PG8_WAIT_L(8); PG8_BAR; PG8_WAIT_L(0); PG8_MMA(0, 0, At, B0); PG8_BAR; PG8_SCHED;
            PG8_LDB(B1, 1, 1); PG8_STAGE(PG8_SB(1, 0), b3, voffB);
            PG8_BAR; PG8_WAIT_L(0); PG8_MMA(0, 1, At, B1); PG8_BAR;
            PG8_LDA(At, 1, 1); PG8_STAGE(PG8_SA(1, 0), a3, voffA);
            PG8_BAR; PG8_WAIT_L(0); PG8_MMA(1, 0, At, B0); PG8_BAR; PG8_SCHED;
            PG8_STAGE(PG8_SB(1, 1), b3 + hstep, voffB);
            PG8_WAIT_V(6); PG8_BAR; PG8_MMA(1, 1, At, B1); PG8_BAR;
        }
        PG8_STAMP();
        if constexpr (!Epi::AFTER_DRAIN) { E(acc, cur, wr, wc, fr, fq); S.done(cur); }
        PG8_STAMP();
        if (!has_next) break;
#pragma unroll
        for (int a = 0; a < 2; ++a)
#pragma unroll
            for (int b = 0; b < 2; ++b)
#pragma unroll
                for (int m = 0; m < 4; ++m)
#pragma unroll
                    for (int n = 0; n < 2; ++n) acc[a][b][m][n] = (f32x4){0.f, 0.f, 0.f, 0.f};
        cur = nxt; cA = nA; cB = nB; ++ui;
    }
    PG8_WAIT_V(0);
    if (wr == 0) PG8_BAR;
    PG8_BAR;
    if constexpr (Epi::AFTER_DRAIN) { E.fused(acc, cur, wr, wc, fr, fq, lds, wid, lane); S.done(cur); }
    PG8_STAMP();
    if (STAMP && wid == 0) { stamps[lane] = lane < nts ? (((unsigned long long)(unsigned)ts_hi << 32) | (unsigned)ts_lo) : 0ull;
        if (lane == 62) stamps[62] = rt_entry; if (lane == 63) stamps[63] = (unsigned long long)wall_clock64(); }
#undef PG8_STAMP
#undef PG8_SA
#undef PG8_SB
#undef PG8_STAGE
#undef PG8_LDA
#undef PG8_LDB
#undef PG8_MMA
#undef PG8_WAIT_V
#undef PG8_WAIT_L
#undef PG8_BAR
#undef PG8_SCHED
}
}
#define XB_TMO      128
#define XB_XCNT(j)  (256  + 64 * (j))
#define XB_XSUB(j)  (1280 + 64 * (j))
#define XB_XGEN(j)  (2304 + 64 * (j))
#define XB_TOP      3328
#define XB_TOPGEN   3392
#define XCD_BAR_WORDS 3456
#define XB_SPIN_CAP (1u << 18)

__device__ __forceinline__ unsigned xb_ld(unsigned* p)              { return __hip_atomic_load(p, __ATOMIC_RELAXED, __HIP_MEMORY_SCOPE_AGENT); }
__device__ __forceinline__ unsigned xb_add(unsigned* p, unsigned v) { return __hip_atomic_fetch_add(p, v, __ATOMIC_RELAXED, __HIP_MEMORY_SCOPE_AGENT); }
__device__ __forceinline__ unsigned xb_xcc_id() { return (unsigned)__builtin_amdgcn_s_getreg((3 << 11) | 20) & 0xFu; }
#define XB_SPIN(cond, bar) do { unsigned _sp = 0; while (cond) { __builtin_amdgcn_s_sleep(1); \
    if ((++_sp & 255u) == 0u) { if (xb_ld(&(bar)[XB_TMO])) break; if (_sp > XB_SPIN_CAP) { atomicAdd(&(bar)[XB_TMO], 1u); break; } } } } while (0)

struct XcdBarrier {
    unsigned* bar; unsigned x;
    volatile LAS unsigned* st;
};

__device__ __forceinline__ XcdBarrier xcd_barrier_post(unsigned* bar, volatile LAS unsigned* st) {
    XcdBarrier b; b.bar = bar; b.x = xb_xcc_id(); b.st = st;
    if (threadIdx.x == 0) (void)xb_add(&bar[XB_XCNT(b.x)], 1u);
    return b;
}
__device__ __forceinline__ void xcd_barrier_complete(unsigned* bar, unsigned x, unsigned& nloc, unsigned& nx) {
    const unsigned G = gridDim.x * gridDim.y * gridDim.z;
    unsigned sum, cnt, mine, sp = 0u;
    for (;;) {
        sum = 0u; cnt = 0u; mine = 0u;
#pragma unroll
        for (unsigned j = 0; j < 16; ++j) { const unsigned c = xb_ld(&bar[XB_XCNT(j)]); sum += c; cnt += (c > 0u) ? 1u : 0u; mine = (j == x) ? c : mine; }
        if (sum == G) break;
        __builtin_amdgcn_s_sleep(1);
        if ((++sp & 255u) == 0u) { if (xb_ld(&bar[XB_TMO])) break; if (sp > XB_SPIN_CAP) { atomicAdd(&bar[XB_TMO], 1u); break; } }
    }
    nloc = mine > 0u ? mine : 1u; nx = cnt > 0u ? cnt : 1u;
}

__device__ __forceinline__ void xcd_barrier(const XcdBarrier& b) {
    asm volatile("s_waitcnt vmcnt(0)" ::: "memory");
    __syncthreads();
    if (threadIdx.x == 0) {
        unsigned* bar = b.bar;
        __builtin_amdgcn_s_waitcnt(0);
        unsigned nloc = b.st[0], nx = b.st[1];
        if (nloc == 0u) { xcd_barrier_complete(bar, b.x, nloc, nx); b.st[0] = nloc; b.st[1] = nx; }
        const unsigned old = xb_add(&bar[XB_XSUB(b.x)], 1u);
        const unsigned gen = old / nloc;
        if (old + 1u == (gen + 1u) * nloc) {
            __builtin_amdgcn_fence(__ATOMIC_RELEASE, "agent");
            asm volatile("s_waitcnt vmcnt(0)" ::: "memory");
            const unsigned og = xb_add(&bar[XB_TOP], 1u);
            const unsigned tg = og / nx;
            if (og + 1u == (tg + 1u) * nx) xb_add(&bar[XB_TOPGEN], 1u);
            else XB_SPIN(xb_ld(&bar[XB_TOPGEN]) == tg, bar);
            __builtin_amdgcn_fence(__ATOMIC_ACQUIRE, "agent");
            xb_add(&bar[XB_XGEN(b.x)], 1u);
            asm volatile("s_waitcnt vmcnt(0)" ::: "memory");
        } else {
            XB_SPIN(xb_ld(&bar[XB_XGEN(b.x)]) == gen, bar);
            __builtin_amdgcn_fence(__ATOMIC_ACQUIRE, "agent");
            asm volatile("s_waitcnt vmcnt(0)" ::: "memory");
        }
    }
    __syncthreads();
}

__device__ __forceinline__ void ph_mod(const P& p, const float* X, const float* g, int shift_off, int scale_off, bf16* H, int bid, int nb) {
  const float* ada = (const float*)(p.ws + OFF_ADA);
  const int tidm = tid_fresh(); int wave = tidm >> 6, lane = tidm & 63;
  const int rstride = nb * (int)(blockDim.x >> 6);
  int row = bid * (int)(blockDim.x >> 6) + wave;
  float4 v[4];
  if (row < TT) {
    const float4* xr = (const float4*)(X + (size_t)row * DM);
#pragma unroll
    for (int i = 0; i < 4; ++i) v[i] = xr[lane + i * 64];
  }
  for (; row < TT; row += rstride) {
    float4 vn[4];
    const int nrow = row + rstride;
    {
      const float4* xn = (const float4*)(X + (size_t)((nrow < TT) ? nrow : row) * DM);
#pragma unroll
      for (int i = 0; i < 4; ++i) vn[i] = xn[lane + i * 64];
    }
    float ss = 0.f;
#pragma unroll
    for (int i = 0; i < 4; ++i) ss += v[i].x * v[i].x + v[i].y * v[i].y + v[i].z * v[i].z + v[i].w * v[i].w;
    ss = wave_sum(ss);
    float rstd = rsqrtf(ss * (1.f / DM) + 1e-6f);
    int b = row >> 12;
    const float* sh = ada + b * 6144 + shift_off;
    const float* sc = ada + b * 6144 + scale_off;
#pragma unroll
    for (int i = 0; i < 4; ++i) {
      int c0 = (lane + i * 64) * 4;
      float4 gg = *(const float4*)(g + c0);
      float4 s4 = *(const float4*)(sc + c0);
      float4 h4 = *(const float4*)(sh + c0);
      ushort4 o;
      o.x = f2bf(v[i].x * rstd * gg.x * (1.f + s4.x) + h4.x);
      o.y = f2bf(v[i].y * rstd * gg.y * (1.f + s4.y) + h4.y);
      o.z = f2bf(v[i].z * rstd * gg.z * (1.f + s4.z) + h4.z);
      o.w = f2bf(v[i].w * rstd * gg.w * (1.f + s4.w) + h4.w);
      *(ushort4*)(H + (size_t)row * DM + c0) = o;
    }
#pragma unroll
    for (int i = 0; i < 4; ++i) v[i] = vn[i];
  }
}

using pg8::f32x4;
using pg8::u32x4;
using pg8::Unit;
using pg8::cvt_pk_bf16;
typedef short s16x4_t __attribute__((ext_vector_type(4)));
typedef unsigned u32x4_t __attribute__((ext_vector_type(4)));
typedef unsigned short u16x4_t __attribute__((ext_vector_type(4)));

__device__ __forceinline__ size_t tm_off(size_t row, int col, int kbn) {
  return (((row >> 4) * kbn + (col >> 5)) * 64 + ((col >> 3) & 3) * 16 + (row & 15)) * 8 + (col & 7);
}

__device__ __forceinline__ int in_srcmap(int d) {
  if (d < 2048) return d;
  if (d < 3072) return 3088 + (d - 2048);
  if (d < 3328) return 4112 + (d - 3072);
  if (d < 3840) return 4368 + (d - 3328);
  if (d < 3904) return 4880 + (d - 3840);
  if (d < 3912) return 4944 + (d - 3904);
  if (d < 3928) return 3072 + (d - 3912);
  if (d < 4096) return -1;
  if (d < 5120) return 2048 + (d - 4096);
  return 4952 + (d - 5120);
}
template <bool MAP>
__device__ __forceinline__ void transpose_item(const float* W, int ldw, int K, bf16* WT, int item, int nblk, float* scr, int lane) {
  const int kb = item / nblk, nbk = item % nblk, k0 = 64 * kb, n0 = 32 * nbk;
  const int d = n0 + (lane & 31);
  const int src = MAP ? in_srcmap(d) : d;
#pragma unroll 8
  for (int i = 0; i < 32; ++i) {
    const int kk = 2 * i + (lane >> 5);
    scr[kk * 33 + (lane & 31)] = (src >= 0) ? W[(size_t)(k0 + kk) * ldw + src] : 0.f;
  }
  asm volatile("s_waitcnt lgkmcnt(0)" ::: "memory");
  const int c = lane & 7;
#pragma unroll
  for (int j = 0; j < 4; ++j) {
    const int n = (lane >> 3) + 8 * j;
    const float* s = scr + (8 * c) * 33 + n;
    uint4 o;
    o.x = pk2(s[0 * 33], s[1 * 33]); o.y = pk2(s[2 * 33], s[3 * 33]); o.z = pk2(s[4 * 33], s[5 * 33]); o.w = pk2(s[6 * 33], s[7 * 33]);
    *(uint4*)(WT + (size_t)(n0 + n) * K + k0 + 8 * c) = o;
  }
  asm volatile("s_waitcnt lgkmcnt(0)" ::: "memory");
}

__device__ __forceinline__ void ph_prep(const P& p, float* sm) {
  const int tid = tid_fresh(), wave = tid >> 6, lane = tid & 63;
  const int bid = blockIdx.x, nb = gridDim.x;
  float* silc = sm + 8 * 2112 + 64;
  float* red = silc + 8192;
  float* ada = (float*)(p.ws + OFF_ADA);
  if (bid < 192) {
    for (int i = tid; i < 8192; i += 512) silc[i] = siluf_(p.c[i]);
    __syncthreads();
    for (int it = bid; it < 192; it += nb) {
      const int kg = tid >> 5, cn = tid & 31, n = it * 32 + cn;
      float acc[8];
#pragma unroll
      for (int b = 0; b < 8; ++b) acc[b] = 0.f;
      for (int k = kg * 64; k < kg * 64 + 64; ++k) {
        const float w = p.w_ada[(size_t)k * 6144 + n];
#pragma unroll
        for (int b = 0; b < 8; ++b) acc[b] += silc[b * 1024 + k] * w;
      }
#pragma unroll
      for (int b = 0; b < 8; ++b) red[(kg * 8 + b) * 32 + cn] = acc[b];
      __syncthreads();
      if (tid < 256) {
        const int b = tid >> 5, c2 = tid & 31;
        float s = 0.f;
#pragma unroll
        for (int g = 0; g < 16; ++g) s += red[(g * 8 + b) * 32 + c2];
        ada[b * 6144 + it * 32 + c2] = s + p.b_ada[it * 32 + c2];
      }
      __syncthreads();
    }
  }
  {
    unsigned char* PU8 = (unsigned char*)(p.ws + OFF_PU);
    unsigned char* PV8 = (unsigned char*)(p.ws + OFF_PV);
    float* PSC = (float*)(p.ws + OFF_PSC);
    for (int row = bid * 8 + wave; row < 2 * 16384; row += nb * 8) {
      const float* src = (row < 16384 ? p.peer_u : p.peer_v) + (size_t)(row & 16383) * 1024 + lane * 16;
      f32x4 v[4];
      float mx = 0.f;
#pragma unroll
      for (int q = 0; q < 4; ++q) {
        v[q] = *(const f32x4*)(src + q * 4);
        mx = fmaxf(mx, fmaxf(fmaxf(fabsf(v[q][0]), fabsf(v[q][1])), fmaxf(fabsf(v[q][2]), fabsf(v[q][3]))));
      }
      mx = wave_max(mx);
      const float sc = (mx > 0.f) ? exp2f(floorf(log2f(448.f / mx))) : 1.f;
      u32x4 o;
#pragma unroll
      for (int q = 0; q < 4; ++q) {
        int w = __builtin_amdgcn_cvt_pk_fp8_f32(v[q][0] * sc, v[q][1] * sc, 0, false);
        w = __builtin_amdgcn_cvt_pk_fp8_f32(v[q][2] * sc, v[q][3] * sc, w, true);
        o[q] = (unsigned)w;
      }
      *(u32x4*)((row < 16384 ? PU8 : PV8) + (size_t)(row & 16383) * 1024 + lane * 16) = o;
      if (lane == 0) PSC[row] = 1.f / sc;
    }
    for (int i = bid * 512 + tid; i < 2 * 2048; i += nb * 512) {
      const float* src = (i < 2048) ? p.sk1 : p.sk2;
      const int j = i & 2047;
      const float4 v0 = *(const float4*)(src + j * 8), v1 = *(const float4*)(src + j * 8 + 4);
      uint4 o; o.x = pk2(v0.x, v0.y); o.y = pk2(v0.z, v0.w); o.z = pk2(v1.x, v1.y); o.w = pk2(v1.z, v1.w);
      *(uint4*)((bf16*)(p.ws + OFF_SK) + (size_t)(i >> 11) * 16384 + tm_off((size_t)(j >> 4), (j & 15) * 8, 4)) = o;
    }
  }
  {
    float* prm = (float*)(p.ws + OFF_PRM);
    for (int i = bid * 512 + tid; i < PRM_TOTAL; i += nb * 512) {
      float v;
      if (i < PRM_BG) v = p.w_gate_up[i];
      else if (i < PRM_GNG) v = p.b_gate[i - PRM_BG];
      else if (i < PRM_N2G) v = p.gla_norm_g[i - PRM_GNG];
      else if (i < PRM_FG) v = p.norm2_g[i - PRM_N2G];
      else v = p.final_g[i - PRM_FG];
      prm[i] = v;
    }
  }
  {
    bf16* WUK = (bf16*)(p.ws + OFF_WUK);
    bf16* WUV = (bf16*)(p.ws + OFF_WUV);
    for (int i = bid * 512 + tid; i < 2 * 262144; i += nb * 512) {
      if (i < 262144) {
        const int d = i & 127, cc = (i >> 7) & 255, h = i >> 15;
        WUK[((h * 16 + (cc >> 4)) * 4 + (d >> 5)) * 512 + (((d >> 3) & 3) * 16 + (cc & 15)) * 8 + (d & 7)] =
            f2bf(p.w_uk[((size_t)h * 128 + d) * 256 + cc] * p.kv_norm_g[cc] * 0.08838834764831845f);
      } else {
        const int k = i - 262144;
        const int cc = k & 255, d = (k >> 8) & 127, h = k >> 15;
        WUV[((h * 8 + (d >> 4)) * 8 + (cc >> 5)) * 512 + (((cc >> 3) & 3) * 16 + (d & 15)) * 8 + (cc & 7)] =
            f2bf(p.w_uv[((size_t)h * 256 + cc) * 128 + d] * p.kv_norm_g[cc]);
      }
    }
  }
  float* scr = sm + wave * 2112;
  const int gw = bid * 8 + wave, ngw = nb * 8;
  constexpr int I_IN = 16 * 224, I_SQ = 16 * 32, I_Q = 16 * 64;
  for (int it = gw; it < I_IN + 3 * I_SQ + I_Q; it += ngw) {
    int r = it;
    if (r < I_IN) { transpose_item<true>(p.w_in, NIN, 1024, (bf16*)(p.ws + OFF_WT_IN), r, 224, scr, lane); continue; }
    r -= I_IN;
    if (r < I_SQ) { transpose_item<false>(p.w_a, 1024, 1024, (bf16*)(p.ws + OFF_WT_A), r, 32, scr, lane); continue; }
    r -= I_SQ;
    if (r < I_SQ) { transpose_item<false>(p.w_b, 1024, 1024, (bf16*)(p.ws + OFF_WT_B), r, 32, scr, lane); continue; }
    r -= I_SQ;
    if (r < I_SQ) { transpose_item<false>(p.w_out, 1024, 1024, (bf16*)(p.ws + OFF_WT_OUT), r, 32, scr, lane); continue; }
    r -= I_SQ;
    transpose_item<false>(p.w_q, 2048, 1024, (bf16*)(p.ws + OFF_WT_Q), r, 64, scr, lane);
  }
}


struct EpiIn {
  static constexpr bool PERM = true, AFTER_DRAIN = false;
  char* ws; float* out;
  __device__ __forceinline__ void operator()(const f32x4 (&acc)[2][2][4][2], const Unit& u, int wr, int wc, int fr, int fq) const {
    const int pn = u.pn;
    const int row0 = u.pm * 256 + wr * 64 + fr, cl0 = wc * 32 + 8 * fq;
    if (pn == 12) {
      bf16* dst = (bf16*)(ws + OFF_CKV);
      float* ssp = (float*)(ws + OFF_SSP);
#pragma unroll
      for (int ai = 0; ai < 2; ++ai)
#pragma unroll
        for (int m = 0; m < 4; ++m) {
          const size_t row = row0 + ai * 128 + m * 16;
          float ss = 0.f;
#pragma unroll
          for (int bj = 0; bj < 2; ++bj) {
            const f32x4 v0 = acc[ai][bj][m][0], v1 = acc[ai][bj][m][1];
            ss += (v0[0] * v0[0] + v0[1] * v0[1]) + (v0[2] * v0[2] + v0[3] * v0[3]) + (v1[0] * v1[0] + v1[1] * v1[1]) + (v1[2] * v1[2] + v1[3] * v1[3]);
            u32x4 w; w.x = cvt_pk_bf16(v0[0], v0[1]); w.y = cvt_pk_bf16(v0[2], v0[3]); w.z = cvt_pk_bf16(v1[0], v1[1]); w.w = cvt_pk_bf16(v1[2], v1[3]);
            *(u32x4*)(dst + row * 256 + cl0 + bj * 128) = w;
          }
          ss += __shfl_xor(ss, 16); ss += __shfl_xor(ss, 32);
          if (fq == 0) ssp[row * 4 + wc] = ss;
        }
    } else if (pn == 15) {
      bf16* IK = (bf16*)(ws + OFF_IK);
      float* IW = (float*)(ws + OFF_IW);
      float* GLOW = (float*)(ws + OFF_GLOW);
#pragma unroll
      for (int ai = 0; ai < 2; ++ai)
#pragma unroll
        for (int m = 0; m < 4; ++m) {
          const size_t row = row0 + ai * 128 + m * 16;
          const int cl = cl0;
          const f32x4 v0 = acc[ai][0][m][0], v1 = acc[ai][0][m][1];
          if (cl < 64) {
            u32x4 w; w.x = cvt_pk_bf16(v0[0], v0[1]); w.y = cvt_pk_bf16(v0[2], v0[3]); w.z = cvt_pk_bf16(v1[0], v1[1]); w.w = cvt_pk_bf16(v1[2], v1[3]);
            *(u32x4*)(IK + tm_off(row, cl, 2)) = w;
          } else if (cl < 72) {
            *(f32x4*)(IW + row * 8) = v0 * 0.35355339059327373f;
            *(f32x4*)(IW + row * 8 + 4) = v1 * 0.35355339059327373f;
          } else if (cl < 88) {
            *(f32x4*)(GLOW + row * 16 + (cl - 72)) = v0;
            *(f32x4*)(GLOW + row * 16 + (cl - 72) + 4) = v1;
          }
        }
    } else {
      bf16* dst; int ld; float scale = 1.f; int act = 0; int coff; bool tm = false;
      if (pn < 2) { dst = (bf16*)(ws + OFF_Q); ld = 512; coff = pn * 256; scale = 0.08838834764831845f; }
      else if (pn < 4) { dst = (bf16*)(ws + OFF_K); ld = 512; coff = (pn - 2) * 256; }
      else if (pn < 8) { dst = (bf16*)(ws + OFF_V); ld = 1024; coff = (pn - 4) * 256; }
      else if (pn < 12) { dst = (bf16*)(ws + OFF_DQ); ld = 1024; coff = (pn - 8) * 256; tm = true; }
      else if (pn < 15) { dst = (bf16*)(ws + OFF_IQ); ld = 512; coff = (pn - 13) * 256; scale = 0.125f; tm = true; }
      else if (pn < 20) { dst = (bf16*)(ws + OFF_SGR); ld = 1024; coff = (pn - 16) * 256; act = 1; }
      else if (pn < 24) { dst = (bf16*)out; ld = 1024; coff = (pn - 20) * 256; act = 2; tm = true; }
      else { dst = (bf16*)out + (size_t)TT * 1024; ld = 1024; coff = (pn - 24) * 256; act = 2; tm = true; }
#pragma unroll
      for (int ai = 0; ai < 2; ++ai)
#pragma unroll
        for (int m = 0; m < 4; ++m) {
          const size_t row = row0 + ai * 128 + m * 16;
#pragma unroll
          for (int bj = 0; bj < 2; ++bj) {
            f32x4 v0 = acc[ai][bj][m][0] * scale, v1 = acc[ai][bj][m][1] * scale;
            if (act == 1) {
#pragma unroll
              for (int j = 0; j < 4; ++j) { v0[j] = siluf_(v0[j]); v1[j] = siluf_(v1[j]); }
            } else if (act == 2) {
#pragma unroll
              for (int j = 0; j < 4; ++j) { v0[j] = sigmoidf_(v0[j]); v1[j] = sigmoidf_(v1[j]); }
            }
            u32x4 w; w.x = cvt_pk_bf16(v0[0], v0[1]); w.y = cvt_pk_bf16(v0[2], v0[3]); w.z = cvt_pk_bf16(v1[0], v1[1]); w.w = cvt_pk_bf16(v1[2], v1[3]);
            *(u32x4*)(dst + (tm ? tm_off(row, coff + cl0 + bj * 128, ld >> 5) : row * ld + coff + cl0 + bj * 128)) = w;
          }
        }
    }
  }
};

template <bool ADD> struct EpiMix {
  static constexpr bool PERM = true, AFTER_DRAIN = false;
  const bf16* SZ; bf16* MIX;
  __device__ __forceinline__ void operator()(const f32x4 (&acc)[2][2][4][2], const Unit& u, int wr, int wc, int fr, int fq) const {
    const int row0 = u.pm * 256 + wr * 64 + fr, col0 = u.pn * 256 + wc * 32 + 8 * fq;
    u32x4 sc[2], oc[2], sn[2], on[2];
    {
      const size_t idx = (size_t)row0 * 1024 + col0;
      sc[0] = *(const u32x4*)(SZ + tm_off(row0, col0, 32)); sc[1] = *(const u32x4*)(SZ + tm_off(row0, col0 + 128, 32));
      if (ADD) { oc[0] = *(const u32x4*)(MIX + idx); oc[1] = *(const u32x4*)(MIX + idx + 128); }
    }
#pragma unroll
    for (int s = 0; s < 8; ++s) {
      const int ai = s >> 2, m = s & 3;
      const size_t idx = (size_t)(row0 + ai * 128 + m * 16) * 1024 + col0;
      if (s < 7) {
        const int ai2 = (s + 1) >> 2, m2 = (s + 1) & 3;
        const size_t idn = (size_t)(row0 + ai2 * 128 + m2 * 16) * 1024 + col0;
        sn[0] = *(const u32x4*)(SZ + tm_off(row0 + ai2 * 128 + m2 * 16, col0, 32)); sn[1] = *(const u32x4*)(SZ + tm_off(row0 + ai2 * 128 + m2 * 16, col0 + 128, 32));
        if (ADD) { on[0] = *(const u32x4*)(MIX + idn); on[1] = *(const u32x4*)(MIX + idn + 128); }
      }
#pragma unroll
      for (int bj = 0; bj < 2; ++bj) {
        const u32x4 sv = sc[bj];
        f32x4 v0 = acc[ai][bj][m][0], v1 = acc[ai][bj][m][1];
        v0[0] *= bflo(sv.x); v0[1] *= bfhi(sv.x); v0[2] *= bflo(sv.y); v0[3] *= bfhi(sv.y);
        v1[0] *= bflo(sv.z); v1[1] *= bfhi(sv.z); v1[2] *= bflo(sv.w); v1[3] *= bfhi(sv.w);
        if (ADD) {
          const u32x4 o = oc[bj];
          v0[0] += bflo(o.x); v0[1] += bfhi(o.x); v0[2] += bflo(o.y); v0[3] += bfhi(o.y);
          v1[0] += bflo(o.z); v1[1] += bfhi(o.z); v1[2] += bflo(o.w); v1[3] += bfhi(o.w);
        }
        u32x4 w; w.x = cvt_pk_bf16(v0[0], v0[1]); w.y = cvt_pk_bf16(v0[2], v0[3]); w.z = cvt_pk_bf16(v1[0], v1[1]); w.w = cvt_pk_bf16(v1[2], v1[3]);
        *(u32x4*)(MIX + idx + bj * 128) = w;
      }
      if (s < 7) { sc[0] = sn[0]; sc[1] = sn[1]; if (ADD) { oc[0] = on[0]; oc[1] = on[1]; } }
    }
  }
};

struct EpiX1 {
  static constexpr bool PERM = true, AFTER_DRAIN = false;
  const float* x; const float* ada; float* out;
  __device__ __forceinline__ void operator()(const f32x4 (&acc)[2][2][4][2], const Unit& u, int wr, int wc, int fr, int fq) const {
    const int row0 = u.pm * 256 + wr * 64 + fr, col0 = u.pn * 256 + wc * 32 + 8 * fq;
    const int b = (u.pm * 256) >> 12;
    f32x4 g[2][2];
#pragma unroll
    for (int bj = 0; bj < 2; ++bj) {
      g[bj][0] = *(const f32x4*)(ada + b * 6144 + 2048 + col0 + bj * 128);
      g[bj][1] = *(const f32x4*)(ada + b * 6144 + 2048 + col0 + bj * 128 + 4);
    }
    f32x4 xc[4], xn[4];
    {
      const size_t idx = (size_t)row0 * 1024 + col0;
      xc[0] = *(const f32x4*)(x + idx); xc[1] = *(const f32x4*)(x + idx + 4);
      xc[2] = *(const f32x4*)(x + idx + 128); xc[3] = *(const f32x4*)(x + idx + 132);
    }
#pragma unroll
    for (int s = 0; s < 8; ++s) {
      const int ai = s >> 2, m = s & 3;
      const size_t idx = (size_t)(row0 + ai * 128 + m * 16) * 1024 + col0;
      if (s < 7) {
        const int ai2 = (s + 1) >> 2, m2 = (s + 1) & 3;
        const size_t idn = (size_t)(row0 + ai2 * 128 + m2 * 16) * 1024 + col0;
        xn[0] = *(const f32x4*)(x + idn); xn[1] = *(const f32x4*)(x + idn + 4);
        xn[2] = *(const f32x4*)(x + idn + 128); xn[3] = *(const f32x4*)(x + idn + 132);
      }
#pragma unroll
      for (int bj = 0; bj < 2; ++bj) {
        *(f32x4*)(out + idx + bj * 128) = xc[2 * bj] + g[bj][0] * acc[ai][bj][m][0];
        *(f32x4*)(out + idx + bj * 128 + 4) = xc[2 * bj + 1] + g[bj][1] * acc[ai][bj][m][1];
      }
      if (s < 7) { xc[0] = xn[0]; xc[1] = xn[1]; xc[2] = xn[2]; xc[3] = xn[3]; }
    }
  }
};

struct EpiPlain {
  static constexpr bool PERM = true, AFTER_DRAIN = false;
  bf16* O; int ld;
  __device__ __forceinline__ void operator()(const f32x4 (&acc)[2][2][4][2], const Unit& u, int wr, int wc, int fr, int fq) const {
    const int row0 = u.pm * 256 + wr * 64 + fr, col0 = u.pn * 256 + wc * 32 + 8 * fq;
#pragma unroll
    for (int ai = 0; ai < 2; ++ai)
#pragma unroll
      for (int m = 0; m < 4; ++m)
#pragma unroll
        for (int bj = 0; bj < 2; ++bj) {
          const f32x4 v0 = acc[ai][bj][m][0], v1 = acc[ai][bj][m][1];
          u32x4 w; w.x = cvt_pk_bf16(v0[0], v0[1]); w.y = cvt_pk_bf16(v0[2], v0[3]); w.z = cvt_pk_bf16(v1[0], v1[1]); w.w = cvt_pk_bf16(v1[2], v1[3]);
          *(u32x4*)(O + tm_off((size_t)(row0 + ai * 128 + m * 16), col0 + bj * 128, ld >> 5)) = w;
        }
  }
};

template <class Epi>
__device__ __forceinline__ void gemm_run(LAS unsigned char* lds, const bf16* A, const bf16* Bt, int M, int N, int K, const Epi& E) {
  pg8::Gemm g{A, Bt, M, N, K};
  pg8::StaticOrder S;
  S.init(M, N, gridDim.x, blockIdx.x);
  pg8::gemm_phase<Epi, pg8::StaticOrder, false>(lds, g, S, E, nullptr);
}

typedef short bf16x8_t __attribute__((ext_vector_type(8)));
typedef __bf16 bf16x2_t __attribute__((ext_vector_type(2)));
__device__ __forceinline__ float dot2bf(unsigned a, unsigned b, float acc) {
  return __builtin_amdgcn_fdot2_f32_bf16(__builtin_bit_cast(bf16x2_t, a), __builtin_bit_cast(bf16x2_t, b), acc, false);
}
__device__ __forceinline__ void wave_lds_fence() { asm volatile("s_waitcnt lgkmcnt(0)" ::: "memory"); }
template <int N> __device__ __forceinline__ float row_ror(float x) {
  return __int_as_float(__builtin_amdgcn_update_dpp(0, __float_as_int(x), 0x120 + N, 0xf, 0xf, false));
}
__device__ __forceinline__ float row16_max(float m) {
  m = fmaxf(m, row_ror<8>(m)); m = fmaxf(m, row_ror<4>(m)); m = fmaxf(m, row_ror<2>(m)); m = fmaxf(m, row_ror<1>(m));
  return m;
}
__device__ __forceinline__ float row16_sum(float m) {
  m += row_ror<8>(m); m += row_ror<4>(m); m += row_ror<2>(m); m += row_ror<1>(m);
  return m;
}
__device__ __forceinline__ float wave_sum_dpp(float s) {
  s = row16_sum(s);
  const int si = __float_as_int(s);
  return __int_as_float(__builtin_amdgcn_readlane(si, 0)) + __int_as_float(__builtin_amdgcn_readlane(si, 16)) +
         (__int_as_float(__builtin_amdgcn_readlane(si, 32)) + __int_as_float(__builtin_amdgcn_readlane(si, 48)));
}
__device__ __forceinline__ constexpr int cand_i(int L) {
  return L < 16 ? 0 : L < 24 ? 1 : L < 29 ? 2 : L < 33 ? 3 : L < 36 ? 4 : L < 38 ? 5 : L < 40 ? 6 : L < 42 ? 7 : (L - 42 + 8);
}
__device__ __forceinline__ constexpr int cand_j(int L) {
  return L < 16 ? L : L < 24 ? L - 16 : L < 29 ? L - 24 : L < 33 ? L - 29 : L < 36 ? L - 33 : L < 38 ? L - 36 : L < 40 ? L - 38 : L < 42 ? L - 40 : 0;
}
template <int K> struct CandRank {
  static __device__ __forceinline__ void run(int ki, unsigned key, int& rank) {
    const unsigned o = (unsigned)__builtin_amdgcn_readlane(ki, K);
    rank += (o > key) ? 1 : 0;
    CandRank<K + 1>::run(ki, key, rank);
  }
};
template <> struct CandRank<50> { static __device__ __forceinline__ void run(int, unsigned, int&) {} };
__device__ __forceinline__ unsigned peer_f2ord(float f) {
  if (f == 0.f) f = 0.f;
  const unsigned u = __float_as_uint(f);
  return (u & 0x80000000u) ? ~u : (u | 0x80000000u);
}
__device__ __forceinline__ float peer_ord2f(unsigned u) { return __uint_as_float((u & 0x80000000u) ? (u ^ 0x80000000u) : ~u); }
__device__ __forceinline__ unsigned umax3(unsigned a, unsigned b, unsigned c) { const unsigned t = a > b ? a : b; return t > c ? t : c; }
template <int N> __device__ __forceinline__ unsigned row_ror_u(unsigned x) {
  return (unsigned)__builtin_amdgcn_update_dpp(0, (int)x, 0x120 + N, 0xf, 0xf, false);
}
__device__ __forceinline__ unsigned row16_umax(unsigned m) {
  unsigned t;
  t = row_ror_u<8>(m); m = t > m ? t : m; t = row_ror_u<4>(m); m = t > m ? t : m;
  t = row_ror_u<2>(m); m = t > m ? t : m; t = row_ror_u<1>(m); m = t > m ? t : m;
  return m;
}
__device__ __forceinline__ float gelu_exact(float v) { return 0.5f * v * (1.f + erff(v * 0.7071067811865476f)); }

typedef float f32x2_t __attribute__((ext_vector_type(2)));
typedef unsigned peer_u32x2 __attribute__((ext_vector_type(2)));
__device__ __forceinline__ float peer_fold32(float a, float b) {
  const peer_u32x2 r = __builtin_amdgcn_permlane32_swap(__float_as_uint(a), __float_as_uint(b), false, false);
  return __uint_as_float(r.x) + __uint_as_float(r.y);
}
__device__ __forceinline__ float peer_fold16(float a, float b) {
  const peer_u32x2 r = __builtin_amdgcn_permlane16_swap(__float_as_uint(a), __float_as_uint(b), false, false);
  return __uint_as_float(r.x) + __uint_as_float(r.y);
}
#define GAS __attribute__((address_space(1)))
#define PEER_NB 6
#define PEER_LOAD(buf, TAB, tk, e0)                                                               \
  {                                                                                               \
    const unsigned* rp_ = (const unsigned*)(ridx + ((tk) * 128 + (e0)));                          \
    const unsigned w0_ = rp_[0], w1_ = rp_[1], w2_ = rp_[2];                                      \
    const int i0_ = __builtin_amdgcn_readfirstlane((int)(w0_ & 0x3fffu)), i1_ = __builtin_amdgcn_readfirstlane((int)((w0_ >> 16) & 0x3fffu)); \
    const int i2_ = __builtin_amdgcn_readfirstlane((int)(w1_ & 0x3fffu)), i3_ = __builtin_amdgcn_readfirstlane((int)((w1_ >> 16) & 0x3fffu)); \
    const int i4_ = __builtin_amdgcn_readfirstlane((int)(w2_ & 0x3fffu)), i5_ = __builtin_amdgcn_readfirstlane((int)((w2_ >> 16) & 0x3fffu)); \
    buf[0] = *(const GAS u32x4_t*)((TAB) + (size_t)i0_ * 1024 + lane * 16);                       \
    buf[1] = *(const GAS u32x4_t*)((TAB) + (size_t)i1_ * 1024 + lane * 16);                       \
    buf[2] = *(const GAS u32x4_t*)((TAB) + (size_t)i2_ * 1024 + lane * 16);                       \
    buf[3] = *(const GAS u32x4_t*)((TAB) + (size_t)i3_ * 1024 + lane * 16);                       \
    buf[4] = *(const GAS u32x4_t*)((TAB) + (size_t)i4_ * 1024 + lane * 16);                       \
    buf[5] = *(const GAS u32x4_t*)((TAB) + (size_t)i5_ * 1024 + lane * 16);                       \
  }
#define PEER_UDOT(buf, e0)                                                                        \
  {                                                                                               \
    float sp[6];                                                                                  \
    _Pragma("unroll") for (int j = 0; j < 6; ++j) {                                               \
      float s0 = 0.f, s1 = 0.f;                                                                   \
      _Pragma("unroll") for (int w = 0; w < 4; ++w) {                                             \
        const f32x2_t lo = __builtin_amdgcn_cvt_pk_f32_fp8((int)buf[j][w], false);                \
        const f32x2_t hi = __builtin_amdgcn_cvt_pk_f32_fp8((int)buf[j][w], true);                 \
        s0 = __builtin_fmaf(lo.x, hf[4 * w], s0); s1 = __builtin_fmaf(lo.y, hf[4 * w + 1], s1);   \
        s0 = __builtin_fmaf(hi.x, hf[4 * w + 2], s0); s1 = __builtin_fmaf(hi.y, hf[4 * w + 3], s1); \
      }                                                                                           \
      sp[j] = s0 + s1;                                                                            \
    }                                                                                             \
    const float u01 = peer_fold32(sp[0], sp[1]), u23 = peer_fold32(sp[2], sp[3]), u45 = peer_fold32(sp[4], sp[5]); \
    const float wq = row16_sum(peer_fold16(u01, u23));     \
    const float wr = row16_sum(peer_fold16(u45, u45));         \
    const int wqi = __float_as_int(wq), wri = __float_as_int(wr);                                 \
    PEER_PUT((e0) + 0, __builtin_amdgcn_readlane(wqi, 0));                                        \
    PEER_PUT((e0) + 1, __builtin_amdgcn_readlane(wqi, 32));                                       \
    PEER_PUT((e0) + 2, __builtin_amdgcn_readlane(wqi, 16));                                       \
    PEER_PUT((e0) + 3, __builtin_amdgcn_readlane(wqi, 48));                                       \
    PEER_PUT((e0) + 4, __builtin_amdgcn_readlane(wri, 0));                                        \
    PEER_PUT((e0) + 5, __builtin_amdgcn_readlane(wri, 32));                                       \
  }
#define PEER_PUT(ee_, vi_)                                                                        \
  {                                                                                               \
    const int ee = (ee_); const float sv = __int_as_float(vi_);                                   \
    const bool mine = (lane == (ee & 63));                                                        \
    dotA = (mine && ee < 64) ? sv : dotA;                                                         \
    dotB = (mine && ee >= 64 && ee < 128) ? sv : dotB;                                            \
  }
#define PEER_VACC(buf, e0)                                                                        \
  _Pragma("unroll") for (int j = 0; j < PEER_NB; ++j) {                                                 \
    const int ee = (e0) + j;                                                                      \
    const float a = (ee < 128) ? __int_as_float(__builtin_amdgcn_readlane(__float_as_int(ee < 64 ? aA : aB), ee & 63)) : 0.f; \
    _Pragma("unroll") for (int w = 0; w < 4; ++w) {                                               \
      const f32x2_t lo = __builtin_amdgcn_cvt_pk_f32_fp8((int)buf[j][w], false);                  \
      const f32x2_t hi = __builtin_amdgcn_cvt_pk_f32_fp8((int)buf[j][w], true);                   \
      acc[4 * w] += a * lo.x; acc[4 * w + 1] += a * lo.y; acc[4 * w + 2] += a * hi.x; acc[4 * w + 3] += a * hi.y; \
    }                                                                                             \
    __builtin_amdgcn_sched_barrier(0);                                                           \
  }

#ifndef PROBE_PEER
#define PROBE_PEER 0
#endif
#if PROBE_PEER
#define PEER_MARK(k) do { const unsigned long long n_ = __builtin_amdgcn_s_memrealtime(); if (PROBE_PEER == (k)) { const unsigned long long q_ = n_ - pmark; \
    while (__builtin_amdgcn_s_memrealtime() - n_ < q_) __builtin_amdgcn_s_sleep(2); } pmark = __builtin_amdgcn_s_memrealtime(); } while (0)
#else
#define PEER_MARK(k) do {} while (0)
#endif
__device__ __forceinline__ void ph_peer512(const P& p, unsigned char* lds_raw, float* dst_base) {
  const int tid = tid_fresh(), wave = tid >> 6, lane = tid & 63, g = lane >> 4, c = lane & 15;
  const bf16* PQ = (const bf16*)(p.ws + OFF_PQ);
  const bf16* SK = (const bf16*)(p.ws + OFF_SK);
  float* tv = (float*)(lds_raw + wave * 16384);
  int* ti = (int*)(tv + 512);
  float* rgate = (float*)(ti + 512);
  unsigned short* ridx = (unsigned short*)(rgate + 2048);
  for (int tile = blockIdx.x * 8 + wave; tile < TT / 16; tile += gridDim.x * 8) {
    const int tok0 = tile * 16;
#if PROBE_PEER
    unsigned long long pmark = __builtin_amdgcn_s_memrealtime();
#endif
    unsigned* tk = (unsigned*)tv;
#pragma unroll 1
    for (int hp = 0; hp < 4; ++hp) {
#pragma unroll 1
      for (int hf = 0; hf < 2; ++hf) {
        bf16x8_t bfr[4][8];
#pragma unroll
        for (int ks = 0; ks < 4; ++ks)
#pragma unroll
          for (int nt = 0; nt < 8; ++nt) bfr[ks][nt] = *(const bf16x8_t*)(SK + hf * 16384 + ((nt * 4 + ks) * 64 + lane) * 8);
#pragma unroll 1
        for (int h2 = 0; h2 < 2; ++h2) {
          const int hd = 2 * hp + h2;
          f32x4 acc[8];
#pragma unroll
          for (int nt = 0; nt < 8; ++nt) acc[nt] = (f32x4){0.f, 0.f, 0.f, 0.f};
#pragma unroll
          for (int ks = 0; ks < 4; ++ks) {
            const bf16x8_t a = *(const bf16x8_t*)(PQ + ((size_t)(tile * 64 + hd * 8 + hf * 4 + ks) * 64 + lane) * 8);
#pragma unroll
            for (int nt = 0; nt < 8; ++nt) acc[nt] = __builtin_amdgcn_mfma_f32_16x16x32_bf16(a, bfr[ks][nt], acc[nt], 0, 0, 0);
          }
          asm volatile("" :: "v"(acc[0][0]), "v"(acc[7][3]));
          PEER_MARK(1);
          unsigned kq[4][8], res[4];
#pragma unroll
          for (int i = 0; i < 4; ++i) {
            res[i] = 0u;
#pragma unroll
            for (int nt = 0; nt < 8; ++nt) kq[i][nt] = (peer_f2ord(acc[nt][i]) & ~127u) | (unsigned)(127 - (16 * nt + c));
          }
#pragma unroll 1
          for (int r = 0; r < 16; ++r) {
#pragma unroll
            for (int i = 0; i < 4; ++i) {
              unsigned m = umax3(umax3(kq[i][0], kq[i][1], kq[i][2]), umax3(kq[i][3], kq[i][4], kq[i][5]), (kq[i][6] > kq[i][7]) ? kq[i][6] : kq[i][7]);
              m = row16_umax(m);
#pragma unroll
              for (int nt = 0; nt < 8; ++nt) kq[i][nt] = (kq[i][nt] == m) ? 0u : kq[i][nt];
              res[i] = (c == r) ? m : res[i];
            }
          }
#pragma unroll
          for (int i = 0; i < 4; ++i) tk[((h2 * 2 + hf) * 16 + 4 * g + i) * 16 + c] = res[i];
        }
      }
      wave_lds_fence();
      PEER_MARK(2);
      const int ci = cand_i(lane < 50 ? lane : 0), cj = cand_j(lane < 50 ? lane : 0);
#pragma unroll 1
      for (int hr = 0; hr < 32; ++hr) {
        const int h2 = hr >> 4, row = hr & 15, hd = 2 * hp + h2;
        const unsigned k1 = tk[((h2 * 2 + 0) * 16 + row) * 16 + ci], k2 = tk[((h2 * 2 + 1) * 16 + row) * 16 + cj];
        const float val = peer_ord2f(k1 & ~127u) + peer_ord2f(k2 & ~127u);
        const unsigned key = (lane < 50) ? ((peer_f2ord(val) & ~63u) | (unsigned)(63 - lane)) : 0u;
        int rank = 0;
        CandRank<0>::run((int)key, key, rank);
        if (lane < 50 && rank < 16) {
          rgate[row * 128 + hd * 16 + rank] = val;
          ridx[row * 128 + hd * 16 + rank] = (unsigned short)((127 - (int)(k1 & 127u)) * 128 + (127 - (int)(k2 & 127u)));
        }
      }
      wave_lds_fence();
      PEER_MARK(3);
#pragma unroll
      for (int h2 = 0; h2 < 2; ++h2) {
        const int hd = 2 * hp + h2;
        const int row = lane >> 2, q = lane & 3;
        float* gp = rgate + row * 128 + hd * 16;
        const float mx = gp[0];
        const f32x4 b4 = *(const f32x4*)(gp + q * 4);
        f32x4 e4;
        e4[0] = __expf(b4[0] - mx); e4[1] = __expf(b4[1] - mx); e4[2] = __expf(b4[2] - mx); e4[3] = __expf(b4[3] - mx);
        float s = (e4[0] + e4[1]) + (e4[2] + e4[3]);
        s += __shfl_xor(s, 1); s += __shfl_xor(s, 2);
        const float inv = 1.f / s;
        wave_lds_fence();
        *(f32x4*)(gp + q * 4) = e4 * inv;
      }
      wave_lds_fence();
    }
    char* wsl = p.ws;
    asm volatile("" : "+s"(wsl));
    const GAS bf16* H2 = (const GAS bf16*)(wsl + OFF_H);
    const GAS unsigned char* PU = (const GAS unsigned char*)(wsl + OFF_PU);
    const GAS unsigned char* PV = (const GAS unsigned char*)(wsl + OFF_PV);
    const GAS float* USC = (const GAS float*)(wsl + OFF_PSC);
    const GAS float* VSC = USC + 16384;
    const GAS float* ada = (const GAS float*)(wsl + OFF_ADA);
    u32x4_t a0[PEER_NB], a1[PEER_NB], hn0, hn1;
#define PSB() __builtin_amdgcn_sched_barrier(0)
#define PEER_ROWS (((128 + 2 * PEER_NB - 1) / (2 * PEER_NB)) * 2 * PEER_NB)
    {
      const int tidx = tid_fresh(), lane = tidx & 63, wv = __builtin_amdgcn_readfirstlane(tidx >> 6);
      const unsigned short* ridx = (const unsigned short*)(lds_raw + wv * 16384 + 4096 + 8192);
      hn0 = *(const GAS u32x4_t*)(H2 + (size_t)tok0 * 1024 + lane * 16); hn1 = *(const GAS u32x4_t*)(H2 + (size_t)tok0 * 1024 + lane * 16 + 8);
      PEER_LOAD(a0, PU, 0, 0); PSB();
      PEER_LOAD(a1, PU, 0, PEER_NB); PSB();
    }
#pragma unroll 1
    for (int tt = 0; tt < 16; ++tt) {
      const int tidx = tid_fresh(), lane = tidx & 63, wv = __builtin_amdgcn_readfirstlane(tidx >> 6);
      const float* rgate = (const float*)(lds_raw + wv * 16384 + 4096);
      const unsigned short* ridx = (const unsigned short*)(lds_raw + wv * 16384 + 4096 + 8192);
      const size_t tok = (size_t)tok0 + tt;
      const int ttn = (tt < 15) ? tt + 1 : tt;
      float hf[16];
#pragma unroll
      for (int w = 0; w < 4; ++w) { hf[2 * w] = bflo(hn0[w]); hf[2 * w + 1] = bfhi(hn0[w]); hf[8 + 2 * w] = bflo(hn1[w]); hf[8 + 2 * w + 1] = bfhi(hn1[w]); }
      const int eA = (int)ridx[tt * 128 + lane], eB = (int)ridx[tt * 128 + 64 + lane];
      const float usA = USC[eA], usB = USC[eB];
      float dotA = 0.f, dotB = 0.f;
#pragma unroll 1
      for (int e0 = 0; e0 < PEER_ROWS; e0 += 2 * PEER_NB) {
        const bool more = e0 + 2 * PEER_NB < PEER_ROWS;
        const GAS unsigned char* tb = more ? PU : PV;
        const int r0 = more ? e0 + 2 * PEER_NB : 0;
        PEER_UDOT(a0, e0); PSB();
        PEER_LOAD(a0, tb, tt, r0); PSB();
        PEER_UDOT(a1, e0 + PEER_NB); PSB();
        PEER_LOAD(a1, tb, tt, r0 + PEER_NB); PSB();
      }
      const float aA = gelu_exact(dotA * usA) * rgate[tt * 128 + lane] * VSC[(int)ridx[tt * 128 + lane]],
                  aB = gelu_exact(dotB * usB) * rgate[tt * 128 + 64 + lane] * VSC[(int)ridx[tt * 128 + 64 + lane]];
      float acc[16];
#pragma unroll
      for (int k = 0; k < 16; ++k) acc[k] = 0.f;
      hn0 = *(const GAS u32x4_t*)(H2 + ((size_t)tok0 + ttn) * 1024 + lane * 16); hn1 = *(const GAS u32x4_t*)(H2 + ((size_t)tok0 + ttn) * 1024 + lane * 16 + 8);
      PSB();
#pragma unroll 1
      for (int e0 = 0; e0 < PEER_ROWS; e0 += 2 * PEER_NB) {
        const bool more = e0 + 2 * PEER_NB < PEER_ROWS;
        const GAS unsigned char* tb = more ? PV : PU;
        const int r0 = more ? e0 + 2 * PEER_NB : 0, tkk = more ? tt : ttn;
        PEER_VACC(a0, e0); PSB();
        PEER_LOAD(a0, tb, tkk, r0); PSB();
        PEER_VACC(a1, e0 + PEER_NB); PSB();
        PEER_LOAD(a1, tb, tkk, r0 + PEER_NB); PSB();
      }
      const int b = (int)(tok >> 12);
      const GAS float* xrow = (const GAS float*)p.out + tok * 1024;
      GAS float* orow = (GAS float*)dst_base + tok * 1024;
      const GAS float* g2 = ada + b * 6144 + 5120;
      float x2[16];
      float ss = 0.f;
#pragma unroll
      for (int q = 0; q < 4; ++q) {
        const int col = lane * 16 + q * 4;
        const f32x4 xv = *(const GAS f32x4*)(xrow + col), gv = *(const GAS f32x4*)(g2 + col);
#pragma unroll
        for (int k = 0; k < 4; ++k) { const float t = xv[k] + gv[k] * acc[q * 4 + k]; x2[q * 4 + k] = t; ss += t * t; }
      }
      ss = wave_sum_dpp(ss);
      const float rstd = rsqrtf(ss * (1.f / 1024.f) + 1e-6f);
#pragma unroll
      for (int q = 0; q < 4; ++q) {
        const int col = lane * 16 + q * 4;
        const f32x4 fg = *(const GAS f32x4*)((const GAS float*)(wsl + OFF_PRM) + PRM_FG + col);
        f32x4 o;
#pragma unroll
        for (int k = 0; k < 4; ++k) o[k] = x2[q * 4 + k] * rstd * fg[k];
        *(GAS f32x4*)(orow + col) = o;
      }
    }
    wave_lds_fence();
  }
}

#define DS_KEY16   0
#define DS_CHUNK   17408
#define DS_SEL     139264
#define DS_WAVE    147456
#define DS_TOTAL   155648
#define DS_RS      544

__device__ __forceinline__ unsigned f2ord(float f) {
  if (f == 0.f) f = 0.f;
  unsigned u = __float_as_uint(f);
  return (u & 0x80000000u) ? ~u : (u | 0x80000000u);
}
__device__ __forceinline__ int wave_scan_incl(int v, int lane) {
#pragma unroll
  for (int o = 1; o < 64; o <<= 1) { const int t = __shfl_up(v, o); v += (lane >= o) ? t : 0; }
  return v;
}
__device__ __forceinline__ void find_digit(const LAS unsigned* hist, int K, int lane, int& digit, int& above) {
  const u32x4_t h4 = *(const LAS u32x4_t*)(hist + 252 - 4 * lane);
  const int c0 = (int)h4.w, c1 = (int)h4.z, c2 = (int)h4.y, c3 = (int)h4.x;
  const int tot = c0 + c1 + c2 + c3;
  int run = wave_scan_incl(tot, lane) - tot;
  int found = -1, ab = 0;
  if (run < K && run + c0 >= K) { found = 255 - 4 * lane; ab = run; } run += c0;
  if (run < K && run + c1 >= K) { found = 254 - 4 * lane; ab = run; } run += c1;
  if (run < K && run + c2 >= K) { found = 253 - 4 * lane; ab = run; } run += c2;
  if (run < K && run + c3 >= K) { found = 252 - 4 * lane; ab = run; }
  const unsigned long long mk = __ballot(found >= 0);
  const int src = (int)__ffsll((unsigned long long)mk) - 1;
  digit = __builtin_amdgcn_readlane(found, src);
  above = __builtin_amdgcn_readlane(ab, src);
}

typedef unsigned u32x2_t __attribute__((ext_vector_type(2)));
__device__ __forceinline__ float xrow_max(float x) {
  u32x2_t r = __builtin_amdgcn_permlane16_swap(__float_as_uint(x), __float_as_uint(x), false, false);
  x = fmaxf(__uint_as_float(r.x), __uint_as_float(r.y));
  r = __builtin_amdgcn_permlane32_swap(__float_as_uint(x), __float_as_uint(x), false, false);
  return fmaxf(__uint_as_float(r.x), __uint_as_float(r.y));
}
__device__ __forceinline__ float xrow_sum(float x) {
  u32x2_t r = __builtin_amdgcn_permlane16_swap(__float_as_uint(x), __float_as_uint(x), false, false);
  x = __uint_as_float(r.x) + __uint_as_float(r.y);
  r = __builtin_amdgcn_permlane32_swap(__float_as_uint(x), __float_as_uint(x), false, false);
  return __uint_as_float(r.x) + __uint_as_float(r.y);
}
__device__ __forceinline__ s16x4_t tr_read_b64(unsigned addr) {
  s16x4_t r; asm volatile("ds_read_b64_tr_b16 %0, %1" : "=&v"(r) : "v"(addr) : "memory"); return r;
}

#ifndef PROBE_DSA
#define PROBE_DSA 0
#endif
#if PROBE_DSA
#define DSA_MARK(k) do { const unsigned long long n_ = __builtin_amdgcn_s_memrealtime(); if (PROBE_DSA == (k)) { const unsigned long long q_ = n_ - tmark; \
    while (__builtin_amdgcn_s_memrealtime() - n_ < q_) __builtin_amdgcn_s_sleep(2); } tmark = __builtin_amdgcn_s_memrealtime(); } while (0)
#else
#define DSA_MARK(k) do {} while (0)
#endif
#if PROBE_DSA >= 10
#define DSA_MARKI(k) DSA_MARK(k)
#else
#define DSA_MARKI(k) do {} while (0)
#endif
__device__ __forceinline__ void dsa_batch(const P& p, unsigned char* lds_raw, int b, int pos2) {
  const int t00 = pos2 * 32;
#define DSA_IDS const int tid = tid_fresh(), wave = __builtin_amdgcn_readfirstlane(tid >> 6), lane = tid & 63, g = lane >> 4, c = lane & 15; (void)wave; (void)g; (void)c;
  const size_t tokb = (size_t)b * SEQ, tok00 = tokb + t00;
  const bf16* DQ = (const bf16*)(p.ws + OFF_DQ);
  const bf16* CKV = (const bf16*)(p.ws + OFF_CKV);
  const float* SSP = (const float*)(p.ws + OFF_SSP);
  const bf16* IQ = (const bf16*)(p.ws + OFF_IQ);
  const bf16* IK = (const bf16*)(p.ws + OFF_IK);
  const float* IW = (const float*)(p.ws + OFF_IW);
  const bf16* WUK = (const bf16*)(p.ws + OFF_WUK);
  const bf16* WUV = (const bf16*)(p.ws + OFF_WUV);
  bf16* ODSA = (bf16*)(p.ws + OFF_ODSA);
  bf16* QL = (bf16*)(p.ws + OFF_DSCR + (size_t)blockIdx.x * 131072);
  bf16* OL = QL;
  LAS unsigned char* lds = (LAS unsigned char*)lds_raw;
  LAS unsigned short* key16 = (LAS unsigned short*)(lds + DS_KEY16);
  LAS unsigned short* sel = (LAS unsigned short*)(lds + DS_SEL);

#if PROBE_DSA
  unsigned long long tmark = __builtin_amdgcn_s_memrealtime();
#endif
  {
    DSA_IDS
    const int h = wave;
    bf16x8_t dq0[4], dq1[4];
#pragma unroll
    for (int ks = 0; ks < 4; ++ks) {
      dq0[ks] = *(const bf16x8_t*)(DQ + (((tok00 >> 4) * 32 + h * 4 + ks) * 64 + lane) * 8);
      dq1[ks] = *(const bf16x8_t*)(DQ + ((((tok00 >> 4) + 1) * 32 + h * 4 + ks) * 64 + lane) * 8);
    }
#pragma unroll 1
    for (int hn = 0; hn < 2; ++hn) {
      bf16x8_t wf[8][4];
#pragma unroll
      for (int n8 = 0; n8 < 8; ++n8)
#pragma unroll
        for (int ks = 0; ks < 4; ++ks) wf[n8][ks] = *(const bf16x8_t*)(WUK + (size_t)((h * 16 + hn * 8 + n8) * 4 + ks) * 512 + lane * 8);
      __builtin_amdgcn_sched_barrier(0);
#pragma unroll
      for (int n8 = 0; n8 < 8; ++n8) {
        const int nt = hn * 8 + n8;
        f32x4 a0 = (f32x4){0.f, 0.f, 0.f, 0.f}, a1 = a0;
#pragma unroll
        for (int ks = 0; ks < 4; ++ks) {
          a0 = __builtin_amdgcn_mfma_f32_16x16x32_bf16(wf[n8][ks], dq0[ks], a0, 0, 0, 0);
          a1 = __builtin_amdgcn_mfma_f32_16x16x32_bf16(wf[n8][ks], dq1[ks], a1, 0, 0, 0);
        }
        uint2 o; o.x = pk2(a0[0], a0[1]); o.y = pk2(a0[2], a0[3]);
        *(uint2*)(QL + c * 2048 + h * 256 + nt * 16 + 4 * g) = o;
        o.x = pk2(a1[0], a1[1]); o.y = pk2(a1[2], a1[3]);
        *(uint2*)(QL + (16 + c) * 2048 + h * 256 + nt * 16 + 4 * g) = o;
      }
      __builtin_amdgcn_sched_barrier(0);
    }
  }
  DSA_MARK(1);
#pragma unroll 1
  for (int half = 0; half < 2; ++half) {
  const int t0 = t00 + 16 * half;
  const size_t tok0 = tokb + t0;
  bf16* QLh = QL + half * 16 * 2048;
  bf16* OLh = QLh;
  if (t0 >= 256) {
    DSA_IDS
    bf16x8_t qf[8][2];
    float iw[8];
#pragma unroll
    for (int h = 0; h < 8; ++h) {
      qf[h][0] = *(const bf16x8_t*)(IQ + (((tok0 >> 4) * 16 + h * 2) * 64 + lane) * 8);
      qf[h][1] = *(const bf16x8_t*)(IQ + (((tok0 >> 4) * 16 + h * 2 + 1) * 64 + lane) * 8);
      iw[h] = IW[(tok0 + c) * 8 + h];
    }
    const int ntile = (t0 >> 4) + 1;
    bf16x8_t k0n = (bf16x8_t){0, 0, 0, 0, 0, 0, 0, 0}, k1n = k0n;
    if (wave < ntile) { const bf16* kr = IK + ((((tokb >> 4) + wave) * 2) * 64 + lane) * 8; k0n = *(const bf16x8_t*)kr; k1n = *(const bf16x8_t*)(kr + 512); }
    for (int kt = wave; kt < ntile; kt += 8) {
      const bf16x8_t k0 = k0n, k1 = k1n;
      { const int ktn = (kt + 8 < ntile) ? kt + 8 : kt; const bf16* kr = IK + ((((tokb >> 4) + ktn) * 2) * 64 + lane) * 8; k0n = *(const bf16x8_t*)kr; k1n = *(const bf16x8_t*)(kr + 512); }
      f32x4 sc = (f32x4){0.f, 0.f, 0.f, 0.f};
#pragma unroll
      for (int h = 0; h < 8; ++h) {
        f32x4 d = __builtin_amdgcn_mfma_f32_16x16x32_bf16(k0, qf[h][0], (f32x4){0.f, 0.f, 0.f, 0.f}, 0, 0, 0);
        d = __builtin_amdgcn_mfma_f32_16x16x32_bf16(k1, qf[h][1], d, 0, 0, 0);
#pragma unroll
        for (int i = 0; i < 4; ++i) sc[i] += iw[h] * fmaxf(d[i], 0.f);
      }
      u16x4_t o;
      const int sb = kt * 16 + 4 * g, tq = t0 + c;
      o.x = (sb + 0 <= tq) ? (unsigned short)(f2ord(sc[0]) >> 16) : (unsigned short)0;
      o.y = (sb + 1 <= tq) ? (unsigned short)(f2ord(sc[1]) >> 16) : (unsigned short)0;
      o.z = (sb + 2 <= tq) ? (unsigned short)(f2ord(sc[2]) >> 16) : (unsigned short)0;
      o.w = (sb + 3 <= tq) ? (unsigned short)(f2ord(sc[3]) >> 16) : (unsigned short)0;
      *(LAS u16x4_t*)(key16 + c * 4096 + sb) = o;
    }
  }
  DSA_MARK(2);
  __syncthreads();
#pragma unroll 1
  for (int qq = 0; qq < 2; ++qq) {
    DSA_IDS
    const int q = wave + 8 * qq, t = t0 + q;
    LAS unsigned short* selq = sel + q * 256;
    if (t < 256) {
      for (int j = lane; j < 256; j += 64) selq[j] = (unsigned short)((j <= t) ? j : 0);
    } else {
      const LAS unsigned short* kq = key16 + q * 4096;
      const int nit = (t >> 9) + 1;
      unsigned kp[8][4];
#pragma unroll
      for (int it = 0; it < 8; ++it) {
        const int s0 = 512 * it + 8 * lane;
        u32x4_t v = (u32x4_t){0u, 0u, 0u, 0u};
        if (s0 <= t) v = *(const LAS u32x4_t*)(kq + s0);
#pragma unroll
        for (int j = 0; j < 4; ++j) {
          const unsigned lo = (s0 + 2 * j <= t) ? (v[j] & 0xffffu) : 0u, hi = (s0 + 2 * j + 1 <= t) ? (v[j] & 0xffff0000u) : 0u;
          kp[it][j] = lo | hi;
        }
      }
      asm volatile("" :: "v"(kp[0][0]), "v"(kp[7][3]));
      DSA_MARKI(21);
      unsigned B = 0u;
#pragma unroll 1
      for (int bit = 15; bit >= 0; --bit) {
        const unsigned cand = B | (1u << bit);
        const unsigned c2 = (cand - 1u) * 0x00010001u;
        unsigned cnt2 = 0u;
#pragma unroll
        for (int it = 0; it < 8; ++it) {
          if (it < nit) {
#pragma unroll
            for (int j = 0; j < 4; ++j) {
              unsigned dd;
              asm("v_pk_sub_u16 %0, %1, %2 clamp\n\tv_pk_min_u16 %0, %0, %3" : "=&v"(dd) : "v"(kp[it][j]), "v"(c2), "v"(0x00010001u));
              cnt2 += dd;
            }
          }
        }
        const int tot = (int)wave_sum_dpp((float)((cnt2 & 0xffffu) + (cnt2 >> 16)));
        if (tot >= 256) B = cand;
      }
      int cgt = 0;
#pragma unroll
      for (int it = 0; it < 8; ++it)
#pragma unroll
        for (int j = 0; j < 4; ++j) cgt += (((kp[it][j] & 0xffffu) > B) ? 1 : 0) + (((kp[it][j] >> 16) > B) ? 1 : 0);
      const int m = 256 - (int)wave_sum_dpp((float)cgt);
      DSA_MARKI(22);
      int base = 0, eqbase = 0;
#pragma unroll
      for (int it = 0; it < 8; ++it) {
        if (it < nit) {
          unsigned kk[8];
#pragma unroll
          for (int j = 0; j < 4; ++j) { kk[2 * j] = kp[it][j] & 0xffffu; kk[2 * j + 1] = kp[it][j] >> 16; }
          unsigned anyeq = 0u;
#pragma unroll
          for (int j = 0; j < 8; ++j) anyeq |= (kk[j] == B) ? 1u : 0u;
          int eqlow = 0, eqtot = 0;
          if (__builtin_amdgcn_ballot_w64(anyeq != 0u) != 0ull) {
#pragma unroll
            for (int j = 0; j < 8; ++j) {
              const unsigned long long mk = __builtin_amdgcn_ballot_w64(kk[j] == B);
              eqlow += (int)__builtin_amdgcn_mbcnt_hi((unsigned)(mk >> 32), __builtin_amdgcn_mbcnt_lo((unsigned)mk, 0u));
              eqtot += __builtin_popcountll(mk);
            }
          }
          int eqr = eqbase + eqlow;
          int ps = base, tot = 0;
          bool tk[8];
#pragma unroll
          for (int j = 0; j < 8; ++j) {
            const bool eq = kk[j] == B;
            tk[j] = (kk[j] > B) || (eq && eqr < m);
            eqr += eq ? 1 : 0;
          }
#pragma unroll
          for (int j = 0; j < 8; ++j) {
            const unsigned long long mk = __builtin_amdgcn_ballot_w64(tk[j]);
            ps += (int)__builtin_amdgcn_mbcnt_hi((unsigned)(mk >> 32), __builtin_amdgcn_mbcnt_lo((unsigned)mk, 0u));
            tot += __builtin_popcountll(mk);
          }
#pragma unroll
          for (int j = 0; j < 8; ++j) {
            if (tk[j]) { if (ps < 256) selq[ps] = (unsigned short)(512 * it + 8 * lane + j); ++ps; }
          }
          base += tot;
          eqbase += eqtot;
        }
      }
    }
  }
  DSA_MARK(3);
  __syncthreads();
  {
    DSA_IDS
    const int wave_b = wave;
    const float slope = (c < 8) ? exp2f(-(float)(c + 1)) : 0.f;
#pragma unroll 1
    for (int qq = 0; qq < 2; ++qq) {
      const int q = wave + 8 * qq, t = t0 + q;
      const int nsel = (t + 1 < 256) ? (t + 1) : 256, nch = (nsel + 31) >> 5;
      const LAS unsigned short* selq = sel + q * 256;
      bf16x8_t qf[8];
      {
        const int lq = tid_fresh() & 63;
        const bf16* qlp = QLh + q * 2048 + (lq & 7) * 256 + 8 * (lq >> 4);
#pragma unroll
        for (int ks = 0; ks < 8; ++ks) qf[ks] = *(const bf16x8_t*)(qlp + ks * 32);
      }
      float mrun = -1e30f, lrun = 0.f;
      f32x4 o[16];
#pragma unroll
      for (int nt = 0; nt < 16; ++nt) o[nt] = (f32x4){0.f, 0.f, 0.f, 0.f};
      u32x4_t st[16];
      f32x4 st_ss = (f32x4){0.f, 0.f, 0.f, 0.f}; float st_d = -1.f;
#define DSA_ISSUE(ch)                                                                                   \
      {          \
        _Pragma("unroll") for (int r = 0; r < 16; ++r) {                                                \
          const int idx = (int)selq[(ch) * 32 + 2 * r + (lane >> 5)];                                   \
          st[r] = *(const u32x4_t*)(CKV + (tokb + idx) * 256 + (lane & 31) * 8);                        \
        }                                                                                               \
        const int j2 = (ch) * 32 + (lane & 31);                                                         \
        const int idx2 = (int)selq[j2];                                                                 \
        st_ss = *(const f32x4*)(SSP + (tokb + idx2) * 4);                                               \
        st_d = (j2 < nsel) ? (float)(t - idx2) : -1.f;                                                  \
      }
      DSA_ISSUE(0);
#pragma unroll 1
      for (int ch = 0; ch < nch; ++ch) {
        const int lane = tid_fresh() & 63, g = lane >> 4, c = lane & 15;
        LAS unsigned char* buf = lds + DS_KEY16 + wave_b * DS_CHUNK;
        LAS float* kr = (LAS float*)(lds + DS_WAVE + wave_b * 1024);
        LAS float* kd = kr + 32;
        const unsigned vb = (unsigned)(uintptr_t)buf + (unsigned)((4 * g + (c >> 2)) * DS_RS + 8 * (c & 3));
#pragma unroll
        for (int r = 0; r < 16; ++r) *(LAS u32x4_t*)(buf + (2 * r + (lane >> 5)) * DS_RS + (lane & 31) * 16) = st[r];
        if (lane < 32) { kr[lane] = rsqrtf(((st_ss[0] + st_ss[1]) + (st_ss[2] + st_ss[3])) * (1.f / 256.f) + 1e-6f); kd[lane] = st_d; }
        wave_lds_fence();
        DSA_MARKI(11);
        DSA_ISSUE((ch + 1 < nch) ? ch + 1 : ch);
        f32x4 s0 = (f32x4){0.f, 0.f, 0.f, 0.f}, s1 = (f32x4){0.f, 0.f, 0.f, 0.f};
#pragma unroll
        for (int ks = 0; ks < 8; ++ks) {
          const bf16x8_t a0 = *(const LAS bf16x8_t*)(buf + c * DS_RS + (ks * 32 + 8 * g) * 2);
          const bf16x8_t a1 = *(const LAS bf16x8_t*)(buf + (16 + c) * DS_RS + (ks * 32 + 8 * g) * 2);
          s0 = __builtin_amdgcn_mfma_f32_16x16x32_bf16(a0, qf[ks], s0, 0, 0, 0);
          s1 = __builtin_amdgcn_mfma_f32_16x16x32_bf16(a1, qf[ks], s1, 0, 0, 0);
        }
        asm volatile("" :: "v"(s0[0]), "v"(s1[0]));
        DSA_MARKI(12);
        const f32x4 r0 = *(const LAS f32x4*)(kr + 4 * g), r1 = *(const LAS f32x4*)(kr + 16 + 4 * g);
        const f32x4 d0 = *(const LAS f32x4*)(kd + 4 * g), d1 = *(const LAS f32x4*)(kd + 16 + 4 * g);
        float x[8];
#pragma unroll
        for (int i = 0; i < 4; ++i) {
          x[i] = (d0[i] < 0.f) ? -1e30f : (s0[i] * r0[i] - slope * d0[i]);
          x[4 + i] = (d1[i] < 0.f) ? -1e30f : (s1[i] * r1[i] - slope * d1[i]);
        }
        float mx = fmaxf(fmaxf(fmaxf(x[0], x[1]), fmaxf(x[2], x[3])), fmaxf(fmaxf(x[4], x[5]), fmaxf(x[6], x[7])));
        mx = xrow_max(mx);
        const float mn = fmaxf(mrun, mx);
        const float alpha = __expf(mrun - mn);
        mrun = mn;
        float pr[8], ps = 0.f;
#pragma unroll
        for (int i = 0; i < 8; ++i) { pr[i] = (x[i] <= -1e29f) ? 0.f : __expf(x[i] - mn); ps += pr[i]; }
        ps = xrow_sum(ps);
        lrun = lrun * alpha + ps;
        if (__builtin_amdgcn_ballot_w64(alpha != 1.f) != 0ull) {
#pragma unroll
          for (int nt = 0; nt < 16; ++nt) o[nt] *= alpha;
        }
        union { bf16x8_t v; unsigned u[4]; } pf;
        pf.u[0] = pk2(pr[0] * r0[0], pr[1] * r0[1]); pf.u[1] = pk2(pr[2] * r0[2], pr[3] * r0[3]);
        pf.u[2] = pk2(pr[4] * r1[0], pr[5] * r1[1]); pf.u[3] = pk2(pr[6] * r1[2], pr[7] * r1[3]);
        asm volatile("" :: "v"(pf.u[0]));
        DSA_MARKI(13);
        {
          s16x4_t loA[4], hiA[4], loB[4], hiB[4];
#define PV_READ(L, H, nt0) _Pragma("unroll") for (int u = 0; u < 4; ++u) { L[u] = tr_read_b64(vb + ((nt0) + u) * 32); H[u] = tr_read_b64(vb + ((nt0) + u) * 32 + 16 * DS_RS); }
#define PV_MMA(L, H, nt0) _Pragma("unroll") for (int u = 0; u < 4; ++u) { \
            const bf16x8_t af = (bf16x8_t){L[u][0], L[u][1], L[u][2], L[u][3], H[u][0], H[u][1], H[u][2], H[u][3]}; \
            o[(nt0) + u] = __builtin_amdgcn_mfma_f32_16x16x32_bf16(af, pf.v, o[(nt0) + u], 0, 0, 0); }
          PV_READ(loA, hiA, 0);
          PV_READ(loB, hiB, 4);
          asm volatile("s_waitcnt lgkmcnt(8)" ::: "memory"); __builtin_amdgcn_sched_barrier(0);
          PV_MMA(loA, hiA, 0); __builtin_amdgcn_sched_barrier(0);
          PV_READ(loA, hiA, 8);
          asm volatile("s_waitcnt lgkmcnt(8)" ::: "memory"); __builtin_amdgcn_sched_barrier(0);
          PV_MMA(loB, hiB, 4); __builtin_amdgcn_sched_barrier(0);
          PV_READ(loB, hiB, 12);
          asm volatile("s_waitcnt lgkmcnt(8)" ::: "memory"); __builtin_amdgcn_sched_barrier(0);
          PV_MMA(loA, hiA, 8); __builtin_amdgcn_sched_barrier(0);
          asm volatile("s_waitcnt lgkmcnt(0)" ::: "memory"); __builtin_amdgcn_sched_barrier(0);
          PV_MMA(loB, hiB, 12);
#undef PV_READ
#undef PV_MMA
        }
        wave_lds_fence();
        asm volatile("" :: "v"(o[0][0]), "v"(o[15][0]));
        DSA_MARKI(14);
      }
#undef DSA_ISSUE
      if (c < 8) {
        const float inv = 1.f / lrun;
#pragma unroll
        for (int nt = 0; nt < 16; ++nt) {
          uint2 w; w.x = pk2(o[nt][0] * inv, o[nt][1] * inv); w.y = pk2(o[nt][2] * inv, o[nt][3] * inv);
          *(uint2*)(OLh + q * 2048 + c * 256 + nt * 16 + 4 * g) = w;
        }
      }
    }
  }
  DSA_MARK(4);
  __syncthreads();
  }
  {
    DSA_IDS
    const int h = wave;
    bf16x8_t of0[8], of1[8];
#pragma unroll
    for (int ks = 0; ks < 8; ++ks) {
      of0[ks] = *(const bf16x8_t*)(OL + c * 2048 + h * 256 + ks * 32 + 8 * g);
      of1[ks] = *(const bf16x8_t*)(OL + (16 + c) * 2048 + h * 256 + ks * 32 + 8 * g);
    }
#pragma unroll 1
    for (int np = 0; np < 2; ++np) {
      bf16x8_t wf[4][8];
#pragma unroll
      for (int n4 = 0; n4 < 4; ++n4)
#pragma unroll
        for (int ks = 0; ks < 8; ++ks) wf[n4][ks] = *(const bf16x8_t*)(WUV + (size_t)((h * 8 + np * 4 + n4) * 8 + ks) * 512 + lane * 8);
      __builtin_amdgcn_sched_barrier(0);
#pragma unroll
      for (int n4 = 0; n4 < 4; ++n4) {
        const int nt = np * 4 + n4;
        f32x4 a0 = (f32x4){0.f, 0.f, 0.f, 0.f}, a1 = a0;
#pragma unroll
        for (int ks = 0; ks < 8; ++ks) {
          a0 = __builtin_amdgcn_mfma_f32_16x16x32_bf16(wf[n4][ks], of0[ks], a0, 0, 0, 0);
          a1 = __builtin_amdgcn_mfma_f32_16x16x32_bf16(wf[n4][ks], of1[ks], a1, 0, 0, 0);
        }
        uint2 w; w.x = pk2(a0[0], a0[1]); w.y = pk2(a0[2], a0[3]);
        *(uint2*)(ODSA + (tok00 + c) * 1024 + h * 128 + nt * 16 + 4 * g) = w;
        w.x = pk2(a1[0], a1[1]); w.y = pk2(a1[2], a1[3]);
        *(uint2*)(ODSA + (tok00 + 16 + c) * 1024 + h * 128 + nt * 16 + 4 * g) = w;
      }
      __builtin_amdgcn_sched_barrier(0);
    }
  }
  DSA_MARK(5);
  __syncthreads();
}

#undef DSA_IDS
__device__ __forceinline__ void ph_dsa512(const P& p, unsigned char* lds_raw) {
  for (int it = blockIdx.x; it < TT / 16; it += gridDim.x) {
    const int k = it >> 8, j = it & 255;
    dsa_batch(p, lds_raw, k, ((k & 1) ? 255 - j : j) >> 1);
  }
}

#define GL_QD    0
#define GL_KI    18432
#define GL_KE    36864
#define GL_V     55296
#define GL_AT    90112
#define GL_GLOW  99328
#define GL_QT    103424
#define GL_DEC   105472
#define GL_SSQ   105984
#define GL_LB    108032
#define GL_TOTAL 140800

#define GLA_BAR() do { asm volatile("s_waitcnt lgkmcnt(0)" ::: "memory"); __builtin_amdgcn_s_barrier(); asm volatile("" ::: "memory"); } while (0)
#ifndef PROBE_GLA
#define PROBE_GLA 0
#endif
#if PROBE_GLA
#define GLA_MARK(k) do { const unsigned long long n_ = __builtin_amdgcn_s_memrealtime(); if (PROBE_GLA == (k)) { const unsigned long long q_ = n_ - tmark; \
    while (__builtin_amdgcn_s_memrealtime() - n_ < q_) __builtin_amdgcn_s_sleep(2); } tmark = __builtin_amdgcn_s_memrealtime(); } while (0)
#else
#define GLA_MARK(k) do {} while (0)
#endif
__device__ __forceinline__ void gla_item(const P& p, unsigned char* lds_raw, int item) {
  int tid = tid_fresh();
  const int b = item >> 2, h = item & 3;
  const size_t tokb = (size_t)b * SEQ;
  const bf16* Qg = (const bf16*)(p.ws + OFF_Q);
  const bf16* Kg = (const bf16*)(p.ws + OFF_K);
  bf16* Vg = (bf16*)(p.ws + OFF_V);
  const float* GLOWg = (const float*)(p.ws + OFF_GLOW);
  const bf16* SGR = (const bf16*)(p.ws + OFF_SGR);
  LAS unsigned char* lds = (LAS unsigned char*)lds_raw;
  const unsigned lds0 = (unsigned)(uintptr_t)lds;
  LAS float* QT = (LAS float*)(lds + GL_QT);
  LAS float* DEC = (LAS float*)(lds + GL_DEC);
  LAS float* SSQ = (LAS float*)(lds + GL_SSQ);
  float wg[16];
  const float* prm = (const float*)(p.ws + OFF_PRM);
#pragma unroll
  for (int r = 0; r < 16; ++r) wg[r] = prm[PRM_WGU + r * 512 + h * 128 + (tid & 127)];
  const float bg = prm[PRM_BG + h * 128 + (tid & 127)];
  const float gn0 = prm[PRM_GNG + h * 256 + 32 * (tid >> 6) + (tid & 15)], gn1 = prm[PRM_GNG + h * 256 + 32 * (tid >> 6) + 16 + (tid & 15)];
  u32x4_t rq[2], rk[2], rv[4], rg = (u32x4_t){0u, 0u, 0u, 0u};
#define GLA_LOAD(ch)                                                                                      \
  {                                                                                                       \
    const size_t tb = tokb + (size_t)(ch) * 64;                                                           \
    _Pragma("unroll") for (int i = 0; i < 2; ++i) {                                                       \
      const int id = tid + 512 * i, tk = id >> 4, part = id & 15;                                         \
      rq[i] = *(const u32x4_t*)(Qg + (tb + tk) * 512 + h * 128 + part * 8);                               \
      rk[i] = *(const u32x4_t*)(Kg + (tb + tk) * 512 + h * 128 + part * 8);                               \
    }                                                                                                     \
    _Pragma("unroll") for (int i = 0; i < 4; ++i) {                                                       \
      const int id = tid + 512 * i, tk = id >> 5, part = id & 31;                                         \
      rv[i] = *(const u32x4_t*)(Vg + (tb + tk) * 1024 + h * 256 + part * 8);                              \
    }                                                                                                     \
    if (tid < 256) rg = *(const u32x4_t*)(GLOWg + (tb + (tid >> 2)) * 16 + (tid & 3) * 4);                \
  }
  f32x4 S[8][2];
#pragma unroll
  for (int a = 0; a < 8; ++a) { S[a][0] = (f32x4){0.f, 0.f, 0.f, 0.f}; S[a][1] = (f32x4){0.f, 0.f, 0.f, 0.f}; }
  GLA_LOAD(0);
#if PROBE_GLA
  unsigned long long tmark = __builtin_amdgcn_s_memrealtime();
#endif
#pragma unroll 1
  for (int ch = 0; ch < SEQ / 64; ++ch) {
    asm volatile("" : "+v"(tid));
    const int wave = __builtin_amdgcn_readfirstlane(tid >> 6), lane = tid & 63, g = lane >> 4, c = lane & 15;
    const int d = tid & 127, tq = __builtin_amdgcn_readfirstlane(tid >> 7);
    const unsigned vtr = lds0 + GL_V + (unsigned)((8 * g + (c >> 2)) * 544 + (32 * wave + 4 * (c & 3)) * 2);
    const unsigned ketr = lds0 + GL_KE + (unsigned)((8 * g + (c >> 2)) * 288 + (4 * (c & 3)) * 2);
    const size_t tb = tokb + (size_t)ch * 64;
#pragma unroll
    for (int i = 0; i < 2; ++i) {
      const int id = tid + 512 * i, tk = id >> 4, part = id & 15;
      *(LAS u32x4_t*)(lds + GL_QD + tk * 288 + part * 16) = rq[i];
      *(LAS u32x4_t*)(lds + GL_KI + tk * 288 + part * 16) = rk[i];
    }
#pragma unroll
    for (int i = 0; i < 4; ++i) {
      const int id = tid + 512 * i, tk = id >> 5, part = id & 31;
      *(LAS u32x4_t*)(lds + GL_V + tk * 544 + part * 16) = rv[i];
    }
    if (tid < 256) *(LAS u32x4_t*)(lds + GL_GLOW + (tid >> 2) * 64 + (tid & 3) * 16) = rg;
    GLA_MARK(1); GLA_BAR();
    GLA_LOAD((ch + 1 < SEQ / 64) ? ch + 1 : ch);
    u32x4_t rs[4];
#pragma unroll
    for (int i = 0; i < 4; ++i) {
      const int id = tid + 512 * i, tk = id >> 5, part = id & 31;
      rs[i] = *(const u32x4_t*)(SGR + (tb + tk) * 1024 + h * 256 + part * 8);
    }
    LAS float* LB = (LAS float*)(lds + GL_LB);
    float run = 0.f;
#pragma unroll 2
    for (int i = 0; i < 16; ++i) {
      const LAS f32x4* gp = (const LAS f32x4*)(lds + GL_GLOW + (16 * tq + i) * 64);
      const f32x4 g0 = gp[0], g1 = gp[1], g2 = gp[2], g3 = gp[3];
      float gl = bg;
      gl += g0[0] * wg[0] + g0[1] * wg[1] + g0[2] * wg[2] + g0[3] * wg[3];
      gl += g1[0] * wg[4] + g1[1] * wg[5] + g1[2] * wg[6] + g1[3] * wg[7];
      gl += g2[0] * wg[8] + g2[1] * wg[9] + g2[2] * wg[10] + g2[3] * wg[11];
      gl += g3[0] * wg[12] + g3[1] * wg[13] + g3[2] * wg[14] + g3[3] * wg[15];
      const float ls = fminf(gl, 0.f) - __logf(1.f + __expf(-fabsf(gl)));
      run += ls * (1.f / 16.f);
      LB[(16 * tq + i) * 128 + d] = run;
    }
    QT[tq * 128 + d] = run;
    GLA_MARK(2); GLA_BAR();
    {
      float off = 0.f, tot = 0.f;
#pragma unroll
      for (int k = 0; k < 4; ++k) { const float v = QT[k * 128 + d]; tot += v; off += (k < tq) ? v : 0.f; }
      const float eb = __expf(tot);
#pragma unroll 2
      for (int i = 0; i < 16; ++i) {
        const int t = 16 * tq + i;
        const float bb = LB[t * 128 + d] + off;
        const float e = __expf(bb), r = __expf(-bb);
        LAS bf16* qp = (LAS bf16*)(lds + GL_QD + t * 288) + d;
        LAS bf16* kp = (LAS bf16*)(lds + GL_KI + t * 288) + d;
        LAS bf16* ep = (LAS bf16*)(lds + GL_KE + t * 288) + d;
        const float q = bf2f(*qp), k = bf2f(*kp);
        *qp = f2bf(q * e);
        *kp = f2bf(k * r);
        *ep = f2bf(k * (eb * r));
      }
      if (tq == 0) DEC[d] = eb;
    }
    GLA_MARK(3); GLA_BAR();
    {
      const int ti = wave >> 1;
#pragma unroll
      for (int u = 0; u < 2; ++u) {
        const int tj = 2 * (wave & 1) + u;
        f32x4 acc = (f32x4){0.f, 0.f, 0.f, 0.f};
        if (tj <= ti) {
#pragma unroll
          for (int ks = 0; ks < 4; ++ks) {
            const bf16x8_t a = *(const LAS bf16x8_t*)(lds + GL_QD + (16 * ti + c) * 288 + (32 * ks + 8 * g) * 2);
            const bf16x8_t bb = *(const LAS bf16x8_t*)(lds + GL_KI + (16 * tj + c) * 288 + (32 * ks + 8 * g) * 2);
            acc = __builtin_amdgcn_mfma_f32_16x16x32_bf16(a, bb, acc, 0, 0, 0);
          }
        }
#pragma unroll
        for (int r = 0; r < 4; ++r) {
          const int i = 16 * ti + 4 * g + r, j = 16 * tj + c;
          *((LAS bf16*)(lds + GL_AT + i * 144) + j) = f2bf((j <= i) ? acc[r] : 0.f);
        }
      }
    }
    GLA_MARK(4); GLA_BAR();
    f32x4 o[4][2];
    {
      bf16x8_t vf[2][2];
      {
        s16x4_t lo[4], hi[4];
#pragma unroll
        for (int ks = 0; ks < 2; ++ks)
#pragma unroll
          for (int tn = 0; tn < 2; ++tn) {
            lo[ks * 2 + tn] = tr_read_b64(vtr + (32 * ks) * 544 + tn * 32);
            hi[ks * 2 + tn] = tr_read_b64(vtr + (32 * ks + 4) * 544 + tn * 32);
          }
        asm volatile("s_waitcnt lgkmcnt(0)" ::: "memory");
        __builtin_amdgcn_sched_barrier(0);
#pragma unroll
        for (int u = 0; u < 4; ++u)
          vf[u >> 1][u & 1] = (bf16x8_t){lo[u][0], lo[u][1], lo[u][2], lo[u][3], hi[u][0], hi[u][1], hi[u][2], hi[u][3]};
      }
#pragma unroll
      for (int tm = 0; tm < 4; ++tm) { o[tm][0] = (f32x4){0.f, 0.f, 0.f, 0.f}; o[tm][1] = (f32x4){0.f, 0.f, 0.f, 0.f}; }
#pragma unroll
      for (int tm = 0; tm < 4; ++tm)
#pragma unroll
        for (int ks = 0; ks < 2; ++ks) {
          if (ks == 1 && tm < 2) continue;
          const bf16x8_t a = *(const LAS bf16x8_t*)(lds + GL_AT + (16 * tm + c) * 144 + (32 * ks + 8 * g) * 2);
          o[tm][0] = __builtin_amdgcn_mfma_f32_16x16x32_bf16(a, vf[ks][0], o[tm][0], 0, 0, 0);
          o[tm][1] = __builtin_amdgcn_mfma_f32_16x16x32_bf16(a, vf[ks][1], o[tm][1], 0, 0, 0);
          __builtin_amdgcn_sched_barrier(0);
        }
#pragma unroll
      for (int u = 0; u < 4; ++u) {
        union { bf16x8_t v; unsigned w[4]; } s0, s1;
        s0.w[0] = pk2(S[2 * u][0][0], S[2 * u][0][1]); s0.w[1] = pk2(S[2 * u][0][2], S[2 * u][0][3]);
        s0.w[2] = pk2(S[2 * u + 1][0][0], S[2 * u + 1][0][1]); s0.w[3] = pk2(S[2 * u + 1][0][2], S[2 * u + 1][0][3]);
        s1.w[0] = pk2(S[2 * u][1][0], S[2 * u][1][1]); s1.w[1] = pk2(S[2 * u][1][2], S[2 * u][1][3]);
        s1.w[2] = pk2(S[2 * u + 1][1][0], S[2 * u + 1][1][1]); s1.w[3] = pk2(S[2 * u + 1][1][2], S[2 * u + 1][1][3]);
#pragma unroll
        for (int tm = 0; tm < 4; ++tm) {
          const LAS unsigned char* qrow = lds + GL_QD + (16 * tm + c) * 288 + (32 * u + 4 * g) * 2;
          const s16x4_t q0 = *(const LAS s16x4_t*)qrow, q1 = *(const LAS s16x4_t*)(qrow + 32);
          const bf16x8_t a = (bf16x8_t){q0[0], q0[1], q0[2], q0[3], q1[0], q1[1], q1[2], q1[3]};
          o[tm][0] = __builtin_amdgcn_mfma_f32_16x16x32_bf16(a, s0.v, o[tm][0], 0, 0, 0);
          o[tm][1] = __builtin_amdgcn_mfma_f32_16x16x32_bf16(a, s1.v, o[tm][1], 0, 0, 0);
        }
        __builtin_amdgcn_sched_barrier(0);
      }
#pragma unroll
      for (int tk = 0; tk < 8; ++tk) {
        const f32x4 dec4 = *(const LAS f32x4*)(DEC + 16 * tk + 4 * g);
        S[tk][0] *= dec4; S[tk][1] *= dec4;
        s16x4_t lo0 = tr_read_b64(ketr + tk * 32), hi0 = tr_read_b64(ketr + 4 * 288 + tk * 32);
        s16x4_t lo1 = tr_read_b64(ketr + 32 * 288 + tk * 32), hi1 = tr_read_b64(ketr + 36 * 288 + tk * 32);
        asm volatile("s_waitcnt lgkmcnt(0)" ::: "memory");
        __builtin_amdgcn_sched_barrier(0);
        const bf16x8_t a0 = (bf16x8_t){lo0[0], lo0[1], lo0[2], lo0[3], hi0[0], hi0[1], hi0[2], hi0[3]};
        const bf16x8_t a1 = (bf16x8_t){lo1[0], lo1[1], lo1[2], lo1[3], hi1[0], hi1[1], hi1[2], hi1[3]};
        S[tk][0] = __builtin_amdgcn_mfma_f32_16x16x32_bf16(a0, vf[0][0], S[tk][0], 0, 0, 0);
        S[tk][1] = __builtin_amdgcn_mfma_f32_16x16x32_bf16(a0, vf[0][1], S[tk][1], 0, 0, 0);
        S[tk][0] = __builtin_amdgcn_mfma_f32_16x16x32_bf16(a1, vf[1][0], S[tk][0], 0, 0, 0);
        S[tk][1] = __builtin_amdgcn_mfma_f32_16x16x32_bf16(a1, vf[1][1], S[tk][1], 0, 0, 0);
        __builtin_amdgcn_sched_barrier(0);
      }
#pragma unroll
      for (int tm = 0; tm < 4; ++tm)
#pragma unroll
        for (int r = 0; r < 4; ++r) {
          float ss = o[tm][0][r] * o[tm][0][r] + o[tm][1][r] * o[tm][1][r];
          ss = row16_sum(ss);
          if (c == 0) SSQ[(16 * tm + 4 * g + r) * 8 + wave] = ss;
        }
    }
    GLA_MARK(5); GLA_BAR();
    {
      LAS bf16* OB = (LAS bf16*)(lds + GL_LB);
#pragma unroll
      for (int tm = 0; tm < 4; ++tm)
#pragma unroll
        for (int r = 0; r < 4; ++r) {
          const int t = 16 * tm + 4 * g + r;
          const f32x4 p0 = *(const LAS f32x4*)(SSQ + t * 8), p1 = *(const LAS f32x4*)(SSQ + t * 8 + 4);
          const float tot = ((p0[0] + p0[1]) + (p0[2] + p0[3])) + ((p1[0] + p1[1]) + (p1[2] + p1[3]));
          const float rstd = rsqrtf(tot * (1.f / 256.f) + 1e-6f);
          OB[t * 256 + 32 * wave + c] = f2bf(o[tm][0][r] * rstd * gn0);
          OB[t * 256 + 32 * wave + 16 + c] = f2bf(o[tm][1][r] * rstd * gn1);
        }
    }
    GLA_MARK(6); GLA_BAR();
#pragma unroll
    for (int i = 0; i < 4; ++i) {
      const int id = tid + 512 * i, tk = id >> 5, part = id & 31;
      const u32x4_t ov = *(const LAS u32x4_t*)(lds + GL_LB + tk * 512 + part * 16);
      const u32x4_t sv = rs[i];
      u32x4_t gv;
      gv[0] = pk2(bflo(ov[0]) * bflo(sv[0]), bfhi(ov[0]) * bfhi(sv[0]));
      gv[1] = pk2(bflo(ov[1]) * bflo(sv[1]), bfhi(ov[1]) * bfhi(sv[1]));
      gv[2] = pk2(bflo(ov[2]) * bflo(sv[2]), bfhi(ov[2]) * bfhi(sv[2]));
      gv[3] = pk2(bflo(ov[3]) * bflo(sv[3]), bfhi(ov[3]) * bfhi(sv[3]));
      *(u32x4_t*)(Vg + (tb + tk) * 1024 + h * 256 + part * 8) = gv;
    }
    GLA_MARK(7);
  }
#undef GLA_LOAD
  __syncthreads();
}

#define LDS_BYTES 155712
#define OFF_XBAR (224ull * 1024)
#define OFF_CTR (200ull * 1024)

__device__ __forceinline__ unsigned xcc_id() { return (unsigned)__builtin_amdgcn_s_getreg((3 << 11) | 20) & 0x7u; }
__device__ __forceinline__ void ph_mixer(const P& p, unsigned char* lds_raw, bool do_gla) {
  if (do_gla && blockIdx.x < 32) { gla_item(p, lds_raw, blockIdx.x); if (blockIdx.x == 0) TS_SET(p, 20); }
  unsigned* ctr = (unsigned*)(p.ws + OFF_CTR);
  LAS unsigned* slot = (LAS unsigned*)((LAS unsigned char*)lds_raw + DS_TOTAL);
  const unsigned home = xcc_id();
  unsigned k = 0;
  for (;;) {
    if (tid_fresh() == 0) {
      unsigned qi = 0xffffffffu;
      while (k < 8) {
        const unsigned b = (home + k) & 7u;
        const unsigned v = __hip_atomic_fetch_add(ctr + 64 * b, 1u, __ATOMIC_RELAXED, __HIP_MEMORY_SCOPE_AGENT);
        if (v < 128u) { qi = (b << 8) | v; break; }
        ++k;
      }
      slot[0] = qi; slot[1] = k;
    }
    __syncthreads();
    const unsigned qi = slot[0];
    k = slot[1];
    __syncthreads();
    if (qi == 0xffffffffu) break;
    dsa_batch(p, lds_raw, (int)(qi >> 8), 127 - (int)(qi & 255u));
  }
}

__global__ void __launch_bounds__(512, 2) mega(P p) {
  extern __shared__ __attribute__((aligned(16))) unsigned char lds_raw[];
  LAS unsigned char* lds = (LAS unsigned char*)lds_raw;
  cg::grid_group grid = cg::this_grid();
  char* ws = p.ws;
  const int bid = blockIdx.x, nb = gridDim.x;
  if (bid == 0 && threadIdx.x < 8) *(unsigned*)(ws + OFF_CTR + 256 * threadIdx.x) = 0u;
  if (bid == 0) { for (int i = threadIdx.x; i < XCD_BAR_WORDS; i += 512) ((unsigned*)(ws + OFF_XBAR))[i] = 0u; }
  volatile LAS unsigned* xst = (volatile LAS unsigned*)(lds + DS_TOTAL + 16);
  if (threadIdx.x < 4) xst[threadIdx.x] = 0u;
#if PROBE_TS
  { const int t_ = tid_fresh(); if (bid == 0 && t_ < 64) ((unsigned long long*)(ws + OFF_TS))[t_] = 0ull; }
  __syncthreads();
  if (bid == 0) TS_SET(p, 0);
#endif
  ph_prep(p, (float*)lds_raw);
  grid.sync();
  const XcdBarrier xb = xcd_barrier_post((unsigned*)(ws + OFF_XBAR), xst);
  if (bid == 0) TS_SET(p, 1);
  ph_mod(p, p.x, p.norm1_g, 0, 1024, (bf16*)(ws + OFF_H), bid, nb);
  xcd_barrier(xb);
  if (bid == 0) TS_SET(p, 2);
  gemm_run(lds, (const bf16*)(ws + OFF_H), (const bf16*)(ws + OFF_WT_IN), TT, 7168, 1024, EpiIn{ws, p.out});
  xcd_barrier(xb);
  if (bid == 0) TS_SET(p, 3);
  ph_mixer(p, lds_raw, true);
  if (bid == 0) TS_SET(p, 21);
  xcd_barrier(xb);
  if (bid == 0) TS_SET(p, 4);
  gemm_run(lds, (const bf16*)(ws + OFF_V), (const bf16*)(ws + OFF_WT_A), TT, 1024, 1024,
           EpiMix<false>{(const bf16*)p.out, (bf16*)(ws + OFF_MIX)});
  gemm_run(lds, (const bf16*)(ws + OFF_ODSA), (const bf16*)(ws + OFF_WT_B), TT, 1024, 1024,
           EpiMix<true>{(const bf16*)p.out + (size_t)TT * 1024, (bf16*)(ws + OFF_MIX)});
  xcd_barrier(xb);
  if (bid == 0) TS_SET(p, 5);
  gemm_run(lds, (const bf16*)(ws + OFF_MIX), (const bf16*)(ws + OFF_WT_OUT), TT, 1024, 1024,
           EpiX1{p.x, (const float*)(ws + OFF_ADA), p.out});
  xcd_barrier(xb);
  if (bid == 0) TS_SET(p, 6);
  ph_mod(p, p.out, (const float*)(ws + OFF_PRM) + PRM_N2G, 3072, 4096, (bf16*)(ws + OFF_H), bid, nb);
  xcd_barrier(xb);
  if (bid == 0) TS_SET(p, 7);
  gemm_run(lds, (const bf16*)(ws + OFF_H), (const bf16*)(ws + OFF_WT_Q), TT, 2048, 1024, EpiPlain{(bf16*)(ws + OFF_PQ), 2048});
  xcd_barrier(xb);
  if (bid == 0) TS_SET(p, 8);
  ph_peer512(p, lds_raw, p.out);
#if PROBE_TS
  if (bid == 0) TS_SET(p, 18);
  xcd_barrier(xb);
  {
    const unsigned long long* T = (const unsigned long long*)(ws + OFF_TS);
    const unsigned long long q = (unsigned long long)(PROBE_Q), t0 = __builtin_amdgcn_s_memrealtime();
    while (__builtin_amdgcn_s_memrealtime() - t0 < q) __builtin_amdgcn_s_sleep(8);
  }
#endif
}

extern "C" void kernel_launch(void* const* d_in, const int* in_sizes, int n_in, void* d_out, int out_size, void* d_ws,
                              size_t ws_size, hipStream_t stream) {
  P p{};
  const float** f = (const float**)&p;
  for (int i = 0; i < 22; ++i) f[i] = (const float*)d_in[i];
  p.out = (float*)d_out;
  p.ws = (char*)d_ws;
  if (ws_size < WS_NEED) { fprintf(stderr, "workspace too small: %zu\n", ws_size); return; }
  static int grid_blocks = 0;
  if (!grid_blocks) {
    int dev = 0, cus = 0, per_cu = 0;
    (void)hipGetDevice(&dev);
    (void)hipDeviceGetAttribute(&cus, hipDeviceAttributeMultiprocessorCount, dev);
    if (hipFuncSetAttribute((const void*)mega, hipFuncAttributeMaxDynamicSharedMemorySize, LDS_BYTES) != hipSuccess) {
      fprintf(stderr, "hipFuncSetAttribute failed\n"); grid_blocks = -1; return;
    }
    if (hipOccupancyMaxActiveBlocksPerMultiprocessor(&per_cu, (const void*)mega, 512, LDS_BYTES) != hipSuccess || per_cu < 1) {
      fprintf(stderr, "occupancy query failed\n"); grid_blocks = -1; return;
    }
    grid_blocks = cus;
  }
  if (grid_blocks <= 0) return;
  void* args[] = {&p};
  hipError_t e = hipLaunchCooperativeKernel((void*)mega, dim3(grid_blocks), dim3(512), args, LDS_BYTES, stream);
  if (e != hipSuccess) fprintf(stderr, "cooperative launch failed: %s (grid %d)\n", hipGetErrorString(e), grid_blocks);
}
```

```cpp
#include <hip/hip_runtime.h>
#include <hip/hip_cooperative_groups.h>
#include <cstdio>
#include <cstdint>
namespace cg = cooperative_groups;

#define TT 32768
#define SEQ 4096
#define DM 1024
#define NIN 7000
typedef unsigned short bf16;
#define LAS __attribute__((address_space(3)))

struct P {
  const float *x, *c, *w_ada, *b_ada, *norm1_g, *w_in, *w_gate_up, *b_gate, *gla_norm_g, *kv_norm_g,
      *w_uk, *w_uv, *w_a, *w_b, *w_out, *norm2_g, *w_q, *sk1, *sk2, *peer_u, *peer_v, *final_g;
  float* out;
  char* ws;
};

#define MB (1ull << 20)
#define OFF_ADA   (0ull)
#define OFF_H     (1 * MB)
#define OFF_ODSA  (1 * MB)
#define OFF_Q     (65 * MB)
#define OFF_K     (97 * MB)
#define OFF_MIX   (65 * MB)
#define OFF_V     (129 * MB)
#define OFF_DQ    (193 * MB)
#define OFF_PQ    (129 * MB)
#define OFF_DSCR  (257 * MB)
#define OFF_SSP   (256ull * 1024)
#define OFF_CKV   (289 * MB)
#define OFF_IQ    (305 * MB)
#define OFF_IK    (337 * MB)
#define OFF_IW    (341 * MB)
#define OFF_GLOW  (342 * MB)
#define OFF_SGR   (344 * MB)
#define OFF_WT    (408 * MB)
#define OFF_WT_IN  (OFF_WT)
#define OFF_WT_A   (OFF_WT + 7168ull * 2048)
#define OFF_WT_B   (OFF_WT_A + 1024ull * 2048)
#define OFF_WT_OUT (OFF_WT_B + 1024ull * 2048)
#define OFF_WT_Q   (OFF_WT_OUT + 1024ull * 2048)
#define OFF_PU    (432 * MB)
#define OFF_PV    (464 * MB)
#define OFF_SK    (496 * MB)
#define OFF_PSC   (496 * MB + 128 * 1024)
#define OFF_WUK   (497 * MB)
#define OFF_WUV   (497 * MB + 512 * 1024)
#define WS_NEED   (498 * MB)

__device__ __forceinline__ bf16 f2bf(float f) {
  unsigned u = __float_as_uint(f);
  u += 0x7fffu + ((u >> 16) & 1u);
  return (bf16)(u >> 16);
}
__device__ __forceinline__ unsigned pk2(float lo, float hi) { return (unsigned)f2bf(lo) | ((unsigned)f2bf(hi) << 16); }
__device__ __forceinline__ float bf2f(bf16 h) { return __uint_as_float(((unsigned)h) << 16); }
__device__ __forceinline__ float bflo(unsigned u) { return __uint_as_float(u << 16); }
__device__ __forceinline__ float bfhi(unsigned u) { return __uint_as_float(u & 0xffff0000u); }
__device__ __forceinline__ float wave_sum(float v) {
#pragma unroll
  for (int o = 32; o > 0; o >>= 1) v += __shfl_xor(v, o);
  return v;
}
__device__ __forceinline__ float wave_max(float v) {
#pragma unroll
  for (int o = 32; o > 0; o >>= 1) v = fmaxf(v, __shfl_xor(v, o));
  return v;
}
#ifndef PROBE_TS
#define PROBE_TS 0
#endif
#define OFF_PRM (800ull * 1024)
#define PRM_WGU   0
#define PRM_BG    8192
#define PRM_GNG   8704
#define PRM_N2G   9728
#define PRM_FG    10752
#define PRM_TOTAL 11776
#define OFF_TS (208ull * 1024)
#if PROBE_TS
#define TS_SET(p, k) do { if (tid_fresh() == 0) ((unsigned long long*)((p).ws + OFF_TS))[k] = __builtin_amdgcn_s_memrealtime(); } while (0)
#define TS_ADD(p, k, t0) do { if (tid_fresh() == 0) ((unsigned long long*)((p).ws + OFF_TS))[k] += __builtin_amdgcn_s_memrealtime() - (t0); } while (0)
#define TS_NOW() __builtin_amdgcn_s_memrealtime()
#else
#define TS_SET(p, k) do {} while (0)
#define TS_ADD(p, k, t0) do {} while (0)
#define TS_NOW() 0ull
#endif
__device__ __forceinline__ int tid_fresh() { int t = threadIdx.x; asm volatile("" : "+v"(t)); return t; }
__device__ __forceinline__ float sigmoidf_(float v) { return 1.f / (1.f + __expf(-v)); }
__device__ __forceinline__ float siluf_(float v) { return v / (1.f + __expf(-v)); }

#include <hip/hip_runtime.h>
namespace pg8 {
#define PG8_LAS __attribute__((address_space(3)))
typedef unsigned short bf16_t;
typedef short bf16x8 __attribute__((ext_vector_type(8)));
typedef float f32x4 __attribute__((ext_vector_type(4)));
typedef unsigned u32x4 __attribute__((ext_vector_type(4)));
constexpr int BM = 256, BK = 64, HALF = 128, HTB = HALF * BK * 2  , STAGE_BYTES = 8 * HTB, NXCD = 8, WGM = 8;

__host__ __device__ __forceinline__ int lds_byte(int r, int c) { const int st = (r >> 4) * 2 + (c >> 5), rr = r & 15, cc = c & 31, ob = rr * 64 + cc * 2; return st * 1024 + (ob ^ (((ob >> 9) & 1) << 5)); }
__host__ __device__ __forceinline__ void stage_rc(int b, int& R, int& C) { const int st = b / 1024, sb = b % 1024, swz = sb ^ (((sb >> 9) & 1) << 5); R = (st >> 1) * 16 + swz / 64; C = (st & 1) * 32 + (swz % 64) / 2; }
__host__ __device__ __forceinline__ int perm32(int rho) { const int n = rho >> 4, i = rho & 15; return 8 * (i >> 2) + 4 * n + (i & 3); }

struct Unit { int pm, pn; };
struct Gemm { const bf16_t* A; const bf16_t* Bt; int M, N, K; };

struct StaticOrder {
    int nM, nN, nwg, G, c;
    __host__ __device__ void init(int M, int N, int G_, int c_) { nM = M / BM; nN = N / BM; nwg = nM * nN; G = G_; c = c_; }
    __host__ __device__ bool next(int i, Unit& u) const {
        const long L = (long)i * G + c; if (L >= nwg) return false;
        int wgid = (int)L; { const int q = nwg / NXCD, r = nwg % NXCD, xcd = wgid % NXCD, off = wgid / NXCD; wgid = (xcd < r ? xcd * (q + 1) : r * (q + 1) + (xcd - r) * q) + off; }
        const int nig = WGM * nN, gid = wgid / nig, fm = gid * WGM, gsz = (nM - fm) < WGM ? (nM - fm) : WGM;
        u.pm = fm + ((wgid % nig) % gsz); u.pn = (wgid % nig) / gsz; return true;
    }
    __device__ __forceinline__ void a_ready(const Unit&) const {}
    __device__ __forceinline__ void done(const Unit&) const {}
};
__device__ __forceinline__ unsigned cvt_pk_bf16(float lo, float hi) { unsigned r; asm volatile("v_cvt_pk_bf16_f32 %0, %1, %2" : "=v"(r) : "v"(lo), "v"(hi)); return r; }

template <class Epi, class Sched, bool STAMP = false>
__device__ __forceinline__ void gemm_phase(PG8_LAS unsigned char* lds, const Gemm g, const Sched& S, const Epi& E, unsigned long long* stamps) {
    const int tid = ::tid_fresh(), wid = __builtin_amdgcn_readfirstlane(tid >> 6), lane = tid & 63, wr = wid >> 2, wc = wid & 3, fr = lane & 15, fq = lane >> 4;
    const int K = g.K, nt = K / BK;
    int ts_lo = 0, ts_hi = 0, nts = 0; const unsigned long long rt_entry = STAMP ? (unsigned long long)wall_clock64() : 0ull;
#define PG8_STAMP() do { if (STAMP && wid == 0 && nts < 64) { const unsigned long long _c = (unsigned long long)clock64(); \
        ts_lo = (lane == nts) ? (int)(unsigned)_c : ts_lo; ts_hi = (lane == nts) ? (int)(unsigned)(_c >> 32) : ts_hi; ++nts; } } while (0)
    PG8_STAMP();
    unsigned voffA[2], voffB[2];
#pragma unroll
    for (int i = 0; i < 2; ++i) { int R, C; stage_rc(tid * 16 + i * 8192, R, C); const int Rb = Epi::PERM ? ((R & ~31) + perm32(R & 31)) : R;
        voffA[i] = (unsigned)(R * K + C) * 2u; voffB[i] = (unsigned)(Rb * K + C) * 2u; }
    const size_t kstep = (size_t)(BK * 2);
    const size_t hstep = (size_t)HALF * K * 2;
    const size_t tstep = 2 * hstep;
    const unsigned ldsw = (unsigned)wid * 1024u;
    const int aoff = lds_byte(wr * 64 + fr, fq * 8), boff = lds_byte(wc * 32 + fr, fq * 8);
#define PG8_SA(b, h) (((b) * 2 + (h)) * HTB)
#define PG8_SB(b, h) ((4 + (b) * 2 + (h)) * HTB)
#define PG8_STAGE(bufoff, gbase, voff) do { _Pragma("unroll") for (int _i = 0; _i < 2; ++_i) \
        __builtin_amdgcn_global_load_lds((const unsigned*)((const char*)(gbase) + (voff)[_i]), (PG8_LAS unsigned*)(lds + (bufoff) + ldsw + _i * 8192), 16, 0, 0); } while (0)
#define PG8_LDA(dst, b, h) do { _Pragma("unroll") for (int m = 0; m < 4; ++m) _Pragma("unroll") for (int k = 0; k < 2; ++k) dst[m][k] = *(const PG8_LAS bf16x8*)(lds + PG8_SA(b, h) + aoff + m * 2048 + k * 1024); } while (0)
#define PG8_LDB(dst, b, h) do { _Pragma("unroll") for (int n = 0; n < 2; ++n) _Pragma("unroll") for (int k = 0; k < 2; ++k) dst[n][k] = *(const PG8_LAS bf16x8*)(lds + PG8_SB(b, h) + boff + n * 2048 + k * 1024); } while (0)
#define PG8_MMA(ai, bj, At, Bt) do { __builtin_amdgcn_s_setprio(1); _Pragma("unroll") for (int m = 0; m < 4; ++m) _Pragma("unroll") for (int n = 0; n < 2; ++n) _Pragma("unroll") for (int k = 0; k < 2; ++k) \
        acc[ai][bj][m][n] = __builtin_amdgcn_mfma_f32_16x16x32_bf16(Bt[n][k], At[m][k], acc[ai][bj][m][n], 0, 0, 0); __builtin_amdgcn_s_setprio(0); } while (0)
#define PG8_WAIT_V(n) asm volatile("s_waitcnt vmcnt(" #n ")" ::: "memory")
#define PG8_WAIT_L(n) asm volatile("s_waitcnt lgkmcnt(" #n ")" ::: "memory")
#define PG8_BAR __builtin_amdgcn_s_barrier()
#define PG8_SCHED __builtin_amdgcn_sched_barrier(0)
    Unit cur, nxt; int ui = 0;
    if (!S.next(0, cur)) return;
    f32x4 acc[2][2][4][2];
#pragma unroll
    for (int a = 0; a < 2; ++a)
#pragma unroll
        for (int b = 0; b < 2; ++b)
#pragma unroll
            for (int m = 0; m < 4; ++m)
#pragma unroll
                for (int n = 0; n < 2; ++n) acc[a][b][m][n] = (f32x4){0.f, 0.f, 0.f, 0.f};
    bf16x8 At[4][2], B0[2][2], B1[2][2];
    const char* cA = (const char*)g.A + (size_t)cur.pm * tstep; const char* cB = (const char*)g.Bt + (size_t)cur.pn * tstep;
    S.a_ready(cur);
    PG8_STAGE(PG8_SB(0, 0), cB, voffB); PG8_STAGE(PG8_SA(0, 0), cA, voffA); PG8_STAGE(PG8_SB(0, 1), cB + hstep, voffB); PG8_STAGE(PG8_SA(0, 1), cA + hstep, voffA);
    if (wr == 1) PG8_BAR;
    PG8_WAIT_V(4); PG8_BAR;
    PG8_STAGE(PG8_SB(1, 0), cB + kstep, voffB); PG8_STAGE(PG8_SA(1, 0), cA + kstep, voffA); PG8_STAGE(PG8_SB(1, 1), cB + hstep + kstep, voffB);
    PG8_WAIT_V(6); PG8_BAR;
    PG8_STAMP();
    for (;;) {
        const bool has_next = S.next(ui + 1, nxt);
        const char* nA = has_next ? (const char*)g.A + (size_t)nxt.pm * tstep : cA; const char* nB = has_next ? (const char*)g.Bt + (size_t)nxt.pn * tstep : cB;
        for (int t = 0; t < nt; t += 2) {
            const bool last = (t == nt - 2);
            const char* a1 = cA + (size_t)(t + 1) * kstep;
            const char* a2 = last ? nA : cA + (size_t)(t + 2) * kstep; const char* b2 = last ? nB : cB + (size_t)(t + 2) * kstep;
            const char* a3 = a2 + kstep; const char* b3 = b2 + kstep;
            if (last && has_next) S.a_ready(nxt);
            PG8_LDB(B0, 0, 0); PG8_SCHED; PG8_LDA(At, 0, 0); PG8_STAGE(PG8_SA(1, 1), a1 + hstep, voffA);
            PG8_WAIT_L(8); PG8_BAR; PG8_WAIT_L(0); PG8_MMA(0, 0, At, B0); PG8_BAR; PG8_SCHED;
            PG8_LDB(B1, 0, 1); PG8_STAGE(PG8_SB(0, 0), b2, voffB);
            PG8_BAR; PG8_WAIT_L(0); PG8_MMA(0, 1, At, B1); PG8_BAR;
            PG8_LDA(At, 0, 1); PG8_STAGE(PG8_SA(0, 0), a2, voffA);
            PG8_BAR; PG8_WAIT_L(0); PG8_MMA(1, 0, At, B0); PG8_BAR; PG8_SCHED;
            PG8_STAGE(PG8_SB(0, 1), b2 + hstep, voffB);
            PG8_WAIT_V(6); PG8_BAR; PG8_MMA(1, 1, At, B1); PG8_BAR;
            PG8_LDB(B0, 1, 0); PG8_SCHED; PG8_LDA(At, 1, 0); PG8_STAGE(PG8_SA(0, 1), a2 + hstep, voffA);
            PG8_WAIT_L(8); PG8_BAR; PG8_WAIT_L(0); PG8_MMA(0, 0, At, B0); PG8_BAR; PG8_SCHED;
            PG8_LDB(B1, 1, 1); PG8_STAGE(PG8_SB(1, 0), b3, voffB);
            PG8_BAR; PG8_WAIT_L(0); PG8_MMA(0, 1, At, B1); PG8_BAR;
            PG8_LDA(At, 1, 1); PG8_STAGE(PG8_SA(1, 0), a3, voffA);
            PG8_BAR; PG8_WAIT_L(0); PG8_MMA(1, 0, At, B0); PG8_BAR; PG8_SCHED;
            PG8_STAGE(PG8_SB(1, 1), b3 + hstep, voffB);
            PG8_WAIT_V(6); PG8_BAR; PG8_MMA(1, 1, At, B1); PG8_BAR;
        }
        PG8_STAMP();
        if constexpr (!Epi::AFTER_DRAIN) { E(acc, cur, wr, wc, fr, fq); S.done(cur); }
        PG8_STAMP();
        if (!has_next) break;
#pragma unroll
        for (int a = 0; a < 2; ++a)
#pragma unroll
            for (int b = 0; b < 2; ++b)
#pragma unroll
                for (int m = 0; m < 4; ++m)
#pragma unroll
                    for (int n = 0; n < 2; ++n) acc[a][b][m][n] = (f32x4){0.f, 0.f, 0.f, 0.f};
        cur = nxt; cA = nA; cB = nB; ++ui;
    }
    PG8_WAIT_V(0);
    if (wr == 0) PG8_BAR;
    PG8_BAR;
    if constexpr (Epi::AFTER_DRAIN) { E.fused(acc, cur, wr, wc, fr, fq, lds, wid, lane); S.done(cur); }
    PG8_STAMP();
    if (STAMP && wid == 0) { stamps[lane] = lane < nts ? (((unsigned long long)(unsigned)ts_hi << 32) | (unsigned)ts_lo) : 0ull;
        if (lane == 62) stamps[62] = rt_entry; if (lane == 63) stamps[63] = (unsigned long long)wall_clock64(); }
#undef PG8_STAMP
#undef PG8_SA
#undef PG8_SB
#undef PG8_STAGE
#undef PG8_LDA
#undef PG8_LDB
#undef PG8_MMA
#undef PG8_WAIT_V
#undef PG8_WAIT_L
#undef PG8_BAR
#undef PG8_SCHED
}
}
#define XB_TMO      128
#define XB_XCNT(j)  (256  + 64 * (j))
#define XB_XSUB(j)  (1280 + 64 * (j))
#define XB_XGEN(j)  (2304 + 64 * (j))
#define XB_TOP      3328
#define XB_TOPGEN   3392
#define XCD_BAR_WORDS 3456
#define XB_SPIN_CAP (1u << 18)

__device__ __forceinline__ unsigned xb_ld(unsigned* p)              { return __hip_atomic_load(p, __ATOMIC_RELAXED, __HIP_MEMORY_SCOPE_AGENT); }
__device__ __forceinline__ unsigned xb_add(unsigned* p, unsigned v) { return __hip_atomic_fetch_add(p, v, __ATOMIC_RELAXED, __HIP_MEMORY_SCOPE_AGENT); }
__device__ __forceinline__ unsigned xb_xcc_id() { return (unsigned)__builtin_amdgcn_s_getreg((3 << 11) | 20) & 0xFu; }
#define XB_SPIN(cond, bar) do { unsigned _sp = 0; while (cond) { __builtin_amdgcn_s_sleep(1); \
    if ((++_sp & 255u) == 0u) { if (xb_ld(&(bar)[XB_TMO])) break; if (_sp > XB_SPIN_CAP) { atomicAdd(&(bar)[XB_TMO], 1u); break; } } } } while (0)

struct XcdBarrier {
    unsigned* bar; unsigned x;
    volatile LAS unsigned* st;
};

__device__ __forceinline__ XcdBarrier xcd_barrier_post(unsigned* bar, volatile LAS unsigned* st) {
    XcdBarrier b; b.bar = bar; b.x = xb_xcc_id(); b.st = st;
    if (threadIdx.x == 0) (void)xb_add(&bar[XB_XCNT(b.x)], 1u);
    return b;
}
__device__ __forceinline__ void xcd_barrier_complete(unsigned* bar, unsigned x, unsigned& nloc, unsigned& nx) {
    const unsigned G = gridDim.x * gridDim.y * gridDim.z;
    unsigned sum, cnt, mine, sp = 0u;
    for (;;) {
        sum = 0u; cnt = 0u; mine = 0u;
#pragma unroll
        for (unsigned j = 0; j < 16; ++j) { const unsigned c = xb_ld(&bar[XB_XCNT(j)]); sum += c; cnt += (c > 0u) ? 1u : 0u; mine = (j == x) ? c : mine; }
        if (sum == G) break;
        __builtin_amdgcn_s_sleep(1);
        if ((++sp & 255u) == 0u) { if (xb_ld(&bar[XB_TMO])) break; if (sp > XB_SPIN_CAP) { atomicAdd(&bar[XB_TMO], 1u); break; } }
    }
    nloc = mine > 0u ? mine : 1u; nx = cnt > 0u ? cnt : 1u;
}

__device__ __forceinline__ void xcd_barrier(const XcdBarrier& b) {
    asm volatile("s_waitcnt vmcnt(0)" ::: "memory");
    __syncthreads();
    if (threadIdx.x == 0) {
        unsigned* bar = b.bar;
        __builtin_amdgcn_s_waitcnt(0);
        unsigned nloc = b.st[0], nx = b.st[1];
        if (nloc == 0u) { xcd_barrier_complete(bar, b.x, nloc, nx); b.st[0] = nloc; b.st[1] = nx; }
        const unsigned old = xb_add(&bar[XB_XSUB(b.x)], 1u);
        const unsigned gen = old / nloc;
        if (old + 1u == (gen + 1u) * nloc) {
            __builtin_amdgcn_fence(__ATOMIC_RELEASE, "agent");
            asm volatile("s_waitcnt vmcnt(0)" ::: "memory");
            const unsigned og = xb_add(&bar[XB_TOP], 1u);
            const unsigned tg = og / nx;
            if (og + 1u == (tg + 1u) * nx) xb_add(&bar[XB_TOPGEN], 1u);
            else XB_SPIN(xb_ld(&bar[XB_TOPGEN]) == tg, bar);
            __builtin_amdgcn_fence(__ATOMIC_ACQUIRE, "agent");
            xb_add(&bar[XB_XGEN(b.x)], 1u);
            asm volatile("s_waitcnt vmcnt(0)" ::: "memory");
        } else {
            XB_SPIN(xb_ld(&bar[XB_XGEN(b.x)]) == gen, bar);
            __builtin_amdgcn_fence(__ATOMIC_ACQUIRE, "agent");
            asm volatile("s_waitcnt vmcnt(0)" ::: "memory");
        }
    }
    __syncthreads();
}

__device__ __forceinline__ void ph_mod(const P& p, const float* X, const float* g, int shift_off, int scale_off, bf16* H, int bid, int nb) {
  const float* ada = (const float*)(p.ws + OFF_ADA);
  const int tidm = tid_fresh(); int wave = tidm >> 6, lane = tidm & 63;
  const int rstride = nb * (int)(blockDim.x >> 6);
  int row = bid * (int)(blockDim.x >> 6) + wave;
  float4 v[4];
  if (row < TT) {
    const float4* xr = (const float4*)(X + (size_t)row * DM);
#pragma unroll
    for (int i = 0; i < 4; ++i) v[i] = xr[lane + i * 64];
  }
  for (; row < TT; row += rstride) {
    float4 vn[4];
    const int nrow = row + rstride;
    {
      const float4* xn = (const float4*)(X + (size_t)((nrow < TT) ? nrow : row) * DM);
#pragma unroll
      for (int i = 0; i < 4; ++i) vn[i] = xn[lane + i * 64];
    }
    float ss = 0.f;
#pragma unroll
    for (int i = 0; i < 4; ++i) ss += v[i].x * v[i].x + v[i].y * v[i].y + v[i].z * v[i].z + v[i].w * v[i].w;
    ss = wave_sum(ss);
    float rstd = rsqrtf(ss * (1.f / DM) + 1e-6f);
    int b = row >> 12;
    const float* sh = ada + b * 6144 + shift_off;
    const float* sc = ada + b * 6144 + scale_off;
#pragma unroll
    for (int i = 0; i < 4; ++i) {
      int c0 = (lane + i * 64) * 4;
      float4 gg = *(const float4*)(g + c0);
      float4 s4 = *(const float4*)(sc + c0);
      float4 h4 = *(const float4*)(sh + c0);
      ushort4 o;
      o.x = f2bf(v[i].x * rstd * gg.x * (1.f + s4.x) + h4.x);
      o.y = f2bf(v[i].y * rstd * gg.y * (1.f + s4.y) + h4.y);
      o.z = f2bf(v[i].z * rstd * gg.z * (1.f + s4.z) + h4.z);
      o.w = f2bf(v[i].w * rstd * gg.w * (1.f + s4.w) + h4.w);
      *(ushort4*)(H + (size_t)row * DM + c0) = o;
    }
#pragma unroll
    for (int i = 0; i < 4; ++i) v[i] = vn[i];
  }
}

using pg8::f32x4;
using pg8::u32x4;
using pg8::Unit;
using pg8::cvt_pk_bf16;
typedef short s16x4_t __attribute__((ext_vector_type(4)));
typedef unsigned u32x4_t __attribute__((ext_vector_type(4)));
typedef unsigned short u16x4_t __attribute__((ext_vector_type(4)));

__device__ __forceinline__ size_t tm_off(size_t row, int col, int kbn) {
  return (((row >> 4) * kbn + (col >> 5)) * 64 + ((col >> 3) & 3) * 16 + (row & 15)) * 8 + (col & 7);
}

__device__ __forceinline__ int in_srcmap(int d) {
  if (d < 2048) return d;
  if (d < 3072) return 3088 + (d - 2048);
  if (d < 3328) return 4112 + (d - 3072);
  if (d < 3840) return 4368 + (d - 3328);
  if (d < 3904) return 4880 + (d - 3840);
  if (d < 3912) return 4944 + (d - 3904);
  if (d < 3928) return 3072 + (d - 3912);
  if (d < 4096) return -1;
  if (d < 5120) return 2048 + (d - 4096);
  return 4952 + (d - 5120);
}
template <bool MAP>
__device__ __forceinline__ void transpose_item(const float* W, int ldw, int K, bf16* WT, int item, int nblk, float* scr, int lane) {
  const int kb = item / nblk, nbk = item % nblk, k0 = 64 * kb, n0 = 32 * nbk;
  const int d = n0 + (lane & 31);
  const int src = MAP ? in_srcmap(d) : d;
  float r[32];
  const int srcc = (src >= 0) ? src : 0;
#pragma unroll
  for (int i = 0; i < 32; ++i) r[i] = W[(size_t)(k0 + 2 * i + (lane >> 5)) * ldw + srcc];
#pragma unroll
  for (int i = 0; i < 32; ++i) scr[(2 * i + (lane >> 5)) * 33 + (lane & 31)] = (src >= 0) ? r[i] : 0.f;
  asm volatile("s_waitcnt lgkmcnt(0)" ::: "memory");
  const int c = lane & 7;
#pragma unroll
  for (int j = 0; j < 4; ++j) {
    const int n = (lane >> 3) + 8 * j;
    const float* s = scr + (8 * c) * 33 + n;
    uint4 o;
    o.x = pk2(s[0 * 33], s[1 * 33]); o.y = pk2(s[2 * 33], s[3 * 33]); o.z = pk2(s[4 * 33], s[5 * 33]); o.w = pk2(s[6 * 33], s[7 * 33]);
    *(uint4*)(WT + (size_t)(n0 + n) * K + k0 + 8 * c) = o;
  }
  asm volatile("s_waitcnt lgkmcnt(0)" ::: "memory");
}

__device__ __forceinline__ void ph_prep(const P& p, float* sm) {
  const int tid = tid_fresh(), wave = tid >> 6, lane = tid & 63;
  const int bid = blockIdx.x, nb = gridDim.x;
  float* silc = sm + 8 * 2112 + 64;
  float* red = silc + 8192;
  float* ada = (float*)(p.ws + OFF_ADA);
  if (bid < 192) {
    for (int i = tid; i < 8192; i += 512) silc[i] = siluf_(p.c[i]);
    __syncthreads();
    for (int it = bid; it < 192; it += nb) {
      const int kg = tid >> 5, cn = tid & 31, n = it * 32 + cn;
      float acc[8];
#pragma unroll
      for (int b = 0; b < 8; ++b) acc[b] = 0.f;
#pragma unroll 1
      for (int kq = 0; kq < 2; ++kq) {
        float w[32];
#pragma unroll
        for (int j = 0; j < 32; ++j) w[j] = p.w_ada[(size_t)(kg * 64 + kq * 32 + j) * 6144 + n];
#pragma unroll
        for (int j = 0; j < 32; ++j) {
          const int k = kg * 64 + kq * 32 + j;
#pragma unroll
          for (int b = 0; b < 8; ++b) acc[b] += silc[b * 1024 + k] * w[j];
        }
      }
#pragma unroll
      for (int b = 0; b < 8; ++b) red[(kg * 8 + b) * 32 + cn] = acc[b];
      __syncthreads();
      if (tid < 256) {
        const int b = tid >> 5, c2 = tid & 31;
        float s = 0.f;
#pragma unroll
        for (int g = 0; g < 16; ++g) s += red[(g * 8 + b) * 32 + c2];
        ada[b * 6144 + it * 32 + c2] = s + p.b_ada[it * 32 + c2];
      }
      __syncthreads();
    }
  }
  {
    unsigned char* PU8 = (unsigned char*)(p.ws + OFF_PU);
    unsigned char* PV8 = (unsigned char*)(p.ws + OFF_PV);
    float* PSC = (float*)(p.ws + OFF_PSC);
    f32x4 va[4], vb[4];
    {
      const int r0 = bid * 8 + wave, r1 = (r0 + nb * 8 < 2 * 16384) ? r0 + nb * 8 : r0;
      const float* s0 = (r0 < 16384 ? p.peer_u : p.peer_v) + (size_t)(r0 & 16383) * 1024 + lane * 16;
      const float* s1 = (r1 < 16384 ? p.peer_u : p.peer_v) + (size_t)(r1 & 16383) * 1024 + lane * 16;
#pragma unroll
      for (int q = 0; q < 4; ++q) { va[q] = *(const f32x4*)(s0 + q * 4); vb[q] = *(const f32x4*)(s1 + q * 4); }
    }
    for (int row = bid * 8 + wave; row < 2 * 16384; row += nb * 8) {
      f32x4 v[4], vn[4];
      {
        const int r2 = (row + 2 * nb * 8 < 2 * 16384) ? row + 2 * nb * 8 : row;
        const float* s2 = (r2 < 16384 ? p.peer_u : p.peer_v) + (size_t)(r2 & 16383) * 1024 + lane * 16;
#pragma unroll
        for (int q = 0; q < 4; ++q) vn[q] = *(const f32x4*)(s2 + q * 4);
      }
      float mx = 0.f;
#pragma unroll
      for (int q = 0; q < 4; ++q) {
        v[q] = va[q]; va[q] = vb[q]; vb[q] = vn[q];
        mx = fmaxf(mx, fmaxf(fmaxf(fabsf(v[q][0]), fabsf(v[q][1])), fmaxf(fabsf(v[q][2]), fabsf(v[q][3]))));
      }
      mx = wave_max(mx);
      const float sc = (mx > 0.f) ? exp2f(floorf(log2f(448.f / mx))) : 1.f;
      u32x4 o;
#pragma unroll
      for (int q = 0; q < 4; ++q) {
        int w = __builtin_amdgcn_cvt_pk_fp8_f32(v[q][0] * sc, v[q][1] * sc, 0, false);
        w = __builtin_amdgcn_cvt_pk_fp8_f32(v[q][2] * sc, v[q][3] * sc, w, true);
        o[q] = (unsigned)w;
      }
      *(u32x4*)((row < 16384 ? PU8 : PV8) + (size_t)(row & 16383) * 1024 + lane * 16) = o;
      if (lane == 0) PSC[row] = 1.f / sc;
    }
    for (int i = bid * 512 + tid; i < 2 * 2048; i += nb * 512) {
      const float* src = (i < 2048) ? p.sk1 : p.sk2;
      const int j = i & 2047;
      const float4 v0 = *(const float4*)(src + j * 8), v1 = *(const float4*)(src + j * 8 + 4);
      uint4 o; o.x = pk2(v0.x, v0.y); o.y = pk2(v0.z, v0.w); o.z = pk2(v1.x, v1.y); o.w = pk2(v1.z, v1.w);
      *(uint4*)((bf16*)(p.ws + OFF_SK) + (size_t)(i >> 11) * 16384 + tm_off((size_t)(j >> 4), (j & 15) * 8, 4)) = o;
    }
  }
  {
    float* prm = (float*)(p.ws + OFF_PRM);
    for (int i = bid * 512 + tid; i < PRM_TOTAL; i += nb * 512) {
      float v;
      if (i < PRM_BG) v = p.w_gate_up[i];
      else if (i < PRM_GNG) v = p.b_gate[i - PRM_BG];
      else if (i < PRM_N2G) v = p.gla_norm_g[i - PRM_GNG];
      else if (i < PRM_FG) v = p.norm2_g[i - PRM_N2G];
      else v = p.final_g[i - PRM_FG];
      prm[i] = v;
    }
  }
  {
    bf16* WUK = (bf16*)(p.ws + OFF_WUK);
    bf16* WUV = (bf16*)(p.ws + OFF_WUV);
    for (int i = bid * 512 + tid; i < 2 * 262144; i += nb * 512) {
      if (i < 262144) {
        const int cc = i & 255, d = (i >> 8) & 127, h = i >> 15;
        WUK[((h * 16 + (cc >> 4)) * 4 + (d >> 5)) * 512 + (((d >> 3) & 3) * 16 + (cc & 15)) * 8 + (d & 7)] =
            f2bf(p.w_uk[i] * p.kv_norm_g[cc] * 0.08838834764831845f);
      } else {
        const int k = i - 262144;
        const int d = k & 127, cc = (k >> 7) & 255, h = k >> 15;
        WUV[((h * 8 + (d >> 4)) * 8 + (cc >> 5)) * 512 + (((cc >> 3) & 3) * 16 + (d & 15)) * 8 + (cc & 7)] =
            f2bf(p.w_uv[k] * p.kv_norm_g[cc]);
      }
    }
  }
  float* scr = sm + wave * 2112;
  const int gw = bid * 8 + wave, ngw = nb * 8;
  constexpr int I_IN = 16 * 224, I_SQ = 16 * 32, I_Q = 16 * 64;
  for (int it = gw; it < I_IN + 3 * I_SQ + I_Q; it += ngw) {
    int r = it;
    if (r < I_IN) { transpose_item<true>(p.w_in, NIN, 1024, (bf16*)(p.ws + OFF_WT_IN), r, 224, scr, lane); continue; }
    r -= I_IN;
    if (r < I_SQ) { transpose_item<false>(p.w_a, 1024, 1024, (bf16*)(p.ws + OFF_WT_A), r, 32, scr, lane); continue; }
    r -= I_SQ;
    if (r < I_SQ) { transpose_item<false>(p.w_b, 1024, 1024, (bf16*)(p.ws + OFF_WT_B), r, 32, scr, lane); continue; }
    r -= I_SQ;
    if (r < I_SQ) { transpose_item<false>(p.w_out, 1024, 1024, (bf16*)(p.ws + OFF_WT_OUT), r, 32, scr, lane); continue; }
    r -= I_SQ;
    transpose_item<false>(p.w_q, 2048, 1024, (bf16*)(p.ws + OFF_WT_Q), r, 64, scr, lane);
  }
}


struct EpiIn {
  static constexpr bool PERM = true, AFTER_DRAIN = false;
  char* ws; float* out;
  __device__ __forceinline__ void operator()(const f32x4 (&acc)[2][2][4][2], const Unit& u, int wr, int wc, int fr, int fq) const {
    const int pn = u.pn;
    const int row0 = u.pm * 256 + wr * 64 + fr, cl0 = wc * 32 + 8 * fq;
    if (pn == 12) {
      bf16* dst = (bf16*)(ws + OFF_CKV);
      float* ssp = (float*)(ws + OFF_SSP);
#pragma unroll
      for (int ai = 0; ai < 2; ++ai)
#pragma unroll
        for (int m = 0; m < 4; ++m) {
          const size_t row = row0 + ai * 128 + m * 16;
          float ss = 0.f;
#pragma unroll
          for (int bj = 0; bj < 2; ++bj) {
            const f32x4 v0 = acc[ai][bj][m][0], v1 = acc[ai][bj][m][1];
            ss += (v0[0] * v0[0] + v0[1] * v0[1]) + (v0[2] * v0[2] + v0[3] * v0[3]) + (v1[0] * v1[0] + v1[1] * v1[1]) + (v1[2] * v1[2] + v1[3] * v1[3]);
            u32x4 w; w.x = cvt_pk_bf16(v0[0], v0[1]); w.y = cvt_pk_bf16(v0[2], v0[3]); w.z = cvt_pk_bf16(v1[0], v1[1]); w.w = cvt_pk_bf16(v1[2], v1[3]);
            *(u32x4*)(dst + row * 256 + cl0 + bj * 128) = w;
          }
          ss += __shfl_xor(ss, 16); ss += __shfl_xor(ss, 32);
          if (fq == 0) ssp[row * 4 + wc] = ss;
        }
    } else if (pn == 15) {
      bf16* IK = (bf16*)(ws + OFF_IK);
      float* IW = (float*)(ws + OFF_IW);
      float* GLOW = (float*)(ws + OFF_GLOW);
#pragma unroll
      for (int ai = 0; ai < 2; ++ai)
#pragma unroll
        for (int m = 0; m < 4; ++m) {
          const size_t row = row0 + ai * 128 + m * 16;
          const int cl = cl0;
          const f32x4 v0 = acc[ai][0][m][0], v1 = acc[ai][0][m][1];
          if (cl < 64) {
            u32x4 w; w.x = cvt_pk_bf16(v0[0], v0[1]); w.y = cvt_pk_bf16(v0[2], v0[3]); w.z = cvt_pk_bf16(v1[0], v1[1]); w.w = cvt_pk_bf16(v1[2], v1[3]);
            *(u32x4*)(IK + tm_off(row, cl, 2)) = w;
          } else if (cl < 72) {
            *(f32x4*)(IW + row * 8) = v0 * 0.35355339059327373f;
            *(f32x4*)(IW + row * 8 + 4) = v1 * 0.35355339059327373f;
          } else if (cl < 88) {
            *(f32x4*)(GLOW + row * 16 + (cl - 72)) = v0;
            *(f32x4*)(GLOW + row * 16 + (cl - 72) + 4) = v1;
          }
        }
    } else {
      bf16* dst; int ld; float scale = 1.f; int act = 0; int coff; bool tm = false;
      if (pn < 2) { dst = (bf16*)(ws + OFF_Q); ld = 512; coff = pn * 256; scale = 0.08838834764831845f; }
      else if (pn < 4) { dst = (bf16*)(ws + OFF_K); ld = 512; coff = (pn - 2) * 256; }
      else if (pn < 8) { dst = (bf16*)(ws + OFF_V); ld = 1024; coff = (pn - 4) * 256; }
      else if (pn < 12) { dst = (bf16*)(ws + OFF_DQ); ld = 1024; coff = (pn - 8) * 256; tm = true; }
      else if (pn < 15) { dst = (bf16*)(ws + OFF_IQ); ld = 512; coff = (pn - 13) * 256; scale = 0.125f; tm = true; }
      else if (pn < 20) { dst = (bf16*)(ws + OFF_SGR); ld = 1024; coff = (pn - 16) * 256; act = 1; }
      else if (pn < 24) { dst = (bf16*)out; ld = 1024; coff = (pn - 20) * 256; act = 2; tm = true; }
      else { dst = (bf16*)out + (size_t)TT * 1024; ld = 1024; coff = (pn - 24) * 256; act = 2; tm = true; }
#pragma unroll
      for (int ai = 0; ai < 2; ++ai)
#pragma unroll
        for (int m = 0; m < 4; ++m) {
          const size_t row = row0 + ai * 128 + m * 16;
#pragma unroll
          for (int bj = 0; bj < 2; ++bj) {
            f32x4 v0 = acc[ai][bj][m][0] * scale, v1 = acc[ai][bj][m][1] * scale;
            if (act == 1) {
#pragma unroll
              for (int j = 0; j < 4; ++j) { v0[j] = siluf_(v0[j]); v1[j] = siluf_(v1[j]); }
            } else if (act == 2) {
#pragma unroll
              for (int j = 0; j < 4; ++j) { v0[j] = sigmoidf_(v0[j]); v1[j] = sigmoidf_(v1[j]); }
            }
            u32x4 w; w.x = cvt_pk_bf16(v0[0], v0[1]); w.y = cvt_pk_bf16(v0[2], v0[3]); w.z = cvt_pk_bf16(v1[0], v1[1]); w.w = cvt_pk_bf16(v1[2], v1[3]);
            *(u32x4*)(dst + (tm ? tm_off(row, coff + cl0 + bj * 128, ld >> 5) : row * ld + coff + cl0 + bj * 128)) = w;
          }
        }
    }
  }
};

template <bool ADD> struct EpiMix {
  static constexpr bool PERM = true, AFTER_DRAIN = false;
  const bf16* SZ; bf16* MIX;
  __device__ __forceinline__ void operator()(const f32x4 (&acc)[2][2][4][2], const Unit& u, int wr, int wc, int fr, int fq) const {
    const int row0 = u.pm * 256 + wr * 64 + fr, col0 = u.pn * 256 + wc * 32 + 8 * fq;
    u32x4 sc[2], oc[2], sn[2], on[2];
    {
      const size_t idx = (size_t)row0 * 1024 + col0;
      sc[0] = *(const u32x4*)(SZ + tm_off(row0, col0, 32)); sc[1] = *(const u32x4*)(SZ + tm_off(row0, col0 + 128, 32));
      if (ADD) { oc[0] = *(const u32x4*)(MIX + idx); oc[1] = *(const u32x4*)(MIX + idx + 128); }
    }
#pragma unroll
    for (int s = 0; s < 8; ++s) {
      const int ai = s >> 2, m = s & 3;
      const size_t idx = (size_t)(row0 + ai * 128 + m * 16) * 1024 + col0;
      if (s < 7) {
        const int ai2 = (s + 1) >> 2, m2 = (s + 1) & 3;
        const size_t idn = (size_t)(row0 + ai2 * 128 + m2 * 16) * 1024 + col0;
        sn[0] = *(const u32x4*)(SZ + tm_off(row0 + ai2 * 128 + m2 * 16, col0, 32)); sn[1] = *(const u32x4*)(SZ + tm_off(row0 + ai2 * 128 + m2 * 16, col0 + 128, 32));
        if (ADD) { on[0] = *(const u32x4*)(MIX + idn); on[1] = *(const u32x4*)(MIX + idn + 128); }
      }
#pragma unroll
      for (int bj = 0; bj < 2; ++bj) {
        const u32x4 sv = sc[bj];
        f32x4 v0 = acc[ai][bj][m][0], v1 = acc[ai][bj][m][1];
        v0[0] *= bflo(sv.x); v0[1] *= bfhi(sv.x); v0[2] *= bflo(sv.y); v0[3] *= bfhi(sv.y);
        v1[0] *= bflo(sv.z); v1[1] *= bfhi(sv.z); v1[2] *= bflo(sv.w); v1[3] *= bfhi(sv.w);
        if (ADD) {
          const u32x4 o = oc[bj];
          v0[0] += bflo(o.x); v0[1] += bfhi(o.x); v0[2] += bflo(o.y); v0[3] += bfhi(o.y);
          v1[0] += bflo(o.z); v1[1] += bfhi(o.z); v1[2] += bflo(o.w); v1[3] += bfhi(o.w);
        }
        u32x4 w; w.x = cvt_pk_bf16(v0[0], v0[1]); w.y = cvt_pk_bf16(v0[2], v0[3]); w.z = cvt_pk_bf16(v1[0], v1[1]); w.w = cvt_pk_bf16(v1[2], v1[3]);
        *(u32x4*)(MIX + idx + bj * 128) = w;
      }
      if (s < 7) { sc[0] = sn[0]; sc[1] = sn[1]; if (ADD) { oc[0] = on[0]; oc[1] = on[1]; } }
    }
  }
};

struct EpiX1 {
  static constexpr bool PERM = true, AFTER_DRAIN = false;
  const float* x; const float* ada; float* out;
  __device__ __forceinline__ void operator()(const f32x4 (&acc)[2][2][4][2], const Unit& u, int wr, int wc, int fr, int fq) const {
    const int row0 = u.pm * 256 + wr * 64 + fr, col0 = u.pn * 256 + wc * 32 + 8 * fq;
    const int b = (u.pm * 256) >> 12;
    f32x4 g[2][2];
#pragma unroll
    for (int bj = 0; bj < 2; ++bj) {
      g[bj][0] = *(const f32x4*)(ada + b * 6144 + 2048 + col0 + bj * 128);
      g[bj][1] = *(const f32x4*)(ada + b * 6144 + 2048 + col0 + bj * 128 + 4);
    }
    f32x4 xc[4], xn[4];
    {
      const size_t idx = (size_t)row0 * 1024 + col0;
      xc[0] = *(const f32x4*)(x + idx); xc[1] = *(const f32x4*)(x + idx + 4);
      xc[2] = *(const f32x4*)(x + idx + 128); xc[3] = *(const f32x4*)(x + idx + 132);
    }
#pragma unroll
    for (int s = 0; s < 8; ++s) {
      const int ai = s >> 2, m = s & 3;
      const size_t idx = (size_t)(row0 + ai * 128 + m * 16) * 1024 + col0;
      if (s < 7) {
        const int ai2 = (s + 1) >> 2, m2 = (s + 1) & 3;
        const size_t idn = (size_t)(row0 + ai2 * 128 + m2 * 16) * 1024 + col0;
        xn[0] = *(const f32x4*)(x + idn); xn[1] = *(const f32x4*)(x + idn + 4);
        xn[2] = *(const f32x4*)(x + idn + 128); xn[3] = *(const f32x4*)(x + idn + 132);
      }
#pragma unroll
      for (int bj = 0; bj < 2; ++bj) {
        *(f32x4*)(out + idx + bj * 128) = xc[2 * bj] + g[bj][0] * acc[ai][bj][m][0];
        *(f32x4*)(out + idx + bj * 128 + 4) = xc[2 * bj + 1] + g[bj][1] * acc[ai][bj][m][1];
      }
      if (s < 7) { xc[0] = xn[0]; xc[1] = xn[1]; xc[2] = xn[2]; xc[3] = xn[3]; }
    }
  }
};

struct EpiPlain {
  static constexpr bool PERM = true, AFTER_DRAIN = false;
  bf16* O; int ld;
  __device__ __forceinline__ void operator()(const f32x4 (&acc)[2][2][4][2], const Unit& u, int wr, int wc, int fr, int fq) const {
    const int row0 = u.pm * 256 + wr * 64 + fr, col0 = u.pn * 256 + wc * 32 + 8 * fq;
#pragma unroll
    for (int ai = 0; ai < 2; ++ai)
#pragma unroll
      for (int m = 0; m < 4; ++m)
#pragma unroll
        for (int bj = 0; bj < 2; ++bj) {
          const f32x4 v0 = acc[ai][bj][m][0], v1 = acc[ai][bj][m][1];
          u32x4 w; w.x = cvt_pk_bf16(v0[0], v0[1]); w.y = cvt_pk_bf16(v0[2], v0[3]); w.z = cvt_pk_bf16(v1[0], v1[1]); w.w = cvt_pk_bf16(v1[2], v1[3]);
          *(u32x4*)(O + tm_off((size_t)(row0 + ai * 128 + m * 16), col0 + bj * 128, ld >> 5)) = w;
        }
  }
};

template <class Epi>
__device__ __forceinline__ void gemm_run(LAS unsigned char* lds, const bf16* A, const bf16* Bt, int M, int N, int K, const Epi& E) {
  pg8::Gemm g{A, Bt, M, N, K};
  pg8::StaticOrder S;
  S.init(M, N, gridDim.x, blockIdx.x);
  pg8::gemm_phase<Epi, pg8::StaticOrder, false>(lds, g, S, E, nullptr);
}

typedef short bf16x8_t __attribute__((ext_vector_type(8)));
typedef __bf16 bf16x2_t __attribute__((ext_vector_type(2)));
__device__ __forceinline__ float dot2bf(unsigned a, unsigned b, float acc) {
  return __builtin_amdgcn_fdot2_f32_bf16(__builtin_bit_cast(bf16x2_t, a), __builtin_bit_cast(bf16x2_t, b), acc, false);
}
__device__ __forceinline__ void wave_lds_fence() { asm volatile("s_waitcnt lgkmcnt(0)" ::: "memory"); }
template <int N> __device__ __forceinline__ float row_ror(float x) {
  return __int_as_float(__builtin_amdgcn_update_dpp(0, __float_as_int(x), 0x120 + N, 0xf, 0xf, false));
}
__device__ __forceinline__ float row16_max(float m) {
  m = fmaxf(m, row_ror<8>(m)); m = fmaxf(m, row_ror<4>(m)); m = fmaxf(m, row_ror<2>(m)); m = fmaxf(m, row_ror<1>(m));
  return m;
}
__device__ __forceinline__ float row16_sum(float m) {
  m += row_ror<8>(m); m += row_ror<4>(m); m += row_ror<2>(m); m += row_ror<1>(m);
  return m;
}
__device__ __forceinline__ float wave_sum_dpp(float s) {
  s = row16_sum(s);
  const int si = __float_as_int(s);
  return __int_as_float(__builtin_amdgcn_readlane(si, 0)) + __int_as_float(__builtin_amdgcn_readlane(si, 16)) +
         (__int_as_float(__builtin_amdgcn_readlane(si, 32)) + __int_as_float(__builtin_amdgcn_readlane(si, 48)));
}
__device__ __forceinline__ constexpr int cand_i(int L) {
  return L < 16 ? 0 : L < 24 ? 1 : L < 29 ? 2 : L < 33 ? 3 : L < 36 ? 4 : L < 38 ? 5 : L < 40 ? 6 : L < 42 ? 7 : (L - 42 + 8);
}
__device__ __forceinline__ constexpr int cand_j(int L) {
  return L < 16 ? L : L < 24 ? L - 16 : L < 29 ? L - 24 : L < 33 ? L - 29 : L < 36 ? L - 33 : L < 38 ? L - 36 : L < 40 ? L - 38 : L < 42 ? L - 40 : 0;
}
template <int K> struct CandRank {
  static __device__ __forceinline__ void run(int ki, unsigned key, int& rank) {
    const unsigned o = (unsigned)__builtin_amdgcn_readlane(ki, K);
    rank += (o > key) ? 1 : 0;
    CandRank<K + 1>::run(ki, key, rank);
  }
};
template <> struct CandRank<50> { static __device__ __forceinline__ void run(int, unsigned, int&) {} };
__device__ __forceinline__ unsigned peer_f2ord(float f) {
  if (f == 0.f) f = 0.f;
  const unsigned u = __float_as_uint(f);
  return (u & 0x80000000u) ? ~u : (u | 0x80000000u);
}
__device__ __forceinline__ float peer_ord2f(unsigned u) { return __uint_as_float((u & 0x80000000u) ? (u ^ 0x80000000u) : ~u); }
__device__ __forceinline__ unsigned umax3(unsigned a, unsigned b, unsigned c) { const unsigned t = a > b ? a : b; return t > c ? t : c; }
template <int N> __device__ __forceinline__ unsigned row_ror_u(unsigned x) {
  return (unsigned)__builtin_amdgcn_update_dpp(0, (int)x, 0x120 + N, 0xf, 0xf, false);
}
__device__ __forceinline__ unsigned row16_umax(unsigned m) {
  unsigned t;
  t = row_ror_u<8>(m); m = t > m ? t : m; t = row_ror_u<4>(m); m = t > m ? t : m;
  t = row_ror_u<2>(m); m = t > m ? t : m; t = row_ror_u<1>(m); m = t > m ? t : m;
  return m;
}
__device__ __forceinline__ float gelu_exact(float v) { return 0.5f * v * (1.f + erff(v * 0.7071067811865476f)); }

typedef float f32x2_t __attribute__((ext_vector_type(2)));
typedef unsigned peer_u32x2 __attribute__((ext_vector_type(2)));
__device__ __forceinline__ float peer_fold32(float a, float b) {
  const peer_u32x2 r = __builtin_amdgcn_permlane32_swap(__float_as_uint(a), __float_as_uint(b), false, false);
  return __uint_as_float(r.x) + __uint_as_float(r.y);
}
__device__ __forceinline__ float peer_fold16(float a, float b) {
  const peer_u32x2 r = __builtin_amdgcn_permlane16_swap(__float_as_uint(a), __float_as_uint(b), false, false);
  return __uint_as_float(r.x) + __uint_as_float(r.y);
}
#define GAS __attribute__((address_space(1)))
#define PEER_NB 6
#define PEER_LOAD(buf, TAB, tk, e0)                                                               \
  {                                                                                               \
    const unsigned* rp_ = (const unsigned*)(ridx + ((tk) * 128 + (e0)));                          \
    const unsigned w0_ = rp_[0], w1_ = rp_[1], w2_ = rp_[2];                                      \
    const int i0_ = __builtin_amdgcn_readfirstlane((int)(w0_ & 0x3fffu)), i1_ = __builtin_amdgcn_readfirstlane((int)((w0_ >> 16) & 0x3fffu)); \
    const int i2_ = __builtin_amdgcn_readfirstlane((int)(w1_ & 0x3fffu)), i3_ = __builtin_amdgcn_readfirstlane((int)((w1_ >> 16) & 0x3fffu)); \
    const int i4_ = __builtin_amdgcn_readfirstlane((int)(w2_ & 0x3fffu)), i5_ = __builtin_amdgcn_readfirstlane((int)((w2_ >> 16) & 0x3fffu)); \
    buf[0] = *(const GAS u32x4_t*)((TAB) + (size_t)i0_ * 1024 + lane * 16);                       \
    buf[1] = *(const GAS u32x4_t*)((TAB) + (size_t)i1_ * 1024 + lane * 16);                       \
    buf[2] = *(const GAS u32x4_t*)((TAB) + (size_t)i2_ * 1024 + lane * 16);                       \
    buf[3] = *(const GAS u32x4_t*)((TAB) + (size_t)i3_ * 1024 + lane * 16);                       \
    buf[4] = *(const GAS u32x4_t*)((TAB) + (size_t)i4_ * 1024 + lane * 16);                       \
    buf[5] = *(const GAS u32x4_t*)((TAB) + (size_t)i5_ * 1024 + lane * 16);                       \
  }
#define PEER_UDOT(buf, e0)                                                                        \
  {                                                                                               \
    float sp[6];                                                                                  \
    _Pragma("unroll") for (int j = 0; j < 6; ++j) {                                               \
      float s0 = 0.f, s1 = 0.f;                                                                   \
      _Pragma("unroll") for (int w = 0; w < 4; ++w) {                                             \
        const f32x2_t lo = __builtin_amdgcn_cvt_pk_f32_fp8((int)buf[j][w], false);                \
        const f32x2_t hi = __builtin_amdgcn_cvt_pk_f32_fp8((int)buf[j][w], true);                 \
        s0 = __builtin_fmaf(lo.x, hf[4 * w], s0); s1 = __builtin_fmaf(lo.y, hf[4 * w + 1], s1);   \
        s0 = __builtin_fmaf(hi.x, hf[4 * w + 2], s0); s1 = __builtin_fmaf(hi.y, hf[4 * w + 3], s1); \
      }                                                                                           \
      sp[j] = s0 + s1;                                                                            \
    }                                                                                             \
    const float u01 = peer_fold32(sp[0], sp[1]), u23 = peer_fold32(sp[2], sp[3]), u45 = peer_fold32(sp[4], sp[5]); \
    const float wq = row16_sum(peer_fold16(u01, u23));     \
    const float wr = row16_sum(peer_fold16(u45, u45));         \
    const int wqi = __float_as_int(wq), wri = __float_as_int(wr);                                 \
    PEER_PUT((e0) + 0, __builtin_amdgcn_readlane(wqi, 0));                                        \
    PEER_PUT((e0) + 1, __builtin_amdgcn_readlane(wqi, 32));                                       \
    PEER_PUT((e0) + 2, __builtin_amdgcn_readlane(wqi, 16));                                       \
    PEER_PUT((e0) + 3, __builtin_amdgcn_readlane(wqi, 48));                                       \
    PEER_PUT((e0) + 4, __builtin_amdgcn_readlane(wri, 0));                                        \
    PEER_PUT((e0) + 5, __builtin_amdgcn_readlane(wri, 32));                                       \
  }
#define PEER_PUT(ee_, vi_)                                                                        \
  {                                                                                               \
    const int ee = (ee_); const float sv = __int_as_float(vi_);                                   \
    const bool mine = (lane == (ee & 63));                                                        \
    dotA = (mine && ee < 64) ? sv : dotA;                                                         \
    dotB = (mine && ee >= 64 && ee < 128) ? sv : dotB;                                            \
  }
#define PEER_VACC(buf, e0)                                                                        \
  _Pragma("unroll") for (int j = 0; j < PEER_NB; ++j) {                                                 \
    const int ee = (e0) + j;                                                                      \
    const float a = (ee < 128) ? __int_as_float(__builtin_amdgcn_readlane(__float_as_int(ee < 64 ? aA : aB), ee & 63)) : 0.f; \
    _Pragma("unroll") for (int w = 0; w < 4; ++w) {                                               \
      const f32x2_t lo = __builtin_amdgcn_cvt_pk_f32_fp8((int)buf[j][w], false);                  \
      const f32x2_t hi = __builtin_amdgcn_cvt_pk_f32_fp8((int)buf[j][w], true);                   \
      acc[4 * w] += a * lo.x; acc[4 * w + 1] += a * lo.y; acc[4 * w + 2] += a * hi.x; acc[4 * w + 3] += a * hi.y; \
    }                                                                                             \
    __builtin_amdgcn_sched_barrier(0);                                                           \
  }

#ifndef PROBE_PEER
#define PROBE_PEER 0
#endif
#if PROBE_PEER
#define PEER_MARK(k) do { const unsigned long long n_ = __builtin_amdgcn_s_memrealtime(); if (PROBE_PEER == (k)) { const unsigned long long q_ = n_ - pmark; \
    while (__builtin_amdgcn_s_memrealtime() - n_ < q_) __builtin_amdgcn_s_sleep(2); } pmark = __builtin_amdgcn_s_memrealtime(); } while (0)
#else
#define PEER_MARK(k) do {} while (0)
#endif
__device__ __forceinline__ void ph_peer512(const P& p, unsigned char* lds_raw, float* dst_base) {
  const int tid = tid_fresh(), wave = tid >> 6, lane = tid & 63, g = lane >> 4, c = lane & 15;
  const bf16* PQ = (const bf16*)(p.ws + OFF_PQ);
  const bf16* SK = (const bf16*)(p.ws + OFF_SK);
  float* tv = (float*)(lds_raw + wave * 16384);
  int* ti = (int*)(tv + 512);
  float* rgate = (float*)(ti + 512);
  unsigned short* ridx = (unsigned short*)(rgate + 2048);
  for (int tile = blockIdx.x * 8 + wave; tile < TT / 16; tile += gridDim.x * 8) {
    const int tok0 = tile * 16;
#if PROBE_PEER
    unsigned long long pmark = __builtin_amdgcn_s_memrealtime();
#endif
    unsigned* tk = (unsigned*)tv;
#pragma unroll 1
    for (int hp = 0; hp < 4; ++hp) {
#pragma unroll 1
      for (int hf = 0; hf < 2; ++hf) {
        bf16x8_t bfr[4][8];
#pragma unroll
        for (int ks = 0; ks < 4; ++ks)
#pragma unroll
          for (int nt = 0; nt < 8; ++nt) bfr[ks][nt] = *(const bf16x8_t*)(SK + hf * 16384 + ((nt * 4 + ks) * 64 + lane) * 8);
#pragma unroll 1
        for (int h2 = 0; h2 < 2; ++h2) {
          const int hd = 2 * hp + h2;
          f32x4 acc[8];
#pragma unroll
          for (int nt = 0; nt < 8; ++nt) acc[nt] = (f32x4){0.f, 0.f, 0.f, 0.f};
#pragma unroll
          for (int ks = 0; ks < 4; ++ks) {
            const bf16x8_t a = *(const bf16x8_t*)(PQ + ((size_t)(tile * 64 + hd * 8 + hf * 4 + ks) * 64 + lane) * 8);
#pragma unroll
            for (int nt = 0; nt < 8; ++nt) acc[nt] = __builtin_amdgcn_mfma_f32_16x16x32_bf16(a, bfr[ks][nt], acc[nt], 0, 0, 0);
          }
          asm volatile("" :: "v"(acc[0][0]), "v"(acc[7][3]));
          PEER_MARK(1);
          unsigned kq[4][8], res[4];
#pragma unroll
          for (int i = 0; i < 4; ++i) {
            res[i] = 0u;
#pragma unroll
            for (int nt = 0; nt < 8; ++nt) kq[i][nt] = (peer_f2ord(acc[nt][i]) & ~127u) | (unsigned)(127 - (16 * nt + c));
          }
#pragma unroll 1
          for (int r = 0; r < 16; ++r) {
#pragma unroll
            for (int i = 0; i < 4; ++i) {
              unsigned m = umax3(umax3(kq[i][0], kq[i][1], kq[i][2]), umax3(kq[i][3], kq[i][4], kq[i][5]), (kq[i][6] > kq[i][7]) ? kq[i][6] : kq[i][7]);
              m = row16_umax(m);
#pragma unroll
              for (int nt = 0; nt < 8; ++nt) kq[i][nt] = (kq[i][nt] == m) ? 0u : kq[i][nt];
              res[i] = (c == r) ? m : res[i];
            }
          }
#pragma unroll
          for (int i = 0; i < 4; ++i) tk[((h2 * 2 + hf) * 16 + 4 * g + i) * 16 + c] = res[i];
        }
      }
      wave_lds_fence();
      PEER_MARK(2);
      const int ci = cand_i(lane < 50 ? lane : 0), cj = cand_j(lane < 50 ? lane : 0);
#pragma unroll 1
      for (int hr = 0; hr < 32; ++hr) {
        const int h2 = hr >> 4, row = hr & 15, hd = 2 * hp + h2;
        const unsigned k1 = tk[((h2 * 2 + 0) * 16 + row) * 16 + ci], k2 = tk[((h2 * 2 + 1) * 16 + row) * 16 + cj];
        const float val = peer_ord2f(k1 & ~127u) + peer_ord2f(k2 & ~127u);
        const unsigned key = (lane < 50) ? ((peer_f2ord(val) & ~63u) | (unsigned)(63 - lane)) : 0u;
        int rank = 0;
        CandRank<0>::run((int)key, key, rank);
        if (lane < 50 && rank < 16) {
          rgate[row * 128 + hd * 16 + rank] = val;
          ridx[row * 128 + hd * 16 + rank] = (unsigned short)((127 - (int)(k1 & 127u)) * 128 + (127 - (int)(k2 & 127u)));
        }
      }
      wave_lds_fence();
      PEER_MARK(3);
#pragma unroll
      for (int h2 = 0; h2 < 2; ++h2) {
        const int hd = 2 * hp + h2;
        const int row = lane >> 2, q = lane & 3;
        float* gp = rgate + row * 128 + hd * 16;
        const float mx = gp[0];
        const f32x4 b4 = *(const f32x4*)(gp + q * 4);
        f32x4 e4;
        e4[0] = __expf(b4[0] - mx); e4[1] = __expf(b4[1] - mx); e4[2] = __expf(b4[2] - mx); e4[3] = __expf(b4[3] - mx);
        float s = (e4[0] + e4[1]) + (e4[2] + e4[3]);
        s += __shfl_xor(s, 1); s += __shfl_xor(s, 2);
        const float inv = 1.f / s;
        wave_lds_fence();
        *(f32x4*)(gp + q * 4) = e4 * inv;
      }
      wave_lds_fence();
    }
    char* wsl = p.ws;
    asm volatile("" : "+s"(wsl));
    const GAS bf16* H2 = (const GAS bf16*)(wsl + OFF_H);
    const GAS unsigned char* PU = (const GAS unsigned char*)(wsl + OFF_PU);
    const GAS unsigned char* PV = (const GAS unsigned char*)(wsl + OFF_PV);
    const GAS float* USC = (const GAS float*)(wsl + OFF_PSC);
    const GAS float* VSC = USC + 16384;
    const GAS float* ada = (const GAS float*)(wsl + OFF_ADA);
    u32x4_t a0[PEER_NB], a1[PEER_NB], hn0, hn1;
#define PSB() __builtin_amdgcn_sched_barrier(0)
#define PEER_ROWS (((128 + 2 * PEER_NB - 1) / (2 * PEER_NB)) * 2 * PEER_NB)
    {
      const int tidx = tid_fresh(), lane = tidx & 63, wv = __builtin_amdgcn_readfirstlane(tidx >> 6);
      const unsigned short* ridx = (const unsigned short*)(lds_raw + wv * 16384 + 4096 + 8192);
      hn0 = *(const GAS u32x4_t*)(H2 + (size_t)tok0 * 1024 + lane * 16); hn1 = *(const GAS u32x4_t*)(H2 + (size_t)tok0 * 1024 + lane * 16 + 8);
      PEER_LOAD(a0, PU, 0, 0); PSB();
      PEER_LOAD(a1, PU, 0, PEER_NB); PSB();
    }
#pragma unroll 1
    for (int tt = 0; tt < 16; ++tt) {
      const int tidx = tid_fresh(), lane = tidx & 63, wv = __builtin_amdgcn_readfirstlane(tidx >> 6);
      const float* rgate = (const float*)(lds_raw + wv * 16384 + 4096);
      const unsigned short* ridx = (const unsigned short*)(lds_raw + wv * 16384 + 4096 + 8192);
      const size_t tok = (size_t)tok0 + tt;
      const int ttn = (tt < 15) ? tt + 1 : tt;
      float hf[16];
#pragma unroll
      for (int w = 0; w < 4; ++w) { hf[2 * w] = bflo(hn0[w]); hf[2 * w + 1] = bfhi(hn0[w]); hf[8 + 2 * w] = bflo(hn1[w]); hf[8 + 2 * w + 1] = bfhi(hn1[w]); }
      const int eA = (int)ridx[tt * 128 + lane], eB = (int)ridx[tt * 128 + 64 + lane];
      const float usA = USC[eA], usB = USC[eB];
      float dotA = 0.f, dotB = 0.f;
#pragma unroll 1
      for (int e0 = 0; e0 < PEER_ROWS; e0 += 2 * PEER_NB) {
        const bool more = e0 + 2 * PEER_NB < PEER_ROWS;
        const GAS unsigned char* tb = more ? PU : PV;
        const int r0 = more ? e0 + 2 * PEER_NB : 0;
        PEER_UDOT(a0, e0); PSB();
        PEER_LOAD(a0, tb, tt, r0); PSB();
        PEER_UDOT(a1, e0 + PEER_NB); PSB();
        PEER_LOAD(a1, tb, tt, r0 + PEER_NB); PSB();
      }
      const float aA = gelu_exact(dotA * usA) * rgate[tt * 128 + lane] * VSC[(int)ridx[tt * 128 + lane]],
                  aB = gelu_exact(dotB * usB) * rgate[tt * 128 + 64 + lane] * VSC[(int)ridx[tt * 128 + 64 + lane]];
      float acc[16];
#pragma unroll
      for (int k = 0; k < 16; ++k) acc[k] = 0.f;
      hn0 = *(const GAS u32x4_t*)(H2 + ((size_t)tok0 + ttn) * 1024 + lane * 16); hn1 = *(const GAS u32x4_t*)(H2 + ((size_t)tok0 + ttn) * 1024 + lane * 16 + 8);
      PSB();
#pragma unroll 1
      for (int e0 = 0; e0 < PEER_ROWS; e0 += 2 * PEER_NB) {
        const bool more = e0 + 2 * PEER_NB < PEER_ROWS;
        const GAS unsigned char* tb = more ? PV : PU;
        const int r0 = more ? e0 + 2 * PEER_NB : 0, tkk = more ? tt : ttn;
        PEER_VACC(a0, e0); PSB();
        PEER_LOAD(a0, tb, tkk, r0); PSB();
        PEER_VACC(a1, e0 + PEER_NB); PSB();
        PEER_LOAD(a1, tb, tkk, r0 + PEER_NB); PSB();
      }
      const int b = (int)(tok >> 12);
      const GAS float* xrow = (const GAS float*)p.out + tok * 1024;
      GAS float* orow = (GAS float*)dst_base + tok * 1024;
      const GAS float* g2 = ada + b * 6144 + 5120;
      float x2[16];
      float ss = 0.f;
#pragma unroll
      for (int q = 0; q < 4; ++q) {
        const int col = lane * 16 + q * 4;
        const f32x4 xv = *(const GAS f32x4*)(xrow + col), gv = *(const GAS f32x4*)(g2 + col);
#pragma unroll
        for (int k = 0; k < 4; ++k) { const float t = xv[k] + gv[k] * acc[q * 4 + k]; x2[q * 4 + k] = t; ss += t * t; }
      }
      ss = wave_sum_dpp(ss);
      const float rstd = rsqrtf(ss * (1.f / 1024.f) + 1e-6f);
#pragma unroll
      for (int q = 0; q < 4; ++q) {
        const int col = lane * 16 + q * 4;
        const f32x4 fg = *(const GAS f32x4*)((const GAS float*)(wsl + OFF_PRM) + PRM_FG + col);
        f32x4 o;
#pragma unroll
        for (int k = 0; k < 4; ++k) o[k] = x2[q * 4 + k] * rstd * fg[k];
        *(GAS f32x4*)(orow + col) = o;
      }
    }
    wave_lds_fence();
  }
}

#define DS_KEY16   0
#define DS_CHUNK   17408
#define DS_SEL     139264
#define DS_WAVE    147456
#define DS_TOTAL   155648
#define DS_RS      544

__device__ __forceinline__ unsigned f2ord(float f) {
  if (f == 0.f) f = 0.f;
  unsigned u = __float_as_uint(f);
  return (u & 0x80000000u) ? ~u : (u | 0x80000000u);
}
__device__ __forceinline__ int wave_scan_incl(int v, int lane) {
#pragma unroll
  for (int o = 1; o < 64; o <<= 1) { const int t = __shfl_up(v, o); v += (lane >= o) ? t : 0; }
  return v;
}
__device__ __forceinline__ void find_digit(const LAS unsigned* hist, int K, int lane, int& digit, int& above) {
  const u32x4_t h4 = *(const LAS u32x4_t*)(hist + 252 - 4 * lane);
  const int c0 = (int)h4.w, c1 = (int)h4.z, c2 = (int)h4.y, c3 = (int)h4.x;
  const int tot = c0 + c1 + c2 + c3;
  int run = wave_scan_incl(tot, lane) - tot;
  int found = -1, ab = 0;
  if (run < K && run + c0 >= K) { found = 255 - 4 * lane; ab = run; } run += c0;
  if (run < K && run + c1 >= K) { found = 254 - 4 * lane; ab = run; } run += c1;
  if (run < K && run + c2 >= K) { found = 253 - 4 * lane; ab = run; } run += c2;
  if (run < K && run + c3 >= K) { found = 252 - 4 * lane; ab = run; }
  const unsigned long long mk = __ballot(found >= 0);
  const int src = (int)__ffsll((unsigned long long)mk) - 1;
  digit = __builtin_amdgcn_readlane(found, src);
  above = __builtin_amdgcn_readlane(ab, src);
}

typedef unsigned u32x2_t __attribute__((ext_vector_type(2)));
__device__ __forceinline__ float xrow_max(float x) {
  u32x2_t r = __builtin_amdgcn_permlane16_swap(__float_as_uint(x), __float_as_uint(x), false, false);
  x = fmaxf(__uint_as_float(r.x), __uint_as_float(r.y));
  r = __builtin_amdgcn_permlane32_swap(__float_as_uint(x), __float_as_uint(x), false, false);
  return fmaxf(__uint_as_float(r.x), __uint_as_float(r.y));
}
__device__ __forceinline__ float xrow_sum(float x) {
  u32x2_t r = __builtin_amdgcn_permlane16_swap(__float_as_uint(x), __float_as_uint(x), false, false);
  x = __uint_as_float(r.x) + __uint_as_float(r.y);
  r = __builtin_amdgcn_permlane32_swap(__float_as_uint(x), __float_as_uint(x), false, false);
  return __uint_as_float(r.x) + __uint_as_float(r.y);
}
__device__ __forceinline__ s16x4_t tr_read_b64(unsigned addr) {
  s16x4_t r; asm volatile("ds_read_b64_tr_b16 %0, %1" : "=&v"(r) : "v"(addr) : "memory"); return r;
}

#ifndef PROBE_DSA
#define PROBE_DSA 0
#endif
#if PROBE_DSA
#define DSA_MARK(k) do { const unsigned long long n_ = __builtin_amdgcn_s_memrealtime(); if (PROBE_DSA == (k)) { const unsigned long long q_ = n_ - tmark; \
    while (__builtin_amdgcn_s_memrealtime() - n_ < q_) __builtin_amdgcn_s_sleep(2); } tmark = __builtin_amdgcn_s_memrealtime(); } while (0)
#else
#define DSA_MARK(k) do {} while (0)
#endif
#if PROBE_DSA >= 10
#define DSA_MARKI(k) DSA_MARK(k)
#else
#define DSA_MARKI(k) do {} while (0)
#endif
__device__ __forceinline__ void dsa_batch(const P& p, unsigned char* lds_raw, int b, int pos2) {
  const int t00 = pos2 * 32;
#define DSA_IDS const int tid = tid_fresh(), wave = __builtin_amdgcn_readfirstlane(tid >> 6), lane = tid & 63, g = lane >> 4, c = lane & 15; (void)wave; (void)g; (void)c;
  const size_t tokb = (size_t)b * SEQ, tok00 = tokb + t00;
  const bf16* DQ = (const bf16*)(p.ws + OFF_DQ);
  const bf16* CKV = (const bf16*)(p.ws + OFF_CKV);
  const float* SSP = (const float*)(p.ws + OFF_SSP);
  const bf16* IQ = (const bf16*)(p.ws + OFF_IQ);
  const bf16* IK = (const bf16*)(p.ws + OFF_IK);
  const float* IW = (const float*)(p.ws + OFF_IW);
  const bf16* WUK = (const bf16*)(p.ws + OFF_WUK);
  const bf16* WUV = (const bf16*)(p.ws + OFF_WUV);
  bf16* ODSA = (bf16*)(p.ws + OFF_ODSA);
  bf16* QL = (bf16*)(p.ws + OFF_DSCR + (size_t)blockIdx.x * 131072);
  bf16* OL = QL;
  LAS unsigned char* lds = (LAS unsigned char*)lds_raw;
  LAS unsigned short* key16 = (LAS unsigned short*)(lds + DS_KEY16);
  LAS unsigned short* sel = (LAS unsigned short*)(lds + DS_SEL);

#if PROBE_DSA
  unsigned long long tmark = __builtin_amdgcn_s_memrealtime();
#endif
  {
    DSA_IDS
    const int h = wave;
    bf16x8_t dq0[4], dq1[4];
#pragma unroll
    for (int ks = 0; ks < 4; ++ks) {
      dq0[ks] = *(const bf16x8_t*)(DQ + (((tok00 >> 4) * 32 + h * 4 + ks) * 64 + lane) * 8);
      dq1[ks] = *(const bf16x8_t*)(DQ + ((((tok00 >> 4) + 1) * 32 + h * 4 + ks) * 64 + lane) * 8);
    }
#pragma unroll 1
    for (int hn = 0; hn < 2; ++hn) {
      bf16x8_t wf[8][4];
#pragma unroll
      for (int n8 = 0; n8 < 8; ++n8)
#pragma unroll
        for (int ks = 0; ks < 4; ++ks) wf[n8][ks] = *(const bf16x8_t*)(WUK + (size_t)((h * 16 + hn * 8 + n8) * 4 + ks) * 512 + lane * 8);
      __builtin_amdgcn_sched_barrier(0);
#pragma unroll
      for (int n8 = 0; n8 < 8; ++n8) {
        const int nt = hn * 8 + n8;
        f32x4 a0 = (f32x4){0.f, 0.f, 0.f, 0.f}, a1 = a0;
#pragma unroll
        for (int ks = 0; ks < 4; ++ks) {
          a0 = __builtin_amdgcn_mfma_f32_16x16x32_bf16(wf[n8][ks], dq0[ks], a0, 0, 0, 0);
          a1 = __builtin_amdgcn_mfma_f32_16x16x32_bf16(wf[n8][ks], dq1[ks], a1, 0, 0, 0);
        }
        uint2 o; o.x = pk2(a0[0], a0[1]); o.y = pk2(a0[2], a0[3]);
        *(uint2*)(QL + c * 2048 + h * 256 + nt * 16 + 4 * g) = o;
        o.x = pk2(a1[0], a1[1]); o.y = pk2(a1[2], a1[3]);
        *(uint2*)(QL + (16 + c) * 2048 + h * 256 + nt * 16 + 4 * g) = o;
      }
      __builtin_amdgcn_sched_barrier(0);
    }
  }
  DSA_MARK(1);
#pragma unroll 1
  for (int half = 0; half < 2; ++half) {
  const int t0 = t00 + 16 * half;
  const size_t tok0 = tokb + t0;
  bf16* QLh = QL + half * 16 * 2048;
  bf16* OLh = QLh;
  if (t0 >= 256) {
    DSA_IDS
    bf16x8_t qf[8][2];
    float iw[8];
#pragma unroll
    for (int h = 0; h < 8; ++h) {
      qf[h][0] = *(const bf16x8_t*)(IQ + (((tok0 >> 4) * 16 + h * 2) * 64 + lane) * 8);
      qf[h][1] = *(const bf16x8_t*)(IQ + (((tok0 >> 4) * 16 + h * 2 + 1) * 64 + lane) * 8);
      iw[h] = IW[(tok0 + c) * 8 + h];
    }
    const int ntile = (t0 >> 4) + 1;
    bf16x8_t k0n = (bf16x8_t){0, 0, 0, 0, 0, 0, 0, 0}, k1n = k0n;
    if (wave < ntile) { const bf16* kr = IK + ((((tokb >> 4) + wave) * 2) * 64 + lane) * 8; k0n = *(const bf16x8_t*)kr; k1n = *(const bf16x8_t*)(kr + 512); }
    for (int kt = wave; kt < ntile; kt += 8) {
      const bf16x8_t k0 = k0n, k1 = k1n;
      { const int ktn = (kt + 8 < ntile) ? kt + 8 : kt; const bf16* kr = IK + ((((tokb >> 4) + ktn) * 2) * 64 + lane) * 8; k0n = *(const bf16x8_t*)kr; k1n = *(const bf16x8_t*)(kr + 512); }
      f32x4 sc = (f32x4){0.f, 0.f, 0.f, 0.f};
#pragma unroll
      for (int h = 0; h < 8; ++h) {
        f32x4 d = __builtin_amdgcn_mfma_f32_16x16x32_bf16(k0, qf[h][0], (f32x4){0.f, 0.f, 0.f, 0.f}, 0, 0, 0);
        d = __builtin_amdgcn_mfma_f32_16x16x32_bf16(k1, qf[h][1], d, 0, 0, 0);
#pragma unroll
        for (int i = 0; i < 4; ++i) sc[i] += iw[h] * fmaxf(d[i], 0.f);
      }
      u16x4_t o;
      const int sb = kt * 16 + 4 * g, tq = t0 + c;
      o.x = (sb + 0 <= tq) ? (unsigned short)(f2ord(sc[0]) >> 16) : (unsigned short)0;
      o.y = (sb + 1 <= tq) ? (unsigned short)(f2ord(sc[1]) >> 16) : (unsigned short)0;
      o.z = (sb + 2 <= tq) ? (unsigned short)(f2ord(sc[2]) >> 16) : (unsigned short)0;
      o.w = (sb + 3 <= tq) ? (unsigned short)(f2ord(sc[3]) >> 16) : (unsigned short)0;
      *(LAS u16x4_t*)(key16 + c * 4096 + sb) = o;
    }
  }
  DSA_MARK(2);
  __syncthreads();
#pragma unroll 1
  for (int qq = 0; qq < 2; ++qq) {
    DSA_IDS
    const int q = wave + 8 * qq, t = t0 + q;
    LAS unsigned short* selq = sel + q * 256;
    if (t < 256) {
      for (int j = lane; j < 256; j += 64) selq[j] = (unsigned short)((j <= t) ? j : 0);
    } else {
      const LAS unsigned short* kq = key16 + q * 4096;
      const int nit = (t >> 9) + 1;
      unsigned kp[8][4];
#pragma unroll
      for (int it = 0; it < 8; ++it) {
        const int s0 = 512 * it + 8 * lane;
        u32x4_t v = (u32x4_t){0u, 0u, 0u, 0u};
        if (s0 <= t) v = *(const LAS u32x4_t*)(kq + s0);
#pragma unroll
        for (int j = 0; j < 4; ++j) {
          const unsigned lo = (s0 + 2 * j <= t) ? (v[j] & 0xffffu) : 0u, hi = (s0 + 2 * j + 1 <= t) ? (v[j] & 0xffff0000u) : 0u;
          kp[it][j] = lo | hi;
        }
      }
      asm volatile("" :: "v"(kp[0][0]), "v"(kp[7][3]));
      DSA_MARKI(21);
      unsigned B = 0u;
#pragma unroll 1
      for (int bit = 15; bit >= 0; --bit) {
        const unsigned cand = B | (1u << bit);
        const unsigned c2 = (cand - 1u) * 0x00010001u;
        unsigned cnt2 = 0u;
#pragma unroll
        for (int it = 0; it < 8; ++it) {
          if (it < nit) {
#pragma unroll
            for (int j = 0; j < 4; ++j) {
              unsigned dd;
              asm("v_pk_sub_u16 %0, %1, %2 clamp\n\tv_pk_min_u16 %0, %0, %3" : "=&v"(dd) : "v"(kp[it][j]), "v"(c2), "v"(0x00010001u));
              cnt2 += dd;
            }
          }
        }
        const int tot = (int)wave_sum_dpp((float)((cnt2 & 0xffffu) + (cnt2 >> 16)));
        if (tot >= 256) B = cand;
      }
      int cgt = 0;
#pragma unroll
      for (int it = 0; it < 8; ++it)
#pragma unroll
        for (int j = 0; j < 4; ++j) cgt += (((kp[it][j] & 0xffffu) > B) ? 1 : 0) + (((kp[it][j] >> 16) > B) ? 1 : 0);
      const int m = 256 - (int)wave_sum_dpp((float)cgt);
      DSA_MARKI(22);
      int base = 0, eqbase = 0;
#pragma unroll
      for (int it = 0; it < 8; ++it) {
        if (it < nit) {
          unsigned kk[8];
#pragma unroll
          for (int j = 0; j < 4; ++j) { kk[2 * j] = kp[it][j] & 0xffffu; kk[2 * j + 1] = kp[it][j] >> 16; }
          unsigned anyeq = 0u;
#pragma unroll
          for (int j = 0; j < 8; ++j) anyeq |= (kk[j] == B) ? 1u : 0u;
          int eqlow = 0, eqtot = 0;
          if (__builtin_amdgcn_ballot_w64(anyeq != 0u) != 0ull) {
#pragma unroll
            for (int j = 0; j < 8; ++j) {
              const unsigned long long mk = __builtin_amdgcn_ballot_w64(kk[j] == B);
              eqlow += (int)__builtin_amdgcn_mbcnt_hi((unsigned)(mk >> 32), __builtin_amdgcn_mbcnt_lo((unsigned)mk, 0u));
              eqtot += __builtin_popcountll(mk);
            }
          }
          int eqr = eqbase + eqlow;
          int ps = base, tot = 0;
          bool tk[8];
#pragma unroll
          for (int j = 0; j < 8; ++j) {
            const bool eq = kk[j] == B;
            tk[j] = (kk[j] > B) || (eq && eqr < m);
            eqr += eq ? 1 : 0;
          }
#pragma unroll
          for (int j = 0; j < 8; ++j) {
            const unsigned long long mk = __builtin_amdgcn_ballot_w64(tk[j]);
            ps += (int)__builtin_amdgcn_mbcnt_hi((unsigned)(mk >> 32), __builtin_amdgcn_mbcnt_lo((unsigned)mk, 0u));
            tot += __builtin_popcountll(mk);
          }
#pragma unroll
          for (int j = 0; j < 8; ++j) {
            if (tk[j]) { if (ps < 256) selq[ps] = (unsigned short)(512 * it + 8 * lane + j); ++ps; }
          }
          base += tot;
          eqbase += eqtot;
        }
      }
    }
  }
  DSA_MARK(3);
  __syncthreads();
  {
    DSA_IDS
    const int wave_b = wave;
    const float slope = (c < 8) ? exp2f(-(float)(c + 1)) : 0.f;
#pragma unroll 1
    for (int qq = 0; qq < 2; ++qq) {
      const int q = wave + 8 * qq, t = t0 + q;
      const int nsel = (t + 1 < 256) ? (t + 1) : 256, nch = (nsel + 31) >> 5;
      const LAS unsigned short* selq = sel + q * 256;
      bf16x8_t qf[8];
      {
        const int lq = tid_fresh() & 63;
        const bf16* qlp = QLh + q * 2048 + (lq & 7) * 256 + 8 * (lq >> 4);
#pragma unroll
        for (int ks = 0; ks < 8; ++ks) qf[ks] = *(const bf16x8_t*)(qlp + ks * 32);
      }
      float mrun = -1e30f, lrun = 0.f;
      f32x4 o[16];
#pragma unroll
      for (int nt = 0; nt < 16; ++nt) o[nt] = (f32x4){0.f, 0.f, 0.f, 0.f};
      u32x4_t st[16];
      f32x4 st_ss = (f32x4){0.f, 0.f, 0.f, 0.f}; float st_d = -1.f;
#define DSA_ISSUE(ch)                                                                                   \
      {          \
        _Pragma("unroll") for (int r = 0; r < 16; ++r) {                                                \
          const int idx = (int)selq[(ch) * 32 + 2 * r + (lane >> 5)];                                   \
          st[r] = *(const u32x4_t*)(CKV + (tokb + idx) * 256 + (lane & 31) * 8);                        \
        }                                                                                               \
        const int j2 = (ch) * 32 + (lane & 31);                                                         \
        const int idx2 = (int)selq[j2];                                                                 \
        st_ss = *(const f32x4*)(SSP + (tokb + idx2) * 4);                                               \
        st_d = (j2 < nsel) ? (float)(t - idx2) : -1.f;                                                  \
      }
      DSA_ISSUE(0);
#pragma unroll 1
      for (int ch = 0; ch < nch; ++ch) {
        const int lane = tid_fresh() & 63, g = lane >> 4, c = lane & 15;
        LAS unsigned char* buf = lds + DS_KEY16 + wave_b * DS_CHUNK;
        LAS float* kr = (LAS float*)(lds + DS_WAVE + wave_b * 1024);
        LAS float* kd = kr + 32;
        const unsigned vb = (unsigned)(uintptr_t)buf + (unsigned)((4 * g + (c >> 2)) * DS_RS + 8 * (c & 3));
#pragma unroll
        for (int r = 0; r < 16; ++r) *(LAS u32x4_t*)(buf + (2 * r + (lane >> 5)) * DS_RS + (lane & 31) * 16) = st[r];
        if (lane < 32) { kr[lane] = rsqrtf(((st_ss[0] + st_ss[1]) + (st_ss[2] + st_ss[3])) * (1.f / 256.f) + 1e-6f); kd[lane] = st_d; }
        wave_lds_fence();
        DSA_MARKI(11);
        DSA_ISSUE((ch + 1 < nch) ? ch + 1 : ch);
        f32x4 s0 = (f32x4){0.f, 0.f, 0.f, 0.f}, s1 = (f32x4){0.f, 0.f, 0.f, 0.f};
#pragma unroll
        for (int ks = 0; ks < 8; ++ks) {
          const bf16x8_t a0 = *(const LAS bf16x8_t*)(buf + c * DS_RS + (ks * 32 + 8 * g) * 2);
          const bf16x8_t a1 = *(const LAS bf16x8_t*)(buf + (16 + c) * DS_RS + (ks * 32 + 8 * g) * 2);
          s0 = __builtin_amdgcn_mfma_f32_16x16x32_bf16(a0, qf[ks], s0, 0, 0, 0);
          s1 = __builtin_amdgcn_mfma_f32_16x16x32_bf16(a1, qf[ks], s1, 0, 0, 0);
        }
        asm volatile("" :: "v"(s0[0]), "v"(s1[0]));
        DSA_MARKI(12);
        const f32x4 r0 = *(const LAS f32x4*)(kr + 4 * g), r1 = *(const LAS f32x4*)(kr + 16 + 4 * g);
        const f32x4 d0 = *(const LAS f32x4*)(kd + 4 * g), d1 = *(const LAS f32x4*)(kd + 16 + 4 * g);
        float x[8];
#pragma unroll
        for (int i = 0; i < 4; ++i) {
          x[i] = (d0[i] < 0.f) ? -1e30f : (s0[i] * r0[i] - slope * d0[i]);
          x[4 + i] = (d1[i] < 0.f) ? -1e30f : (s1[i] * r1[i] - slope * d1[i]);
        }
        float mx = fmaxf(fmaxf(fmaxf(x[0], x[1]), fmaxf(x[2], x[3])), fmaxf(fmaxf(x[4], x[5]), fmaxf(x[6], x[7])));
        mx = xrow_max(mx);
        const float mn = fmaxf(mrun, mx);
        const float alpha = __expf(mrun - mn);
        mrun = mn;
        float pr[8], ps = 0.f;
#pragma unroll
        for (int i = 0; i < 8; ++i) { pr[i] = (x[i] <= -1e29f) ? 0.f : __expf(x[i] - mn); ps += pr[i]; }
        ps = xrow_sum(ps);
        lrun = lrun * alpha + ps;
        if (__builtin_amdgcn_ballot_w64(alpha != 1.f) != 0ull) {
#pragma unroll
          for (int nt = 0; nt < 16; ++nt) o[nt] *= alpha;
        }
        union { bf16x8_t v; unsigned u[4]; } pf;
        pf.u[0] = pk2(pr[0] * r0[0], pr[1] * r0[1]); pf.u[1] = pk2(pr[2] * r0[2], pr[3] * r0[3]);
        pf.u[2] = pk2(pr[4] * r1[0], pr[5] * r1[1]); pf.u[3] = pk2(pr[6] * r1[2], pr[7] * r1[3]);
        asm volatile("" :: "v"(pf.u[0]));
        DSA_MARKI(13);
        {
          s16x4_t loA[4], hiA[4], loB[4], hiB[4];
#define PV_READ(L, H, nt0) _Pragma("unroll") for (int u = 0; u < 4; ++u) { L[u] = tr_read_b64(vb + ((nt0) + u) * 32); H[u] = tr_read_b64(vb + ((nt0) + u) * 32 + 16 * DS_RS); }
#define PV_MMA(L, H, nt0) _Pragma("unroll") for (int u = 0; u < 4; ++u) { \
            const bf16x8_t af = (bf16x8_t){L[u][0], L[u][1], L[u][2], L[u][3], H[u][0], H[u][1], H[u][2], H[u][3]}; \
            o[(nt0) + u] = __builtin_amdgcn_mfma_f32_16x16x32_bf16(af, pf.v, o[(nt0) + u], 0, 0, 0); }
          PV_READ(loA, hiA, 0);
          PV_READ(loB, hiB, 4);
          asm volatile("s_waitcnt lgkmcnt(8)" ::: "memory"); __builtin_amdgcn_sched_barrier(0);
          PV_MMA(loA, hiA, 0); __builtin_amdgcn_sched_barrier(0);
          PV_READ(loA, hiA, 8);
          asm volatile("s_waitcnt lgkmcnt(8)" ::: "memory"); __builtin_amdgcn_sched_barrier(0);
          PV_MMA(loB, hiB, 4); __builtin_amdgcn_sched_barrier(0);
          PV_READ(loB, hiB, 12);
          asm volatile("s_waitcnt lgkmcnt(8)" ::: "memory"); __builtin_amdgcn_sched_barrier(0);
          PV_MMA(loA, hiA, 8); __builtin_amdgcn_sched_barrier(0);
          asm volatile("s_waitcnt lgkmcnt(0)" ::: "memory"); __builtin_amdgcn_sched_barrier(0);
          PV_MMA(loB, hiB, 12);
#undef PV_READ
#undef PV_MMA
        }
        wave_lds_fence();
        asm volatile("" :: "v"(o[0][0]), "v"(o[15][0]));
        DSA_MARKI(14);
      }
#undef DSA_ISSUE
      if (c < 8) {
        const float inv = 1.f / lrun;
#pragma unroll
        for (int nt = 0; nt < 16; ++nt) {
          uint2 w; w.x = pk2(o[nt][0] * inv, o[nt][1] * inv); w.y = pk2(o[nt][2] * inv, o[nt][3] * inv);
          *(uint2*)(OLh + q * 2048 + c * 256 + nt * 16 + 4 * g) = w;
        }
      }
    }
  }
  DSA_MARK(4);
  __syncthreads();
  }
  {
    DSA_IDS
    const int h = wave;
    bf16x8_t of0[8], of1[8];
#pragma unroll
    for (int ks = 0; ks < 8; ++ks) {
      of0[ks] = *(const bf16x8_t*)(OL + c * 2048 + h * 256 + ks * 32 + 8 * g);
      of1[ks] = *(const bf16x8_t*)(OL + (16 + c) * 2048 + h * 256 + ks * 32 + 8 * g);
    }
#pragma unroll 1
    for (int np = 0; np < 2; ++np) {
      bf16x8_t wf[4][8];
#pragma unroll
      for (int n4 = 0; n4 < 4; ++n4)
#pragma unroll
        for (int ks = 0; ks < 8; ++ks) wf[n4][ks] = *(const bf16x8_t*)(WUV + (size_t)((h * 8 + np * 4 + n4) * 8 + ks) * 512 + lane * 8);
      __builtin_amdgcn_sched_barrier(0);
#pragma unroll
      for (int n4 = 0; n4 < 4; ++n4) {
        const int nt = np * 4 + n4;
        f32x4 a0 = (f32x4){0.f, 0.f, 0.f, 0.f}, a1 = a0;
#pragma unroll
        for (int ks = 0; ks < 8; ++ks) {
          a0 = __builtin_amdgcn_mfma_f32_16x16x32_bf16(wf[n4][ks], of0[ks], a0, 0, 0, 0);
          a1 = __builtin_amdgcn_mfma_f32_16x16x32_bf16(wf[n4][ks], of1[ks], a1, 0, 0, 0);
        }
        uint2 w; w.x = pk2(a0[0], a0[1]); w.y = pk2(a0[2], a0[3]);
        *(uint2*)(ODSA + (tok00 + c) * 1024 + h * 128 + nt * 16 + 4 * g) = w;
        w.x = pk2(a1[0], a1[1]); w.y = pk2(a1[2], a1[3]);
        *(uint2*)(ODSA + (tok00 + 16 + c) * 1024 + h * 128 + nt * 16 + 4 * g) = w;
      }
      __builtin_amdgcn_sched_barrier(0);
    }
  }
  DSA_MARK(5);
  __syncthreads();
}

#undef DSA_IDS
__device__ __forceinline__ void ph_dsa512(const P& p, unsigned char* lds_raw) {
  for (int it = blockIdx.x; it < TT / 16; it += gridDim.x) {
    const int k = it >> 8, j = it & 255;
    dsa_batch(p, lds_raw, k, ((k & 1) ? 255 - j : j) >> 1);
  }
}

#define GL_QD    0
#define GL_KI    18432
#define GL_KE    36864
#define GL_V     55296
#define GL_AT    90112
#define GL_GLOW  99328
#define GL_QT    103424
#define GL_DEC   105472
#define GL_SSQ   105984
#define GL_LB    108032
#define GL_TOTAL 140800

#define GLA_BAR() do { asm volatile("s_waitcnt lgkmcnt(0)" ::: "memory"); __builtin_amdgcn_s_barrier(); asm volatile("" ::: "memory"); } while (0)
#ifndef PROBE_GLA
#define PROBE_GLA 0
#endif
#if PROBE_GLA
#define GLA_MARK(k) do { const unsigned long long n_ = __builtin_amdgcn_s_memrealtime(); if (PROBE_GLA == (k)) { const unsigned long long q_ = n_ - tmark; \
    while (__builtin_amdgcn_s_memrealtime() - n_ < q_) __builtin_amdgcn_s_sleep(2); } tmark = __builtin_amdgcn_s_memrealtime(); } while (0)
#else
#define GLA_MARK(k) do {} while (0)
#endif
__device__ __forceinline__ void gla_item(const P& p, unsigned char* lds_raw, int item) {
  int tid = tid_fresh();
  const int b = item >> 2, h = item & 3;
  const size_t tokb = (size_t)b * SEQ;
  const bf16* Qg = (const bf16*)(p.ws + OFF_Q);
  const bf16* Kg = (const bf16*)(p.ws + OFF_K);
  bf16* Vg = (bf16*)(p.ws + OFF_V);
  const float* GLOWg = (const float*)(p.ws + OFF_GLOW);
  const bf16* SGR = (const bf16*)(p.ws + OFF_SGR);
  LAS unsigned char* lds = (LAS unsigned char*)lds_raw;
  const unsigned lds0 = (unsigned)(uintptr_t)lds;
  LAS float* QT = (LAS float*)(lds + GL_QT);
  LAS float* DEC = (LAS float*)(lds + GL_DEC);
  LAS float* SSQ = (LAS float*)(lds + GL_SSQ);
  float wg[16];
  const float* prm = (const float*)(p.ws + OFF_PRM);
#pragma unroll
  for (int r = 0; r < 16; ++r) wg[r] = prm[PRM_WGU + r * 512 + h * 128 + (tid & 127)];
  const float bg = prm[PRM_BG + h * 128 + (tid & 127)];
  const float gn0 = prm[PRM_GNG + h * 256 + 32 * (tid >> 6) + (tid & 15)], gn1 = prm[PRM_GNG + h * 256 + 32 * (tid >> 6) + 16 + (tid & 15)];
  u32x4_t rq[2], rk[2], rv[4], rg = (u32x4_t){0u, 0u, 0u, 0u};
#define GLA_LOAD(ch)                                                                                      \
  {                                                                                                       \
    const size_t tb = tokb + (size_t)(ch) * 64;                                                           \
    _Pragma("unroll") for (int i = 0; i < 2; ++i) {                                                       \
      const int id = tid + 512 * i, tk = id >> 4, part = id & 15;                                         \
      rq[i] = *(const u32x4_t*)(Qg + (tb + tk) * 512 + h * 128 + part * 8);                               \
      rk[i] = *(const u32x4_t*)(Kg + (tb + tk) * 512 + h * 128 + part * 8);                               \
    }                                                                                                     \
    _Pragma("unroll") for (int i = 0; i < 4; ++i) {                                                       \
      const int id = tid + 512 * i, tk = id >> 5, part = id & 31;                                         \
      rv[i] = *(const u32x4_t*)(Vg + (tb + tk) * 1024 + h * 256 + part * 8);                              \
    }                                                                                                     \
    if (tid < 256) rg = *(const u32x4_t*)(GLOWg + (tb + (tid >> 2)) * 16 + (tid & 3) * 4);                \
  }
  f32x4 S[8][2];
#pragma unroll
  for (int a = 0; a < 8; ++a) { S[a][0] = (f32x4){0.f, 0.f, 0.f, 0.f}; S[a][1] = (f32x4){0.f, 0.f, 0.f, 0.f}; }
  GLA_LOAD(0);
#if PROBE_GLA
  unsigned long long tmark = __builtin_amdgcn_s_memrealtime();
#endif
#pragma unroll 1
  for (int ch = 0; ch < SEQ / 64; ++ch) {
    asm volatile("" : "+v"(tid));
    const int wave = __builtin_amdgcn_readfirstlane(tid >> 6), lane = tid & 63, g = lane >> 4, c = lane & 15;
    const int d = tid & 127, tq = __builtin_amdgcn_readfirstlane(tid >> 7);
    const unsigned vtr = lds0 + GL_V + (unsigned)((8 * g + (c >> 2)) * 544 + (32 * wave + 4 * (c & 3)) * 2);
    const unsigned ketr = lds0 + GL_KE + (unsigned)((8 * g + (c >> 2)) * 288 + (4 * (c & 3)) * 2);
    const size_t tb = tokb + (size_t)ch * 64;
#pragma unroll
    for (int i = 0; i < 2; ++i) {
      const int id = tid + 512 * i, tk = id >> 4, part = id & 15;
      *(LAS u32x4_t*)(lds + GL_QD + tk * 288 + part * 16) = rq[i];
      *(LAS u32x4_t*)(lds + GL_KI + tk * 288 + part * 16) = rk[i];
    }
#pragma unroll
    for (int i = 0; i < 4; ++i) {
      const int id = tid + 512 * i, tk = id >> 5, part = id & 31;
      *(LAS u32x4_t*)(lds + GL_V + tk * 544 + part * 16) = rv[i];
    }
    if (tid < 256) *(LAS u32x4_t*)(lds + GL_GLOW + (tid >> 2) * 64 + (tid & 3) * 16) = rg;
    GLA_MARK(1); GLA_BAR();
    GLA_LOAD((ch + 1 < SEQ / 64) ? ch + 1 : ch);
    u32x4_t rs[4];
#pragma unroll
    for (int i = 0; i < 4; ++i) {
      const int id = tid + 512 * i, tk = id >> 5, part = id & 31;
      rs[i] = *(const u32x4_t*)(SGR + (tb + tk) * 1024 + h * 256 + part * 8);
    }
    LAS float* LB = (LAS float*)(lds + GL_LB);
    float run = 0.f;
#pragma unroll 2
    for (int i = 0; i < 16; ++i) {
      const LAS f32x4* gp = (const LAS f32x4*)(lds + GL_GLOW + (16 * tq + i) * 64);
      const f32x4 g0 = gp[0], g1 = gp[1], g2 = gp[2], g3 = gp[3];
      float gl = bg;
      gl += g0[0] * wg[0] + g0[1] * wg[1] + g0[2] * wg[2] + g0[3] * wg[3];
      gl += g1[0] * wg[4] + g1[1] * wg[5] + g1[2] * wg[6] + g1[3] * wg[7];
      gl += g2[0] * wg[8] + g2[1] * wg[9] + g2[2] * wg[10] + g2[3] * wg[11];
      gl += g3[0] * wg[12] + g3[1] * wg[13] + g3[2] * wg[14] + g3[3] * wg[15];
      const float ls = fminf(gl, 0.f) - __logf(1.f + __expf(-fabsf(gl)));
      run += ls * (1.f / 16.f);
      LB[(16 * tq + i) * 128 + d] = run;
    }
    QT[tq * 128 + d] = run;
    GLA_MARK(2); GLA_BAR();
    {
      float off = 0.f, tot = 0.f;
#pragma unroll
      for (int k = 0; k < 4; ++k) { const float v = QT[k * 128 + d]; tot += v; off += (k < tq) ? v : 0.f; }
      const float eb = __expf(tot);
#pragma unroll 2
      for (int i = 0; i < 16; ++i) {
        const int t = 16 * tq + i;
        const float bb = LB[t * 128 + d] + off;
        const float e = __expf(bb), r = __expf(-bb);
        LAS bf16* qp = (LAS bf16*)(lds + GL_QD + t * 288) + d;
        LAS bf16* kp = (LAS bf16*)(lds + GL_KI + t * 288) + d;
        LAS bf16* ep = (LAS bf16*)(lds + GL_KE + t * 288) + d;
        const float q = bf2f(*qp), k = bf2f(*kp);
        *qp = f2bf(q * e);
        *kp = f2bf(k * r);
        *ep = f2bf(k * (eb * r));
      }
      if (tq == 0) DEC[d] = eb;
    }
    GLA_MARK(3); GLA_BAR();
    {
      const int ti = wave >> 1;
#pragma unroll
      for (int u = 0; u < 2; ++u) {
        const int tj = 2 * (wave & 1) + u;
        f32x4 acc = (f32x4){0.f, 0.f, 0.f, 0.f};
        if (tj <= ti) {
#pragma unroll
          for (int ks = 0; ks < 4; ++ks) {
            const bf16x8_t a = *(const LAS bf16x8_t*)(lds + GL_QD + (16 * ti + c) * 288 + (32 * ks + 8 * g) * 2);
            const bf16x8_t bb = *(const LAS bf16x8_t*)(lds + GL_KI + (16 * tj + c) * 288 + (32 * ks + 8 * g) * 2);
            acc = __builtin_amdgcn_mfma_f32_16x16x32_bf16(a, bb, acc, 0, 0, 0);
          }
        }
#pragma unroll
        for (int r = 0; r < 4; ++r) {
          const int i = 16 * ti + 4 * g + r, j = 16 * tj + c;
          *((LAS bf16*)(lds + GL_AT + i * 144) + j) = f2bf((j <= i) ? acc[r] : 0.f);
        }
      }
    }
    GLA_MARK(4); GLA_BAR();
    f32x4 o[4][2];
    {
      bf16x8_t vf[2][2];
      {
        s16x4_t lo[4], hi[4];
#pragma unroll
        for (int ks = 0; ks < 2; ++ks)
#pragma unroll
          for (int tn = 0; tn < 2; ++tn) {
            lo[ks * 2 + tn] = tr_read_b64(vtr + (32 * ks) * 544 + tn * 32);
            hi[ks * 2 + tn] = tr_read_b64(vtr + (32 * ks + 4) * 544 + tn * 32);
          }
        asm volatile("s_waitcnt lgkmcnt(0)" ::: "memory");
        __builtin_amdgcn_sched_barrier(0);
#pragma unroll
        for (int u = 0; u < 4; ++u)
          vf[u >> 1][u & 1] = (bf16x8_t){lo[u][0], lo[u][1], lo[u][2], lo[u][3], hi[u][0], hi[u][1], hi[u][2], hi[u][3]};
      }
#pragma unroll
      for (int tm = 0; tm < 4; ++tm) { o[tm][0] = (f32x4){0.f, 0.f, 0.f, 0.f}; o[tm][1] = (f32x4){0.f, 0.f, 0.f, 0.f}; }
#pragma unroll
      for (int tm = 0; tm < 4; ++tm)
#pragma unroll
        for (int ks = 0; ks < 2; ++ks) {
          if (ks == 1 && tm < 2) continue;
          const bf16x8_t a = *(const LAS bf16x8_t*)(lds + GL_AT + (16 * tm + c) * 144 + (32 * ks + 8 * g) * 2);
          o[tm][0] = __builtin_amdgcn_mfma_f32_16x16x32_bf16(a, vf[ks][0], o[tm][0], 0, 0, 0);
          o[tm][1] = __builtin_amdgcn_mfma_f32_16x16x32_bf16(a, vf[ks][1], o[tm][1], 0, 0, 0);
          __builtin_amdgcn_sched_barrier(0);
        }
#pragma unroll
      for (int u = 0; u < 4; ++u) {
        union { bf16x8_t v; unsigned w[4]; } s0, s1;
        s0.w[0] = pk2(S[2 * u][0][0], S[2 * u][0][1]); s0.w[1] = pk2(S[2 * u][0][2], S[2 * u][0][3]);
        s0.w[2] = pk2(S[2 * u + 1][0][0], S[2 * u + 1][0][1]); s0.w[3] = pk2(S[2 * u + 1][0][2], S[2 * u + 1][0][3]);
        s1.w[0] = pk2(S[2 * u][1][0], S[2 * u][1][1]); s1.w[1] = pk2(S[2 * u][1][2], S[2 * u][1][3]);
        s1.w[2] = pk2(S[2 * u + 1][1][0], S[2 * u + 1][1][1]); s1.w[3] = pk2(S[2 * u + 1][1][2], S[2 * u + 1][1][3]);
#pragma unroll
        for (int tm = 0; tm < 4; ++tm) {
          const LAS unsigned char* qrow = lds + GL_QD + (16 * tm + c) * 288 + (32 * u + 4 * g) * 2;
          const s16x4_t q0 = *(const LAS s16x4_t*)qrow, q1 = *(const LAS s16x4_t*)(qrow + 32);
          const bf16x8_t a = (bf16x8_t){q0[0], q0[1], q0[2], q0[3], q1[0], q1[1], q1[2], q1[3]};
          o[tm][0] = __builtin_amdgcn_mfma_f32_16x16x32_bf16(a, s0.v, o[tm][0], 0, 0, 0);
          o[tm][1] = __builtin_amdgcn_mfma_f32_16x16x32_bf16(a, s1.v, o[tm][1], 0, 0, 0);
        }
        __builtin_amdgcn_sched_barrier(0);
      }
#pragma unroll
      for (int tk = 0; tk < 8; ++tk) {
        const f32x4 dec4 = *(const LAS f32x4*)(DEC + 16 * tk + 4 * g);
        S[tk][0] *= dec4; S[tk][1] *= dec4;
        s16x4_t lo0 = tr_read_b64(ketr + tk * 32), hi0 = tr_read_b64(ketr + 4 * 288 + tk * 32);
        s16x4_t lo1 = tr_read_b64(ketr + 32 * 288 + tk * 32), hi1 = tr_read_b64(ketr + 36 * 288 + tk * 32);
        asm volatile("s_waitcnt lgkmcnt(0)" ::: "memory");
        __builtin_amdgcn_sched_barrier(0);
        const bf16x8_t a0 = (bf16x8_t){lo0[0], lo0[1], lo0[2], lo0[3], hi0[0], hi0[1], hi0[2], hi0[3]};
        const bf16x8_t a1 = (bf16x8_t){lo1[0], lo1[1], lo1[2], lo1[3], hi1[0], hi1[1], hi1[2], hi1[3]};
        S[tk][0] = __builtin_amdgcn_mfma_f32_16x16x32_bf16(a0, vf[0][0], S[tk][0], 0, 0, 0);
        S[tk][1] = __builtin_amdgcn_mfma_f32_16x16x32_bf16(a0, vf[0][1], S[tk][1], 0, 0, 0);
        S[tk][0] = __builtin_amdgcn_mfma_f32_16x16x32_bf16(a1, vf[1][0], S[tk][0], 0, 0, 0);
        S[tk][1] = __builtin_amdgcn_mfma_f32_16x16x32_bf16(a1, vf[1][1], S[tk][1], 0, 0, 0);
        __builtin_amdgcn_sched_barrier(0);
      }
#pragma unroll
      for (int tm = 0; tm < 4; ++tm)
#pragma unroll
        for (int r = 0; r < 4; ++r) {
          float ss = o[tm][0][r] * o[tm][0][r] + o[tm][1][r] * o[tm][1][r];
          ss = row16_sum(ss);
          if (c == 0) SSQ[(16 * tm + 4 * g + r) * 8 + wave] = ss;
        }
    }
    GLA_MARK(5); GLA_BAR();
    {
      LAS bf16* OB = (LAS bf16*)(lds + GL_LB);
#pragma unroll
      for (int tm = 0; tm < 4; ++tm)
#pragma unroll
        for (int r = 0; r < 4; ++r) {
          const int t = 16 * tm + 4 * g + r;
          const f32x4 p0 = *(const LAS f32x4*)(SSQ + t * 8), p1 = *(const LAS f32x4*)(SSQ + t * 8 + 4);
          const float tot = ((p0[0] + p0[1]) + (p0[2] + p0[3])) + ((p1[0] + p1[1]) + (p1[2] + p1[3]));
          const float rstd = rsqrtf(tot * (1.f / 256.f) + 1e-6f);
          OB[t * 256 + 32 * wave + c] = f2bf(o[tm][0][r] * rstd * gn0);
          OB[t * 256 + 32 * wave + 16 + c] = f2bf(o[tm][1][r] * rstd * gn1);
        }
    }
    GLA_MARK(6); GLA_BAR();
#pragma unroll
    for (int i = 0; i < 4; ++i) {
      const int id = tid + 512 * i, tk = id >> 5, part = id & 31;
      const u32x4_t ov = *(const LAS u32x4_t*)(lds + GL_LB + tk * 512 + part * 16);
      const u32x4_t sv = rs[i];
      u32x4_t gv;
      gv[0] = pk2(bflo(ov[0]) * bflo(sv[0]), bfhi(ov[0]) * bfhi(sv[0]));
      gv[1] = pk2(bflo(ov[1]) * bflo(sv[1]), bfhi(ov[1]) * bfhi(sv[1]));
      gv[2] = pk2(bflo(ov[2]) * bflo(sv[2]), bfhi(ov[2]) * bfhi(sv[2]));
      gv[3] = pk2(bflo(ov[3]) * bflo(sv[3]), bfhi(ov[3]) * bfhi(sv[3]));
      *(u32x4_t*)(Vg + (tb + tk) * 1024 + h * 256 + part * 8) = gv;
    }
    GLA_MARK(7);
  }
#undef GLA_LOAD
  __syncthreads();
}

#define LDS_BYTES 155712
#define OFF_XBAR (224ull * 1024)
#define OFF_CTR (200ull * 1024)

__device__ __forceinline__ unsigned xcc_id() { return (unsigned)__builtin_amdgcn_s_getreg((3 << 11) | 20) & 0x7u; }
__device__ __forceinline__ void ph_mixer(const P& p, unsigned char* lds_raw, bool do_gla) {
  if (do_gla && blockIdx.x < 32) { gla_item(p, lds_raw, blockIdx.x); if (blockIdx.x == 0) TS_SET(p, 20); }
  unsigned* ctr = (unsigned*)(p.ws + OFF_CTR);
  LAS unsigned* slot = (LAS unsigned*)((LAS unsigned char*)lds_raw + DS_TOTAL);
  const unsigned home = xcc_id();
  unsigned k = 0;
  for (;;) {
    if (tid_fresh() == 0) {
      unsigned qi = 0xffffffffu;
      while (k < 8) {
        const unsigned b = (home + k) & 7u;
        const unsigned v = __hip_atomic_fetch_add(ctr + 64 * b, 1u, __ATOMIC_RELAXED, __HIP_MEMORY_SCOPE_AGENT);
        if (v < 128u) { qi = (b << 8) | v; break; }
        ++k;
      }
      slot[0] = qi; slot[1] = k;
    }
    __syncthreads();
    const unsigned qi = slot[0];
    k = slot[1];
    __syncthreads();
    if (qi == 0xffffffffu) break;
    dsa_batch(p, lds_raw, (int)(qi >> 8), 127 - (int)(qi & 255u));
  }
}

__global__ void __launch_bounds__(512, 2) mega(P p) {
  extern __shared__ __attribute__((aligned(16))) unsigned char lds_raw[];
  LAS unsigned char* lds = (LAS unsigned char*)lds_raw;
  cg::grid_group grid = cg::this_grid();
  char* ws = p.ws;
  const int bid = blockIdx.x, nb = gridDim.x;
  if (bid == 0 && threadIdx.x < 8) *(unsigned*)(ws + OFF_CTR + 256 * threadIdx.x) = 0u;
  if (bid == 0) { for (int i = threadIdx.x; i < XCD_BAR_WORDS; i += 512) ((unsigned*)(ws + OFF_XBAR))[i] = 0u; }
  volatile LAS unsigned* xst = (volatile LAS unsigned*)(lds + DS_TOTAL + 16);
  if (threadIdx.x < 4) xst[threadIdx.x] = 0u;
#if PROBE_TS
  { const int t_ = tid_fresh(); if (bid == 0 && t_ < 64) ((unsigned long long*)(ws + OFF_TS))[t_] = 0ull; }
  __syncthreads();
  if (bid == 0) TS_SET(p, 0);
#endif
  ph_prep(p, (float*)lds_raw);
  grid.sync();
  const XcdBarrier xb = xcd_barrier_post((unsigned*)(ws + OFF_XBAR), xst);
  if (bid == 0) TS_SET(p, 1);
  ph_mod(p, p.x, p.norm1_g, 0, 1024, (bf16*)(ws + OFF_H), bid, nb);
  xcd_barrier(xb);
  if (bid == 0) TS_SET(p, 2);
  gemm_run(lds, (const bf16*)(ws + OFF_H), (const bf16*)(ws + OFF_WT_IN), TT, 7168, 1024, EpiIn{ws, p.out});
  xcd_barrier(xb);
  if (bid == 0) TS_SET(p, 3);
  ph_mixer(p, lds_raw, true);
  if (bid == 0) TS_SET(p, 21);
  xcd_barrier(xb);
  if (bid == 0) TS_SET(p, 4);
  gemm_run(lds, (const bf16*)(ws + OFF_V), (const bf16*)(ws + OFF_WT_A), TT, 1024, 1024,
           EpiMix<false>{(const bf16*)p.out, (bf16*)(ws + OFF_MIX)});
  gemm_run(lds, (const bf16*)(ws + OFF_ODSA), (const bf16*)(ws + OFF_WT_B), TT, 1024, 1024,
           EpiMix<true>{(const bf16*)p.out + (size_t)TT * 1024, (bf16*)(ws + OFF_MIX)});
  xcd_barrier(xb);
  if (bid == 0) TS_SET(p, 5);
  gemm_run(lds, (const bf16*)(ws + OFF_MIX), (const bf16*)(ws + OFF_WT_OUT), TT, 1024, 1024,
           EpiX1{p.x, (const float*)(ws + OFF_ADA), p.out});
  xcd_barrier(xb);
  if (bid == 0) TS_SET(p, 6);
  ph_mod(p, p.out, (const float*)(ws + OFF_PRM) + PRM_N2G, 3072, 4096, (bf16*)(ws + OFF_H), bid, nb);
  xcd_barrier(xb);
  if (bid == 0) TS_SET(p, 7);
  gemm_run(lds, (const bf16*)(ws + OFF_H), (const bf16*)(ws + OFF_WT_Q), TT, 2048, 1024, EpiPlain{(bf16*)(ws + OFF_PQ), 2048});
  xcd_barrier(xb);
  if (bid == 0) TS_SET(p, 8);
  ph_peer512(p, lds_raw, p.out);
#if PROBE_TS
  if (bid == 0) TS_SET(p, 18);
  xcd_barrier(xb);
  {
    const unsigned long long* T = (const unsigned long long*)(ws + OFF_TS);
    const unsigned long long q = (unsigned long long)(PROBE_Q), t0 = __builtin_amdgcn_s_memrealtime();
    while (__builtin_amdgcn_s_memrealtime() - t0 < q) __builtin_amdgcn_s_sleep(8);
  }
#endif
}

extern "C" void kernel_launch(void* const* d_in, const int* in_sizes, int n_in, void* d_out, int out_size, void* d_ws,
                              size_t ws_size, hipStream_t stream) {
  P p{};
  const float** f = (const float**)&p;
  for (int i = 0; i < 22; ++i) f[i] = (const float*)d_in[i];
  p.out = (float*)d_out;
  p.ws = (char*)d_ws;
  if (ws_size < WS_NEED) { fprintf(stderr, "workspace too small: %zu\n", ws_size); return; }
  static int grid_blocks = 0;
  if (!grid_blocks) {
    int dev = 0, cus = 0, per_cu = 0;
    (void)hipGetDevice(&dev);
    (void)hipDeviceGetAttribute(&cus, hipDeviceAttributeMultiprocessorCount, dev);
    if (hipFuncSetAttribute((const void*)mega, hipFuncAttributeMaxDynamicSharedMemorySize, LDS_BYTES) != hipSuccess) {
      fprintf(stderr, "hipFuncSetAttribute failed\n"); grid_blocks = -1; return;
    }
    if (hipOccupancyMaxActiveBlocksPerMultiprocessor(&per_cu, (const void*)mega, 512, LDS_BYTES) != hipSuccess || per_cu < 1) {
      fprintf(stderr, "occupancy query failed\n"); grid_blocks = -1; return;
    }
    grid_blocks = cus;
  }
  if (grid_blocks <= 0) return;
  void* args[] = {&p};
  hipError_t e = hipLaunchCooperativeKernel((void*)mega, dim3(grid_blocks), dim3(512), args, LDS_BYTES, stream);
  if (e != hipSuccess) fprintf(stderr, "cooperative launch failed: %s (grid %d)\n", hipGetErrorString(e), grid_blocks);
}
```

```cpp
#include <hip/hip_runtime.h>
#include <hip/hip_cooperative_groups.h>
#include <cstdio>
#include <cstdint>
namespace cg = cooperative_groups;

#define TT 32768
#define SEQ 4096
#define DM 1024
#define NIN 7000
typedef unsigned short bf16;
#define LAS __attribute__((address_space(3)))

struct P {
  const float *x, *c, *w_ada, *b_ada, *norm1_g, *w_in, *w_gate_up, *b_gate, *gla_norm_g, *kv_norm_g,
      *w_uk, *w_uv, *w_a, *w_b, *w_out, *norm2_g, *w_q, *sk1, *sk2, *peer_u, *peer_v, *final_g;
  float* out;
  char* ws;
};

#define MB (1ull << 20)
#define OFF_ADA   (0ull)
#define OFF_H     (1 * MB)
#define OFF_ODSA  (1 * MB)
#define OFF_Q     (65 * MB)
#define OFF_K     (97 * MB)
#define OFF_MIX   (65 * MB)
#define OFF_V     (129 * MB)
#define OFF_DQ    (193 * MB)
#define OFF_PQ    (129 * MB)
#define OFF_DSCR  (257 * MB)
#define OFF_SSP   (256ull * 1024)
#define OFF_CKV   (289 * MB)
#define OFF_IQ    (305 * MB)
#define OFF_IK    (337 * MB)
#define OFF_IW    (341 * MB)
#define OFF_GLOW  (342 * MB)
#define OFF_SGR   (344 * MB)
#define OFF_X1    (344 * MB)
#define OFF_WT    (408 * MB)
#define OFF_WT_IN  (OFF_WT)
#define OFF_WT_A   (OFF_WT + 7168ull * 2048)
#define OFF_WT_B   (OFF_WT_A + 1024ull * 2048)
#define OFF_WT_OUT (OFF_WT_B + 1024ull * 2048)
#define OFF_WT_Q   (OFF_WT_OUT + 1024ull * 2048)
#define OFF_PU    (432 * MB)
#define OFF_PV    (464 * MB)
#define OFF_SK    (496 * MB)
#define OFF_PSC   (496 * MB + 128 * 1024)
#define OFF_WUK   (497 * MB)
#define OFF_WUV   (497 * MB + 512 * 1024)
#define WS_NEED   (498 * MB)

__device__ __forceinline__ bf16 f2bf(float f) {
  unsigned u = __float_as_uint(f);
  u += 0x7fffu + ((u >> 16) & 1u);
  return (bf16)(u >> 16);
}
__device__ __forceinline__ unsigned pk2(float lo, float hi) { return (unsigned)f2bf(lo) | ((unsigned)f2bf(hi) << 16); }
__device__ __forceinline__ float bf2f(bf16 h) { return __uint_as_float(((unsigned)h) << 16); }
__device__ __forceinline__ float bflo(unsigned u) { return __uint_as_float(u << 16); }
__device__ __forceinline__ float bfhi(unsigned u) { return __uint_as_float(u & 0xffff0000u); }
__device__ __forceinline__ float wave_sum(float v) {
#pragma unroll
  for (int o = 32; o > 0; o >>= 1) v += __shfl_xor(v, o);
  return v;
}
__device__ __forceinline__ float wave_max(float v) {
#pragma unroll
  for (int o = 32; o > 0; o >>= 1) v = fmaxf(v, __shfl_xor(v, o));
  return v;
}
#ifndef PROBE_TS
#define PROBE_TS 0
#endif
#define OFF_PRM (800ull * 1024)
#define PRM_WGU   0
#define PRM_BG    8192
#define PRM_GNG   8704
#define PRM_N2G   9728
#define PRM_FG    10752
#define PRM_TOTAL 11776
#define OFF_TS (208ull * 1024)
#if PROBE_TS
#define TS_SET(p, k) do { if (tid_fresh() == 0) ((unsigned long long*)((p).ws + OFF_TS))[k] = __builtin_amdgcn_s_memrealtime(); } while (0)
#define TS_ADD(p, k, t0) do { if (tid_fresh() == 0) ((unsigned long long*)((p).ws + OFF_TS))[k] += __builtin_amdgcn_s_memrealtime() - (t0); } while (0)
#define TS_NOW() __builtin_amdgcn_s_memrealtime()
#else
#define TS_SET(p, k) do {} while (0)
#define TS_ADD(p, k, t0) do {} while (0)
#define TS_NOW() 0ull
#endif
__device__ __forceinline__ int tid_fresh() { int t = threadIdx.x; asm volatile("" : "+v"(t)); return t; }
__device__ __forceinline__ float sigmoidf_(float v) { return 1.f / (1.f + __expf(-v)); }
__device__ __forceinline__ float siluf_(float v) { return v / (1.f + __expf(-v)); }

#include <hip/hip_runtime.h>
namespace pg8 {
#define PG8_LAS __attribute__((address_space(3)))
typedef unsigned short bf16_t;
typedef short bf16x8 __attribute__((ext_vector_type(8)));
typedef float f32x4 __attribute__((ext_vector_type(4)));
typedef unsigned u32x4 __attribute__((ext_vector_type(4)));
constexpr int BM = 256, BK = 64, HALF = 128, HTB = HALF * BK * 2  , STAGE_BYTES = 8 * HTB, NXCD = 8, WGM = 8;

__host__ __device__ __forceinline__ int lds_byte(int r, int c) { const int st = (r >> 4) * 2 + (c >> 5), rr = r & 15, cc = c & 31, ob = rr * 64 + cc * 2; return st * 1024 + (ob ^ (((ob >> 9) & 1) << 5)); }
__host__ __device__ __forceinline__ void stage_rc(int b, int& R, int& C) { const int st = b / 1024, sb = b % 1024, swz = sb ^ (((sb >> 9) & 1) << 5); R = (st >> 1) * 16 + swz / 64; C = (st & 1) * 32 + (swz % 64) / 2; }
__host__ __device__ __forceinline__ int perm32(int rho) { const int n = rho >> 4, i = rho & 15; return 8 * (i >> 2) + 4 * n + (i & 3); }

struct Unit { int pm, pn; };
struct Gemm { const bf16_t* A; const bf16_t* Bt; int M, N, K; };

struct StaticOrder {
    int nM, nN, nwg, G, c;
    __host__ __device__ void init(int M, int N, int G_, int c_) { nM = M / BM; nN = N / BM; nwg = nM * nN; G = G_; c = c_; }
    __host__ __device__ bool next(int i, Unit& u) const {
        const long L = (long)i * G + c; if (L >= nwg) return false;
        int wgid = (int)L; { const int q = nwg / NXCD, r = nwg % NXCD, xcd = wgid % NXCD, off = wgid / NXCD; wgid = (xcd < r ? xcd * (q + 1) : r * (q + 1) + (xcd - r) * q) + off; }
        const int nig = WGM * nN, gid = wgid / nig, fm = gid * WGM, gsz = (nM - fm) < WGM ? (nM - fm) : WGM;
        u.pm = fm + ((wgid % nig) % gsz); u.pn = (wgid % nig) / gsz; return true;
    }
    __device__ __forceinline__ void a_ready(const Unit&) const {}
    __device__ __forceinline__ void done(const Unit&) const {}
};
__device__ __forceinline__ unsigned cvt_pk_bf16(float lo, float hi) { unsigned r; asm volatile("v_cvt_pk_bf16_f32 %0, %1, %2" : "=v"(r) : "v"(lo), "v"(hi)); return r; }

template <class Epi, class Sched, bool STAMP = false>
__device__ __forceinline__ void gemm_phase(PG8_LAS unsigned char* lds, const Gemm g, const Sched& S, const Epi& E, unsigned long long* stamps) {
    const int tid = ::tid_fresh(), wid = __builtin_amdgcn_readfirstlane(tid >> 6), lane = tid & 63, wr = wid >> 2, wc = wid & 3, fr = lane & 15, fq = lane >> 4;
    const int K = g.K, nt = K / BK;
    int ts_lo = 0, ts_hi = 0, nts = 0; const unsigned long long rt_entry = STAMP ? (unsigned long long)wall_clock64() : 0ull;
#define PG8_STAMP() do { if (STAMP && wid == 0 && nts < 64) { const unsigned long long _c = (unsigned long long)clock64(); \
        ts_lo = (lane == nts) ? (int)(unsigned)_c : ts_lo; ts_hi = (lane == nts) ? (int)(unsigned)(_c >> 32) : ts_hi; ++nts; } } while (0)
    PG8_STAMP();
    unsigned voffA[2], voffB[2];
#pragma unroll
    for (int i = 0; i < 2; ++i) { int R, C; stage_rc(tid * 16 + i * 8192, R, C); const int Rb = Epi::PERM ? ((R & ~31) + perm32(R & 31)) : R;
        voffA[i] = (unsigned)(R * K + C) * 2u; voffB[i] = (unsigned)(Rb * K + C) * 2u; }
    const size_t kstep = (size_t)(BK * 2);
    const size_t hstep = (size_t)HALF * K * 2;
    const size_t tstep = 2 * hstep;
    const unsigned ldsw = (unsigned)wid * 1024u;
    const int aoff = lds_byte(wr * 64 + fr, fq * 8), boff = lds_byte(wc * 32 + fr, fq * 8);
#define PG8_SA(b, h) (((b) * 2 + (h)) * HTB)
#define PG8_SB(b, h) ((4 + (b) * 2 + (h)) * HTB)
#define PG8_STAGE(bufoff, gbase, voff) do { _Pragma("unroll") for (int _i = 0; _i < 2; ++_i) \
        __builtin_amdgcn_global_load_lds((const unsigned*)((const char*)(gbase) + (voff)[_i]), (PG8_LAS unsigned*)(lds + (bufoff) + ldsw + _i * 8192), 16, 0, 0); } while (0)
#define PG8_LDA(dst, b, h) do { _Pragma("unroll") for (int m = 0; m < 4; ++m) _Pragma("unroll") for (int k = 0; k < 2; ++k) dst[m][k] = *(const PG8_LAS bf16x8*)(lds + PG8_SA(b, h) + aoff + m * 2048 + k * 1024); } while (0)
#define PG8_LDB(dst, b, h) do { _Pragma("unroll") for (int n = 0; n < 2; ++n) _Pragma("unroll") for (int k = 0; k < 2; ++k) dst[n][k] = *(const PG8_LAS bf16x8*)(lds + PG8_SB(b, h) + boff + n * 2048 + k * 1024); } while (0)
#define PG8_MMA(ai, bj, At, Bt) do { __builtin_amdgcn_s_setprio(1); _Pragma("unroll") for (int m = 0; m < 4; ++m) _Pragma("unroll") for (int n = 0; n < 2; ++n) _Pragma("unroll") for (int k = 0; k < 2; ++k) \
        acc[ai][bj][m][n] = __builtin_amdgcn_mfma_f32_16x16x32_bf16(Bt[n][k], At[m][k], acc[ai][bj][m][n], 0, 0, 0); __builtin_amdgcn_s_setprio(0); } while (0)
#define PG8_WAIT_V(n) asm volatile("s_waitcnt vmcnt(" #n ")" ::: "memory")
#define PG8_WAIT_L(n) asm volatile("s_waitcnt lgkmcnt(" #n ")" ::: "memory")
#define PG8_BAR __builtin_amdgcn_s_barrier()
#define PG8_SCHED __builtin_amdgcn_sched_barrier(0)
    Unit cur, nxt; int ui = 0;
    if (!S.next(0, cur)) return;
    f32x4 acc[2][2][4][2];
#pragma unroll
    for (int a = 0; a < 2; ++a)
#pragma unroll
        for (int b = 0; b < 2; ++b)
#pragma unroll
            for (int m = 0; m < 4; ++m)
#pragma unroll
                for (int n = 0; n < 2; ++n) acc[a][b][m][n] = (f32x4){0.f, 0.f, 0.f, 0.f};
    bf16x8 At[4][2], B0[2][2], B1[2][2];
    const char* cA = (const char*)g.A + (size_t)cur.pm * tstep; const char* cB = (const char*)g.Bt + (size_t)cur.pn * tstep;
    S.a_ready(cur);
    PG8_STAGE(PG8_SB(0, 0), cB, voffB); PG8_STAGE(PG8_SA(0, 0), cA, voffA); PG8_STAGE(PG8_SB(0, 1), cB + hstep, voffB); PG8_STAGE(PG8_SA(0, 1), cA + hstep, voffA);
    if (wr == 1) PG8_BAR;
    PG8_WAIT_V(4); PG8_BAR;
    PG8_STAGE(PG8_SB(1, 0), cB + kstep, voffB); PG8_STAGE(PG8_SA(1, 0), cA + kstep, voffA); PG8_STAGE(PG8_SB(1, 1), cB + hstep + kstep, voffB);
    PG8_WAIT_V(6); PG8_BAR;
    PG8_STAMP();
    for (;;) {
        const bool has_next = S.next(ui + 1, nxt);
        const char* nA = has_next ? (const char*)g.A + (size_t)nxt.pm * tstep : cA; const char* nB = has_next ? (const char*)g.Bt + (size_t)nxt.pn * tstep : cB;
        for (int t = 0; t < nt; t += 2) {
            const bool last = (t == nt - 2);
            const char* a1 = cA + (size_t)(t + 1) * kstep;
            const char* a2 = last ? nA : cA + (size_t)(t + 2) * kstep; const char* b2 = last ? nB : cB + (size_t)(t + 2) * kstep;
            const char* a3 = a2 + kstep; const char* b3 = b2 + kstep;
            if (last && has_next) S.a_ready(nxt);
            PG8_LDB(B0, 0, 0); PG8_SCHED; PG8_LDA(At, 0, 0); PG8_STAGE(PG8_SA(1, 1), a1 + hstep, voffA);
            PG8_WAIT_L(8); PG8_BAR; PG8_WAIT_L(0); PG8_MMA(0, 0, At, B0); PG8_BAR; PG8_SCHED;
            PG8_LDB(B1, 0, 1); PG8_STAGE(PG8_SB(0, 0), b2, voffB);
            PG8_BAR; PG8_WAIT_L(0); PG8_MMA(0, 1, At, B1); PG8_BAR;
            PG8_LDA(At, 0, 1); PG8_STAGE(PG8_SA(0, 0), a2, voffA);
            PG8_BAR; PG8_WAIT_L(0); PG8_MMA(1, 0, At, B0); PG8_BAR; PG8_SCHED;
            PG8_STAGE(PG8_SB(0, 1), b2 + hstep, voffB);
            PG8_WAIT_V(6); PG8_BAR; PG8_MMA(1, 1, At, B1); PG8_BAR;
            PG8_LDB(B0, 1, 0); PG8_SCHED; PG8_LDA(At, 1, 0); PG8_STAGE(PG8_SA(0, 1), a2 + hstep, voffA);
            PG8_WAIT_L(8); PG8_BAR; PG8_WAIT_L(0); PG8_MMA(0, 0, At, B0); PG8_BAR; PG8_SCHED;
            PG8_LDB(B1, 1, 1); PG8_STAGE(PG8_SB(1, 0), b3, voffB);
            PG8_BAR; PG8_WAIT_L(0); PG8_MMA(0, 1, At, B1); PG8_BAR;
            PG8_LDA(At, 1, 1); PG8_STAGE(PG8_SA(1, 0), a3, voffA);
            PG8_BAR; PG8_WAIT_L(0); PG8_MMA(1, 0, At, B0); PG8_BAR; PG8_SCHED;
            PG8_STAGE(PG8_SB(1, 1), b3 + hstep, voffB);
            PG8_WAIT_V(6); PG8_BAR; PG8_MMA(1, 1, At, B1); PG8_BAR;
        }
        PG8_STAMP();
        if constexpr (!Epi::AFTER_DRAIN) { E(acc, cur, wr, wc, fr, fq); S.done(cur); }
        PG8_STAMP();
        if (!has_next) break;
#pragma unroll
        for (int a = 0; a < 2; ++a)
#pragma unroll
            for (int b = 0; b < 2; ++b)
#pragma unroll
                for (int m = 0; m < 4; ++m)
#pragma unroll
                    for (int n = 0; n < 2; ++n) acc[a][b][m][n] = (f32x4){0.f, 0.f, 0.f, 0.f};
        cur = nxt; cA = nA; cB = nB; ++ui;
    }
    PG8_WAIT_V(0);
    if (wr == 0) PG8_BAR;
    PG8_BAR;
    if constexpr (Epi::AFTER_DRAIN) { E.fused(acc, cur, wr, wc, fr, fq, lds, wid, lane); S.done(cur); }
    PG8_STAMP();
    if (STAMP && wid == 0) { stamps[lane] = lane < nts ? (((unsigned long long)(unsigned)ts_hi << 32) | (unsigned)ts_lo) : 0ull;
        if (lane == 62) stamps[62] = rt_entry; if (lane == 63) stamps[63] = (unsigned long long)wall_clock64(); }
#undef PG8_STAMP
#undef PG8_SA
#undef PG8_SB
#undef PG8_STAGE
#undef PG8_LDA
#undef PG8_LDB
#undef PG8_MMA
#undef PG8_WAIT_V
#undef PG8_WAIT_L
#undef PG8_BAR
#undef PG8_SCHED
}
}
#define XB_TMO      128
#define XB_XCNT(j)  (256  + 64 * (j))
#define XB_XSUB(j)  (1280 + 64 * (j))
#define XB_XGEN(j)  (2304 + 64 * (j))
#define XB_TOP      3328
#define XB_TOPGEN   3392
#define XCD_BAR_WORDS 3456
#define XB_SPIN_CAP (1u << 18)

__device__ __forceinline__ unsigned xb_ld(unsigned* p)              { return __hip_atomic_load(p, __ATOMIC_RELAXED, __HIP_MEMORY_SCOPE_AGENT); }
__device__ __forceinline__ unsigned xb_add(unsigned* p, unsigned v) { return __hip_atomic_fetch_add(p, v, __ATOMIC_RELAXED, __HIP_MEMORY_SCOPE_AGENT); }
__device__ __forceinline__ unsigned xb_xcc_id() { return (unsigned)__builtin_amdgcn_s_getreg((3 << 11) | 20) & 0xFu; }
#define XB_SPIN(cond, bar) do { unsigned _sp = 0; while (cond) { __builtin_amdgcn_s_sleep(1); \
    if ((++_sp & 255u) == 0u) { if (xb_ld(&(bar)[XB_TMO])) break; if (_sp > XB_SPIN_CAP) { atomicAdd(&(bar)[XB_TMO], 1u); break; } } } } while (0)

struct XcdBarrier {
    unsigned* bar; unsigned x;
    volatile LAS unsigned* st;
};

__device__ __forceinline__ XcdBarrier xcd_barrier_post(unsigned* bar, volatile LAS unsigned* st) {
    XcdBarrier b; b.bar = bar; b.x = xb_xcc_id(); b.st = st;
    if (threadIdx.x == 0) (void)xb_add(&bar[XB_XCNT(b.x)], 1u);
    return b;
}
__device__ __forceinline__ void xcd_barrier_complete(unsigned* bar, unsigned x, unsigned& nloc, unsigned& nx) {
    const unsigned G = gridDim.x * gridDim.y * gridDim.z;
    unsigned sum, cnt, mine, sp = 0u;
    for (;;) {
        sum = 0u; cnt = 0u; mine = 0u;
#pragma unroll
        for (unsigned j = 0; j < 16; ++j) { const unsigned c = xb_ld(&bar[XB_XCNT(j)]); sum += c; cnt += (c > 0u) ? 1u : 0u; mine = (j == x) ? c : mine; }
        if (sum == G) break;
        __builtin_amdgcn_s_sleep(1);
        if ((++sp & 255u) == 0u) { if (xb_ld(&bar[XB_TMO])) break; if (sp > XB_SPIN_CAP) { atomicAdd(&bar[XB_TMO], 1u); break; } }
    }
    nloc = mine > 0u ? mine : 1u; nx = cnt > 0u ? cnt : 1u;
}

__device__ __forceinline__ void xcd_barrier(const XcdBarrier& b) {
    asm volatile("s_waitcnt vmcnt(0)" ::: "memory");
    __syncthreads();
    if (threadIdx.x == 0) {
        unsigned* bar = b.bar;
        __builtin_amdgcn_s_waitcnt(0);
        unsigned nloc = b.st[0], nx = b.st[1];
        if (nloc == 0u) { xcd_barrier_complete(bar, b.x, nloc, nx); b.st[0] = nloc; b.st[1] = nx; }
        const unsigned old = xb_add(&bar[XB_XSUB(b.x)], 1u);
        const unsigned gen = old / nloc;
        if (old + 1u == (gen + 1u) * nloc) {
            __builtin_amdgcn_fence(__ATOMIC_RELEASE, "agent");
            asm volatile("s_waitcnt vmcnt(0)" ::: "memory");
            const unsigned og = xb_add(&bar[XB_TOP], 1u);
            const unsigned tg = og / nx;
            if (og + 1u == (tg + 1u) * nx) xb_add(&bar[XB_TOPGEN], 1u);
            else XB_SPIN(xb_ld(&bar[XB_TOPGEN]) == tg, bar);
            __builtin_amdgcn_fence(__ATOMIC_ACQUIRE, "agent");
            xb_add(&bar[XB_XGEN(b.x)], 1u);
            asm volatile("s_waitcnt vmcnt(0)" ::: "memory");
        } else {
            XB_SPIN(xb_ld(&bar[XB_XGEN(b.x)]) == gen, bar);
            __builtin_amdgcn_fence(__ATOMIC_ACQUIRE, "agent");
            asm volatile("s_waitcnt vmcnt(0)" ::: "memory");
        }
    }
    __syncthreads();
}

template <bool BF16IN>
__device__ __forceinline__ void ph_mod(const P& p, const void* Xv, const float* g, int shift_off, int scale_off, bf16* H, int bid, int nb) {
  const float* ada = (const float*)(p.ws + OFF_ADA);
  const int tidm = tid_fresh(); int wave = tidm >> 6, lane = tidm & 63;
  const int rstride = nb * (int)(blockDim.x >> 6);
  int row = bid * (int)(blockDim.x >> 6) + wave;
  float4 v[4];
#define MOD_LOAD(dst, r_)                                                                                       \
  {                                                                                                             \
    if (BF16IN) {                                                                                               \
      const uint2* xr = (const uint2*)((const bf16*)Xv + (size_t)(r_) * DM);                                    \
      _Pragma("unroll") for (int i = 0; i < 4; ++i) { const uint2 w = xr[lane + i * 64]; dst[i] = make_float4(bflo(w.x), bfhi(w.x), bflo(w.y), bfhi(w.y)); } \
    } else {                                                                                                    \
      const float4* xr = (const float4*)((const float*)Xv + (size_t)(r_) * DM);                                 \
      _Pragma("unroll") for (int i = 0; i < 4; ++i) dst[i] = xr[lane + i * 64];                                 \
    }                                                                                                           \
  }
  if (row < TT) MOD_LOAD(v, row)
  for (; row < TT; row += rstride) {
    float4 vn[4];
    const int nrow = row + rstride;
    MOD_LOAD(vn, (nrow < TT) ? nrow : row)
    float ss = 0.f;
#pragma unroll
    for (int i = 0; i < 4; ++i) ss += v[i].x * v[i].x + v[i].y * v[i].y + v[i].z * v[i].z + v[i].w * v[i].w;
    ss = wave_sum(ss);
    float rstd = rsqrtf(ss * (1.f / DM) + 1e-6f);
    int b = row >> 12;
    const float* sh = ada + b * 6144 + shift_off;
    const float* sc = ada + b * 6144 + scale_off;
#pragma unroll
    for (int i = 0; i < 4; ++i) {
      int c0 = (lane + i * 64) * 4;
      float4 gg = *(const float4*)(g + c0);
      float4 s4 = *(const float4*)(sc + c0);
      float4 h4 = *(const float4*)(sh + c0);
      ushort4 o;
      o.x = f2bf(v[i].x * rstd * gg.x * (1.f + s4.x) + h4.x);
      o.y = f2bf(v[i].y * rstd * gg.y * (1.f + s4.y) + h4.y);
      o.z = f2bf(v[i].z * rstd * gg.z * (1.f + s4.z) + h4.z);
      o.w = f2bf(v[i].w * rstd * gg.w * (1.f + s4.w) + h4.w);
      *(ushort4*)(H + (size_t)row * DM + c0) = o;
    }
#pragma unroll
    for (int i = 0; i < 4; ++i) v[i] = vn[i];
  }
#undef MOD_LOAD
}

using pg8::f32x4;
using pg8::u32x4;
using pg8::Unit;
using pg8::cvt_pk_bf16;
typedef short s16x4_t __attribute__((ext_vector_type(4)));
typedef unsigned u32x4_t __attribute__((ext_vector_type(4)));
typedef unsigned short u16x4_t __attribute__((ext_vector_type(4)));

__device__ __forceinline__ size_t tm_off(size_t row, int col, int kbn) {
  return (((row >> 4) * kbn + (col >> 5)) * 64 + ((col >> 3) & 3) * 16 + (row & 15)) * 8 + (col & 7);
}

__device__ __forceinline__ int in_srcmap(int d) {
  if (d < 2048) return d;
  if (d < 3072) return 3088 + (d - 2048);
  if (d < 3328) return 4112 + (d - 3072);
  if (d < 3840) return 4368 + (d - 3328);
  if (d < 3904) return 4880 + (d - 3840);
  if (d < 3912) return 4944 + (d - 3904);
  if (d < 3928) return 3072 + (d - 3912);
  if (d < 4096) return -1;
  if (d < 5120) return 2048 + (d - 4096);
  return 4952 + (d - 5120);
}
template <bool MAP>
__device__ __forceinline__ void transpose_item(const float* W, int ldw, int K, bf16* WT, int item, int nblk, float* scr, int lane) {
  const int kb = item / nblk, nbk = item % nblk, k0 = 64 * kb, n0 = 32 * nbk;
  const int d = n0 + (lane & 31);
  const int src = MAP ? in_srcmap(d) : d;
  float r[32];
  const int srcc = (src >= 0) ? src : 0;
#pragma unroll
  for (int i = 0; i < 32; ++i) r[i] = W[(size_t)(k0 + 2 * i + (lane >> 5)) * ldw + srcc];
#pragma unroll
  for (int i = 0; i < 32; ++i) scr[(2 * i + (lane >> 5)) * 33 + (lane & 31)] = (src >= 0) ? r[i] : 0.f;
  asm volatile("s_waitcnt lgkmcnt(0)" ::: "memory");
  const int c = lane & 7;
#pragma unroll
  for (int j = 0; j < 4; ++j) {
    const int n = (lane >> 3) + 8 * j;
    const float* s = scr + (8 * c) * 33 + n;
    uint4 o;
    o.x = pk2(s[0 * 33], s[1 * 33]); o.y = pk2(s[2 * 33], s[3 * 33]); o.z = pk2(s[4 * 33], s[5 * 33]); o.w = pk2(s[6 * 33], s[7 * 33]);
    *(uint4*)(WT + (size_t)(n0 + n) * K + k0 + 8 * c) = o;
  }
  asm volatile("s_waitcnt lgkmcnt(0)" ::: "memory");
}

__device__ __forceinline__ void ph_prep(const P& p, float* sm) {
  const int tid = tid_fresh(), wave = tid >> 6, lane = tid & 63;
  const int bid = blockIdx.x, nb = gridDim.x;
  float* silc = sm + 8 * 2112 + 64;
  float* red = silc + 8192;
  float* ada = (float*)(p.ws + OFF_ADA);
  if (bid < 192) {
    for (int i = tid; i < 8192; i += 512) silc[i] = siluf_(p.c[i]);
    __syncthreads();
    for (int it = bid; it < 192; it += nb) {
      const int kg = tid >> 5, cn = tid & 31, n = it * 32 + cn;
      float acc[8];
#pragma unroll
      for (int b = 0; b < 8; ++b) acc[b] = 0.f;
#pragma unroll 1
      for (int kq = 0; kq < 2; ++kq) {
        float w[32];
#pragma unroll
        for (int j = 0; j < 32; ++j) w[j] = p.w_ada[(size_t)(kg * 64 + kq * 32 + j) * 6144 + n];
#pragma unroll
        for (int j = 0; j < 32; ++j) {
          const int k = kg * 64 + kq * 32 + j;
#pragma unroll
          for (int b = 0; b < 8; ++b) acc[b] += silc[b * 1024 + k] * w[j];
        }
      }
#pragma unroll
      for (int b = 0; b < 8; ++b) red[(kg * 8 + b) * 32 + cn] = acc[b];
      __syncthreads();
      if (tid < 256) {
        const int b = tid >> 5, c2 = tid & 31;
        float s = 0.f;
#pragma unroll
        for (int g = 0; g < 16; ++g) s += red[(g * 8 + b) * 32 + c2];
        ada[b * 6144 + it * 32 + c2] = s + p.b_ada[it * 32 + c2];
      }
      __syncthreads();
    }
  }
  {
    unsigned char* PU8 = (unsigned char*)(p.ws + OFF_PU);
    unsigned char* PV8 = (unsigned char*)(p.ws + OFF_PV);
    float* PSC = (float*)(p.ws + OFF_PSC);
    f32x4 va[4], vb[4];
    {
      const int r0 = bid * 8 + wave, r1 = (r0 + nb * 8 < 2 * 16384) ? r0 + nb * 8 : r0;
      const float* s0 = (r0 < 16384 ? p.peer_u : p.peer_v) + (size_t)(r0 & 16383) * 1024 + lane * 16;
      const float* s1 = (r1 < 16384 ? p.peer_u : p.peer_v) + (size_t)(r1 & 16383) * 1024 + lane * 16;
#pragma unroll
      for (int q = 0; q < 4; ++q) { va[q] = *(const f32x4*)(s0 + q * 4); vb[q] = *(const f32x4*)(s1 + q * 4); }
    }
    for (int row = bid * 8 + wave; row < 2 * 16384; row += nb * 8) {
      f32x4 v[4], vn[4];
      {
        const int r2 = (row + 2 * nb * 8 < 2 * 16384) ? row + 2 * nb * 8 : row;
        const float* s2 = (r2 < 16384 ? p.peer_u : p.peer_v) + (size_t)(r2 & 16383) * 1024 + lane * 16;
#pragma unroll
        for (int q = 0; q < 4; ++q) vn[q] = *(const f32x4*)(s2 + q * 4);
      }
      float mx = 0.f;
#pragma unroll
      for (int q = 0; q < 4; ++q) {
        v[q] = va[q]; va[q] = vb[q]; vb[q] = vn[q];
        mx = fmaxf(mx, fmaxf(fmaxf(fabsf(v[q][0]), fabsf(v[q][1])), fmaxf(fabsf(v[q][2]), fabsf(v[q][3]))));
      }
      mx = wave_max(mx);
      const float sc = (mx > 0.f) ? exp2f(floorf(log2f(448.f / mx))) : 1.f;
      u32x4 o;
#pragma unroll
      for (int q = 0; q < 4; ++q) {
        int w = __builtin_amdgcn_cvt_pk_fp8_f32(v[q][0] * sc, v[q][1] * sc, 0, false);
        w = __builtin_amdgcn_cvt_pk_fp8_f32(v[q][2] * sc, v[q][3] * sc, w, true);
        o[q] = (unsigned)w;
      }
      *(u32x4*)((row < 16384 ? PU8 : PV8) + (size_t)(row & 16383) * 1024 + lane * 16) = o;
      if (lane == 0) PSC[row] = 1.f / sc;
    }
    for (int i = bid * 512 + tid; i < 2 * 2048; i += nb * 512) {
      const float* src = (i < 2048) ? p.sk1 : p.sk2;
      const int j = i & 2047;
      const float4 v0 = *(const float4*)(src + j * 8), v1 = *(const float4*)(src + j * 8 + 4);
      uint4 o; o.x = pk2(v0.x, v0.y); o.y = pk2(v0.z, v0.w); o.z = pk2(v1.x, v1.y); o.w = pk2(v1.z, v1.w);
      *(uint4*)((bf16*)(p.ws + OFF_SK) + (size_t)(i >> 11) * 16384 + tm_off((size_t)(j >> 4), (j & 15) * 8, 4)) = o;
    }
  }
  {
    float* prm = (float*)(p.ws + OFF_PRM);
    for (int i = bid * 512 + tid; i < PRM_TOTAL; i += nb * 512) {
      float v;
      if (i < PRM_BG) v = p.w_gate_up[i];
      else if (i < PRM_GNG) v = p.b_gate[i - PRM_BG];
      else if (i < PRM_N2G) v = p.gla_norm_g[i - PRM_GNG];
      else if (i < PRM_FG) v = p.norm2_g[i - PRM_N2G];
      else v = p.final_g[i - PRM_FG];
      prm[i] = v;
    }
  }
  {
    bf16* WUK = (bf16*)(p.ws + OFF_WUK);
    bf16* WUV = (bf16*)(p.ws + OFF_WUV);
    for (int i = bid * 512 + tid; i < 2 * 262144; i += nb * 512) {
      if (i < 262144) {
        const int cc = i & 255, d = (i >> 8) & 127, h = i >> 15;
        WUK[((h * 16 + (cc >> 4)) * 4 + (d >> 5)) * 512 + (((d >> 3) & 3) * 16 + (cc & 15)) * 8 + (d & 7)] =
            f2bf(p.w_uk[i] * p.kv_norm_g[cc] * 0.08838834764831845f);
      } else {
        const int k = i - 262144;
        const int d = k & 127, cc = (k >> 7) & 255, h = k >> 15;
        WUV[((h * 8 + (d >> 4)) * 8 + (cc >> 5)) * 512 + (((cc >> 3) & 3) * 16 + (d & 15)) * 8 + (cc & 7)] =
            f2bf(p.w_uv[k] * p.kv_norm_g[cc]);
      }
    }
  }
  float* scr = sm + wave * 2112;
  const int gw = bid * 8 + wave, ngw = nb * 8;
  constexpr int I_IN = 16 * 224, I_SQ = 16 * 32, I_Q = 16 * 64;
  for (int it = gw; it < I_IN + 3 * I_SQ + I_Q; it += ngw) {
    int r = it;
    if (r < I_IN) { transpose_item<true>(p.w_in, NIN, 1024, (bf16*)(p.ws + OFF_WT_IN), r, 224, scr, lane); continue; }
    r -= I_IN;
    if (r < I_SQ) { transpose_item<false>(p.w_a, 1024, 1024, (bf16*)(p.ws + OFF_WT_A), r, 32, scr, lane); continue; }
    r -= I_SQ;
    if (r < I_SQ) { transpose_item<false>(p.w_b, 1024, 1024, (bf16*)(p.ws + OFF_WT_B), r, 32, scr, lane); continue; }
    r -= I_SQ;
    if (r < I_SQ) { transpose_item<false>(p.w_out, 1024, 1024, (bf16*)(p.ws + OFF_WT_OUT), r, 32, scr, lane); continue; }
    r -= I_SQ;
    transpose_item<false>(p.w_q, 2048, 1024, (bf16*)(p.ws + OFF_WT_Q), r, 64, scr, lane);
  }
}


struct EpiIn {
  static constexpr bool PERM = true, AFTER_DRAIN = false;
  char* ws; float* out;
  __device__ __forceinline__ void operator()(const f32x4 (&acc)[2][2][4][2], const Unit& u, int wr, int wc, int fr, int fq) const {
    const int pn = u.pn;
    const int row0 = u.pm * 256 + wr * 64 + fr, cl0 = wc * 32 + 8 * fq;
    if (pn == 12) {
      bf16* dst = (bf16*)(ws + OFF_CKV);
      float* ssp = (float*)(ws + OFF_SSP);
#pragma unroll
      for (int ai = 0; ai < 2; ++ai)
#pragma unroll
        for (int m = 0; m < 4; ++m) {
          const size_t row = row0 + ai * 128 + m * 16;
          float ss = 0.f;
#pragma unroll
          for (int bj = 0; bj < 2; ++bj) {
            const f32x4 v0 = acc[ai][bj][m][0], v1 = acc[ai][bj][m][1];
            ss += (v0[0] * v0[0] + v0[1] * v0[1]) + (v0[2] * v0[2] + v0[3] * v0[3]) + (v1[0] * v1[0] + v1[1] * v1[1]) + (v1[2] * v1[2] + v1[3] * v1[3]);
            u32x4 w; w.x = cvt_pk_bf16(v0[0], v0[1]); w.y = cvt_pk_bf16(v0[2], v0[3]); w.z = cvt_pk_bf16(v1[0], v1[1]); w.w = cvt_pk_bf16(v1[2], v1[3]);
            *(u32x4*)(dst + row * 256 + cl0 + bj * 128) = w;
          }
          ss += __shfl_xor(ss, 16); ss += __shfl_xor(ss, 32);
          if (fq == 0) ssp[row * 4 + wc] = ss;
        }
    } else if (pn == 15) {
      bf16* IK = (bf16*)(ws + OFF_IK);
      float* IW = (float*)(ws + OFF_IW);
      float* GLOW = (float*)(ws + OFF_GLOW);
#pragma unroll
      for (int ai = 0; ai < 2; ++ai)
#pragma unroll
        for (int m = 0; m < 4; ++m) {
          const size_t row = row0 + ai * 128 + m * 16;
          const int cl = cl0;
          const f32x4 v0 = acc[ai][0][m][0], v1 = acc[ai][0][m][1];
          if (cl < 64) {
            u32x4 w; w.x = cvt_pk_bf16(v0[0], v0[1]); w.y = cvt_pk_bf16(v0[2], v0[3]); w.z = cvt_pk_bf16(v1[0], v1[1]); w.w = cvt_pk_bf16(v1[2], v1[3]);
            *(u32x4*)(IK + tm_off(row, cl, 2)) = w;
          } else if (cl < 72) {
            *(f32x4*)(IW + row * 8) = v0 * 0.35355339059327373f;
            *(f32x4*)(IW + row * 8 + 4) = v1 * 0.35355339059327373f;
          } else if (cl < 88) {
            *(f32x4*)(GLOW + row * 16 + (cl - 72)) = v0;
            *(f32x4*)(GLOW + row * 16 + (cl - 72) + 4) = v1;
          }
        }
    } else {
      bf16* dst; int ld; float scale = 1.f; int act = 0; int coff; bool tm = false;
      if (pn < 2) { dst = (bf16*)(ws + OFF_Q); ld = 512; coff = pn * 256; scale = 0.08838834764831845f; }
      else if (pn < 4) { dst = (bf16*)(ws + OFF_K); ld = 512; coff = (pn - 2) * 256; }
      else if (pn < 8) { dst = (bf16*)(ws + OFF_V); ld = 1024; coff = (pn - 4) * 256; }
      else if (pn < 12) { dst = (bf16*)(ws + OFF_DQ); ld = 1024; coff = (pn - 8) * 256; tm = true; }
      else if (pn < 15) { dst = (bf16*)(ws + OFF_IQ); ld = 512; coff = (pn - 13) * 256; scale = 0.125f; tm = true; }
      else if (pn < 20) { dst = (bf16*)(ws + OFF_SGR); ld = 1024; coff = (pn - 16) * 256; act = 1; }
      else if (pn < 24) { dst = (bf16*)out; ld = 1024; coff = (pn - 20) * 256; act = 2; tm = true; }
      else { dst = (bf16*)out + (size_t)TT * 1024; ld = 1024; coff = (pn - 24) * 256; act = 2; tm = true; }
#pragma unroll
      for (int ai = 0; ai < 2; ++ai)
#pragma unroll
        for (int m = 0; m < 4; ++m) {
          const size_t row = row0 + ai * 128 + m * 16;
#pragma unroll
          for (int bj = 0; bj < 2; ++bj) {
            f32x4 v0 = acc[ai][bj][m][0] * scale, v1 = acc[ai][bj][m][1] * scale;
            if (act == 1) {
#pragma unroll
              for (int j = 0; j < 4; ++j) { v0[j] = siluf_(v0[j]); v1[j] = siluf_(v1[j]); }
            } else if (act == 2) {
#pragma unroll
              for (int j = 0; j < 4; ++j) { v0[j] = sigmoidf_(v0[j]); v1[j] = sigmoidf_(v1[j]); }
            }
            u32x4 w; w.x = cvt_pk_bf16(v0[0], v0[1]); w.y = cvt_pk_bf16(v0[2], v0[3]); w.z = cvt_pk_bf16(v1[0], v1[1]); w.w = cvt_pk_bf16(v1[2], v1[3]);
            *(u32x4*)(dst + (tm ? tm_off(row, coff + cl0 + bj * 128, ld >> 5) : row * ld + coff + cl0 + bj * 128)) = w;
          }
        }
    }
  }
};

template <bool ADD> struct EpiMix {
  static constexpr bool PERM = true, AFTER_DRAIN = false;
  const bf16* SZ; bf16* MIX;
  __device__ __forceinline__ void operator()(const f32x4 (&acc)[2][2][4][2], const Unit& u, int wr, int wc, int fr, int fq) const {
    const int row0 = u.pm * 256 + wr * 64 + fr, col0 = u.pn * 256 + wc * 32 + 8 * fq;
    u32x4 sc[2], oc[2], sn[2], on[2];
    {
      const size_t idx = (size_t)row0 * 1024 + col0;
      sc[0] = *(const u32x4*)(SZ + tm_off(row0, col0, 32)); sc[1] = *(const u32x4*)(SZ + tm_off(row0, col0 + 128, 32));
      if (ADD) { oc[0] = *(const u32x4*)(MIX + idx); oc[1] = *(const u32x4*)(MIX + idx + 128); }
    }
#pragma unroll
    for (int s = 0; s < 8; ++s) {
      const int ai = s >> 2, m = s & 3;
      const size_t idx = (size_t)(row0 + ai * 128 + m * 16) * 1024 + col0;
      if (s < 7) {
        const int ai2 = (s + 1) >> 2, m2 = (s + 1) & 3;
        const size_t idn = (size_t)(row0 + ai2 * 128 + m2 * 16) * 1024 + col0;
        sn[0] = *(const u32x4*)(SZ + tm_off(row0 + ai2 * 128 + m2 * 16, col0, 32)); sn[1] = *(const u32x4*)(SZ + tm_off(row0 + ai2 * 128 + m2 * 16, col0 + 128, 32));
        if (ADD) { on[0] = *(const u32x4*)(MIX + idn); on[1] = *(const u32x4*)(MIX + idn + 128); }
      }
#pragma unroll
      for (int bj = 0; bj < 2; ++bj) {
        const u32x4 sv = sc[bj];
        f32x4 v0 = acc[ai][bj][m][0], v1 = acc[ai][bj][m][1];
        v0[0] *= bflo(sv.x); v0[1] *= bfhi(sv.x); v0[2] *= bflo(sv.y); v0[3] *= bfhi(sv.y);
        v1[0] *= bflo(sv.z); v1[1] *= bfhi(sv.z); v1[2] *= bflo(sv.w); v1[3] *= bfhi(sv.w);
        if (ADD) {
          const u32x4 o = oc[bj];
          v0[0] += bflo(o.x); v0[1] += bfhi(o.x); v0[2] += bflo(o.y); v0[3] += bfhi(o.y);
          v1[0] += bflo(o.z); v1[1] += bfhi(o.z); v1[2] += bflo(o.w); v1[3] += bfhi(o.w);
        }
        u32x4 w; w.x = cvt_pk_bf16(v0[0], v0[1]); w.y = cvt_pk_bf16(v0[2], v0[3]); w.z = cvt_pk_bf16(v1[0], v1[1]); w.w = cvt_pk_bf16(v1[2], v1[3]);
        *(u32x4*)(MIX + idx + bj * 128) = w;
      }
      if (s < 7) { sc[0] = sn[0]; sc[1] = sn[1]; if (ADD) { oc[0] = on[0]; oc[1] = on[1]; } }
    }
  }
};

struct EpiX1 {
  static constexpr bool PERM = true, AFTER_DRAIN = false;
  const float* x; const float* ada; bf16* out;
  __device__ __forceinline__ void operator()(const f32x4 (&acc)[2][2][4][2], const Unit& u, int wr, int wc, int fr, int fq) const {
    const int row0 = u.pm * 256 + wr * 64 + fr, col0 = u.pn * 256 + wc * 32 + 8 * fq;
    const int b = (u.pm * 256) >> 12;
    f32x4 g[2][2];
#pragma unroll
    for (int bj = 0; bj < 2; ++bj) {
      g[bj][0] = *(const f32x4*)(ada + b * 6144 + 2048 + col0 + bj * 128);
      g[bj][1] = *(const f32x4*)(ada + b * 6144 + 2048 + col0 + bj * 128 + 4);
    }
    f32x4 xc[4], xn[4];
    {
      const size_t idx = (size_t)row0 * 1024 + col0;
      xc[0] = *(const f32x4*)(x + idx); xc[1] = *(const f32x4*)(x + idx + 4);
      xc[2] = *(const f32x4*)(x + idx + 128); xc[3] = *(const f32x4*)(x + idx + 132);
    }
#pragma unroll
    for (int s = 0; s < 8; ++s) {
      const int ai = s >> 2, m = s & 3;
      const size_t idx = (size_t)(row0 + ai * 128 + m * 16) * 1024 + col0;
      if (s < 7) {
        const int ai2 = (s + 1) >> 2, m2 = (s + 1) & 3;
        const size_t idn = (size_t)(row0 + ai2 * 128 + m2 * 16) * 1024 + col0;
        xn[0] = *(const f32x4*)(x + idn); xn[1] = *(const f32x4*)(x + idn + 4);
        xn[2] = *(const f32x4*)(x + idn + 128); xn[3] = *(const f32x4*)(x + idn + 132);
      }
#pragma unroll
      for (int bj = 0; bj < 2; ++bj) {
        const f32x4 v0 = xc[2 * bj] + g[bj][0] * acc[ai][bj][m][0], v1 = xc[2 * bj + 1] + g[bj][1] * acc[ai][bj][m][1];
        u32x4 w; w.x = cvt_pk_bf16(v0[0], v0[1]); w.y = cvt_pk_bf16(v0[2], v0[3]); w.z = cvt_pk_bf16(v1[0], v1[1]); w.w = cvt_pk_bf16(v1[2], v1[3]);
        *(u32x4*)(out + idx + bj * 128) = w;
      }
      if (s < 7) { xc[0] = xn[0]; xc[1] = xn[1]; xc[2] = xn[2]; xc[3] = xn[3]; }
    }
  }
};

struct EpiPlain {
  static constexpr bool PERM = true, AFTER_DRAIN = false;
  bf16* O; int ld;
  __device__ __forceinline__ void operator()(const f32x4 (&acc)[2][2][4][2], const Unit& u, int wr, int wc, int fr, int fq) const {
    const int row0 = u.pm * 256 + wr * 64 + fr, col0 = u.pn * 256 + wc * 32 + 8 * fq;
#pragma unroll
    for (int ai = 0; ai < 2; ++ai)
#pragma unroll
      for (int m = 0; m < 4; ++m)
#pragma unroll
        for (int bj = 0; bj < 2; ++bj) {
          const f32x4 v0 = acc[ai][bj][m][0], v1 = acc[ai][bj][m][1];
          u32x4 w; w.x = cvt_pk_bf16(v0[0], v0[1]); w.y = cvt_pk_bf16(v0[2], v0[3]); w.z = cvt_pk_bf16(v1[0], v1[1]); w.w = cvt_pk_bf16(v1[2], v1[3]);
          *(u32x4*)(O + tm_off((size_t)(row0 + ai * 128 + m * 16), col0 + bj * 128, ld >> 5)) = w;
        }
  }
};

template <class Epi>
__device__ __forceinline__ void gemm_run(LAS unsigned char* lds, const bf16* A, const bf16* Bt, int M, int N, int K, const Epi& E) {
  pg8::Gemm g{A, Bt, M, N, K};
  pg8::StaticOrder S;
  S.init(M, N, gridDim.x, blockIdx.x);
  pg8::gemm_phase<Epi, pg8::StaticOrder, false>(lds, g, S, E, nullptr);
}

typedef short bf16x8_t __attribute__((ext_vector_type(8)));
typedef __bf16 bf16x2_t __attribute__((ext_vector_type(2)));
__device__ __forceinline__ float dot2bf(unsigned a, unsigned b, float acc) {
  return __builtin_amdgcn_fdot2_f32_bf16(__builtin_bit_cast(bf16x2_t, a), __builtin_bit_cast(bf16x2_t, b), acc, false);
}
__device__ __forceinline__ void wave_lds_fence() { asm volatile("s_waitcnt lgkmcnt(0)" ::: "memory"); }
template <int N> __device__ __forceinline__ float row_ror(float x) {
  return __int_as_float(__builtin_amdgcn_update_dpp(0, __float_as_int(x), 0x120 + N, 0xf, 0xf, false));
}
__device__ __forceinline__ float row16_max(float m) {
  m = fmaxf(m, row_ror<8>(m)); m = fmaxf(m, row_ror<4>(m)); m = fmaxf(m, row_ror<2>(m)); m = fmaxf(m, row_ror<1>(m));
  return m;
}
__device__ __forceinline__ float row16_sum(float m) {
  m += row_ror<8>(m); m += row_ror<4>(m); m += row_ror<2>(m); m += row_ror<1>(m);
  return m;
}
__device__ __forceinline__ float wave_sum_dpp(float s) {
  s = row16_sum(s);
  const int si = __float_as_int(s);
  return __int_as_float(__builtin_amdgcn_readlane(si, 0)) + __int_as_float(__builtin_amdgcn_readlane(si, 16)) +
         (__int_as_float(__builtin_amdgcn_readlane(si, 32)) + __int_as_float(__builtin_amdgcn_readlane(si, 48)));
}
__device__ __forceinline__ constexpr int cand_i(int L) {
  return L < 16 ? 0 : L < 24 ? 1 : L < 29 ? 2 : L < 33 ? 3 : L < 36 ? 4 : L < 38 ? 5 : L < 40 ? 6 : L < 42 ? 7 : (L - 42 + 8);
}
__device__ __forceinline__ constexpr int cand_j(int L) {
  return L < 16 ? L : L < 24 ? L - 16 : L < 29 ? L - 24 : L < 33 ? L - 29 : L < 36 ? L - 33 : L < 38 ? L - 36 : L < 40 ? L - 38 : L < 42 ? L - 40 : 0;
}
template <int K> struct CandRank {
  static __device__ __forceinline__ void run(int ki, unsigned key, int& rank) {
    const unsigned o = (unsigned)__builtin_amdgcn_readlane(ki, K);
    rank += (o > key) ? 1 : 0;
    CandRank<K + 1>::run(ki, key, rank);
  }
};
template <> struct CandRank<50> { static __device__ __forceinline__ void run(int, unsigned, int&) {} };
__device__ __forceinline__ unsigned peer_f2ord(float f) {
  if (f == 0.f) f = 0.f;
  const unsigned u = __float_as_uint(f);
  return (u & 0x80000000u) ? ~u : (u | 0x80000000u);
}
__device__ __forceinline__ float peer_ord2f(unsigned u) { return __uint_as_float((u & 0x80000000u) ? (u ^ 0x80000000u) : ~u); }
__device__ __forceinline__ unsigned umax3(unsigned a, unsigned b, unsigned c) { const unsigned t = a > b ? a : b; return t > c ? t : c; }
template <int N> __device__ __forceinline__ unsigned row_ror_u(unsigned x) {
  return (unsigned)__builtin_amdgcn_update_dpp(0, (int)x, 0x120 + N, 0xf, 0xf, false);
}
__device__ __forceinline__ unsigned row16_umax(unsigned m) {
  unsigned t;
  t = row_ror_u<8>(m); m = t > m ? t : m; t = row_ror_u<4>(m); m = t > m ? t : m;
  t = row_ror_u<2>(m); m = t > m ? t : m; t = row_ror_u<1>(m); m = t > m ? t : m;
  return m;
}
__device__ __forceinline__ float gelu_exact(float v) { return 0.5f * v * (1.f + erff(v * 0.7071067811865476f)); }

typedef float f32x2_t __attribute__((ext_vector_type(2)));
typedef unsigned peer_u32x2 __attribute__((ext_vector_type(2)));
__device__ __forceinline__ float peer_fold32(float a, float b) {
  const peer_u32x2 r = __builtin_amdgcn_permlane32_swap(__float_as_uint(a), __float_as_uint(b), false, false);
  return __uint_as_float(r.x) + __uint_as_float(r.y);
}
__device__ __forceinline__ float peer_fold16(float a, float b) {
  const peer_u32x2 r = __builtin_amdgcn_permlane16_swap(__float_as_uint(a), __float_as_uint(b), false, false);
  return __uint_as_float(r.x) + __uint_as_float(r.y);
}
#define GAS __attribute__((address_space(1)))
#define PEER_NB 6
#define PEER_LOAD(buf, TAB, tk, e0)                                                               \
  {                                                                                               \
    const unsigned* rp_ = (const unsigned*)(ridx + ((tk) * 128 + (e0)));                          \
    const unsigned w0_ = rp_[0], w1_ = rp_[1], w2_ = rp_[2];                                      \
    const int i0_ = __builtin_amdgcn_readfirstlane((int)(w0_ & 0x3fffu)), i1_ = __builtin_amdgcn_readfirstlane((int)((w0_ >> 16) & 0x3fffu)); \
    const int i2_ = __builtin_amdgcn_readfirstlane((int)(w1_ & 0x3fffu)), i3_ = __builtin_amdgcn_readfirstlane((int)((w1_ >> 16) & 0x3fffu)); \
    const int i4_ = __builtin_amdgcn_readfirstlane((int)(w2_ & 0x3fffu)), i5_ = __builtin_amdgcn_readfirstlane((int)((w2_ >> 16) & 0x3fffu)); \
    buf[0] = *(const GAS u32x4_t*)((TAB) + (size_t)i0_ * 1024 + lane * 16);                       \
    buf[1] = *(const GAS u32x4_t*)((TAB) + (size_t)i1_ * 1024 + lane * 16);                       \
    buf[2] = *(const GAS u32x4_t*)((TAB) + (size_t)i2_ * 1024 + lane * 16);                       \
    buf[3] = *(const GAS u32x4_t*)((TAB) + (size_t)i3_ * 1024 + lane * 16);                       \
    buf[4] = *(const GAS u32x4_t*)((TAB) + (size_t)i4_ * 1024 + lane * 16);                       \
    buf[5] = *(const GAS u32x4_t*)((TAB) + (size_t)i5_ * 1024 + lane * 16);                       \
  }
#define PEER_UDOT(buf, e0)                                                                        \
  {                                                                                               \
    float sp[6];                                                                                  \
    _Pragma("unroll") for (int j = 0; j < 6; ++j) {                                               \
      float s0 = 0.f, s1 = 0.f;                                                                   \
      _Pragma("unroll") for (int w = 0; w < 4; ++w) {                                             \
        const f32x2_t lo = __builtin_amdgcn_cvt_pk_f32_fp8((int)buf[j][w], false);                \
        const f32x2_t hi = __builtin_amdgcn_cvt_pk_f32_fp8((int)buf[j][w], true);                 \
        s0 = __builtin_fmaf(lo.x, hf[4 * w], s0); s1 = __builtin_fmaf(lo.y, hf[4 * w + 1], s1);   \
        s0 = __builtin_fmaf(hi.x, hf[4 * w + 2], s0); s1 = __builtin_fmaf(hi.y, hf[4 * w + 3], s1); \
      }                                                                                           \
      sp[j] = s0 + s1;                                                                            \
    }                                                                                             \
    const float u01 = peer_fold32(sp[0], sp[1]), u23 = peer_fold32(sp[2], sp[3]), u45 = peer_fold32(sp[4], sp[5]); \
    const float wq = row16_sum(peer_fold16(u01, u23));     \
    const float wr = row16_sum(peer_fold16(u45, u45));         \
    const int wqi = __float_as_int(wq), wri = __float_as_int(wr);                                 \
    PEER_PUT((e0) + 0, __builtin_amdgcn_readlane(wqi, 0));                                        \
    PEER_PUT((e0) + 1, __builtin_amdgcn_readlane(wqi, 32));                                       \
    PEER_PUT((e0) + 2, __builtin_amdgcn_readlane(wqi, 16));                                       \
    PEER_PUT((e0) + 3, __builtin_amdgcn_readlane(wqi, 48));                                       \
    PEER_PUT((e0) + 4, __builtin_amdgcn_readlane(wri, 0));                                        \
    PEER_PUT((e0) + 5, __builtin_amdgcn_readlane(wri, 32));                                       \
  }
#define PEER_PUT(ee_, vi_)                                                                        \
  {                                                                                               \
    const int ee = (ee_); const float sv = __int_as_float(vi_);                                   \
    const bool mine = (lane == (ee & 63));                                                        \
    dotA = (mine && ee < 64) ? sv : dotA;                                                         \
    dotB = (mine && ee >= 64 && ee < 128) ? sv : dotB;                                            \
  }
#define PEER_VACC(buf, e0)                                                                        \
  _Pragma("unroll") for (int j = 0; j < PEER_NB; ++j) {                                                 \
    const int ee = (e0) + j;                                                                      \
    const float a = (ee < 128) ? __int_as_float(__builtin_amdgcn_readlane(__float_as_int(ee < 64 ? aA : aB), ee & 63)) : 0.f; \
    _Pragma("unroll") for (int w = 0; w < 4; ++w) {                                               \
      const f32x2_t lo = __builtin_amdgcn_cvt_pk_f32_fp8((int)buf[j][w], false);                  \
      const f32x2_t hi = __builtin_amdgcn_cvt_pk_f32_fp8((int)buf[j][w], true);                   \
      acc[4 * w] += a * lo.x; acc[4 * w + 1] += a * lo.y; acc[4 * w + 2] += a * hi.x; acc[4 * w + 3] += a * hi.y; \
    }                                                                                             \
    __builtin_amdgcn_sched_barrier(0);                                                           \
  }

#ifndef PROBE_PEER
#define PROBE_PEER 0
#endif
#if PROBE_PEER
#define PEER_MARK(k) do { const unsigned long long n_ = __builtin_amdgcn_s_memrealtime(); if (PROBE_PEER == (k)) { const unsigned long long q_ = n_ - pmark; \
    while (__builtin_amdgcn_s_memrealtime() - n_ < q_) __builtin_amdgcn_s_sleep(2); } pmark = __builtin_amdgcn_s_memrealtime(); } while (0)
#else
#define PEER_MARK(k) do {} while (0)
#endif
__device__ __forceinline__ void ph_peer512(const P& p, unsigned char* lds_raw, float* dst_base) {
  const int tid = tid_fresh(), wave = tid >> 6, lane = tid & 63, g = lane >> 4, c = lane & 15;
  const bf16* PQ = (const bf16*)(p.ws + OFF_PQ);
  const bf16* SK = (const bf16*)(p.ws + OFF_SK);
  float* tv = (float*)(lds_raw + wave * 16384);
  int* ti = (int*)(tv + 512);
  float* rgate = (float*)(ti + 512);
  unsigned short* ridx = (unsigned short*)(rgate + 2048);
  for (int tile = blockIdx.x * 8 + wave; tile < TT / 16; tile += gridDim.x * 8) {
    const int tok0 = tile * 16;
#if PROBE_PEER
    unsigned long long pmark = __builtin_amdgcn_s_memrealtime();
#endif
    unsigned* tk = (unsigned*)tv;
#pragma unroll 1
    for (int hp = 0; hp < 4; ++hp) {
#pragma unroll 1
      for (int hf = 0; hf < 2; ++hf) {
        bf16x8_t bfr[4][8];
#pragma unroll
        for (int ks = 0; ks < 4; ++ks)
#pragma unroll
          for (int nt = 0; nt < 8; ++nt) bfr[ks][nt] = *(const bf16x8_t*)(SK + hf * 16384 + ((nt * 4 + ks) * 64 + lane) * 8);
#pragma unroll 1
        for (int h2 = 0; h2 < 2; ++h2) {
          const int hd = 2 * hp + h2;
          f32x4 acc[8];
#pragma unroll
          for (int nt = 0; nt < 8; ++nt) acc[nt] = (f32x4){0.f, 0.f, 0.f, 0.f};
#pragma unroll
          for (int ks = 0; ks < 4; ++ks) {
            const bf16x8_t a = *(const bf16x8_t*)(PQ + ((size_t)(tile * 64 + hd * 8 + hf * 4 + ks) * 64 + lane) * 8);
#pragma unroll
            for (int nt = 0; nt < 8; ++nt) acc[nt] = __builtin_amdgcn_mfma_f32_16x16x32_bf16(a, bfr[ks][nt], acc[nt], 0, 0, 0);
          }
          asm volatile("" :: "v"(acc[0][0]), "v"(acc[7][3]));
          PEER_MARK(1);
          unsigned kq[4][8], res[4];
#pragma unroll
          for (int i = 0; i < 4; ++i) {
            res[i] = 0u;
#pragma unroll
            for (int nt = 0; nt < 8; ++nt) kq[i][nt] = (peer_f2ord(acc[nt][i]) & ~127u) | (unsigned)(127 - (16 * nt + c));
          }
#pragma unroll 1
          for (int r = 0; r < 16; ++r) {
#pragma unroll
            for (int i = 0; i < 4; ++i) {
              unsigned m = umax3(umax3(kq[i][0], kq[i][1], kq[i][2]), umax3(kq[i][3], kq[i][4], kq[i][5]), (kq[i][6] > kq[i][7]) ? kq[i][6] : kq[i][7]);
              m = row16_umax(m);
#pragma unroll
              for (int nt = 0; nt < 8; ++nt) kq[i][nt] = (kq[i][nt] == m) ? 0u : kq[i][nt];
              res[i] = (c == r) ? m : res[i];
            }
          }
#pragma unroll
          for (int i = 0; i < 4; ++i) tk[((h2 * 2 + hf) * 16 + 4 * g + i) * 16 + c] = res[i];
        }
      }
      wave_lds_fence();
      PEER_MARK(2);
      const int ci = cand_i(lane < 50 ? lane : 0), cj = cand_j(lane < 50 ? lane : 0);
#pragma unroll 1
      for (int hr = 0; hr < 32; ++hr) {
        const int h2 = hr >> 4, row = hr & 15, hd = 2 * hp + h2;
        const unsigned k1 = tk[((h2 * 2 + 0) * 16 + row) * 16 + ci], k2 = tk[((h2 * 2 + 1) * 16 + row) * 16 + cj];
        const float val = peer_ord2f(k1 & ~127u) + peer_ord2f(k2 & ~127u);
        const unsigned key = (lane < 50) ? ((peer_f2ord(val) & ~63u) | (unsigned)(63 - lane)) : 0u;
        int rank = 0;
        CandRank<0>::run((int)key, key, rank);
        if (lane < 50 && rank < 16) {
          rgate[row * 128 + hd * 16 + rank] = val;
          ridx[row * 128 + hd * 16 + rank] = (unsigned short)((127 - (int)(k1 & 127u)) * 128 + (127 - (int)(k2 & 127u)));
        }
      }
      wave_lds_fence();
      PEER_MARK(3);
#pragma unroll
      for (int h2 = 0; h2 < 2; ++h2) {
        const int hd = 2 * hp + h2;
        const int row = lane >> 2, q = lane & 3;
        float* gp = rgate + row * 128 + hd * 16;
        const float mx = gp[0];
        const f32x4 b4 = *(const f32x4*)(gp + q * 4);
        f32x4 e4;
        e4[0] = __expf(b4[0] - mx); e4[1] = __expf(b4[1] - mx); e4[2] = __expf(b4[2] - mx); e4[3] = __expf(b4[3] - mx);
        float s = (e4[0] + e4[1]) + (e4[2] + e4[3]);
        s += __shfl_xor(s, 1); s += __shfl_xor(s, 2);
        const float inv = 1.f / s;
        wave_lds_fence();
        *(f32x4*)(gp + q * 4) = e4 * inv;
      }
      wave_lds_fence();
    }
    char* wsl = p.ws;
    asm volatile("" : "+s"(wsl));
    const GAS bf16* H2 = (const GAS bf16*)(wsl + OFF_H);
    const GAS unsigned char* PU = (const GAS unsigned char*)(wsl + OFF_PU);
    const GAS unsigned char* PV = (const GAS unsigned char*)(wsl + OFF_PV);
    const GAS float* USC = (const GAS float*)(wsl + OFF_PSC);
    const GAS float* VSC = USC + 16384;
    const GAS float* ada = (const GAS float*)(wsl + OFF_ADA);
    u32x4_t a0[PEER_NB], a1[PEER_NB], hn0, hn1;
#define PSB() __builtin_amdgcn_sched_barrier(0)
#define PEER_ROWS (((128 + 2 * PEER_NB - 1) / (2 * PEER_NB)) * 2 * PEER_NB)
    {
      const int tidx = tid_fresh(), lane = tidx & 63, wv = __builtin_amdgcn_readfirstlane(tidx >> 6);
      const unsigned short* ridx = (const unsigned short*)(lds_raw + wv * 16384 + 4096 + 8192);
      hn0 = *(const GAS u32x4_t*)(H2 + (size_t)tok0 * 1024 + lane * 16); hn1 = *(const GAS u32x4_t*)(H2 + (size_t)tok0 * 1024 + lane * 16 + 8);
      PEER_LOAD(a0, PU, 0, 0); PSB();
      PEER_LOAD(a1, PU, 0, PEER_NB); PSB();
    }
#pragma unroll 1
    for (int tt = 0; tt < 16; ++tt) {
      const int tidx = tid_fresh(), lane = tidx & 63, wv = __builtin_amdgcn_readfirstlane(tidx >> 6);
      const float* rgate = (const float*)(lds_raw + wv * 16384 + 4096);
      const unsigned short* ridx = (const unsigned short*)(lds_raw + wv * 16384 + 4096 + 8192);
      const size_t tok = (size_t)tok0 + tt;
      const int ttn = (tt < 15) ? tt + 1 : tt;
      float hf[16];
#pragma unroll
      for (int w = 0; w < 4; ++w) { hf[2 * w] = bflo(hn0[w]); hf[2 * w + 1] = bfhi(hn0[w]); hf[8 + 2 * w] = bflo(hn1[w]); hf[8 + 2 * w + 1] = bfhi(hn1[w]); }
      const int eA = (int)ridx[tt * 128 + lane], eB = (int)ridx[tt * 128 + 64 + lane];
      const float usA = USC[eA], usB = USC[eB];
      float dotA = 0.f, dotB = 0.f;
#pragma unroll 1
      for (int e0 = 0; e0 < PEER_ROWS; e0 += 2 * PEER_NB) {
        const bool more = e0 + 2 * PEER_NB < PEER_ROWS;
        const GAS unsigned char* tb = more ? PU : PV;
        const int r0 = more ? e0 + 2 * PEER_NB : 0;
        PEER_UDOT(a0, e0); PSB();
        PEER_LOAD(a0, tb, tt, r0); PSB();
        PEER_UDOT(a1, e0 + PEER_NB); PSB();
        PEER_LOAD(a1, tb, tt, r0 + PEER_NB); PSB();
      }
      const float aA = gelu_exact(dotA * usA) * rgate[tt * 128 + lane] * VSC[(int)ridx[tt * 128 + lane]],
                  aB = gelu_exact(dotB * usB) * rgate[tt * 128 + 64 + lane] * VSC[(int)ridx[tt * 128 + 64 + lane]];
      float acc[16];
#pragma unroll
      for (int k = 0; k < 16; ++k) acc[k] = 0.f;
      hn0 = *(const GAS u32x4_t*)(H2 + ((size_t)tok0 + ttn) * 1024 + lane * 16); hn1 = *(const GAS u32x4_t*)(H2 + ((size_t)tok0 + ttn) * 1024 + lane * 16 + 8);
      PSB();
#pragma unroll 1
      for (int e0 = 0; e0 < PEER_ROWS; e0 += 2 * PEER_NB) {
        const bool more = e0 + 2 * PEER_NB < PEER_ROWS;
        const GAS unsigned char* tb = more ? PV : PU;
        const int r0 = more ? e0 + 2 * PEER_NB : 0, tkk = more ? tt : ttn;
        PEER_VACC(a0, e0); PSB();
        PEER_LOAD(a0, tb, tkk, r0); PSB();
        PEER_VACC(a1, e0 + PEER_NB); PSB();
        PEER_LOAD(a1, tb, tkk, r0 + PEER_NB); PSB();
      }
      const int b = (int)(tok >> 12);
      const GAS bf16* xrow = (const GAS bf16*)(wsl + OFF_X1) + tok * 1024;
      const u32x4_t xw0 = *(const GAS u32x4_t*)(xrow + lane * 16), xw1 = *(const GAS u32x4_t*)(xrow + lane * 16 + 8);
      GAS float* orow = (GAS float*)dst_base + tok * 1024;
      const GAS float* g2 = ada + b * 6144 + 5120;
      float x2[16];
      float ss = 0.f;
#pragma unroll
      for (int q = 0; q < 4; ++q) {
        const int col = lane * 16 + q * 4;
        const unsigned xa = (q < 2) ? xw0[2 * (q & 1)] : xw1[2 * (q & 1)], xb = (q < 2) ? xw0[2 * (q & 1) + 1] : xw1[2 * (q & 1) + 1];
        const f32x4 xv = (f32x4){bflo(xa), bfhi(xa), bflo(xb), bfhi(xb)}, gv = *(const GAS f32x4*)(g2 + col);
#pragma unroll
        for (int k = 0; k < 4; ++k) { const float t = xv[k] + gv[k] * acc[q * 4 + k]; x2[q * 4 + k] = t; ss += t * t; }
      }
      ss = wave_sum_dpp(ss);
      const float rstd = rsqrtf(ss * (1.f / 1024.f) + 1e-6f);
#pragma unroll
      for (int q = 0; q < 4; ++q) {
        const int col = lane * 16 + q * 4;
        const f32x4 fg = *(const GAS f32x4*)((const GAS float*)(wsl + OFF_PRM) + PRM_FG + col);
        f32x4 o;
#pragma unroll
        for (int k = 0; k < 4; ++k) o[k] = x2[q * 4 + k] * rstd * fg[k];
        *(GAS f32x4*)(orow + col) = o;
      }
    }
    wave_lds_fence();
  }
}

#define DS_KEY16   0
#define DS_CHUNK   17408
#define DS_SEL     139264
#define DS_WAVE    147456
#define DS_TOTAL   155648
#define DS_RS      544

__device__ __forceinline__ unsigned f2ord(float f) {
  if (f == 0.f) f = 0.f;
  unsigned u = __float_as_uint(f);
  return (u & 0x80000000u) ? ~u : (u | 0x80000000u);
}
__device__ __forceinline__ int wave_scan_incl(int v, int lane) {
#pragma unroll
  for (int o = 1; o < 64; o <<= 1) { const int t = __shfl_up(v, o); v += (lane >= o) ? t : 0; }
  return v;
}
__device__ __forceinline__ void find_digit(const LAS unsigned* hist, int K, int lane, int& digit, int& above) {
  const u32x4_t h4 = *(const LAS u32x4_t*)(hist + 252 - 4 * lane);
  const int c0 = (int)h4.w, c1 = (int)h4.z, c2 = (int)h4.y, c3 = (int)h4.x;
  const int tot = c0 + c1 + c2 + c3;
  int run = wave_scan_incl(tot, lane) - tot;
  int found = -1, ab = 0;
  if (run < K && run + c0 >= K) { found = 255 - 4 * lane; ab = run; } run += c0;
  if (run < K && run + c1 >= K) { found = 254 - 4 * lane; ab = run; } run += c1;
  if (run < K && run + c2 >= K) { found = 253 - 4 * lane; ab = run; } run += c2;
  if (run < K && run + c3 >= K) { found = 252 - 4 * lane; ab = run; }
  const unsigned long long mk = __ballot(found >= 0);
  const int src = (int)__ffsll((unsigned long long)mk) - 1;
  digit = __builtin_amdgcn_readlane(found, src);
  above = __builtin_amdgcn_readlane(ab, src);
}

typedef unsigned u32x2_t __attribute__((ext_vector_type(2)));
__device__ __forceinline__ float xrow_max(float x) {
  u32x2_t r = __builtin_amdgcn_permlane16_swap(__float_as_uint(x), __float_as_uint(x), false, false);
  x = fmaxf(__uint_as_float(r.x), __uint_as_float(r.y));
  r = __builtin_amdgcn_permlane32_swap(__float_as_uint(x), __float_as_uint(x), false, false);
  return fmaxf(__uint_as_float(r.x), __uint_as_float(r.y));
}
__device__ __forceinline__ float xrow_sum(float x) {
  u32x2_t r = __builtin_amdgcn_permlane16_swap(__float_as_uint(x), __float_as_uint(x), false, false);
  x = __uint_as_float(r.x) + __uint_as_float(r.y);
  r = __builtin_amdgcn_permlane32_swap(__float_as_uint(x), __float_as_uint(x), false, false);
  return __uint_as_float(r.x) + __uint_as_float(r.y);
}
__device__ __forceinline__ s16x4_t tr_read_b64(unsigned addr) {
  s16x4_t r; asm volatile("ds_read_b64_tr_b16 %0, %1" : "=&v"(r) : "v"(addr) : "memory"); return r;
}

#ifndef PROBE_DSA
#define PROBE_DSA 0
#endif
#if PROBE_DSA
#define DSA_MARK(k) do { const unsigned long long n_ = __builtin_amdgcn_s_memrealtime(); if (PROBE_DSA == (k)) { const unsigned long long q_ = n_ - tmark; \
    while (__builtin_amdgcn_s_memrealtime() - n_ < q_) __builtin_amdgcn_s_sleep(2); } tmark = __builtin_amdgcn_s_memrealtime(); } while (0)
#else
#define DSA_MARK(k) do {} while (0)
#endif
#if PROBE_DSA >= 10
#define DSA_MARKI(k) DSA_MARK(k)
#else
#define DSA_MARKI(k) do {} while (0)
#endif
__device__ __forceinline__ void dsa_batch(const P& p, unsigned char* lds_raw, int b, int pos2) {
  const int t00 = pos2 * 32;
#define DSA_IDS const int tid = tid_fresh(), wave = __builtin_amdgcn_readfirstlane(tid >> 6), lane = tid & 63, g = lane >> 4, c = lane & 15; (void)wave; (void)g; (void)c;
  const size_t tokb = (size_t)b * SEQ, tok00 = tokb + t00;
  const bf16* DQ = (const bf16*)(p.ws + OFF_DQ);
  const bf16* CKV = (const bf16*)(p.ws + OFF_CKV);
  const float* SSP = (const float*)(p.ws + OFF_SSP);
  const bf16* IQ = (const bf16*)(p.ws + OFF_IQ);
  const bf16* IK = (const bf16*)(p.ws + OFF_IK);
  const float* IW = (const float*)(p.ws + OFF_IW);
  const bf16* WUK = (const bf16*)(p.ws + OFF_WUK);
  const bf16* WUV = (const bf16*)(p.ws + OFF_WUV);
  bf16* ODSA = (bf16*)(p.ws + OFF_ODSA);
  bf16* QL = (bf16*)(p.ws + OFF_DSCR + (size_t)blockIdx.x * 131072);
  bf16* OL = QL;
  LAS unsigned char* lds = (LAS unsigned char*)lds_raw;
  LAS unsigned short* key16 = (LAS unsigned short*)(lds + DS_KEY16);
  LAS unsigned short* sel = (LAS unsigned short*)(lds + DS_SEL);

#if PROBE_DSA
  unsigned long long tmark = __builtin_amdgcn_s_memrealtime();
#endif
  {
    DSA_IDS
    const int h = wave;
    bf16x8_t dq0[4], dq1[4];
#pragma unroll
    for (int ks = 0; ks < 4; ++ks) {
      dq0[ks] = *(const bf16x8_t*)(DQ + (((tok00 >> 4) * 32 + h * 4 + ks) * 64 + lane) * 8);
      dq1[ks] = *(const bf16x8_t*)(DQ + ((((tok00 >> 4) + 1) * 32 + h * 4 + ks) * 64 + lane) * 8);
    }
#pragma unroll 1
    for (int hn = 0; hn < 2; ++hn) {
      bf16x8_t wf[8][4];
#pragma unroll
      for (int n8 = 0; n8 < 8; ++n8)
#pragma unroll
        for (int ks = 0; ks < 4; ++ks) wf[n8][ks] = *(const bf16x8_t*)(WUK + (size_t)((h * 16 + hn * 8 + n8) * 4 + ks) * 512 + lane * 8);
      __builtin_amdgcn_sched_barrier(0);
#pragma unroll
      for (int n8 = 0; n8 < 8; ++n8) {
        const int nt = hn * 8 + n8;
        f32x4 a0 = (f32x4){0.f, 0.f, 0.f, 0.f}, a1 = a0;
#pragma unroll
        for (int ks = 0; ks < 4; ++ks) {
          a0 = __builtin_amdgcn_mfma_f32_16x16x32_bf16(wf[n8][ks], dq0[ks], a0, 0, 0, 0);
          a1 = __builtin_amdgcn_mfma_f32_16x16x32_bf16(wf[n8][ks], dq1[ks], a1, 0, 0, 0);
        }
        uint2 o; o.x = pk2(a0[0], a0[1]); o.y = pk2(a0[2], a0[3]);
        *(uint2*)(QL + c * 2048 + h * 256 + nt * 16 + 4 * g) = o;
        o.x = pk2(a1[0], a1[1]); o.y = pk2(a1[2], a1[3]);
        *(uint2*)(QL + (16 + c) * 2048 + h * 256 + nt * 16 + 4 * g) = o;
      }
      __builtin_amdgcn_sched_barrier(0);
    }
  }
  DSA_MARK(1);
#pragma unroll 1
  for (int half = 0; half < 2; ++half) {
  const int t0 = t00 + 16 * half;
  const size_t tok0 = tokb + t0;
  bf16* QLh = QL + half * 16 * 2048;
  bf16* OLh = QLh;
  if (t0 >= 256) {
    DSA_IDS
    bf16x8_t qf[8][2];
    float iw[8];
#pragma unroll
    for (int h = 0; h < 8; ++h) {
      qf[h][0] = *(const bf16x8_t*)(IQ + (((tok0 >> 4) * 16 + h * 2) * 64 + lane) * 8);
      qf[h][1] = *(const bf16x8_t*)(IQ + (((tok0 >> 4) * 16 + h * 2 + 1) * 64 + lane) * 8);
      iw[h] = IW[(tok0 + c) * 8 + h];
    }
    const int ntile = (t0 >> 4) + 1;
    bf16x8_t k0n = (bf16x8_t){0, 0, 0, 0, 0, 0, 0, 0}, k1n = k0n;
    if (wave < ntile) { const bf16* kr = IK + ((((tokb >> 4) + wave) * 2) * 64 + lane) * 8; k0n = *(const bf16x8_t*)kr; k1n = *(const bf16x8_t*)(kr + 512); }
    for (int kt = wave; kt < ntile; kt += 8) {
      const bf16x8_t k0 = k0n, k1 = k1n;
      { const int ktn = (kt + 8 < ntile) ? kt + 8 : kt; const bf16* kr = IK + ((((tokb >> 4) + ktn) * 2) * 64 + lane) * 8; k0n = *(const bf16x8_t*)kr; k1n = *(const bf16x8_t*)(kr + 512); }
      f32x4 sc = (f32x4){0.f, 0.f, 0.f, 0.f};
#pragma unroll
      for (int h = 0; h < 8; ++h) {
        f32x4 d = __builtin_amdgcn_mfma_f32_16x16x32_bf16(k0, qf[h][0], (f32x4){0.f, 0.f, 0.f, 0.f}, 0, 0, 0);
        d = __builtin_amdgcn_mfma_f32_16x16x32_bf16(k1, qf[h][1], d, 0, 0, 0);
#pragma unroll
        for (int i = 0; i < 4; ++i) sc[i] += iw[h] * fmaxf(d[i], 0.f);
      }
      u16x4_t o;
      const int sb = kt * 16 + 4 * g, tq = t0 + c;
      o.x = (sb + 0 <= tq) ? (unsigned short)(f2ord(sc[0]) >> 16) : (unsigned short)0;
      o.y = (sb + 1 <= tq) ? (unsigned short)(f2ord(sc[1]) >> 16) : (unsigned short)0;
      o.z = (sb + 2 <= tq) ? (unsigned short)(f2ord(sc[2]) >> 16) : (unsigned short)0;
      o.w = (sb + 3 <= tq) ? (unsigned short)(f2ord(sc[3]) >> 16) : (unsigned short)0;
      *(LAS u16x4_t*)(key16 + c * 4096 + sb) = o;
    }
  }
  DSA_MARK(2);
  __syncthreads();
#pragma unroll 1
  for (int qq = 0; qq < 2; ++qq) {
    DSA_IDS
    const int q = wave + 8 * qq, t = t0 + q;
    LAS unsigned short* selq = sel + q * 256;
    if (t < 256) {
      for (int j = lane; j < 256; j += 64) selq[j] = (unsigned short)((j <= t) ? j : 0);
    } else {
      const LAS unsigned short* kq = key16 + q * 4096;
      const int nit = (t >> 9) + 1;
      unsigned kp[8][4];
#pragma unroll
      for (int it = 0; it < 8; ++it) {
        const int s0 = 512 * it + 8 * lane;
        u32x4_t v = (u32x4_t){0u, 0u, 0u, 0u};
        if (s0 <= t) v = *(const LAS u32x4_t*)(kq + s0);
#pragma unroll
        for (int j = 0; j < 4; ++j) {
          const unsigned lo = (s0 + 2 * j <= t) ? (v[j] & 0xffffu) : 0u, hi = (s0 + 2 * j + 1 <= t) ? (v[j] & 0xffff0000u) : 0u;
          kp[it][j] = lo | hi;
        }
      }
      asm volatile("" :: "v"(kp[0][0]), "v"(kp[7][3]));
      DSA_MARKI(21);
      unsigned B = 0u;
#pragma unroll 1
      for (int bit = 15; bit >= 0; --bit) {
        const unsigned cand = B | (1u << bit);
        const unsigned c2 = (cand - 1u) * 0x00010001u;
        unsigned cnt2 = 0u;
#pragma unroll
        for (int it = 0; it < 8; ++it) {
          if (it < nit) {
#pragma unroll
            for (int j = 0; j < 4; ++j) {
              unsigned dd;
              asm("v_pk_sub_u16 %0, %1, %2 clamp\n\tv_pk_min_u16 %0, %0, %3" : "=&v"(dd) : "v"(kp[it][j]), "v"(c2), "v"(0x00010001u));
              cnt2 += dd;
            }
          }
        }
        const int tot = (int)wave_sum_dpp((float)((cnt2 & 0xffffu) + (cnt2 >> 16)));
        if (tot >= 256) B = cand;
      }
      int cgt = 0;
#pragma unroll
      for (int it = 0; it < 8; ++it)
#pragma unroll
        for (int j = 0; j < 4; ++j) cgt += (((kp[it][j] & 0xffffu) > B) ? 1 : 0) + (((kp[it][j] >> 16) > B) ? 1 : 0);
      const int m = 256 - (int)wave_sum_dpp((float)cgt);
      DSA_MARKI(22);
      int base = 0, eqbase = 0;
#pragma unroll
      for (int it = 0; it < 8; ++it) {
        if (it < nit) {
          unsigned kk[8];
#pragma unroll
          for (int j = 0; j < 4; ++j) { kk[2 * j] = kp[it][j] & 0xffffu; kk[2 * j + 1] = kp[it][j] >> 16; }
          unsigned anyeq = 0u;
#pragma unroll
          for (int j = 0; j < 8; ++j) anyeq |= (kk[j] == B) ? 1u : 0u;
          int eqlow = 0, eqtot = 0;
          if (__builtin_amdgcn_ballot_w64(anyeq != 0u) != 0ull) {
#pragma unroll
            for (int j = 0; j < 8; ++j) {
              const unsigned long long mk = __builtin_amdgcn_ballot_w64(kk[j] == B);
              eqlow += (int)__builtin_amdgcn_mbcnt_hi((unsigned)(mk >> 32), __builtin_amdgcn_mbcnt_lo((unsigned)mk, 0u));
              eqtot += __builtin_popcountll(mk);
            }
          }
          int eqr = eqbase + eqlow;
          int ps = base, tot = 0;
          bool tk[8];
#pragma unroll
          for (int j = 0; j < 8; ++j) {
            const bool eq = kk[j] == B;
            tk[j] = (kk[j] > B) || (eq && eqr < m);
            eqr += eq ? 1 : 0;
          }
#pragma unroll
          for (int j = 0; j < 8; ++j) {
            const unsigned long long mk = __builtin_amdgcn_ballot_w64(tk[j]);
            ps += (int)__builtin_amdgcn_mbcnt_hi((unsigned)(mk >> 32), __builtin_amdgcn_mbcnt_lo((unsigned)mk, 0u));
            tot += __builtin_popcountll(mk);
          }
#pragma unroll
          for (int j = 0; j < 8; ++j) {
            if (tk[j]) { if (ps < 256) selq[ps] = (unsigned short)(512 * it + 8 * lane + j); ++ps; }
          }
          base += tot;
          eqbase += eqtot;
        }
      }
    }
  }
  DSA_MARK(3);
  __syncthreads();
  {
    DSA_IDS
    const int wave_b = wave;
    const float slope = (c < 8) ? exp2f(-(float)(c + 1)) : 0.f;
#pragma unroll 1
    for (int qq = 0; qq < 2; ++qq) {
      const int q = wave + 8 * qq, t = t0 + q;
      const int nsel = (t + 1 < 256) ? (t + 1) : 256, nch = (nsel + 31) >> 5;
      const LAS unsigned short* selq = sel + q * 256;
      bf16x8_t qf[8];
      {
        const int lq = tid_fresh() & 63;
        const bf16* qlp = QLh + q * 2048 + (lq & 7) * 256 + 8 * (lq >> 4);
#pragma unroll
        for (int ks = 0; ks < 8; ++ks) qf[ks] = *(const bf16x8_t*)(qlp + ks * 32);
      }
      float mrun = -1e30f, lrun = 0.f;
      f32x4 o[16];
#pragma unroll
      for (int nt = 0; nt < 16; ++nt) o[nt] = (f32x4){0.f, 0.f, 0.f, 0.f};
      u32x4_t st[16];
      f32x4 st_ss = (f32x4){0.f, 0.f, 0.f, 0.f}; float st_d = -1.f;
#define DSA_ISSUE(ch)                                                                                   \
      {          \
        _Pragma("unroll") for (int r = 0; r < 16; ++r) {                                                \
          const int idx = (int)selq[(ch) * 32 + 2 * r + (lane >> 5)];                                   \
          st[r] = *(const u32x4_t*)(CKV + (tokb + idx) * 256 + (lane & 31) * 8);                        \
        }                                                                                               \
        const int j2 = (ch) * 32 + (lane & 31);                                                         \
        const int idx2 = (int)selq[j2];                                                                 \
        st_ss = *(const f32x4*)(SSP + (tokb + idx2) * 4);                                               \
        st_d = (j2 < nsel) ? (float)(t - idx2) : -1.f;                                                  \
      }
      DSA_ISSUE(0);
#pragma unroll 1
      for (int ch = 0; ch < nch; ++ch) {
        const int lane = tid_fresh() & 63, g = lane >> 4, c = lane & 15;
        LAS unsigned char* buf = lds + DS_KEY16 + wave_b * DS_CHUNK;
        LAS float* kr = (LAS float*)(lds + DS_WAVE + wave_b * 1024);
        LAS float* kd = kr + 32;
        const unsigned vb = (unsigned)(uintptr_t)buf + (unsigned)((4 * g + (c >> 2)) * DS_RS + 8 * (c & 3));
#pragma unroll
        for (int r = 0; r < 16; ++r) *(LAS u32x4_t*)(buf + (2 * r + (lane >> 5)) * DS_RS + (lane & 31) * 16) = st[r];
        if (lane < 32) { kr[lane] = rsqrtf(((st_ss[0] + st_ss[1]) + (st_ss[2] + st_ss[3])) * (1.f / 256.f) + 1e-6f); kd[lane] = st_d; }
        wave_lds_fence();
        DSA_MARKI(11);
        DSA_ISSUE((ch + 1 < nch) ? ch + 1 : ch);
        f32x4 s0 = (f32x4){0.f, 0.f, 0.f, 0.f}, s1 = (f32x4){0.f, 0.f, 0.f, 0.f};
#pragma unroll
        for (int ks = 0; ks < 8; ++ks) {
          const bf16x8_t a0 = *(const LAS bf16x8_t*)(buf + c * DS_RS + (ks * 32 + 8 * g) * 2);
          const bf16x8_t a1 = *(const LAS bf16x8_t*)(buf + (16 + c) * DS_RS + (ks * 32 + 8 * g) * 2);
          s0 = __builtin_amdgcn_mfma_f32_16x16x32_bf16(a0, qf[ks], s0, 0, 0, 0);
          s1 = __builtin_amdgcn_mfma_f32_16x16x32_bf16(a1, qf[ks], s1, 0, 0, 0);
        }
        asm volatile("" :: "v"(s0[0]), "v"(s1[0]));
        DSA_MARKI(12);
        const f32x4 r0 = *(const LAS f32x4*)(kr + 4 * g), r1 = *(const LAS f32x4*)(kr + 16 + 4 * g);
        const f32x4 d0 = *(const LAS f32x4*)(kd + 4 * g), d1 = *(const LAS f32x4*)(kd + 16 + 4 * g);
        float x[8];
#pragma unroll
        for (int i = 0; i < 4; ++i) {
          x[i] = (d0[i] < 0.f) ? -1e30f : (s0[i] * r0[i] - slope * d0[i]);
          x[4 + i] = (d1[i] < 0.f) ? -1e30f : (s1[i] * r1[i] - slope * d1[i]);
        }
        float mx = fmaxf(fmaxf(fmaxf(x[0], x[1]), fmaxf(x[2], x[3])), fmaxf(fmaxf(x[4], x[5]), fmaxf(x[6], x[7])));
        mx = xrow_max(mx);
        const float mn = fmaxf(mrun, mx);
        const float alpha = __expf(mrun - mn);
        mrun = mn;
        float pr[8], ps = 0.f;
#pragma unroll
        for (int i = 0; i < 8; ++i) { pr[i] = (x[i] <= -1e29f) ? 0.f : __expf(x[i] - mn); ps += pr[i]; }
        ps = xrow_sum(ps);
        lrun = lrun * alpha + ps;
        if (__builtin_amdgcn_ballot_w64(alpha != 1.f) != 0ull) {
#pragma unroll
          for (int nt = 0; nt < 16; ++nt) o[nt] *= alpha;
        }
        union { bf16x8_t v; unsigned u[4]; } pf;
        pf.u[0] = pk2(pr[0] * r0[0], pr[1] * r0[1]); pf.u[1] = pk2(pr[2] * r0[2], pr[3] * r0[3]);
        pf.u[2] = pk2(pr[4] * r1[0], pr[5] * r1[1]); pf.u[3] = pk2(pr[6] * r1[2], pr[7] * r1[3]);
        asm volatile("" :: "v"(pf.u[0]));
        DSA_MARKI(13);
        {
          s16x4_t loA[4], hiA[4], loB[4], hiB[4];
#define PV_READ(L, H, nt0) _Pragma("unroll") for (int u = 0; u < 4; ++u) { L[u] = tr_read_b64(vb + ((nt0) + u) * 32); H[u] = tr_read_b64(vb + ((nt0) + u) * 32 + 16 * DS_RS); }
#define PV_MMA(L, H, nt0) _Pragma("unroll") for (int u = 0; u < 4; ++u) { \
            const bf16x8_t af = (bf16x8_t){L[u][0], L[u][1], L[u][2], L[u][3], H[u][0], H[u][1], H[u][2], H[u][3]}; \
            o[(nt0) + u] = __builtin_amdgcn_mfma_f32_16x16x32_bf16(af, pf.v, o[(nt0) + u], 0, 0, 0); }
          PV_READ(loA, hiA, 0);
          PV_READ(loB, hiB, 4);
          asm volatile("s_waitcnt lgkmcnt(8)" ::: "memory"); __builtin_amdgcn_sched_barrier(0);
          PV_MMA(loA, hiA, 0); __builtin_amdgcn_sched_barrier(0);
          PV_READ(loA, hiA, 8);
          asm volatile("s_waitcnt lgkmcnt(8)" ::: "memory"); __builtin_amdgcn_sched_barrier(0);
          PV_MMA(loB, hiB, 4); __builtin_amdgcn_sched_barrier(0);
          PV_READ(loB, hiB, 12);
          asm volatile("s_waitcnt lgkmcnt(8)" ::: "memory"); __builtin_amdgcn_sched_barrier(0);
          PV_MMA(loA, hiA, 8); __builtin_amdgcn_sched_barrier(0);
          asm volatile("s_waitcnt lgkmcnt(0)" ::: "memory"); __builtin_amdgcn_sched_barrier(0);
          PV_MMA(loB, hiB, 12);
#undef PV_READ
#undef PV_MMA
        }
        wave_lds_fence();
        asm volatile("" :: "v"(o[0][0]), "v"(o[15][0]));
        DSA_MARKI(14);
      }
#undef DSA_ISSUE
      if (c < 8) {
        const float inv = 1.f / lrun;
#pragma unroll
        for (int nt = 0; nt < 16; ++nt) {
          uint2 w; w.x = pk2(o[nt][0] * inv, o[nt][1] * inv); w.y = pk2(o[nt][2] * inv, o[nt][3] * inv);
          *(uint2*)(OLh + q * 2048 + c * 256 + nt * 16 + 4 * g) = w;
        }
      }
    }
  }
  DSA_MARK(4);
  __syncthreads();
  }
  {
    DSA_IDS
    const int h = wave;
    bf16x8_t of0[8], of1[8];
#pragma unroll
    for (int ks = 0; ks < 8; ++ks) {
      of0[ks] = *(const bf16x8_t*)(OL + c * 2048 + h * 256 + ks * 32 + 8 * g);
      of1[ks] = *(const bf16x8_t*)(OL + (16 + c) * 2048 + h * 256 + ks * 32 + 8 * g);
    }
#pragma unroll 1
    for (int np = 0; np < 2; ++np) {
      bf16x8_t wf[4][8];
#pragma unroll
      for (int n4 = 0; n4 < 4; ++n4)
#pragma unroll
        for (int ks = 0; ks < 8; ++ks) wf[n4][ks] = *(const bf16x8_t*)(WUV + (size_t)((h * 8 + np * 4 + n4) * 8 + ks) * 512 + lane * 8);
      __builtin_amdgcn_sched_barrier(0);
#pragma unroll
      for (int n4 = 0; n4 < 4; ++n4) {
        const int nt = np * 4 + n4;
        f32x4 a0 = (f32x4){0.f, 0.f, 0.f, 0.f}, a1 = a0;
#pragma unroll
        for (int ks = 0; ks < 8; ++ks) {
          a0 = __builtin_amdgcn_mfma_f32_16x16x32_bf16(wf[n4][ks], of0[ks], a0, 0, 0, 0);
          a1 = __builtin_amdgcn_mfma_f32_16x16x32_bf16(wf[n4][ks], of1[ks], a1, 0, 0, 0);
        }
        uint2 w; w.x = pk2(a0[0], a0[1]); w.y = pk2(a0[2], a0[3]);
        *(uint2*)(ODSA + (tok00 + c) * 1024 + h * 128 + nt * 16 + 4 * g) = w;
        w.x = pk2(a1[0], a1[1]); w.y = pk2(a1[2], a1[3]);
        *(uint2*)(ODSA + (tok00 + 16 + c) * 1024 + h * 128 + nt * 16 + 4 * g) = w;
      }
      __builtin_amdgcn_sched_barrier(0);
    }
  }
  DSA_MARK(5);
  __syncthreads();
}

#undef DSA_IDS
__device__ __forceinline__ void ph_dsa512(const P& p, unsigned char* lds_raw) {
  for (int it = blockIdx.x; it < TT / 16; it += gridDim.x) {
    const int k = it >> 8, j = it & 255;
    dsa_batch(p, lds_raw, k, ((k & 1) ? 255 - j : j) >> 1);
  }
}

#define GL_QD    0
#define GL_KI    18432
#define GL_KE    36864
#define GL_V     55296
#define GL_AT    90112
#define GL_GLOW  99328
#define GL_QT    103424
#define GL_DEC   105472
#define GL_SSQ   105984
#define GL_LB    108032
#define GL_TOTAL 140800

#define GLA_BAR() do { asm volatile("s_waitcnt lgkmcnt(0)" ::: "memory"); __builtin_amdgcn_s_barrier(); asm volatile("" ::: "memory"); } while (0)
#ifndef PROBE_GLA
#define PROBE_GLA 0
#endif
#if PROBE_GLA
#define GLA_MARK(k) do { const unsigned long long n_ = __builtin_amdgcn_s_memrealtime(); if (PROBE_GLA == (k)) { const unsigned long long q_ = n_ - tmark; \
    while (__builtin_amdgcn_s_memrealtime() - n_ < q_) __builtin_amdgcn_s_sleep(2); } tmark = __builtin_amdgcn_s_memrealtime(); } while (0)
#else
#define GLA_MARK(k) do {} while (0)
#endif
__device__ __forceinline__ void gla_item(const P& p, unsigned char* lds_raw, int item) {
  int tid = tid_fresh();
  const int b = item >> 2, h = item & 3;
  const size_t tokb = (size_t)b * SEQ;
  const bf16* Qg = (const bf16*)(p.ws + OFF_Q);
  const bf16* Kg = (const bf16*)(p.ws + OFF_K);
  bf16* Vg = (bf16*)(p.ws + OFF_V);
  const float* GLOWg = (const float*)(p.ws + OFF_GLOW);
  const bf16* SGR = (const bf16*)(p.ws + OFF_SGR);
  LAS unsigned char* lds = (LAS unsigned char*)lds_raw;
  const unsigned lds0 = (unsigned)(uintptr_t)lds;
  LAS float* QT = (LAS float*)(lds + GL_QT);
  LAS float* DEC = (LAS float*)(lds + GL_DEC);
  LAS float* SSQ = (LAS float*)(lds + GL_SSQ);
  float wg[16];
  const float* prm = (const float*)(p.ws + OFF_PRM);
#pragma unroll
  for (int r = 0; r < 16; ++r) wg[r] = prm[PRM_WGU + r * 512 + h * 128 + (tid & 127)];
  const float bg = prm[PRM_BG + h * 128 + (tid & 127)];
  const float gn0 = prm[PRM_GNG + h * 256 + 32 * (tid >> 6) + (tid & 15)], gn1 = prm[PRM_GNG + h * 256 + 32 * (tid >> 6) + 16 + (tid & 15)];
  u32x4_t rq[2], rk[2], rv[4], rg = (u32x4_t){0u, 0u, 0u, 0u};
#define GLA_LOAD(ch)                                                                                      \
  {                                                                                                       \
    const size_t tb = tokb + (size_t)(ch) * 64;                                                           \
    _Pragma("unroll") for (int i = 0; i < 2; ++i) {                                                       \
      const int id = tid + 512 * i, tk = id >> 4, part = id & 15;                                         \
      rq[i] = *(const u32x4_t*)(Qg + (tb + tk) * 512 + h * 128 + part * 8);                               \
      rk[i] = *(const u32x4_t*)(Kg + (tb + tk) * 512 + h * 128 + part * 8);                               \
    }                                                                                                     \
    _Pragma("unroll") for (int i = 0; i < 4; ++i) {                                                       \
      const int id = tid + 512 * i, tk = id >> 5, part = id & 31;                                         \
      rv[i] = *(const u32x4_t*)(Vg + (tb + tk) * 1024 + h * 256 + part * 8);                              \
    }                                                                                                     \
    if (tid < 256) rg = *(const u32x4_t*)(GLOWg + (tb + (tid >> 2)) * 16 + (tid & 3) * 4);                \
  }
  f32x4 S[8][2];
#pragma unroll
  for (int a = 0; a < 8; ++a) { S[a][0] = (f32x4){0.f, 0.f, 0.f, 0.f}; S[a][1] = (f32x4){0.f, 0.f, 0.f, 0.f}; }
  GLA_LOAD(0);
#if PROBE_GLA
  unsigned long long tmark = __builtin_amdgcn_s_memrealtime();
#endif
#pragma unroll 1
  for (int ch = 0; ch < SEQ / 64; ++ch) {
    asm volatile("" : "+v"(tid));
    const int wave = __builtin_amdgcn_readfirstlane(tid >> 6), lane = tid & 63, g = lane >> 4, c = lane & 15;
    const int d = tid & 127, tq = __builtin_amdgcn_readfirstlane(tid >> 7);
    const unsigned vtr = lds0 + GL_V + (unsigned)((8 * g + (c >> 2)) * 544 + (32 * wave + 4 * (c & 3)) * 2);
    const unsigned ketr = lds0 + GL_KE + (unsigned)((8 * g + (c >> 2)) * 288 + (4 * (c & 3)) * 2);
    const size_t tb = tokb + (size_t)ch * 64;
#pragma unroll
    for (int i = 0; i < 2; ++i) {
      const int id = tid + 512 * i, tk = id >> 4, part = id & 15;
      *(LAS u32x4_t*)(lds + GL_QD + tk * 288 + part * 16) = rq[i];
      *(LAS u32x4_t*)(lds + GL_KI + tk * 288 + part * 16) = rk[i];
    }
#pragma unroll
    for (int i = 0; i < 4; ++i) {
      const int id = tid + 512 * i, tk = id >> 5, part = id & 31;
      *(LAS u32x4_t*)(lds + GL_V + tk * 544 + part * 16) = rv[i];
    }
    if (tid < 256) *(LAS u32x4_t*)(lds + GL_GLOW + (tid >> 2) * 64 + (tid & 3) * 16) = rg;
    GLA_MARK(1); GLA_BAR();
    GLA_LOAD((ch + 1 < SEQ / 64) ? ch + 1 : ch);
    u32x4_t rs[4];
#pragma unroll
    for (int i = 0; i < 4; ++i) {
      const int id = tid + 512 * i, tk = id >> 5, part = id & 31;
      rs[i] = *(const u32x4_t*)(SGR + (tb + tk) * 1024 + h * 256 + part * 8);
    }
    LAS float* LB = (LAS float*)(lds + GL_LB);
    float run = 0.f;
#pragma unroll 2
    for (int i = 0; i < 16; ++i) {
      const LAS f32x4* gp = (const LAS f32x4*)(lds + GL_GLOW + (16 * tq + i) * 64);
      const f32x4 g0 = gp[0], g1 = gp[1], g2 = gp[2], g3 = gp[3];
      float gl = bg;
      gl += g0[0] * wg[0] + g0[1] * wg[1] + g0[2] * wg[2] + g0[3] * wg[3];
      gl += g1[0] * wg[4] + g1[1] * wg[5] + g1[2] * wg[6] + g1[3] * wg[7];
      gl += g2[0] * wg[8] + g2[1] * wg[9] + g2[2] * wg[10] + g2[3] * wg[11];
      gl += g3[0] * wg[12] + g3[1] * wg[13] + g3[2] * wg[14] + g3[3] * wg[15];
      const float ls = fminf(gl, 0.f) - __logf(1.f + __expf(-fabsf(gl)));
      run += ls * (1.f / 16.f);
      LB[(16 * tq + i) * 128 + d] = run;
    }
    QT[tq * 128 + d] = run;
    GLA_MARK(2); GLA_BAR();
    {
      float off = 0.f, tot = 0.f;
#pragma unroll
      for (int k = 0; k < 4; ++k) { const float v = QT[k * 128 + d]; tot += v; off += (k < tq) ? v : 0.f; }
      const float eb = __expf(tot);
#pragma unroll 2
      for (int i = 0; i < 16; ++i) {
        const int t = 16 * tq + i;
        const float bb = LB[t * 128 + d] + off;
        const float e = __expf(bb), r = __expf(-bb);
        LAS bf16* qp = (LAS bf16*)(lds + GL_QD + t * 288) + d;
        LAS bf16* kp = (LAS bf16*)(lds + GL_KI + t * 288) + d;
        LAS bf16* ep = (LAS bf16*)(lds + GL_KE + t * 288) + d;
        const float q = bf2f(*qp), k = bf2f(*kp);
        *qp = f2bf(q * e);
        *kp = f2bf(k * r);
        *ep = f2bf(k * (eb * r));
      }
      if (tq == 0) DEC[d] = eb;
    }
    GLA_MARK(3); GLA_BAR();
    {
      const int ti = wave >> 1;
#pragma unroll
      for (int u = 0; u < 2; ++u) {
        const int tj = 2 * (wave & 1) + u;
        f32x4 acc = (f32x4){0.f, 0.f, 0.f, 0.f};
        if (tj <= ti) {
#pragma unroll
          for (int ks = 0; ks < 4; ++ks) {
            const bf16x8_t a = *(const LAS bf16x8_t*)(lds + GL_QD + (16 * ti + c) * 288 + (32 * ks + 8 * g) * 2);
            const bf16x8_t bb = *(const LAS bf16x8_t*)(lds + GL_KI + (16 * tj + c) * 288 + (32 * ks + 8 * g) * 2);
            acc = __builtin_amdgcn_mfma_f32_16x16x32_bf16(a, bb, acc, 0, 0, 0);
          }
        }
#pragma unroll
        for (int r = 0; r < 4; ++r) {
          const int i = 16 * ti + 4 * g + r, j = 16 * tj + c;
          *((LAS bf16*)(lds + GL_AT + i * 144) + j) = f2bf((j <= i) ? acc[r] : 0.f);
        }
      }
    }
    GLA_MARK(4); GLA_BAR();
    f32x4 o[4][2];
    {
      bf16x8_t vf[2][2];
      {
        s16x4_t lo[4], hi[4];
#pragma unroll
        for (int ks = 0; ks < 2; ++ks)
#pragma unroll
          for (int tn = 0; tn < 2; ++tn) {
            lo[ks * 2 + tn] = tr_read_b64(vtr + (32 * ks) * 544 + tn * 32);
            hi[ks * 2 + tn] = tr_read_b64(vtr + (32 * ks + 4) * 544 + tn * 32);
          }
        asm volatile("s_waitcnt lgkmcnt(0)" ::: "memory");
        __builtin_amdgcn_sched_barrier(0);
#pragma unroll
        for (int u = 0; u < 4; ++u)
          vf[u >> 1][u & 1] = (bf16x8_t){lo[u][0], lo[u][1], lo[u][2], lo[u][3], hi[u][0], hi[u][1], hi[u][2], hi[u][3]};
      }
#pragma unroll
      for (int tm = 0; tm < 4; ++tm) { o[tm][0] = (f32x4){0.f, 0.f, 0.f, 0.f}; o[tm][1] = (f32x4){0.f, 0.f, 0.f, 0.f}; }
#pragma unroll
      for (int tm = 0; tm < 4; ++tm)
#pragma unroll
        for (int ks = 0; ks < 2; ++ks) {
          if (ks == 1 && tm < 2) continue;
          const bf16x8_t a = *(const LAS bf16x8_t*)(lds + GL_AT + (16 * tm + c) * 144 + (32 * ks + 8 * g) * 2);
          o[tm][0] = __builtin_amdgcn_mfma_f32_16x16x32_bf16(a, vf[ks][0], o[tm][0], 0, 0, 0);
          o[tm][1] = __builtin_amdgcn_mfma_f32_16x16x32_bf16(a, vf[ks][1], o[tm][1], 0, 0, 0);
          __builtin_amdgcn_sched_barrier(0);
        }
#pragma unroll
      for (int u = 0; u < 4; ++u) {
        union { bf16x8_t v; unsigned w[4]; } s0, s1;
        s0.w[0] = pk2(S[2 * u][0][0], S[2 * u][0][1]); s0.w[1] = pk2(S[2 * u][0][2], S[2 * u][0][3]);
        s0.w[2] = pk2(S[2 * u + 1][0][0], S[2 * u + 1][0][1]); s0.w[3] = pk2(S[2 * u + 1][0][2], S[2 * u + 1][0][3]);
        s1.w[0] = pk2(S[2 * u][1][0], S[2 * u][1][1]); s1.w[1] = pk2(S[2 * u][1][2], S[2 * u][1][3]);
        s1.w[2] = pk2(S[2 * u + 1][1][0], S[2 * u + 1][1][1]); s1.w[3] = pk2(S[2 * u + 1][1][2], S[2 * u + 1][1][3]);
#pragma unroll
        for (int tm = 0; tm < 4; ++tm) {
          const LAS unsigned char* qrow = lds + GL_QD + (16 * tm + c) * 288 + (32 * u + 4 * g) * 2;
          const s16x4_t q0 = *(const LAS s16x4_t*)qrow, q1 = *(const LAS s16x4_t*)(qrow + 32);
          const bf16x8_t a = (bf16x8_t){q0[0], q0[1], q0[2], q0[3], q1[0], q1[1], q1[2], q1[3]};
          o[tm][0] = __builtin_amdgcn_mfma_f32_16x16x32_bf16(a, s0.v, o[tm][0], 0, 0, 0);
          o[tm][1] = __builtin_amdgcn_mfma_f32_16x16x32_bf16(a, s1.v, o[tm][1], 0, 0, 0);
        }
        __builtin_amdgcn_sched_barrier(0);
      }
#pragma unroll
      for (int tk = 0; tk < 8; ++tk) {
        const f32x4 dec4 = *(const LAS f32x4*)(DEC + 16 * tk + 4 * g);
        S[tk][0] *= dec4; S[tk][1] *= dec4;
        s16x4_t lo0 = tr_read_b64(ketr + tk * 32), hi0 = tr_read_b64(ketr + 4 * 288 + tk * 32);
        s16x4_t lo1 = tr_read_b64(ketr + 32 * 288 + tk * 32), hi1 = tr_read_b64(ketr + 36 * 288 + tk * 32);
        asm volatile("s_waitcnt lgkmcnt(0)" ::: "memory");
        __builtin_amdgcn_sched_barrier(0);
        const bf16x8_t a0 = (bf16x8_t){lo0[0], lo0[1], lo0[2], lo0[3], hi0[0], hi0[1], hi0[2], hi0[3]};
        const bf16x8_t a1 = (bf16x8_t){lo1[0], lo1[1], lo1[2], lo1[3], hi1[0], hi1[1], hi1[2], hi1[3]};
        S[tk][0] = __builtin_amdgcn_mfma_f32_16x16x32_bf16(a0, vf[0][0], S[tk][0], 0, 0, 0);
        S[tk][1] = __builtin_amdgcn_mfma_f32_16x16x32_bf16(a0, vf[0][1], S[tk][1], 0, 0, 0);
        S[tk][0] = __builtin_amdgcn_mfma_f32_16x16x32_bf16(a1, vf[1][0], S[tk][0], 0, 0, 0);
        S[tk][1] = __builtin_amdgcn_mfma_f32_16x16x32_bf16(a1, vf[1][1], S[tk][1], 0, 0, 0);
        __builtin_amdgcn_sched_barrier(0);
      }
#pragma unroll
      for (int tm = 0; tm < 4; ++tm)
#pragma unroll
        for (int r = 0; r < 4; ++r) {
          float ss = o[tm][0][r] * o[tm][0][r] + o[tm][1][r] * o[tm][1][r];
          ss = row16_sum(ss);
          if (c == 0) SSQ[(16 * tm + 4 * g + r) * 8 + wave] = ss;
        }
    }
    GLA_MARK(5); GLA_BAR();
    {
      LAS bf16* OB = (LAS bf16*)(lds + GL_LB);
#pragma unroll
      for (int tm = 0; tm < 4; ++tm)
#pragma unroll
        for (int r = 0; r < 4; ++r) {
          const int t = 16 * tm + 4 * g + r;
          const f32x4 p0 = *(const LAS f32x4*)(SSQ + t * 8), p1 = *(const LAS f32x4*)(SSQ + t * 8 + 4);
          const float tot = ((p0[0] + p0[1]) + (p0[2] + p0[3])) + ((p1[0] + p1[1]) + (p1[2] + p1[3]));
          const float rstd = rsqrtf(tot * (1.f / 256.f) + 1e-6f);
          OB[t * 256 + 32 * wave + c] = f2bf(o[tm][0][r] * rstd * gn0);
          OB[t * 256 + 32 * wave + 16 + c] = f2bf(o[tm][1][r] * rstd * gn1);
        }
    }
    GLA_MARK(6); GLA_BAR();
#pragma unroll
    for (int i = 0; i < 4; ++i) {
      const int id = tid + 512 * i, tk = id >> 5, part = id & 31;
      const u32x4_t ov = *(const LAS u32x4_t*)(lds + GL_LB + tk * 512 + part * 16);
      const u32x4_t sv = rs[i];
      u32x4_t gv;
      gv[0] = pk2(bflo(ov[0]) * bflo(sv[0]), bfhi(ov[0]) * bfhi(sv[0]));
      gv[1] = pk2(bflo(ov[1]) * bflo(sv[1]), bfhi(ov[1]) * bfhi(sv[1]));
      gv[2] = pk2(bflo(ov[2]) * bflo(sv[2]), bfhi(ov[2]) * bfhi(sv[2]));
      gv[3] = pk2(bflo(ov[3]) * bflo(sv[3]), bfhi(ov[3]) * bfhi(sv[3]));
      *(u32x4_t*)(Vg + (tb + tk) * 1024 + h * 256 + part * 8) = gv;
    }
    GLA_MARK(7);
  }
#undef GLA_LOAD
  __syncthreads();
}

#define LDS_BYTES 155712
#define OFF_XBAR (224ull * 1024)
#define OFF_CTR (200ull * 1024)

__device__ __forceinline__ unsigned xcc_id() { return (unsigned)__builtin_amdgcn_s_getreg((3 << 11) | 20) & 0x7u; }
__device__ __forceinline__ void ph_mixer(const P& p, unsigned char* lds_raw, bool do_gla) {
  if (do_gla && blockIdx.x < 32) { gla_item(p, lds_raw, blockIdx.x); if (blockIdx.x == 0) TS_SET(p, 20); }
  unsigned* ctr = (unsigned*)(p.ws + OFF_CTR);
  LAS unsigned* slot = (LAS unsigned*)((LAS unsigned char*)lds_raw + DS_TOTAL);
  const unsigned home = xcc_id();
  unsigned k = 0;
  for (;;) {
    if (tid_fresh() == 0) {
      unsigned qi = 0xffffffffu;
      while (k < 8) {
        const unsigned b = (home + k) & 7u;
        const unsigned v = __hip_atomic_fetch_add(ctr + 64 * b, 1u, __ATOMIC_RELAXED, __HIP_MEMORY_SCOPE_AGENT);
        if (v < 128u) { qi = (b << 8) | v; break; }
        ++k;
      }
      slot[0] = qi; slot[1] = k;
    }
    __syncthreads();
    const unsigned qi = slot[0];
    k = slot[1];
    __syncthreads();
    if (qi == 0xffffffffu) break;
    dsa_batch(p, lds_raw, (int)(qi >> 8), 127 - (int)(qi & 255u));
  }
}

__global__ void __launch_bounds__(512, 2) mega(P p) {
  extern __shared__ __attribute__((aligned(16))) unsigned char lds_raw[];
  LAS unsigned char* lds = (LAS unsigned char*)lds_raw;
  cg::grid_group grid = cg::this_grid();
  char* ws = p.ws;
  const int bid = blockIdx.x, nb = gridDim.x;
  if (bid == 0 && threadIdx.x < 8) *(unsigned*)(ws + OFF_CTR + 256 * threadIdx.x) = 0u;
  if (bid == 0) { for (int i = threadIdx.x; i < XCD_BAR_WORDS; i += 512) ((unsigned*)(ws + OFF_XBAR))[i] = 0u; }
  volatile LAS unsigned* xst = (volatile LAS unsigned*)(lds + DS_TOTAL + 16);
  if (threadIdx.x < 4) xst[threadIdx.x] = 0u;
#if PROBE_TS
  { const int t_ = tid_fresh(); if (bid == 0 && t_ < 64) ((unsigned long long*)(ws + OFF_TS))[t_] = 0ull; }
  __syncthreads();
  if (bid == 0) TS_SET(p, 0);
#endif
  ph_prep(p, (float*)lds_raw);
  grid.sync();
  const XcdBarrier xb = xcd_barrier_post((unsigned*)(ws + OFF_XBAR), xst);
  if (bid == 0) TS_SET(p, 1);
  ph_mod<false>(p, p.x, p.norm1_g, 0, 1024, (bf16*)(ws + OFF_H), bid, nb);
  xcd_barrier(xb);
  if (bid == 0) TS_SET(p, 2);
  gemm_run(lds, (const bf16*)(ws + OFF_H), (const bf16*)(ws + OFF_WT_IN), TT, 7168, 1024, EpiIn{ws, p.out});
  xcd_barrier(xb);
  if (bid == 0) TS_SET(p, 3);
  ph_mixer(p, lds_raw, true);
  if (bid == 0) TS_SET(p, 21);
  xcd_barrier(xb);
  if (bid == 0) TS_SET(p, 4);
  gemm_run(lds, (const bf16*)(ws + OFF_V), (const bf16*)(ws + OFF_WT_A), TT, 1024, 1024,
           EpiMix<false>{(const bf16*)p.out, (bf16*)(ws + OFF_MIX)});
  gemm_run(lds, (const bf16*)(ws + OFF_ODSA), (const bf16*)(ws + OFF_WT_B), TT, 1024, 1024,
           EpiMix<true>{(const bf16*)p.out + (size_t)TT * 1024, (bf16*)(ws + OFF_MIX)});
  xcd_barrier(xb);
  if (bid == 0) TS_SET(p, 5);
  gemm_run(lds, (const bf16*)(ws + OFF_MIX), (const bf16*)(ws + OFF_WT_OUT), TT, 1024, 1024,
           EpiX1{p.x, (const float*)(ws + OFF_ADA), (bf16*)(ws + OFF_X1)});
  xcd_barrier(xb);
  if (bid == 0) TS_SET(p, 6);
  ph_mod<true>(p, ws + OFF_X1, (const float*)(ws + OFF_PRM) + PRM_N2G, 3072, 4096, (bf16*)(ws + OFF_H), bid, nb);
  xcd_barrier(xb);
  if (bid == 0) TS_SET(p, 7);
  gemm_run(lds, (const bf16*)(ws + OFF_H), (const bf16*)(ws + OFF_WT_Q), TT, 2048, 1024, EpiPlain{(bf16*)(ws + OFF_PQ), 2048});
  xcd_barrier(xb);
  if (bid == 0) TS_SET(p, 8);
  ph_peer512(p, lds_raw, p.out);
#if PROBE_TS
  if (bid == 0) TS_SET(p, 18);
  xcd_barrier(xb);
  {
    const unsigned long long* T = (const unsigned long long*)(ws + OFF_TS);
    const unsigned long long q = (unsigned long long)(PROBE_Q), t0 = __builtin_amdgcn_s_memrealtime();
    while (__builtin_amdgcn_s_memrealtime() - t0 < q) __builtin_amdgcn_s_sleep(8);
  }
#endif
}

extern "C" void kernel_launch(void* const* d_in, const int* in_sizes, int n_in, void* d_out, int out_size, void* d_ws,
                              size_t ws_size, hipStream_t stream) {
  P p{};
  const float** f = (const float**)&p;
  for (int i = 0; i < 22; ++i) f[i] = (const float*)d_in[i];
  p.out = (float*)d_out;
  p.ws = (char*)d_ws;
  if (ws_size < WS_NEED) { fprintf(stderr, "workspace too small: %zu\n", ws_size); return; }
  static int grid_blocks = 0;
  if (!grid_blocks) {
    int dev = 0, cus = 0, per_cu = 0;
    (void)hipGetDevice(&dev);
    (void)hipDeviceGetAttribute(&cus, hipDeviceAttributeMultiprocessorCount, dev);
    if (hipFuncSetAttribute((const void*)mega, hipFuncAttributeMaxDynamicSharedMemorySize, LDS_BYTES) != hipSuccess) {
      fprintf(stderr, "hipFuncSetAttribute failed\n"); grid_blocks = -1; return;
    }
    if (hipOccupancyMaxActiveBlocksPerMultiprocessor(&per_cu, (const void*)mega, 512, LDS_BYTES) != hipSuccess || per_cu < 1) {
      fprintf(stderr, "occupancy query failed\n"); grid_blocks = -1; return;
    }
    grid_blocks = cus;
  }
  if (grid_blocks <= 0) return;
  void* args[] = {&p};
  hipError_t e = hipLaunchCooperativeKernel((void*)mega, dim3(grid_blocks), dim3(512), args, LDS_BYTES, stream);
  if (e != hipSuccess) fprintf(stderr, "cooperative launch failed: %s (grid %d)\n", hipGetErrorString(e), grid_blocks);
}
```

```cpp
#include <hip/hip_runtime.h>
#include <hip/hip_cooperative_groups.h>
#include <cstdio>
#include <cstdint>
namespace cg = cooperative_groups;

#define TT 32768
#define SEQ 4096
#define DM 1024
#define NIN 7000
typedef unsigned short bf16;
#define LAS __attribute__((address_space(3)))

struct P {
  const float *x, *c, *w_ada, *b_ada, *norm1_g, *w_in, *w_gate_up, *b_gate, *gla_norm_g, *kv_norm_g,
      *w_uk, *w_uv, *w_a, *w_b, *w_out, *norm2_g, *w_q, *sk1, *sk2, *peer_u, *peer_v, *final_g;
  float* out;
  char* ws;
};

#define MB (1ull << 20)
#define OFF_ADA   (0ull)
#define OFF_H     (1 * MB)
#define OFF_ODSA  (1 * MB)
#define OFF_Q     (65 * MB)
#define OFF_K     (97 * MB)
#define OFF_MIX   (65 * MB)
#define OFF_V     (129 * MB)
#define OFF_DQ    (193 * MB)
#define OFF_PQ    (193 * MB)
#define OFF_DSCR  (257 * MB)
#define OFF_SSP   (256ull * 1024)
#define OFF_CKV   (289 * MB)
#define OFF_IQ    (305 * MB)
#define OFF_IK    (337 * MB)
#define OFF_IW    (341 * MB)
#define OFF_GLOW  (342 * MB)
#define OFF_SGR   (344 * MB)
#define OFF_X1    (344 * MB)
#define OFF_WT    (408 * MB)
#define OFF_WT_IN  (OFF_WT)
#define OFF_WT_A   (OFF_WT + 7168ull * 2048)
#define OFF_WT_B   (OFF_WT_A + 1024ull * 2048)
#define OFF_WT_OUT (OFF_WT_B + 1024ull * 2048)
#define OFF_WT_Q   (OFF_WT_OUT + 1024ull * 2048)
#define OFF_PU    (432 * MB)
#define OFF_PV    (464 * MB)
#define OFF_SK    (496 * MB)
#define OFF_PSC   (496 * MB + 128 * 1024)
#define OFF_WUK   (497 * MB)
#define OFF_WUV   (497 * MB + 512 * 1024)
#define WS_NEED   (498 * MB)

typedef __bf16 bf16n2_t __attribute__((ext_vector_type(2)));
typedef float f32n2_t __attribute__((ext_vector_type(2)));
__device__ __forceinline__ bf16 f2bf(float f) { return __builtin_bit_cast(unsigned short, (__bf16)f); }
__device__ __forceinline__ unsigned pk2(float lo, float hi) { const f32n2_t v = {lo, hi}; return __builtin_bit_cast(unsigned, __builtin_convertvector(v, bf16n2_t)); }
__device__ __forceinline__ float bf2f(bf16 h) { return __uint_as_float(((unsigned)h) << 16); }
__device__ __forceinline__ float bflo(unsigned u) { return __uint_as_float(u << 16); }
__device__ __forceinline__ float bfhi(unsigned u) { return __uint_as_float(u & 0xffff0000u); }
__device__ __forceinline__ float wave_sum(float v) {
#pragma unroll
  for (int o = 32; o > 0; o >>= 1) v += __shfl_xor(v, o);
  return v;
}
__device__ __forceinline__ float wave_max(float v) {
#pragma unroll
  for (int o = 32; o > 0; o >>= 1) v = fmaxf(v, __shfl_xor(v, o));
  return v;
}
#ifndef PROBE_TS
#define PROBE_TS 0
#endif
#define OFF_PRM (800ull * 1024)
#define PRM_WGU   0
#define PRM_BG    8192
#define PRM_GNG   8704
#define PRM_N2G   9728
#define PRM_FG    10752
#define PRM_TOTAL 11776
#define OFF_TS (208ull * 1024)
#if PROBE_TS
#define TS_SET(p, k) do { if (tid_fresh() == 0) ((unsigned long long*)((p).ws + OFF_TS))[k] = __builtin_amdgcn_s_memrealtime(); } while (0)
#define TS_ADD(p, k, t0) do { if (tid_fresh() == 0) ((unsigned long long*)((p).ws + OFF_TS))[k] += __builtin_amdgcn_s_memrealtime() - (t0); } while (0)
#define TS_NOW() __builtin_amdgcn_s_memrealtime()
#else
#define TS_SET(p, k) do {} while (0)
#define TS_ADD(p, k, t0) do {} while (0)
#define TS_NOW() 0ull
#endif
#define LDS_BAR() do { asm volatile("s_waitcnt lgkmcnt(0)" ::: "memory"); __builtin_amdgcn_s_barrier(); asm volatile("" ::: "memory"); } while (0)
__device__ __forceinline__ int tid_fresh() { int t = threadIdx.x; asm volatile("" : "+v"(t)); return t; }
__device__ __forceinline__ float sigmoidf_(float v) { return __builtin_amdgcn_rcpf(1.f + __expf(-v)); }
__device__ __forceinline__ float siluf_(float v) { return v * __builtin_amdgcn_rcpf(1.f + __expf(-v)); }

#include <hip/hip_runtime.h>
namespace pg8 {
#define PG8_LAS __attribute__((address_space(3)))
typedef unsigned short bf16_t;
typedef short bf16x8 __attribute__((ext_vector_type(8)));
typedef float f32x4 __attribute__((ext_vector_type(4)));
typedef unsigned u32x4 __attribute__((ext_vector_type(4)));
constexpr int BM = 256, BK = 64, HALF = 128, HTB = HALF * BK * 2  , STAGE_BYTES = 8 * HTB, NXCD = 8, WGM = 8;

__host__ __device__ __forceinline__ int lds_byte(int r, int c) { const int st = (r >> 4) * 2 + (c >> 5), rr = r & 15, cc = c & 31, ob = rr * 64 + cc * 2; return st * 1024 + (ob ^ (((ob >> 9) & 1) << 5)); }
__host__ __device__ __forceinline__ void stage_rc(int b, int& R, int& C) { const int st = b / 1024, sb = b % 1024, swz = sb ^ (((sb >> 9) & 1) << 5); R = (st >> 1) * 16 + swz / 64; C = (st & 1) * 32 + (swz % 64) / 2; }
__host__ __device__ __forceinline__ int perm32(int rho) { const int n = rho >> 4, i = rho & 15; return 8 * (i >> 2) + 4 * n + (i & 3); }

struct Unit { int pm, pn; };
struct Gemm { const bf16_t* A; const bf16_t* Bt; int M, N, K;
              const bf16_t* A2; const bf16_t* Bt2; int ld; };

struct StaticOrder {
    int nM, nN, nwg, G, c;
    __host__ __device__ void init(int M, int N, int G_, int c_) { nM = M / BM; nN = N / BM; nwg = nM * nN; G = G_; c = c_; }
    __host__ __device__ bool next(int i, Unit& u) const {
        const long L = (long)i * G + c; if (L >= nwg) return false;
        int wgid = (int)L; { const int q = nwg / NXCD, r = nwg % NXCD, xcd = wgid % NXCD, off = wgid / NXCD; wgid = (xcd < r ? xcd * (q + 1) : r * (q + 1) + (xcd - r) * q) + off; }
        const int nig = WGM * nN, gid = wgid / nig, fm = gid * WGM, gsz = (nM - fm) < WGM ? (nM - fm) : WGM;
        u.pm = fm + ((wgid % nig) % gsz); u.pn = (wgid % nig) / gsz; return true;
    }
    __device__ __forceinline__ void a_ready(const Unit&) const {}
    __device__ __forceinline__ void done(const Unit&) const {}
};
__device__ __forceinline__ unsigned cvt_pk_bf16(float lo, float hi) { unsigned r; asm volatile("v_cvt_pk_bf16_f32 %0, %1, %2" : "=v"(r) : "v"(lo), "v"(hi)); return r; }

template <class Epi, class Sched, bool STAMP = false>
__device__ __forceinline__ void gemm_phase(PG8_LAS unsigned char* lds, const Gemm g, const Sched& S, const Epi& E, unsigned long long* stamps) {
    const int tid = ::tid_fresh(), wid = __builtin_amdgcn_readfirstlane(tid >> 6), lane = tid & 63, wr = wid >> 2, wc = wid & 3, fr = lane & 15, fq = lane >> 4;
    const int K = g.K, nt = K / BK, ld = g.ld;
    const int nth = Epi::SPLITK ? nt / 2 : nt;
    int ts_lo = 0, ts_hi = 0, nts = 0; const unsigned long long rt_entry = STAMP ? (unsigned long long)wall_clock64() : 0ull;
#define PG8_STAMP() do { if (STAMP && wid == 0 && nts < 64) { const unsigned long long _c = (unsigned long long)clock64(); \
        ts_lo = (lane == nts) ? (int)(unsigned)_c : ts_lo; ts_hi = (lane == nts) ? (int)(unsigned)(_c >> 32) : ts_hi; ++nts; } } while (0)
    PG8_STAMP();
    unsigned voffA[2], voffB[2];
#pragma unroll
    for (int i = 0; i < 2; ++i) { int R, C; stage_rc(tid * 16 + i * 8192, R, C); const int Rb = Epi::PERM ? ((R & ~31) + perm32(R & 31)) : R;
        voffA[i] = (unsigned)(R * ld + C) * 2u; voffB[i] = (unsigned)(Rb * ld + C) * 2u; }
    const size_t kstep = (size_t)(BK * 2);
    const size_t hstep = (size_t)HALF * ld * 2;
    const size_t tstep = 2 * hstep;
    const unsigned ldsw = (unsigned)wid * 1024u;
    const int aoff = lds_byte(wr * 64 + fr, fq * 8), boff = lds_byte(wc * 32 + fr, fq * 8);
#define PG8_SA(b, h) (((b) * 2 + (h)) * HTB)
#define PG8_SB(b, h) ((4 + (b) * 2 + (h)) * HTB)
#define PG8_STAGE(bufoff, gbase, voff) do { _Pragma("unroll") for (int _i = 0; _i < 2; ++_i) \
        __builtin_amdgcn_global_load_lds((const unsigned*)((const char*)(gbase) + (voff)[_i]), (PG8_LAS unsigned*)(lds + (bufoff) + ldsw + _i * 8192), 16, 0, 0); } while (0)
#define PG8_LDA(dst, b, h) do { _Pragma("unroll") for (int m = 0; m < 4; ++m) _Pragma("unroll") for (int k = 0; k < 2; ++k) dst[m][k] = *(const PG8_LAS bf16x8*)(lds + PG8_SA(b, h) + aoff + m * 2048 + k * 1024); } while (0)
#define PG8_LDB(dst, b, h) do { _Pragma("unroll") for (int n = 0; n < 2; ++n) _Pragma("unroll") for (int k = 0; k < 2; ++k) dst[n][k] = *(const PG8_LAS bf16x8*)(lds + PG8_SB(b, h) + boff + n * 2048 + k * 1024); } while (0)
#define PG8_MMA(ai, bj, At, Bt) do { __builtin_amdgcn_s_setprio(1); _Pragma("unroll") for (int m = 0; m < 4; ++m) _Pragma("unroll") for (int n = 0; n < 2; ++n) _Pragma("unroll") for (int k = 0; k < 2; ++k) \
        acc[ai][bj][m][n] = __builtin_amdgcn_mfma_f32_16x16x32_bf16(Bt[n][k], At[m][k], acc[ai][bj][m][n], 0, 0, 0); __builtin_amdgcn_s_setprio(0); } while (0)
#define PG8_WAIT_V(n) asm volatile("s_waitcnt vmcnt(" #n ")" ::: "memory")
#define PG8_WAIT_L(n) asm volatile("s_waitcnt lgkmcnt(" #n ")" ::: "memory")
#define PG8_BAR __builtin_amdgcn_s_barrier()
#define PG8_SCHED __builtin_amdgcn_sched_barrier(0)
    Unit cur, nxt; int ui = 0;
    if (!S.next(0, cur)) return;
    f32x4 acc[2][2][4][2];
#pragma unroll
    for (int a = 0; a < 2; ++a)
#pragma unroll
        for (int b = 0; b < 2; ++b)
#pragma unroll
            for (int m = 0; m < 4; ++m)
#pragma unroll
                for (int n = 0; n < 2; ++n) acc[a][b][m][n] = (f32x4){0.f, 0.f, 0.f, 0.f};
    bf16x8 At[4][2], B0[2][2], B1[2][2];
    const char* cA = (const char*)g.A + (size_t)cur.pm * tstep; const char* cB = (const char*)g.Bt + (size_t)cur.pn * tstep;
#define PG8_AT(kt) ((!Epi::SPLITK || (kt) < nth) ? cA + (size_t)(kt) * kstep : (const char*)g.A2 + (size_t)cur.pm * tstep + (size_t)((kt) - nth) * kstep)
#define PG8_BT(kt) ((!Epi::SPLITK || (kt) < nth) ? cB + (size_t)(kt) * kstep : (const char*)g.Bt2 + (size_t)cur.pn * tstep + (size_t)((kt) - nth) * kstep)
    S.a_ready(cur);
    PG8_STAGE(PG8_SB(0, 0), cB, voffB); PG8_STAGE(PG8_SA(0, 0), cA, voffA); PG8_STAGE(PG8_SB(0, 1), cB + hstep, voffB); PG8_STAGE(PG8_SA(0, 1), cA + hstep, voffA);
    if (wr == 1) PG8_BAR;
    PG8_WAIT_V(4); PG8_BAR;
    PG8_STAGE(PG8_SB(1, 0), cB + kstep, voffB); PG8_STAGE(PG8_SA(1, 0), cA + kstep, voffA); PG8_STAGE(PG8_SB(1, 1), cB + hstep + kstep, voffB);
    PG8_WAIT_V(6); PG8_BAR;
    PG8_STAMP();
    for (;;) {
        const bool has_next = S.next(ui + 1, nxt);
        const char* nA = has_next ? (const char*)g.A + (size_t)nxt.pm * tstep : cA; const char* nB = has_next ? (const char*)g.Bt + (size_t)nxt.pn * tstep : cB;
#define PG8_KBODY(t) { \
            const bool last = (t == nt - 2); \
            const char* a1 = PG8_AT(t + 1); \
            const char* a2 = last ? nA : PG8_AT(t + 2); const char* b2 = last ? nB : PG8_BT(t + 2); \
            const char* a3 = last ? nA + kstep : PG8_AT(t + 3); const char* b3 = last ? nB + kstep : PG8_BT(t + 3); \
            if (last && has_next) S.a_ready(nxt); \
            PG8_LDB(B0, 0, 0); PG8_SCHED; PG8_LDA(At, 0, 0); PG8_STAGE(PG8_SA(1, 1), a1 + hstep, voffA); \
            PG8_WAIT_L(8); PG8_BAR; PG8_WAIT_L(0); PG8_MMA(0, 0, At, B0); PG8_BAR; PG8_SCHED; \
            PG8_LDB(B1, 0, 1); PG8_STAGE(PG8_SB(0, 0), b2, voffB); \
            PG8_BAR; PG8_WAIT_L(0); PG8_MMA(0, 1, At, B1); PG8_BAR; \
            PG8_LDA(At, 0, 1); PG8_STAGE(PG8_SA(0, 0), a2, voffA); \
            PG8_BAR; PG8_WAIT_L(0); PG8_MMA(1, 0, At, B0); PG8_BAR; PG8_SCHED; \
            PG8_STAGE(PG8_SB(0, 1), b2 + hstep, voffB); \
            PG8_WAIT_V(6); PG8_BAR; PG8_MMA(1, 1, At, B1); PG8_BAR; \
            PG8_LDB(B0, 1, 0); PG8_SCHED; PG8_LDA(At, 1, 0); PG8_STAGE(PG8_SA(0, 1), a2 + hstep, voffA); \
            PG8_WAIT_L(8); PG8_BAR; PG8_WAIT_L(0); PG8_MMA(0, 0, At, B0); PG8_BAR; PG8_SCHED; \
            PG8_LDB(B1, 1, 1); PG8_STAGE(PG8_SB(1, 0), b3, voffB); \
            PG8_BAR; PG8_WAIT_L(0); PG8_MMA(0, 1, At, B1); PG8_BAR; \
            PG8_LDA(At, 1, 1); PG8_STAGE(PG8_SA(1, 0), a3, voffA); \
            PG8_BAR; PG8_WAIT_L(0); PG8_MMA(1, 0, At, B0); PG8_BAR; PG8_SCHED; \
            PG8_STAGE(PG8_SB(1, 1), b3 + hstep, voffB); \
            PG8_WAIT_V(6); PG8_BAR; PG8_MMA(1, 1, At, B1); PG8_BAR; \
        }
        for (int t = 0; t < nth; t += 2) PG8_KBODY(t)
        if constexpr (Epi::SPLITK) {
            E.mid(acc, cur, wr, wc, fr, fq);
            for (int t = nth; t < nt; t += 2) PG8_KBODY(t)
        }
#undef PG8_KBODY
        PG8_STAMP();
        if constexpr (!Epi::AFTER_DRAIN) { E(acc, cur, wr, wc, fr, fq); S.done(cur); }
        PG8_STAMP();
        if (!has_next) break;
#pragma unroll
        for (int a = 0; a < 2; ++a)
#pragma unroll
            for (int b = 0; b < 2; ++b)
#pragma unroll
                for (int m = 0; m < 4; ++m)
#pragma unroll
                    for (int n = 0; n < 2; ++n) acc[a][b][m][n] = (f32x4){0.f, 0.f, 0.f, 0.f};
        cur = nxt; cA = nA; cB = nB; ++ui;
    }
    PG8_WAIT_V(0);
    if (wr == 0) PG8_BAR;
    PG8_BAR;
    if constexpr (Epi::AFTER_DRAIN) { E.fused(acc, cur, wr, wc, fr, fq, lds, wid, lane); S.done(cur); }
    PG8_STAMP();
    if (STAMP && wid == 0) { stamps[lane] = lane < nts ? (((unsigned long long)(unsigned)ts_hi << 32) | (unsigned)ts_lo) : 0ull;
        if (lane == 62) stamps[62] = rt_entry; if (lane == 63) stamps[63] = (unsigned long long)wall_clock64(); }
#undef PG8_STAMP
#undef PG8_AT
#undef PG8_BT
#undef PG8_SA
#undef PG8_SB
#undef PG8_STAGE
#undef PG8_LDA
#undef PG8_LDB
#undef PG8_MMA
#undef PG8_WAIT_V
#undef PG8_WAIT_L
#undef PG8_BAR
#undef PG8_SCHED
}
}
#define XB_TMO      128
#define XB_XCNT(j)  (256  + 64 * (j))
#define XB_XSUB(j)  (1280 + 64 * (j))
#define XB_XGEN(j)  (2304 + 64 * (j))
#define XB_TOP      3328
#define XB_TOPGEN   3392
#define XA_TMO      4032
#define XA_SUB(j)   (4096 + 64 * (j))
#define XA_GEN(j)   (5120 + 64 * (j))
#define XCD_BAR_WORDS 6144
#define XB_SPIN_CAP (1u << 18)

__device__ __forceinline__ unsigned xb_ld(unsigned* p)              { return __hip_atomic_load(p, __ATOMIC_RELAXED, __HIP_MEMORY_SCOPE_AGENT); }
__device__ __forceinline__ unsigned xb_add(unsigned* p, unsigned v) { return __hip_atomic_fetch_add(p, v, __ATOMIC_RELAXED, __HIP_MEMORY_SCOPE_AGENT); }
__device__ __forceinline__ unsigned xb_xcc_id() { return (unsigned)__builtin_amdgcn_s_getreg((3 << 11) | 20) & 0xFu; }
#define XB_SPIN(cond, bar) do { unsigned _sp = 0; while (cond) { __builtin_amdgcn_s_sleep(1); \
    if ((++_sp & 255u) == 0u) { if (xb_ld(&(bar)[XB_TMO])) break; if (_sp > XB_SPIN_CAP) { atomicAdd(&(bar)[XB_TMO], 1u); break; } } } } while (0)

struct XcdBarrier {
    unsigned* bar; unsigned x;
    volatile LAS unsigned* st;
};

__device__ __forceinline__ XcdBarrier xcd_barrier_post(unsigned* bar, volatile LAS unsigned* st) {
    XcdBarrier b; b.bar = bar; b.x = xb_xcc_id(); b.st = st;
    if (threadIdx.x == 0) (void)xb_add(&bar[XB_XCNT(b.x)], 1u);
    return b;
}
__device__ __forceinline__ void xcd_barrier_complete(unsigned* bar, unsigned x, unsigned& nloc, unsigned& nx) {
    const unsigned G = gridDim.x * gridDim.y * gridDim.z;
    unsigned sum, cnt, mine, sp = 0u;
    for (;;) {
        sum = 0u; cnt = 0u; mine = 0u;
#pragma unroll
        for (unsigned j = 0; j < 16; ++j) { const unsigned c = xb_ld(&bar[XB_XCNT(j)]); sum += c; cnt += (c > 0u) ? 1u : 0u; mine = (j == x) ? c : mine; }
        if (sum == G) break;
        __builtin_amdgcn_s_sleep(1);
        if ((++sp & 255u) == 0u) { if (xb_ld(&bar[XB_TMO])) break; if (sp > XB_SPIN_CAP) { atomicAdd(&bar[XB_TMO], 1u); break; } }
    }
    nloc = mine > 0u ? mine : 1u; nx = cnt > 0u ? cnt : 1u;
}

__device__ __forceinline__ void xcd_barrier(const XcdBarrier& b) {
    asm volatile("s_waitcnt vmcnt(0)" ::: "memory");
    __syncthreads();
    if (threadIdx.x == 0) {
        unsigned* bar = b.bar;
        __builtin_amdgcn_s_waitcnt(0);
        unsigned nloc = b.st[0], nx = b.st[1];
        if (nloc == 0u) { xcd_barrier_complete(bar, b.x, nloc, nx); b.st[0] = nloc; b.st[1] = nx; }
        const unsigned old = xb_add(&bar[XB_XSUB(b.x)], 1u);
        const unsigned gen = old / nloc;
        if (old + 1u == (gen + 1u) * nloc) {
            __builtin_amdgcn_fence(__ATOMIC_RELEASE, "agent");
            asm volatile("s_waitcnt vmcnt(0)" ::: "memory");
            const unsigned og = xb_add(&bar[XB_TOP], 1u);
            const unsigned tg = og / nx;
            if (og + 1u == (tg + 1u) * nx) xb_add(&bar[XB_TOPGEN], 1u);
            else XB_SPIN(xb_ld(&bar[XB_TOPGEN]) == tg, bar);
            __builtin_amdgcn_fence(__ATOMIC_ACQUIRE, "agent");
            xb_add(&bar[XB_XGEN(b.x)], 1u);
            asm volatile("s_waitcnt vmcnt(0)" ::: "memory");
        } else {
            XB_SPIN(xb_ld(&bar[XB_XGEN(b.x)]) == gen, bar);
            __builtin_amdgcn_fence(__ATOMIC_ACQUIRE, "agent");
            asm volatile("s_waitcnt vmcnt(0)" ::: "memory");
        }
    }
    __syncthreads();
}


__device__ __forceinline__ void xcd_align(const XcdBarrier& b) {
    __builtin_amdgcn_s_barrier();
    if (tid_fresh() == 0) {
        unsigned* bar = b.bar;
        const unsigned nloc = b.st[0];
        if (nloc != 0u) {
            const unsigned old = xb_add(&bar[XA_SUB(b.x)], 1u), gen = old / nloc;
            if (old + 1u == (gen + 1u) * nloc) xb_add(&bar[XA_GEN(b.x)], 1u);
            else { unsigned sp = 0u; while (xb_ld(&bar[XA_GEN(b.x)]) == gen) { __builtin_amdgcn_s_sleep(1); ++sp; if ((sp & 31u) == 0u) { if (xb_ld(&bar[XA_TMO]) != 0u) break; if (sp > 400u) { atomicAdd(&bar[XA_TMO], 1u); break; } } } }
        }
    }
    __builtin_amdgcn_s_barrier();
}

#define XP_WORD(pair) (XCD_BAR_WORDS + 16 * (pair))
#define XP_WORDS (128 * 16)
__device__ __forceinline__ void pair_post_id(unsigned* flag, int half, unsigned myx) { if (threadIdx.x == 0) __hip_atomic_store(flag + 1 + half, myx + 1u, __ATOMIC_RELAXED, __HIP_MEMORY_SCOPE_AGENT); }
__device__ __forceinline__ void pair_sync(unsigned* bar, unsigned* flag, unsigned target, int half, unsigned myx) {
    unsigned pid = 0u;
    if (threadIdx.x == 0) {
        const unsigned i0 = xb_ld(flag + 1), i1 = xb_ld(flag + 2), i2 = xb_ld(flag + 3), i3 = xb_ld(flag + 4), me = myx + 1u;
        pid = (i0 == me && i1 == me && i2 == me && i3 == me) ? me : 0u;
    }
    asm volatile("s_waitcnt vmcnt(0)" ::: "memory");
    __syncthreads();
    if (threadIdx.x == 0) {
        __builtin_amdgcn_s_waitcnt(0);
        if (pid != myx + 1u) {
            __builtin_amdgcn_fence(__ATOMIC_RELEASE, "agent");
            asm volatile("s_waitcnt vmcnt(0)" ::: "memory");
        }
        (void)xb_add(flag, 1u);
        XB_SPIN(xb_ld(flag) < target, bar);
        __builtin_amdgcn_fence(__ATOMIC_ACQUIRE, "agent");
        asm volatile("s_waitcnt vmcnt(0)" ::: "memory");
    }
    __syncthreads();
}
template <bool BF16IN>
__device__ __forceinline__ void ph_mod_rows(const P& p, const void* Xv, const float* g, int shift_off, int scale_off, bf16* H, int rfirst, int rstride, int rend) {
  const float* ada = (const float*)(p.ws + OFF_ADA);
  const int tidm = tid_fresh(); int wave = tidm >> 6, lane = tidm & 63;
  int row = rfirst + wave;
  float4 v[4];
#define MOD_LOAD(dst, r_)                                                                                       \
  {                                                                                                             \
    if (BF16IN) {                                                                                               \
      const uint2* xr = (const uint2*)((const bf16*)Xv + (size_t)(r_) * DM);                                    \
      _Pragma("unroll") for (int i = 0; i < 4; ++i) { const uint2 w = xr[lane + i * 64]; dst[i] = make_float4(bflo(w.x), bfhi(w.x), bflo(w.y), bfhi(w.y)); } \
    } else {                                                                                                    \
      const float4* xr = (const float4*)((const float*)Xv + (size_t)(r_) * DM);                                 \
      _Pragma("unroll") for (int i = 0; i < 4; ++i) dst[i] = xr[lane + i * 64];                                 \
    }                                                                                                           \
  }
  float4 vn[4];
  if (row < rend) { MOD_LOAD(v, row) MOD_LOAD(vn, (row + rstride < rend) ? row + rstride : row) }
  for (; row < rend; row += rstride) {
    float4 vnn[4];
    const int nrow = row + 2 * rstride;
    MOD_LOAD(vnn, (nrow < rend) ? nrow : row)
    float ss = 0.f;
#pragma unroll
    for (int i = 0; i < 4; ++i) ss += v[i].x * v[i].x + v[i].y * v[i].y + v[i].z * v[i].z + v[i].w * v[i].w;
    ss = wave_sum(ss);
    float rstd = rsqrtf(ss * (1.f / DM) + 1e-6f);
    int b = row >> 12;
    const float* sh = ada + b * 6144 + shift_off;
    const float* sc = ada + b * 6144 + scale_off;
#pragma unroll
    for (int i = 0; i < 4; ++i) {
      int c0 = (lane + i * 64) * 4;
      float4 gg = *(const float4*)(g + c0);
      float4 s4 = *(const float4*)(sc + c0);
      float4 h4 = *(const float4*)(sh + c0);
      ushort4 o;
      o.x = f2bf(v[i].x * rstd * gg.x * (1.f + s4.x) + h4.x);
      o.y = f2bf(v[i].y * rstd * gg.y * (1.f + s4.y) + h4.y);
      o.z = f2bf(v[i].z * rstd * gg.z * (1.f + s4.z) + h4.z);
      o.w = f2bf(v[i].w * rstd * gg.w * (1.f + s4.w) + h4.w);
      *(ushort4*)(H + (size_t)row * DM + c0) = o;
    }
#pragma unroll
    for (int i = 0; i < 4; ++i) { v[i] = vn[i]; vn[i] = vnn[i]; }
  }
#undef MOD_LOAD
}
template <bool BF16IN>
__device__ __forceinline__ void ph_mod(const P& p, const void* Xv, const float* g, int shift_off, int scale_off, bf16* H, int bid, int nb) {
  ph_mod_rows<BF16IN>(p, Xv, g, shift_off, scale_off, H, bid * 8, nb * 8, TT);
}

using pg8::f32x4;
using pg8::u32x4;
using pg8::Unit;
using pg8::cvt_pk_bf16;
typedef short s16x4_t __attribute__((ext_vector_type(4)));
typedef unsigned u32x4_t __attribute__((ext_vector_type(4)));
typedef unsigned short u16x4_t __attribute__((ext_vector_type(4)));

__device__ __forceinline__ size_t tm_off(size_t row, int col, int kbn) {
  return (((row >> 4) * kbn + (col >> 5)) * 64 + ((col >> 3) & 3) * 16 + (row & 15)) * 8 + (col & 7);
}

__device__ __forceinline__ int in_srcmap(int d) {
  if (d < 2048) return d;
  if (d < 3072) return 3088 + (d - 2048);
  if (d < 3328) return 4112 + (d - 3072);
  if (d < 3840) return 4368 + (d - 3328);
  if (d < 3904) return 4880 + (d - 3840);
  if (d < 3912) return 4944 + (d - 3904);
  if (d < 3928) return 3072 + (d - 3912);
  if (d < 4096) return -1;
  if (d < 5120) return 2048 + (d - 4096);
  return 4952 + (d - 5120);
}
template <bool MAP>
__device__ __forceinline__ void transpose_item(const float* W, int ldw, int K, bf16* WT, int item, int nblk, float* scr, int lane) {
  const int kb = item / nblk, nbk = item % nblk, k0 = 64 * kb, n0 = 32 * nbk;
  const int d = n0 + (lane & 31);
  const int src = MAP ? in_srcmap(d) : d;
  float r[32];
  const int srcc = (src >= 0) ? src : 0;
#pragma unroll
  for (int i = 0; i < 32; ++i) r[i] = W[(size_t)(k0 + 2 * i + (lane >> 5)) * ldw + srcc];
#pragma unroll
  for (int i = 0; i < 32; ++i) scr[(2 * i + (lane >> 5)) * 33 + (lane & 31)] = (src >= 0) ? r[i] : 0.f;
  asm volatile("s_waitcnt lgkmcnt(0)" ::: "memory");
  const int c = lane & 7;
#pragma unroll
  for (int j = 0; j < 4; ++j) {
    const int n = (lane >> 3) + 8 * j;
    const float* s = scr + (8 * c) * 33 + n;
    uint4 o;
    o.x = pk2(s[0 * 33], s[1 * 33]); o.y = pk2(s[2 * 33], s[3 * 33]); o.z = pk2(s[4 * 33], s[5 * 33]); o.w = pk2(s[6 * 33], s[7 * 33]);
    *(uint4*)(WT + (size_t)(n0 + n) * K + k0 + 8 * c) = o;
  }
  asm volatile("s_waitcnt lgkmcnt(0)" ::: "memory");
}

__device__ __forceinline__ void peer_tab_convert(const P& p, int row0, int rend, int rstep) {
  const int lane = tid_fresh() & 63;
  unsigned char* PU8 = (unsigned char*)(p.ws + OFF_PU);
  unsigned char* PV8 = (unsigned char*)(p.ws + OFF_PV);
  float* PSC = (float*)(p.ws + OFF_PSC);
  f32x4 va[4], vb[4];
  {
    const int r0 = row0 < rend ? row0 : rend - 1, r1 = (row0 + rstep < rend) ? row0 + rstep : r0;
    const float* s0 = (r0 < 16384 ? p.peer_u : p.peer_v) + (size_t)(r0 & 16383) * 1024 + lane * 4;
    const float* s1 = (r1 < 16384 ? p.peer_u : p.peer_v) + (size_t)(r1 & 16383) * 1024 + lane * 4;
#pragma unroll
    for (int q = 0; q < 4; ++q) { va[q] = *(const f32x4*)(s0 + q * 256); vb[q] = *(const f32x4*)(s1 + q * 256); }
  }
  for (int row = row0; row < rend; row += rstep) {
    f32x4 v[4], vn[4];
    {
      const int r2 = (row + 2 * rstep < rend) ? row + 2 * rstep : row;
      const float* s2 = (r2 < 16384 ? p.peer_u : p.peer_v) + (size_t)(r2 & 16383) * 1024 + lane * 4;
#pragma unroll
      for (int q = 0; q < 4; ++q) vn[q] = *(const f32x4*)(s2 + q * 256);
    }
    float mx = 0.f;
#pragma unroll
    for (int q = 0; q < 4; ++q) {
      v[q] = va[q]; va[q] = vb[q]; vb[q] = vn[q];
      mx = fmaxf(mx, fmaxf(fmaxf(fabsf(v[q][0]), fabsf(v[q][1])), fmaxf(fabsf(v[q][2]), fabsf(v[q][3]))));
    }
    mx = wave_max(mx);
    const float sc = (mx > 0.f) ? exp2f(floorf(log2f(448.f / mx))) : 1.f;
    u32x4 o;
#pragma unroll
    for (int q = 0; q < 4; ++q) {
      int w = __builtin_amdgcn_cvt_pk_fp8_f32(v[q][0] * sc, v[q][1] * sc, 0, false);
      w = __builtin_amdgcn_cvt_pk_fp8_f32(v[q][2] * sc, v[q][3] * sc, w, true);
      o[q] = (unsigned)w;
    }
    *(u32x4*)((row < 16384 ? PU8 : PV8) + (size_t)(row & 16383) * 1024 + lane * 16) = o;
    if (lane == 0) PSC[row] = 1.f / sc;
  }
}

struct TrDesc { const float* W; bf16* WT; int ldw, K, k0, n0; bool map; };
__device__ __forceinline__ TrDesc tr_desc(const P& p, int it) {
  constexpr int I_IN = 16 * 224, I_SQ = 16 * 32;
  TrDesc d; int r = it, nblk;
  if (r < I_IN) { d.W = p.w_in; d.WT = (bf16*)(p.ws + OFF_WT_IN); d.ldw = NIN; d.K = 1024; nblk = 224; d.map = true; }
  else {
    r -= I_IN; d.map = false; d.K = 1024;
    if (r < I_SQ) { d.W = p.w_a; d.WT = (bf16*)(p.ws + OFF_WT_A); d.ldw = 1024; nblk = 32; }
    else if (r < 2 * I_SQ) { r -= I_SQ; d.W = p.w_b; d.WT = (bf16*)(p.ws + OFF_WT_B); d.ldw = 1024; nblk = 32; }
    else if (r < 3 * I_SQ) { r -= 2 * I_SQ; d.W = p.w_out; d.WT = (bf16*)(p.ws + OFF_WT_OUT); d.ldw = 1024; nblk = 32; }
    else { r -= 3 * I_SQ; d.W = p.w_q; d.WT = (bf16*)(p.ws + OFF_WT_Q); d.ldw = 2048; nblk = 64; }
  }
  d.k0 = 64 * (r / nblk); d.n0 = 32 * (r % nblk);
  return d;
}
__device__ __forceinline__ int tr_load(const TrDesc& d, int lane, float (&r)[32]) {
  const int dd = d.n0 + (lane & 31);
  const int src = d.map ? in_srcmap(dd) : dd, srcc = (src >= 0) ? src : 0;
#pragma unroll
  for (int i = 0; i < 32; ++i) r[i] = d.W[(size_t)(d.k0 + 2 * i + (lane >> 5)) * d.ldw + srcc];
  return src;
}
__device__ __forceinline__ void tr_store(const TrDesc& d, int src, float* scr, int lane, const float (&r)[32]) {
#pragma unroll
  for (int i = 0; i < 32; ++i) scr[(2 * i + (lane >> 5)) * 33 + (lane & 31)] = (src >= 0) ? r[i] : 0.f;
  asm volatile("s_waitcnt lgkmcnt(0)" ::: "memory");
  const int c = lane & 7;
#pragma unroll
  for (int j = 0; j < 4; ++j) {
    const int n = (lane >> 3) + 8 * j;
    const float* s = scr + (8 * c) * 33 + n;
    uint4 o;
    o.x = pk2(s[0 * 33], s[1 * 33]); o.y = pk2(s[2 * 33], s[3 * 33]); o.z = pk2(s[4 * 33], s[5 * 33]); o.w = pk2(s[6 * 33], s[7 * 33]);
    *(uint4*)(d.WT + (size_t)(d.n0 + n) * d.K + d.k0 + 8 * c) = o;
  }
  asm volatile("s_waitcnt lgkmcnt(0)" ::: "memory");
}
__device__ __forceinline__ void ph_prep(const P& p, float* sm) {
  const int tid = tid_fresh(), wave = tid >> 6, lane = tid & 63;
  const int bid = blockIdx.x, nb = gridDim.x;
  float* silc = sm + 8 * 2112 + 64;
  float* red = silc + 8192;
  float* ada = (float*)(p.ws + OFF_ADA);
  if (bid < 192) {
    for (int i = tid; i < 8192; i += 512) silc[i] = siluf_(p.c[i]);
    __syncthreads();
    for (int it = bid; it < 192; it += nb) {
      const int kg = tid >> 5, cn = tid & 31, n = it * 32 + cn;
      float acc[8];
#pragma unroll
      for (int b = 0; b < 8; ++b) acc[b] = 0.f;
#pragma unroll 1
      for (int kq = 0; kq < 2; ++kq) {
        float w[32];
#pragma unroll
        for (int j = 0; j < 32; ++j) w[j] = p.w_ada[(size_t)(kg * 64 + kq * 32 + j) * 6144 + n];
#pragma unroll
        for (int j = 0; j < 32; ++j) {
          const int k = kg * 64 + kq * 32 + j;
#pragma unroll
          for (int b = 0; b < 8; ++b) acc[b] += silc[b * 1024 + k] * w[j];
        }
      }
#pragma unroll
      for (int b = 0; b < 8; ++b) red[(kg * 8 + b) * 32 + cn] = acc[b];
      __syncthreads();
      if (tid < 256) {
        const int b = tid >> 5, c2 = tid & 31;
        float s = 0.f;
#pragma unroll
        for (int g = 0; g < 16; ++g) s += red[(g * 8 + b) * 32 + c2];
        ada[b * 6144 + it * 32 + c2] = s + p.b_ada[it * 32 + c2];
      }
      __syncthreads();
    }
  }
  {
    for (int i = bid * 512 + tid; i < 2 * 2048; i += nb * 512) {
      const float* src = (i < 2048) ? p.sk1 : p.sk2;
      const int j = i & 2047;
      const float4 v0 = *(const float4*)(src + j * 8), v1 = *(const float4*)(src + j * 8 + 4);
      uint4 o; o.x = pk2(v0.x, v0.y); o.y = pk2(v0.z, v0.w); o.z = pk2(v1.x, v1.y); o.w = pk2(v1.z, v1.w);
      *(uint4*)((bf16*)(p.ws + OFF_SK) + (size_t)(i >> 11) * 16384 + tm_off((size_t)(j >> 4), (j & 15) * 8, 4)) = o;
    }
  }
  {
    float* prm = (float*)(p.ws + OFF_PRM);
    for (int i = bid * 512 + tid; i < PRM_TOTAL; i += nb * 512) {
      float v;
      if (i < PRM_BG) v = p.w_gate_up[i];
      else if (i < PRM_GNG) v = p.b_gate[i - PRM_BG];
      else if (i < PRM_N2G) v = p.gla_norm_g[i - PRM_GNG];
      else if (i < PRM_FG) v = p.norm2_g[i - PRM_N2G];
      else v = p.final_g[i - PRM_FG];
      prm[i] = v;
    }
  }
  {
    bf16* WUK = (bf16*)(p.ws + OFF_WUK);
    bf16* WUV = (bf16*)(p.ws + OFF_WUV);
    for (int i = bid * 512 + tid; i < 2 * 262144; i += nb * 512) {
      if (i < 262144) {
        const int cc = i & 255, d = (i >> 8) & 127, h = i >> 15;
        WUK[((h * 16 + (cc >> 4)) * 4 + (d >> 5)) * 512 + (((d >> 3) & 3) * 16 + (cc & 15)) * 8 + (d & 7)] =
            f2bf(p.w_uk[i] * p.kv_norm_g[cc] * 0.08838834764831845f);
      } else {
        const int k = i - 262144;
        const int d = k & 127, cc = (k >> 7) & 255, h = k >> 15;
        WUV[((h * 8 + (d >> 4)) * 8 + (cc >> 5)) * 512 + (((cc >> 3) & 3) * 16 + (d & 15)) * 8 + (cc & 7)] =
            f2bf(p.w_uv[k] * p.kv_norm_g[cc]);
      }
    }
  }
  float* scr = sm + wave * 2112;
  const int gw = bid * 8 + wave, ngw = nb * 8;
  constexpr int I_TOT = 16 * 224 + 3 * 16 * 32 + 16 * 64;
  for (int it = gw; it < I_TOT; it += 2 * ngw) {
    const bool hasb = it + ngw < I_TOT;
    const TrDesc da = tr_desc(p, it), db = tr_desc(p, hasb ? it + ngw : it);
    float ra[32], rb[32];
    const int sa = tr_load(da, lane, ra), sb = tr_load(db, lane, rb);
    tr_store(da, sa, scr, lane, ra);
    if (hasb) tr_store(db, sb, scr, lane, rb);
  }
}


struct EpiIn {
  static constexpr bool PERM = true, AFTER_DRAIN = false, SPLITK = false;
  char* ws; float* out;
  __device__ __forceinline__ void operator()(const f32x4 (&acc)[2][2][4][2], const Unit& u, int wr, int wc, int fr, int fq) const {
    const int pn = u.pn;
    const int row0 = u.pm * 256 + wr * 64 + fr, cl0 = wc * 32 + 8 * fq;
    if (pn == 12) {
      bf16* dst = (bf16*)(ws + OFF_CKV);
      float* ssp = (float*)(ws + OFF_SSP);
#pragma unroll
      for (int ai = 0; ai < 2; ++ai)
#pragma unroll
        for (int m = 0; m < 4; ++m) {
          const size_t row = row0 + ai * 128 + m * 16;
          float ss = 0.f;
#pragma unroll
          for (int bj = 0; bj < 2; ++bj) {
            const f32x4 v0 = acc[ai][bj][m][0], v1 = acc[ai][bj][m][1];
            ss += (v0[0] * v0[0] + v0[1] * v0[1]) + (v0[2] * v0[2] + v0[3] * v0[3]) + (v1[0] * v1[0] + v1[1] * v1[1]) + (v1[2] * v1[2] + v1[3] * v1[3]);
            u32x4 w; w.x = cvt_pk_bf16(v0[0], v0[1]); w.y = cvt_pk_bf16(v0[2], v0[3]); w.z = cvt_pk_bf16(v1[0], v1[1]); w.w = cvt_pk_bf16(v1[2], v1[3]);
            *(u32x4*)(dst + row * 256 + cl0 + bj * 128) = w;
          }
          ss += __shfl_xor(ss, 16); ss += __shfl_xor(ss, 32);
          if (fq == 0) ssp[row * 4 + wc] = ss;
        }
    } else if (pn == 15) {
      bf16* IK = (bf16*)(ws + OFF_IK);
      float* IW = (float*)(ws + OFF_IW);
      float* GLOW = (float*)(ws + OFF_GLOW);
#pragma unroll
      for (int ai = 0; ai < 2; ++ai)
#pragma unroll
        for (int m = 0; m < 4; ++m) {
          const size_t row = row0 + ai * 128 + m * 16;
          const int cl = cl0;
          const f32x4 v0 = acc[ai][0][m][0], v1 = acc[ai][0][m][1];
          if (cl < 64) {
            u32x4 w; w.x = cvt_pk_bf16(v0[0], v0[1]); w.y = cvt_pk_bf16(v0[2], v0[3]); w.z = cvt_pk_bf16(v1[0], v1[1]); w.w = cvt_pk_bf16(v1[2], v1[3]);
            *(u32x4*)(IK + tm_off(row, cl, 2)) = w;
          } else if (cl < 72) {
            *(f32x4*)(IW + row * 8) = v0 * 0.35355339059327373f;
            *(f32x4*)(IW + row * 8 + 4) = v1 * 0.35355339059327373f;
          } else if (cl < 88) {
            *(f32x4*)(GLOW + row * 16 + (cl - 72)) = v0;
            *(f32x4*)(GLOW + row * 16 + (cl - 72) + 4) = v1;
          }
        }
    } else {
      bf16* dst; int ld; float scale = 1.f; int act = 0; int coff; bool tm = false;
      if (pn < 2) { dst = (bf16*)(ws + OFF_Q); ld = 512; coff = pn * 256; scale = 0.08838834764831845f; }
      else if (pn < 4) { dst = (bf16*)(ws + OFF_K); ld = 512; coff = (pn - 2) * 256; }
      else if (pn < 8) { dst = (bf16*)(ws + OFF_V); ld = 1024; coff = (pn - 4) * 256; }
      else if (pn < 12) { dst = (bf16*)(ws + OFF_DQ); ld = 1024; coff = (pn - 8) * 256; tm = true; }
      else if (pn < 15) { dst = (bf16*)(ws + OFF_IQ); ld = 512; coff = (pn - 13) * 256; scale = 0.125f; tm = true; }
      else if (pn < 20) { dst = (bf16*)(ws + OFF_SGR); ld = 1024; coff = (pn - 16) * 256; act = 1; }
      else if (pn < 24) { dst = (bf16*)out; ld = 1024; coff = (pn - 20) * 256; act = 2; tm = true; }
      else { dst = (bf16*)out + (size_t)TT * 1024; ld = 1024; coff = (pn - 24) * 256; act = 2; tm = true; }
#pragma unroll
      for (int ai = 0; ai < 2; ++ai)
#pragma unroll
        for (int m = 0; m < 4; ++m) {
          const size_t row = row0 + ai * 128 + m * 16;
#pragma unroll
          for (int bj = 0; bj < 2; ++bj) {
            f32x4 v0 = acc[ai][bj][m][0] * scale, v1 = acc[ai][bj][m][1] * scale;
            if (act == 1) {
#pragma unroll
              for (int j = 0; j < 4; ++j) { v0[j] = siluf_(v0[j]); v1[j] = siluf_(v1[j]); }
            } else if (act == 2) {
#pragma unroll
              for (int j = 0; j < 4; ++j) { v0[j] = sigmoidf_(v0[j]); v1[j] = sigmoidf_(v1[j]); }
            }
            u32x4 w; w.x = cvt_pk_bf16(v0[0], v0[1]); w.y = cvt_pk_bf16(v0[2], v0[3]); w.z = cvt_pk_bf16(v1[0], v1[1]); w.w = cvt_pk_bf16(v1[2], v1[3]);
            *(u32x4*)(dst + (tm ? tm_off(row, coff + cl0 + bj * 128, ld >> 5) : row * ld + coff + cl0 + bj * 128)) = w;
          }
        }
    }
  }
};

template <bool ADD> struct EpiMix {
  static constexpr bool PERM = true, AFTER_DRAIN = false, SPLITK = false;
  const bf16* SZ; bf16* MIX;
  __device__ __forceinline__ void operator()(const f32x4 (&acc)[2][2][4][2], const Unit& u, int wr, int wc, int fr, int fq) const {
    const int row0 = u.pm * 256 + wr * 64 + fr, col0 = u.pn * 256 + wc * 32 + 8 * fq;
    u32x4 sc[2], oc[2], sn[2], on[2];
    {
      const size_t idx = (size_t)row0 * 1024 + col0;
      sc[0] = *(const u32x4*)(SZ + tm_off(row0, col0, 32)); sc[1] = *(const u32x4*)(SZ + tm_off(row0, col0 + 128, 32));
      if (ADD) { oc[0] = *(const u32x4*)(MIX + idx); oc[1] = *(const u32x4*)(MIX + idx + 128); }
    }
#pragma unroll
    for (int s = 0; s < 8; ++s) {
      const int ai = s >> 2, m = s & 3;
      const size_t idx = (size_t)(row0 + ai * 128 + m * 16) * 1024 + col0;
      if (s < 7) {
        const int ai2 = (s + 1) >> 2, m2 = (s + 1) & 3;
        const size_t idn = (size_t)(row0 + ai2 * 128 + m2 * 16) * 1024 + col0;
        sn[0] = *(const u32x4*)(SZ + tm_off(row0 + ai2 * 128 + m2 * 16, col0, 32)); sn[1] = *(const u32x4*)(SZ + tm_off(row0 + ai2 * 128 + m2 * 16, col0 + 128, 32));
        if (ADD) { on[0] = *(const u32x4*)(MIX + idn); on[1] = *(const u32x4*)(MIX + idn + 128); }
      }
#pragma unroll
      for (int bj = 0; bj < 2; ++bj) {
        const u32x4 sv = sc[bj];
        f32x4 v0 = acc[ai][bj][m][0], v1 = acc[ai][bj][m][1];
        v0[0] *= bflo(sv.x); v0[1] *= bfhi(sv.x); v0[2] *= bflo(sv.y); v0[3] *= bfhi(sv.y);
        v1[0] *= bflo(sv.z); v1[1] *= bfhi(sv.z); v1[2] *= bflo(sv.w); v1[3] *= bfhi(sv.w);
        if (ADD) {
          const u32x4 o = oc[bj];
          v0[0] += bflo(o.x); v0[1] += bfhi(o.x); v0[2] += bflo(o.y); v0[3] += bfhi(o.y);
          v1[0] += bflo(o.z); v1[1] += bfhi(o.z); v1[2] += bflo(o.w); v1[3] += bfhi(o.w);
        }
        u32x4 w; w.x = cvt_pk_bf16(v0[0], v0[1]); w.y = cvt_pk_bf16(v0[2], v0[3]); w.z = cvt_pk_bf16(v1[0], v1[1]); w.w = cvt_pk_bf16(v1[2], v1[3]);
        *(u32x4*)(MIX + idx + bj * 128) = w;
      }
      if (s < 7) { sc[0] = sn[0]; sc[1] = sn[1]; if (ADD) { oc[0] = on[0]; oc[1] = on[1]; } }
    }
  }
};

struct EpiMixMerged {
  static constexpr bool PERM = true, AFTER_DRAIN = false, SPLITK = true;
  const bf16* SZA; const bf16* SZB; bf16* MIX;
  __device__ __forceinline__ void mid(f32x4 (&acc)[2][2][4][2], const Unit& u, int wr, int wc, int fr, int fq) const {
    const int row0 = u.pm * 256 + wr * 64 + fr, col0 = u.pn * 256 + wc * 32 + 8 * fq;
    const bf16* pa = SZA + tm_off(row0, col0, 32);
    const bf16* pb = SZB + tm_off(row0, col0, 32);
    u32x4 ac[2], bc[2];
    ac[0] = *(const u32x4*)pa; ac[1] = *(const u32x4*)(pa + 4 * 512); bc[0] = *(const u32x4*)pb; bc[1] = *(const u32x4*)(pb + 4 * 512);
#pragma unroll
    for (int s = 0; s < 8; ++s) {
      const int ai = s >> 2, m = s & 3;
      u32x4 an[2], bn[2];
      if (s < 7) {
        const size_t d = (size_t)(((s + 1) >> 2) * 8 + ((s + 1) & 3)) * 32 * 512;
        an[0] = *(const u32x4*)(pa + d); an[1] = *(const u32x4*)(pa + d + 4 * 512); bn[0] = *(const u32x4*)(pb + d); bn[1] = *(const u32x4*)(pb + d + 4 * 512);
      }
#pragma unroll
      for (int bj = 0; bj < 2; ++bj) {
        const u32x4 a = ac[bj], b = bc[bj];
        f32x4& v0 = acc[ai][bj][m][0]; f32x4& v1 = acc[ai][bj][m][1];
        v0[0] *= bflo(a.x) * __builtin_amdgcn_rcpf(bflo(b.x)); v0[1] *= bfhi(a.x) * __builtin_amdgcn_rcpf(bfhi(b.x));
        v0[2] *= bflo(a.y) * __builtin_amdgcn_rcpf(bflo(b.y)); v0[3] *= bfhi(a.y) * __builtin_amdgcn_rcpf(bfhi(b.y));
        v1[0] *= bflo(a.z) * __builtin_amdgcn_rcpf(bflo(b.z)); v1[1] *= bfhi(a.z) * __builtin_amdgcn_rcpf(bfhi(b.z));
        v1[2] *= bflo(a.w) * __builtin_amdgcn_rcpf(bflo(b.w)); v1[3] *= bfhi(a.w) * __builtin_amdgcn_rcpf(bfhi(b.w));
      }
      if (s < 7) { ac[0] = an[0]; ac[1] = an[1]; bc[0] = bn[0]; bc[1] = bn[1]; }
      __builtin_amdgcn_sched_barrier(0);
    }
  }
  __device__ __forceinline__ void operator()(const f32x4 (&acc)[2][2][4][2], const Unit& u, int wr, int wc, int fr, int fq) const {
    const int row0 = u.pm * 256 + wr * 64 + fr, col0 = u.pn * 256 + wc * 32 + 8 * fq;
    u32x4 bc[2], bn[2];
    bc[0] = *(const u32x4*)(SZB + tm_off(row0, col0, 32)); bc[1] = *(const u32x4*)(SZB + tm_off(row0, col0 + 128, 32));
#pragma unroll
    for (int s = 0; s < 8; ++s) {
      const int ai = s >> 2, m = s & 3;
      const size_t idx = (size_t)(row0 + ai * 128 + m * 16) * 1024 + col0;
      if (s < 7) {
        const int rn = row0 + ((s + 1) >> 2) * 128 + ((s + 1) & 3) * 16;
        bn[0] = *(const u32x4*)(SZB + tm_off(rn, col0, 32)); bn[1] = *(const u32x4*)(SZB + tm_off(rn, col0 + 128, 32));
      }
#pragma unroll
      for (int bj = 0; bj < 2; ++bj) {
        const u32x4 b = bc[bj];
        f32x4 v0 = acc[ai][bj][m][0], v1 = acc[ai][bj][m][1];
        v0[0] *= bflo(b.x); v0[1] *= bfhi(b.x); v0[2] *= bflo(b.y); v0[3] *= bfhi(b.y);
        v1[0] *= bflo(b.z); v1[1] *= bfhi(b.z); v1[2] *= bflo(b.w); v1[3] *= bfhi(b.w);
        u32x4 w; w.x = cvt_pk_bf16(v0[0], v0[1]); w.y = cvt_pk_bf16(v0[2], v0[3]); w.z = cvt_pk_bf16(v1[0], v1[1]); w.w = cvt_pk_bf16(v1[2], v1[3]);
        *(u32x4*)(MIX + idx + bj * 128) = w;
      }
      if (s < 7) { bc[0] = bn[0]; bc[1] = bn[1]; }
    }
  }
};

struct EpiX1 {
  static constexpr bool PERM = true, AFTER_DRAIN = false, SPLITK = false;
  const float* x; const float* ada; bf16* out;
  __device__ __forceinline__ void operator()(const f32x4 (&acc)[2][2][4][2], const Unit& u, int wr, int wc, int fr, int fq) const {
    const int row0 = u.pm * 256 + wr * 64 + fr, col0 = u.pn * 256 + wc * 32 + 8 * fq;
    const int b = (u.pm * 256) >> 12;
    f32x4 g[2][2];
#pragma unroll
    for (int bj = 0; bj < 2; ++bj) {
      g[bj][0] = *(const f32x4*)(ada + b * 6144 + 2048 + col0 + bj * 128);
      g[bj][1] = *(const f32x4*)(ada + b * 6144 + 2048 + col0 + bj * 128 + 4);
    }
    f32x4 xc[4], xn[4];
    {
      const size_t idx = (size_t)row0 * 1024 + col0;
      xc[0] = *(const f32x4*)(x + idx); xc[1] = *(const f32x4*)(x + idx + 4);
      xc[2] = *(const f32x4*)(x + idx + 128); xc[3] = *(const f32x4*)(x + idx + 132);
    }
#pragma unroll
    for (int s = 0; s < 8; ++s) {
      const int ai = s >> 2, m = s & 3;
      const size_t idx = (size_t)(row0 + ai * 128 + m * 16) * 1024 + col0;
      if (s < 7) {
        const int ai2 = (s + 1) >> 2, m2 = (s + 1) & 3;
        const size_t idn = (size_t)(row0 + ai2 * 128 + m2 * 16) * 1024 + col0;
        xn[0] = *(const f32x4*)(x + idn); xn[1] = *(const f32x4*)(x + idn + 4);
        xn[2] = *(const f32x4*)(x + idn + 128); xn[3] = *(const f32x4*)(x + idn + 132);
      }
#pragma unroll
      for (int bj = 0; bj < 2; ++bj) {
        const f32x4 v0 = xc[2 * bj] + g[bj][0] * acc[ai][bj][m][0], v1 = xc[2 * bj + 1] + g[bj][1] * acc[ai][bj][m][1];
        u32x4 w; w.x = cvt_pk_bf16(v0[0], v0[1]); w.y = cvt_pk_bf16(v0[2], v0[3]); w.z = cvt_pk_bf16(v1[0], v1[1]); w.w = cvt_pk_bf16(v1[2], v1[3]);
        *(u32x4*)(out + idx + bj * 128) = w;
      }
      if (s < 7) { xc[0] = xn[0]; xc[1] = xn[1]; xc[2] = xn[2]; xc[3] = xn[3]; }
    }
  }
};

struct EpiPlain {
  static constexpr bool PERM = true, AFTER_DRAIN = false, SPLITK = false;
  bf16* O; int ld;
  __device__ __forceinline__ void operator()(const f32x4 (&acc)[2][2][4][2], const Unit& u, int wr, int wc, int fr, int fq) const {
    const int row0 = u.pm * 256 + wr * 64 + fr, col0 = u.pn * 256 + wc * 32 + 8 * fq;
#pragma unroll
    for (int ai = 0; ai < 2; ++ai)
#pragma unroll
      for (int m = 0; m < 4; ++m)
#pragma unroll
        for (int bj = 0; bj < 2; ++bj) {
          const f32x4 v0 = acc[ai][bj][m][0], v1 = acc[ai][bj][m][1];
          u32x4 w; w.x = cvt_pk_bf16(v0[0], v0[1]); w.y = cvt_pk_bf16(v0[2], v0[3]); w.z = cvt_pk_bf16(v1[0], v1[1]); w.w = cvt_pk_bf16(v1[2], v1[3]);
          *(u32x4*)(O + tm_off((size_t)(row0 + ai * 128 + m * 16), col0 + bj * 128, ld >> 5)) = w;
        }
  }
};

template <class Epi>
__device__ __forceinline__ void gemm_run(LAS unsigned char* lds, const bf16* A, const bf16* Bt, int M, int N, int K, const Epi& E) {
  pg8::Gemm g{A, Bt, M, N, K, A, Bt, K};
  pg8::StaticOrder S;
  S.init(M, N, gridDim.x, blockIdx.x);
  pg8::gemm_phase<Epi, pg8::StaticOrder, false>(lds, g, S, E, nullptr);
}
template <class Epi>
__device__ __forceinline__ void gemm_run_split(LAS unsigned char* lds, const bf16* A, const bf16* Bt, const bf16* A2, const bf16* Bt2, int M, int N, int K, const Epi& E) {
  pg8::Gemm g{A, Bt, M, N, K, A2, Bt2, K / 2};
  pg8::StaticOrder S;
  S.init(M, N, gridDim.x, blockIdx.x);
  pg8::gemm_phase<Epi, pg8::StaticOrder, false>(lds, g, S, E, nullptr);
}

struct PairOrder {
  int pm, pn0, csh;
  __device__ __forceinline__ bool next(int i, pg8::Unit& u) const { if (i >= (2 << csh)) return false; int pmv = pm + (i >> csh); asm volatile("" : "+s"(pmv)); u.pm = pmv; u.pn = pn0 + (i & ((1 << csh) - 1)); return true; }
  __device__ __forceinline__ void a_ready(const pg8::Unit&) const {}
  __device__ __forceinline__ void done(const pg8::Unit&) const {}
};
template <class Epi>
__device__ __forceinline__ void gemm_run_pair(LAS unsigned char* lds, const bf16* A, const bf16* Bt, int M, int N, int K, const Epi& E, int pm, int pn0, int csh) {
  pg8::Gemm g{A, Bt, M, N, K, A, Bt, K};
  PairOrder S{pm, pn0, csh};
  pg8::gemm_phase<Epi, PairOrder, false>(lds, g, S, E, nullptr);
}
template <class Epi>
__device__ __forceinline__ void gemm_run_split_pair(LAS unsigned char* lds, const bf16* A, const bf16* Bt, const bf16* A2, const bf16* Bt2, int M, int N, int K, const Epi& E, int pm, int pn0, int csh) {
  pg8::Gemm g{A, Bt, M, N, K, A2, Bt2, K / 2};
  PairOrder S{pm, pn0, csh};
  pg8::gemm_phase<Epi, PairOrder, false>(lds, g, S, E, nullptr);
}

typedef short bf16x8_t __attribute__((ext_vector_type(8)));
typedef __bf16 bf16x2_t __attribute__((ext_vector_type(2)));
__device__ __forceinline__ float dot2bf(unsigned a, unsigned b, float acc) {
  return __builtin_amdgcn_fdot2_f32_bf16(__builtin_bit_cast(bf16x2_t, a), __builtin_bit_cast(bf16x2_t, b), acc, false);
}
__device__ __forceinline__ void wave_lds_fence() { asm volatile("s_waitcnt lgkmcnt(0)" ::: "memory"); }
template <int N> __device__ __forceinline__ float row_ror(float x) {
  return __int_as_float(__builtin_amdgcn_update_dpp(0, __float_as_int(x), 0x120 + N, 0xf, 0xf, false));
}
__device__ __forceinline__ float row16_max(float m) {
  m = fmaxf(m, row_ror<8>(m)); m = fmaxf(m, row_ror<4>(m)); m = fmaxf(m, row_ror<2>(m)); m = fmaxf(m, row_ror<1>(m));
  return m;
}
__device__ __forceinline__ float row16_sum(float m) {
  m += row_ror<8>(m); m += row_ror<4>(m); m += row_ror<2>(m); m += row_ror<1>(m);
  return m;
}
__device__ __forceinline__ float wave_sum_dpp(float s) {
  s = row16_sum(s);
  const int si = __float_as_int(s);
  return __int_as_float(__builtin_amdgcn_readlane(si, 0)) + __int_as_float(__builtin_amdgcn_readlane(si, 16)) +
         (__int_as_float(__builtin_amdgcn_readlane(si, 32)) + __int_as_float(__builtin_amdgcn_readlane(si, 48)));
}
__device__ __forceinline__ constexpr int cand_i(int L) {
  return L < 16 ? 0 : L < 24 ? 1 : L < 29 ? 2 : L < 33 ? 3 : L < 36 ? 4 : L < 38 ? 5 : L < 40 ? 6 : L < 42 ? 7 : (L - 42 + 8);
}
__device__ __forceinline__ constexpr int cand_j(int L) {
  return L < 16 ? L : L < 24 ? L - 16 : L < 29 ? L - 24 : L < 33 ? L - 29 : L < 36 ? L - 33 : L < 38 ? L - 36 : L < 40 ? L - 38 : L < 42 ? L - 40 : 0;
}
template <int K> struct CandRank {
  static __device__ __forceinline__ void run(int ki, unsigned key, int& rank) {
    const unsigned o = (unsigned)__builtin_amdgcn_readlane(ki, K);
    rank += (o > key) ? 1 : 0;
    CandRank<K + 1>::run(ki, key, rank);
  }
};
template <> struct CandRank<50> { static __device__ __forceinline__ void run(int, unsigned, int&) {} };
__device__ __forceinline__ unsigned peer_f2ord(float f) {
  if (f == 0.f) f = 0.f;
  const unsigned u = __float_as_uint(f);
  return (u & 0x80000000u) ? ~u : (u | 0x80000000u);
}
__device__ __forceinline__ float peer_ord2f(unsigned u) { return __uint_as_float((u & 0x80000000u) ? (u ^ 0x80000000u) : ~u); }
__device__ __forceinline__ unsigned umax3(unsigned a, unsigned b, unsigned c) { const unsigned t = a > b ? a : b; return t > c ? t : c; }
template <int N> __device__ __forceinline__ unsigned row_ror_u(unsigned x) {
  return (unsigned)__builtin_amdgcn_update_dpp(0, (int)x, 0x120 + N, 0xf, 0xf, false);
}
__device__ __forceinline__ unsigned row16_umax(unsigned m) {
  unsigned t;
  t = row_ror_u<8>(m); m = t > m ? t : m; t = row_ror_u<4>(m); m = t > m ? t : m;
  t = row_ror_u<2>(m); m = t > m ? t : m; t = row_ror_u<1>(m); m = t > m ? t : m;
  return m;
}
__device__ __forceinline__ float gelu_exact(float v) { return 0.5f * v * (1.f + erff(v * 0.7071067811865476f)); }

typedef float f32x2_t __attribute__((ext_vector_type(2)));
typedef unsigned peer_u32x2 __attribute__((ext_vector_type(2)));
__device__ __forceinline__ float peer_fold32(float a, float b) {
  const peer_u32x2 r = __builtin_amdgcn_permlane32_swap(__float_as_uint(a), __float_as_uint(b), false, false);
  return __uint_as_float(r.x) + __uint_as_float(r.y);
}
__device__ __forceinline__ float peer_fold16(float a, float b) {
  const peer_u32x2 r = __builtin_amdgcn_permlane16_swap(__float_as_uint(a), __float_as_uint(b), false, false);
  return __uint_as_float(r.x) + __uint_as_float(r.y);
}
#define GAS __attribute__((address_space(1)))
#define PEER_NB 6
#define PEER_LOAD(buf, TAB, tk, e0)                                                               \
  {                                                                                               \
    const unsigned* rp_ = (const unsigned*)(ridx + ((tk) * 128 + (e0)));                          \
    const unsigned w0_ = rp_[0], w1_ = rp_[1], w2_ = rp_[2];                                      \
    const int i0_ = __builtin_amdgcn_readfirstlane((int)(w0_ & 0x3fffu)), i1_ = __builtin_amdgcn_readfirstlane((int)((w0_ >> 16) & 0x3fffu)); \
    const int i2_ = __builtin_amdgcn_readfirstlane((int)(w1_ & 0x3fffu)), i3_ = __builtin_amdgcn_readfirstlane((int)((w1_ >> 16) & 0x3fffu)); \
    const int i4_ = __builtin_amdgcn_readfirstlane((int)(w2_ & 0x3fffu)), i5_ = __builtin_amdgcn_readfirstlane((int)((w2_ >> 16) & 0x3fffu)); \
    buf[0] = *(const GAS u32x4_t*)((TAB) + (size_t)i0_ * 1024 + lane * 16);                       \
    buf[1] = *(const GAS u32x4_t*)((TAB) + (size_t)i1_ * 1024 + lane * 16);                       \
    buf[2] = *(const GAS u32x4_t*)((TAB) + (size_t)i2_ * 1024 + lane * 16);                       \
    buf[3] = *(const GAS u32x4_t*)((TAB) + (size_t)i3_ * 1024 + lane * 16);                       \
    buf[4] = *(const GAS u32x4_t*)((TAB) + (size_t)i4_ * 1024 + lane * 16);                       \
    buf[5] = *(const GAS u32x4_t*)((TAB) + (size_t)i5_ * 1024 + lane * 16);                       \
  }
#define PEER_UDOT(buf, e0, hfp, dotA, dotB)                                                                        \
  {                                                                                               \
    float sp[6];                                                                                  \
    _Pragma("unroll") for (int j = 0; j < 6; ++j) {                                               \
      f32x2_t s2 = (f32x2_t){0.f, 0.f};            \
      _Pragma("unroll") for (int w = 0; w < 4; ++w) {                                             \
        const f32x2_t lo = __builtin_amdgcn_cvt_pk_f32_fp8((int)buf[j][w], false);                \
        const f32x2_t hi = __builtin_amdgcn_cvt_pk_f32_fp8((int)buf[j][w], true);                 \
        s2 = __builtin_elementwise_fma(lo, hfp[2 * w], s2);                                       \
        s2 = __builtin_elementwise_fma(hi, hfp[2 * w + 1], s2);                                   \
      }                                                                                           \
      sp[j] = s2.x + s2.y;                                                                        \
    }                                                                                             \
    const float u01 = peer_fold32(sp[0], sp[1]), u23 = peer_fold32(sp[2], sp[3]), u45 = peer_fold32(sp[4], sp[5]); \
    const float wq = row16_sum(peer_fold16(u01, u23));     \
    const float wr = row16_sum(peer_fold16(u45, u45));         \
    const int wqi = __float_as_int(wq), wri = __float_as_int(wr);                                 \
    PEER_PUT((e0) + 0, __builtin_amdgcn_readlane(wqi, 0), dotA, dotB);                                        \
    PEER_PUT((e0) + 1, __builtin_amdgcn_readlane(wqi, 32), dotA, dotB);                                       \
    PEER_PUT((e0) + 2, __builtin_amdgcn_readlane(wqi, 16), dotA, dotB);                                       \
    PEER_PUT((e0) + 3, __builtin_amdgcn_readlane(wqi, 48), dotA, dotB);                                       \
    PEER_PUT((e0) + 4, __builtin_amdgcn_readlane(wri, 0), dotA, dotB);                                        \
    PEER_PUT((e0) + 5, __builtin_amdgcn_readlane(wri, 32), dotA, dotB);                                       \
  }
#define PEER_PUT(ee_, vi_, dotA, dotB)                                                                        \
  {                                                                                               \
    const int ee = (ee_); const float sv = __int_as_float(vi_);                                   \
    const bool mine = (lane == (ee & 63));                                                        \
    dotA = (mine && ee < 64) ? sv : dotA;                                                         \
    dotB = (mine && ee >= 64 && ee < 128) ? sv : dotB;                                            \
  }
#define PEER_VACC(buf, e0, aA, aB, acc)                                                                        \
  _Pragma("unroll") for (int j = 0; j < PEER_NB; ++j) {                                                 \
    const int ee = (e0) + j;                                                                      \
    const float a = (ee < 128) ? __int_as_float(__builtin_amdgcn_readlane(__float_as_int(ee < 64 ? aA : aB), ee & 63)) : 0.f; \
    _Pragma("unroll") for (int w = 0; w < 4; ++w) {                                               \
      const f32x2_t lo = __builtin_amdgcn_cvt_pk_f32_fp8((int)buf[j][w], false);                  \
      const f32x2_t hi = __builtin_amdgcn_cvt_pk_f32_fp8((int)buf[j][w], true);                   \
      acc[4 * w] += a * lo.x; acc[4 * w + 1] += a * lo.y; acc[4 * w + 2] += a * hi.x; acc[4 * w + 3] += a * hi.y; \
    }                                                                                             \
    __builtin_amdgcn_sched_barrier(0);                                                           \
  }

#ifndef PROBE_PEER
#define PROBE_PEER 0
#endif
#if PROBE_PEER
#define PEER_MARK(k) do { const unsigned long long n_ = __builtin_amdgcn_s_memrealtime(); if (PROBE_PEER == (k)) { const unsigned long long q_ = n_ - pmark; \
    while (__builtin_amdgcn_s_memrealtime() - n_ < q_) __builtin_amdgcn_s_sleep(2); } pmark = __builtin_amdgcn_s_memrealtime(); } while (0)
#else
#define PEER_MARK(k) do {} while (0)
#endif
__device__ __forceinline__ void ph_peer512(const P& p, unsigned char* lds_raw, float* dst_base, const XcdBarrier& xb, int vb) {
  const bool align_ok = ((TT / 16) % ((int)gridDim.x * 8)) == 0;
  const int wave0 = __builtin_amdgcn_readfirstlane(tid_fresh() >> 6);
  for (int tile = vb * 8 + wave0; tile < TT / 16; tile += gridDim.x * 8) {
    const int tok0 = tile * 16;
    const int tid = tid_fresh(), wave = __builtin_amdgcn_readfirstlane(tid >> 6), lane = tid & 63, g = lane >> 4, c = lane & 15;
    const bf16* PQ = (const bf16*)(p.ws + OFF_PQ);
    const bf16* SK = (const bf16*)(p.ws + OFF_SK);
    float* tv = (float*)(lds_raw + wave * 16384);
    int* ti = (int*)(tv + 512);
    float* rgate = (float*)(ti + 512);
    unsigned short* ridx = (unsigned short*)(rgate + 2048);
    LAS unsigned short* clut = (LAS unsigned short*)((LAS unsigned char*)lds_raw + 131072 + wave * 128);
    clut[lane] = (unsigned short)(cand_i(lane < 50 ? lane : 0) | (cand_j(lane < 50 ? lane : 0) << 4));
    unsigned cpk[4];
#pragma unroll
    for (int k = 0; k < 4; ++k) { const int L = (c + 16 * k < 50) ? c + 16 * k : 0; cpk[k] = (unsigned)(cand_i(L) | (cand_j(L) << 4)); }
    wave_lds_fence();
#if PROBE_PEER
    unsigned long long pmark = __builtin_amdgcn_s_memrealtime();
#endif
    unsigned* tk = (unsigned*)tv;
    unsigned* rk0 = (unsigned*)rgate;
    bf16x8_t an[4];
#pragma unroll
    for (int ks = 0; ks < 4; ++ks) an[ks] = *(const bf16x8_t*)(PQ + ((size_t)(tile * 64 + ks) * 64 + lane) * 8);
#pragma unroll 1
    for (int hf = 0; hf < 2; ++hf) {
      bf16x8_t bfr[4][8];
#pragma unroll
      for (int ks = 0; ks < 4; ++ks)
#pragma unroll
        for (int nt = 0; nt < 8; ++nt) bfr[ks][nt] = *(const bf16x8_t*)(SK + hf * 16384 + ((nt * 4 + ks) * 64 + lane) * 8);
#pragma unroll 1
      for (int hp = 0; hp < 4; ++hp) {
#pragma unroll 1
        for (int h2 = 0; h2 < 2; ++h2) {
          const int hd = 2 * hp + h2;
          f32x4 acc[8];
#pragma unroll
          for (int nt = 0; nt < 8; ++nt) acc[nt] = (f32x4){0.f, 0.f, 0.f, 0.f};
#pragma unroll
          for (int ks = 0; ks < 4; ++ks) {
#pragma unroll
            for (int nt = 0; nt < 8; ++nt) acc[nt] = __builtin_amdgcn_mfma_f32_16x16x32_bf16(an[ks], bfr[ks][nt], acc[nt], 0, 0, 0);
          }
          asm volatile("" :: "v"(acc[0][0]), "v"(acc[7][3]));
          {
            const int s1 = hf * 8 + hd + 1, sn = s1 < 16 ? s1 : 15, hdn = sn & 7, hfn = sn >> 3;
#pragma unroll
            for (int ks = 0; ks < 4; ++ks) an[ks] = *(const bf16x8_t*)(PQ + ((size_t)(tile * 64 + hdn * 8 + hfn * 4 + ks) * 64 + lane) * 8);
          }
          PEER_MARK(1);
          unsigned kq[4][8], res[4];
#pragma unroll
          for (int i = 0; i < 4; ++i) {
            res[i] = 0u;
#pragma unroll
            for (int nt = 0; nt < 8; ++nt) kq[i][nt] = (peer_f2ord(acc[nt][i]) & ~127u) | (unsigned)(127 - (16 * nt + c));
          }
#define PEER_CE(a_, b_) { const unsigned hi_ = (kq[i][a_] > kq[i][b_]) ? kq[i][a_] : kq[i][b_], lo_ = (kq[i][a_] > kq[i][b_]) ? kq[i][b_] : kq[i][a_]; kq[i][a_] = hi_; kq[i][b_] = lo_; }
#pragma unroll
          for (int i = 0; i < 4; ++i) {
            PEER_CE(0, 2) PEER_CE(1, 3) PEER_CE(4, 6) PEER_CE(5, 7)
            PEER_CE(0, 4) PEER_CE(1, 5) PEER_CE(2, 6) PEER_CE(3, 7)
            PEER_CE(0, 1) PEER_CE(2, 3) PEER_CE(4, 5) PEER_CE(6, 7)
            PEER_CE(2, 4) PEER_CE(3, 5)
            PEER_CE(1, 4) PEER_CE(3, 6)
            PEER_CE(1, 2) PEER_CE(3, 4) PEER_CE(5, 6)
          }
#undef PEER_CE
#pragma unroll 1
          for (int r = 0; r < 16; ++r) {
#pragma unroll
            for (int i = 0; i < 4; ++i) {
              const unsigned m = row16_umax(kq[i][0]);
              const bool mine = (kq[i][0] == m);
#pragma unroll
              for (int nt = 0; nt < 7; ++nt) kq[i][nt] = mine ? kq[i][nt + 1] : kq[i][nt];
              kq[i][7] = mine ? 0u : kq[i][7];
              res[i] = (c == r) ? m : res[i];
            }
          }
          unsigned* lp = (hf == 0) ? rk0 + hd * 16 : tk + h2 * 256;
          const int lst = (hf == 0) ? 128 : 16;
#pragma unroll
          for (int i = 0; i < 4; ++i) lp[(4 * g + i) * lst + c] = res[i];
        }
        if (hf == 1) {
          wave_lds_fence();
          PEER_MARK(2);
#pragma unroll 1
          for (int rb = 0; rb < 2; ++rb) {
            unsigned kk[4][4], res[4];
#pragma unroll
            for (int q = 0; q < 4; ++q) {
              const int row = 4 * (rb + 2 * (q >> 1)) + g, h2 = q & 1, hd = 2 * hp + h2;
              res[q] = 0u;
#pragma unroll
              for (int k = 0; k < 4; ++k) {
                const unsigned k1 = rk0[row * 128 + hd * 16 + (int)(cpk[k] & 15u)], k2 = tk[(h2 * 16 + row) * 16 + (int)((cpk[k] >> 4) & 15u)];
                const float val = peer_ord2f(k1 & ~127u) + peer_ord2f(k2 & ~127u);
                kk[q][k] = (c + 16 * k < 50) ? ((peer_f2ord(val) & ~63u) | (unsigned)(63 - (c + 16 * k))) : 0u;
              }
            }
#define PEER_CE4(a_, b_) { const unsigned hi_ = (kk[q][a_] > kk[q][b_]) ? kk[q][a_] : kk[q][b_], lo_ = (kk[q][a_] > kk[q][b_]) ? kk[q][b_] : kk[q][a_]; kk[q][a_] = hi_; kk[q][b_] = lo_; }
#pragma unroll
            for (int q = 0; q < 4; ++q) { PEER_CE4(0, 1) PEER_CE4(2, 3) PEER_CE4(0, 2) PEER_CE4(1, 3) PEER_CE4(1, 2) }
#undef PEER_CE4
#pragma unroll 1
            for (int r = 0; r < 16; ++r) {
#pragma unroll
              for (int q = 0; q < 4; ++q) {
                const unsigned m = row16_umax(kk[q][0]);
                const bool mine = (kk[q][0] == m);
                kk[q][0] = mine ? kk[q][1] : kk[q][0]; kk[q][1] = mine ? kk[q][2] : kk[q][1]; kk[q][2] = mine ? kk[q][3] : kk[q][2]; kk[q][3] = mine ? 0u : kk[q][3];
                res[q] = (c == r) ? m : res[q];
              }
            }
            unsigned k1v[4], k2v[4];
#pragma unroll
            for (int q = 0; q < 4; ++q) {
              const int row = 4 * (rb + 2 * (q >> 1)) + g, h2 = q & 1, hd = 2 * hp + h2;
              const unsigned e = (unsigned)clut[63 - (int)(res[q] & 63u)];
              k1v[q] = rk0[row * 128 + hd * 16 + (int)(e & 15u)]; k2v[q] = tk[(h2 * 16 + row) * 16 + (int)(e >> 4)];
            }
            wave_lds_fence();
#pragma unroll
            for (int q = 0; q < 4; ++q) {
              const int row = 4 * (rb + 2 * (q >> 1)) + g, h2 = q & 1, hd = 2 * hp + h2;
              rgate[row * 128 + hd * 16 + c] = peer_ord2f(k1v[q] & ~127u) + peer_ord2f(k2v[q] & ~127u);
              ridx[row * 128 + hd * 16 + c] = (unsigned short)((127 - (int)(k1v[q] & 127u)) * 128 + (127 - (int)(k2v[q] & 127u)));
            }
          }
          wave_lds_fence();
          PEER_MARK(3);
#pragma unroll
          for (int h2 = 0; h2 < 2; ++h2) {
            const int hd = 2 * hp + h2;
            const int row = lane >> 2, q = lane & 3;
            float* gp = rgate + row * 128 + hd * 16;
            const float mx = gp[0];
            const f32x4 b4 = *(const f32x4*)(gp + q * 4);
            f32x4 e4;
            e4[0] = __expf(b4[0] - mx); e4[1] = __expf(b4[1] - mx); e4[2] = __expf(b4[2] - mx); e4[3] = __expf(b4[3] - mx);
            float s = (e4[0] + e4[1]) + (e4[2] + e4[3]);
            s += __shfl_xor(s, 1); s += __shfl_xor(s, 2);
            const float inv = 1.f / s;
            wave_lds_fence();
            *(f32x4*)(gp + q * 4) = e4 * inv;
          }
          wave_lds_fence();
        }
      }
    }
#pragma unroll 1
    for (int tt = 0; tt < 16; ++tt) {
      const int ln = tid_fresh() & 63;
      unsigned e0 = ridx[tt * 128 + ln], e1 = ridx[tt * 128 + 64 + ln];
      float g0 = rgate[tt * 128 + ln], g1 = rgate[tt * 128 + 64 + ln];
      unsigned pos0, pos1;
#define PEER_DIGIT_PASS(SH, ND)                                                                                   \
      {                                                                                                           \
        const unsigned b0 = (e0 >> (SH)) & ((ND) - 1u), b1 = (e1 >> (SH)) & ((ND) - 1u);                            \
        unsigned base = 0u; pos0 = 0u; pos1 = 0u;                                                                 \
        _Pragma("unroll") for (unsigned b = 0; b < (ND); ++b) {                                                   \
          const unsigned long long m0 = __builtin_amdgcn_ballot_w64(b0 == b), m1 = __builtin_amdgcn_ballot_w64(b1 == b); \
          const unsigned c0 = (unsigned)__builtin_popcountll(m0), c1 = (unsigned)__builtin_popcountll(m1);        \
          const unsigned r0 = __builtin_amdgcn_mbcnt_hi((unsigned)(m0 >> 32), __builtin_amdgcn_mbcnt_lo((unsigned)m0, 0u)); \
          const unsigned r1 = __builtin_amdgcn_mbcnt_hi((unsigned)(m1 >> 32), __builtin_amdgcn_mbcnt_lo((unsigned)m1, 0u)); \
          pos0 = (b0 == b) ? base + r0 : pos0;                                                                    \
          pos1 = (b1 == b) ? base + c0 + r1 : pos1;                                                               \
          base += c0 + c1;                                                                                        \
        }                                                                                                         \
      }
      PEER_DIGIT_PASS(9, 4u)
      ridx[tt * 128 + pos0] = (unsigned short)e0; ridx[tt * 128 + pos1] = (unsigned short)e1;
      rgate[tt * 128 + pos0] = g0; rgate[tt * 128 + pos1] = g1;
      wave_lds_fence();
      e0 = ridx[tt * 128 + ln]; e1 = ridx[tt * 128 + 64 + ln];
      g0 = rgate[tt * 128 + ln]; g1 = rgate[tt * 128 + 64 + ln];
      wave_lds_fence();
      PEER_DIGIT_PASS(11, 8u)
#undef PEER_DIGIT_PASS
      ridx[tt * 128 + pos0] = (unsigned short)e0; ridx[tt * 128 + pos1] = (unsigned short)e1;
      rgate[tt * 128 + pos0] = g0; rgate[tt * 128 + pos1] = g1;
    }
    wave_lds_fence();
    char* wsl = p.ws;
    asm volatile("" : "+s"(wsl));
    const GAS bf16* H2 = (const GAS bf16*)(wsl + OFF_H);
    const GAS unsigned char* PU = (const GAS unsigned char*)(wsl + OFF_PU);
    const GAS unsigned char* PV = (const GAS unsigned char*)(wsl + OFF_PV);
    const GAS float* USC = (const GAS float*)(wsl + OFF_PSC);
    const GAS float* VSC = USC + 16384;
    const GAS float* ada = (const GAS float*)(wsl + OFF_ADA);
#define PEER_T 2
    u32x4_t a0[PEER_NB], a1[PEER_NB], hq[PEER_T][2];
#define PSB() __builtin_amdgcn_sched_barrier(0)
#define PEER_ROW16(dst, rowp)                                                                     \
  {                                                                                               \
    const GAS bf16* rp16_ = (rowp) + 4 * lane;                                                    \
    const peer_u32x2 q0_ = *(const GAS peer_u32x2*)rp16_, q1_ = *(const GAS peer_u32x2*)(rp16_ + 256);                     \
    const peer_u32x2 q2_ = *(const GAS peer_u32x2*)(rp16_ + 512), q3_ = *(const GAS peer_u32x2*)(rp16_ + 768);             \
    dst[0] = (u32x4_t){q0_.x, q0_.y, q1_.x, q1_.y}; dst[1] = (u32x4_t){q2_.x, q2_.y, q3_.x, q3_.y};                        \
  }
#define PEER_ROWS (((128 + 2 * PEER_NB - 1) / (2 * PEER_NB)) * 2 * PEER_NB)
    {
      const int tidx = tid_fresh(), lane = tidx & 63, wv = __builtin_amdgcn_readfirstlane(tidx >> 6);
      const unsigned short* ridx = (const unsigned short*)(lds_raw + wv * 16384 + 4096 + 8192);
#pragma unroll
      for (int k = 0; k < PEER_T; ++k) {
        PEER_ROW16(hq[k], H2 + ((size_t)tok0 + k) * 1024)
      }
      PEER_LOAD(a0, PU, 0, 0); PSB();
      PEER_LOAD(a1, PU, 0, PEER_NB); PSB();
    }
#pragma unroll 1
    for (int grp = 0; grp < 16 / PEER_T; ++grp) {
      if (align_ok) xcd_align(xb);
      const int tidx = tid_fresh(), lane = tidx & 63, wv = __builtin_amdgcn_readfirstlane(tidx >> 6);
      const float* rgate = (const float*)(lds_raw + wv * 16384 + 4096);
      const unsigned short* ridx = (const unsigned short*)(lds_raw + wv * 16384 + 4096 + 8192);
      const int t0g = grp * PEER_T, t0n = (grp + 1 < 16 / PEER_T) ? t0g + PEER_T : t0g;
      f32x2_t hfp[PEER_T][8];
      float usA[PEER_T], usB[PEER_T], vsA[PEER_T], vsB[PEER_T], dotA[PEER_T], dotB[PEER_T];
#pragma unroll
      for (int k = 0; k < PEER_T; ++k) {
#pragma unroll
        for (int w = 0; w < 4; ++w) { hfp[k][w] = (f32x2_t){bflo(hq[k][0][w]), bfhi(hq[k][0][w])}; hfp[k][4 + w] = (f32x2_t){bflo(hq[k][1][w]), bfhi(hq[k][1][w])}; }
        usA[k] = USC[(int)ridx[(t0g + k) * 128 + lane]]; usB[k] = USC[(int)ridx[(t0g + k) * 128 + 64 + lane]];
        vsA[k] = VSC[(int)ridx[(t0g + k) * 128 + lane]]; vsB[k] = VSC[(int)ridx[(t0g + k) * 128 + 64 + lane]];
        dotA[k] = 0.f; dotB[k] = 0.f;
      }
#pragma unroll 1
      for (int e0 = 0; e0 < PEER_ROWS; e0 += 2 * PEER_NB) {
        const bool more = e0 + 2 * PEER_NB < PEER_ROWS;
#pragma unroll
        for (int k = 0; k < PEER_T; ++k) {
          const bool lastk = (k == PEER_T - 1);
          const GAS unsigned char* tb = (!lastk || more) ? PU : PV;
          const int tkn = lastk ? t0g : t0g + k + 1, r0 = lastk ? (more ? e0 + 2 * PEER_NB : 0) : e0;
          PEER_UDOT(a0, e0, hfp[k], dotA[k], dotB[k]); PSB();
          PEER_LOAD(a0, tb, tkn, r0); PSB();
          PEER_UDOT(a1, e0 + PEER_NB, hfp[k], dotA[k], dotB[k]); PSB();
          PEER_LOAD(a1, tb, tkn, r0 + PEER_NB); PSB();
        }
      }
      float aA[PEER_T], aB[PEER_T];
#pragma unroll
      for (int k = 0; k < PEER_T; ++k) {
        aA[k] = gelu_exact(dotA[k] * usA[k]) * rgate[(t0g + k) * 128 + lane] * vsA[k];
        aB[k] = gelu_exact(dotB[k] * usB[k]) * rgate[(t0g + k) * 128 + 64 + lane] * vsB[k];
      }
      float acc[PEER_T][16];
      u32x4_t xq[PEER_T][2];
#pragma unroll
      for (int k = 0; k < PEER_T; ++k) {
        PEER_ROW16(xq[k], (const GAS bf16*)(wsl + OFF_X1) + ((size_t)tok0 + t0g + k) * 1024)
#pragma unroll
        for (int i = 0; i < 16; ++i) acc[k][i] = 0.f;
        PEER_ROW16(hq[k], H2 + ((size_t)tok0 + t0n + k) * 1024)
      }
      PSB();
#pragma unroll 1
      for (int e0 = 0; e0 < PEER_ROWS; e0 += 2 * PEER_NB) {
        const bool more = e0 + 2 * PEER_NB < PEER_ROWS;
#pragma unroll
        for (int k = 0; k < PEER_T; ++k) {
          const bool lastk = (k == PEER_T - 1);
          const GAS unsigned char* tb = (!lastk || more) ? PV : PU;
          const int tkn = lastk ? (more ? t0g : t0n) : t0g + k + 1, r0 = lastk ? (more ? e0 + 2 * PEER_NB : 0) : e0;
          PEER_VACC(a0, e0, aA[k], aB[k], acc[k]); PSB();
          PEER_LOAD(a0, tb, tkn, r0); PSB();
          PEER_VACC(a1, e0 + PEER_NB, aA[k], aB[k], acc[k]); PSB();
          PEER_LOAD(a1, tb, tkn, r0 + PEER_NB); PSB();
        }
      }
#pragma unroll
      for (int k = 0; k < PEER_T; ++k) {
        const size_t tok = (size_t)tok0 + t0g + k;
        const int b = (int)(tok >> 12);
        const u32x4_t xw0 = xq[k][0], xw1 = xq[k][1];
        GAS float* orow = (GAS float*)dst_base + tok * 1024;
        const GAS float* g2 = ada + b * 6144 + 5120;
        float x2[16];
        float ss = 0.f;
#pragma unroll
        for (int q = 0; q < 4; ++q) {
          const int col = 256 * q + 4 * lane;
          const unsigned xa = (q < 2) ? xw0[2 * (q & 1)] : xw1[2 * (q & 1)], xc = (q < 2) ? xw0[2 * (q & 1) + 1] : xw1[2 * (q & 1) + 1];
          const f32x4 xv = (f32x4){bflo(xa), bfhi(xa), bflo(xc), bfhi(xc)}, gv = *(const GAS f32x4*)(g2 + col);
#pragma unroll
          for (int i = 0; i < 4; ++i) { const float t = xv[i] + gv[i] * acc[k][q * 4 + i]; x2[q * 4 + i] = t; ss += t * t; }
        }
        ss = wave_sum_dpp(ss);
        const float rstd = rsqrtf(ss * (1.f / 1024.f) + 1e-6f);
#pragma unroll
        for (int q = 0; q < 4; ++q) {
          const int col = 256 * q + 4 * lane;
          const f32x4 fg = *(const GAS f32x4*)((const GAS float*)(wsl + OFF_PRM) + PRM_FG + col);
          f32x4 o;
#pragma unroll
          for (int i = 0; i < 4; ++i) o[i] = x2[q * 4 + i] * rstd * fg[i];
          *(GAS f32x4*)(orow + col) = o;
        }
      }
    }
    wave_lds_fence();
  }
}

#define DS_KEY16   0
#define DS_CHUNK   17408
#define DS_SEL     139264
#define DS_WAVE    147456
#define DS_TOTAL   155648
#define DS_RS      544

__device__ __forceinline__ unsigned f2ord(float f) {
  if (f == 0.f) f = 0.f;
  unsigned u = __float_as_uint(f);
  return (u & 0x80000000u) ? ~u : (u | 0x80000000u);
}
__device__ __forceinline__ int wave_scan_incl(int v, int lane) {
#pragma unroll
  for (int o = 1; o < 64; o <<= 1) { const int t = __shfl_up(v, o); v += (lane >= o) ? t : 0; }
  return v;
}
__device__ __forceinline__ void find_digit(const LAS unsigned* hist, int K, int lane, int& digit, int& above) {
  const u32x4_t h4 = *(const LAS u32x4_t*)(hist + 252 - 4 * lane);
  const int c0 = (int)h4.w, c1 = (int)h4.z, c2 = (int)h4.y, c3 = (int)h4.x;
  const int tot = c0 + c1 + c2 + c3;
  int run = wave_scan_incl(tot, lane) - tot;
  int found = -1, ab = 0;
  if (run < K && run + c0 >= K) { found = 255 - 4 * lane; ab = run; } run += c0;
  if (run < K && run + c1 >= K) { found = 254 - 4 * lane; ab = run; } run += c1;
  if (run < K && run + c2 >= K) { found = 253 - 4 * lane; ab = run; } run += c2;
  if (run < K && run + c3 >= K) { found = 252 - 4 * lane; ab = run; }
  const unsigned long long mk = __ballot(found >= 0);
  const int src = (int)__ffsll((unsigned long long)mk) - 1;
  digit = __builtin_amdgcn_readlane(found, src);
  above = __builtin_amdgcn_readlane(ab, src);
}

typedef unsigned u32x2_t __attribute__((ext_vector_type(2)));
__device__ __forceinline__ float xrow_max(float x) {
  u32x2_t r = __builtin_amdgcn_permlane16_swap(__float_as_uint(x), __float_as_uint(x), false, false);
  x = fmaxf(__uint_as_float(r.x), __uint_as_float(r.y));
  r = __builtin_amdgcn_permlane32_swap(__float_as_uint(x), __float_as_uint(x), false, false);
  return fmaxf(__uint_as_float(r.x), __uint_as_float(r.y));
}
__device__ __forceinline__ float xrow_sum(float x) {
  u32x2_t r = __builtin_amdgcn_permlane16_swap(__float_as_uint(x), __float_as_uint(x), false, false);
  x = __uint_as_float(r.x) + __uint_as_float(r.y);
  r = __builtin_amdgcn_permlane32_swap(__float_as_uint(x), __float_as_uint(x), false, false);
  return __uint_as_float(r.x) + __uint_as_float(r.y);
}
template <int OFF> __device__ __forceinline__ s16x4_t tr_read_b64o(unsigned addr) {
  s16x4_t r; asm volatile("ds_read_b64_tr_b16 %0, %1 offset:%2" : "=&v"(r) : "v"(addr), "n"(OFF) : "memory"); return r;
}
__device__ __forceinline__ s16x4_t tr_read_b64(unsigned addr) {
  s16x4_t r; asm volatile("ds_read_b64_tr_b16 %0, %1" : "=&v"(r) : "v"(addr) : "memory"); return r;
}

#ifndef PROBE_DSA
#define PROBE_DSA 0
#endif
#if PROBE_DSA
#define DSA_MARK(k) do { const unsigned long long n_ = __builtin_amdgcn_s_memrealtime(); if (PROBE_DSA == (k)) { const unsigned long long q_ = n_ - tmark; \
    while (__builtin_amdgcn_s_memrealtime() - n_ < q_) __builtin_amdgcn_s_sleep(2); } tmark = __builtin_amdgcn_s_memrealtime(); } while (0)
#else
#define DSA_MARK(k) do {} while (0)
#endif
#if PROBE_DSA >= 10
#define DSA_MARKI(k) DSA_MARK(k)
#else
#define DSA_MARKI(k) do {} while (0)
#endif
__device__ __forceinline__ int dsa_wave_sum_i(int s) {
  s += __builtin_amdgcn_update_dpp(0, s, 0x128, 0xf, 0xf, false); s += __builtin_amdgcn_update_dpp(0, s, 0x124, 0xf, 0xf, false);
  s += __builtin_amdgcn_update_dpp(0, s, 0x122, 0xf, 0xf, false); s += __builtin_amdgcn_update_dpp(0, s, 0x121, 0xf, 0xf, false);
  return __builtin_amdgcn_readlane(s, 0) + __builtin_amdgcn_readlane(s, 16) + (__builtin_amdgcn_readlane(s, 32) + __builtin_amdgcn_readlane(s, 48));
}
__device__ __forceinline__ void dsa_batch(const P& p, unsigned char* lds_raw, int b, int pos2) {
  const int t00 = pos2 * 32;
#define DSA_IDS const int tid = tid_fresh(), wave = __builtin_amdgcn_readfirstlane(tid >> 6), lane = tid & 63, g = lane >> 4, c = lane & 15; (void)wave; (void)g; (void)c;
  const size_t tokb = (size_t)b * SEQ, tok00 = tokb + t00;
  const bf16* DQ = (const bf16*)(p.ws + OFF_DQ);
  const bf16* CKV = (const bf16*)(p.ws + OFF_CKV);
  const float* SSP = (const float*)(p.ws + OFF_SSP);
  const bf16* IQ = (const bf16*)(p.ws + OFF_IQ);
  const bf16* IK = (const bf16*)(p.ws + OFF_IK);
  const float* IW = (const float*)(p.ws + OFF_IW);
  const bf16* WUK = (const bf16*)(p.ws + OFF_WUK);
  const bf16* WUV = (const bf16*)(p.ws + OFF_WUV);
  bf16* ODSA = (bf16*)(p.ws + OFF_ODSA);
  bf16* QL = (bf16*)(p.ws + OFF_DSCR + (size_t)blockIdx.x * 131072);
  bf16* OL = QL;
  LAS unsigned char* lds = (LAS unsigned char*)lds_raw;
  LAS unsigned short* key16 = (LAS unsigned short*)(lds + DS_KEY16);
  LAS unsigned short* sel = (LAS unsigned short*)(lds + DS_SEL);

#if PROBE_DSA
  unsigned long long tmark = __builtin_amdgcn_s_memrealtime();
#endif
  {
    DSA_IDS
    const int h = wave;
    LAS unsigned char* tbA = lds + DS_KEY16 + wave * DS_CHUNK;
    bf16x8_t dq0[4], dq1[4];
#pragma unroll
    for (int ks = 0; ks < 4; ++ks) {
      dq0[ks] = *(const bf16x8_t*)(DQ + (((tok00 >> 4) * 32 + h * 4 + ks) * 64 + lane) * 8);
      dq1[ks] = *(const bf16x8_t*)(DQ + ((((tok00 >> 4) + 1) * 32 + h * 4 + ks) * 64 + lane) * 8);
    }
    {
      bf16x8_t wA[4][4], wB[4][4];
#define DSA_A_LOAD(W, q)                                                                                          \
      _Pragma("unroll") for (int n4 = 0; n4 < 4; ++n4)                                                            \
        _Pragma("unroll") for (int ks = 0; ks < 4; ++ks) W[n4][ks] = *(const bf16x8_t*)(WUK + (size_t)((h * 16 + (q) * 4 + n4) * 4 + ks) * 512 + lane * 8);
#define DSA_A_COMP(W, q)                                                                                          \
      _Pragma("unroll") for (int n4 = 0; n4 < 4; ++n4) {                                                          \
        const int nt = (q) * 4 + n4;                                                                              \
        f32x4 a0 = (f32x4){0.f, 0.f, 0.f, 0.f}, a1 = a0;                                                          \
        _Pragma("unroll") for (int ks = 0; ks < 4; ++ks) {                                                        \
          a0 = __builtin_amdgcn_mfma_f32_16x16x32_bf16(W[n4][ks], dq0[ks], a0, 0, 0, 0);                          \
          a1 = __builtin_amdgcn_mfma_f32_16x16x32_bf16(W[n4][ks], dq1[ks], a1, 0, 0, 0);                          \
        }                                                                                                         \
          \
        u32x2_t o; o.x = pk2(a0[0], a0[1]); o.y = pk2(a0[2], a0[3]);                                              \
        *(LAS u32x2_t*)(tbA + c * 528 + (nt * 16 + 4 * g) * 2) = o;                                               \
        o.x = pk2(a1[0], a1[1]); o.y = pk2(a1[2], a1[3]);                                                         \
        *(LAS u32x2_t*)(tbA + (16 + c) * 528 + (nt * 16 + 4 * g) * 2) = o;                                        \
      }
      DSA_A_LOAD(wA, 0) DSA_A_LOAD(wB, 1) __builtin_amdgcn_sched_barrier(0);
      DSA_A_COMP(wA, 0) __builtin_amdgcn_sched_barrier(0); DSA_A_LOAD(wA, 2) __builtin_amdgcn_sched_barrier(0);
      DSA_A_COMP(wB, 1) __builtin_amdgcn_sched_barrier(0); DSA_A_LOAD(wB, 3) __builtin_amdgcn_sched_barrier(0);
      DSA_A_COMP(wA, 2) __builtin_amdgcn_sched_barrier(0);
      DSA_A_COMP(wB, 3) __builtin_amdgcn_sched_barrier(0);
#undef DSA_A_LOAD
#undef DSA_A_COMP
    }
    wave_lds_fence();
#pragma unroll
    for (int it = 0; it < 16; ++it) {
      const int qr = it * 2 + (lane >> 5);
      const u32x4_t v = *(const LAS u32x4_t*)(tbA + qr * 528 + (lane & 31) * 16);
      *(u32x4_t*)(QL + qr * 2048 + h * 256 + (lane & 31) * 8) = v;
    }
  }
  DSA_MARK(1);
  LDS_BAR();
#pragma unroll 1
  for (int half = 0; half < 2; ++half) {
  const int t0 = t00 + 16 * half;
  const size_t tok0 = tokb + t0;
  bf16* QLh = QL + half * 16 * 2048;
  bf16* OLh = QLh;
  if (t0 >= 256) {
    DSA_IDS
    bf16x8_t qf[8][2];
    float iw[8];
#pragma unroll
    for (int h = 0; h < 8; ++h) {
      qf[h][0] = *(const bf16x8_t*)(IQ + (((tok0 >> 4) * 16 + h * 2) * 64 + lane) * 8);
      qf[h][1] = *(const bf16x8_t*)(IQ + (((tok0 >> 4) * 16 + h * 2 + 1) * 64 + lane) * 8);
      iw[h] = IW[(tok0 + c) * 8 + h];
    }
    const int ntile = (t0 >> 4) + 1;
    bf16x8_t k0n = (bf16x8_t){0, 0, 0, 0, 0, 0, 0, 0}, k1n = k0n;
    if (wave < ntile) { const bf16* kr = IK + ((((tokb >> 4) + wave) * 2) * 64 + lane) * 8; k0n = *(const bf16x8_t*)kr; k1n = *(const bf16x8_t*)(kr + 512); }
    for (int kt = wave; kt < ntile; kt += 8) {
      const bf16x8_t k0 = k0n, k1 = k1n;
      { const int ktn = (kt + 8 < ntile) ? kt + 8 : kt; const bf16* kr = IK + ((((tokb >> 4) + ktn) * 2) * 64 + lane) * 8; k0n = *(const bf16x8_t*)kr; k1n = *(const bf16x8_t*)(kr + 512); }
      f32x4 sc = (f32x4){0.f, 0.f, 0.f, 0.f};
#pragma unroll
      for (int h = 0; h < 8; ++h) {
        f32x4 d = __builtin_amdgcn_mfma_f32_16x16x32_bf16(k0, qf[h][0], (f32x4){0.f, 0.f, 0.f, 0.f}, 0, 0, 0);
        d = __builtin_amdgcn_mfma_f32_16x16x32_bf16(k1, qf[h][1], d, 0, 0, 0);
#pragma unroll
        for (int i = 0; i < 4; ++i) sc[i] += iw[h] * fmaxf(d[i], 0.f);
      }
      u16x4_t o;
      const int sb = kt * 16 + 4 * g, tq = t0 + c;
      o.x = (sb + 0 <= tq) ? (unsigned short)(f2ord(sc[0]) >> 16) : (unsigned short)0;
      o.y = (sb + 1 <= tq) ? (unsigned short)(f2ord(sc[1]) >> 16) : (unsigned short)0;
      o.z = (sb + 2 <= tq) ? (unsigned short)(f2ord(sc[2]) >> 16) : (unsigned short)0;
      o.w = (sb + 3 <= tq) ? (unsigned short)(f2ord(sc[3]) >> 16) : (unsigned short)0;
      *(LAS u16x4_t*)(key16 + c * 4096 + sb) = o;
    }
  }
  DSA_MARK(2);
  LDS_BAR();
#pragma unroll 1
  for (int qq = 0; qq < 2; ++qq) {
    DSA_IDS
    const int q = wave + 8 * qq, t = t0 + q;
    LAS unsigned short* selq = sel + q * 256;
    if (t < 256) {
      for (int j = lane; j < 256; j += 64) selq[j] = (unsigned short)((j <= t) ? j : 0);
    } else {
      const LAS unsigned short* kq = key16 + q * 4096;
      LAS unsigned short* tdummy = (LAS unsigned short*)(lds + DS_WAVE + wave * 1024) + lane;
      const int nit = (t >> 9) + 1;
      unsigned kp[8][4];
#pragma unroll
      for (int it = 0; it < 8; ++it) {
        const int s0 = 512 * it + 8 * lane;
        u32x4_t v = (u32x4_t){0u, 0u, 0u, 0u};
        if (s0 <= t) v = *(const LAS u32x4_t*)(kq + s0);
#pragma unroll
        for (int j = 0; j < 4; ++j) kp[it][j] = v[j];
      }
      asm volatile("" :: "v"(kp[0][0]), "v"(kp[7][3]));
      DSA_MARKI(21);
      unsigned B = 0u;
#pragma unroll 1
      for (int bit = 15; bit >= 0; --bit) {
        const unsigned cand = B | (1u << bit);
        const unsigned c2 = (cand - 1u) * 0x00010001u;
        unsigned cnt2 = 0u;
#pragma unroll
        for (int it = 0; it < 8; ++it) {
          if (it < nit) {
#pragma unroll
            for (int j = 0; j < 4; ++j) {
              unsigned dd;
              asm("v_pk_sub_u16 %0, %1, %2 clamp\n\tv_pk_min_u16 %0, %0, %3" : "=&v"(dd) : "v"(kp[it][j]), "v"(c2), "v"(0x00010001u));
              cnt2 += dd;
            }
          }
        }
        const int tot = dsa_wave_sum_i((int)((cnt2 & 0xffffu) + (cnt2 >> 16)));
        if (tot >= 256) B = cand;
      }
      int cgt = 0;
#pragma unroll
      for (int it = 0; it < 8; ++it)
#pragma unroll
        for (int j = 0; j < 4; ++j) cgt += (((kp[it][j] & 0xffffu) > B) ? 1 : 0) + (((kp[it][j] >> 16) > B) ? 1 : 0);
      const int m = 256 - dsa_wave_sum_i(cgt);
      DSA_MARKI(22);
      int base = 0, eqbase = 0;
#pragma unroll
      for (int it = 0; it < 8; ++it) {
        if (it < nit) {
          unsigned kk[8];
#pragma unroll
          for (int j = 0; j < 4; ++j) { kk[2 * j] = kp[it][j] & 0xffffu; kk[2 * j + 1] = kp[it][j] >> 16; }
          unsigned anyeq = 0u;
#pragma unroll
          for (int j = 0; j < 8; ++j) anyeq |= (kk[j] == B) ? 1u : 0u;
          int eqlow = 0, eqtot = 0;
          if (__builtin_amdgcn_ballot_w64(anyeq != 0u) != 0ull) {
#pragma unroll
            for (int j = 0; j < 8; ++j) {
              const unsigned long long mk = __builtin_amdgcn_ballot_w64(kk[j] == B);
              eqlow += (int)__builtin_amdgcn_mbcnt_hi((unsigned)(mk >> 32), __builtin_amdgcn_mbcnt_lo((unsigned)mk, 0u));
              eqtot += __builtin_popcountll(mk);
            }
          }
          int eqr = eqbase + eqlow;
          int ps = base, tot = 0;
          bool tk[8];
#pragma unroll
          for (int j = 0; j < 8; ++j) {
            const bool eq = kk[j] == B;
            tk[j] = (kk[j] > B) || (eq && eqr < m);
            eqr += eq ? 1 : 0;
          }
#pragma unroll
          for (int j = 0; j < 8; ++j) {
            const unsigned long long mk = __builtin_amdgcn_ballot_w64(tk[j]);
            ps += (int)__builtin_amdgcn_mbcnt_hi((unsigned)(mk >> 32), __builtin_amdgcn_mbcnt_lo((unsigned)mk, 0u));
            tot += __builtin_popcountll(mk);
          }
#pragma unroll
          for (int j = 0; j < 8; ++j) {
            LAS unsigned short* dstp = tk[j] ? selq + ps : tdummy;
            *dstp = (unsigned short)(512 * it + 8 * lane + j);
            ps += tk[j] ? 1 : 0;
          }
          base += tot;
          eqbase += eqtot;
        }
      }
    }
  }
  DSA_MARK(3);
  __syncthreads();
  {
    DSA_IDS
    const int wave_b = wave;
    const float slope = (c < 8) ? exp2f(-(float)(c + 1)) : 0.f;
#pragma unroll 1
    for (int qq = 0; qq < 2; ++qq) {
      const int q = wave + 8 * qq, t = t0 + q;
      const int nsel = (t + 1 < 256) ? (t + 1) : 256, nch = (nsel + 31) >> 5;
      const LAS unsigned short* selq = sel + q * 256;
      bf16x8_t qf[8];
      u32x4_t qraw[4];
      {
        const int lq = tid_fresh() & 63;
#pragma unroll
        for (int it = 0; it < 4; ++it) qraw[it] = *(const u32x4_t*)(QLh + q * 2048 + it * 512 + lq * 8);
      }
      float mrun = -1e30f, lrun = 0.f;
      f32x4 o[16];
#pragma unroll
      for (int nt = 0; nt < 16; ++nt) o[nt] = (f32x4){0.f, 0.f, 0.f, 0.f};
      u32x4_t st[16];
      f32x4 st_ss = (f32x4){0.f, 0.f, 0.f, 0.f}; float st_d = -1.f;
#define DSA_ISSUE(ch)                                                                                   \
      {          \
        const LAS u32x4_t* sp_ = (const LAS u32x4_t*)(selq + (ch) * 32);     \
        const unsigned sh_ = (unsigned)(lane >> 5) * 16u;                                               \
        _Pragma("unroll") for (int r4 = 0; r4 < 4; ++r4) {                                              \
          const u32x4_t w_ = sp_[r4];                                                                   \
          _Pragma("unroll") for (int j = 0; j < 4; ++j) {                                               \
            const int idx = (int)((w_[j] >> sh_) & 0xffffu);     \
            st[4 * r4 + j] = *(const u32x4_t*)(CKV + (tokb + idx) * 256 + (lane & 31) * 8);             \
          }                                                                                             \
        }                                                                                               \
        const int j2 = (ch) * 32 + (lane & 31);                                                         \
        const int idx2 = (int)selq[j2];                                                                 \
        st_ss = *(const f32x4*)(SSP + (tokb + idx2) * 4);                                               \
        st_d = (j2 < nsel) ? (float)(t - idx2) : -1.f;                                                  \
      }
      DSA_ISSUE(0);
      {
        const int lq = tid_fresh() & 63;
        LAS unsigned char* tbq = lds + DS_KEY16 + wave_b * DS_CHUNK;
#pragma unroll
        for (int it = 0; it < 4; ++it) *(LAS u32x4_t*)(tbq + (it * 2 + (lq >> 5)) * 528 + (lq & 31) * 16) = qraw[it];
        wave_lds_fence();
#pragma unroll
        for (int ks = 0; ks < 8; ++ks) qf[ks] = *(const LAS bf16x8_t*)(tbq + (lq & 7) * 528 + (ks * 32 + 8 * (lq >> 4)) * 2);
        wave_lds_fence();
      }
#pragma unroll 1
      for (int ch = 0; ch < nch; ++ch) {
        const int lane = tid_fresh() & 63, g = lane >> 4, c = lane & 15;
        LAS unsigned char* buf = lds + DS_KEY16 + wave_b * DS_CHUNK;
        LAS float* kr = (LAS float*)(lds + DS_WAVE + wave_b * 1024);
        LAS float* kd = kr + 32;
        const unsigned vb = (unsigned)(uintptr_t)buf + (unsigned)((4 * g + (c >> 2)) * DS_RS + 8 * (c & 3));
#pragma unroll
        for (int r = 0; r < 16; ++r) *(LAS u32x4_t*)(buf + (2 * r + (lane >> 5)) * DS_RS + (lane & 31) * 16) = st[r];
        if (lane < 32) { kr[lane] = rsqrtf(((st_ss[0] + st_ss[1]) + (st_ss[2] + st_ss[3])) * (1.f / 256.f) + 1e-6f); kd[lane] = st_d; }
        wave_lds_fence();
        DSA_MARKI(11);
        DSA_ISSUE((ch + 1 < nch) ? ch + 1 : ch);
        f32x4 s0 = (f32x4){0.f, 0.f, 0.f, 0.f}, s1 = (f32x4){0.f, 0.f, 0.f, 0.f};
#pragma unroll
        for (int ks = 0; ks < 8; ++ks) {
          const bf16x8_t a0 = *(const LAS bf16x8_t*)(buf + c * DS_RS + (ks * 32 + 8 * g) * 2);
          const bf16x8_t a1 = *(const LAS bf16x8_t*)(buf + (16 + c) * DS_RS + (ks * 32 + 8 * g) * 2);
          s0 = __builtin_amdgcn_mfma_f32_16x16x32_bf16(a0, qf[ks], s0, 0, 0, 0);
          s1 = __builtin_amdgcn_mfma_f32_16x16x32_bf16(a1, qf[ks], s1, 0, 0, 0);
        }
        asm volatile("" :: "v"(s0[0]), "v"(s1[0]));
        DSA_MARKI(12);
        const f32x4 r0 = *(const LAS f32x4*)(kr + 4 * g), r1 = *(const LAS f32x4*)(kr + 16 + 4 * g);
        const f32x4 d0 = *(const LAS f32x4*)(kd + 4 * g), d1 = *(const LAS f32x4*)(kd + 16 + 4 * g);
        float x[8];
#pragma unroll
        for (int i = 0; i < 4; ++i) {
          x[i] = (d0[i] < 0.f) ? -1e30f : (s0[i] * r0[i] - slope * d0[i]);
          x[4 + i] = (d1[i] < 0.f) ? -1e30f : (s1[i] * r1[i] - slope * d1[i]);
        }
        float mx = fmaxf(fmaxf(fmaxf(x[0], x[1]), fmaxf(x[2], x[3])), fmaxf(fmaxf(x[4], x[5]), fmaxf(x[6], x[7])));
        mx = xrow_max(mx);
        const float mn = (mx > mrun + 8.f) ? mx : mrun;
        const float alpha = __expf(mrun - mn);
        mrun = mn;
        float pr[8], ps = 0.f;
#pragma unroll
        for (int i = 0; i < 8; ++i) { pr[i] = (x[i] <= -1e29f) ? 0.f : __expf(x[i] - mn); ps += pr[i]; }
        ps = xrow_sum(ps);
        lrun = lrun * alpha + ps;
        if (__builtin_amdgcn_ballot_w64(alpha != 1.f) != 0ull) {
#pragma unroll
          for (int nt = 0; nt < 16; ++nt) o[nt] *= alpha;
        }
        union { bf16x8_t v; unsigned u[4]; } pf;
        pf.u[0] = pk2(pr[0] * r0[0], pr[1] * r0[1]); pf.u[1] = pk2(pr[2] * r0[2], pr[3] * r0[3]);
        pf.u[2] = pk2(pr[4] * r1[0], pr[5] * r1[1]); pf.u[3] = pk2(pr[6] * r1[2], pr[7] * r1[3]);
        asm volatile("" :: "v"(pf.u[0]));
        DSA_MARKI(13);
        {
          s16x4_t loA[4], hiA[4], loB[4], hiB[4];
#define PV_READ1(L, H, nt0, u) L[u] = tr_read_b64o<((nt0) + (u)) * 32>(vb); H[u] = tr_read_b64o<((nt0) + (u)) * 32 + 16 * DS_RS>(vb);
#define PV_READ(L, H, nt0) { PV_READ1(L, H, nt0, 0) PV_READ1(L, H, nt0, 1) PV_READ1(L, H, nt0, 2) PV_READ1(L, H, nt0, 3) }
#define PV_MMA(L, H, nt0) _Pragma("unroll") for (int u = 0; u < 4; ++u) { \
            const bf16x8_t af = (bf16x8_t){L[u][0], L[u][1], L[u][2], L[u][3], H[u][0], H[u][1], H[u][2], H[u][3]}; \
            o[(nt0) + u] = __builtin_amdgcn_mfma_f32_16x16x32_bf16(af, pf.v, o[(nt0) + u], 0, 0, 0); }
          PV_READ(loA, hiA, 0);
          PV_READ(loB, hiB, 4);
          asm volatile("s_waitcnt lgkmcnt(8)" ::: "memory"); __builtin_amdgcn_sched_barrier(0);
          PV_MMA(loA, hiA, 0); __builtin_amdgcn_sched_barrier(0);
          PV_READ(loA, hiA, 8);
          asm volatile("s_waitcnt lgkmcnt(8)" ::: "memory"); __builtin_amdgcn_sched_barrier(0);
          PV_MMA(loB, hiB, 4); __builtin_amdgcn_sched_barrier(0);
          PV_READ(loB, hiB, 12);
          asm volatile("s_waitcnt lgkmcnt(8)" ::: "memory"); __builtin_amdgcn_sched_barrier(0);
          PV_MMA(loA, hiA, 8); __builtin_amdgcn_sched_barrier(0);
          asm volatile("s_waitcnt lgkmcnt(0)" ::: "memory"); __builtin_amdgcn_sched_barrier(0);
          PV_MMA(loB, hiB, 12);
#undef PV_READ
#undef PV_READ1
#undef PV_MMA
        }
        wave_lds_fence();
        asm volatile("" :: "v"(o[0][0]), "v"(o[15][0]));
        DSA_MARKI(14);
      }
#undef DSA_ISSUE
      {
        const int ln = tid_fresh() & 63, g2 = ln >> 4, c2 = ln & 15;
        LAS unsigned char* tbo = lds + DS_KEY16 + wave_b * DS_CHUNK;
        const float inv = 1.f / lrun;
        if (c2 < 8) {
#pragma unroll
          for (int nt = 0; nt < 16; ++nt) {
            u32x2_t w; w.x = pk2(o[nt][0] * inv, o[nt][1] * inv); w.y = pk2(o[nt][2] * inv, o[nt][3] * inv);
            *(LAS u32x2_t*)(tbo + c2 * 528 + (nt * 16 + 4 * g2) * 2) = w;
          }
        }
        wave_lds_fence();
#pragma unroll
        for (int it = 0; it < 4; ++it) {
          const u32x4_t v = *(const LAS u32x4_t*)(tbo + (it * 2 + (ln >> 5)) * 528 + (ln & 31) * 16);
          *(u32x4_t*)(OLh + q * 2048 + it * 512 + ln * 8) = v;
        }
        wave_lds_fence();
      }
    }
  }
  DSA_MARK(4);
  if (half == 1) __syncthreads(); else LDS_BAR();
  }
  {
    DSA_IDS
    const int h = wave;
    bf16x8_t of0[8], of1[8];
    LAS unsigned char* tbC = lds + DS_KEY16 + wave * DS_CHUNK;
    {
      u32x4_t rr[16];
#pragma unroll
      for (int it = 0; it < 16; ++it) rr[it] = *(const u32x4_t*)(OL + (it * 2 + (lane >> 5)) * 2048 + h * 256 + (lane & 31) * 8);
#pragma unroll
      for (int it = 0; it < 16; ++it) *(LAS u32x4_t*)(tbC + (it * 2 + (lane >> 5)) * 528 + (lane & 31) * 16) = rr[it];
      wave_lds_fence();
#pragma unroll
      for (int ks = 0; ks < 8; ++ks) {
        of0[ks] = *(const LAS bf16x8_t*)(tbC + c * 528 + (ks * 32 + 8 * g) * 2);
        of1[ks] = *(const LAS bf16x8_t*)(tbC + (16 + c) * 528 + (ks * 32 + 8 * g) * 2);
      }
      wave_lds_fence();
    }
    {
      bf16x8_t wA[2][8], wB[2][8];
#define DSA_C_LOAD(W, q)                                                                                          \
      _Pragma("unroll") for (int n2 = 0; n2 < 2; ++n2)                                                            \
        _Pragma("unroll") for (int ks = 0; ks < 8; ++ks) W[n2][ks] = *(const bf16x8_t*)(WUV + (size_t)((h * 8 + (q) * 2 + n2) * 8 + ks) * 512 + lane * 8);
#define DSA_C_COMP(W, q)                                                                                          \
      _Pragma("unroll") for (int n2 = 0; n2 < 2; ++n2) {                                                          \
        const int nt = (q) * 2 + n2;                                                                              \
        f32x4 a0 = (f32x4){0.f, 0.f, 0.f, 0.f}, a1 = a0;                                                          \
        _Pragma("unroll") for (int ks = 0; ks < 8; ++ks) {                                                        \
          a0 = __builtin_amdgcn_mfma_f32_16x16x32_bf16(W[n2][ks], of0[ks], a0, 0, 0, 0);                          \
          a1 = __builtin_amdgcn_mfma_f32_16x16x32_bf16(W[n2][ks], of1[ks], a1, 0, 0, 0);                          \
        }                                                                                                         \
          \
        u32x2_t w; w.x = pk2(a0[0], a0[1]); w.y = pk2(a0[2], a0[3]);                                              \
        *(LAS u32x2_t*)(tbC + c * 272 + (nt * 16 + 4 * g) * 2) = w;                                               \
        w.x = pk2(a1[0], a1[1]); w.y = pk2(a1[2], a1[3]);                                                         \
        *(LAS u32x2_t*)(tbC + (16 + c) * 272 + (nt * 16 + 4 * g) * 2) = w;                                        \
      }
      DSA_C_LOAD(wA, 0) DSA_C_LOAD(wB, 1) __builtin_amdgcn_sched_barrier(0);
      DSA_C_COMP(wA, 0) __builtin_amdgcn_sched_barrier(0); DSA_C_LOAD(wA, 2) __builtin_amdgcn_sched_barrier(0);
      DSA_C_COMP(wB, 1) __builtin_amdgcn_sched_barrier(0); DSA_C_LOAD(wB, 3) __builtin_amdgcn_sched_barrier(0);
      DSA_C_COMP(wA, 2) __builtin_amdgcn_sched_barrier(0);
      DSA_C_COMP(wB, 3) __builtin_amdgcn_sched_barrier(0);
#undef DSA_C_LOAD
#undef DSA_C_COMP
    }
    wave_lds_fence();
#pragma unroll
    for (int it = 0; it < 8; ++it) {
      const int qr = it * 4 + (lane >> 4);
      const u32x4_t v = *(const LAS u32x4_t*)(tbC + qr * 272 + (lane & 15) * 16);
      *(u32x4_t*)(ODSA + (tok00 + qr) * 1024 + h * 128 + (lane & 15) * 8) = v;
    }
    wave_lds_fence();
  }
  DSA_MARK(5);
}

#undef DSA_IDS
__device__ __forceinline__ void ph_dsa512(const P& p, unsigned char* lds_raw) {
  for (int it = blockIdx.x; it < TT / 16; it += gridDim.x) {
    const int k = it >> 8, j = it & 255;
    dsa_batch(p, lds_raw, k, ((k & 1) ? 255 - j : j) >> 1);
  }
}

#define GL_QD    0
#define GL_KI    18432
#define GL_KE    36864
#define GL_V     55296
#define GL_AT    90112
#define GL_GLOW  99328
#define GL_QT    103424
#define GL_DEC   105472
#define GL_SSQ   105984
#define GL_LB    108032
#define GL_TOTAL 140800

#define GLA_BAR() do { asm volatile("s_waitcnt lgkmcnt(0)" ::: "memory"); __builtin_amdgcn_s_barrier(); asm volatile("" ::: "memory"); } while (0)
#ifndef PROBE_GLA
#define PROBE_GLA 0
#endif
#if PROBE_GLA
#define GLA_MARK(k) do { const unsigned long long n_ = __builtin_amdgcn_s_memrealtime(); if (PROBE_GLA == (k)) { const unsigned long long q_ = n_ - tmark; \
    while (__builtin_amdgcn_s_memrealtime() - n_ < q_) __builtin_amdgcn_s_sleep(2); } tmark = __builtin_amdgcn_s_memrealtime(); } while (0)
#else
#define GLA_MARK(k) do {} while (0)
#endif
__device__ __forceinline__ void gla_item(const P& p, unsigned char* lds_raw, int item) {
  int tid = tid_fresh();
  const int b = item >> 2, h = item & 3;
  const size_t tokb = (size_t)b * SEQ;
  const bf16* Qg = (const bf16*)(p.ws + OFF_Q);
  const bf16* Kg = (const bf16*)(p.ws + OFF_K);
  bf16* Vg = (bf16*)(p.ws + OFF_V);
  const float* GLOWg = (const float*)(p.ws + OFF_GLOW);
  const bf16* SGR = (const bf16*)(p.ws + OFF_SGR);
  LAS unsigned char* lds = (LAS unsigned char*)lds_raw;
  const unsigned lds0 = (unsigned)(uintptr_t)lds;
  LAS float* QT = (LAS float*)(lds + GL_QT);
  LAS float* DEC = (LAS float*)(lds + GL_DEC);
  LAS float* SSQ = (LAS float*)(lds + GL_SSQ);
  float wg[16];
  const float* prm = (const float*)(p.ws + OFF_PRM);
#pragma unroll
  for (int r = 0; r < 16; ++r) wg[r] = prm[PRM_WGU + r * 512 + h * 128 + (tid & 127)];
  const float bg = prm[PRM_BG + h * 128 + (tid & 127)];
  const float gn0 = prm[PRM_GNG + h * 256 + 32 * (tid >> 6) + (tid & 15)], gn1 = prm[PRM_GNG + h * 256 + 32 * (tid >> 6) + 16 + (tid & 15)];
  u32x4_t rq[2], rk[2], rv[4], rg = (u32x4_t){0u, 0u, 0u, 0u};
#define GLA_LOAD(ch)                                                                                      \
  {                                                                                                       \
    const size_t tb = tokb + (size_t)(ch) * 64;                                                           \
    _Pragma("unroll") for (int i = 0; i < 2; ++i) {                                                       \
      const int id = tid + 512 * i, tk = id >> 4, part = id & 15;                                         \
      rq[i] = *(const u32x4_t*)(Qg + (tb + tk) * 512 + h * 128 + part * 8);                               \
      rk[i] = *(const u32x4_t*)(Kg + (tb + tk) * 512 + h * 128 + part * 8);                               \
    }                                                                                                     \
    _Pragma("unroll") for (int i = 0; i < 4; ++i) {                                                       \
      const int id = tid + 512 * i, tk = id >> 5, part = id & 31;                                         \
      rv[i] = *(const u32x4_t*)(Vg + (tb + tk) * 1024 + h * 256 + part * 8);                              \
    }                                                                                                     \
    if (tid < 256) rg = *(const u32x4_t*)(GLOWg + (tb + (tid >> 2)) * 16 + (tid & 3) * 4);                \
  }
  f32x4 S[8][2];
#pragma unroll
  for (int a = 0; a < 8; ++a) { S[a][0] = (f32x4){0.f, 0.f, 0.f, 0.f}; S[a][1] = (f32x4){0.f, 0.f, 0.f, 0.f}; }
  GLA_LOAD(0);
#if PROBE_GLA
  unsigned long long tmark = __builtin_amdgcn_s_memrealtime();
#endif
#pragma unroll 1
  for (int ch = 0; ch < SEQ / 64; ++ch) {
    asm volatile("" : "+v"(tid));
    const int wave = __builtin_amdgcn_readfirstlane(tid >> 6), lane = tid & 63, g = lane >> 4, c = lane & 15;
    const int d = tid & 127, tq = __builtin_amdgcn_readfirstlane(tid >> 7);
    const unsigned vtr = lds0 + GL_V + (unsigned)((8 * g + (c >> 2)) * 544 + (32 * wave + 4 * (c & 3)) * 2);
    const unsigned ketr = lds0 + GL_KE + (unsigned)((8 * g + (c >> 2)) * 288 + (4 * (c & 3)) * 2);
    const size_t tb = tokb + (size_t)ch * 64;
#pragma unroll
    for (int i = 0; i < 2; ++i) {
      const int id = tid + 512 * i, tk = id >> 4, part = id & 15;
      *(LAS u32x4_t*)(lds + GL_QD + tk * 288 + part * 16) = rq[i];
      *(LAS u32x4_t*)(lds + GL_KI + tk * 288 + part * 16) = rk[i];
    }
#pragma unroll
    for (int i = 0; i < 4; ++i) {
      const int id = tid + 512 * i, tk = id >> 5, part = id & 31;
      *(LAS u32x4_t*)(lds + GL_V + tk * 544 + part * 16) = rv[i];
    }
    if (tid < 256) *(LAS u32x4_t*)(lds + GL_GLOW + (tid >> 2) * 64 + (tid & 3) * 16) = rg;
    GLA_MARK(1); GLA_BAR();
    GLA_LOAD((ch + 1 < SEQ / 64) ? ch + 1 : ch);
    u32x4_t rs[4];
#pragma unroll
    for (int i = 0; i < 4; ++i) {
      const int id = tid + 512 * i, tk = id >> 5, part = id & 31;
      rs[i] = *(const u32x4_t*)(SGR + (tb + tk) * 1024 + h * 256 + part * 8);
    }
    LAS float* LB = (LAS float*)(lds + GL_LB);
    float run = 0.f;
#pragma unroll 2
    for (int i = 0; i < 16; ++i) {
      const LAS f32x4* gp = (const LAS f32x4*)(lds + GL_GLOW + (16 * tq + i) * 64);
      const f32x4 g0 = gp[0], g1 = gp[1], g2 = gp[2], g3 = gp[3];
      float gl = bg;
      gl += g0[0] * wg[0] + g0[1] * wg[1] + g0[2] * wg[2] + g0[3] * wg[3];
      gl += g1[0] * wg[4] + g1[1] * wg[5] + g1[2] * wg[6] + g1[3] * wg[7];
      gl += g2[0] * wg[8] + g2[1] * wg[9] + g2[2] * wg[10] + g2[3] * wg[11];
      gl += g3[0] * wg[12] + g3[1] * wg[13] + g3[2] * wg[14] + g3[3] * wg[15];
      const float ls = fminf(gl, 0.f) - __logf(1.f + __expf(-fabsf(gl)));
      run += ls * (1.f / 16.f);
      LB[(16 * tq + i) * 128 + d] = run;
    }
    QT[tq * 128 + d] = run;
    GLA_MARK(2); GLA_BAR();
    {
      float off = 0.f, tot = 0.f;
#pragma unroll
      for (int k = 0; k < 4; ++k) { const float v = QT[k * 128 + d]; tot += v; off += (k < tq) ? v : 0.f; }
      const float eb = __expf(tot);
#pragma unroll 2
      for (int i = 0; i < 16; ++i) {
        const int t = 16 * tq + i;
        const float bb = LB[t * 128 + d] + off;
        const float e = __expf(bb), r = __expf(-bb);
        LAS bf16* qp = (LAS bf16*)(lds + GL_QD + t * 288) + d;
        LAS bf16* kp = (LAS bf16*)(lds + GL_KI + t * 288) + d;
        LAS bf16* ep = (LAS bf16*)(lds + GL_KE + t * 288) + d;
        const float q = bf2f(*qp), k = bf2f(*kp);
        *qp = f2bf(q * e);
        *kp = f2bf(k * r);
        *ep = f2bf(k * (eb * r));
      }
      if (tq == 0) DEC[d] = eb;
    }
    GLA_MARK(3); GLA_BAR();
    {
      const int ti = wave >> 1;
#pragma unroll
      for (int u = 0; u < 2; ++u) {
        const int tj = 2 * (wave & 1) + u;
        f32x4 acc = (f32x4){0.f, 0.f, 0.f, 0.f};
        if (tj <= ti) {
#pragma unroll
          for (int ks = 0; ks < 4; ++ks) {
            const bf16x8_t a = *(const LAS bf16x8_t*)(lds + GL_QD + (16 * ti + c) * 288 + (32 * ks + 8 * g) * 2);
            const bf16x8_t bb = *(const LAS bf16x8_t*)(lds + GL_KI + (16 * tj + c) * 288 + (32 * ks + 8 * g) * 2);
            acc = __builtin_amdgcn_mfma_f32_16x16x32_bf16(a, bb, acc, 0, 0, 0);
          }
        }
#pragma unroll
        for (int r = 0; r < 4; ++r) {
          const int i = 16 * ti + 4 * g + r, j = 16 * tj + c;
          *((LAS bf16*)(lds + GL_AT + i * 144) + j) = f2bf((j <= i) ? acc[r] : 0.f);
        }
      }
    }
    GLA_MARK(4); GLA_BAR();
    f32x4 o[4][2];
    {
      bf16x8_t vf[2][2];
      {
        s16x4_t lo[4], hi[4];
#pragma unroll
        for (int ks = 0; ks < 2; ++ks)
#pragma unroll
          for (int tn = 0; tn < 2; ++tn) {
            lo[ks * 2 + tn] = tr_read_b64(vtr + (32 * ks) * 544 + tn * 32);
            hi[ks * 2 + tn] = tr_read_b64(vtr + (32 * ks + 4) * 544 + tn * 32);
          }
        asm volatile("s_waitcnt lgkmcnt(0)" ::: "memory");
        __builtin_amdgcn_sched_barrier(0);
#pragma unroll
        for (int u = 0; u < 4; ++u)
          vf[u >> 1][u & 1] = (bf16x8_t){lo[u][0], lo[u][1], lo[u][2], lo[u][3], hi[u][0], hi[u][1], hi[u][2], hi[u][3]};
      }
#pragma unroll
      for (int tm = 0; tm < 4; ++tm) { o[tm][0] = (f32x4){0.f, 0.f, 0.f, 0.f}; o[tm][1] = (f32x4){0.f, 0.f, 0.f, 0.f}; }
#pragma unroll
      for (int tm = 0; tm < 4; ++tm)
#pragma unroll
        for (int ks = 0; ks < 2; ++ks) {
          if (ks == 1 && tm < 2) continue;
          const bf16x8_t a = *(const LAS bf16x8_t*)(lds + GL_AT + (16 * tm + c) * 144 + (32 * ks + 8 * g) * 2);
          o[tm][0] = __builtin_amdgcn_mfma_f32_16x16x32_bf16(a, vf[ks][0], o[tm][0], 0, 0, 0);
          o[tm][1] = __builtin_amdgcn_mfma_f32_16x16x32_bf16(a, vf[ks][1], o[tm][1], 0, 0, 0);
          __builtin_amdgcn_sched_barrier(0);
        }
#pragma unroll
      for (int u = 0; u < 4; ++u) {
        union { bf16x8_t v; unsigned w[4]; } s0, s1;
        s0.w[0] = pk2(S[2 * u][0][0], S[2 * u][0][1]); s0.w[1] = pk2(S[2 * u][0][2], S[2 * u][0][3]);
        s0.w[2] = pk2(S[2 * u + 1][0][0], S[2 * u + 1][0][1]); s0.w[3] = pk2(S[2 * u + 1][0][2], S[2 * u + 1][0][3]);
        s1.w[0] = pk2(S[2 * u][1][0], S[2 * u][1][1]); s1.w[1] = pk2(S[2 * u][1][2], S[2 * u][1][3]);
        s1.w[2] = pk2(S[2 * u + 1][1][0], S[2 * u + 1][1][1]); s1.w[3] = pk2(S[2 * u + 1][1][2], S[2 * u + 1][1][3]);
#pragma unroll
        for (int tm = 0; tm < 4; ++tm) {
          const LAS unsigned char* qrow = lds + GL_QD + (16 * tm + c) * 288 + (32 * u + 4 * g) * 2;
          const s16x4_t q0 = *(const LAS s16x4_t*)qrow, q1 = *(const LAS s16x4_t*)(qrow + 32);
          const bf16x8_t a = (bf16x8_t){q0[0], q0[1], q0[2], q0[3], q1[0], q1[1], q1[2], q1[3]};
          o[tm][0] = __builtin_amdgcn_mfma_f32_16x16x32_bf16(a, s0.v, o[tm][0], 0, 0, 0);
          o[tm][1] = __builtin_amdgcn_mfma_f32_16x16x32_bf16(a, s1.v, o[tm][1], 0, 0, 0);
        }
        __builtin_amdgcn_sched_barrier(0);
      }
#pragma unroll
      for (int tk = 0; tk < 8; ++tk) {
        const f32x4 dec4 = *(const LAS f32x4*)(DEC + 16 * tk + 4 * g);
        S[tk][0] *= dec4; S[tk][1] *= dec4;
        s16x4_t lo0 = tr_read_b64(ketr + tk * 32), hi0 = tr_read_b64(ketr + 4 * 288 + tk * 32);
        s16x4_t lo1 = tr_read_b64(ketr + 32 * 288 + tk * 32), hi1 = tr_read_b64(ketr + 36 * 288 + tk * 32);
        asm volatile("s_waitcnt lgkmcnt(0)" ::: "memory");
        __builtin_amdgcn_sched_barrier(0);
        const bf16x8_t a0 = (bf16x8_t){lo0[0], lo0[1], lo0[2], lo0[3], hi0[0], hi0[1], hi0[2], hi0[3]};
        const bf16x8_t a1 = (bf16x8_t){lo1[0], lo1[1], lo1[2], lo1[3], hi1[0], hi1[1], hi1[2], hi1[3]};
        S[tk][0] = __builtin_amdgcn_mfma_f32_16x16x32_bf16(a0, vf[0][0], S[tk][0], 0, 0, 0);
        S[tk][1] = __builtin_amdgcn_mfma_f32_16x16x32_bf16(a0, vf[0][1], S[tk][1], 0, 0, 0);
        S[tk][0] = __builtin_amdgcn_mfma_f32_16x16x32_bf16(a1, vf[1][0], S[tk][0], 0, 0, 0);
        S[tk][1] = __builtin_amdgcn_mfma_f32_16x16x32_bf16(a1, vf[1][1], S[tk][1], 0, 0, 0);
        __builtin_amdgcn_sched_barrier(0);
      }
#pragma unroll
      for (int tm = 0; tm < 4; ++tm)
#pragma unroll
        for (int r = 0; r < 4; ++r) {
          float ss = o[tm][0][r] * o[tm][0][r] + o[tm][1][r] * o[tm][1][r];
          ss = row16_sum(ss);
          if (c == 0) SSQ[(16 * tm + 4 * g + r) * 8 + wave] = ss;
        }
    }
    GLA_MARK(5); GLA_BAR();
    {
      LAS bf16* OB = (LAS bf16*)(lds + GL_LB);
#pragma unroll
      for (int tm = 0; tm < 4; ++tm)
#pragma unroll
        for (int r = 0; r < 4; ++r) {
          const int t = 16 * tm + 4 * g + r;
          const f32x4 p0 = *(const LAS f32x4*)(SSQ + t * 8), p1 = *(const LAS f32x4*)(SSQ + t * 8 + 4);
          const float tot = ((p0[0] + p0[1]) + (p0[2] + p0[3])) + ((p1[0] + p1[1]) + (p1[2] + p1[3]));
          const float rstd = rsqrtf(tot * (1.f / 256.f) + 1e-6f);
          OB[t * 256 + 32 * wave + c] = f2bf(o[tm][0][r] * rstd * gn0);
          OB[t * 256 + 32 * wave + 16 + c] = f2bf(o[tm][1][r] * rstd * gn1);
        }
    }
    GLA_MARK(6); GLA_BAR();
#pragma unroll
    for (int i = 0; i < 4; ++i) {
      const int id = tid + 512 * i, tk = id >> 5, part = id & 31;
      const u32x4_t ov = *(const LAS u32x4_t*)(lds + GL_LB + tk * 512 + part * 16);
      const u32x4_t sv = rs[i];
      u32x4_t gv;
      gv[0] = pk2(bflo(ov[0]) * bflo(sv[0]), bfhi(ov[0]) * bfhi(sv[0]));
      gv[1] = pk2(bflo(ov[1]) * bflo(sv[1]), bfhi(ov[1]) * bfhi(sv[1]));
      gv[2] = pk2(bflo(ov[2]) * bflo(sv[2]), bfhi(ov[2]) * bfhi(sv[2]));
      gv[3] = pk2(bflo(ov[3]) * bflo(sv[3]), bfhi(ov[3]) * bfhi(sv[3]));
      *(u32x4_t*)(Vg + (tb + tk) * 1024 + h * 256 + part * 8) = gv;
    }
    GLA_MARK(7);
  }
#undef GLA_LOAD
  __syncthreads();
}

#define LDS_BYTES 155712
#define OFF_XBAR (224ull * 1024)
#define OFF_CTR (200ull * 1024)

__device__ __forceinline__ unsigned xcc_id() { return (unsigned)__builtin_amdgcn_s_getreg((3 << 11) | 20) & 0x7u; }
__device__ __forceinline__ void ph_mixer(const P& p, unsigned char* lds_raw, bool do_gla) {
  if (do_gla && blockIdx.x < 32) { gla_item(p, lds_raw, blockIdx.x); if (blockIdx.x == 0) TS_SET(p, 20); }
  unsigned* ctr = (unsigned*)(p.ws + OFF_CTR);
  LAS unsigned* slot = (LAS unsigned*)((LAS unsigned char*)lds_raw + DS_TOTAL);
  const unsigned home = xcc_id();
  unsigned k = 0;
  for (;;) {
    if (tid_fresh() == 0) {
      unsigned qi = 0xffffffffu;
      while (k < 8) {
        const unsigned b = (home + k) & 7u;
        const unsigned v = __hip_atomic_fetch_add(ctr + 64 * b, 1u, __ATOMIC_RELAXED, __HIP_MEMORY_SCOPE_AGENT);
        if (v < 128u) { qi = (b << 8) | v; break; }
        ++k;
      }
      slot[0] = qi; slot[1] = k;
    }
    LDS_BAR();
    const unsigned qi = slot[0];
    k = slot[1];
    LDS_BAR();
    if (qi == 0xffffffffu) break;
    dsa_batch(p, lds_raw, (int)(qi >> 8), 127 - (int)(qi & 255u));
  }
  for (;;) {
    if (tid_fresh() == 0) slot[0] = __hip_atomic_fetch_add(ctr + 64 * 8, 1u, __ATOMIC_RELAXED, __HIP_MEMORY_SCOPE_AGENT);
    __syncthreads();
    const unsigned ch = slot[0];
    __syncthreads();
    if (ch >= 512u) break;
    peer_tab_convert(p, (int)ch * 64 + (tid_fresh() >> 6), (int)ch * 64 + 64, 8);
  }
}

__global__ void __launch_bounds__(512, 2) mega(P p) {
  extern __shared__ __attribute__((aligned(16))) unsigned char lds_raw[];
  LAS unsigned char* lds = (LAS unsigned char*)lds_raw;
  char* ws = p.ws;
  const int bid = blockIdx.x, nb = gridDim.x;
  volatile LAS unsigned* xst = (volatile LAS unsigned*)(lds + DS_TOTAL + 16);
  if (threadIdx.x < 4) xst[threadIdx.x] = 0u;
  const XcdBarrier xb = xcd_barrier_post((unsigned*)(ws + OFF_XBAR), xst);
  pair_post_id((unsigned*)(ws + OFF_XBAR) + XP_WORD((bid >> 5) * 8 + (bid & 7)), (bid >> 3) & 3, xb.x);
#if PROBE_TS
  { const int t_ = tid_fresh(); if (bid == 0 && t_ < 64) ((unsigned long long*)(ws + OFF_TS))[t_] = 0ull; }
  __syncthreads();
  if (bid == 0) TS_SET(p, 0);
#endif
  ph_prep(p, (float*)lds_raw);
  xcd_barrier(xb);
  if (bid == 0) TS_SET(p, 1);
  ph_mod<false>(p, p.x, p.norm1_g, 0, 1024, (bf16*)(ws + OFF_H), bid, nb);
  xcd_barrier(xb);
  if (bid == 0) TS_SET(p, 2);
  gemm_run(lds, (const bf16*)(ws + OFF_H), (const bf16*)(ws + OFF_WT_IN), TT, 7168, 1024, EpiIn{ws, p.out});
  xcd_barrier(xb);
  if (bid == 0) TS_SET(p, 3);
  ph_mixer(p, lds_raw, true);
  if (bid == 0) TS_SET(p, 21);
  xcd_barrier(xb);
  if (bid == 0) TS_SET(p, 4);
  {
    const int mj = (bid >> 3) & 3, gq = (bid >> 5) * 8 + (bid & 7);
    unsigned* bar = (unsigned*)(ws + OFF_XBAR);
    unsigned* pf = bar + XP_WORD(gq);
    unsigned tgt = 0u;
    for (int pm = 2 * gq; pm < TT / 256; pm += (nb >> 1)) {
      gemm_run_split_pair(lds, (const bf16*)(ws + OFF_V), (const bf16*)(ws + OFF_WT_A), (const bf16*)(ws + OFF_ODSA), (const bf16*)(ws + OFF_WT_B), TT, 1024, 2048,
                          EpiMixMerged{(const bf16*)p.out, (const bf16*)p.out + (size_t)TT * 1024, (bf16*)(ws + OFF_MIX)}, pm, mj, 0);
      pair_sync(bar, pf, tgt + 4u, mj, xb.x);
      if (threadIdx.x == 0) (void)xb_add(bar + XP_WORD(100), 1u);
      gemm_run_pair(lds, (const bf16*)(ws + OFF_MIX), (const bf16*)(ws + OFF_WT_OUT), TT, 1024, 1024,
                    EpiX1{p.x, (const float*)(ws + OFF_ADA), (bf16*)(ws + OFF_X1)}, pm, mj, 0);
      pair_sync(bar, pf, tgt + 8u, mj, xb.x);
      ph_mod_rows<true>(p, ws + OFF_X1, (const float*)(ws + OFF_PRM) + PRM_N2G, 3072, 4096, (bf16*)(ws + OFF_H), pm * 256 + mj * 128, 8, pm * 256 + mj * 128 + 128);
      pair_sync(bar, pf, tgt + 12u, mj, xb.x);
      gemm_run_pair(lds, (const bf16*)(ws + OFF_H), (const bf16*)(ws + OFF_WT_Q), TT, 2048, 1024, EpiPlain{(bf16*)(ws + OFF_PQ), 2048}, pm, mj * 2, 1);
      tgt += 12u;
    }
    if (nb == 256) {
      pair_sync(bar, pf, tgt + 4u, mj, xb.x);
      if (threadIdx.x == 0) XB_SPIN(xb_ld(bar + XP_WORD(100)) < 256u, bar);
      __syncthreads();
    } else xcd_barrier(xb);
    if (bid == 0) TS_SET(p, 8);
    ph_peer512(p, lds_raw, p.out, xb, (nb == 256) ? gq * 4 + mj : bid);
  }
#if PROBE_TS
  if (bid == 0) TS_SET(p, 18);
  xcd_barrier(xb);
  {
    const unsigned long long* T = (const unsigned long long*)(ws + OFF_TS);
    const unsigned long long q = (unsigned long long)(PROBE_Q), t0 = __builtin_amdgcn_s_memrealtime();
    while (__builtin_amdgcn_s_memrealtime() - t0 < q) __builtin_amdgcn_s_sleep(8);
  }
#endif
}

extern "C" void kernel_launch(void* const* d_in, const int* in_sizes, int n_in, void* d_out, int out_size, void* d_ws,
                              size_t ws_size, hipStream_t stream) {
  P p{};
  const float** f = (const float**)&p;
  for (int i = 0; i < 22; ++i) f[i] = (const float*)d_in[i];
  p.out = (float*)d_out;
  p.ws = (char*)d_ws;
  if (ws_size < WS_NEED) { fprintf(stderr, "workspace too small: %zu\n", ws_size); return; }
  static int grid_blocks = 0;
  if (!grid_blocks) {
    int dev = 0, cus = 0, per_cu = 0;
    (void)hipGetDevice(&dev);
    (void)hipDeviceGetAttribute(&cus, hipDeviceAttributeMultiprocessorCount, dev);
    if (hipFuncSetAttribute((const void*)mega, hipFuncAttributeMaxDynamicSharedMemorySize, LDS_BYTES) != hipSuccess) {
      fprintf(stderr, "hipFuncSetAttribute failed\n"); grid_blocks = -1; return;
    }
    if (hipOccupancyMaxActiveBlocksPerMultiprocessor(&per_cu, (const void*)mega, 512, LDS_BYTES) != hipSuccess || per_cu < 1) {
      fprintf(stderr, "occupancy query failed\n"); grid_blocks = -1; return;
    }
    grid_blocks = (cus < 256 ? cus : 256) & ~31;
  }
  if (grid_blocks <= 0) return;
  if (hipMemsetAsync((char*)d_ws + OFF_CTR, 0, (size_t)(OFF_XBAR + (XCD_BAR_WORDS + XP_WORDS) * 4 - OFF_CTR), stream) != hipSuccess) { fprintf(stderr, "memset failed\n"); return; }
  void* args[] = {&p};
  hipError_t e = hipLaunchCooperativeKernel((void*)mega, dim3(grid_blocks), dim3(512), args, LDS_BYTES, stream);
  if (e != hipSuccess) fprintf(stderr, "cooperative launch failed: %s (grid %d)\n", hipGetErrorString(e), grid_blocks);
}
```
